# Optimizing an MI355X kernel written in HIP

```python
import jax, jax.numpy as jnp
from jax import lax
import numpy as np

D_MODEL = 2048
BATCH = 1
SEQ = 8192
DEPTH = 1
DEC_BATCH = 128
DEC_SEQ = 1
PAST_LEN = 8192
PAGE_SIZE = 128

ATT_HEADS = 16
ATT_KV_HEADS = 2
ATT_HEAD_DIM = 64
ATT_GROUP = ATT_HEADS // ATT_KV_HEADS
WINDOW = 128
BLOCK = WINDOW
RET_HEADS = 4
RET_DK = 256
RET_DV = 256
RET_CHUNK = 128
ROPE_BASE = 10000.0
D_FF = 4 * D_MODEL
EPS = 1e-6

ATT_WIDTH = ATT_HEADS * ATT_HEAD_DIM
KV_WIDTH = ATT_KV_HEADS * ATT_HEAD_DIM
RET_QK_WIDTH = RET_HEADS * RET_DK
RET_V_WIDTH = RET_HEADS * RET_DV
MIX_WIDTH = ATT_WIDTH + RET_V_WIDTH
IN_WIDTH = ATT_WIDTH + 2 * KV_WIDTH + 2 * RET_QK_WIDTH + 2 * RET_V_WIDTH
IN_SPLITS = (ATT_WIDTH,
             ATT_WIDTH + KV_WIDTH,
             ATT_WIDTH + 2 * KV_WIDTH,
             ATT_WIDTH + 2 * KV_WIDTH + RET_QK_WIDTH,
             ATT_WIDTH + 2 * KV_WIDTH + 2 * RET_QK_WIDTH,
             ATT_WIDTH + 2 * KV_WIDTH + 2 * RET_QK_WIDTH + RET_V_WIDTH)

kernel_name = 'hymba_swa_sink_retention_decoder_step'


def _rmsnorm(x, g):
    xf = x.astype(jnp.float32)
    var = jnp.mean(jnp.square(xf), axis=-1, keepdims=True)
    return (xf * lax.rsqrt(var + EPS) * g.astype(jnp.float32)).astype(x.dtype)


def _rotary(x, pos):
    half = x.shape[-1] // 2
    inv = ROPE_BASE ** (-jnp.arange(half, dtype=jnp.float32) / half)
    ang = pos.astype(jnp.float32)[:, None] * inv[None, :]
    cos = jnp.cos(ang)[None, :, None, :]
    sin = jnp.sin(ang)[None, :, None, :]
    xf = x.astype(jnp.float32)
    x1, x2 = xf[..., :half], xf[..., half:]
    return jnp.concatenate([x1 * cos - x2 * sin, x2 * cos + x1 * sin], axis=-1).astype(x.dtype)


def _sink_softmax(s, mask, sinks):
    s = jnp.where(mask, s, -jnp.inf)
    sk = sinks.astype(jnp.float32).reshape(ATT_KV_HEADS, ATT_GROUP)[:, :, None, None]
    m = jnp.maximum(jnp.max(s, axis=-1, keepdims=True), sk)
    p = jnp.exp(s - m)
    return p / (jnp.sum(p, axis=-1, keepdims=True) + jnp.exp(sk - m))


def _swa_prompt(q, k, v, sinks):
    B, L = q.shape[:2]
    nb = L // BLOCK
    qb = q.reshape(B, nb, BLOCK, ATT_KV_HEADS, ATT_GROUP, ATT_HEAD_DIM)
    kb = k.reshape(B, nb, BLOCK, ATT_KV_HEADS, ATT_HEAD_DIM)
    vb = v.reshape(B, nb, BLOCK, ATT_KV_HEADS, ATT_HEAD_DIM)
    shift = ((0, 0), (1, 0), (0, 0), (0, 0), (0, 0))
    kk = jnp.concatenate([jnp.pad(kb[:, :-1], shift), kb], axis=2)
    vv = jnp.concatenate([jnp.pad(vb[:, :-1], shift), vb], axis=2)
    s = jnp.einsum('bnikgd,bnjkd->bnkgij', qb, kk,
                   preferred_element_type=jnp.float32) * (ATT_HEAD_DIM ** -0.5)
    blk = jnp.arange(nb)[:, None]
    qpos = blk * BLOCK + jnp.arange(BLOCK)[None, :]
    kpos = (blk - 1) * BLOCK + jnp.arange(2 * BLOCK)[None, :]
    rel = qpos[:, :, None] - kpos[:, None, :]
    mask = (rel >= 0) & (rel <= WINDOW) & (kpos[:, None, :] >= 0)
    p = _sink_softmax(s, mask[None, :, None, None], sinks)
    o = jnp.einsum('bnkgij,bnjkd->bnikgd', p.astype(v.dtype), vv)
    wb = min(WINDOW, L)
    return o.reshape(B, L, ATT_WIDTH), k[:, L - wb:], v[:, L - wb:]


def _swa_decode(q, k, v, k_buf, v_buf, sinks):
    B, T = q.shape[:2]
    W = k_buf.shape[1]
    kk = jnp.concatenate([k_buf, k], axis=1)
    vv = jnp.concatenate([v_buf, v], axis=1)
    qg = q.reshape(B, T, ATT_KV_HEADS, ATT_GROUP, ATT_HEAD_DIM)
    s = jnp.einsum('btkgd,bjkd->bkgtj', qg, kk,
                   preferred_element_type=jnp.float32) * (ATT_HEAD_DIM ** -0.5)
    qpos = PAST_LEN + jnp.arange(T)
    kpos = jnp.concatenate([PAST_LEN - W + jnp.arange(W), PAST_LEN + jnp.arange(T)])
    rel = qpos[:, None] - kpos[None, :]
    mask = (rel >= 0) & (rel <= WINDOW)
    p = _sink_softmax(s, mask[None, None, None], sinks)
    o = jnp.einsum('bkgtj,bjkd->btkgd', p.astype(v.dtype), vv)
    return o.reshape(B, T, ATT_WIDTH), kk[:, T:], vv[:, T:]


def _retention(q, k, v, s0):
    B, L = q.shape[:2]
    C = RET_CHUNK if L % RET_CHUNK == 0 else L
    n = L // C
    log_g = jnp.log1p(-jnp.exp2(-5.0 - jnp.arange(RET_HEADS, dtype=jnp.float32)))
    idx = jnp.arange(C, dtype=jnp.float32)
    rel = idx[:, None] - idx[None, :]
    dmask = jnp.where(rel[None] >= 0,
                      jnp.exp(log_g[:, None, None] * jnp.maximum(rel, 0.0)[None]), 0.0)
    qc = q.reshape(B, n, C, RET_HEADS, RET_DK)
    kc = k.reshape(B, n, C, RET_HEADS, RET_DK)
    vc = v.reshape(B, n, C, RET_HEADS, RET_DV)
    att = jnp.einsum('bnihd,bnjhd->bnhij', qc, kc) * dmask
    o_intra = jnp.einsum('bnhij,bnjhv->bnihv', att, vc)
    k_dec = kc * jnp.exp(log_g[None, :] * (C - 1.0 - idx)[:, None])[None, None, :, :, None]
    kv = jnp.einsum('bnjhd,bnjhv->bnhdv', k_dec, vc)
    chunk_decay = jnp.exp(log_g * C)[:, None, None]

    def step(s, kv_n):
        return chunk_decay * s + kv_n, s

    s_final, s_prev = lax.scan(step, s0, jnp.moveaxis(kv, 1, 0))
    s_prev = jnp.moveaxis(s_prev, 0, 1)
    q_dec = qc * jnp.exp(log_g[None, :] * (idx + 1.0)[:, None])[None, None, :, :, None]
    o_inter = jnp.einsum('bnihd,bnhdv->bnihv', q_dec, s_prev)
    return (o_intra + o_inter).reshape(B, L, RET_HEADS, RET_DV), s_final


def _layer(x, pos, k_buf, v_buf, s0, ln1_g, w_in, q_norm_g, k_norm_g, attn_sinks,
           ret_norm_g, w_out, ln2_g, w_up, w_down):
    B, L, _ = x.shape
    h = _rmsnorm(x, ln1_g)
    z = h @ w_in
    aq, ak, av, rq, rk, rv, rg = jnp.split(z, IN_SPLITS, axis=-1)
    aq = _rmsnorm(aq.reshape(B, L, ATT_HEADS, ATT_HEAD_DIM), q_norm_g)
    ak = _rmsnorm(ak.reshape(B, L, ATT_KV_HEADS, ATT_HEAD_DIM), k_norm_g)
    av = av.reshape(B, L, ATT_KV_HEADS, ATT_HEAD_DIM)
    if k_buf is None:
        a_out, k_new, v_new = _swa_prompt(aq, ak, av, attn_sinks)
    else:
        a_out, k_new, v_new = _swa_decode(aq, ak, av, k_buf, v_buf, attn_sinks)
    rq = _rotary(rq.reshape(B, L, RET_HEADS, RET_DK), pos)
    rk = _rotary(rk.reshape(B, L, RET_HEADS, RET_DK), pos)
    rv = rv.reshape(B, L, RET_HEADS, RET_DV)
    r_o, s_new = _retention(rq.astype(jnp.float32),
                            rk.astype(jnp.float32) * (RET_DK ** -0.5),
                            rv.astype(jnp.float32), s0.astype(jnp.float32))
    r_o = _rmsnorm(r_o, ret_norm_g.reshape(RET_HEADS, RET_DV)).reshape(B, L, RET_V_WIDTH)
    r_out = r_o.astype(x.dtype) * jax.nn.silu(rg)
    x = x + jnp.concatenate([a_out, r_out], axis=-1) @ w_out
    h2 = _rmsnorm(x, ln2_g)
    x = x + jnp.square(jax.nn.relu(h2 @ w_up)) @ w_down
    return x, k_new, v_new, s_new.astype(x.dtype)


def setup_inputs(seed: int = 0) -> dict:
    key = jax.random.key(seed)
    ks = jax.random.split(key, 16)
    wb = min(WINDOW, PAST_LEN)
    f32 = jnp.float32
    nrm = lambda k, shape, scale: jax.random.normal(k, shape, f32) * scale
    return {
        'x_prompt': nrm(ks[0], (BATCH, SEQ, D_MODEL), 1.0),
        'x_sample': nrm(ks[1], (DEC_BATCH, DEC_SEQ, D_MODEL), 1.0),
        'cache_k_win': nrm(ks[2], (DEPTH, DEC_BATCH, wb, ATT_KV_HEADS, ATT_HEAD_DIM), 1.0),
        'cache_v_win': nrm(ks[3], (DEPTH, DEC_BATCH, wb, ATT_KV_HEADS, ATT_HEAD_DIM), 1.0),
        'state_ret': nrm(ks[4], (DEPTH, DEC_BATCH, RET_HEADS, RET_DK, RET_DV), 0.3),
        'ln1_g': 1.0 + nrm(ks[5], (DEPTH, D_MODEL), 0.02),
        'w_in': nrm(ks[6], (DEPTH, D_MODEL, IN_WIDTH), D_MODEL ** -0.5),
        'q_norm_g': 1.0 + nrm(ks[7], (DEPTH, ATT_HEAD_DIM), 0.02),
        'k_norm_g': 1.0 + nrm(ks[8], (DEPTH, ATT_HEAD_DIM), 0.02),
        'attn_sinks': nrm(ks[9], (DEPTH, ATT_HEADS), 0.5),
        'ret_norm_g': 1.0 + nrm(ks[10], (DEPTH, RET_V_WIDTH), 0.02),
        'w_out': nrm(ks[11], (DEPTH, MIX_WIDTH, D_MODEL), MIX_WIDTH ** -0.5),
        'ln2_g': 1.0 + nrm(ks[12], (DEPTH, D_MODEL), 0.02),
        'w_up': nrm(ks[13], (DEPTH, D_MODEL, D_FF), D_MODEL ** -0.5),
        'w_down': nrm(ks[14], (DEPTH, D_FF, D_MODEL), D_FF ** -0.5),
    }


def reference(x_prompt, x_sample, cache_k_win, cache_v_win, state_ret, ln1_g, w_in, q_norm_g,
              k_norm_g, attn_sinks, ret_norm_g, w_out, ln2_g, w_up, w_down):
    pos_p = jnp.arange(x_prompt.shape[1], dtype=jnp.int32)
    pos_s = PAST_LEN + jnp.arange(x_sample.shape[1], dtype=jnp.int32)
    yp, ys = x_prompt, x_sample
    kp_l, vp_l, sp_l, ks_l, vs_l, ss_l = [], [], [], [], [], []
    s0_p = jnp.zeros((x_prompt.shape[0], RET_HEADS, RET_DK, RET_DV), jnp.float32)
    for l in range(DEPTH):
        w = (ln1_g[l], w_in[l], q_norm_g[l], k_norm_g[l], attn_sinks[l], ret_norm_g[l],
             w_out[l], ln2_g[l], w_up[l], w_down[l])
        yp, kp, vp, sp = _layer(yp, pos_p, None, None, s0_p, *w)
        ys, kn, vn, sn = _layer(ys, pos_s, cache_k_win[l], cache_v_win[l], state_ret[l], *w)
        kp_l.append(kp); vp_l.append(vp); sp_l.append(sp)
        ks_l.append(kn); vs_l.append(vn); ss_l.append(sn)
    return (yp, ys, jnp.stack(kp_l), jnp.stack(vp_l), jnp.stack(sp_l),
            jnp.stack(ks_l), jnp.stack(vs_l), jnp.stack(ss_l))
```

```cpp
#include <hip/hip_runtime.h>
#include <hip/hip_cooperative_groups.h>
#include <cstdio>
#include <cstdint>
namespace cg = cooperative_groups;

#define DI __device__ __forceinline__
#define LAS __attribute__((address_space(3)))
typedef float f32x2 __attribute__((ext_vector_type(2)));
typedef float f32x16 __attribute__((ext_vector_type(16)));
typedef short s16x4 __attribute__((ext_vector_type(4)));
typedef unsigned u32x2 __attribute__((ext_vector_type(2)));
typedef __bf16 bf16x2v __attribute__((ext_vector_type(2)));

constexpr int DM = 2048, LP = 8192, NS = 128, MR = LP + NS  , MP = 8448  ;
constexpr int INW = 5376, FF = 8192;
constexpr int C_AQ = 0, C_AK = 1024, C_AV = 1152, C_RQ = 1280, C_RK = 2304, C_RV = 3328, C_RG = 4352;
constexpr float EPS = 1e-6f;

DI unsigned pk2(float lo, float hi) { f32x2 v = {lo, hi}; return __builtin_bit_cast(unsigned, __builtin_convertvector(v, bf16x2v)); }
DI float bflo(unsigned u) { return __uint_as_float(u << 16); }
DI float bfhi(unsigned u) { return __uint_as_float(u & 0xffff0000u); }
DI float bf2f(unsigned short u) { return __uint_as_float(((unsigned)u) << 16); }

namespace pg8 {
#define PG8_LAS __attribute__((address_space(3)))
typedef unsigned short bf16_t;
typedef short bf16x8 __attribute__((ext_vector_type(8)));
typedef float f32x4 __attribute__((ext_vector_type(4)));
typedef unsigned u32x4 __attribute__((ext_vector_type(4)));
constexpr int BM = 256, BK = 64, HALF = 128, HTB = HALF * BK * 2  , STAGE_BYTES = 8 * HTB, NXCD = 8, WGM = 8;

__host__ __device__ __forceinline__ int lds_byte(int r, int c) { const int st = (r >> 4) * 2 + (c >> 5), rr = r & 15, cc = c & 31, ob = rr * 64 + cc * 2; return st * 1024 + (ob ^ (((ob >> 9) & 1) << 5)); }
__host__ __device__ __forceinline__ void stage_rc(int b, int& R, int& C) { const int st = b / 1024, sb = b % 1024, swz = sb ^ (((sb >> 9) & 1) << 5); R = (st >> 1) * 16 + swz / 64; C = (st & 1) * 32 + (swz % 64) / 2; }
__host__ __device__ __forceinline__ int perm32(int rho) { const int n = rho >> 4, i = rho & 15; return 8 * (i >> 2) + 4 * n + (i & 3); }

struct Unit { int pm, pn; };
struct Gemm { const bf16_t* A; const bf16_t* Bt; int M, N, K; };

struct StaticOrder {
    int nM, nN, nwg, G, c;
    __host__ __device__ void init(int M, int N, int G_, int c_) { nM = M / BM; nN = N / BM; nwg = nM * nN; G = G_; c = c_; }
    __host__ __device__ bool next(int i, Unit& u) const {
        const long L = (long)i * G + c; if (L >= nwg) return false;
        int wgid = (int)L; { const int q = nwg / NXCD, r = nwg % NXCD, xcd = wgid % NXCD, off = wgid / NXCD; wgid = (xcd < r ? xcd * (q + 1) : r * (q + 1) + (xcd - r) * q) + off; }
        const int nig = WGM * nN, gid = wgid / nig, fm = gid * WGM, gsz = (nM - fm) < WGM ? (nM - fm) : WGM;
        u.pm = fm + ((wgid % nig) % gsz); u.pn = (wgid % nig) / gsz; return true;
    }
    __device__ __forceinline__ void a_ready(const Unit&) const {}
    __device__ __forceinline__ void done(const Unit&) const {}
};


DI u32x4 pack8f(const f32x4& a, const f32x4& b) { u32x4 w; w.x = pk2(a[0], a[1]); w.y = pk2(a[2], a[3]); w.z = pk2(b[0], b[1]); w.w = pk2(b[2], b[3]); return w; }

struct EpiIn {
    static constexpr bool PERM = true, AFTER_DRAIN = false;
    bf16_t* Z;
    __device__ __forceinline__ void operator()(const f32x4 (&acc)[2][2][4][2], const Unit& u, int wr, int wc, int fr, int fq) const {
        const int row0 = u.pm * BM + wr * 64 + fr, col0 = u.pn * BM + wc * 32 + 8 * fq;
        if (u.pn < 5 || u.pn > 12) {
#pragma unroll
            for (int ai = 0; ai < 2; ++ai)
#pragma unroll
                for (int m = 0; m < 4; ++m) { bf16_t* rowp = Z + (size_t)(row0 + ai * HALF + m * 16) * INW + col0;
#pragma unroll
                    for (int bj = 0; bj < 2; ++bj) *(u32x4*)(rowp + bj * HALF) = pack8f(acc[ai][bj][m][0], acc[ai][bj][m][1]); }
        } else {
            const int head = (u.pn - 5) & 3; const bool isk = u.pn >= 9;
            const float lg = log1pf(-exp2f(-5.0f - (float)head));
            float inv[8];
#pragma unroll
            for (int j = 0; j < 8; ++j) inv[j] = powf(10000.0f, -(float)(wc * 32 + 8 * fq + j) * (1.0f / 128.0f));
#pragma unroll
            for (int ai = 0; ai < 2; ++ai)
#pragma unroll
                for (int m = 0; m < 4; ++m) {
                    const int row = row0 + ai * HALF + m * 16;
                    const int pos = row < LP ? row : LP; const float t = row < LP ? (float)(row & 127) : 0.0f;
                    const float f = isk ? 0.0625f * __expf(-lg * t) : __expf(lg * t);
                    f32x4 o1[2], o2[2];
#pragma unroll
                    for (int n = 0; n < 2; ++n)
#pragma unroll
                        for (int e = 0; e < 4; ++e) {
                            const float ang = (float)pos * inv[n * 4 + e];
                            double rev = (double)ang * 0.15915494309189535; rev -= floor(rev);
                            const float fr_ = (float)rev; const float sn = __builtin_amdgcn_sinf(fr_), cs = __builtin_amdgcn_cosf(fr_);
                            const float x1 = acc[ai][0][m][n][e], x2 = acc[ai][1][m][n][e];
                            o1[n][e] = (x1 * cs - x2 * sn) * f; o2[n][e] = (x2 * cs + x1 * sn) * f;
                        }
                    bf16_t* rowp = Z + (size_t)row * INW + col0;
                    *(u32x4*)(rowp) = pack8f(o1[0], o1[1]); *(u32x4*)(rowp + HALF) = pack8f(o2[0], o2[1]);
                }
        }
    }
};

struct EpiOut {
    static constexpr bool PERM = true, AFTER_DRAIN = false;
    const float* xp; const float* xs; float* X1; bf16_t* XG; const float* g2; float* part;
    __device__ __forceinline__ void operator()(const f32x4 (&acc)[2][2][4][2], const Unit& u, int wr, int wc, int fr, int fq) const {
#pragma unroll
        for (int ai = 0; ai < 2; ++ai) {
            const int rbase = u.pm * BM + ai * HALF; const bool valid = rbase < MR;
#pragma unroll
            for (int m = 0; m < 4; ++m) {
                const int row = rbase + wr * 64 + m * 16 + fr;
                const float* xrow = row < LP ? xp + (size_t)row * DM : xs + (size_t)(row - LP) * DM;
                float ss = 0.f;
#pragma unroll
                for (int bj = 0; bj < 2; ++bj) {
                    const int col = u.pn * BM + bj * HALF + wc * 32 + 8 * fq;
                    f32x4 v0 = {0.f, 0.f, 0.f, 0.f}, v1 = {0.f, 0.f, 0.f, 0.f};
                    if (valid) { v0 = acc[ai][bj][m][0] + *(const f32x4*)(xrow + col); v1 = acc[ai][bj][m][1] + *(const f32x4*)(xrow + col + 4);
                        *(f32x4*)(X1 + (size_t)row * DM + col) = v0; *(f32x4*)(X1 + (size_t)row * DM + col + 4) = v1; }
                    ss += (v0[0] * v0[0] + v0[1] * v0[1]) + (v0[2] * v0[2] + v0[3] * v0[3]) + (v1[0] * v1[0] + v1[1] * v1[1]) + (v1[2] * v1[2] + v1[3] * v1[3]);
                    const f32x4 ga = *(const f32x4*)(g2 + col), gb = *(const f32x4*)(g2 + col + 4);
                    *(u32x4*)(XG + (size_t)row * DM + col) = pack8f(v0 * ga, v1 * gb);
                }
                ss += __shfl_xor(ss, 16); ss += __shfl_xor(ss, 32);
                if (fq == 0) part[(size_t)row * 32 + u.pn * 4 + wc] = ss;
            }
        }
    }
};

struct EpiUp {
    static constexpr bool PERM = true, AFTER_DRAIN = false;
    bf16_t* U;
    __device__ __forceinline__ void operator()(const f32x4 (&acc)[2][2][4][2], const Unit& u, int wr, int wc, int fr, int fq) const {
        const int row0 = u.pm * BM + wr * 64 + fr, col0 = u.pn * BM + wc * 32 + 8 * fq;
#pragma unroll
        for (int ai = 0; ai < 2; ++ai)
#pragma unroll
            for (int m = 0; m < 4; ++m) { bf16_t* rowp = U + (size_t)(row0 + ai * HALF + m * 16) * FF + col0;
#pragma unroll
                for (int bj = 0; bj < 2; ++bj) { f32x4 a = acc[ai][bj][m][0], b = acc[ai][bj][m][1];
#pragma unroll
                    for (int e = 0; e < 4; ++e) { a[e] = fmaxf(a[e], 0.f); a[e] *= a[e]; b[e] = fmaxf(b[e], 0.f); b[e] *= b[e]; }
                    *(u32x4*)(rowp + bj * HALF) = pack8f(a, b); } }
    }
};

struct EpiDown {
    static constexpr bool PERM = true, AFTER_DRAIN = false;
    float* Y; const float* rstd2;
    __device__ __forceinline__ void operator()(const f32x4 (&acc)[2][2][4][2], const Unit& u, int wr, int wc, int fr, int fq) const {
#pragma unroll
        for (int ai = 0; ai < 2; ++ai) {
            const int rbase = u.pm * BM + ai * HALF; if (rbase >= MR) continue;
#pragma unroll
            for (int m = 0; m < 4; ++m) {
                const int row = rbase + wr * 64 + m * 16 + fr; const float r2 = rstd2[row];
#pragma unroll
                for (int bj = 0; bj < 2; ++bj) { float* p = Y + (size_t)row * DM + u.pn * BM + bj * HALF + wc * 32 + 8 * fq;
                    const f32x4 a = *(const f32x4*)p, b = *(const f32x4*)(p + 4);
                    *(f32x4*)p = a + acc[ai][bj][m][0] * r2; *(f32x4*)(p + 4) = b + acc[ai][bj][m][1] * r2; }
            }
        }
    }
};
template <class Epi, class Sched, bool ALIGN_EPI = false, bool SP2 = false>
__device__ __forceinline__ void gemm_phase(PG8_LAS unsigned char* lds, const Gemm g, const Sched& S, const Epi& E) {
    const int tid = threadIdx.x, wid = __builtin_amdgcn_readfirstlane(tid >> 6), lane = tid & 63, wr = wid >> 2, wc = wid & 3, fr = lane & 15, fq = lane >> 4;
    const int K = g.K, nt = K / BK;
    unsigned voffA[2], voffB[2];
#pragma unroll
    for (int i = 0; i < 2; ++i) { int R, C; stage_rc(tid * 16 + i * 8192, R, C); const int Rb = Epi::PERM ? ((R & ~31) + perm32(R & 31)) : R;
        voffA[i] = (unsigned)(R * K + C) * 2u; voffB[i] = (unsigned)(Rb * K + C) * 2u; }
    const size_t kstep = (size_t)(BK * 2);
    const size_t hstep = (size_t)HALF * K * 2;
    const size_t tstep = 2 * hstep;
    const unsigned ldsw = (unsigned)wid * 1024u;
    const int aoff = lds_byte(wr * 64 + fr, fq * 8), boff = lds_byte(wc * 32 + fr, fq * 8);
#define PG8_SA(b, h) (((b) * 2 + (h)) * HTB)
#define PG8_SB(b, h) ((4 + (b) * 2 + (h)) * HTB)
#define PG8_STAGE(bufoff, gbase, voff) do { _Pragma("unroll") for (int _i = 0; _i < 2; ++_i) \
        __builtin_amdgcn_global_load_lds((const unsigned*)((const char*)(gbase) + (voff)[_i]), (PG8_LAS unsigned*)(lds + (bufoff) + ldsw + _i * 8192), 16, 0, 0); } while (0)
#define PG8_LDA(dst, b, h) do { _Pragma("unroll") for (int m = 0; m < 4; ++m) _Pragma("unroll") for (int k = 0; k < 2; ++k) dst[m][k] = *(const PG8_LAS bf16x8*)(lds + PG8_SA(b, h) + aoff + m * 2048 + k * 1024); } while (0)
#define PG8_LDB(dst, b, h) do { _Pragma("unroll") for (int n = 0; n < 2; ++n) _Pragma("unroll") for (int k = 0; k < 2; ++k) dst[n][k] = *(const PG8_LAS bf16x8*)(lds + PG8_SB(b, h) + boff + n * 2048 + k * 1024); } while (0)
#define PG8_MMA(ai, bj, At, Bt) do { __builtin_amdgcn_s_setprio(1); _Pragma("unroll") for (int m = 0; m < 4; ++m) _Pragma("unroll") for (int n = 0; n < 2; ++n) _Pragma("unroll") for (int k = 0; k < 2; ++k) \
        acc[ai][bj][m][n] = __builtin_amdgcn_mfma_f32_16x16x32_bf16(Bt[n][k], At[m][k], acc[ai][bj][m][n], 0, 0, 0); __builtin_amdgcn_s_setprio(0); } while (0)
#define PG8_WAIT_V(n) asm volatile("s_waitcnt vmcnt(" #n ")" ::: "memory")
#define PG8_WAIT_L(n) asm volatile("s_waitcnt lgkmcnt(" #n ")" ::: "memory")
#define PG8_BAR __builtin_amdgcn_s_barrier()
#define PG8_SCHED __builtin_amdgcn_sched_barrier(0)
    Unit cur, nxt; int ui = 0;
    if (!S.next(0, cur)) return;
    f32x4 acc[2][2][4][2];
#pragma unroll
    for (int a = 0; a < 2; ++a)
#pragma unroll
        for (int b = 0; b < 2; ++b)
#pragma unroll
            for (int m = 0; m < 4; ++m)
#pragma unroll
                for (int n = 0; n < 2; ++n) acc[a][b][m][n] = (f32x4){0.f, 0.f, 0.f, 0.f};
    bf16x8 At[4][2], B0[2][2], B1[2][2];
    const char* cA = (const char*)g.A + (size_t)cur.pm * tstep; const char* cB = (const char*)g.Bt + (size_t)cur.pn * tstep;
    S.a_ready(cur);
    if constexpr (SP2) {
        PG8_STAGE(PG8_SB(0, 0), cB, voffB); PG8_STAGE(PG8_SB(0, 1), cB + hstep, voffB); PG8_STAGE(PG8_SA(0, 0), cA, voffA); PG8_STAGE(PG8_SA(0, 1), cA + hstep, voffA);
        if (wr == 1) PG8_BAR;
        PG8_WAIT_V(2); PG8_BAR;
        PG8_STAGE(PG8_SB(1, 0), cB + kstep, voffB); PG8_STAGE(PG8_SA(1, 0), cA + kstep, voffA); PG8_STAGE(PG8_SB(1, 1), cB + hstep + kstep, voffB);
        PG8_WAIT_V(6); PG8_BAR;
    } else {
        PG8_STAGE(PG8_SB(0, 0), cB, voffB); PG8_STAGE(PG8_SA(0, 0), cA, voffA); PG8_STAGE(PG8_SB(0, 1), cB + hstep, voffB); PG8_STAGE(PG8_SA(0, 1), cA + hstep, voffA);
        if (wr == 1) PG8_BAR;
        PG8_WAIT_V(4); PG8_BAR;
        PG8_STAGE(PG8_SB(1, 0), cB + kstep, voffB); PG8_STAGE(PG8_SA(1, 0), cA + kstep, voffA); PG8_STAGE(PG8_SB(1, 1), cB + hstep + kstep, voffB);
        PG8_WAIT_V(6); PG8_BAR;
    }
    for (;;) {
        const bool has_next = S.next(ui + 1, nxt);
        const char* nA = has_next ? (const char*)g.A + (size_t)nxt.pm * tstep : cA; const char* nB = has_next ? (const char*)g.Bt + (size_t)nxt.pn * tstep : cB;
        for (int t = 0; t < nt; t += 2) {
            const bool last = (t == nt - 2);
            const char* a1 = cA + (size_t)(t + 1) * kstep;
            const char* a2 = last ? nA : cA + (size_t)(t + 2) * kstep; const char* b2 = last ? nB : cB + (size_t)(t + 2) * kstep;
            const char* a3 = a2 + kstep; const char* b3 = b2 + kstep;
            if (last && has_next) S.a_ready(nxt);
            if constexpr (SP2) {
            PG8_LDB(B0, 0, 0); PG8_LDB(B1, 0, 1); PG8_SCHED; PG8_LDA(At, 0, 0); PG8_STAGE(PG8_SA(1, 1), a1 + hstep, voffA);
            PG8_WAIT_V(8); PG8_WAIT_L(0); PG8_BAR; PG8_MMA(0, 0, At, B0); PG8_MMA(0, 1, At, B1); PG8_BAR; PG8_SCHED;
            PG8_LDA(At, 0, 1); PG8_STAGE(PG8_SB(0, 0), b2, voffB); PG8_STAGE(PG8_SB(0, 1), b2 + hstep, voffB); PG8_STAGE(PG8_SA(0, 0), a2, voffA);
            PG8_WAIT_V(8); PG8_WAIT_L(0); PG8_BAR; PG8_MMA(1, 0, At, B0); PG8_MMA(1, 1, At, B1); PG8_BAR; PG8_SCHED;
            PG8_LDB(B0, 1, 0); PG8_LDB(B1, 1, 1); PG8_SCHED; PG8_LDA(At, 1, 0); PG8_STAGE(PG8_SA(0, 1), a2 + hstep, voffA);
            PG8_WAIT_V(8); PG8_WAIT_L(0); PG8_BAR; PG8_MMA(0, 0, At, B0); PG8_MMA(0, 1, At, B1); PG8_BAR; PG8_SCHED;
            PG8_LDA(At, 1, 1); PG8_STAGE(PG8_SB(1, 0), b3, voffB); PG8_STAGE(PG8_SB(1, 1), b3 + hstep, voffB); PG8_STAGE(PG8_SA(1, 0), a3, voffA);
            PG8_WAIT_V(8); PG8_WAIT_L(0); PG8_BAR; PG8_MMA(1, 0, At, B0); PG8_MMA(1, 1, At, B1); PG8_BAR; PG8_SCHED;
            } else {
            PG8_LDB(B0, 0, 0); PG8_SCHED; PG8_LDA(At, 0, 0); PG8_STAGE(PG8_SA(1, 1), a1 + hstep, voffA);
            PG8_WAIT_L(8); PG8_BAR; PG8_WAIT_L(0); PG8_MMA(0, 0, At, B0); PG8_BAR; PG8_SCHED;
            PG8_LDB(B1, 0, 1); PG8_STAGE(PG8_SB(0, 0), b2, voffB);
            PG8_BAR; PG8_WAIT_L(0); PG8_MMA(0, 1, At, B1); PG8_BAR;
            PG8_LDA(At, 0, 1); PG8_STAGE(PG8_SA(0, 0), a2, voffA);
            PG8_BAR; PG8_WAIT_L(0); PG8_MMA(1, 0, At, B0); PG8_BAR; PG8_SCHED;
            PG8_STAGE(PG8_SB(0, 1), b2 + hstep, voffB);
            PG8_WAIT_V(6); PG8_BAR; PG8_MMA(1, 1, At, B1); PG8_BAR;
            PG8_LDB(B0, 1, 0); PG8_SCHED; PG8_LDA(At, 1, 0); PG8_STAGE(PG8_SA(0, 1), a2 + hstep, voffA);
            PG8_WAIT_L(8); PG8_BAR; PG8_WAIT_L(0); PG8_MMA(0, 0, At, B0); PG8_BAR; PG8_SCHED;
            PG8_LDB(B1, 1, 1); PG8_STAGE(PG8_SB(1, 0), b3, voffB);
            PG8_BAR; PG8_WAIT_L(0); PG8_MMA(0, 1, At, B1); PG8_BAR;
            PG8_LDA(At, 1, 1); PG8_STAGE(PG8_SA(1, 0), a3, voffA);
            PG8_BAR; PG8_WAIT_L(0); PG8_MMA(1, 0, At, B0); PG8_BAR; PG8_SCHED;
            PG8_STAGE(PG8_SB(1, 1), b3 + hstep, voffB);
            PG8_WAIT_V(6); PG8_BAR; PG8_MMA(1, 1, At, B1); PG8_BAR;
            }
        }
        if constexpr (ALIGN_EPI) { if (wr == 0) PG8_BAR; }
        if constexpr (!Epi::AFTER_DRAIN) { E(acc, cur, wr, wc, fr, fq); S.done(cur); }
        if (!has_next) break;
#pragma unroll
        for (int a = 0; a < 2; ++a)
#pragma unroll
            for (int b = 0; b < 2; ++b)
#pragma unroll
                for (int m = 0; m < 4; ++m)
#pragma unroll
                    for (int n = 0; n < 2; ++n) acc[a][b][m][n] = (f32x4){0.f, 0.f, 0.f, 0.f};
        cur = nxt; cA = nA; cB = nB; ++ui;
        if constexpr (ALIGN_EPI) { if (wr == 1) PG8_BAR; }
    }
    PG8_WAIT_V(0);
    if constexpr (!ALIGN_EPI) { if (wr == 0) PG8_BAR; }
    PG8_BAR;
    if constexpr (Epi::AFTER_DRAIN) { E.fused(acc, cur, wr, wc, fr, fq, lds, wid, lane); S.done(cur); }
#undef PG8_SA
#undef PG8_SB
#undef PG8_STAGE
#undef PG8_LDA
#undef PG8_LDB
#undef PG8_MMA
#undef PG8_WAIT_V
#undef PG8_WAIT_L
#undef PG8_BAR
#undef PG8_SCHED
}
}

using pg8::bf16_t; using pg8::bf16x8; using pg8::f32x4; using pg8::u32x4;
#define MFMA32(a, b, c) __builtin_amdgcn_mfma_f32_32x32x16_bf16((a), (b), (c), 0, 0, 0)
DI int crow(int reg, int h) { return (reg & 3) + 8 * (reg >> 2) + 4 * h; }
DI float wave_sum(float v) {
#pragma unroll
    for (int o = 1; o < 64; o <<= 1) v += __shfl_xor(v, o);
    return v;
}
DI float wave_max(float v) {
#pragma unroll
    for (int o = 1; o < 64; o <<= 1) v = fmaxf(v, __shfl_xor(v, o));
    return v;
}
DI bf16x8 pack8(const f32x16& x, int s) { u32x4 p; p.x = pk2(x[8 * s], x[8 * s + 1]); p.y = pk2(x[8 * s + 2], x[8 * s + 3]); p.z = pk2(x[8 * s + 4], x[8 * s + 5]); p.w = pk2(x[8 * s + 6], x[8 * s + 7]); return __builtin_bit_cast(bf16x8, p); }
DI bf16x8 cat4(s16x4 lo, s16x4 hi) { return __builtin_shufflevector(lo, hi, 0, 1, 2, 3, 4, 5, 6, 7); }
DI f32x16 zero16() { f32x16 z;
#pragma unroll
    for (int i = 0; i < 16; ++i) z[i] = 0.f;
    return z; }
DI float gamma_of(int h) { return 1.0f - exp2f(-5.0f - (float)h); }

constexpr size_t MiB = 1u << 20;
constexpr size_t WS_WIN = 1 * MiB;
constexpr size_t WS_WOUT = 23 * MiB;
constexpr size_t WS_WUP = 31 * MiB;
constexpr size_t WS_WDN = 63 * MiB;
constexpr size_t WS_H1 = 95 * MiB;
constexpr size_t WS_MIX = 128 * MiB;
constexpr size_t WS_PART = 161 * MiB;
constexpr size_t WS_RSTD2 = 163 * MiB;
constexpr size_t WS_Z = 164 * MiB;
constexpr size_t WS_KV = 252 * MiB;
constexpr size_t WS_SP = 316 * MiB;
constexpr size_t WS_U = 164 * MiB;
constexpr size_t WS_END = 348 * MiB;
static_assert(WS_Z + (size_t)MP * INW * 2 <= WS_KV && WS_U + (size_t)MP * FF * 2 <= WS_END && WS_H1 + (size_t)MP * DM * 2 <= WS_MIX && WS_MIX + (size_t)MP * DM * 2 <= WS_PART, "ws map");
constexpr int LDS_BYTES = 147456;

constexpr size_t O_Y = 0, O_KP = (size_t)MR * DM, O_VP = O_KP + 16384, O_SP = O_VP + 16384, O_KS = O_SP + 262144, O_VS = O_KS + 2097152, O_SS = O_VS + 2097152, O_END = O_SS + 33554432;

DI void p0_transpose_item(const float* W, int K, int N, bf16_t* WT, LAS float* scr, int item, int lane) {
    const int nblk = N / 32, kb = item / nblk, nb = item % nblk, k0 = 64 * kb, n0 = 32 * nb;
#pragma unroll 8
    for (int i = 0; i < 32; ++i) { const int kk = 2 * i + (lane >> 5); scr[kk * 33 + (lane & 31)] = W[(size_t)(k0 + kk) * N + n0 + (lane & 31)]; }
    asm volatile("s_waitcnt lgkmcnt(0)" ::: "memory");
    const int c = lane & 7;
#pragma unroll
    for (int j = 0; j < 4; ++j) { const int n = (lane >> 3) + 8 * j; const LAS float* s = scr + (8 * c) * 33 + n;
        u32x4 o; o.x = pk2(s[0 * 33], s[1 * 33]); o.y = pk2(s[2 * 33], s[3 * 33]); o.z = pk2(s[4 * 33], s[5 * 33]); o.w = pk2(s[6 * 33], s[7 * 33]);
        *(u32x4*)(WT + (size_t)(n0 + n) * K + k0 + 8 * c) = o; }
    asm volatile("s_waitcnt lgkmcnt(0)" ::: "memory");
}
DI void rms_row(const float* xrow, const float* g, bf16_t* orow, int lane) {
    f32x4 v[8]; float s = 0.f;
#pragma unroll
    for (int j = 0; j < 8; ++j) { v[j] = *((const f32x4*)xrow + lane + 64 * j); s += (v[j][0] * v[j][0] + v[j][1] * v[j][1]) + (v[j][2] * v[j][2] + v[j][3] * v[j][3]); }
    const float rstd = rsqrtf(wave_sum(s) * (1.0f / DM) + EPS);
#pragma unroll
    for (int j = 0; j < 8; ++j) { const f32x4 gg = *((const f32x4*)g + lane + 64 * j); u32x2 o; o.x = pk2(v[j][0] * rstd * gg[0], v[j][1] * rstd * gg[1]); o.y = pk2(v[j][2] * rstd * gg[2], v[j][3] * rstd * gg[3]);
        *((u32x2*)orow + lane + 64 * j) = o; }
}

DI void stage_T128x256(LAS unsigned char* img, const bf16_t* src, int tid) {
#pragma unroll
    for (int k = 0; k < 4; ++k) {
        const int it = k * 512 + tid, dgl = it & 3, tpl = (it >> 2) & 15, rest = it >> 6, dg = dgl + 4 * (rest & 7), tp = tpl + 16 * (rest >> 3);
        const bf16_t* p = src + (size_t)(2 * tp) * INW + dg * 8;
        const u32x4 a = *(const u32x4*)p, b = *(const u32x4*)(p + INW);
#pragma unroll
        for (int e = 0; e < 8; ++e) {
            const unsigned lo = (e & 1) ? (a[e >> 1] >> 16) : (a[e >> 1] & 0xffffu), hi = (e & 1) ? (b[e >> 1] & 0xffff0000u) : (b[e >> 1] << 16);
            *(LAS unsigned*)(img + (dg * 8 + e) * 264 + tp * 4) = lo | hi;
        }
    }
}

DI void ret_step1(LAS unsigned char* lds, const bf16_t* Z, float* KV, int n, int h, int tid) {
    LAS unsigned char* Kt = lds; LAS unsigned char* Vt = lds + 256 * 264;
    const int lane = tid & 63, wid = tid >> 6, r = lane & 31, hh = lane >> 5;
    stage_T128x256(Kt, Z + (size_t)(n * 128) * INW + C_RK + h * 256, tid);
    stage_T128x256(Vt, Z + (size_t)(n * 128) * INW + C_RV + h * 256, tid);
    __syncthreads();
    f32x16 acc[8];
#pragma unroll
    for (int i = 0; i < 8; ++i) acc[i] = zero16();
    const int dv0 = wid * 32;
#pragma unroll 2
    for (int s = 0; s < 8; ++s) {
        const LAS unsigned char* pa = Vt + (dv0 + r) * 264 + (16 * s + 8 * hh) * 2;
        const bf16x8 A = cat4(*(const LAS s16x4*)pa, *(const LAS s16x4*)(pa + 8));
#pragma unroll
        for (int dt = 0; dt < 8; ++dt) {
            const LAS unsigned char* pb = Kt + (dt * 32 + r) * 264 + (16 * s + 8 * hh) * 2;
            const bf16x8 B = cat4(*(const LAS s16x4*)pb, *(const LAS s16x4*)(pb + 8));
            acc[dt] = MFMA32(A, B, acc[dt]);
        }
    }
    float* out = KV + ((size_t)(n * 4 + h) * 256 + dv0) * 256;
#pragma unroll
    for (int dt = 0; dt < 8; ++dt)
#pragma unroll
        for (int i = 0; i < 16; ++i) out[(size_t)crow(i, hh) * 256 + dt * 32 + r] = acc[dt][i];
    __syncthreads();
}

DI void ret_scan(const float* KV, bf16_t* SP, float* o_state, int gt, int nthreads) {
    for (int e = gt; e < 65536; e += nthreads) {
        const int h = e >> 14, dv = (e >> 6) & 255, dk4 = (e & 63) * 4;
        const float lg = log1pf(-exp2f(-5.0f - (float)h)), Dc = __expf(128.0f * lg), c1 = __expf(127.0f * lg);
        const size_t base = ((size_t)(h * 256 + dv)) * 256 + dk4;
        f32x4 s = {0.f, 0.f, 0.f, 0.f};
        for (int n0 = 0; n0 < 64; n0 += 8) {
            f32x4 kv[8];
#pragma unroll
            for (int u = 0; u < 8; ++u) kv[u] = *(const f32x4*)(KV + (size_t)(n0 + u) * 262144 + base);
#pragma unroll
            for (int u = 0; u < 8; ++u) { u32x2 o; o.x = pk2(s[0], s[1]); o.y = pk2(s[2], s[3]); *(u32x2*)(SP + (size_t)(n0 + u) * 262144 + base) = o; s = s * Dc + kv[u] * c1; }
        }
#pragma unroll
        for (int j = 0; j < 4; ++j) o_state[((size_t)(h * 256 + dk4 + j)) * 256 + dv] = s[j];
    }
}

DI float silu_f(float x) { return x / (1.0f + __expf(-x)); }

DI void ret_step2(LAS unsigned char* lds, const bf16_t* Z, const bf16_t* SP, bf16_t* MIX, const float* rng, int n, int h, int tid) {
    LAS unsigned char* Kr = lds; LAS unsigned char* Vt = lds + 128 * 528; LAS float* red = (LAS float*)(lds + 128 * 528 + 256 * 264);
    const int lane = tid & 63, wid = tid >> 6, r = lane & 31, hh = lane >> 5;
    const bf16_t* zc = Z + (size_t)(n * 128) * INW;
#pragma unroll
    for (int k = 0; k < 8; ++k) { const int it = k * 512 + tid, row = it >> 5, c = it & 31;
        *(LAS u32x4*)(Kr + row * 528 + c * 16) = *(const u32x4*)(zc + (size_t)row * INW + C_RK + h * 256 + c * 8); }
    stage_T128x256(Vt, zc + C_RV + h * 256, tid);
    const int it_ = wid >> 1, dh = wid & 1;
    bf16x8 qf[16];
    { const bf16_t* qp = zc + (size_t)(32 * it_ + r) * INW + C_RQ + h * 256 + 8 * hh;
#pragma unroll
      for (int s = 0; s < 16; ++s) qf[s] = *(const bf16x8*)(qp + 16 * s); }
    f32x16 acc[4];
#pragma unroll
    for (int i = 0; i < 4; ++i) acc[i] = zero16();
    { const bf16_t* sp = SP + ((size_t)(n * 4 + h) * 256 + 128 * dh + r) * 256 + 8 * hh;
#pragma unroll
      for (int dt = 0; dt < 4; ++dt)
#pragma unroll
          for (int s = 0; s < 16; ++s) { const bf16x8 A = *(const bf16x8*)(sp + (size_t)dt * 32 * 256 + 16 * s); acc[dt] = MFMA32(A, qf[s], acc[dt]); } }
    const float gm = gamma_of(h);
#pragma unroll
    for (int dt = 0; dt < 4; ++dt) acc[dt] = acc[dt] * gm;
    __syncthreads();
    for (int jt = 0; jt <= it_; ++jt) {
        f32x16 X = zero16();
#pragma unroll
        for (int s = 0; s < 16; ++s) { const bf16x8 A = *(const LAS bf16x8*)(Kr + (32 * jt + r) * 528 + (16 * s + 8 * hh) * 2); X = MFMA32(A, qf[s], X); }
        if (jt == it_) {
#pragma unroll
            for (int i = 0; i < 16; ++i) X[i] = (crow(i, hh) > r) ? 0.f : X[i];
        }
#pragma unroll
        for (int s2 = 0; s2 < 2; ++s2) { const bf16x8 xs = pack8(X, s2);
#pragma unroll
            for (int dt = 0; dt < 4; ++dt) { const LAS unsigned char* pa = Vt + (128 * dh + 32 * dt + r) * 264 + (32 * jt + 16 * s2 + 4 * hh) * 2;
                const bf16x8 A = cat4(*(const LAS s16x4*)pa, *(const LAS s16x4*)(pa + 16)); acc[dt] = MFMA32(A, xs, acc[dt]); } }
    }
    float ss = 0.f;
#pragma unroll
    for (int dt = 0; dt < 4; ++dt)
#pragma unroll
        for (int i = 0; i < 16; ++i) ss += acc[dt][i] * acc[dt][i];
    ss += __shfl_xor(ss, 32);
    if (hh == 0) red[wid * 32 + r] = ss;
    __syncthreads();
    const float rstd = rsqrtf((red[wid * 32 + r] + red[(wid ^ 1) * 32 + r]) * (1.0f / 256.0f) + EPS);
    const size_t token = (size_t)n * 128 + 32 * it_ + r;
#pragma unroll
    for (int dt = 0; dt < 4; ++dt)
#pragma unroll
        for (int g4 = 0; g4 < 4; ++g4) {
            const int dv = 128 * dh + 32 * dt + 8 * g4 + 4 * hh;
            const u32x2 gz = *(const u32x2*)(Z + token * INW + C_RG + h * 256 + dv);
            const f32x4 gn = *(const f32x4*)(rng + h * 256 + dv);
            const float y0 = acc[dt][4 * g4 + 0] * rstd * gn[0] * silu_f(bflo(gz.x)), y1 = acc[dt][4 * g4 + 1] * rstd * gn[1] * silu_f(bfhi(gz.x));
            const float y2 = acc[dt][4 * g4 + 2] * rstd * gn[2] * silu_f(bflo(gz.y)), y3 = acc[dt][4 * g4 + 3] * rstd * gn[3] * silu_f(bfhi(gz.y));
            u32x2 o; o.x = pk2(y0, y1); o.y = pk2(y2, y3);
            *(u32x2*)(MIX + token * DM + 1024 + h * 256 + dv) = o;
        }
    __syncthreads();
}

DI void ret_decode_unit(LAS unsigned char* lds, const bf16_t* Z, const float* S0, float* S1, bf16_t* MIX, const float* rng, int b, int h, int tid) {
    LAS float* qv = (LAS float*)lds; LAS float* red = qv + 768;
    const int lane = tid & 63, wid = tid >> 6;
    const bf16_t* zrow = Z + (size_t)(LP + b) * INW;
    if (tid < 256) { qv[tid] = bf2f(zrow[C_RQ + h * 256 + tid]); qv[256 + tid] = bf2f(zrow[C_RK + h * 256 + tid]); qv[512 + tid] = bf2f(zrow[C_RV + h * 256 + tid]); }
    __syncthreads();
    const float gm = gamma_of(h);
    const f32x4 v4 = *(const LAS f32x4*)(qv + 512 + 4 * lane);
    f32x4 acc = {0.f, 0.f, 0.f, 0.f};
    const size_t off = ((size_t)(b * 4 + h) * 256 + wid * 32) * 256 + 4 * lane;
    const float* s0 = S0 + off; float* s1 = S1 + off;
#pragma unroll 1
    for (int rr = 0; rr < 32; rr += 8) {
        f32x4 s[8];
#pragma unroll
        for (int u = 0; u < 8; ++u) s[u] = __builtin_nontemporal_load((const f32x4*)(s0 + (size_t)(rr + u) * 256));
#pragma unroll
        for (int u = 0; u < 8; ++u) { const int dk = wid * 32 + rr + u; const float kk = qv[256 + dk], qq = qv[dk];
            const f32x4 sn = s[u] * gm + v4 * kk; __builtin_nontemporal_store(sn, (f32x4*)(s1 + (size_t)(rr + u) * 256)); acc += sn * qq; }
    }
    *(LAS f32x4*)(red + wid * 256 + 4 * lane) = acc;
    __syncthreads();
    if (wid == 0) {
        f32x4 o = {0.f, 0.f, 0.f, 0.f};
#pragma unroll
        for (int w = 0; w < 8; ++w) o += *(const LAS f32x4*)(red + w * 256 + 4 * lane);
        const float ssq = wave_sum((o[0] * o[0] + o[1] * o[1]) + (o[2] * o[2] + o[3] * o[3]));
        const float rstd = rsqrtf(ssq * (1.0f / 256.0f) + EPS);
        const u32x2 gz = *(const u32x2*)(zrow + C_RG + h * 256 + 4 * lane);
        const f32x4 gn = *(const f32x4*)(rng + h * 256 + 4 * lane);
        u32x2 y; y.x = pk2(o[0] * rstd * gn[0] * silu_f(bflo(gz.x)), o[1] * rstd * gn[1] * silu_f(bfhi(gz.x)));
        y.y = pk2(o[2] * rstd * gn[2] * silu_f(bflo(gz.y)), o[3] * rstd * gn[3] * silu_f(bfhi(gz.y)));
        *(u32x2*)(MIX + (size_t)(LP + b) * DM + 1024 + h * 256 + 4 * lane) = y;
    }
    __syncthreads();
}

DI void attn_prompt_unit(LAS unsigned char* lds, const bf16_t* Z, bf16_t* MIX, const float* gq, const float* gk, const float* sinks, float* o_k, float* o_v, int nb, int kh, int hf, int tid) {
    LAS unsigned char* Kn = lds; LAS unsigned char* Vt = lds + 256 * 144;
    const int lane = tid & 63, wid = tid >> 6, r = lane & 31, hh = lane >> 5;
    {
        const int row = tid >> 1, half = tid & 1; const int tok = (nb - 1) * 128 + row;
        u32x4 v[4];
#pragma unroll
        for (int c = 0; c < 4; ++c) v[c] = (u32x4){0u, 0u, 0u, 0u};
        if (tok >= 0) {
#pragma unroll
            for (int c = 0; c < 4; ++c) v[c] = *(const u32x4*)(Z + (size_t)tok * INW + C_AK + kh * 64 + half * 32 + c * 8);
        }
        float f[32]; float ss = 0.f;
#pragma unroll
        for (int c = 0; c < 4; ++c)
#pragma unroll
            for (int e = 0; e < 4; ++e) { f[c * 8 + 2 * e] = bflo(v[c][e]); f[c * 8 + 2 * e + 1] = bfhi(v[c][e]); }
#pragma unroll
        for (int e = 0; e < 32; ++e) ss += f[e] * f[e];
        ss += __shfl_xor(ss, 1);
        const float rstd = rsqrtf(ss * (1.0f / 64.0f) + EPS);
#pragma unroll
        for (int c = 0; c < 8; ++c) { const f32x4 g = *(const f32x4*)(gk + half * 32 + c * 4);
#pragma unroll
            for (int e = 0; e < 4; ++e) f[c * 4 + e] *= rstd * g[e]; }
#pragma unroll
        for (int c = 0; c < 4; ++c) { u32x4 w; w.x = pk2(f[c * 8], f[c * 8 + 1]); w.y = pk2(f[c * 8 + 2], f[c * 8 + 3]); w.z = pk2(f[c * 8 + 4], f[c * 8 + 5]); w.w = pk2(f[c * 8 + 6], f[c * 8 + 7]);
            *(LAS u32x4*)(Kn + row * 144 + half * 64 + c * 16) = w; }
        if (nb == 63 && hf == 0 && row >= 128) { float* o = o_k + ((size_t)(row - 128) * 2 + kh) * 64 + half * 32;
#pragma unroll
            for (int c = 0; c < 8; ++c) *(f32x4*)(o + c * 4) = (f32x4){f[c * 4], f[c * 4 + 1], f[c * 4 + 2], f[c * 4 + 3]}; }
    }
#pragma unroll
    for (int k = 0; k < 2; ++k) {
        const int it = k * 512 + tid, kpl = it & 15, dgl = (it >> 4) & 3, rest = it >> 6, dg = dgl + 4 * (rest & 1), kp = kpl + 16 * (rest >> 1);
        const int tok0 = (nb - 1) * 128 + 2 * kp;
        u32x4 a = {0u, 0u, 0u, 0u}, b = {0u, 0u, 0u, 0u};
        if (tok0 >= 0) { const bf16_t* p = Z + (size_t)tok0 * INW + C_AV + kh * 64 + dg * 8; a = *(const u32x4*)p; b = *(const u32x4*)(p + INW); }
#pragma unroll
        for (int e = 0; e < 8; ++e) {
            const unsigned lo = (e & 1) ? (a[e >> 1] >> 16) : (a[e >> 1] & 0xffffu), hi = (e & 1) ? (b[e >> 1] & 0xffff0000u) : (b[e >> 1] << 16);
            *(LAS unsigned*)(Vt + (dg * 8 + e) * 520 + kp * 4) = lo | hi;
        }
        if (nb == 63 && hf == 0 && kp >= 64) { float* o = o_v + ((size_t)(2 * kp - 128) * 2 + kh) * 64 + dg * 8;
#pragma unroll
            for (int e = 0; e < 4; ++e) { o[2 * e] = bflo(a[e]); o[2 * e + 1] = bfhi(a[e]); o[128 + 2 * e] = bflo(b[e]); o[128 + 2 * e + 1] = bfhi(b[e]); } }
    }
    __syncthreads();
    const int hq = kh * 8 + 4 * hf + (wid >> 1), qh = wid & 1;
    const float sink = sinks[hq];
#pragma unroll 1
    for (int qq = 0; qq < 2; ++qq) {
        const int qi = 2 * qh + qq; const size_t tokq = (size_t)nb * 128 + 32 * qi + r;
        bf16x8 qf[4];
        {   const bf16_t* qp = Z + tokq * INW + hq * 64 + 8 * hh;
            u32x4 raw[4]; float ss = 0.f;
#pragma unroll
            for (int s = 0; s < 4; ++s) { raw[s] = *(const u32x4*)(qp + 16 * s);
#pragma unroll
                for (int e = 0; e < 4; ++e) { const float lo = bflo(raw[s][e]), hi = bfhi(raw[s][e]); ss += lo * lo + hi * hi; } }
            ss += __shfl_xor(ss, 32);
            const float rstd = rsqrtf(ss * (1.0f / 64.0f) + EPS) * 0.125f;
#pragma unroll
            for (int s = 0; s < 4; ++s) { const f32x4 g0 = *(const f32x4*)(gq + 16 * s + 8 * hh), g1 = *(const f32x4*)(gq + 16 * s + 8 * hh + 4); u32x4 w;
                w.x = pk2(bflo(raw[s].x) * rstd * g0[0], bfhi(raw[s].x) * rstd * g0[1]); w.y = pk2(bflo(raw[s].y) * rstd * g0[2], bfhi(raw[s].y) * rstd * g0[3]);
                w.z = pk2(bflo(raw[s].z) * rstd * g1[0], bfhi(raw[s].z) * rstd * g1[1]); w.w = pk2(bflo(raw[s].w) * rstd * g1[2], bfhi(raw[s].w) * rstd * g1[3]);
                qf[s] = __builtin_bit_cast(bf16x8, w); }
        }
        f32x16 X[5];
#pragma unroll
        for (int t = 0; t < 5; ++t) { X[t] = zero16();
#pragma unroll
            for (int s = 0; s < 4; ++s) { const bf16x8 A = *(const LAS bf16x8*)(Kn + (32 * (qi + t) + r) * 144 + (16 * s + 8 * hh) * 2); X[t] = MFMA32(A, qf[s], X[t]); } }
        const int ii = 32 * qi + r;
        float m = -1e30f;
#pragma unroll
        for (int t = 0; t < 5; ++t)
#pragma unroll
            for (int i = 0; i < 16; ++i) { const int jj = 32 * (qi + t) + crow(i, hh); const bool ok = (jj >= ii) && (jj <= ii + 128) && (nb > 0 || jj >= 128);
                X[t][i] = ok ? X[t][i] : -1e30f; m = fmaxf(m, X[t][i]); }
        m = fmaxf(m, __shfl_xor(m, 32)); m = fmaxf(m, sink);
        float sum = 0.f;
#pragma unroll
        for (int t = 0; t < 5; ++t)
#pragma unroll
            for (int i = 0; i < 16; ++i) { const float p = __expf(X[t][i] - m); X[t][i] = p; sum += p; }
        sum += __shfl_xor(sum, 32);
        const float inv = 1.0f / (sum + __expf(sink - m));
        f32x16 o[2]; o[0] = zero16(); o[1] = zero16();
#pragma unroll
        for (int t = 0; t < 5; ++t)
#pragma unroll
            for (int s2 = 0; s2 < 2; ++s2) { const bf16x8 xs = pack8(X[t], s2);
#pragma unroll
                for (int dt = 0; dt < 2; ++dt) { const LAS unsigned char* pa = Vt + (32 * dt + r) * 520 + (32 * (qi + t) + 16 * s2 + 4 * hh) * 2;
                    const bf16x8 A = cat4(*(const LAS s16x4*)pa, *(const LAS s16x4*)(pa + 16)); o[dt] = MFMA32(A, xs, o[dt]); } }
#pragma unroll
        for (int dt = 0; dt < 2; ++dt)
#pragma unroll
            for (int g4 = 0; g4 < 4; ++g4) { u32x2 w; w.x = pk2(o[dt][4 * g4] * inv, o[dt][4 * g4 + 1] * inv); w.y = pk2(o[dt][4 * g4 + 2] * inv, o[dt][4 * g4 + 3] * inv);
                *(u32x2*)(MIX + tokq * DM + hq * 64 + 32 * dt + 8 * g4 + 4 * hh) = w; }
    }
    __syncthreads();
}

DI void attn_decode_unit(LAS unsigned char* lds, const bf16_t* Z, const float* ck, const float* cv, bf16_t* MIX, const float* gq, const float* gk, const float* sinks, float* o_k, float* o_v, int b, int kh, int tid) {
    LAS float* Kc = (LAS float*)lds; LAS float* Vc = Kc + 129 * 65; LAS float* qs = Vc + 129 * 64; LAS float* pw = qs + 512;
    const int lane = tid & 63, wid = tid >> 6;
#pragma unroll
    for (int k = 0; k < 4; ++k) {
        const int it = k * 512 + tid, w = it >> 4, c4 = (it & 15) * 4;
        const size_t src = ((size_t)(b * 128 + w) * 2 + kh) * 64 + c4;
        const f32x4 k4 = *(const f32x4*)(ck + src), v4 = *(const f32x4*)(cv + src);
#pragma unroll
        for (int e = 0; e < 4; ++e) { Kc[w * 65 + c4 + e] = k4[e]; Vc[w * 64 + c4 + e] = v4[e]; }
        if (w >= 1) { const size_t dst = ((size_t)(b * 128 + w - 1) * 2 + kh) * 64 + c4; *(f32x4*)(o_k + dst) = k4; *(f32x4*)(o_v + dst) = v4; }
    }
    const bf16_t* zrow = Z + (size_t)(LP + b) * INW;
    const size_t dnew = ((size_t)(b * 128 + 127) * 2 + kh) * 64 + lane;
    if (wid == 0) { const float kx = bf2f(zrow[C_AK + kh * 64 + lane]); const float ss = wave_sum(kx * kx); const float kn = kx * rsqrtf(ss * (1.0f / 64.0f) + EPS) * gk[lane];
        Kc[128 * 65 + lane] = kn; o_k[dnew] = kn; }
    if (wid == 1) { const float vx = bf2f(zrow[C_AV + kh * 64 + lane]); Vc[128 * 64 + lane] = vx; o_v[dnew] = vx; }
    const int hq = kh * 8 + wid;
    { const float qx = bf2f(zrow[hq * 64 + lane]); const float ss = wave_sum(qx * qx); qs[wid * 64 + lane] = qx * rsqrtf(ss * (1.0f / 64.0f) + EPS) * gq[lane] * 0.125f; }
    __syncthreads();
    float s1 = 0.f, s2 = 0.f;
#pragma unroll 8
    for (int d = 0; d < 64; ++d) { const float q = qs[wid * 64 + d]; s1 += q * Kc[lane * 65 + d]; s2 += q * Kc[(lane + 64) * 65 + d]; }
    const float s3 = wave_sum(qs[wid * 64 + lane] * Kc[128 * 65 + lane]);
    const float sink = sinks[hq];
    const float m = fmaxf(wave_max(fmaxf(s1, s2)), fmaxf(s3, sink));
    const float p1 = __expf(s1 - m), p2 = __expf(s2 - m), p3 = __expf(s3 - m);
    const float denom = wave_sum(p1 + p2) + p3 + __expf(sink - m);
    pw[wid * 132 + lane] = p1; pw[wid * 132 + 64 + lane] = p2; if (lane == 0) pw[wid * 132 + 128] = p3;
    __syncthreads();
    float o = 0.f;
#pragma unroll 3
    for (int j = 0; j < 129; ++j) o += pw[wid * 132 + j] * Vc[j * 64 + lane];
    MIX[(size_t)(LP + b) * DM + hq * 64 + lane] = (bf16_t)(pk2(o / denom, 0.f) & 0xffffu);
    __syncthreads();
}

struct Args { const float* in[15]; float* out; unsigned char* ws; int ph_lo, ph_hi; };
constexpr int NPH = 8;

__global__ void __launch_bounds__(512, 2) fwd_kernel(Args a) {
    extern __shared__ __attribute__((aligned(16))) unsigned char lds_raw[];
    LAS unsigned char* lds = (LAS unsigned char*)lds_raw;
    cg::grid_group grid = cg::this_grid();
    const int tid = threadIdx.x, lane = tid & 63, wid = __builtin_amdgcn_readfirstlane(tid >> 6);
    const int G = gridDim.x, bx = blockIdx.x;
    unsigned char* ws = a.ws; float* out = a.out;
    const float* x_p = a.in[0]; const float* x_s = a.in[1]; const float* cache_k = a.in[2]; const float* cache_v = a.in[3]; const float* state0 = a.in[4];
    const float* ln1_g = a.in[5]; const float* w_in = a.in[6]; const float* gq = a.in[7]; const float* gk = a.in[8]; const float* sinks = a.in[9];
    const float* rng = a.in[10]; const float* w_out = a.in[11]; const float* ln2_g = a.in[12]; const float* w_up = a.in[13]; const float* w_dn = a.in[14];
    bf16_t* WIN = (bf16_t*)(ws + WS_WIN); bf16_t* WOUT = (bf16_t*)(ws + WS_WOUT); bf16_t* WUP = (bf16_t*)(ws + WS_WUP); bf16_t* WDN = (bf16_t*)(ws + WS_WDN);
    bf16_t* H1 = (bf16_t*)(ws + WS_H1); bf16_t* XG = H1; bf16_t* MIX = (bf16_t*)(ws + WS_MIX); bf16_t* Z = (bf16_t*)(ws + WS_Z); bf16_t* U = (bf16_t*)(ws + WS_U);
    float* PART = (float*)(ws + WS_PART); float* RSTD2 = (float*)(ws + WS_RSTD2); float* KV = (float*)(ws + WS_KV); bf16_t* SP = (bf16_t*)(ws + WS_SP);
    const int lo = a.ph_lo, hi = a.ph_hi;
#define IN(k) (lo <= (k) && (k) < hi)
#define SEAM(k) do { if (IN(k) && IN((k) + 1)) grid.sync(); } while (0)

    if (IN(0)) {
        LAS float* scr = (LAS float*)(lds + wid * 16384);
        const int gw = bx * 8 + wid, NGW = G * 8;
        constexpr int I_IN = (DM / 64) * (INW / 32), I_OUT = (DM / 64) * (DM / 32), I_UP = (DM / 64) * (FF / 32), I_DN = (FF / 64) * (DM / 32);
        for (int it = gw; it < I_IN + I_OUT + I_UP + I_DN; it += NGW) {
            int r = it;
            if (r < I_IN) { p0_transpose_item(w_in, DM, INW, WIN, scr, r, lane); continue; } r -= I_IN;
            if (r < I_OUT) { p0_transpose_item(w_out, DM, DM, WOUT, scr, r, lane); continue; } r -= I_OUT;
            if (r < I_UP) { p0_transpose_item(w_up, DM, FF, WUP, scr, r, lane); continue; } r -= I_UP;
            p0_transpose_item(w_dn, FF, DM, WDN, scr, r, lane);
        }
        for (int m = gw; m < MP; m += NGW) {
            if (m < MR) rms_row(m < LP ? x_p + (size_t)m * DM : x_s + (size_t)(m - LP) * DM, ln1_g, H1 + (size_t)m * DM, lane);
            else {
#pragma unroll
                for (int j = 0; j < 8; ++j) *((u32x2*)(H1 + (size_t)m * DM) + lane + 64 * j) = (u32x2){0u, 0u};
            }
        }
    }
    SEAM(0);
    if (IN(1)) {
        pg8::Gemm g{H1, WIN, MP, INW, DM}; pg8::StaticOrder S; S.init(MP, INW, G, bx);
        pg8::EpiIn E{Z};
        pg8::gemm_phase<pg8::EpiIn, pg8::StaticOrder, true, true>(lds, g, S, E);
    }
    SEAM(1);
    if (IN(2)) {
        for (int u = bx; u < 256; u += G) ret_step1(lds, Z, KV, u >> 2, u & 3, tid);
        for (int u = bx; u < 256; u += G) attn_prompt_unit(lds, Z, MIX, gq, gk, sinks, out + O_KP, out + O_VP, u >> 2, (u >> 1) & 1, u & 1, tid);
        for (int u = bx; u < 256; u += G) attn_decode_unit(lds, Z, cache_k, cache_v, MIX, gq, gk, sinks, out + O_KS, out + O_VS, u >> 1, u & 1, tid);
    }
    SEAM(2);
    if (IN(3)) {
        ret_scan(KV, SP, out + O_SP, bx * 512 + tid, G * 512);
        if (G == 256) {
            if (bx < 128) ret_decode_unit(lds, Z, state0, out + O_SS, MIX, rng, bx >> 2, bx & 3, tid);
            else for (int j = 0; j < 3; ++j) { const int u = 128 + 3 * (bx - 128) + j; ret_decode_unit(lds, Z, state0, out + O_SS, MIX, rng, u >> 2, u & 3, tid); }
        } else for (int u = bx; u < 512; u += G) ret_decode_unit(lds, Z, state0, out + O_SS, MIX, rng, u >> 2, u & 3, tid);
    }
    SEAM(3);
    if (IN(4)) {
        for (int u = bx; u < 256; u += G) ret_step2(lds, Z, SP, MIX, rng, u >> 2, u & 3, tid);
    }
    SEAM(4);
    if (IN(5)) {
        pg8::Gemm g{MIX, WOUT, MP, DM, DM}; pg8::StaticOrder S; S.init(MP, DM, G, bx);
        pg8::EpiOut E{x_p, x_s, out + O_Y, XG, ln2_g, PART};
        pg8::gemm_phase<pg8::EpiOut, pg8::StaticOrder, true, true>(lds, g, S, E);
    }
    SEAM(5);
    if (IN(6)) {
        for (int row = bx + G * tid; row < MP; row += G * 512) { float s = 0.f;
#pragma unroll
            for (int j = 0; j < 8; ++j) { const f32x4 p = *(const f32x4*)(PART + (size_t)row * 32 + 4 * j); s += (p[0] + p[1]) + (p[2] + p[3]); }
            RSTD2[row] = 1.0f / (s * (1.0f / DM) + EPS); }
        pg8::Gemm g{XG, WUP, MP, FF, DM}; pg8::StaticOrder S; S.init(MP, FF, G, bx);
        pg8::EpiUp E{U};
        pg8::gemm_phase<pg8::EpiUp, pg8::StaticOrder, true, true>(lds, g, S, E);
    }
    SEAM(6);
    if (IN(7)) {
        pg8::Gemm g{U, WDN, MP, DM, FF}; pg8::StaticOrder S; S.init(MP, DM, G, bx);
        pg8::EpiDown E{out + O_Y, RSTD2};
        pg8::gemm_phase<pg8::EpiDown, pg8::StaticOrder, true, true>(lds, g, S, E);
    }
#undef IN
#undef SEAM
}

#ifndef N_LAUNCHES
#define N_LAUNCHES 1
#endif
extern "C" void kernel_launch(void* const* d_in, const int* in_sizes, int n_in, void* d_out, int out_size, void* d_ws, size_t ws_size, hipStream_t stream) {
    static int grid = 0;
    if (grid == 0) {
        if (n_in != 15 || (size_t)out_size != O_END || ws_size < WS_END) { fprintf(stderr, "kernel_launch: unexpected shapes (n_in %d out %d ws %zu)\n", n_in, out_size, ws_size); grid = -1; return; }
        int dev = 0, cus = 0, per_cu = 0;
        (void)hipGetDevice(&dev); (void)hipDeviceGetAttribute(&cus, hipDeviceAttributeMultiprocessorCount, dev);
        if (hipFuncSetAttribute((const void*)fwd_kernel, hipFuncAttributeMaxDynamicSharedMemorySize, LDS_BYTES) != hipSuccess) { fprintf(stderr, "kernel_launch: hipFuncSetAttribute failed\n"); grid = -1; return; }
        (void)hipOccupancyMaxActiveBlocksPerMultiprocessor(&per_cu, (const void*)fwd_kernel, 512, LDS_BYTES);
        (void)hipGetLastError();
        if (per_cu < 1) { fprintf(stderr, "kernel_launch: occupancy query says %d blocks per CU\n", per_cu); }
        grid = cus > 0 ? cus : 256;
    }
    if (grid < 0) return;
    Args a{};
    for (int i = 0; i < 15; ++i) a.in[i] = (const float*)d_in[i];
    a.out = (float*)d_out; a.ws = (unsigned char*)d_ws;
    if (N_LAUNCHES == 1) {
        a.ph_lo = 0; a.ph_hi = NPH;
        void* args[] = {&a};
        hipError_t e = hipLaunchCooperativeKernel((const void*)fwd_kernel, dim3(grid), dim3(512), args, LDS_BYTES, stream);
        if (e != hipSuccess) fprintf(stderr, "cooperative launch failed: %s (grid %d)\n", hipGetErrorString(e), grid);
    } else {
        for (int p = 0; p < NPH; ++p) { a.ph_lo = p; a.ph_hi = p + 1; hipLaunchKernelGGL(fwd_kernel, dim3(grid), dim3(512), LDS_BYTES, stream, a); }
    }
}
```

```cpp
#include <hip/hip_runtime.h>
#include <hip/hip_cooperative_groups.h>
#include <cstdio>
#include <cstdint>
namespace cg = cooperative_groups;

#ifndef DUPMASK
#define DUPMASK 0
#endif
#define DI __device__ __forceinline__
#define LAS __attribute__((address_space(3)))
typedef float f32x2 __attribute__((ext_vector_type(2)));
typedef float f32x16 __attribute__((ext_vector_type(16)));
typedef short s16x4 __attribute__((ext_vector_type(4)));
typedef unsigned u32x2 __attribute__((ext_vector_type(2)));
typedef __bf16 bf16x2v __attribute__((ext_vector_type(2)));

constexpr int DM = 2048, LP = 8192, NS = 128, MR = LP + NS  , MP = 8448  ;
constexpr int INW = 5376, FF = 8192;
constexpr int C_AQ = 0, C_AK = 1024, C_AV = 1152, C_RQ = 1280, C_RK = 2304, C_RV = 3328, C_RG = 4352;
constexpr float EPS = 1e-6f;

DI unsigned pk2(float lo, float hi) { f32x2 v = {lo, hi}; return __builtin_bit_cast(unsigned, __builtin_convertvector(v, bf16x2v)); }
DI float bflo(unsigned u) { return __uint_as_float(u << 16); }
DI float bfhi(unsigned u) { return __uint_as_float(u & 0xffff0000u); }
DI float bf2f(unsigned short u) { return __uint_as_float(((unsigned)u) << 16); }

namespace pg8 {
#define PG8_LAS __attribute__((address_space(3)))
typedef unsigned short bf16_t;
typedef short bf16x8 __attribute__((ext_vector_type(8)));
typedef float f32x4 __attribute__((ext_vector_type(4)));
typedef unsigned u32x4 __attribute__((ext_vector_type(4)));
constexpr int BM = 256, BK = 64, HALF = 128, HTB = HALF * BK * 2  , STAGE_BYTES = 8 * HTB, NXCD = 8, WGM = 8;

__host__ __device__ __forceinline__ int lds_byte(int r, int c) { const int st = (r >> 4) * 2 + (c >> 5), rr = r & 15, cc = c & 31, ob = rr * 64 + cc * 2; return st * 1024 + (ob ^ (((ob >> 9) & 1) << 5)); }
__host__ __device__ __forceinline__ void stage_rc(int b, int& R, int& C) { const int st = b / 1024, sb = b % 1024, swz = sb ^ (((sb >> 9) & 1) << 5); R = (st >> 1) * 16 + swz / 64; C = (st & 1) * 32 + (swz % 64) / 2; }
__host__ __device__ __forceinline__ int perm32(int rho) { const int n = rho >> 4, i = rho & 15; return 8 * (i >> 2) + 4 * n + (i & 3); }

struct Unit { int pm, pn; };
struct Gemm { const bf16_t* A; const bf16_t* Bt; int M, N, K; };

struct StaticOrder {
    int nM, nN, nwg, G, c;
    __host__ __device__ void init(int M, int N, int G_, int c_) { nM = M / BM; nN = N / BM; nwg = nM * nN; G = G_; c = c_; }
    __host__ __device__ bool next(int i, Unit& u) const {
        const long L = (long)i * G + c; if (L >= nwg) return false;
        int wgid = (int)L; { const int q = nwg / NXCD, r = nwg % NXCD, xcd = wgid % NXCD, off = wgid / NXCD; wgid = (xcd < r ? xcd * (q + 1) : r * (q + 1) + (xcd - r) * q) + off; }
        const int nig = WGM * nN, gid = wgid / nig, fm = gid * WGM, gsz = (nM - fm) < WGM ? (nM - fm) : WGM;
        u.pm = fm + ((wgid % nig) % gsz); u.pn = (wgid % nig) / gsz; return true;
    }
    __device__ __forceinline__ void a_ready(const Unit&) const {}
    __device__ __forceinline__ void done(const Unit&) const {}
};


DI u32x4 pack8f(const f32x4& a, const f32x4& b) { u32x4 w; w.x = pk2(a[0], a[1]); w.y = pk2(a[2], a[3]); w.z = pk2(b[0], b[1]); w.w = pk2(b[2], b[3]); return w; }

struct EpiIn {
    static constexpr bool PERM = true, AFTER_DRAIN = false;
    bf16_t* Z;
    __device__ __forceinline__ void operator()(const f32x4 (&acc)[2][2][4][2], const Unit& u, int wr, int wc, int fr, int fq) const {
        const int row0 = u.pm * BM + wr * 64 + fr, col0 = u.pn * BM + wc * 32 + 8 * fq;
        if (u.pn < 5 || u.pn > 12) {
#pragma unroll
            for (int ai = 0; ai < 2; ++ai)
#pragma unroll
                for (int m = 0; m < 4; ++m) { bf16_t* rowp = Z + (size_t)(row0 + ai * HALF + m * 16) * INW + col0;
#pragma unroll
                    for (int bj = 0; bj < 2; ++bj) *(u32x4*)(rowp + bj * HALF) = pack8f(acc[ai][bj][m][0], acc[ai][bj][m][1]); }
        } else {
            const int head = (u.pn - 5) & 3; const bool isk = u.pn >= 9;
            const float lg = log1pf(-exp2f(-5.0f - (float)head));
            float inv[8];
#pragma unroll
            for (int j = 0; j < 8; ++j) inv[j] = powf(10000.0f, -(float)(wc * 32 + 8 * fq + j) * (1.0f / 128.0f));
#pragma unroll
            for (int ai = 0; ai < 2; ++ai)
#pragma unroll
                for (int m = 0; m < 4; ++m) {
                    const int row = row0 + ai * HALF + m * 16;
                    const int pos = row < LP ? row : LP; const float t = row < LP ? (float)(row & 127) : 0.0f;
                    const float f = isk ? 0.0625f * __expf(-lg * t) : __expf(lg * t);
                    f32x4 o1[2], o2[2];
#pragma unroll
                    for (int n = 0; n < 2; ++n)
#pragma unroll
                        for (int e = 0; e < 4; ++e) {
                            const float ang = (float)pos * inv[n * 4 + e];
                            double rev = (double)ang * 0.15915494309189535; rev -= floor(rev);
                            const float fr_ = (float)rev; const float sn = __builtin_amdgcn_sinf(fr_), cs = __builtin_amdgcn_cosf(fr_);
                            const float x1 = acc[ai][0][m][n][e], x2 = acc[ai][1][m][n][e];
                            o1[n][e] = (x1 * cs - x2 * sn) * f; o2[n][e] = (x2 * cs + x1 * sn) * f;
                        }
                    bf16_t* rowp = Z + (size_t)row * INW + col0;
                    *(u32x4*)(rowp) = pack8f(o1[0], o1[1]); *(u32x4*)(rowp + HALF) = pack8f(o2[0], o2[1]);
                }
        }
    }
};

struct EpiOut {
    static constexpr bool PERM = true, AFTER_DRAIN = false;
    const float* xp; const float* xs; float* X1; bf16_t* XG; const float* g2; float* part;
    __device__ __forceinline__ void operator()(const f32x4 (&acc)[2][2][4][2], const Unit& u, int wr, int wc, int fr, int fq) const {
#pragma unroll
        for (int ai = 0; ai < 2; ++ai) {
            const int rbase = u.pm * BM + ai * HALF; const bool valid = rbase < MR;
#pragma unroll
            for (int m = 0; m < 4; ++m) {
                const int row = rbase + wr * 64 + m * 16 + fr;
                const float* xrow = row < LP ? xp + (size_t)row * DM : xs + (size_t)(row - LP) * DM;
                float ss = 0.f;
#pragma unroll
                for (int bj = 0; bj < 2; ++bj) {
                    const int col = u.pn * BM + bj * HALF + wc * 32 + 8 * fq;
                    f32x4 v0 = {0.f, 0.f, 0.f, 0.f}, v1 = {0.f, 0.f, 0.f, 0.f};
                    if (valid) { v0 = acc[ai][bj][m][0] + *(const f32x4*)(xrow + col); v1 = acc[ai][bj][m][1] + *(const f32x4*)(xrow + col + 4);
                        *(f32x4*)(X1 + (size_t)row * DM + col) = v0; *(f32x4*)(X1 + (size_t)row * DM + col + 4) = v1; }
                    ss += (v0[0] * v0[0] + v0[1] * v0[1]) + (v0[2] * v0[2] + v0[3] * v0[3]) + (v1[0] * v1[0] + v1[1] * v1[1]) + (v1[2] * v1[2] + v1[3] * v1[3]);
                    const f32x4 ga = *(const f32x4*)(g2 + col), gb = *(const f32x4*)(g2 + col + 4);
                    *(u32x4*)(XG + (size_t)row * DM + col) = pack8f(v0 * ga, v1 * gb);
                }
                ss += __shfl_xor(ss, 16); ss += __shfl_xor(ss, 32);
                if (fq == 0) part[(size_t)row * 32 + u.pn * 4 + wc] = ss;
            }
        }
    }
};

struct EpiUp {
    static constexpr bool PERM = true, AFTER_DRAIN = false;
    bf16_t* U;
    __device__ __forceinline__ void operator()(const f32x4 (&acc)[2][2][4][2], const Unit& u, int wr, int wc, int fr, int fq) const {
        const int row0 = u.pm * BM + wr * 64 + fr, col0 = u.pn * BM + wc * 32 + 8 * fq;
#pragma unroll
        for (int ai = 0; ai < 2; ++ai)
#pragma unroll
            for (int m = 0; m < 4; ++m) { bf16_t* rowp = U + (size_t)(row0 + ai * HALF + m * 16) * FF + col0;
#pragma unroll
                for (int bj = 0; bj < 2; ++bj) { f32x4 a = acc[ai][bj][m][0], b = acc[ai][bj][m][1];
#pragma unroll
                    for (int e = 0; e < 4; ++e) { a[e] = fmaxf(a[e], 0.f); a[e] *= a[e]; b[e] = fmaxf(b[e], 0.f); b[e] *= b[e]; }
                    *(u32x4*)(rowp + bj * HALF) = pack8f(a, b); } }
    }
};

struct EpiDown {
    static constexpr bool PERM = true, AFTER_DRAIN = false;
    float* Y; const float* rstd2;
    __device__ __forceinline__ void operator()(const f32x4 (&acc)[2][2][4][2], const Unit& u, int wr, int wc, int fr, int fq) const {
#pragma unroll
        for (int ai = 0; ai < 2; ++ai) {
            const int rbase = u.pm * BM + ai * HALF; if (rbase >= MR) continue;
#pragma unroll
            for (int m = 0; m < 4; ++m) {
                const int row = rbase + wr * 64 + m * 16 + fr; const float r2 = rstd2[row];
#pragma unroll
                for (int bj = 0; bj < 2; ++bj) { float* p = Y + (size_t)row * DM + u.pn * BM + bj * HALF + wc * 32 + 8 * fq;
                    const f32x4 a = *(const f32x4*)p, b = *(const f32x4*)(p + 4);
                    *(f32x4*)p = a + acc[ai][bj][m][0] * r2; *(f32x4*)(p + 4) = b + acc[ai][bj][m][1] * r2; }
            }
        }
    }
};
template <class Epi, class Sched, bool ALIGN_EPI = false, bool SP2 = false>
__device__ __forceinline__ void gemm_phase(PG8_LAS unsigned char* lds, const Gemm g, const Sched& S, const Epi& E) {
    const int tid = threadIdx.x, wid = __builtin_amdgcn_readfirstlane(tid >> 6), lane = tid & 63, wr = wid >> 2, wc = wid & 3, fr = lane & 15, fq = lane >> 4;
    const int K = g.K, nt = K / BK;
    unsigned voffA[2], voffB[2];
#pragma unroll
    for (int i = 0; i < 2; ++i) { int R, C; stage_rc(tid * 16 + i * 8192, R, C); const int Rb = Epi::PERM ? ((R & ~31) + perm32(R & 31)) : R;
        voffA[i] = (unsigned)(R * K + C) * 2u; voffB[i] = (unsigned)(Rb * K + C) * 2u; }
    const size_t kstep = (size_t)(BK * 2);
    const size_t hstep = (size_t)HALF * K * 2;
    const size_t tstep = 2 * hstep;
    const unsigned ldsw = (unsigned)wid * 1024u;
    const int aoff = lds_byte(wr * 64 + fr, fq * 8), boff = lds_byte(wc * 32 + fr, fq * 8);
#define PG8_SA(b, h) (((b) * 2 + (h)) * HTB)
#define PG8_SB(b, h) ((4 + (b) * 2 + (h)) * HTB)
#define PG8_STAGE(bufoff, gbase, voff) do { _Pragma("unroll") for (int _i = 0; _i < 2; ++_i) \
        __builtin_amdgcn_global_load_lds((const unsigned*)((const char*)(gbase) + (voff)[_i]), (PG8_LAS unsigned*)(lds + (bufoff) + ldsw + _i * 8192), 16, 0, 0); } while (0)
#define PG8_LDA(dst, b, h) do { _Pragma("unroll") for (int m = 0; m < 4; ++m) _Pragma("unroll") for (int k = 0; k < 2; ++k) dst[m][k] = *(const PG8_LAS bf16x8*)(lds + PG8_SA(b, h) + aoff + m * 2048 + k * 1024); } while (0)
#define PG8_LDB(dst, b, h) do { _Pragma("unroll") for (int n = 0; n < 2; ++n) _Pragma("unroll") for (int k = 0; k < 2; ++k) dst[n][k] = *(const PG8_LAS bf16x8*)(lds + PG8_SB(b, h) + boff + n * 2048 + k * 1024); } while (0)
#define PG8_MMA(ai, bj, At, Bt) do { __builtin_amdgcn_s_setprio(1); _Pragma("unroll") for (int m = 0; m < 4; ++m) _Pragma("unroll") for (int n = 0; n < 2; ++n) _Pragma("unroll") for (int k = 0; k < 2; ++k) \
        acc[ai][bj][m][n] = __builtin_amdgcn_mfma_f32_16x16x32_bf16(Bt[n][k], At[m][k], acc[ai][bj][m][n], 0, 0, 0); __builtin_amdgcn_s_setprio(0); } while (0)
#define PG8_WAIT_V(n) asm volatile("s_waitcnt vmcnt(" #n ")" ::: "memory")
#define PG8_WAIT_L(n) asm volatile("s_waitcnt lgkmcnt(" #n ")" ::: "memory")
#define PG8_BAR __builtin_amdgcn_s_barrier()
#define PG8_SCHED __builtin_amdgcn_sched_barrier(0)
    Unit cur, nxt; int ui = 0;
    if (!S.next(0, cur)) return;
    f32x4 acc[2][2][4][2];
#pragma unroll
    for (int a = 0; a < 2; ++a)
#pragma unroll
        for (int b = 0; b < 2; ++b)
#pragma unroll
            for (int m = 0; m < 4; ++m)
#pragma unroll
                for (int n = 0; n < 2; ++n) acc[a][b][m][n] = (f32x4){0.f, 0.f, 0.f, 0.f};
    bf16x8 At[4][2], B0[2][2], B1[2][2];
    const char* cA = (const char*)g.A + (size_t)cur.pm * tstep; const char* cB = (const char*)g.Bt + (size_t)cur.pn * tstep;
    S.a_ready(cur);
    if constexpr (SP2) {
        PG8_STAGE(PG8_SB(0, 0), cB, voffB); PG8_STAGE(PG8_SB(0, 1), cB + hstep, voffB); PG8_STAGE(PG8_SA(0, 0), cA, voffA); PG8_STAGE(PG8_SA(0, 1), cA + hstep, voffA);
        if (wr == 1) PG8_BAR;
        PG8_WAIT_V(2); PG8_BAR;
        PG8_STAGE(PG8_SB(1, 0), cB + kstep, voffB); PG8_STAGE(PG8_SA(1, 0), cA + kstep, voffA); PG8_STAGE(PG8_SB(1, 1), cB + hstep + kstep, voffB);
        PG8_WAIT_V(6); PG8_BAR;
    } else {
        PG8_STAGE(PG8_SB(0, 0), cB, voffB); PG8_STAGE(PG8_SA(0, 0), cA, voffA); PG8_STAGE(PG8_SB(0, 1), cB + hstep, voffB); PG8_STAGE(PG8_SA(0, 1), cA + hstep, voffA);
        if (wr == 1) PG8_BAR;
        PG8_WAIT_V(4); PG8_BAR;
        PG8_STAGE(PG8_SB(1, 0), cB + kstep, voffB); PG8_STAGE(PG8_SA(1, 0), cA + kstep, voffA); PG8_STAGE(PG8_SB(1, 1), cB + hstep + kstep, voffB);
        PG8_WAIT_V(6); PG8_BAR;
    }
    for (;;) {
        const bool has_next = S.next(ui + 1, nxt);
        const char* nA = has_next ? (const char*)g.A + (size_t)nxt.pm * tstep : cA; const char* nB = has_next ? (const char*)g.Bt + (size_t)nxt.pn * tstep : cB;
        for (int t = 0; t < nt; t += 2) {
            const bool last = (t == nt - 2);
            const char* a1 = cA + (size_t)(t + 1) * kstep;
            const char* a2 = last ? nA : cA + (size_t)(t + 2) * kstep; const char* b2 = last ? nB : cB + (size_t)(t + 2) * kstep;
            const char* a3 = a2 + kstep; const char* b3 = b2 + kstep;
            if (last && has_next) S.a_ready(nxt);
            if constexpr (SP2) {
            PG8_LDB(B0, 0, 0); PG8_LDB(B1, 0, 1); PG8_SCHED; PG8_LDA(At, 0, 0); PG8_STAGE(PG8_SA(1, 1), a1 + hstep, voffA);
            PG8_WAIT_V(8); PG8_WAIT_L(0); PG8_BAR; PG8_MMA(0, 0, At, B0); PG8_MMA(0, 1, At, B1); PG8_BAR; PG8_SCHED;
            PG8_LDA(At, 0, 1); PG8_STAGE(PG8_SB(0, 0), b2, voffB); PG8_STAGE(PG8_SB(0, 1), b2 + hstep, voffB); PG8_STAGE(PG8_SA(0, 0), a2, voffA);
            PG8_WAIT_V(8); PG8_WAIT_L(0); PG8_BAR; PG8_MMA(1, 0, At, B0); PG8_MMA(1, 1, At, B1); PG8_BAR; PG8_SCHED;
            PG8_LDB(B0, 1, 0); PG8_LDB(B1, 1, 1); PG8_SCHED; PG8_LDA(At, 1, 0); PG8_STAGE(PG8_SA(0, 1), a2 + hstep, voffA);
            PG8_WAIT_V(8); PG8_WAIT_L(0); PG8_BAR; PG8_MMA(0, 0, At, B0); PG8_MMA(0, 1, At, B1); PG8_BAR; PG8_SCHED;
            PG8_LDA(At, 1, 1); PG8_STAGE(PG8_SB(1, 0), b3, voffB); PG8_STAGE(PG8_SB(1, 1), b3 + hstep, voffB); PG8_STAGE(PG8_SA(1, 0), a3, voffA);
            PG8_WAIT_V(8); PG8_WAIT_L(0); PG8_BAR; PG8_MMA(1, 0, At, B0); PG8_MMA(1, 1, At, B1); PG8_BAR; PG8_SCHED;
            } else {
            PG8_LDB(B0, 0, 0); PG8_SCHED; PG8_LDA(At, 0, 0); PG8_STAGE(PG8_SA(1, 1), a1 + hstep, voffA);
            PG8_WAIT_L(8); PG8_BAR; PG8_WAIT_L(0); PG8_MMA(0, 0, At, B0); PG8_BAR; PG8_SCHED;
            PG8_LDB(B1, 0, 1); PG8_STAGE(PG8_SB(0, 0), b2, voffB);
            PG8_BAR; PG8_WAIT_L(0); PG8_MMA(0, 1, At, B1); PG8_BAR;
            PG8_LDA(At, 0, 1); PG8_STAGE(PG8_SA(0, 0), a2, voffA);
            PG8_BAR; PG8_WAIT_L(0); PG8_MMA(1, 0, At, B0); PG8_BAR; PG8_SCHED;
            PG8_STAGE(PG8_SB(0, 1), b2 + hstep, voffB);
            PG8_WAIT_V(6); PG8_BAR; PG8_MMA(1, 1, At, B1); PG8_BAR;
            PG8_LDB(B0, 1, 0); PG8_SCHED; PG8_LDA(At, 1, 0); PG8_STAGE(PG8_SA(0, 1), a2 + hstep, voffA);
            PG8_WAIT_L(8); PG8_BAR; PG8_WAIT_L(0); PG8_MMA(0, 0, At, B0); PG8_BAR; PG8_SCHED;
            PG8_LDB(B1, 1, 1); PG8_STAGE(PG8_SB(1, 0), b3, voffB);
            PG8_BAR; PG8_WAIT_L(0); PG8_MMA(0, 1, At, B1); PG8_BAR;
            PG8_LDA(At, 1, 1); PG8_STAGE(PG8_SA(1, 0), a3, voffA);
            PG8_BAR; PG8_WAIT_L(0); PG8_MMA(1, 0, At, B0); PG8_BAR; PG8_SCHED;
            PG8_STAGE(PG8_SB(1, 1), b3 + hstep, voffB);
            PG8_WAIT_V(6); PG8_BAR; PG8_MMA(1, 1, At, B1); PG8_BAR;
            }
        }
        if constexpr (ALIGN_EPI) { if (wr == 0) PG8_BAR; }
        if constexpr (!Epi::AFTER_DRAIN) { E(acc, cur, wr, wc, fr, fq); S.done(cur); }
        if (!has_next) break;
#pragma unroll
        for (int a = 0; a < 2; ++a)
#pragma unroll
            for (int b = 0; b < 2; ++b)
#pragma unroll
                for (int m = 0; m < 4; ++m)
#pragma unroll
                    for (int n = 0; n < 2; ++n) acc[a][b][m][n] = (f32x4){0.f, 0.f, 0.f, 0.f};
        cur = nxt; cA = nA; cB = nB; ++ui;
        if constexpr (ALIGN_EPI) { if (wr == 1) PG8_BAR; }
    }
    PG8_WAIT_V(0);
    if constexpr (!ALIGN_EPI) { if (wr == 0) PG8_BAR; }
    PG8_BAR;
    if constexpr (Epi::AFTER_DRAIN) { E.fused(acc, cur, wr, wc, fr, fq, lds, wid, lane); S.done(cur); }
#undef PG8_SA
#undef PG8_SB
#undef PG8_STAGE
#undef PG8_LDA
#undef PG8_LDB
#undef PG8_MMA
#undef PG8_WAIT_V
#undef PG8_WAIT_L
#undef PG8_BAR
#undef PG8_SCHED
}
}

using pg8::bf16_t; using pg8::bf16x8; using pg8::f32x4; using pg8::u32x4;
#define MFMA32(a, b, c) __builtin_amdgcn_mfma_f32_32x32x16_bf16((a), (b), (c), 0, 0, 0)
DI int crow(int reg, int h) { return (reg & 3) + 8 * (reg >> 2) + 4 * h; }
DI float wave_sum(float v) {
#pragma unroll
    for (int o = 1; o < 64; o <<= 1) v += __shfl_xor(v, o);
    return v;
}
DI float wave_max(float v) {
#pragma unroll
    for (int o = 1; o < 64; o <<= 1) v = fmaxf(v, __shfl_xor(v, o));
    return v;
}
DI bf16x8 pack8(const f32x16& x, int s) { u32x4 p; p.x = pk2(x[8 * s], x[8 * s + 1]); p.y = pk2(x[8 * s + 2], x[8 * s + 3]); p.z = pk2(x[8 * s + 4], x[8 * s + 5]); p.w = pk2(x[8 * s + 6], x[8 * s + 7]); return __builtin_bit_cast(bf16x8, p); }
DI bf16x8 cat4(s16x4 lo, s16x4 hi) { return __builtin_shufflevector(lo, hi, 0, 1, 2, 3, 4, 5, 6, 7); }
DI f32x16 zero16() { f32x16 z;
#pragma unroll
    for (int i = 0; i < 16; ++i) z[i] = 0.f;
    return z; }
DI float gamma_of(int h) { return 1.0f - exp2f(-5.0f - (float)h); }

constexpr size_t MiB = 1u << 20;
constexpr size_t WS_WIN = 1 * MiB;
constexpr size_t WS_WOUT = 23 * MiB;
constexpr size_t WS_WUP = 31 * MiB;
constexpr size_t WS_WDN = 63 * MiB;
constexpr size_t WS_H1 = 95 * MiB;
constexpr size_t WS_MIX = 128 * MiB;
constexpr size_t WS_PART = 161 * MiB;
constexpr size_t WS_RSTD2 = 163 * MiB;
constexpr size_t WS_Z = 164 * MiB;
constexpr size_t WS_KV = 252 * MiB;
constexpr size_t WS_SP = 316 * MiB;
constexpr size_t WS_U = 164 * MiB;
constexpr size_t WS_END = 348 * MiB;
static_assert(WS_Z + (size_t)MP * INW * 2 <= WS_KV && WS_U + (size_t)MP * FF * 2 <= WS_END && WS_H1 + (size_t)MP * DM * 2 <= WS_MIX && WS_MIX + (size_t)MP * DM * 2 <= WS_PART, "ws map");
constexpr int LDS_BYTES = 147456;

constexpr size_t O_Y = 0, O_KP = (size_t)MR * DM, O_VP = O_KP + 16384, O_SP = O_VP + 16384, O_KS = O_SP + 262144, O_VS = O_KS + 2097152, O_SS = O_VS + 2097152, O_END = O_SS + 33554432;

DI void p0_transpose_item(const float* W, int K, int N, bf16_t* WT, LAS float* scr, int item, int lane) {
    const int nblk = N / 32, kb = item / nblk, nb = item % nblk, k0 = 64 * kb, n0 = 32 * nb;
#pragma unroll 8
    for (int i = 0; i < 32; ++i) { const int kk = 2 * i + (lane >> 5); scr[kk * 33 + (lane & 31)] = W[(size_t)(k0 + kk) * N + n0 + (lane & 31)]; }
    asm volatile("s_waitcnt lgkmcnt(0)" ::: "memory");
    const int c = lane & 7;
#pragma unroll
    for (int j = 0; j < 4; ++j) { const int n = (lane >> 3) + 8 * j; const LAS float* s = scr + (8 * c) * 33 + n;
        u32x4 o; o.x = pk2(s[0 * 33], s[1 * 33]); o.y = pk2(s[2 * 33], s[3 * 33]); o.z = pk2(s[4 * 33], s[5 * 33]); o.w = pk2(s[6 * 33], s[7 * 33]);
        *(u32x4*)(WT + (size_t)(n0 + n) * K + k0 + 8 * c) = o; }
    asm volatile("s_waitcnt lgkmcnt(0)" ::: "memory");
}
DI void rms_row(const float* xrow, const float* g, bf16_t* orow, int lane) {
    f32x4 v[8]; float s = 0.f;
#pragma unroll
    for (int j = 0; j < 8; ++j) { v[j] = *((const f32x4*)xrow + lane + 64 * j); s += (v[j][0] * v[j][0] + v[j][1] * v[j][1]) + (v[j][2] * v[j][2] + v[j][3] * v[j][3]); }
    const float rstd = rsqrtf(wave_sum(s) * (1.0f / DM) + EPS);
#pragma unroll
    for (int j = 0; j < 8; ++j) { const f32x4 gg = *((const f32x4*)g + lane + 64 * j); u32x2 o; o.x = pk2(v[j][0] * rstd * gg[0], v[j][1] * rstd * gg[1]); o.y = pk2(v[j][2] * rstd * gg[2], v[j][3] * rstd * gg[3]);
        *((u32x2*)orow + lane + 64 * j) = o; }
}

DI void stage_T128x256(LAS unsigned char* img, const bf16_t* src, int tid) {
#pragma unroll
    for (int k = 0; k < 4; ++k) {
        const int it = k * 512 + tid, dgl = it & 3, tpl = (it >> 2) & 15, rest = it >> 6, dg = dgl + 4 * (rest & 7), tp = tpl + 16 * (rest >> 3);
        const bf16_t* p = src + (size_t)(2 * tp) * INW + dg * 8;
        const u32x4 a = *(const u32x4*)p, b = *(const u32x4*)(p + INW);
#pragma unroll
        for (int e = 0; e < 8; ++e) {
            const unsigned lo = (e & 1) ? (a[e >> 1] >> 16) : (a[e >> 1] & 0xffffu), hi = (e & 1) ? (b[e >> 1] & 0xffff0000u) : (b[e >> 1] << 16);
            *(LAS unsigned*)(img + (dg * 8 + e) * 264 + tp * 4) = lo | hi;
        }
    }
}

DI void ret_step1(LAS unsigned char* lds, const bf16_t* Z, float* KV, int n, int h, int tid) {
    LAS unsigned char* Kt = lds; LAS unsigned char* Vt = lds + 256 * 264;
    const int lane = tid & 63, wid = tid >> 6, r = lane & 31, hh = lane >> 5;
    stage_T128x256(Kt, Z + (size_t)(n * 128) * INW + C_RK + h * 256, tid);
    stage_T128x256(Vt, Z + (size_t)(n * 128) * INW + C_RV + h * 256, tid);
    __syncthreads();
    f32x16 acc[8];
#pragma unroll
    for (int i = 0; i < 8; ++i) acc[i] = zero16();
    const int dv0 = wid * 32;
#pragma unroll 2
    for (int s = 0; s < 8; ++s) {
        const LAS unsigned char* pa = Vt + (dv0 + r) * 264 + (16 * s + 8 * hh) * 2;
        const bf16x8 A = cat4(*(const LAS s16x4*)pa, *(const LAS s16x4*)(pa + 8));
#pragma unroll
        for (int dt = 0; dt < 8; ++dt) {
            const LAS unsigned char* pb = Kt + (dt * 32 + r) * 264 + (16 * s + 8 * hh) * 2;
            const bf16x8 B = cat4(*(const LAS s16x4*)pb, *(const LAS s16x4*)(pb + 8));
            acc[dt] = MFMA32(A, B, acc[dt]);
        }
    }
    float* out = KV + ((size_t)(n * 4 + h) * 256 + dv0) * 256;
#pragma unroll
    for (int dt = 0; dt < 8; ++dt)
#pragma unroll
        for (int i = 0; i < 16; ++i) out[(size_t)crow(i, hh) * 256 + dt * 32 + r] = acc[dt][i];
    __syncthreads();
}

DI void ret_scan(const float* KV, bf16_t* SP, float* o_state, int gt, int nthreads) {
    for (int e = gt; e < 65536; e += nthreads) {
        const int h = e >> 14, dv = (e >> 6) & 255, dk4 = (e & 63) * 4;
        const float lg = log1pf(-exp2f(-5.0f - (float)h)), Dc = __expf(128.0f * lg), c1 = __expf(127.0f * lg);
        const size_t base = ((size_t)(h * 256 + dv)) * 256 + dk4;
        f32x4 s = {0.f, 0.f, 0.f, 0.f};
        for (int n0 = 0; n0 < 64; n0 += 8) {
            f32x4 kv[8];
#pragma unroll
            for (int u = 0; u < 8; ++u) kv[u] = *(const f32x4*)(KV + (size_t)(n0 + u) * 262144 + base);
#pragma unroll
            for (int u = 0; u < 8; ++u) { u32x2 o; o.x = pk2(s[0], s[1]); o.y = pk2(s[2], s[3]); *(u32x2*)(SP + (size_t)(n0 + u) * 262144 + base) = o; s = s * Dc + kv[u] * c1; }
        }
#pragma unroll
        for (int j = 0; j < 4; ++j) o_state[((size_t)(h * 256 + dk4 + j)) * 256 + dv] = s[j];
    }
}

DI float silu_f(float x) { return x / (1.0f + __expf(-x)); }

DI void ret_step2(LAS unsigned char* lds, const bf16_t* Z, const bf16_t* SP, bf16_t* MIX, const float* rng, int n, int h, int tid) {
    LAS unsigned char* Kr = lds; LAS unsigned char* Vt = lds + 128 * 528; LAS float* red = (LAS float*)(lds + 128 * 528 + 256 * 264);
    const int lane = tid & 63, wid = tid >> 6, r = lane & 31, hh = lane >> 5;
    const bf16_t* zc = Z + (size_t)(n * 128) * INW;
#pragma unroll
    for (int k = 0; k < 8; ++k) { const int it = k * 512 + tid, row = it >> 5, c = it & 31;
        *(LAS u32x4*)(Kr + row * 528 + c * 16) = *(const u32x4*)(zc + (size_t)row * INW + C_RK + h * 256 + c * 8); }
    stage_T128x256(Vt, zc + C_RV + h * 256, tid);
    const int it_ = wid >> 1, dh = wid & 1;
    bf16x8 qf[16];
    { const bf16_t* qp = zc + (size_t)(32 * it_ + r) * INW + C_RQ + h * 256 + 8 * hh;
#pragma unroll
      for (int s = 0; s < 16; ++s) qf[s] = *(const bf16x8*)(qp + 16 * s); }
    f32x16 acc[4];
#pragma unroll
    for (int i = 0; i < 4; ++i) acc[i] = zero16();
    { const bf16_t* sp = SP + ((size_t)(n * 4 + h) * 256 + 128 * dh + r) * 256 + 8 * hh;
#pragma unroll
      for (int dt = 0; dt < 4; ++dt)
#pragma unroll
          for (int s = 0; s < 16; ++s) { const bf16x8 A = *(const bf16x8*)(sp + (size_t)dt * 32 * 256 + 16 * s); acc[dt] = MFMA32(A, qf[s], acc[dt]); } }
    const float gm = gamma_of(h);
#pragma unroll
    for (int dt = 0; dt < 4; ++dt) acc[dt] = acc[dt] * gm;
    __syncthreads();
    for (int jt = 0; jt <= it_; ++jt) {
        f32x16 X = zero16();
#pragma unroll
        for (int s = 0; s < 16; ++s) { const bf16x8 A = *(const LAS bf16x8*)(Kr + (32 * jt + r) * 528 + (16 * s + 8 * hh) * 2); X = MFMA32(A, qf[s], X); }
        if (jt == it_) {
#pragma unroll
            for (int i = 0; i < 16; ++i) X[i] = (crow(i, hh) > r) ? 0.f : X[i];
        }
#pragma unroll
        for (int s2 = 0; s2 < 2; ++s2) { const bf16x8 xs = pack8(X, s2);
#pragma unroll
            for (int dt = 0; dt < 4; ++dt) { const LAS unsigned char* pa = Vt + (128 * dh + 32 * dt + r) * 264 + (32 * jt + 16 * s2 + 4 * hh) * 2;
                const bf16x8 A = cat4(*(const LAS s16x4*)pa, *(const LAS s16x4*)(pa + 16)); acc[dt] = MFMA32(A, xs, acc[dt]); } }
    }
    float ss = 0.f;
#pragma unroll
    for (int dt = 0; dt < 4; ++dt)
#pragma unroll
        for (int i = 0; i < 16; ++i) ss += acc[dt][i] * acc[dt][i];
    ss += __shfl_xor(ss, 32);
    if (hh == 0) red[wid * 32 + r] = ss;
    __syncthreads();
    const float rstd = rsqrtf((red[wid * 32 + r] + red[(wid ^ 1) * 32 + r]) * (1.0f / 256.0f) + EPS);
    const size_t token = (size_t)n * 128 + 32 * it_ + r;
#pragma unroll
    for (int dt = 0; dt < 4; ++dt)
#pragma unroll
        for (int g4 = 0; g4 < 4; ++g4) {
            const int dv = 128 * dh + 32 * dt + 8 * g4 + 4 * hh;
            const u32x2 gz = *(const u32x2*)(Z + token * INW + C_RG + h * 256 + dv);
            const f32x4 gn = *(const f32x4*)(rng + h * 256 + dv);
            const float y0 = acc[dt][4 * g4 + 0] * rstd * gn[0] * silu_f(bflo(gz.x)), y1 = acc[dt][4 * g4 + 1] * rstd * gn[1] * silu_f(bfhi(gz.x));
            const float y2 = acc[dt][4 * g4 + 2] * rstd * gn[2] * silu_f(bflo(gz.y)), y3 = acc[dt][4 * g4 + 3] * rstd * gn[3] * silu_f(bfhi(gz.y));
            u32x2 o; o.x = pk2(y0, y1); o.y = pk2(y2, y3);
            *(u32x2*)(MIX + token * DM + 1024 + h * 256 + dv) = o;
        }
    __syncthreads();
}

DI void ret_decode_unit(LAS unsigned char* lds, const bf16_t* Z, const float* S0, float* S1, bf16_t* MIX, const float* rng, int b, int h, int tid) {
    LAS float* qv = (LAS float*)lds; LAS float* red = qv + 768;
    const int lane = tid & 63, wid = tid >> 6;
    const bf16_t* zrow = Z + (size_t)(LP + b) * INW;
    if (tid < 256) { qv[tid] = bf2f(zrow[C_RQ + h * 256 + tid]); qv[256 + tid] = bf2f(zrow[C_RK + h * 256 + tid]); qv[512 + tid] = bf2f(zrow[C_RV + h * 256 + tid]); }
    __syncthreads();
    const float gm = gamma_of(h);
    const f32x4 v4 = *(const LAS f32x4*)(qv + 512 + 4 * lane);
    f32x4 acc = {0.f, 0.f, 0.f, 0.f};
    const size_t off = ((size_t)(b * 4 + h) * 256 + wid * 32) * 256 + 4 * lane;
    const float* s0 = S0 + off; float* s1 = S1 + off;
#pragma unroll 1
    for (int rr = 0; rr < 32; rr += 8) {
        f32x4 s[8];
#pragma unroll
        for (int u = 0; u < 8; ++u) s[u] = __builtin_nontemporal_load((const f32x4*)(s0 + (size_t)(rr + u) * 256));
#pragma unroll
        for (int u = 0; u < 8; ++u) { const int dk = wid * 32 + rr + u; const float kk = qv[256 + dk], qq = qv[dk];
            const f32x4 sn = s[u] * gm + v4 * kk; __builtin_nontemporal_store(sn, (f32x4*)(s1 + (size_t)(rr + u) * 256)); acc += sn * qq; }
    }
    *(LAS f32x4*)(red + wid * 256 + 4 * lane) = acc;
    __syncthreads();
    if (wid == 0) {
        f32x4 o = {0.f, 0.f, 0.f, 0.f};
#pragma unroll
        for (int w = 0; w < 8; ++w) o += *(const LAS f32x4*)(red + w * 256 + 4 * lane);
        const float ssq = wave_sum((o[0] * o[0] + o[1] * o[1]) + (o[2] * o[2] + o[3] * o[3]));
        const float rstd = rsqrtf(ssq * (1.0f / 256.0f) + EPS);
        const u32x2 gz = *(const u32x2*)(zrow + C_RG + h * 256 + 4 * lane);
        const f32x4 gn = *(const f32x4*)(rng + h * 256 + 4 * lane);
        u32x2 y; y.x = pk2(o[0] * rstd * gn[0] * silu_f(bflo(gz.x)), o[1] * rstd * gn[1] * silu_f(bfhi(gz.x)));
        y.y = pk2(o[2] * rstd * gn[2] * silu_f(bflo(gz.y)), o[3] * rstd * gn[3] * silu_f(bfhi(gz.y)));
        *(u32x2*)(MIX + (size_t)(LP + b) * DM + 1024 + h * 256 + 4 * lane) = y;
    }
    __syncthreads();
}

DI void attn_prompt_unit(LAS unsigned char* lds, const bf16_t* Z, bf16_t* MIX, const float* gq, const float* gk, const float* sinks, float* o_k, float* o_v, int nb, int kh, int hf, int tid) {
    LAS unsigned char* Kn = lds; LAS unsigned char* Vt = lds + 256 * 144;
    const int lane = tid & 63, wid = tid >> 6, r = lane & 31, hh = lane >> 5;
    {
        const int row = tid >> 1, half = tid & 1; const int tok = (nb - 1) * 128 + row;
        u32x4 v[4];
#pragma unroll
        for (int c = 0; c < 4; ++c) v[c] = (u32x4){0u, 0u, 0u, 0u};
        if (tok >= 0) {
#pragma unroll
            for (int c = 0; c < 4; ++c) v[c] = *(const u32x4*)(Z + (size_t)tok * INW + C_AK + kh * 64 + half * 32 + c * 8);
        }
        float f[32]; float ss = 0.f;
#pragma unroll
        for (int c = 0; c < 4; ++c)
#pragma unroll
            for (int e = 0; e < 4; ++e) { f[c * 8 + 2 * e] = bflo(v[c][e]); f[c * 8 + 2 * e + 1] = bfhi(v[c][e]); }
#pragma unroll
        for (int e = 0; e < 32; ++e) ss += f[e] * f[e];
        ss += __shfl_xor(ss, 1);
        const float rstd = rsqrtf(ss * (1.0f / 64.0f) + EPS);
#pragma unroll
        for (int c = 0; c < 8; ++c) { const f32x4 g = *(const f32x4*)(gk + half * 32 + c * 4);
#pragma unroll
            for (int e = 0; e < 4; ++e) f[c * 4 + e] *= rstd * g[e]; }
#pragma unroll
        for (int c = 0; c < 4; ++c) { u32x4 w; w.x = pk2(f[c * 8], f[c * 8 + 1]); w.y = pk2(f[c * 8 + 2], f[c * 8 + 3]); w.z = pk2(f[c * 8 + 4], f[c * 8 + 5]); w.w = pk2(f[c * 8 + 6], f[c * 8 + 7]);
            *(LAS u32x4*)(Kn + row * 144 + half * 64 + c * 16) = w; }
        if (nb == 63 && hf == 0 && row >= 128) { float* o = o_k + ((size_t)(row - 128) * 2 + kh) * 64 + half * 32;
#pragma unroll
            for (int c = 0; c < 8; ++c) *(f32x4*)(o + c * 4) = (f32x4){f[c * 4], f[c * 4 + 1], f[c * 4 + 2], f[c * 4 + 3]}; }
    }
#pragma unroll
    for (int k = 0; k < 2; ++k) {
        const int it = k * 512 + tid, kpl = it & 15, dgl = (it >> 4) & 3, rest = it >> 6, dg = dgl + 4 * (rest & 1), kp = kpl + 16 * (rest >> 1);
        const int tok0 = (nb - 1) * 128 + 2 * kp;
        u32x4 a = {0u, 0u, 0u, 0u}, b = {0u, 0u, 0u, 0u};
        if (tok0 >= 0) { const bf16_t* p = Z + (size_t)tok0 * INW + C_AV + kh * 64 + dg * 8; a = *(const u32x4*)p; b = *(const u32x4*)(p + INW); }
#pragma unroll
        for (int e = 0; e < 8; ++e) {
            const unsigned lo = (e & 1) ? (a[e >> 1] >> 16) : (a[e >> 1] & 0xffffu), hi = (e & 1) ? (b[e >> 1] & 0xffff0000u) : (b[e >> 1] << 16);
            *(LAS unsigned*)(Vt + (dg * 8 + e) * 520 + kp * 4) = lo | hi;
        }
        if (nb == 63 && hf == 0 && kp >= 64) { float* o = o_v + ((size_t)(2 * kp - 128) * 2 + kh) * 64 + dg * 8;
#pragma unroll
            for (int e = 0; e < 4; ++e) { o[2 * e] = bflo(a[e]); o[2 * e + 1] = bfhi(a[e]); o[128 + 2 * e] = bflo(b[e]); o[128 + 2 * e + 1] = bfhi(b[e]); } }
    }
    __syncthreads();
    const int hq = kh * 8 + 4 * hf + (wid >> 1), qh = wid & 1;
    const float sink = sinks[hq];
#pragma unroll 1
    for (int qq = 0; qq < 2; ++qq) {
        const int qi = 2 * qh + qq; const size_t tokq = (size_t)nb * 128 + 32 * qi + r;
        bf16x8 qf[4];
        {   const bf16_t* qp = Z + tokq * INW + hq * 64 + 8 * hh;
            u32x4 raw[4]; float ss = 0.f;
#pragma unroll
            for (int s = 0; s < 4; ++s) { raw[s] = *(const u32x4*)(qp + 16 * s);
#pragma unroll
                for (int e = 0; e < 4; ++e) { const float lo = bflo(raw[s][e]), hi = bfhi(raw[s][e]); ss += lo * lo + hi * hi; } }
            ss += __shfl_xor(ss, 32);
            const float rstd = rsqrtf(ss * (1.0f / 64.0f) + EPS) * 0.125f;
#pragma unroll
            for (int s = 0; s < 4; ++s) { const f32x4 g0 = *(const f32x4*)(gq + 16 * s + 8 * hh), g1 = *(const f32x4*)(gq + 16 * s + 8 * hh + 4); u32x4 w;
                w.x = pk2(bflo(raw[s].x) * rstd * g0[0], bfhi(raw[s].x) * rstd * g0[1]); w.y = pk2(bflo(raw[s].y) * rstd * g0[2], bfhi(raw[s].y) * rstd * g0[3]);
                w.z = pk2(bflo(raw[s].z) * rstd * g1[0], bfhi(raw[s].z) * rstd * g1[1]); w.w = pk2(bflo(raw[s].w) * rstd * g1[2], bfhi(raw[s].w) * rstd * g1[3]);
                qf[s] = __builtin_bit_cast(bf16x8, w); }
        }
        f32x16 X[5];
#pragma unroll
        for (int t = 0; t < 5; ++t) { X[t] = zero16();
#pragma unroll
            for (int s = 0; s < 4; ++s) { const bf16x8 A = *(const LAS bf16x8*)(Kn + (32 * (qi + t) + r) * 144 + (16 * s + 8 * hh) * 2); X[t] = MFMA32(A, qf[s], X[t]); } }
        const int ii = 32 * qi + r;
        float m = -1e30f;
#pragma unroll
        for (int t = 0; t < 5; ++t)
#pragma unroll
            for (int i = 0; i < 16; ++i) { const int jj = 32 * (qi + t) + crow(i, hh); const bool ok = (jj >= ii) && (jj <= ii + 128) && (nb > 0 || jj >= 128);
                X[t][i] = ok ? X[t][i] : -1e30f; m = fmaxf(m, X[t][i]); }
        m = fmaxf(m, __shfl_xor(m, 32)); m = fmaxf(m, sink);
        float sum = 0.f;
#pragma unroll
        for (int t = 0; t < 5; ++t)
#pragma unroll
            for (int i = 0; i < 16; ++i) { const float p = __expf(X[t][i] - m); X[t][i] = p; sum += p; }
        sum += __shfl_xor(sum, 32);
        const float inv = 1.0f / (sum + __expf(sink - m));
        f32x16 o[2]; o[0] = zero16(); o[1] = zero16();
#pragma unroll
        for (int t = 0; t < 5; ++t)
#pragma unroll
            for (int s2 = 0; s2 < 2; ++s2) { const bf16x8 xs = pack8(X[t], s2);
#pragma unroll
                for (int dt = 0; dt < 2; ++dt) { const LAS unsigned char* pa = Vt + (32 * dt + r) * 520 + (32 * (qi + t) + 16 * s2 + 4 * hh) * 2;
                    const bf16x8 A = cat4(*(const LAS s16x4*)pa, *(const LAS s16x4*)(pa + 16)); o[dt] = MFMA32(A, xs, o[dt]); } }
#pragma unroll
        for (int dt = 0; dt < 2; ++dt)
#pragma unroll
            for (int g4 = 0; g4 < 4; ++g4) { u32x2 w; w.x = pk2(o[dt][4 * g4] * inv, o[dt][4 * g4 + 1] * inv); w.y = pk2(o[dt][4 * g4 + 2] * inv, o[dt][4 * g4 + 3] * inv);
                *(u32x2*)(MIX + tokq * DM + hq * 64 + 32 * dt + 8 * g4 + 4 * hh) = w; }
    }
    __syncthreads();
}

DI void attn_decode_unit(LAS unsigned char* lds, const bf16_t* Z, const float* ck, const float* cv, bf16_t* MIX, const float* gq, const float* gk, const float* sinks, float* o_k, float* o_v, int b, int kh, int tid) {
    LAS float* Kc = (LAS float*)lds; LAS float* Vc = Kc + 129 * 65; LAS float* qs = Vc + 129 * 64; LAS float* pw = qs + 512;
    const int lane = tid & 63, wid = tid >> 6;
#pragma unroll
    for (int k = 0; k < 4; ++k) {
        const int it = k * 512 + tid, w = it >> 4, c4 = (it & 15) * 4;
        const size_t src = ((size_t)(b * 128 + w) * 2 + kh) * 64 + c4;
        const f32x4 k4 = *(const f32x4*)(ck + src), v4 = *(const f32x4*)(cv + src);
#pragma unroll
        for (int e = 0; e < 4; ++e) { Kc[w * 65 + c4 + e] = k4[e]; Vc[w * 64 + c4 + e] = v4[e]; }
        if (w >= 1) { const size_t dst = ((size_t)(b * 128 + w - 1) * 2 + kh) * 64 + c4; *(f32x4*)(o_k + dst) = k4; *(f32x4*)(o_v + dst) = v4; }
    }
    const bf16_t* zrow = Z + (size_t)(LP + b) * INW;
    const size_t dnew = ((size_t)(b * 128 + 127) * 2 + kh) * 64 + lane;
    if (wid == 0) { const float kx = bf2f(zrow[C_AK + kh * 64 + lane]); const float ss = wave_sum(kx * kx); const float kn = kx * rsqrtf(ss * (1.0f / 64.0f) + EPS) * gk[lane];
        Kc[128 * 65 + lane] = kn; o_k[dnew] = kn; }
    if (wid == 1) { const float vx = bf2f(zrow[C_AV + kh * 64 + lane]); Vc[128 * 64 + lane] = vx; o_v[dnew] = vx; }
    const int hq = kh * 8 + wid;
    { const float qx = bf2f(zrow[hq * 64 + lane]); const float ss = wave_sum(qx * qx); qs[wid * 64 + lane] = qx * rsqrtf(ss * (1.0f / 64.0f) + EPS) * gq[lane] * 0.125f; }
    __syncthreads();
    float s1 = 0.f, s2 = 0.f;
#pragma unroll 8
    for (int d = 0; d < 64; ++d) { const float q = qs[wid * 64 + d]; s1 += q * Kc[lane * 65 + d]; s2 += q * Kc[(lane + 64) * 65 + d]; }
    const float s3 = wave_sum(qs[wid * 64 + lane] * Kc[128 * 65 + lane]);
    const float sink = sinks[hq];
    const float m = fmaxf(wave_max(fmaxf(s1, s2)), fmaxf(s3, sink));
    const float p1 = __expf(s1 - m), p2 = __expf(s2 - m), p3 = __expf(s3 - m);
    const float denom = wave_sum(p1 + p2) + p3 + __expf(sink - m);
    pw[wid * 132 + lane] = p1; pw[wid * 132 + 64 + lane] = p2; if (lane == 0) pw[wid * 132 + 128] = p3;
    __syncthreads();
    float o = 0.f;
#pragma unroll 3
    for (int j = 0; j < 129; ++j) o += pw[wid * 132 + j] * Vc[j * 64 + lane];
    MIX[(size_t)(LP + b) * DM + hq * 64 + lane] = (bf16_t)(pk2(o / denom, 0.f) & 0xffffu);
    __syncthreads();
}

template <class Epi>
DI void skinny_unit(LAS unsigned char* lds, const bf16_t* A, const bf16_t* Wt, int K, int unit, const Epi& E, int tid) {
    const int lane = tid & 63, wid = tid >> 6, r = lane & 31, hh = lane >> 5;
    const int c0 = (unit >> 1) * 32, r0 = (unit & 1) * 64;
    const int kw = K >> 3;
    const bf16_t* pa = A + (size_t)(r0 + r) * K + wid * kw + 8 * hh;
    const bf16_t* pb = Wt + (size_t)(c0 + r) * K + wid * kw + 8 * hh;
    const size_t a1o = (size_t)32 * K;
    f32x16 acc0 = zero16(), acc1 = zero16();
    bf16x8 b[4], a0[4], a1[4];
#pragma unroll
    for (int s = 0; s < 4; ++s) { b[s] = *(const bf16x8*)(pb + 16 * s); a0[s] = *(const bf16x8*)(pa + 16 * s); a1[s] = *(const bf16x8*)(pa + a1o + 16 * s); }
    for (int k = 64; k < kw; k += 64) {
        bf16x8 nb[4], na0[4], na1[4];
#pragma unroll
        for (int s = 0; s < 4; ++s) { nb[s] = *(const bf16x8*)(pb + k + 16 * s); na0[s] = *(const bf16x8*)(pa + k + 16 * s); na1[s] = *(const bf16x8*)(pa + a1o + k + 16 * s); }
#pragma unroll
        for (int s = 0; s < 4; ++s) { acc0 = MFMA32(a0[s], b[s], acc0); acc1 = MFMA32(a1[s], b[s], acc1); }
#pragma unroll
        for (int s = 0; s < 4; ++s) { b[s] = nb[s]; a0[s] = na0[s]; a1[s] = na1[s]; }
    }
#pragma unroll
    for (int s = 0; s < 4; ++s) { acc0 = MFMA32(a0[s], b[s], acc0); acc1 = MFMA32(a1[s], b[s], acc1); }
    LAS float* red = (LAS float*)lds;
#pragma unroll
    for (int i = 0; i < 16; ++i) { red[(wid * 64 + crow(i, hh)) * 32 + r] = acc0[i]; red[(wid * 64 + 32 + crow(i, hh)) * 32 + r] = acc1[i]; }
    __syncthreads();
    const int row = tid >> 3, c4 = (tid & 7) * 4;
    f32x4 s = {0.f, 0.f, 0.f, 0.f};
#pragma unroll
    for (int w = 0; w < 8; ++w) s += *(const LAS f32x4*)(red + (w * 64 + row) * 32 + c4);
    E(r0 + row, c0 + c4, s);
    __syncthreads();
}
struct SkOut { const float* xs; float* X1s; bf16_t* XGs; const float* g2;
    DI void operator()(int row, int col, f32x4 a) const { const f32x4 v = a + *(const f32x4*)(xs + (size_t)row * DM + col); *(f32x4*)(X1s + (size_t)row * DM + col) = v;
        const f32x4 g = *(const f32x4*)(g2 + col); u32x2 o; o.x = pk2(v[0] * g[0], v[1] * g[1]); o.y = pk2(v[2] * g[2], v[3] * g[3]); *(u32x2*)(XGs + (size_t)row * DM + col) = o; } };
struct SkUp { bf16_t* Us;
    DI void operator()(int row, int col, f32x4 a) const {
#pragma unroll
        for (int e = 0; e < 4; ++e) { a[e] = fmaxf(a[e], 0.f); a[e] *= a[e]; }
        u32x2 o; o.x = pk2(a[0], a[1]); o.y = pk2(a[2], a[3]); *(u32x2*)(Us + (size_t)row * FF + col) = o; } };
struct SkDown { float* Ys; const float* r2s;
    DI void operator()(int row, int col, f32x4 a) const { float* p = Ys + (size_t)row * DM + col; *(f32x4*)p = *(const f32x4*)p + a * r2s[row]; } };

#define RLX_AGENT __ATOMIC_RELAXED, __HIP_MEMORY_SCOPE_AGENT
#define XB_TMO      128
#define XB_XCNT(j)  (256  + 64 * (j))
#define XB_XSUB(j)  (1280 + 64 * (j))
#define XB_XGEN(j)  (2304 + 64 * (j))
#define XB_TOP      3328
#define XB_TOPGEN   3392
#define XCD_BAR_WORDS 3456
#define XB_SPIN_CAP (1u << 18)

__device__ __forceinline__ unsigned xb_ld(unsigned* p)              { return __hip_atomic_load(p, __ATOMIC_RELAXED, __HIP_MEMORY_SCOPE_AGENT); }
__device__ __forceinline__ unsigned xb_add(unsigned* p, unsigned v) { return __hip_atomic_fetch_add(p, v, __ATOMIC_RELAXED, __HIP_MEMORY_SCOPE_AGENT); }
__device__ __forceinline__ unsigned xb_xcc_id() { return (unsigned)__builtin_amdgcn_s_getreg((3 << 11) | 20) & 0xFu; }
#define XB_SPIN(cond, bar) do { unsigned _sp = 0; while (cond) { __builtin_amdgcn_s_sleep(1); \
    if ((++_sp & 255u) == 0u) { if (xb_ld(&(bar)[XB_TMO])) break; if (_sp > XB_SPIN_CAP) { atomicAdd(&(bar)[XB_TMO], 1u); break; } } } } while (0)

struct XcdBarrier {
    unsigned* bar; unsigned x;
    volatile LAS unsigned* st;
};

__device__ __forceinline__ XcdBarrier xcd_barrier_post(unsigned* bar, volatile LAS unsigned* st) {
    XcdBarrier b; b.bar = bar; b.x = xb_xcc_id(); b.st = st;
    if (threadIdx.x == 0) (void)xb_add(&bar[XB_XCNT(b.x)], 1u);
    return b;
}
__device__ __forceinline__ void xcd_barrier_complete(unsigned* bar, unsigned x, unsigned& nloc, unsigned& nx) {
    const unsigned G = gridDim.x * gridDim.y * gridDim.z;
    unsigned sum, cnt, mine, sp = 0u;
    for (;;) {
        sum = 0u; cnt = 0u; mine = 0u;
#pragma unroll
        for (unsigned j = 0; j < 16; ++j) { const unsigned c = xb_ld(&bar[XB_XCNT(j)]); sum += c; cnt += (c > 0u) ? 1u : 0u; mine = (j == x) ? c : mine; }
        if (sum == G) break;
        __builtin_amdgcn_s_sleep(1);
        if ((++sp & 255u) == 0u) { if (xb_ld(&bar[XB_TMO])) break; if (sp > XB_SPIN_CAP) { atomicAdd(&bar[XB_TMO], 1u); break; } }
    }
    nloc = mine > 0u ? mine : 1u; nx = cnt > 0u ? cnt : 1u;
}

__device__ __forceinline__ void xcd_barrier(const XcdBarrier& b) {
    asm volatile("s_waitcnt vmcnt(0)" ::: "memory");
    __syncthreads();
    if (threadIdx.x == 0) {
        unsigned* bar = b.bar;
        __builtin_amdgcn_s_waitcnt(0);
        unsigned nloc = b.st[0], nx = b.st[1];
        if (nloc == 0u) { xcd_barrier_complete(bar, b.x, nloc, nx); b.st[0] = nloc; b.st[1] = nx; }
        const unsigned old = xb_add(&bar[XB_XSUB(b.x)], 1u);
        const unsigned gen = old / nloc;
        if (old + 1u == (gen + 1u) * nloc) {
            __builtin_amdgcn_fence(__ATOMIC_RELEASE, "agent");
            asm volatile("s_waitcnt vmcnt(0)" ::: "memory");
            const unsigned og = xb_add(&bar[XB_TOP], 1u);
            const unsigned tg = og / nx;
            if (og + 1u == (tg + 1u) * nx) xb_add(&bar[XB_TOPGEN], 1u);
            else XB_SPIN(xb_ld(&bar[XB_TOPGEN]) == tg, bar);
            __builtin_amdgcn_fence(__ATOMIC_ACQUIRE, "agent");
            xb_add(&bar[XB_XGEN(b.x)], 1u);
            asm volatile("s_waitcnt vmcnt(0)" ::: "memory");
        } else {
            XB_SPIN(xb_ld(&bar[XB_XGEN(b.x)]) == gen, bar);
            __builtin_amdgcn_fence(__ATOMIC_ACQUIRE, "agent");
            asm volatile("s_waitcnt vmcnt(0)" ::: "memory");
        }
    }
    __syncthreads();
}

struct Args { const float* in[15]; float* out; unsigned char* ws; int ph_lo, ph_hi; };
constexpr int NPH = 8;

__global__ void __launch_bounds__(512, 2) fwd_kernel(Args a) {
    extern __shared__ __attribute__((aligned(16))) unsigned char lds_raw[];
    LAS unsigned char* lds = (LAS unsigned char*)lds_raw;
    cg::grid_group grid = cg::this_grid();
    const int tid = threadIdx.x, lane = tid & 63, wid = __builtin_amdgcn_readfirstlane(tid >> 6);
    const int G = gridDim.x, bx = blockIdx.x;
    unsigned char* ws = a.ws; float* out = a.out;
    const float* x_p = a.in[0]; const float* x_s = a.in[1]; const float* cache_k = a.in[2]; const float* cache_v = a.in[3]; const float* state0 = a.in[4];
    const float* ln1_g = a.in[5]; const float* w_in = a.in[6]; const float* gq = a.in[7]; const float* gk = a.in[8]; const float* sinks = a.in[9];
    const float* rng = a.in[10]; const float* w_out = a.in[11]; const float* ln2_g = a.in[12]; const float* w_up = a.in[13]; const float* w_dn = a.in[14];
    bf16_t* WIN = (bf16_t*)(ws + WS_WIN); bf16_t* WOUT = (bf16_t*)(ws + WS_WOUT); bf16_t* WUP = (bf16_t*)(ws + WS_WUP); bf16_t* WDN = (bf16_t*)(ws + WS_WDN);
    bf16_t* H1 = (bf16_t*)(ws + WS_H1); bf16_t* XG = H1; bf16_t* MIX = (bf16_t*)(ws + WS_MIX); bf16_t* Z = (bf16_t*)(ws + WS_Z); bf16_t* U = (bf16_t*)(ws + WS_U);
    float* PART = (float*)(ws + WS_PART); float* RSTD2 = (float*)(ws + WS_RSTD2); float* KV = (float*)(ws + WS_KV); bf16_t* SP = (bf16_t*)(ws + WS_SP);
    const int lo = a.ph_lo, hi = a.ph_hi;
#define IN(k) (lo <= (k) && (k) < hi)
    volatile LAS unsigned* MISC = (volatile LAS unsigned*)(lds + LDS_BYTES - 64);
    if (tid < 16) MISC[tid] = 0u;
    __syncthreads();
    const XcdBarrier bar = xcd_barrier_post((unsigned*)ws + 1024, MISC + 8);
    if (lo > hi) grid.sync();
#define SEAM(k) do { if (IN(k) && IN((k) + 1)) xcd_barrier(bar); } while (0)

    if (IN(0)) for (int rep_ = 0; rep_ < 1 + ((DUPMASK >> 0) & 1); ++rep_) { if (rep_) xcd_barrier(bar);
        LAS float* scr = (LAS float*)(lds + wid * 16384);
        const int gw = bx * 8 + wid, NGW = G * 8;
        constexpr int I_IN = (DM / 64) * (INW / 32), I_OUT = (DM / 64) * (DM / 32), I_UP = (DM / 64) * (FF / 32), I_DN = (FF / 64) * (DM / 32);
        for (int it = gw; it < I_IN + I_OUT + I_UP + I_DN; it += NGW) {
            int r = it;
            if (r < I_IN) { p0_transpose_item(w_in, DM, INW, WIN, scr, r, lane); continue; } r -= I_IN;
            if (r < I_OUT) { p0_transpose_item(w_out, DM, DM, WOUT, scr, r, lane); continue; } r -= I_OUT;
            if (r < I_UP) { p0_transpose_item(w_up, DM, FF, WUP, scr, r, lane); continue; } r -= I_UP;
            p0_transpose_item(w_dn, FF, DM, WDN, scr, r, lane);
        }
        for (int m = gw; m < MP; m += NGW) {
            if (m < MR) rms_row(m < LP ? x_p + (size_t)m * DM : x_s + (size_t)(m - LP) * DM, ln1_g, H1 + (size_t)m * DM, lane);
            else {
#pragma unroll
                for (int j = 0; j < 8; ++j) *((u32x2*)(H1 + (size_t)m * DM) + lane + 64 * j) = (u32x2){0u, 0u};
            }
        }
    }
    SEAM(0);
    if (IN(1)) for (int rep_ = 0; rep_ < 1 + ((DUPMASK >> 1) & 1); ++rep_) { if (rep_) xcd_barrier(bar);
        pg8::Gemm g{H1, WIN, MP, INW, DM}; pg8::StaticOrder S; S.init(MP, INW, G, bx);
        pg8::EpiIn E{Z};
        pg8::gemm_phase<pg8::EpiIn, pg8::StaticOrder, true, true>(lds, g, S, E);
    }
    SEAM(1);
    if (IN(2)) for (int rep_ = 0; rep_ < 1 + ((DUPMASK >> 2) & 1); ++rep_) { if (rep_) xcd_barrier(bar);
        for (int u = bx; u < 256; u += G) ret_step1(lds, Z, KV, u >> 2, u & 3, tid);
        for (int u = bx; u < 256; u += G) attn_prompt_unit(lds, Z, MIX, gq, gk, sinks, out + O_KP, out + O_VP, u >> 2, (u >> 1) & 1, u & 1, tid);
        for (int u = bx; u < 256; u += G) attn_decode_unit(lds, Z, cache_k, cache_v, MIX, gq, gk, sinks, out + O_KS, out + O_VS, u >> 1, u & 1, tid);
    }
    SEAM(2);
    if (IN(3)) for (int rep_ = 0; rep_ < 1 + ((DUPMASK >> 3) & 1); ++rep_) { if (rep_) xcd_barrier(bar);
        ret_scan(KV, SP, out + O_SP, bx * 512 + tid, G * 512);
        if (G == 256) {
            if (bx < 128) ret_decode_unit(lds, Z, state0, out + O_SS, MIX, rng, bx >> 2, bx & 3, tid);
            else for (int j = 0; j < 3; ++j) { const int u = 128 + 3 * (bx - 128) + j; ret_decode_unit(lds, Z, state0, out + O_SS, MIX, rng, u >> 2, u & 3, tid); }
        } else for (int u = bx; u < 512; u += G) ret_decode_unit(lds, Z, state0, out + O_SS, MIX, rng, u >> 2, u & 3, tid);
    }
    SEAM(3);
    if (IN(4)) for (int rep_ = 0; rep_ < 1 + ((DUPMASK >> 4) & 1); ++rep_) { if (rep_) xcd_barrier(bar);
        for (int u = bx; u < 256; u += G) ret_step2(lds, Z, SP, MIX, rng, u >> 2, u & 3, tid);
    }
    SEAM(4);
    if (IN(5)) for (int rep_ = 0; rep_ < 1 + ((DUPMASK >> 5) & 1); ++rep_) { if (rep_) xcd_barrier(bar);
        pg8::Gemm g{MIX, WOUT, LP, DM, DM}; pg8::StaticOrder S; S.init(LP, DM, G, bx);
        pg8::EpiOut E{x_p, x_s, out + O_Y, XG, ln2_g, PART};
        pg8::gemm_phase<pg8::EpiOut, pg8::StaticOrder, true, true>(lds, g, S, E);
        const SkOut SE{x_s, out + O_Y + (size_t)LP * DM, XG + (size_t)LP * DM, ln2_g};
        for (int u = G - 1 - bx; u < 2 * (DM / 32); u += G) skinny_unit(lds, MIX + (size_t)LP * DM, WOUT, DM, u, SE, tid);
    }
    SEAM(5);
    if (IN(6)) for (int rep_ = 0; rep_ < 1 + ((DUPMASK >> 6) & 1); ++rep_) { if (rep_) xcd_barrier(bar);
        for (int row = bx + G * tid; row < LP; row += G * 512) { float s = 0.f;
#pragma unroll
            for (int j = 0; j < 8; ++j) { const f32x4 p = *(const f32x4*)(PART + (size_t)row * 32 + 4 * j); s += (p[0] + p[1]) + (p[2] + p[3]); }
            RSTD2[row] = 1.0f / (s * (1.0f / DM) + EPS); }
        for (int row = LP + bx * 8 + wid; row < MR; row += G * 8) {
            const float* xr = out + O_Y + (size_t)row * DM; float s = 0.f;
#pragma unroll
            for (int j = 0; j < 8; ++j) { const f32x4 v = *((const f32x4*)xr + lane + 64 * j); s += (v[0] * v[0] + v[1] * v[1]) + (v[2] * v[2] + v[3] * v[3]); }
            s = wave_sum(s); if (lane == 0) RSTD2[row] = 1.0f / (s * (1.0f / DM) + EPS); }
        pg8::Gemm g{XG, WUP, LP, FF, DM}; pg8::StaticOrder S; S.init(LP, FF, G, bx);
        pg8::EpiUp E{U};
        pg8::gemm_phase<pg8::EpiUp, pg8::StaticOrder, true, true>(lds, g, S, E);
        const SkUp SE{U + (size_t)LP * FF};
        for (int u = bx; u < 2 * (FF / 32); u += G) skinny_unit(lds, XG + (size_t)LP * DM, WUP, DM, u, SE, tid);
    }
    SEAM(6);
    if (IN(7)) {
        pg8::Gemm g{U, WDN, LP, DM, FF}; pg8::StaticOrder S; S.init(LP, DM, G, bx);
        pg8::EpiDown E{out + O_Y, RSTD2};
        pg8::gemm_phase<pg8::EpiDown, pg8::StaticOrder, true, true>(lds, g, S, E);
        const SkDown SE{out + O_Y + (size_t)LP * DM, RSTD2 + LP};
        for (int u = G - 1 - bx; u < 2 * (DM / 32); u += G) skinny_unit(lds, U + (size_t)LP * FF, WDN, FF, u, SE, tid);
    }
#undef IN
#undef SEAM
}

#ifndef N_LAUNCHES
#define N_LAUNCHES 1
#endif
extern "C" void kernel_launch(void* const* d_in, const int* in_sizes, int n_in, void* d_out, int out_size, void* d_ws, size_t ws_size, hipStream_t stream) {
    static int grid = 0;
    if (grid == 0) {
        if (n_in != 15 || (size_t)out_size != O_END || ws_size < WS_END) { fprintf(stderr, "kernel_launch: unexpected shapes (n_in %d out %d ws %zu)\n", n_in, out_size, ws_size); grid = -1; return; }
        int dev = 0, cus = 0, per_cu = 0;
        (void)hipGetDevice(&dev); (void)hipDeviceGetAttribute(&cus, hipDeviceAttributeMultiprocessorCount, dev);
        if (hipFuncSetAttribute((const void*)fwd_kernel, hipFuncAttributeMaxDynamicSharedMemorySize, LDS_BYTES) != hipSuccess) { fprintf(stderr, "kernel_launch: hipFuncSetAttribute failed\n"); grid = -1; return; }
        (void)hipOccupancyMaxActiveBlocksPerMultiprocessor(&per_cu, (const void*)fwd_kernel, 512, LDS_BYTES);
        (void)hipGetLastError();
        if (per_cu < 1) { fprintf(stderr, "kernel_launch: occupancy query says %d blocks per CU\n", per_cu); }
        grid = cus > 0 ? cus : 256;
    }
    if (grid < 0) return;
    if (hipMemsetAsync(d_ws, 0, 65536, stream) != hipSuccess) { fprintf(stderr, "kernel_launch: memset failed\n"); return; }
    Args a{};
    for (int i = 0; i < 15; ++i) a.in[i] = (const float*)d_in[i];
    a.out = (float*)d_out; a.ws = (unsigned char*)d_ws;
    if (N_LAUNCHES == 1) {
        a.ph_lo = 0; a.ph_hi = NPH;
        void* args[] = {&a};
        hipError_t e = hipLaunchCooperativeKernel((const void*)fwd_kernel, dim3(grid), dim3(512), args, LDS_BYTES, stream);
        if (e != hipSuccess) fprintf(stderr, "cooperative launch failed: %s (grid %d)\n", hipGetErrorString(e), grid);
    } else {
        for (int p = 0; p < NPH; ++p) { a.ph_lo = p; a.ph_hi = p + 1; hipLaunchKernelGGL(fwd_kernel, dim3(grid), dim3(512), LDS_BYTES, stream, a); }
    }
}
```

```cpp
#include <hip/hip_runtime.h>
#include <hip/hip_cooperative_groups.h>
#include <cstdio>
#include <cstdint>
namespace cg = cooperative_groups;

#ifndef DUPMASK
#define DUPMASK 0
#endif
#define DI __device__ __forceinline__
#define LAS __attribute__((address_space(3)))
typedef float f32x2 __attribute__((ext_vector_type(2)));
typedef float f32x16 __attribute__((ext_vector_type(16)));
typedef short s16x4 __attribute__((ext_vector_type(4)));
typedef unsigned u32x2 __attribute__((ext_vector_type(2)));
typedef __bf16 bf16x2v __attribute__((ext_vector_type(2)));

constexpr int DM = 2048, LP = 8192, NS = 128, MR = LP + NS  , MP = 8448  ;
constexpr int INW = 5376, FF = 8192;
constexpr int C_AQ = 0, C_AK = 1024, C_AV = 1152, C_RQ = 1280, C_RK = 2304, C_RV = 3328, C_RG = 4352;
constexpr float EPS = 1e-6f;

DI unsigned pk2(float lo, float hi) { f32x2 v = {lo, hi}; return __builtin_bit_cast(unsigned, __builtin_convertvector(v, bf16x2v)); }
DI float bflo(unsigned u) { return __uint_as_float(u << 16); }
DI float bfhi(unsigned u) { return __uint_as_float(u & 0xffff0000u); }
DI float bf2f(unsigned short u) { return __uint_as_float(((unsigned)u) << 16); }

namespace pg8 {
#define PG8_LAS __attribute__((address_space(3)))
typedef unsigned short bf16_t;
typedef short bf16x8 __attribute__((ext_vector_type(8)));
typedef float f32x4 __attribute__((ext_vector_type(4)));
typedef unsigned u32x4 __attribute__((ext_vector_type(4)));
constexpr int BM = 256, BK = 64, HALF = 128, HTB = HALF * BK * 2  , STAGE_BYTES = 8 * HTB, NXCD = 8, WGM = 8;

__host__ __device__ __forceinline__ int lds_byte(int r, int c) { const int st = (r >> 4) * 2 + (c >> 5), rr = r & 15, cc = c & 31, ob = rr * 64 + cc * 2; return st * 1024 + (ob ^ (((ob >> 9) & 1) << 5)); }
__host__ __device__ __forceinline__ void stage_rc(int b, int& R, int& C) { const int st = b / 1024, sb = b % 1024, swz = sb ^ (((sb >> 9) & 1) << 5); R = (st >> 1) * 16 + swz / 64; C = (st & 1) * 32 + (swz % 64) / 2; }
__host__ __device__ __forceinline__ int perm32(int rho) { const int n = rho >> 4, i = rho & 15; return 8 * (i >> 2) + 4 * n + (i & 3); }

struct Unit { int pm, pn; };
struct Gemm { const bf16_t* A; const bf16_t* Bt; int M, N, K; };

struct StaticOrder {
    int nM, nN, nwg, G, c;
    __host__ __device__ void init(int M, int N, int G_, int c_) { nM = M / BM; nN = N / BM; nwg = nM * nN; G = G_; c = c_; }
    __host__ __device__ bool next(int i, Unit& u) const {
        const long L = (long)i * G + c; if (L >= nwg) return false;
        int wgid = (int)L; { const int q = nwg / NXCD, r = nwg % NXCD, xcd = wgid % NXCD, off = wgid / NXCD; wgid = (xcd < r ? xcd * (q + 1) : r * (q + 1) + (xcd - r) * q) + off; }
        const int nig = WGM * nN, gid = wgid / nig, fm = gid * WGM, gsz = (nM - fm) < WGM ? (nM - fm) : WGM;
        u.pm = fm + ((wgid % nig) % gsz); u.pn = (wgid % nig) / gsz; return true;
    }
    __device__ __forceinline__ void a_ready(const Unit&) const {}
    __device__ __forceinline__ void done(const Unit&) const {}
};


DI u32x4 pack8f(const f32x4& a, const f32x4& b) { u32x4 w; w.x = pk2(a[0], a[1]); w.y = pk2(a[2], a[3]); w.z = pk2(b[0], b[1]); w.w = pk2(b[2], b[3]); return w; }

struct EpiIn {
    static constexpr bool PERM = true, AFTER_DRAIN = false;
    bf16_t* Z;
    __device__ __forceinline__ void operator()(const f32x4 (&acc)[2][2][4][2], const Unit& u, int wr, int wc, int fr, int fq) const {
        const int row0 = u.pm * BM + wr * 64 + fr, col0 = u.pn * BM + wc * 32 + 8 * fq;
        if (u.pn < 5 || u.pn > 12) {
#pragma unroll
            for (int ai = 0; ai < 2; ++ai)
#pragma unroll
                for (int m = 0; m < 4; ++m) { bf16_t* rowp = Z + (size_t)(row0 + ai * HALF + m * 16) * INW + col0;
#pragma unroll
                    for (int bj = 0; bj < 2; ++bj) *(u32x4*)(rowp + bj * HALF) = pack8f(acc[ai][bj][m][0], acc[ai][bj][m][1]); }
        } else {
            const int head = (u.pn - 5) & 3; const bool isk = u.pn >= 9;
            const float lg = log1pf(-exp2f(-5.0f - (float)head));
            float inv[8];
#pragma unroll
            for (int j = 0; j < 8; ++j) inv[j] = powf(10000.0f, -(float)(wc * 32 + 8 * fq + j) * (1.0f / 128.0f));
#pragma unroll
            for (int ai = 0; ai < 2; ++ai)
#pragma unroll
                for (int m = 0; m < 4; ++m) {
                    const int row = row0 + ai * HALF + m * 16;
                    const int pos = row < LP ? row : LP; const float t = row < LP ? (float)(row & 127) : 0.0f;
                    const float f = isk ? 0.0625f * __expf(-lg * t) : __expf(lg * t);
                    f32x4 o1[2], o2[2];
#pragma unroll
                    for (int n = 0; n < 2; ++n)
#pragma unroll
                        for (int e = 0; e < 4; ++e) {
                            const float ang = (float)pos * inv[n * 4 + e];
                            double rev = (double)ang * 0.15915494309189535; rev -= floor(rev);
                            const float fr_ = (float)rev; const float sn = __builtin_amdgcn_sinf(fr_), cs = __builtin_amdgcn_cosf(fr_);
                            const float x1 = acc[ai][0][m][n][e], x2 = acc[ai][1][m][n][e];
                            o1[n][e] = (x1 * cs - x2 * sn) * f; o2[n][e] = (x2 * cs + x1 * sn) * f;
                        }
                    bf16_t* rowp = Z + (size_t)row * INW + col0;
                    *(u32x4*)(rowp) = pack8f(o1[0], o1[1]); *(u32x4*)(rowp + HALF) = pack8f(o2[0], o2[1]);
                }
        }
    }
};

struct EpiOut {
    static constexpr bool PERM = true, AFTER_DRAIN = false;
    const float* xp; const float* xs; float* X1; bf16_t* XG; const float* g2; float* part;
    __device__ __forceinline__ void operator()(const f32x4 (&acc)[2][2][4][2], const Unit& u, int wr, int wc, int fr, int fq) const {
#pragma unroll
        for (int ai = 0; ai < 2; ++ai) {
            const int rbase = u.pm * BM + ai * HALF; const bool valid = rbase < MR;
#pragma unroll
            for (int m = 0; m < 4; ++m) {
                const int row = rbase + wr * 64 + m * 16 + fr;
                const float* xrow = row < LP ? xp + (size_t)row * DM : xs + (size_t)(row - LP) * DM;
                float ss = 0.f;
#pragma unroll
                for (int bj = 0; bj < 2; ++bj) {
                    const int col = u.pn * BM + bj * HALF + wc * 32 + 8 * fq;
                    f32x4 v0 = {0.f, 0.f, 0.f, 0.f}, v1 = {0.f, 0.f, 0.f, 0.f};
                    if (valid) { v0 = acc[ai][bj][m][0] + *(const f32x4*)(xrow + col); v1 = acc[ai][bj][m][1] + *(const f32x4*)(xrow + col + 4);
                        *(f32x4*)(X1 + (size_t)row * DM + col) = v0; *(f32x4*)(X1 + (size_t)row * DM + col + 4) = v1; }
                    ss += (v0[0] * v0[0] + v0[1] * v0[1]) + (v0[2] * v0[2] + v0[3] * v0[3]) + (v1[0] * v1[0] + v1[1] * v1[1]) + (v1[2] * v1[2] + v1[3] * v1[3]);
                    const f32x4 ga = *(const f32x4*)(g2 + col), gb = *(const f32x4*)(g2 + col + 4);
                    *(u32x4*)(XG + (size_t)row * DM + col) = pack8f(v0 * ga, v1 * gb);
                }
                ss += __shfl_xor(ss, 16); ss += __shfl_xor(ss, 32);
                if (fq == 0) part[(size_t)row * 32 + u.pn * 4 + wc] = ss;
            }
        }
    }
};

struct EpiUp {
    static constexpr bool PERM = true, AFTER_DRAIN = false;
    bf16_t* U;
    __device__ __forceinline__ void operator()(const f32x4 (&acc)[2][2][4][2], const Unit& u, int wr, int wc, int fr, int fq) const {
        const int row0 = u.pm * BM + wr * 64 + fr, col0 = u.pn * BM + wc * 32 + 8 * fq;
#pragma unroll
        for (int ai = 0; ai < 2; ++ai)
#pragma unroll
            for (int m = 0; m < 4; ++m) { bf16_t* rowp = U + (size_t)(row0 + ai * HALF + m * 16) * FF + col0;
#pragma unroll
                for (int bj = 0; bj < 2; ++bj) { f32x4 a = acc[ai][bj][m][0], b = acc[ai][bj][m][1];
#pragma unroll
                    for (int e = 0; e < 4; ++e) { a[e] = fmaxf(a[e], 0.f); a[e] *= a[e]; b[e] = fmaxf(b[e], 0.f); b[e] *= b[e]; }
                    *(u32x4*)(rowp + bj * HALF) = pack8f(a, b); } }
    }
};

struct EpiDown {
    static constexpr bool PERM = true, AFTER_DRAIN = false;
    float* Y; const float* rstd2;
    __device__ __forceinline__ void operator()(const f32x4 (&acc)[2][2][4][2], const Unit& u, int wr, int wc, int fr, int fq) const {
#pragma unroll
        for (int ai = 0; ai < 2; ++ai) {
            const int rbase = u.pm * BM + ai * HALF; if (rbase >= MR) continue;
#pragma unroll
            for (int m = 0; m < 4; ++m) {
                const int row = rbase + wr * 64 + m * 16 + fr; const float r2 = rstd2[row];
#pragma unroll
                for (int bj = 0; bj < 2; ++bj) { float* p = Y + (size_t)row * DM + u.pn * BM + bj * HALF + wc * 32 + 8 * fq;
                    const f32x4 a = *(const f32x4*)p, b = *(const f32x4*)(p + 4);
                    *(f32x4*)p = a + acc[ai][bj][m][0] * r2; *(f32x4*)(p + 4) = b + acc[ai][bj][m][1] * r2; }
            }
        }
    }
};
template <class Epi, class Sched, bool ALIGN_EPI = false, bool SP2 = false>
__device__ __forceinline__ void gemm_phase(PG8_LAS unsigned char* lds, const Gemm g, const Sched& S, const Epi& E) {
    const int tid = threadIdx.x, wid = __builtin_amdgcn_readfirstlane(tid >> 6), lane = tid & 63, wr = wid >> 2, wc = wid & 3, fr = lane & 15, fq = lane >> 4;
    const int K = g.K, nt = K / BK;
    unsigned voffA[2], voffB[2];
#pragma unroll
    for (int i = 0; i < 2; ++i) { int R, C; stage_rc(tid * 16 + i * 8192, R, C); const int Rb = Epi::PERM ? ((R & ~31) + perm32(R & 31)) : R;
        voffA[i] = (unsigned)(R * K + C) * 2u; voffB[i] = (unsigned)(Rb * K + C) * 2u; }
    const size_t kstep = (size_t)(BK * 2);
    const size_t hstep = (size_t)HALF * K * 2;
    const size_t tstep = 2 * hstep;
    const unsigned ldsw = (unsigned)wid * 1024u;
    const int aoff = lds_byte(wr * 64 + fr, fq * 8), boff = lds_byte(wc * 32 + fr, fq * 8);
#define PG8_SA(b, h) (((b) * 2 + (h)) * HTB)
#define PG8_SB(b, h) ((4 + (b) * 2 + (h)) * HTB)
#define PG8_STAGE(bufoff, gbase, voff) do { _Pragma("unroll") for (int _i = 0; _i < 2; ++_i) \
        __builtin_amdgcn_global_load_lds((const unsigned*)((const char*)(gbase) + (voff)[_i]), (PG8_LAS unsigned*)(lds + (bufoff) + ldsw + _i * 8192), 16, 0, 0); } while (0)
#define PG8_LDA(dst, b, h) do { _Pragma("unroll") for (int m = 0; m < 4; ++m) _Pragma("unroll") for (int k = 0; k < 2; ++k) dst[m][k] = *(const PG8_LAS bf16x8*)(lds + PG8_SA(b, h) + aoff + m * 2048 + k * 1024); } while (0)
#define PG8_LDB(dst, b, h) do { _Pragma("unroll") for (int n = 0; n < 2; ++n) _Pragma("unroll") for (int k = 0; k < 2; ++k) dst[n][k] = *(const PG8_LAS bf16x8*)(lds + PG8_SB(b, h) + boff + n * 2048 + k * 1024); } while (0)
#define PG8_MMA(ai, bj, At, Bt) do { __builtin_amdgcn_s_setprio(1); _Pragma("unroll") for (int m = 0; m < 4; ++m) _Pragma("unroll") for (int n = 0; n < 2; ++n) _Pragma("unroll") for (int k = 0; k < 2; ++k) \
        acc[ai][bj][m][n] = __builtin_amdgcn_mfma_f32_16x16x32_bf16(Bt[n][k], At[m][k], acc[ai][bj][m][n], 0, 0, 0); __builtin_amdgcn_s_setprio(0); } while (0)
#define PG8_WAIT_V(n) asm volatile("s_waitcnt vmcnt(" #n ")" ::: "memory")
#define PG8_WAIT_L(n) asm volatile("s_waitcnt lgkmcnt(" #n ")" ::: "memory")
#define PG8_BAR __builtin_amdgcn_s_barrier()
#define PG8_SCHED __builtin_amdgcn_sched_barrier(0)
    Unit cur, nxt; int ui = 0;
    if (!S.next(0, cur)) return;
    f32x4 acc[2][2][4][2];
#pragma unroll
    for (int a = 0; a < 2; ++a)
#pragma unroll
        for (int b = 0; b < 2; ++b)
#pragma unroll
            for (int m = 0; m < 4; ++m)
#pragma unroll
                for (int n = 0; n < 2; ++n) acc[a][b][m][n] = (f32x4){0.f, 0.f, 0.f, 0.f};
    bf16x8 At[4][2], B0[2][2], B1[2][2];
    const char* cA = (const char*)g.A + (size_t)cur.pm * tstep; const char* cB = (const char*)g.Bt + (size_t)cur.pn * tstep;
    S.a_ready(cur);
    if constexpr (SP2) {
        PG8_STAGE(PG8_SB(0, 0), cB, voffB); PG8_STAGE(PG8_SB(0, 1), cB + hstep, voffB); PG8_STAGE(PG8_SA(0, 0), cA, voffA); PG8_STAGE(PG8_SA(0, 1), cA + hstep, voffA);
        if (wr == 1) PG8_BAR;
        PG8_WAIT_V(2); PG8_BAR;
        PG8_STAGE(PG8_SB(1, 0), cB + kstep, voffB); PG8_STAGE(PG8_SA(1, 0), cA + kstep, voffA); PG8_STAGE(PG8_SB(1, 1), cB + hstep + kstep, voffB);
        PG8_WAIT_V(6); PG8_BAR;
    } else {
        PG8_STAGE(PG8_SB(0, 0), cB, voffB); PG8_STAGE(PG8_SA(0, 0), cA, voffA); PG8_STAGE(PG8_SB(0, 1), cB + hstep, voffB); PG8_STAGE(PG8_SA(0, 1), cA + hstep, voffA);
        if (wr == 1) PG8_BAR;
        PG8_WAIT_V(4); PG8_BAR;
        PG8_STAGE(PG8_SB(1, 0), cB + kstep, voffB); PG8_STAGE(PG8_SA(1, 0), cA + kstep, voffA); PG8_STAGE(PG8_SB(1, 1), cB + hstep + kstep, voffB);
        PG8_WAIT_V(6); PG8_BAR;
    }
    for (;;) {
        const bool has_next = S.next(ui + 1, nxt);
        const char* nA = has_next ? (const char*)g.A + (size_t)nxt.pm * tstep : cA; const char* nB = has_next ? (const char*)g.Bt + (size_t)nxt.pn * tstep : cB;
        for (int t = 0; t < nt; t += 2) {
            const bool last = (t == nt - 2);
            const char* a1 = cA + (size_t)(t + 1) * kstep;
            const char* a2 = last ? nA : cA + (size_t)(t + 2) * kstep; const char* b2 = last ? nB : cB + (size_t)(t + 2) * kstep;
            const char* a3 = a2 + kstep; const char* b3 = b2 + kstep;
            if (last && has_next) S.a_ready(nxt);
            if constexpr (SP2) {
            PG8_LDB(B0, 0, 0); PG8_LDB(B1, 0, 1); PG8_SCHED; PG8_LDA(At, 0, 0); PG8_STAGE(PG8_SA(1, 1), a1 + hstep, voffA);
            PG8_WAIT_V(8); PG8_WAIT_L(0); PG8_BAR; PG8_MMA(0, 0, At, B0); PG8_MMA(0, 1, At, B1); PG8_BAR; PG8_SCHED;
            PG8_LDA(At, 0, 1); PG8_STAGE(PG8_SB(0, 0), b2, voffB); PG8_STAGE(PG8_SB(0, 1), b2 + hstep, voffB); PG8_STAGE(PG8_SA(0, 0), a2, voffA);
            PG8_WAIT_V(8); PG8_WAIT_L(0); PG8_BAR; PG8_MMA(1, 0, At, B0); PG8_MMA(1, 1, At, B1); PG8_BAR; PG8_SCHED;
            PG8_LDB(B0, 1, 0); PG8_LDB(B1, 1, 1); PG8_SCHED; PG8_LDA(At, 1, 0); PG8_STAGE(PG8_SA(0, 1), a2 + hstep, voffA);
            PG8_WAIT_V(8); PG8_WAIT_L(0); PG8_BAR; PG8_MMA(0, 0, At, B0); PG8_MMA(0, 1, At, B1); PG8_BAR; PG8_SCHED;
            PG8_LDA(At, 1, 1); PG8_STAGE(PG8_SB(1, 0), b3, voffB); PG8_STAGE(PG8_SB(1, 1), b3 + hstep, voffB); PG8_STAGE(PG8_SA(1, 0), a3, voffA);
            PG8_WAIT_V(8); PG8_WAIT_L(0); PG8_BAR; PG8_MMA(1, 0, At, B0); PG8_MMA(1, 1, At, B1); PG8_BAR; PG8_SCHED;
            } else {
            PG8_LDB(B0, 0, 0); PG8_SCHED; PG8_LDA(At, 0, 0); PG8_STAGE(PG8_SA(1, 1), a1 + hstep, voffA);
            PG8_WAIT_L(8); PG8_BAR; PG8_WAIT_L(0); PG8_MMA(0, 0, At, B0); PG8_BAR; PG8_SCHED;
            PG8_LDB(B1, 0, 1); PG8_STAGE(PG8_SB(0, 0), b2, voffB);
            PG8_BAR; PG8_WAIT_L(0); PG8_MMA(0, 1, At, B1); PG8_BAR;
            PG8_LDA(At, 0, 1); PG8_STAGE(PG8_SA(0, 0), a2, voffA);
            PG8_BAR; PG8_WAIT_L(0); PG8_MMA(1, 0, At, B0); PG8_BAR; PG8_SCHED;
            PG8_STAGE(PG8_SB(0, 1), b2 + hstep, voffB);
            PG8_WAIT_V(6); PG8_BAR; PG8_MMA(1, 1, At, B1); PG8_BAR;
            PG8_LDB(B0, 1, 0); PG8_SCHED; PG8_LDA(At, 1, 0); PG8_STAGE(PG8_SA(0, 1), a2 + hstep, voffA);
            PG8_WAIT_L(8); PG8_BAR; PG8_WAIT_L(0); PG8_MMA(0, 0, At, B0); PG8_BAR; PG8_SCHED;
            PG8_LDB(B1, 1, 1); PG8_STAGE(PG8_SB(1, 0), b3, voffB);
            PG8_BAR; PG8_WAIT_L(0); PG8_MMA(0, 1, At, B1); PG8_BAR;
            PG8_LDA(At, 1, 1); PG8_STAGE(PG8_SA(1, 0), a3, voffA);
            PG8_BAR; PG8_WAIT_L(0); PG8_MMA(1, 0, At, B0); PG8_BAR; PG8_SCHED;
            PG8_STAGE(PG8_SB(1, 1), b3 + hstep, voffB);
            PG8_WAIT_V(6); PG8_BAR; PG8_MMA(1, 1, At, B1); PG8_BAR;
            }
        }
        if constexpr (ALIGN_EPI) { if (wr == 0) PG8_BAR; }
        if constexpr (!Epi::AFTER_DRAIN) { E(acc, cur, wr, wc, fr, fq); S.done(cur); }
        if (!has_next) break;
#pragma unroll
        for (int a = 0; a < 2; ++a)
#pragma unroll
            for (int b = 0; b < 2; ++b)
#pragma unroll
                for (int m = 0; m < 4; ++m)
#pragma unroll
                    for (int n = 0; n < 2; ++n) acc[a][b][m][n] = (f32x4){0.f, 0.f, 0.f, 0.f};
        cur = nxt; cA = nA; cB = nB; ++ui;
        if constexpr (ALIGN_EPI) { if (wr == 1) PG8_BAR; }
    }
    PG8_WAIT_V(0);
    if constexpr (!ALIGN_EPI) { if (wr == 0) PG8_BAR; }
    PG8_BAR;
    if constexpr (Epi::AFTER_DRAIN) { E.fused(acc, cur, wr, wc, fr, fq, lds, wid, lane); S.done(cur); }
#undef PG8_SA
#undef PG8_SB
#undef PG8_STAGE
#undef PG8_LDA
#undef PG8_LDB
#undef PG8_MMA
#undef PG8_WAIT_V
#undef PG8_WAIT_L
#undef PG8_BAR
#undef PG8_SCHED
}
}

using pg8::bf16_t; using pg8::bf16x8; using pg8::f32x4; using pg8::u32x4;
#define MFMA32(a, b, c) __builtin_amdgcn_mfma_f32_32x32x16_bf16((a), (b), (c), 0, 0, 0)
DI int crow(int reg, int h) { return (reg & 3) + 8 * (reg >> 2) + 4 * h; }
DI float wave_sum(float v) {
#pragma unroll
    for (int o = 1; o < 64; o <<= 1) v += __shfl_xor(v, o);
    return v;
}
DI float wave_max(float v) {
#pragma unroll
    for (int o = 1; o < 64; o <<= 1) v = fmaxf(v, __shfl_xor(v, o));
    return v;
}
DI bf16x8 pack8(const f32x16& x, int s) { u32x4 p; p.x = pk2(x[8 * s], x[8 * s + 1]); p.y = pk2(x[8 * s + 2], x[8 * s + 3]); p.z = pk2(x[8 * s + 4], x[8 * s + 5]); p.w = pk2(x[8 * s + 6], x[8 * s + 7]); return __builtin_bit_cast(bf16x8, p); }
DI bf16x8 cat4(s16x4 lo, s16x4 hi) { return __builtin_shufflevector(lo, hi, 0, 1, 2, 3, 4, 5, 6, 7); }
DI f32x16 zero16() { f32x16 z;
#pragma unroll
    for (int i = 0; i < 16; ++i) z[i] = 0.f;
    return z; }
DI float gamma_of(int h) { return 1.0f - exp2f(-5.0f - (float)h); }

constexpr size_t MiB = 1u << 20;
constexpr size_t WS_WIN = 1 * MiB;
constexpr size_t WS_WOUT = 23 * MiB;
constexpr size_t WS_WUP = 31 * MiB;
constexpr size_t WS_WDN = 63 * MiB;
constexpr size_t WS_H1 = 95 * MiB;
constexpr size_t WS_MIX = 128 * MiB;
constexpr size_t WS_PART = 161 * MiB;
constexpr size_t WS_RSTD2 = 163 * MiB;
constexpr size_t WS_Z = 164 * MiB;
constexpr size_t WS_KV = 252 * MiB;
constexpr size_t WS_SP = 316 * MiB;
constexpr size_t WS_U = 164 * MiB;
constexpr size_t WS_END = 348 * MiB;
static_assert(WS_Z + (size_t)MP * INW * 2 <= WS_KV && WS_U + (size_t)MP * FF * 2 <= WS_END && WS_H1 + (size_t)MP * DM * 2 <= WS_MIX && WS_MIX + (size_t)MP * DM * 2 <= WS_PART, "ws map");
constexpr int LDS_BYTES = 147456;

constexpr size_t O_Y = 0, O_KP = (size_t)MR * DM, O_VP = O_KP + 16384, O_SP = O_VP + 16384, O_KS = O_SP + 262144, O_VS = O_KS + 2097152, O_SS = O_VS + 2097152, O_END = O_SS + 33554432;

struct TItem { const float* W; bf16_t* WT; int K, N, item; };
DI void p0_load(const TItem& t, f32x4 (&v)[8], int lane) {
    const int nblk = t.N / 32, kb = t.item / nblk, nb = t.item % nblk, k0 = 64 * kb, n0 = 32 * nb, c = lane & 7, rr = lane >> 3;
#pragma unroll
    for (int i = 0; i < 8; ++i) v[i] = __builtin_nontemporal_load((const f32x4*)(t.W + (size_t)(k0 + 8 * i + rr) * t.N + n0 + 4 * c));
}
DI void p0_store(const TItem& t, const f32x4 (&v)[8], LAS float* scr, int lane) {
    const int nblk = t.N / 32, kb = t.item / nblk, nb = t.item % nblk, k0 = 64 * kb, n0 = 32 * nb, c = lane & 7, rr = lane >> 3;
#pragma unroll
    for (int i = 0; i < 8; ++i) { LAS float* d = scr + (8 * i + rr) * 33 + 4 * c; d[0] = v[i][0]; d[1] = v[i][1]; d[2] = v[i][2]; d[3] = v[i][3]; }
    asm volatile("s_waitcnt lgkmcnt(0)" ::: "memory");
#pragma unroll
    for (int j = 0; j < 4; ++j) { const int n = (lane >> 3) + 8 * j; const LAS float* s = scr + (8 * c) * 33 + n;
        u32x4 o; o.x = pk2(s[0 * 33], s[1 * 33]); o.y = pk2(s[2 * 33], s[3 * 33]); o.z = pk2(s[4 * 33], s[5 * 33]); o.w = pk2(s[6 * 33], s[7 * 33]);
        *(u32x4*)(t.WT + (size_t)(n0 + n) * t.K + k0 + 8 * c) = o; }
    asm volatile("s_waitcnt lgkmcnt(0)" ::: "memory");
}
struct ResIn { const float* w; bf16_t* wt; DI TItem operator()(int it) const { return TItem{w, wt, DM, INW, it}; } };
struct ResRest { const float* w_out; const float* w_up; const float* w_dn; bf16_t* WOUT; bf16_t* WUP; bf16_t* WDN;
    DI TItem operator()(int it) const { constexpr int I_OUT = (DM / 64) * (DM / 32), I_UP = (DM / 64) * (FF / 32); int r = it;
        if (r < I_OUT) return TItem{w_out, WOUT, DM, DM, r}; r -= I_OUT;
        if (r < I_UP) return TItem{w_up, WUP, DM, FF, r}; r -= I_UP;
        return TItem{w_dn, WDN, FF, DM, r}; } };
template <class Resolve>
DI void p0_convert(const Resolve R, int first, int stride, int total, LAS float* scr, int lane) {
    for (int it = first; it < total; it += 2 * stride) {
        const bool two = it + stride < total;
        const TItem t0 = R(it), t1 = R(two ? it + stride : it);
        f32x4 v0[8], v1[8];
        p0_load(t0, v0, lane);
        if (two) p0_load(t1, v1, lane);
        p0_store(t0, v0, scr, lane);
        if (two) p0_store(t1, v1, scr + 64 * 33, lane);
    }
}
DI void rms_row(const float* xrow, const float* g, bf16_t* orow, int lane) {
    f32x4 v[8]; float s = 0.f;
#pragma unroll
    for (int j = 0; j < 8; ++j) { v[j] = *((const f32x4*)xrow + lane + 64 * j); s += (v[j][0] * v[j][0] + v[j][1] * v[j][1]) + (v[j][2] * v[j][2] + v[j][3] * v[j][3]); }
    const float rstd = rsqrtf(wave_sum(s) * (1.0f / DM) + EPS);
#pragma unroll
    for (int j = 0; j < 8; ++j) { const f32x4 gg = *((const f32x4*)g + lane + 64 * j); u32x2 o; o.x = pk2(v[j][0] * rstd * gg[0], v[j][1] * rstd * gg[1]); o.y = pk2(v[j][2] * rstd * gg[2], v[j][3] * rstd * gg[3]);
        *((u32x2*)orow + lane + 64 * j) = o; }
}

DI void stage_T128x256(LAS unsigned char* img, const bf16_t* src, int tid) {
#pragma unroll
    for (int k = 0; k < 4; ++k) {
        const int it = k * 512 + tid, dgl = it & 3, tpl = (it >> 2) & 15, rest = it >> 6, dg = dgl + 4 * (rest & 7), tp = tpl + 16 * (rest >> 3);
        const bf16_t* p = src + (size_t)(2 * tp) * INW + dg * 8;
        const u32x4 a = *(const u32x4*)p, b = *(const u32x4*)(p + INW);
#pragma unroll
        for (int e = 0; e < 8; ++e) {
            const unsigned lo = (e & 1) ? (a[e >> 1] >> 16) : (a[e >> 1] & 0xffffu), hi = (e & 1) ? (b[e >> 1] & 0xffff0000u) : (b[e >> 1] << 16);
            *(LAS unsigned*)(img + (dg * 8 + e) * 264 + tp * 4) = lo | hi;
        }
    }
}

DI void ret_step1(LAS unsigned char* lds, const bf16_t* Z, float* KV, int n, int h, int tid) {
    LAS unsigned char* Kt = lds; LAS unsigned char* Vt = lds + 256 * 264;
    const int lane = tid & 63, wid = tid >> 6, r = lane & 31, hh = lane >> 5;
    stage_T128x256(Kt, Z + (size_t)(n * 128) * INW + C_RK + h * 256, tid);
    stage_T128x256(Vt, Z + (size_t)(n * 128) * INW + C_RV + h * 256, tid);
    __syncthreads();
    f32x16 acc[8];
#pragma unroll
    for (int i = 0; i < 8; ++i) acc[i] = zero16();
    const int dv0 = wid * 32;
#pragma unroll 2
    for (int s = 0; s < 8; ++s) {
        const LAS unsigned char* pa = Vt + (dv0 + r) * 264 + (16 * s + 8 * hh) * 2;
        const bf16x8 A = cat4(*(const LAS s16x4*)pa, *(const LAS s16x4*)(pa + 8));
#pragma unroll
        for (int dt = 0; dt < 8; ++dt) {
            const LAS unsigned char* pb = Kt + (dt * 32 + r) * 264 + (16 * s + 8 * hh) * 2;
            const bf16x8 B = cat4(*(const LAS s16x4*)pb, *(const LAS s16x4*)(pb + 8));
            acc[dt] = MFMA32(A, B, acc[dt]);
        }
    }
    float* out = KV + ((size_t)(n * 4 + h) * 256 + dv0) * 256;
#pragma unroll
    for (int dt = 0; dt < 8; ++dt)
#pragma unroll
        for (int i = 0; i < 16; ++i) out[(size_t)crow(i, hh) * 256 + dt * 32 + r] = acc[dt][i];
    __syncthreads();
}

DI void ret_scan(const float* KV, bf16_t* SP, float* o_state, int gt, int nthreads) {
    for (int e = gt; e < 65536; e += nthreads) {
        const int h = e >> 14, dv = (e >> 6) & 255, dk4 = (e & 63) * 4;
        const float lg = log1pf(-exp2f(-5.0f - (float)h)), Dc = __expf(128.0f * lg), c1 = __expf(127.0f * lg);
        const size_t base = ((size_t)(h * 256 + dv)) * 256 + dk4;
        f32x4 s = {0.f, 0.f, 0.f, 0.f};
        for (int n0 = 0; n0 < 64; n0 += 8) {
            f32x4 kv[8];
#pragma unroll
            for (int u = 0; u < 8; ++u) kv[u] = *(const f32x4*)(KV + (size_t)(n0 + u) * 262144 + base);
#pragma unroll
            for (int u = 0; u < 8; ++u) { u32x2 o; o.x = pk2(s[0], s[1]); o.y = pk2(s[2], s[3]); *(u32x2*)(SP + (size_t)(n0 + u) * 262144 + base) = o; s = s * Dc + kv[u] * c1; }
        }
#pragma unroll
        for (int j = 0; j < 4; ++j) o_state[((size_t)(h * 256 + dk4 + j)) * 256 + dv] = s[j];
    }
}

DI float silu_f(float x) { return x / (1.0f + __expf(-x)); }

DI void ret_step2(LAS unsigned char* lds, const bf16_t* Z, const bf16_t* SP, bf16_t* MIX, const float* rng, int n, int h, int tid) {
    LAS unsigned char* Kr = lds; LAS unsigned char* Vt = lds + 128 * 528; LAS float* red = (LAS float*)(lds + 128 * 528 + 256 * 264);
    const int lane = tid & 63, wid = tid >> 6, r = lane & 31, hh = lane >> 5;
    const bf16_t* zc = Z + (size_t)(n * 128) * INW;
#pragma unroll
    for (int k = 0; k < 8; ++k) { const int it = k * 512 + tid, row = it >> 5, c = it & 31;
        *(LAS u32x4*)(Kr + row * 528 + c * 16) = *(const u32x4*)(zc + (size_t)row * INW + C_RK + h * 256 + c * 8); }
    stage_T128x256(Vt, zc + C_RV + h * 256, tid);
    const int it_ = wid >> 1, dh = wid & 1;
    bf16x8 qf[16];
    { const bf16_t* qp = zc + (size_t)(32 * it_ + r) * INW + C_RQ + h * 256 + 8 * hh;
#pragma unroll
      for (int s = 0; s < 16; ++s) qf[s] = *(const bf16x8*)(qp + 16 * s); }
    f32x16 acc[4];
#pragma unroll
    for (int i = 0; i < 4; ++i) acc[i] = zero16();
    { const bf16_t* sp = SP + ((size_t)(n * 4 + h) * 256 + 128 * dh + r) * 256 + 8 * hh;
#pragma unroll
      for (int dt = 0; dt < 4; ++dt)
#pragma unroll
          for (int s = 0; s < 16; ++s) { const bf16x8 A = *(const bf16x8*)(sp + (size_t)dt * 32 * 256 + 16 * s); acc[dt] = MFMA32(A, qf[s], acc[dt]); } }
    const float gm = gamma_of(h);
#pragma unroll
    for (int dt = 0; dt < 4; ++dt) acc[dt] = acc[dt] * gm;
    __syncthreads();
    for (int jt = 0; jt <= it_; ++jt) {
        f32x16 X = zero16();
#pragma unroll
        for (int s = 0; s < 16; ++s) { const bf16x8 A = *(const LAS bf16x8*)(Kr + (32 * jt + r) * 528 + (16 * s + 8 * hh) * 2); X = MFMA32(A, qf[s], X); }
        if (jt == it_) {
#pragma unroll
            for (int i = 0; i < 16; ++i) X[i] = (crow(i, hh) > r) ? 0.f : X[i];
        }
#pragma unroll
        for (int s2 = 0; s2 < 2; ++s2) { const bf16x8 xs = pack8(X, s2);
#pragma unroll
            for (int dt = 0; dt < 4; ++dt) { const LAS unsigned char* pa = Vt + (128 * dh + 32 * dt + r) * 264 + (32 * jt + 16 * s2 + 4 * hh) * 2;
                const bf16x8 A = cat4(*(const LAS s16x4*)pa, *(const LAS s16x4*)(pa + 16)); acc[dt] = MFMA32(A, xs, acc[dt]); } }
    }
    float ss = 0.f;
#pragma unroll
    for (int dt = 0; dt < 4; ++dt)
#pragma unroll
        for (int i = 0; i < 16; ++i) ss += acc[dt][i] * acc[dt][i];
    ss += __shfl_xor(ss, 32);
    if (hh == 0) red[wid * 32 + r] = ss;
    __syncthreads();
    const float rstd = rsqrtf((red[wid * 32 + r] + red[(wid ^ 1) * 32 + r]) * (1.0f / 256.0f) + EPS);
    const size_t token = (size_t)n * 128 + 32 * it_ + r;
#pragma unroll
    for (int dt = 0; dt < 4; ++dt)
#pragma unroll
        for (int g4 = 0; g4 < 4; ++g4) {
            const int dv = 128 * dh + 32 * dt + 8 * g4 + 4 * hh;
            const u32x2 gz = *(const u32x2*)(Z + token * INW + C_RG + h * 256 + dv);
            const f32x4 gn = *(const f32x4*)(rng + h * 256 + dv);
            const float y0 = acc[dt][4 * g4 + 0] * rstd * gn[0] * silu_f(bflo(gz.x)), y1 = acc[dt][4 * g4 + 1] * rstd * gn[1] * silu_f(bfhi(gz.x));
            const float y2 = acc[dt][4 * g4 + 2] * rstd * gn[2] * silu_f(bflo(gz.y)), y3 = acc[dt][4 * g4 + 3] * rstd * gn[3] * silu_f(bfhi(gz.y));
            u32x2 o; o.x = pk2(y0, y1); o.y = pk2(y2, y3);
            *(u32x2*)(MIX + token * DM + 1024 + h * 256 + dv) = o;
        }
    __syncthreads();
}

DI void ret_decode_unit(LAS unsigned char* lds, const bf16_t* Z, const float* S0, float* S1, bf16_t* MIX, const float* rng, int b, int h, int tid) {
    LAS float* qv = (LAS float*)lds; LAS float* red = qv + 768;
    const int lane = tid & 63, wid = tid >> 6;
    const bf16_t* zrow = Z + (size_t)(LP + b) * INW;
    if (tid < 256) { qv[tid] = bf2f(zrow[C_RQ + h * 256 + tid]); qv[256 + tid] = bf2f(zrow[C_RK + h * 256 + tid]); qv[512 + tid] = bf2f(zrow[C_RV + h * 256 + tid]); }
    __syncthreads();
    const float gm = gamma_of(h);
    const f32x4 v4 = *(const LAS f32x4*)(qv + 512 + 4 * lane);
    f32x4 acc = {0.f, 0.f, 0.f, 0.f};
    const size_t off = ((size_t)(b * 4 + h) * 256 + wid * 32) * 256 + 4 * lane;
    const float* s0 = S0 + off; float* s1 = S1 + off;
#pragma unroll 1
    for (int rr = 0; rr < 32; rr += 8) {
        f32x4 s[8];
#pragma unroll
        for (int u = 0; u < 8; ++u) s[u] = __builtin_nontemporal_load((const f32x4*)(s0 + (size_t)(rr + u) * 256));
#pragma unroll
        for (int u = 0; u < 8; ++u) { const int dk = wid * 32 + rr + u; const float kk = qv[256 + dk], qq = qv[dk];
            const f32x4 sn = s[u] * gm + v4 * kk; __builtin_nontemporal_store(sn, (f32x4*)(s1 + (size_t)(rr + u) * 256)); acc += sn * qq; }
    }
    *(LAS f32x4*)(red + wid * 256 + 4 * lane) = acc;
    __syncthreads();
    if (wid == 0) {
        f32x4 o = {0.f, 0.f, 0.f, 0.f};
#pragma unroll
        for (int w = 0; w < 8; ++w) o += *(const LAS f32x4*)(red + w * 256 + 4 * lane);
        const float ssq = wave_sum((o[0] * o[0] + o[1] * o[1]) + (o[2] * o[2] + o[3] * o[3]));
        const float rstd = rsqrtf(ssq * (1.0f / 256.0f) + EPS);
        const u32x2 gz = *(const u32x2*)(zrow + C_RG + h * 256 + 4 * lane);
        const f32x4 gn = *(const f32x4*)(rng + h * 256 + 4 * lane);
        u32x2 y; y.x = pk2(o[0] * rstd * gn[0] * silu_f(bflo(gz.x)), o[1] * rstd * gn[1] * silu_f(bfhi(gz.x)));
        y.y = pk2(o[2] * rstd * gn[2] * silu_f(bflo(gz.y)), o[3] * rstd * gn[3] * silu_f(bfhi(gz.y)));
        *(u32x2*)(MIX + (size_t)(LP + b) * DM + 1024 + h * 256 + 4 * lane) = y;
    }
    __syncthreads();
}

DI void attn_prompt_unit(LAS unsigned char* lds, const bf16_t* Z, bf16_t* MIX, const float* gq, const float* gk, const float* sinks, float* o_k, float* o_v, int nb, int kh, int hf, int tid) {
    LAS unsigned char* Kn = lds; LAS unsigned char* Vt = lds + 256 * 144;
    const int lane = tid & 63, wid = tid >> 6, r = lane & 31, hh = lane >> 5;
    {
        const int row = tid >> 1, half = tid & 1; const int tok = (nb - 1) * 128 + row;
        u32x4 v[4];
#pragma unroll
        for (int c = 0; c < 4; ++c) v[c] = (u32x4){0u, 0u, 0u, 0u};
        if (tok >= 0) {
#pragma unroll
            for (int c = 0; c < 4; ++c) v[c] = *(const u32x4*)(Z + (size_t)tok * INW + C_AK + kh * 64 + half * 32 + c * 8);
        }
        float f[32]; float ss = 0.f;
#pragma unroll
        for (int c = 0; c < 4; ++c)
#pragma unroll
            for (int e = 0; e < 4; ++e) { f[c * 8 + 2 * e] = bflo(v[c][e]); f[c * 8 + 2 * e + 1] = bfhi(v[c][e]); }
#pragma unroll
        for (int e = 0; e < 32; ++e) ss += f[e] * f[e];
        ss += __shfl_xor(ss, 1);
        const float rstd = rsqrtf(ss * (1.0f / 64.0f) + EPS);
#pragma unroll
        for (int c = 0; c < 8; ++c) { const f32x4 g = *(const f32x4*)(gk + half * 32 + c * 4);
#pragma unroll
            for (int e = 0; e < 4; ++e) f[c * 4 + e] *= rstd * g[e]; }
#pragma unroll
        for (int c = 0; c < 4; ++c) { u32x4 w; w.x = pk2(f[c * 8], f[c * 8 + 1]); w.y = pk2(f[c * 8 + 2], f[c * 8 + 3]); w.z = pk2(f[c * 8 + 4], f[c * 8 + 5]); w.w = pk2(f[c * 8 + 6], f[c * 8 + 7]);
            *(LAS u32x4*)(Kn + row * 144 + half * 64 + c * 16) = w; }
        if (nb == 63 && hf == 0 && row >= 128) { float* o = o_k + ((size_t)(row - 128) * 2 + kh) * 64 + half * 32;
#pragma unroll
            for (int c = 0; c < 8; ++c) *(f32x4*)(o + c * 4) = (f32x4){f[c * 4], f[c * 4 + 1], f[c * 4 + 2], f[c * 4 + 3]}; }
    }
#pragma unroll
    for (int k = 0; k < 2; ++k) {
        const int it = k * 512 + tid, kpl = it & 15, dgl = (it >> 4) & 3, rest = it >> 6, dg = dgl + 4 * (rest & 1), kp = kpl + 16 * (rest >> 1);
        const int tok0 = (nb - 1) * 128 + 2 * kp;
        u32x4 a = {0u, 0u, 0u, 0u}, b = {0u, 0u, 0u, 0u};
        if (tok0 >= 0) { const bf16_t* p = Z + (size_t)tok0 * INW + C_AV + kh * 64 + dg * 8; a = *(const u32x4*)p; b = *(const u32x4*)(p + INW); }
#pragma unroll
        for (int e = 0; e < 8; ++e) {
            const unsigned lo = (e & 1) ? (a[e >> 1] >> 16) : (a[e >> 1] & 0xffffu), hi = (e & 1) ? (b[e >> 1] & 0xffff0000u) : (b[e >> 1] << 16);
            *(LAS unsigned*)(Vt + (dg * 8 + e) * 520 + kp * 4) = lo | hi;
        }
        if (nb == 63 && hf == 0 && kp >= 64) { float* o = o_v + ((size_t)(2 * kp - 128) * 2 + kh) * 64 + dg * 8;
#pragma unroll
            for (int e = 0; e < 4; ++e) { o[2 * e] = bflo(a[e]); o[2 * e + 1] = bfhi(a[e]); o[128 + 2 * e] = bflo(b[e]); o[128 + 2 * e + 1] = bfhi(b[e]); } }
    }
    __syncthreads();
    const int hq = kh * 8 + 4 * hf + (wid >> 1), qh = wid & 1;
    const float sink = sinks[hq];
#pragma unroll 1
    for (int qq = 0; qq < 2; ++qq) {
        const int qi = 2 * qh + qq; const size_t tokq = (size_t)nb * 128 + 32 * qi + r;
        bf16x8 qf[4];
        {   const bf16_t* qp = Z + tokq * INW + hq * 64 + 8 * hh;
            u32x4 raw[4]; float ss = 0.f;
#pragma unroll
            for (int s = 0; s < 4; ++s) { raw[s] = *(const u32x4*)(qp + 16 * s);
#pragma unroll
                for (int e = 0; e < 4; ++e) { const float lo = bflo(raw[s][e]), hi = bfhi(raw[s][e]); ss += lo * lo + hi * hi; } }
            ss += __shfl_xor(ss, 32);
            const float rstd = rsqrtf(ss * (1.0f / 64.0f) + EPS) * 0.125f;
#pragma unroll
            for (int s = 0; s < 4; ++s) { const f32x4 g0 = *(const f32x4*)(gq + 16 * s + 8 * hh), g1 = *(const f32x4*)(gq + 16 * s + 8 * hh + 4); u32x4 w;
                w.x = pk2(bflo(raw[s].x) * rstd * g0[0], bfhi(raw[s].x) * rstd * g0[1]); w.y = pk2(bflo(raw[s].y) * rstd * g0[2], bfhi(raw[s].y) * rstd * g0[3]);
                w.z = pk2(bflo(raw[s].z) * rstd * g1[0], bfhi(raw[s].z) * rstd * g1[1]); w.w = pk2(bflo(raw[s].w) * rstd * g1[2], bfhi(raw[s].w) * rstd * g1[3]);
                qf[s] = __builtin_bit_cast(bf16x8, w); }
        }
        f32x16 X[5];
#pragma unroll
        for (int t = 0; t < 5; ++t) { X[t] = zero16();
#pragma unroll
            for (int s = 0; s < 4; ++s) { const bf16x8 A = *(const LAS bf16x8*)(Kn + (32 * (qi + t) + r) * 144 + (16 * s + 8 * hh) * 2); X[t] = MFMA32(A, qf[s], X[t]); } }
        const int ii = 32 * qi + r;
        float m = -1e30f;
#pragma unroll
        for (int t = 0; t < 5; ++t)
#pragma unroll
            for (int i = 0; i < 16; ++i) { const int jj = 32 * (qi + t) + crow(i, hh); const bool ok = (jj >= ii) && (jj <= ii + 128) && (nb > 0 || jj >= 128);
                X[t][i] = ok ? X[t][i] : -1e30f; m = fmaxf(m, X[t][i]); }
        m = fmaxf(m, __shfl_xor(m, 32)); m = fmaxf(m, sink);
        float sum = 0.f;
#pragma unroll
        for (int t = 0; t < 5; ++t)
#pragma unroll
            for (int i = 0; i < 16; ++i) { const float p = __expf(X[t][i] - m); X[t][i] = p; sum += p; }
        sum += __shfl_xor(sum, 32);
        const float inv = 1.0f / (sum + __expf(sink - m));
        f32x16 o[2]; o[0] = zero16(); o[1] = zero16();
#pragma unroll
        for (int t = 0; t < 5; ++t)
#pragma unroll
            for (int s2 = 0; s2 < 2; ++s2) { const bf16x8 xs = pack8(X[t], s2);
#pragma unroll
                for (int dt = 0; dt < 2; ++dt) { const LAS unsigned char* pa = Vt + (32 * dt + r) * 520 + (32 * (qi + t) + 16 * s2 + 4 * hh) * 2;
                    const bf16x8 A = cat4(*(const LAS s16x4*)pa, *(const LAS s16x4*)(pa + 16)); o[dt] = MFMA32(A, xs, o[dt]); } }
#pragma unroll
        for (int dt = 0; dt < 2; ++dt)
#pragma unroll
            for (int g4 = 0; g4 < 4; ++g4) { u32x2 w; w.x = pk2(o[dt][4 * g4] * inv, o[dt][4 * g4 + 1] * inv); w.y = pk2(o[dt][4 * g4 + 2] * inv, o[dt][4 * g4 + 3] * inv);
                *(u32x2*)(MIX + tokq * DM + hq * 64 + 32 * dt + 8 * g4 + 4 * hh) = w; }
    }
    __syncthreads();
}

DI void attn_decode_unit(LAS unsigned char* lds, const bf16_t* Z, const float* ck, const float* cv, bf16_t* MIX, const float* gq, const float* gk, const float* sinks, float* o_k, float* o_v, int b, int kh, int tid) {
    LAS float* Kc = (LAS float*)lds; LAS float* Vc = Kc + 129 * 65; LAS float* qs = Vc + 129 * 64; LAS float* pw = qs + 512;
    const int lane = tid & 63, wid = tid >> 6;
#pragma unroll
    for (int k = 0; k < 4; ++k) {
        const int it = k * 512 + tid, w = it >> 4, c4 = (it & 15) * 4;
        const size_t src = ((size_t)(b * 128 + w) * 2 + kh) * 64 + c4;
        const f32x4 k4 = *(const f32x4*)(ck + src), v4 = *(const f32x4*)(cv + src);
#pragma unroll
        for (int e = 0; e < 4; ++e) { Kc[w * 65 + c4 + e] = k4[e]; Vc[w * 64 + c4 + e] = v4[e]; }
        if (w >= 1) { const size_t dst = ((size_t)(b * 128 + w - 1) * 2 + kh) * 64 + c4; *(f32x4*)(o_k + dst) = k4; *(f32x4*)(o_v + dst) = v4; }
    }
    const bf16_t* zrow = Z + (size_t)(LP + b) * INW;
    const size_t dnew = ((size_t)(b * 128 + 127) * 2 + kh) * 64 + lane;
    if (wid == 0) { const float kx = bf2f(zrow[C_AK + kh * 64 + lane]); const float ss = wave_sum(kx * kx); const float kn = kx * rsqrtf(ss * (1.0f / 64.0f) + EPS) * gk[lane];
        Kc[128 * 65 + lane] = kn; o_k[dnew] = kn; }
    if (wid == 1) { const float vx = bf2f(zrow[C_AV + kh * 64 + lane]); Vc[128 * 64 + lane] = vx; o_v[dnew] = vx; }
    const int hq = kh * 8 + wid;
    { const float qx = bf2f(zrow[hq * 64 + lane]); const float ss = wave_sum(qx * qx); qs[wid * 64 + lane] = qx * rsqrtf(ss * (1.0f / 64.0f) + EPS) * gq[lane] * 0.125f; }
    __syncthreads();
    float s1 = 0.f, s2 = 0.f;
#pragma unroll 8
    for (int d = 0; d < 64; ++d) { const float q = qs[wid * 64 + d]; s1 += q * Kc[lane * 65 + d]; s2 += q * Kc[(lane + 64) * 65 + d]; }
    const float s3 = wave_sum(qs[wid * 64 + lane] * Kc[128 * 65 + lane]);
    const float sink = sinks[hq];
    const float m = fmaxf(wave_max(fmaxf(s1, s2)), fmaxf(s3, sink));
    const float p1 = __expf(s1 - m), p2 = __expf(s2 - m), p3 = __expf(s3 - m);
    const float denom = wave_sum(p1 + p2) + p3 + __expf(sink - m);
    pw[wid * 132 + lane] = p1; pw[wid * 132 + 64 + lane] = p2; if (lane == 0) pw[wid * 132 + 128] = p3;
    __syncthreads();
    float o = 0.f;
#pragma unroll 3
    for (int j = 0; j < 129; ++j) o += pw[wid * 132 + j] * Vc[j * 64 + lane];
    MIX[(size_t)(LP + b) * DM + hq * 64 + lane] = (bf16_t)(pk2(o / denom, 0.f) & 0xffffu);
    __syncthreads();
}

template <class Epi>
DI void skinny_unit(LAS unsigned char* lds, const bf16_t* A, const bf16_t* Wt, int K, int unit, const Epi& E, int tid) {
    const int lane = tid & 63, wid = tid >> 6, r = lane & 31, hh = lane >> 5;
    const int c0 = (unit >> 1) * 32, r0 = (unit & 1) * 64;
    const int kw = K >> 3;
    const bf16_t* pa = A + (size_t)(r0 + r) * K + wid * kw + 8 * hh;
    const bf16_t* pb = Wt + (size_t)(c0 + r) * K + wid * kw + 8 * hh;
    const size_t a1o = (size_t)32 * K;
    f32x16 acc0 = zero16(), acc1 = zero16();
    bf16x8 b[4], a0[4], a1[4];
#pragma unroll
    for (int s = 0; s < 4; ++s) { b[s] = *(const bf16x8*)(pb + 16 * s); a0[s] = *(const bf16x8*)(pa + 16 * s); a1[s] = *(const bf16x8*)(pa + a1o + 16 * s); }
    for (int k = 64; k < kw; k += 64) {
        bf16x8 nb[4], na0[4], na1[4];
#pragma unroll
        for (int s = 0; s < 4; ++s) { nb[s] = *(const bf16x8*)(pb + k + 16 * s); na0[s] = *(const bf16x8*)(pa + k + 16 * s); na1[s] = *(const bf16x8*)(pa + a1o + k + 16 * s); }
#pragma unroll
        for (int s = 0; s < 4; ++s) { acc0 = MFMA32(a0[s], b[s], acc0); acc1 = MFMA32(a1[s], b[s], acc1); }
#pragma unroll
        for (int s = 0; s < 4; ++s) { b[s] = nb[s]; a0[s] = na0[s]; a1[s] = na1[s]; }
    }
#pragma unroll
    for (int s = 0; s < 4; ++s) { acc0 = MFMA32(a0[s], b[s], acc0); acc1 = MFMA32(a1[s], b[s], acc1); }
    LAS float* red = (LAS float*)lds;
#pragma unroll
    for (int i = 0; i < 16; ++i) { red[(wid * 64 + crow(i, hh)) * 32 + r] = acc0[i]; red[(wid * 64 + 32 + crow(i, hh)) * 32 + r] = acc1[i]; }
    __syncthreads();
    const int row = tid >> 3, c4 = (tid & 7) * 4;
    f32x4 s = {0.f, 0.f, 0.f, 0.f};
#pragma unroll
    for (int w = 0; w < 8; ++w) s += *(const LAS f32x4*)(red + (w * 64 + row) * 32 + c4);
    E(r0 + row, c0 + c4, s);
    __syncthreads();
}
struct SkOut { const float* xs; float* X1s; bf16_t* XGs; const float* g2;
    DI void operator()(int row, int col, f32x4 a) const { const f32x4 v = a + *(const f32x4*)(xs + (size_t)row * DM + col); *(f32x4*)(X1s + (size_t)row * DM + col) = v;
        const f32x4 g = *(const f32x4*)(g2 + col); u32x2 o; o.x = pk2(v[0] * g[0], v[1] * g[1]); o.y = pk2(v[2] * g[2], v[3] * g[3]); *(u32x2*)(XGs + (size_t)row * DM + col) = o; } };
struct SkUp { bf16_t* Us;
    DI void operator()(int row, int col, f32x4 a) const {
#pragma unroll
        for (int e = 0; e < 4; ++e) { a[e] = fmaxf(a[e], 0.f); a[e] *= a[e]; }
        u32x2 o; o.x = pk2(a[0], a[1]); o.y = pk2(a[2], a[3]); *(u32x2*)(Us + (size_t)row * FF + col) = o; } };
struct SkDown { float* Ys; const float* r2s;
    DI void operator()(int row, int col, f32x4 a) const { float* p = Ys + (size_t)row * DM + col; *(f32x4*)p = *(const f32x4*)p + a * r2s[row]; } };

#define RLX_AGENT __ATOMIC_RELAXED, __HIP_MEMORY_SCOPE_AGENT
#define XB_TMO      128
#define XB_XCNT(j)  (256  + 64 * (j))
#define XB_XSUB(j)  (1280 + 64 * (j))
#define XB_XGEN(j)  (2304 + 64 * (j))
#define XB_TOP      3328
#define XB_TOPGEN   3392
#define XCD_BAR_WORDS 3456
#define XB_SPIN_CAP (1u << 18)

__device__ __forceinline__ unsigned xb_ld(unsigned* p)              { return __hip_atomic_load(p, __ATOMIC_RELAXED, __HIP_MEMORY_SCOPE_AGENT); }
__device__ __forceinline__ unsigned xb_add(unsigned* p, unsigned v) { return __hip_atomic_fetch_add(p, v, __ATOMIC_RELAXED, __HIP_MEMORY_SCOPE_AGENT); }
__device__ __forceinline__ unsigned xb_xcc_id() { return (unsigned)__builtin_amdgcn_s_getreg((3 << 11) | 20) & 0xFu; }
#define XB_SPIN(cond, bar) do { unsigned _sp = 0; while (cond) { __builtin_amdgcn_s_sleep(1); \
    if ((++_sp & 255u) == 0u) { if (xb_ld(&(bar)[XB_TMO])) break; if (_sp > XB_SPIN_CAP) { atomicAdd(&(bar)[XB_TMO], 1u); break; } } } } while (0)

struct XcdBarrier {
    unsigned* bar; unsigned x;
    volatile LAS unsigned* st;
};

__device__ __forceinline__ XcdBarrier xcd_barrier_post(unsigned* bar, volatile LAS unsigned* st) {
    XcdBarrier b; b.bar = bar; b.x = xb_xcc_id(); b.st = st;
    if (threadIdx.x == 0) (void)xb_add(&bar[XB_XCNT(b.x)], 1u);
    return b;
}
__device__ __forceinline__ void xcd_barrier_complete(unsigned* bar, unsigned x, unsigned& nloc, unsigned& nx) {
    const unsigned G = gridDim.x * gridDim.y * gridDim.z;
    unsigned sum, cnt, mine, sp = 0u;
    for (;;) {
        sum = 0u; cnt = 0u; mine = 0u;
#pragma unroll
        for (unsigned j = 0; j < 16; ++j) { const unsigned c = xb_ld(&bar[XB_XCNT(j)]); sum += c; cnt += (c > 0u) ? 1u : 0u; mine = (j == x) ? c : mine; }
        if (sum == G) break;
        __builtin_amdgcn_s_sleep(1);
        if ((++sp & 255u) == 0u) { if (xb_ld(&bar[XB_TMO])) break; if (sp > XB_SPIN_CAP) { atomicAdd(&bar[XB_TMO], 1u); break; } }
    }
    nloc = mine > 0u ? mine : 1u; nx = cnt > 0u ? cnt : 1u;
}

__device__ __forceinline__ void xcd_barrier(const XcdBarrier& b) {
    asm volatile("s_waitcnt vmcnt(0)" ::: "memory");
    __syncthreads();
    if (threadIdx.x == 0) {
        unsigned* bar = b.bar;
        __builtin_amdgcn_s_waitcnt(0);
        unsigned nloc = b.st[0], nx = b.st[1];
        if (nloc == 0u) { xcd_barrier_complete(bar, b.x, nloc, nx); b.st[0] = nloc; b.st[1] = nx; }
        const unsigned old = xb_add(&bar[XB_XSUB(b.x)], 1u);
        const unsigned gen = old / nloc;
        if (old + 1u == (gen + 1u) * nloc) {
            __builtin_amdgcn_fence(__ATOMIC_RELEASE, "agent");
            asm volatile("s_waitcnt vmcnt(0)" ::: "memory");
            const unsigned og = xb_add(&bar[XB_TOP], 1u);
            const unsigned tg = og / nx;
            if (og + 1u == (tg + 1u) * nx) xb_add(&bar[XB_TOPGEN], 1u);
            else XB_SPIN(xb_ld(&bar[XB_TOPGEN]) == tg, bar);
            __builtin_amdgcn_fence(__ATOMIC_ACQUIRE, "agent");
            xb_add(&bar[XB_XGEN(b.x)], 1u);
            asm volatile("s_waitcnt vmcnt(0)" ::: "memory");
        } else {
            XB_SPIN(xb_ld(&bar[XB_XGEN(b.x)]) == gen, bar);
            __builtin_amdgcn_fence(__ATOMIC_ACQUIRE, "agent");
            asm volatile("s_waitcnt vmcnt(0)" ::: "memory");
        }
    }
    __syncthreads();
}

struct Args { const float* in[15]; float* out; unsigned char* ws; int ph_lo, ph_hi; };
constexpr int NPH = 8;

__global__ void __launch_bounds__(512, 2) fwd_kernel(Args a) {
    extern __shared__ __attribute__((aligned(16))) unsigned char lds_raw[];
    LAS unsigned char* lds = (LAS unsigned char*)lds_raw;
    cg::grid_group grid = cg::this_grid();
    const int tid = threadIdx.x, lane = tid & 63, wid = __builtin_amdgcn_readfirstlane(tid >> 6);
    const int G = gridDim.x, bx = blockIdx.x;
    unsigned char* ws = a.ws; float* out = a.out;
    const float* x_p = a.in[0]; const float* x_s = a.in[1]; const float* cache_k = a.in[2]; const float* cache_v = a.in[3]; const float* state0 = a.in[4];
    const float* ln1_g = a.in[5]; const float* w_in = a.in[6]; const float* gq = a.in[7]; const float* gk = a.in[8]; const float* sinks = a.in[9];
    const float* rng = a.in[10]; const float* w_out = a.in[11]; const float* ln2_g = a.in[12]; const float* w_up = a.in[13]; const float* w_dn = a.in[14];
    bf16_t* WIN = (bf16_t*)(ws + WS_WIN); bf16_t* WOUT = (bf16_t*)(ws + WS_WOUT); bf16_t* WUP = (bf16_t*)(ws + WS_WUP); bf16_t* WDN = (bf16_t*)(ws + WS_WDN);
    bf16_t* H1 = (bf16_t*)(ws + WS_H1); bf16_t* XG = H1; bf16_t* MIX = (bf16_t*)(ws + WS_MIX); bf16_t* Z = (bf16_t*)(ws + WS_Z); bf16_t* U = (bf16_t*)(ws + WS_U);
    float* PART = (float*)(ws + WS_PART); float* RSTD2 = (float*)(ws + WS_RSTD2); float* KV = (float*)(ws + WS_KV); bf16_t* SP = (bf16_t*)(ws + WS_SP);
    const int lo = a.ph_lo, hi = a.ph_hi;
#define IN(k) (lo <= (k) && (k) < hi)
    volatile LAS unsigned* MISC = (volatile LAS unsigned*)(lds + LDS_BYTES - 64);
    if (tid < 16) MISC[tid] = 0u;
    __syncthreads();
    const XcdBarrier bar = xcd_barrier_post((unsigned*)ws + 1024, MISC + 8);
    if (lo > hi) grid.sync();
#define SEAM(k) do { if (IN(k) && IN((k) + 1)) xcd_barrier(bar); } while (0)

    if (IN(0)) for (int rep_ = 0; rep_ < 1 + ((DUPMASK >> 0) & 1); ++rep_) { if (rep_) xcd_barrier(bar);
        LAS float* scr = (LAS float*)(lds + wid * 17408);
        const int gw = bx * 8 + wid, NGW = G * 8;
        constexpr int I_IN = (DM / 64) * (INW / 32);
        p0_convert(ResIn{w_in, WIN}, gw, NGW, I_IN, scr, lane);
        for (int m = gw; m < MP; m += NGW) {
            if (m < MR) rms_row(m < LP ? x_p + (size_t)m * DM : x_s + (size_t)(m - LP) * DM, ln1_g, H1 + (size_t)m * DM, lane);
            else {
#pragma unroll
                for (int j = 0; j < 8; ++j) *((u32x2*)(H1 + (size_t)m * DM) + lane + 64 * j) = (u32x2){0u, 0u};
            }
        }
    }
    SEAM(0);
    if (IN(1)) for (int rep_ = 0; rep_ < 1 + ((DUPMASK >> 1) & 1); ++rep_) { if (rep_) xcd_barrier(bar);
        pg8::Gemm g{H1, WIN, MP, INW, DM}; pg8::StaticOrder S; S.init(MP, INW, G, bx);
        pg8::EpiIn E{Z};
        pg8::gemm_phase<pg8::EpiIn, pg8::StaticOrder, true, true>(lds, g, S, E);
        {
            constexpr int NT = (MP / 256) * (INW / 256); const int rounds = (NT + G - 1) / G, first_idle = NT - (rounds - 1) * G;
            const int nidle = (first_idle < G) ? (G - first_idle) : G, me = (first_idle < G) ? (bx - first_idle) : bx;
            if (me >= 0) {
                LAS float* scr = (LAS float*)(lds + wid * 17408);
                constexpr int I_OUT = (DM / 64) * (DM / 32), I_UP = (DM / 64) * (FF / 32), I_DN = (FF / 64) * (DM / 32);
                p0_convert(ResRest{w_out, w_up, w_dn, WOUT, WUP, WDN}, me * 8 + wid, nidle * 8, I_OUT + I_UP + I_DN, scr, lane);
            }
        }
    }
    SEAM(1);
    if (IN(2)) for (int rep_ = 0; rep_ < 1 + ((DUPMASK >> 2) & 1); ++rep_) { if (rep_) xcd_barrier(bar);
        for (int u = bx; u < 256; u += G) ret_step1(lds, Z, KV, u >> 2, u & 3, tid);
        for (int u = bx; u < 256; u += G) attn_prompt_unit(lds, Z, MIX, gq, gk, sinks, out + O_KP, out + O_VP, u >> 2, (u >> 1) & 1, u & 1, tid);
        for (int u = bx; u < 256; u += G) attn_decode_unit(lds, Z, cache_k, cache_v, MIX, gq, gk, sinks, out + O_KS, out + O_VS, u >> 1, u & 1, tid);
    }
    SEAM(2);
    if (IN(3)) for (int rep_ = 0; rep_ < 1 + ((DUPMASK >> 3) & 1); ++rep_) { if (rep_) xcd_barrier(bar);
        ret_scan(KV, SP, out + O_SP, bx * 512 + tid, G * 512);
        if (G == 256) {
            if (bx < 128) ret_decode_unit(lds, Z, state0, out + O_SS, MIX, rng, bx >> 2, bx & 3, tid);
            else for (int j = 0; j < 3; ++j) { const int u = 128 + 3 * (bx - 128) + j; ret_decode_unit(lds, Z, state0, out + O_SS, MIX, rng, u >> 2, u & 3, tid); }
        } else for (int u = bx; u < 512; u += G) ret_decode_unit(lds, Z, state0, out + O_SS, MIX, rng, u >> 2, u & 3, tid);
    }
    SEAM(3);
    if (IN(4)) for (int rep_ = 0; rep_ < 1 + ((DUPMASK >> 4) & 1); ++rep_) { if (rep_) xcd_barrier(bar);
        for (int u = bx; u < 256; u += G) ret_step2(lds, Z, SP, MIX, rng, u >> 2, u & 3, tid);
    }
    SEAM(4);
    if (IN(5)) for (int rep_ = 0; rep_ < 1 + ((DUPMASK >> 5) & 1); ++rep_) { if (rep_) xcd_barrier(bar);
        pg8::Gemm g{MIX, WOUT, LP, DM, DM}; pg8::StaticOrder S; S.init(LP, DM, G, bx);
        pg8::EpiOut E{x_p, x_s, out + O_Y, XG, ln2_g, PART};
        pg8::gemm_phase<pg8::EpiOut, pg8::StaticOrder, true, true>(lds, g, S, E);
        const SkOut SE{x_s, out + O_Y + (size_t)LP * DM, XG + (size_t)LP * DM, ln2_g};
        for (int u = G - 1 - bx; u < 2 * (DM / 32); u += G) skinny_unit(lds, MIX + (size_t)LP * DM, WOUT, DM, u, SE, tid);
    }
    SEAM(5);
    if (IN(6)) for (int rep_ = 0; rep_ < 1 + ((DUPMASK >> 6) & 1); ++rep_) { if (rep_) xcd_barrier(bar);
        for (int row = bx + G * tid; row < LP; row += G * 512) { float s = 0.f;
#pragma unroll
            for (int j = 0; j < 8; ++j) { const f32x4 p = *(const f32x4*)(PART + (size_t)row * 32 + 4 * j); s += (p[0] + p[1]) + (p[2] + p[3]); }
            RSTD2[row] = 1.0f / (s * (1.0f / DM) + EPS); }
        for (int row = LP + bx * 8 + wid; row < MR; row += G * 8) {
            const float* xr = out + O_Y + (size_t)row * DM; float s = 0.f;
#pragma unroll
            for (int j = 0; j < 8; ++j) { const f32x4 v = *((const f32x4*)xr + lane + 64 * j); s += (v[0] * v[0] + v[1] * v[1]) + (v[2] * v[2] + v[3] * v[3]); }
            s = wave_sum(s); if (lane == 0) RSTD2[row] = 1.0f / (s * (1.0f / DM) + EPS); }
        pg8::Gemm g{XG, WUP, LP, FF, DM}; pg8::StaticOrder S; S.init(LP, FF, G, bx);
        pg8::EpiUp E{U};
        pg8::gemm_phase<pg8::EpiUp, pg8::StaticOrder, true, true>(lds, g, S, E);
        const SkUp SE{U + (size_t)LP * FF};
        for (int u = bx; u < 2 * (FF / 32); u += G) skinny_unit(lds, XG + (size_t)LP * DM, WUP, DM, u, SE, tid);
    }
    SEAM(6);
    if (IN(7)) {
        pg8::Gemm g{U, WDN, LP, DM, FF}; pg8::StaticOrder S; S.init(LP, DM, G, bx);
        pg8::EpiDown E{out + O_Y, RSTD2};
        pg8::gemm_phase<pg8::EpiDown, pg8::StaticOrder, true, true>(lds, g, S, E);
        const SkDown SE{out + O_Y + (size_t)LP * DM, RSTD2 + LP};
        for (int u = G - 1 - bx; u < 2 * (DM / 32); u += G) skinny_unit(lds, U + (size_t)LP * FF, WDN, FF, u, SE, tid);
    }
#undef IN
#undef SEAM
}

#ifndef N_LAUNCHES
#define N_LAUNCHES 1
#endif
extern "C" void kernel_launch(void* const* d_in, const int* in_sizes, int n_in, void* d_out, int out_size, void* d_ws, size_t ws_size, hipStream_t stream) {
    static int grid = 0;
    if (grid == 0) {
        if (n_in != 15 || (size_t)out_size != O_END || ws_size < WS_END) { fprintf(stderr, "kernel_launch: unexpected shapes (n_in %d out %d ws %zu)\n", n_in, out_size, ws_size); grid = -1; return; }
        int dev = 0, cus = 0, per_cu = 0;
        (void)hipGetDevice(&dev); (void)hipDeviceGetAttribute(&cus, hipDeviceAttributeMultiprocessorCount, dev);
        if (hipFuncSetAttribute((const void*)fwd_kernel, hipFuncAttributeMaxDynamicSharedMemorySize, LDS_BYTES) != hipSuccess) { fprintf(stderr, "kernel_launch: hipFuncSetAttribute failed\n"); grid = -1; return; }
        (void)hipOccupancyMaxActiveBlocksPerMultiprocessor(&per_cu, (const void*)fwd_kernel, 512, LDS_BYTES);
        (void)hipGetLastError();
        if (per_cu < 1) { fprintf(stderr, "kernel_launch: occupancy query says %d blocks per CU\n", per_cu); }
        grid = cus > 0 ? cus : 256;
    }
    if (grid < 0) return;
    if (hipMemsetAsync(d_ws, 0, 65536, stream) != hipSuccess) { fprintf(stderr, "kernel_launch: memset failed\n"); return; }
    Args a{};
    for (int i = 0; i < 15; ++i) a.in[i] = (const float*)d_in[i];
    a.out = (float*)d_out; a.ws = (unsigned char*)d_ws;
    if (N_LAUNCHES == 1) {
        a.ph_lo = 0; a.ph_hi = NPH;
        void* args[] = {&a};
        hipError_t e = hipLaunchCooperativeKernel((const void*)fwd_kernel, dim3(grid), dim3(512), args, LDS_BYTES, stream);
        if (e != hipSuccess) fprintf(stderr, "cooperative launch failed: %s (grid %d)\n", hipGetErrorString(e), grid);
    } else {
        for (int p = 0; p < NPH; ++p) { a.ph_lo = p; a.ph_hi = p + 1; hipLaunchKernelGGL(fwd_kernel, dim3(grid), dim3(512), LDS_BYTES, stream, a); }
    }
}
```

```cpp
#include <hip/hip_runtime.h>
#include <hip/hip_cooperative_groups.h>
#include <cstdio>
#include <cstdint>
namespace cg = cooperative_groups;

#ifndef DUPMASK
#define DUPMASK 0
#endif
#define DI __device__ __forceinline__
#define LAS __attribute__((address_space(3)))
typedef float f32x2 __attribute__((ext_vector_type(2)));
typedef float f32x16 __attribute__((ext_vector_type(16)));
typedef short s16x4 __attribute__((ext_vector_type(4)));
typedef unsigned u32x2 __attribute__((ext_vector_type(2)));
typedef __bf16 bf16x2v __attribute__((ext_vector_type(2)));

constexpr int DM = 2048, LP = 8192, NS = 128, MR = LP + NS  , MP = 8448  ;
constexpr int INW = 5376, FF = 8192;
constexpr int C_AQ = 0, C_AK = 1024, C_AV = 1152, C_RQ = 1280, C_RK = 2304, C_RV = 3328, C_RG = 4352;
constexpr float EPS = 1e-6f;

DI unsigned pk2(float lo, float hi) { f32x2 v = {lo, hi}; return __builtin_bit_cast(unsigned, __builtin_convertvector(v, bf16x2v)); }
DI float bflo(unsigned u) { return __uint_as_float(u << 16); }
DI float bfhi(unsigned u) { return __uint_as_float(u & 0xffff0000u); }
DI float bf2f(unsigned short u) { return __uint_as_float(((unsigned)u) << 16); }

namespace pg8 {
#define PG8_LAS __attribute__((address_space(3)))
typedef unsigned short bf16_t;
typedef short bf16x8 __attribute__((ext_vector_type(8)));
typedef float f32x4 __attribute__((ext_vector_type(4)));
typedef unsigned u32x4 __attribute__((ext_vector_type(4)));
constexpr int BM = 256, BK = 64, HALF = 128, HTB = HALF * BK * 2  , STAGE_BYTES = 8 * HTB, NXCD = 8, WGM = 8;

__host__ __device__ __forceinline__ int lds_byte(int r, int c) { const int st = (r >> 4) * 2 + (c >> 5), rr = r & 15, cc = c & 31, ob = rr * 64 + cc * 2; return st * 1024 + (ob ^ (((ob >> 9) & 1) << 5)); }
__host__ __device__ __forceinline__ void stage_rc(int b, int& R, int& C) { const int st = b / 1024, sb = b % 1024, swz = sb ^ (((sb >> 9) & 1) << 5); R = (st >> 1) * 16 + swz / 64; C = (st & 1) * 32 + (swz % 64) / 2; }
__host__ __device__ __forceinline__ int perm32(int rho) { const int n = rho >> 4, i = rho & 15; return 8 * (i >> 2) + 4 * n + (i & 3); }

struct Unit { int pm, pn; };
struct Gemm { const bf16_t* A; const bf16_t* Bt; int M, N, K; };

struct StaticOrder {
    int nM, nN, nwg, G, c;
    __host__ __device__ void init(int M, int N, int G_, int c_) { nM = M / BM; nN = N / BM; nwg = nM * nN; G = G_; c = c_; }
    __host__ __device__ bool next(int i, Unit& u) const {
        const long L = (long)i * G + c; if (L >= nwg) return false;
        int wgid = (int)L; { const int q = nwg / NXCD, r = nwg % NXCD, xcd = wgid % NXCD, off = wgid / NXCD; wgid = (xcd < r ? xcd * (q + 1) : r * (q + 1) + (xcd - r) * q) + off; }
        const int nig = WGM * nN, gid = wgid / nig, fm = gid * WGM, gsz = (nM - fm) < WGM ? (nM - fm) : WGM;
        u.pm = fm + ((wgid % nig) % gsz); u.pn = (wgid % nig) / gsz; return true;
    }
    __device__ __forceinline__ void a_ready(const Unit&) const {}
    __device__ __forceinline__ void done(const Unit&) const {}
};


DI u32x4 pack8f(const f32x4& a, const f32x4& b) { u32x4 w; w.x = pk2(a[0], a[1]); w.y = pk2(a[2], a[3]); w.z = pk2(b[0], b[1]); w.w = pk2(b[2], b[3]); return w; }

struct EpiIn {
    static constexpr bool PERM = true, AFTER_DRAIN = false;
    bf16_t* Z;
    __device__ __forceinline__ void operator()(const f32x4 (&acc)[2][2][4][2], const Unit& u, int wr, int wc, int fr, int fq) const {
        const int row0 = u.pm * BM + wr * 64 + fr, col0 = u.pn * BM + wc * 32 + 8 * fq;
        if (u.pn < 5 || u.pn > 12) {
#pragma unroll
            for (int ai = 0; ai < 2; ++ai)
#pragma unroll
                for (int m = 0; m < 4; ++m) { bf16_t* rowp = Z + (size_t)(row0 + ai * HALF + m * 16) * INW + col0;
#pragma unroll
                    for (int bj = 0; bj < 2; ++bj) *(u32x4*)(rowp + bj * HALF) = pack8f(acc[ai][bj][m][0], acc[ai][bj][m][1]); }
        } else {
            const int head = (u.pn - 5) & 3; const bool isk = u.pn >= 9;
            const float lg = log1pf(-exp2f(-5.0f - (float)head));
            float inv[8];
#pragma unroll
            for (int j = 0; j < 8; ++j) inv[j] = powf(10000.0f, -(float)(wc * 32 + 8 * fq + j) * (1.0f / 128.0f));
#pragma unroll
            for (int ai = 0; ai < 2; ++ai)
#pragma unroll
                for (int m = 0; m < 4; ++m) {
                    const int row = row0 + ai * HALF + m * 16;
                    const int pos = row < LP ? row : LP; const float t = row < LP ? (float)(row & 127) : 0.0f;
                    const float f = isk ? 0.0625f * __expf(-lg * t) : __expf(lg * t);
                    f32x4 o1[2], o2[2];
#pragma unroll
                    for (int n = 0; n < 2; ++n)
#pragma unroll
                        for (int e = 0; e < 4; ++e) {
                            const float ang = (float)pos * inv[n * 4 + e];
                            double rev = (double)ang * 0.15915494309189535; rev -= floor(rev);
                            const float fr_ = (float)rev; const float sn = __builtin_amdgcn_sinf(fr_), cs = __builtin_amdgcn_cosf(fr_);
                            const float x1 = acc[ai][0][m][n][e], x2 = acc[ai][1][m][n][e];
                            o1[n][e] = (x1 * cs - x2 * sn) * f; o2[n][e] = (x2 * cs + x1 * sn) * f;
                        }
                    bf16_t* rowp = Z + (size_t)row * INW + col0;
                    *(u32x4*)(rowp) = pack8f(o1[0], o1[1]); *(u32x4*)(rowp + HALF) = pack8f(o2[0], o2[1]);
                }
        }
    }
};

struct EpiOut {
    static constexpr bool PERM = true, AFTER_DRAIN = false;
    const float* xp; const float* xs; float* X1; bf16_t* XG; const float* g2; float* part;
    __device__ __forceinline__ void operator()(const f32x4 (&acc)[2][2][4][2], const Unit& u, int wr, int wc, int fr, int fq) const {
#pragma unroll
        for (int ai = 0; ai < 2; ++ai) {
            const int rbase = u.pm * BM + ai * HALF; const bool valid = rbase < MR;
#pragma unroll
            for (int m = 0; m < 4; ++m) {
                const int row = rbase + wr * 64 + m * 16 + fr;
                const float* xrow = row < LP ? xp + (size_t)row * DM : xs + (size_t)(row - LP) * DM;
                float ss = 0.f;
#pragma unroll
                for (int bj = 0; bj < 2; ++bj) {
                    const int col = u.pn * BM + bj * HALF + wc * 32 + 8 * fq;
                    f32x4 v0 = {0.f, 0.f, 0.f, 0.f}, v1 = {0.f, 0.f, 0.f, 0.f};
                    if (valid) { v0 = acc[ai][bj][m][0] + *(const f32x4*)(xrow + col); v1 = acc[ai][bj][m][1] + *(const f32x4*)(xrow + col + 4);
                        *(f32x4*)(X1 + (size_t)row * DM + col) = v0; *(f32x4*)(X1 + (size_t)row * DM + col + 4) = v1; }
                    ss += (v0[0] * v0[0] + v0[1] * v0[1]) + (v0[2] * v0[2] + v0[3] * v0[3]) + (v1[0] * v1[0] + v1[1] * v1[1]) + (v1[2] * v1[2] + v1[3] * v1[3]);
                    const f32x4 ga = *(const f32x4*)(g2 + col), gb = *(const f32x4*)(g2 + col + 4);
                    *(u32x4*)(XG + (size_t)row * DM + col) = pack8f(v0 * ga, v1 * gb);
                }
                ss += __shfl_xor(ss, 16); ss += __shfl_xor(ss, 32);
                if (fq == 0) part[(size_t)row * 32 + u.pn * 4 + wc] = ss;
            }
        }
    }
};

struct EpiUp {
    static constexpr bool PERM = true, AFTER_DRAIN = false;
    bf16_t* U;
    __device__ __forceinline__ void operator()(const f32x4 (&acc)[2][2][4][2], const Unit& u, int wr, int wc, int fr, int fq) const {
        const int row0 = u.pm * BM + wr * 64 + fr, col0 = u.pn * BM + wc * 32 + 8 * fq;
#pragma unroll
        for (int ai = 0; ai < 2; ++ai)
#pragma unroll
            for (int m = 0; m < 4; ++m) { bf16_t* rowp = U + (size_t)(row0 + ai * HALF + m * 16) * FF + col0;
#pragma unroll
                for (int bj = 0; bj < 2; ++bj) { f32x4 a = acc[ai][bj][m][0], b = acc[ai][bj][m][1];
#pragma unroll
                    for (int e = 0; e < 4; ++e) { a[e] = fmaxf(a[e], 0.f); a[e] *= a[e]; b[e] = fmaxf(b[e], 0.f); b[e] *= b[e]; }
                    *(u32x4*)(rowp + bj * HALF) = pack8f(a, b); } }
    }
};

struct EpiDown {
    static constexpr bool PERM = true, AFTER_DRAIN = false;
    float* Y; const float* rstd2;
    __device__ __forceinline__ void operator()(const f32x4 (&acc)[2][2][4][2], const Unit& u, int wr, int wc, int fr, int fq) const {
#pragma unroll
        for (int ai = 0; ai < 2; ++ai) {
            const int rbase = u.pm * BM + ai * HALF; if (rbase >= MR) continue;
#pragma unroll
            for (int m = 0; m < 4; ++m) {
                const int row = rbase + wr * 64 + m * 16 + fr; const float r2 = rstd2[row];
#pragma unroll
                for (int bj = 0; bj < 2; ++bj) { float* p = Y + (size_t)row * DM + u.pn * BM + bj * HALF + wc * 32 + 8 * fq;
                    const f32x4 a = *(const f32x4*)p, b = *(const f32x4*)(p + 4);
                    *(f32x4*)p = a + acc[ai][bj][m][0] * r2; *(f32x4*)(p + 4) = b + acc[ai][bj][m][1] * r2; }
            }
        }
    }
};
template <class Epi, class Sched, bool ALIGN_EPI = false, bool SP2 = false>
__device__ __forceinline__ void gemm_phase(PG8_LAS unsigned char* lds, const Gemm g, const Sched& S, const Epi& E) {
    const int tid = threadIdx.x, wid = __builtin_amdgcn_readfirstlane(tid >> 6), lane = tid & 63, wr = wid >> 2, wc = wid & 3, fr = lane & 15, fq = lane >> 4;
    const int K = g.K, nt = K / BK;
    unsigned voffA[2], voffB[2];
#pragma unroll
    for (int i = 0; i < 2; ++i) { int R, C; stage_rc(tid * 16 + i * 8192, R, C); const int Rb = Epi::PERM ? ((R & ~31) + perm32(R & 31)) : R;
        voffA[i] = (unsigned)(R * K + C) * 2u; voffB[i] = (unsigned)(Rb * K + C) * 2u; }
    const size_t kstep = (size_t)(BK * 2);
    const size_t hstep = (size_t)HALF * K * 2;
    const size_t tstep = 2 * hstep;
    const unsigned ldsw = (unsigned)wid * 1024u;
    const int aoff = lds_byte(wr * 64 + fr, fq * 8), boff = lds_byte(wc * 32 + fr, fq * 8);
#define PG8_SA(b, h) (((b) * 2 + (h)) * HTB)
#define PG8_SB(b, h) ((4 + (b) * 2 + (h)) * HTB)
#define PG8_STAGE(bufoff, gbase, voff) do { _Pragma("unroll") for (int _i = 0; _i < 2; ++_i) \
        __builtin_amdgcn_global_load_lds((const unsigned*)((const char*)(gbase) + (voff)[_i]), (PG8_LAS unsigned*)(lds + (bufoff) + ldsw + _i * 8192), 16, 0, 0); } while (0)
#define PG8_LDA(dst, b, h) do { _Pragma("unroll") for (int m = 0; m < 4; ++m) _Pragma("unroll") for (int k = 0; k < 2; ++k) dst[m][k] = *(const PG8_LAS bf16x8*)(lds + PG8_SA(b, h) + aoff + m * 2048 + k * 1024); } while (0)
#define PG8_LDB(dst, b, h) do { _Pragma("unroll") for (int n = 0; n < 2; ++n) _Pragma("unroll") for (int k = 0; k < 2; ++k) dst[n][k] = *(const PG8_LAS bf16x8*)(lds + PG8_SB(b, h) + boff + n * 2048 + k * 1024); } while (0)
#define PG8_MMA(ai, bj, At, Bt) do { __builtin_amdgcn_s_setprio(1); _Pragma("unroll") for (int m = 0; m < 4; ++m) _Pragma("unroll") for (int n = 0; n < 2; ++n) _Pragma("unroll") for (int k = 0; k < 2; ++k) \
        acc[ai][bj][m][n] = __builtin_amdgcn_mfma_f32_16x16x32_bf16(Bt[n][k], At[m][k], acc[ai][bj][m][n], 0, 0, 0); __builtin_amdgcn_s_setprio(0); } while (0)
#define PG8_WAIT_V(n) asm volatile("s_waitcnt vmcnt(" #n ")" ::: "memory")
#define PG8_WAIT_L(n) asm volatile("s_waitcnt lgkmcnt(" #n ")" ::: "memory")
#define PG8_BAR __builtin_amdgcn_s_barrier()
#define PG8_SCHED __builtin_amdgcn_sched_barrier(0)
    Unit cur, nxt; int ui = 0;
    if (!S.next(0, cur)) return;
    f32x4 acc[2][2][4][2];
#pragma unroll
    for (int a = 0; a < 2; ++a)
#pragma unroll
        for (int b = 0; b < 2; ++b)
#pragma unroll
            for (int m = 0; m < 4; ++m)
#pragma unroll
                for (int n = 0; n < 2; ++n) acc[a][b][m][n] = (f32x4){0.f, 0.f, 0.f, 0.f};
    bf16x8 At[4][2], B0[2][2], B1[2][2];
    const char* cA = (const char*)g.A + (size_t)cur.pm * tstep; const char* cB = (const char*)g.Bt + (size_t)cur.pn * tstep;
    S.a_ready(cur);
    if constexpr (SP2) {
        PG8_STAGE(PG8_SB(0, 0), cB, voffB); PG8_STAGE(PG8_SB(0, 1), cB + hstep, voffB); PG8_STAGE(PG8_SA(0, 0), cA, voffA); PG8_STAGE(PG8_SA(0, 1), cA + hstep, voffA);
        if (wr == 1) PG8_BAR;
        PG8_WAIT_V(2); PG8_BAR;
        PG8_STAGE(PG8_SB(1, 0), cB + kstep, voffB); PG8_STAGE(PG8_SA(1, 0), cA + kstep, voffA); PG8_STAGE(PG8_SB(1, 1), cB + hstep + kstep, voffB);
        PG8_WAIT_V(6); PG8_BAR;
    } else {
        PG8_STAGE(PG8_SB(0, 0), cB, voffB); PG8_STAGE(PG8_SA(0, 0), cA, voffA); PG8_STAGE(PG8_SB(0, 1), cB + hstep, voffB); PG8_STAGE(PG8_SA(0, 1), cA + hstep, voffA);
        if (wr == 1) PG8_BAR;
        PG8_WAIT_V(4); PG8_BAR;
        PG8_STAGE(PG8_SB(1, 0), cB + kstep, voffB); PG8_STAGE(PG8_SA(1, 0), cA + kstep, voffA); PG8_STAGE(PG8_SB(1, 1), cB + hstep + kstep, voffB);
        PG8_WAIT_V(6); PG8_BAR;
    }
    for (;;) {
        const bool has_next = S.next(ui + 1, nxt);
        const char* nA = has_next ? (const char*)g.A + (size_t)nxt.pm * tstep : cA; const char* nB = has_next ? (const char*)g.Bt + (size_t)nxt.pn * tstep : cB;
        for (int t = 0; t < nt; t += 2) {
            const bool last = (t == nt - 2);
            const char* a1 = cA + (size_t)(t + 1) * kstep;
            const char* a2 = last ? nA : cA + (size_t)(t + 2) * kstep; const char* b2 = last ? nB : cB + (size_t)(t + 2) * kstep;
            const char* a3 = a2 + kstep; const char* b3 = b2 + kstep;
            if (last && has_next) S.a_ready(nxt);
            if constexpr (SP2) {
            PG8_LDB(B0, 0, 0); PG8_LDB(B1, 0, 1); PG8_SCHED; PG8_LDA(At, 0, 0); PG8_STAGE(PG8_SA(1, 1), a1 + hstep, voffA);
            PG8_WAIT_V(8); PG8_WAIT_L(0); PG8_BAR; PG8_MMA(0, 0, At, B0); PG8_MMA(0, 1, At, B1); PG8_BAR; PG8_SCHED;
            PG8_LDA(At, 0, 1); PG8_STAGE(PG8_SB(0, 0), b2, voffB); PG8_STAGE(PG8_SB(0, 1), b2 + hstep, voffB); PG8_STAGE(PG8_SA(0, 0), a2, voffA);
            PG8_WAIT_V(8); PG8_WAIT_L(0); PG8_BAR; PG8_MMA(1, 0, At, B0); PG8_MMA(1, 1, At, B1); PG8_BAR; PG8_SCHED;
            PG8_LDB(B0, 1, 0); PG8_LDB(B1, 1, 1); PG8_SCHED; PG8_LDA(At, 1, 0); PG8_STAGE(PG8_SA(0, 1), a2 + hstep, voffA);
            PG8_WAIT_V(8); PG8_WAIT_L(0); PG8_BAR; PG8_MMA(0, 0, At, B0); PG8_MMA(0, 1, At, B1); PG8_BAR; PG8_SCHED;
            PG8_LDA(At, 1, 1); PG8_STAGE(PG8_SB(1, 0), b3, voffB); PG8_STAGE(PG8_SB(1, 1), b3 + hstep, voffB); PG8_STAGE(PG8_SA(1, 0), a3, voffA);
            PG8_WAIT_V(8); PG8_WAIT_L(0); PG8_BAR; PG8_MMA(1, 0, At, B0); PG8_MMA(1, 1, At, B1); PG8_BAR; PG8_SCHED;
            } else {
            PG8_LDB(B0, 0, 0); PG8_SCHED; PG8_LDA(At, 0, 0); PG8_STAGE(PG8_SA(1, 1), a1 + hstep, voffA);
            PG8_WAIT_L(8); PG8_BAR; PG8_WAIT_L(0); PG8_MMA(0, 0, At, B0); PG8_BAR; PG8_SCHED;
            PG8_LDB(B1, 0, 1); PG8_STAGE(PG8_SB(0, 0), b2, voffB);
            PG8_BAR; PG8_WAIT_L(0); PG8_MMA(0, 1, At, B1); PG8_BAR;
            PG8_LDA(At, 0, 1); PG8_STAGE(PG8_SA(0, 0), a2, voffA);
            PG8_BAR; PG8_WAIT_L(0); PG8_MMA(1, 0, At, B0); PG8_BAR; PG8_SCHED;
            PG8_STAGE(PG8_SB(0, 1), b2 + hstep, voffB);
            PG8_WAIT_V(6); PG8_BAR; PG8_MMA(1, 1, At, B1); PG8_BAR;
            PG8_LDB(B0, 1, 0); PG8_SCHED; PG8_LDA(At, 1, 0); PG8_STAGE(PG8_SA(0, 1), a2 + hstep, voffA);
            PG8_WAIT_L(8); PG8_BAR; PG8_WAIT_L(0); PG8_MMA(0, 0, At, B0); PG8_BAR; PG8_SCHED;
            PG8_LDB(B1, 1, 1); PG8_STAGE(PG8_SB(1, 0), b3, voffB);
            PG8_BAR; PG8_WAIT_L(0); PG8_MMA(0, 1, At, B1); PG8_BAR;
            PG8_LDA(At, 1, 1); PG8_STAGE(PG8_SA(1, 0), a3, voffA);
            PG8_BAR; PG8_WAIT_L(0); PG8_MMA(1, 0, At, B0); PG8_BAR; PG8_SCHED;
            PG8_STAGE(PG8_SB(1, 1), b3 + hstep, voffB);
            PG8_WAIT_V(6); PG8_BAR; PG8_MMA(1, 1, At, B1); PG8_BAR;
            }
        }
        if constexpr (ALIGN_EPI) { if (wr == 0) PG8_BAR; }
        if constexpr (!Epi::AFTER_DRAIN) { E(acc, cur, wr, wc, fr, fq); S.done(cur); }
        if (!has_next) break;
#pragma unroll
        for (int a = 0; a < 2; ++a)
#pragma unroll
            for (int b = 0; b < 2; ++b)
#pragma unroll
                for (int m = 0; m < 4; ++m)
#pragma unroll
                    for (int n = 0; n < 2; ++n) acc[a][b][m][n] = (f32x4){0.f, 0.f, 0.f, 0.f};
        cur = nxt; cA = nA; cB = nB; ++ui;
        if constexpr (ALIGN_EPI) { if (wr == 1) PG8_BAR; }
    }
    PG8_WAIT_V(0);
    if constexpr (!ALIGN_EPI) { if (wr == 0) PG8_BAR; }
    PG8_BAR;
    if constexpr (Epi::AFTER_DRAIN) { E.fused(acc, cur, wr, wc, fr, fq, lds, wid, lane); S.done(cur); }
#undef PG8_SA
#undef PG8_SB
#undef PG8_STAGE
#undef PG8_LDA
#undef PG8_LDB
#undef PG8_MMA
#undef PG8_WAIT_V
#undef PG8_WAIT_L
#undef PG8_BAR
#undef PG8_SCHED
}
}

using pg8::bf16_t; using pg8::bf16x8; using pg8::f32x4; using pg8::u32x4;
#define MFMA32(a, b, c) __builtin_amdgcn_mfma_f32_32x32x16_bf16((a), (b), (c), 0, 0, 0)
DI int crow(int reg, int h) { return (reg & 3) + 8 * (reg >> 2) + 4 * h; }
DI float wave_sum(float v) {
#pragma unroll
    for (int o = 1; o < 64; o <<= 1) v += __shfl_xor(v, o);
    return v;
}
DI float wave_max(float v) {
#pragma unroll
    for (int o = 1; o < 64; o <<= 1) v = fmaxf(v, __shfl_xor(v, o));
    return v;
}
DI bf16x8 pack8(const f32x16& x, int s) { u32x4 p; p.x = pk2(x[8 * s], x[8 * s + 1]); p.y = pk2(x[8 * s + 2], x[8 * s + 3]); p.z = pk2(x[8 * s + 4], x[8 * s + 5]); p.w = pk2(x[8 * s + 6], x[8 * s + 7]); return __builtin_bit_cast(bf16x8, p); }
DI bf16x8 cat4(s16x4 lo, s16x4 hi) { return __builtin_shufflevector(lo, hi, 0, 1, 2, 3, 4, 5, 6, 7); }
DI f32x16 zero16() { f32x16 z;
#pragma unroll
    for (int i = 0; i < 16; ++i) z[i] = 0.f;
    return z; }
DI float gamma_of(int h) { return 1.0f - exp2f(-5.0f - (float)h); }

constexpr size_t MiB = 1u << 20;
constexpr size_t WS_WIN = 1 * MiB;
constexpr size_t WS_WOUT = 23 * MiB;
constexpr size_t WS_WUP = 31 * MiB;
constexpr size_t WS_WDN = 63 * MiB;
constexpr size_t WS_H1 = 95 * MiB;
constexpr size_t WS_MIX = 128 * MiB;
constexpr size_t WS_PART = 161 * MiB;
constexpr size_t WS_RSTD2 = 163 * MiB;
constexpr size_t WS_Z = 164 * MiB;
constexpr size_t WS_KV = 252 * MiB;
constexpr size_t WS_SP = 316 * MiB;
constexpr size_t WS_U = 164 * MiB;
constexpr size_t WS_END = 348 * MiB;
static_assert(WS_Z + (size_t)MP * INW * 2 <= WS_KV && WS_U + (size_t)MP * FF * 2 <= WS_END && WS_H1 + (size_t)MP * DM * 2 <= WS_MIX && WS_MIX + (size_t)MP * DM * 2 <= WS_PART, "ws map");
constexpr int LDS_BYTES = 147456;

constexpr size_t O_Y = 0, O_KP = (size_t)MR * DM, O_VP = O_KP + 16384, O_SP = O_VP + 16384, O_KS = O_SP + 262144, O_VS = O_KS + 2097152, O_SS = O_VS + 2097152, O_END = O_SS + 33554432;

struct TItem { const float* W; bf16_t* WT; int K, N, item; };
DI void p0_load(const TItem& t, f32x4 (&v)[8], int lane) {
    const int nblk = t.N / 32, kb = t.item / nblk, nb = t.item % nblk, k0 = 64 * kb, n0 = 32 * nb, c = lane & 7, rr = lane >> 3;
#pragma unroll
    for (int i = 0; i < 8; ++i) v[i] = __builtin_nontemporal_load((const f32x4*)(t.W + (size_t)(k0 + 8 * i + rr) * t.N + n0 + 4 * c));
}
DI void p0_store(const TItem& t, const f32x4 (&v)[8], LAS float* scr, int lane) {
    const int nblk = t.N / 32, kb = t.item / nblk, nb = t.item % nblk, k0 = 64 * kb, n0 = 32 * nb, c = lane & 7, rr = lane >> 3;
#pragma unroll
    for (int i = 0; i < 8; ++i) { LAS float* d = scr + (8 * i + rr) * 33 + 4 * c; d[0] = v[i][0]; d[1] = v[i][1]; d[2] = v[i][2]; d[3] = v[i][3]; }
    asm volatile("s_waitcnt lgkmcnt(0)" ::: "memory");
#pragma unroll
    for (int j = 0; j < 4; ++j) { const int n = (lane >> 3) + 8 * j; const LAS float* s = scr + (8 * c) * 33 + n;
        u32x4 o; o.x = pk2(s[0 * 33], s[1 * 33]); o.y = pk2(s[2 * 33], s[3 * 33]); o.z = pk2(s[4 * 33], s[5 * 33]); o.w = pk2(s[6 * 33], s[7 * 33]);
        *(u32x4*)(t.WT + (size_t)(n0 + n) * t.K + k0 + 8 * c) = o; }
    asm volatile("s_waitcnt lgkmcnt(0)" ::: "memory");
}
struct ResIn { const float* w; bf16_t* wt; DI TItem operator()(int it) const { return TItem{w, wt, DM, INW, it}; } };
struct ResRest { const float* w_out; const float* w_up; const float* w_dn; bf16_t* WOUT; bf16_t* WUP; bf16_t* WDN;
    DI TItem operator()(int it) const { constexpr int I_OUT = (DM / 64) * (DM / 32), I_UP = (DM / 64) * (FF / 32); int r = it;
        if (r < I_OUT) return TItem{w_out, WOUT, DM, DM, r}; r -= I_OUT;
        if (r < I_UP) return TItem{w_up, WUP, DM, FF, r}; r -= I_UP;
        return TItem{w_dn, WDN, FF, DM, r}; } };
template <class Resolve>
DI void p0_convert(const Resolve R, int first, int stride, int total, LAS float* scr, int lane) {
    for (int it = first; it < total; it += 2 * stride) {
        const bool two = it + stride < total;
        const TItem t0 = R(it), t1 = R(two ? it + stride : it);
        f32x4 v0[8], v1[8];
        p0_load(t0, v0, lane);
        if (two) p0_load(t1, v1, lane);
        p0_store(t0, v0, scr, lane);
        if (two) p0_store(t1, v1, scr + 64 * 33, lane);
    }
}
DI void rms_row(const float* xrow, const float* g, bf16_t* orow, int lane) {
    f32x4 v[8]; float s = 0.f;
#pragma unroll
    for (int j = 0; j < 8; ++j) { v[j] = *((const f32x4*)xrow + lane + 64 * j); s += (v[j][0] * v[j][0] + v[j][1] * v[j][1]) + (v[j][2] * v[j][2] + v[j][3] * v[j][3]); }
    const float rstd = rsqrtf(wave_sum(s) * (1.0f / DM) + EPS);
#pragma unroll
    for (int j = 0; j < 8; ++j) { const f32x4 gg = *((const f32x4*)g + lane + 64 * j); u32x2 o; o.x = pk2(v[j][0] * rstd * gg[0], v[j][1] * rstd * gg[1]); o.y = pk2(v[j][2] * rstd * gg[2], v[j][3] * rstd * gg[3]);
        *((u32x2*)orow + lane + 64 * j) = o; }
}

DI void stage_T128x256(LAS unsigned char* img, const bf16_t* src, int tid) {
#pragma unroll
    for (int k = 0; k < 4; ++k) {
        const int it = k * 512 + tid, dgl = it & 3, tpl = (it >> 2) & 15, rest = it >> 6, dg = dgl + 4 * (rest & 7), tp = tpl + 16 * (rest >> 3);
        const bf16_t* p = src + (size_t)(2 * tp) * INW + dg * 8;
        const u32x4 a = *(const u32x4*)p, b = *(const u32x4*)(p + INW);
#pragma unroll
        for (int e = 0; e < 8; ++e) {
            const unsigned lo = (e & 1) ? (a[e >> 1] >> 16) : (a[e >> 1] & 0xffffu), hi = (e & 1) ? (b[e >> 1] & 0xffff0000u) : (b[e >> 1] << 16);
            *(LAS unsigned*)(img + (dg * 8 + e) * 264 + tp * 4) = lo | hi;
        }
    }
}

DI void ret_step1(LAS unsigned char* lds, const bf16_t* Z, float* KV, int n, int h, int tid) {
    LAS unsigned char* Kt = lds; LAS unsigned char* Vt = lds + 256 * 264;
    const int lane = tid & 63, wid = tid >> 6, r = lane & 31, hh = lane >> 5;
    stage_T128x256(Kt, Z + (size_t)(n * 128) * INW + C_RK + h * 256, tid);
    stage_T128x256(Vt, Z + (size_t)(n * 128) * INW + C_RV + h * 256, tid);
    __syncthreads();
    f32x16 acc[8];
#pragma unroll
    for (int i = 0; i < 8; ++i) acc[i] = zero16();
    const int dv0 = wid * 32;
#pragma unroll 2
    for (int s = 0; s < 8; ++s) {
        const LAS unsigned char* pa = Vt + (dv0 + r) * 264 + (16 * s + 8 * hh) * 2;
        const bf16x8 A = cat4(*(const LAS s16x4*)pa, *(const LAS s16x4*)(pa + 8));
#pragma unroll
        for (int dt = 0; dt < 8; ++dt) {
            const LAS unsigned char* pb = Kt + (dt * 32 + r) * 264 + (16 * s + 8 * hh) * 2;
            const bf16x8 B = cat4(*(const LAS s16x4*)pb, *(const LAS s16x4*)(pb + 8));
            acc[dt] = MFMA32(A, B, acc[dt]);
        }
    }
    float* out = KV + ((size_t)(n * 4 + h) * 256 + dv0) * 256;
#pragma unroll
    for (int dt = 0; dt < 8; ++dt)
#pragma unroll
        for (int i = 0; i < 16; ++i) out[(size_t)crow(i, hh) * 256 + dt * 32 + r] = acc[dt][i];
    __syncthreads();
}

DI void ret_scan(const float* KV, bf16_t* SP, float* o_state, int gt, int nthreads) {
    for (int e = gt; e < 65536; e += nthreads) {
        const int h = e >> 14, dv = (e >> 6) & 255, dk4 = (e & 63) * 4;
        const float lg = log1pf(-exp2f(-5.0f - (float)h)), Dc = __expf(128.0f * lg), c1 = __expf(127.0f * lg);
        const size_t base = ((size_t)(h * 256 + dv)) * 256 + dk4;
        f32x4 s = {0.f, 0.f, 0.f, 0.f};
        for (int n0 = 0; n0 < 64; n0 += 8) {
            f32x4 kv[8];
#pragma unroll
            for (int u = 0; u < 8; ++u) kv[u] = *(const f32x4*)(KV + (size_t)(n0 + u) * 262144 + base);
#pragma unroll
            for (int u = 0; u < 8; ++u) { u32x2 o; o.x = pk2(s[0], s[1]); o.y = pk2(s[2], s[3]); *(u32x2*)(SP + (size_t)(n0 + u) * 262144 + base) = o; s = s * Dc + kv[u] * c1; }
        }
#pragma unroll
        for (int j = 0; j < 4; ++j) o_state[((size_t)(h * 256 + dk4 + j)) * 256 + dv] = s[j];
    }
}

DI float silu_f(float x) { return x / (1.0f + __expf(-x)); }

DI void ret_step2(LAS unsigned char* lds, const bf16_t* Z, const bf16_t* SP, bf16_t* MIX, const float* rng, int n, int h, int tid) {
    LAS unsigned char* Kr = lds; LAS unsigned char* Vt = lds + 128 * 528; LAS float* red = (LAS float*)(lds + 128 * 528 + 256 * 264);
    const int lane = tid & 63, wid = tid >> 6, r = lane & 31, hh = lane >> 5;
    const bf16_t* zc = Z + (size_t)(n * 128) * INW;
#pragma unroll
    for (int k = 0; k < 8; ++k) { const int it = k * 512 + tid, row = it >> 5, c = it & 31;
        *(LAS u32x4*)(Kr + row * 528 + c * 16) = *(const u32x4*)(zc + (size_t)row * INW + C_RK + h * 256 + c * 8); }
    stage_T128x256(Vt, zc + C_RV + h * 256, tid);
    const int it_ = wid >> 1, dh = wid & 1;
    bf16x8 qf[16];
    { const bf16_t* qp = zc + (size_t)(32 * it_ + r) * INW + C_RQ + h * 256 + 8 * hh;
#pragma unroll
      for (int s = 0; s < 16; ++s) qf[s] = *(const bf16x8*)(qp + 16 * s); }
    f32x16 acc[4];
#pragma unroll
    for (int i = 0; i < 4; ++i) acc[i] = zero16();
    { const bf16_t* sp = SP + ((size_t)(n * 4 + h) * 256 + 128 * dh + r) * 256 + 8 * hh;
#pragma unroll
      for (int dt = 0; dt < 4; ++dt)
#pragma unroll
          for (int s = 0; s < 16; ++s) { const bf16x8 A = *(const bf16x8*)(sp + (size_t)dt * 32 * 256 + 16 * s); acc[dt] = MFMA32(A, qf[s], acc[dt]); } }
    const float gm = gamma_of(h);
#pragma unroll
    for (int dt = 0; dt < 4; ++dt) acc[dt] = acc[dt] * gm;
    __syncthreads();
    for (int jt = 0; jt <= it_; ++jt) {
        f32x16 X = zero16();
#pragma unroll
        for (int s = 0; s < 16; ++s) { const bf16x8 A = *(const LAS bf16x8*)(Kr + (32 * jt + r) * 528 + (16 * s + 8 * hh) * 2); X = MFMA32(A, qf[s], X); }
        if (jt == it_) {
#pragma unroll
            for (int i = 0; i < 16; ++i) X[i] = (crow(i, hh) > r) ? 0.f : X[i];
        }
#pragma unroll
        for (int s2 = 0; s2 < 2; ++s2) { const bf16x8 xs = pack8(X, s2);
#pragma unroll
            for (int dt = 0; dt < 4; ++dt) { const LAS unsigned char* pa = Vt + (128 * dh + 32 * dt + r) * 264 + (32 * jt + 16 * s2 + 4 * hh) * 2;
                const bf16x8 A = cat4(*(const LAS s16x4*)pa, *(const LAS s16x4*)(pa + 16)); acc[dt] = MFMA32(A, xs, acc[dt]); } }
    }
    float ss = 0.f;
#pragma unroll
    for (int dt = 0; dt < 4; ++dt)
#pragma unroll
        for (int i = 0; i < 16; ++i) ss += acc[dt][i] * acc[dt][i];
    ss += __shfl_xor(ss, 32);
    if (hh == 0) red[wid * 32 + r] = ss;
    __syncthreads();
    const float rstd = rsqrtf((red[wid * 32 + r] + red[(wid ^ 1) * 32 + r]) * (1.0f / 256.0f) + EPS);
    const size_t token = (size_t)n * 128 + 32 * it_ + r;
#pragma unroll
    for (int dt = 0; dt < 4; ++dt)
#pragma unroll
        for (int g4 = 0; g4 < 4; ++g4) {
            const int dv = 128 * dh + 32 * dt + 8 * g4 + 4 * hh;
            const u32x2 gz = *(const u32x2*)(Z + token * INW + C_RG + h * 256 + dv);
            const f32x4 gn = *(const f32x4*)(rng + h * 256 + dv);
            const float y0 = acc[dt][4 * g4 + 0] * rstd * gn[0] * silu_f(bflo(gz.x)), y1 = acc[dt][4 * g4 + 1] * rstd * gn[1] * silu_f(bfhi(gz.x));
            const float y2 = acc[dt][4 * g4 + 2] * rstd * gn[2] * silu_f(bflo(gz.y)), y3 = acc[dt][4 * g4 + 3] * rstd * gn[3] * silu_f(bfhi(gz.y));
            u32x2 o; o.x = pk2(y0, y1); o.y = pk2(y2, y3);
            *(u32x2*)(MIX + token * DM + 1024 + h * 256 + dv) = o;
        }
    __syncthreads();
}

DI void ret_decode_unit(LAS unsigned char* lds, const bf16_t* Z, const float* S0, float* S1, bf16_t* MIX, const float* rng, int b, int h, int tid) {
    LAS float* qv = (LAS float*)lds; LAS float* red = qv + 768;
    const int lane = tid & 63, wid = tid >> 6;
    const bf16_t* zrow = Z + (size_t)(LP + b) * INW;
    if (tid < 256) { qv[tid] = bf2f(zrow[C_RQ + h * 256 + tid]); qv[256 + tid] = bf2f(zrow[C_RK + h * 256 + tid]); qv[512 + tid] = bf2f(zrow[C_RV + h * 256 + tid]); }
    __syncthreads();
    const float gm = gamma_of(h);
    const f32x4 v4 = *(const LAS f32x4*)(qv + 512 + 4 * lane);
    f32x4 acc = {0.f, 0.f, 0.f, 0.f};
    const size_t off = ((size_t)(b * 4 + h) * 256 + wid * 32) * 256 + 4 * lane;
    const float* s0 = S0 + off; float* s1 = S1 + off;
#pragma unroll 1
    for (int rr = 0; rr < 32; rr += 8) {
        f32x4 s[8];
#pragma unroll
        for (int u = 0; u < 8; ++u) s[u] = __builtin_nontemporal_load((const f32x4*)(s0 + (size_t)(rr + u) * 256));
#pragma unroll
        for (int u = 0; u < 8; ++u) { const int dk = wid * 32 + rr + u; const float kk = qv[256 + dk], qq = qv[dk];
            const f32x4 sn = s[u] * gm + v4 * kk; __builtin_nontemporal_store(sn, (f32x4*)(s1 + (size_t)(rr + u) * 256)); acc += sn * qq; }
    }
    *(LAS f32x4*)(red + wid * 256 + 4 * lane) = acc;
    __syncthreads();
    if (wid == 0) {
        f32x4 o = {0.f, 0.f, 0.f, 0.f};
#pragma unroll
        for (int w = 0; w < 8; ++w) o += *(const LAS f32x4*)(red + w * 256 + 4 * lane);
        const float ssq = wave_sum((o[0] * o[0] + o[1] * o[1]) + (o[2] * o[2] + o[3] * o[3]));
        const float rstd = rsqrtf(ssq * (1.0f / 256.0f) + EPS);
        const u32x2 gz = *(const u32x2*)(zrow + C_RG + h * 256 + 4 * lane);
        const f32x4 gn = *(const f32x4*)(rng + h * 256 + 4 * lane);
        u32x2 y; y.x = pk2(o[0] * rstd * gn[0] * silu_f(bflo(gz.x)), o[1] * rstd * gn[1] * silu_f(bfhi(gz.x)));
        y.y = pk2(o[2] * rstd * gn[2] * silu_f(bflo(gz.y)), o[3] * rstd * gn[3] * silu_f(bfhi(gz.y)));
        *(u32x2*)(MIX + (size_t)(LP + b) * DM + 1024 + h * 256 + 4 * lane) = y;
    }
    __syncthreads();
}

DI void attn_prompt_unit(LAS unsigned char* lds, const bf16_t* Z, bf16_t* MIX, const float* gq, const float* gk, const float* sinks, float* o_k, float* o_v, int nb, int kh, int hf, int tid) {
    LAS unsigned char* Kn = lds; LAS unsigned char* Vt = lds + 256 * 144;
    const int lane = tid & 63, wid = tid >> 6, r = lane & 31, hh = lane >> 5;
    {
        const int row = tid >> 1, half = tid & 1; const int tok = (nb - 1) * 128 + row;
        u32x4 v[4];
#pragma unroll
        for (int c = 0; c < 4; ++c) v[c] = (u32x4){0u, 0u, 0u, 0u};
        if (tok >= 0) {
#pragma unroll
            for (int c = 0; c < 4; ++c) v[c] = *(const u32x4*)(Z + (size_t)tok * INW + C_AK + kh * 64 + half * 32 + c * 8);
        }
        float f[32]; float ss = 0.f;
#pragma unroll
        for (int c = 0; c < 4; ++c)
#pragma unroll
            for (int e = 0; e < 4; ++e) { f[c * 8 + 2 * e] = bflo(v[c][e]); f[c * 8 + 2 * e + 1] = bfhi(v[c][e]); }
#pragma unroll
        for (int e = 0; e < 32; ++e) ss += f[e] * f[e];
        ss += __shfl_xor(ss, 1);
        const float rstd = rsqrtf(ss * (1.0f / 64.0f) + EPS);
#pragma unroll
        for (int c = 0; c < 8; ++c) { const f32x4 g = *(const f32x4*)(gk + half * 32 + c * 4);
#pragma unroll
            for (int e = 0; e < 4; ++e) f[c * 4 + e] *= rstd * g[e]; }
#pragma unroll
        for (int c = 0; c < 4; ++c) { u32x4 w; w.x = pk2(f[c * 8], f[c * 8 + 1]); w.y = pk2(f[c * 8 + 2], f[c * 8 + 3]); w.z = pk2(f[c * 8 + 4], f[c * 8 + 5]); w.w = pk2(f[c * 8 + 6], f[c * 8 + 7]);
            *(LAS u32x4*)(Kn + row * 144 + half * 64 + c * 16) = w; }
        if (nb == 63 && hf == 0 && row >= 128) { float* o = o_k + ((size_t)(row - 128) * 2 + kh) * 64 + half * 32;
#pragma unroll
            for (int c = 0; c < 8; ++c) *(f32x4*)(o + c * 4) = (f32x4){f[c * 4], f[c * 4 + 1], f[c * 4 + 2], f[c * 4 + 3]}; }
    }
#pragma unroll
    for (int k = 0; k < 2; ++k) {
        const int it = k * 512 + tid, kpl = it & 15, dgl = (it >> 4) & 3, rest = it >> 6, dg = dgl + 4 * (rest & 1), kp = kpl + 16 * (rest >> 1);
        const int tok0 = (nb - 1) * 128 + 2 * kp;
        u32x4 a = {0u, 0u, 0u, 0u}, b = {0u, 0u, 0u, 0u};
        if (tok0 >= 0) { const bf16_t* p = Z + (size_t)tok0 * INW + C_AV + kh * 64 + dg * 8; a = *(const u32x4*)p; b = *(const u32x4*)(p + INW); }
#pragma unroll
        for (int e = 0; e < 8; ++e) {
            const unsigned lo = (e & 1) ? (a[e >> 1] >> 16) : (a[e >> 1] & 0xffffu), hi = (e & 1) ? (b[e >> 1] & 0xffff0000u) : (b[e >> 1] << 16);
            *(LAS unsigned*)(Vt + (dg * 8 + e) * 520 + kp * 4) = lo | hi;
        }
        if (nb == 63 && hf == 0 && kp >= 64) { float* o = o_v + ((size_t)(2 * kp - 128) * 2 + kh) * 64 + dg * 8;
#pragma unroll
            for (int e = 0; e < 4; ++e) { o[2 * e] = bflo(a[e]); o[2 * e + 1] = bfhi(a[e]); o[128 + 2 * e] = bflo(b[e]); o[128 + 2 * e + 1] = bfhi(b[e]); } }
    }
    __syncthreads();
    const int hq = kh * 8 + 4 * hf + (wid >> 1), qh = wid & 1;
    const float sink = sinks[hq];
#pragma unroll 1
    for (int qq = 0; qq < 2; ++qq) {
        const int qi = 2 * qh + qq; const size_t tokq = (size_t)nb * 128 + 32 * qi + r;
        bf16x8 qf[4];
        {   const bf16_t* qp = Z + tokq * INW + hq * 64 + 8 * hh;
            u32x4 raw[4]; float ss = 0.f;
#pragma unroll
            for (int s = 0; s < 4; ++s) { raw[s] = *(const u32x4*)(qp + 16 * s);
#pragma unroll
                for (int e = 0; e < 4; ++e) { const float lo = bflo(raw[s][e]), hi = bfhi(raw[s][e]); ss += lo * lo + hi * hi; } }
            ss += __shfl_xor(ss, 32);
            const float rstd = rsqrtf(ss * (1.0f / 64.0f) + EPS) * 0.125f;
#pragma unroll
            for (int s = 0; s < 4; ++s) { const f32x4 g0 = *(const f32x4*)(gq + 16 * s + 8 * hh), g1 = *(const f32x4*)(gq + 16 * s + 8 * hh + 4); u32x4 w;
                w.x = pk2(bflo(raw[s].x) * rstd * g0[0], bfhi(raw[s].x) * rstd * g0[1]); w.y = pk2(bflo(raw[s].y) * rstd * g0[2], bfhi(raw[s].y) * rstd * g0[3]);
                w.z = pk2(bflo(raw[s].z) * rstd * g1[0], bfhi(raw[s].z) * rstd * g1[1]); w.w = pk2(bflo(raw[s].w) * rstd * g1[2], bfhi(raw[s].w) * rstd * g1[3]);
                qf[s] = __builtin_bit_cast(bf16x8, w); }
        }
        f32x16 X[5];
#pragma unroll
        for (int t = 0; t < 5; ++t) { X[t] = zero16();
#pragma unroll
            for (int s = 0; s < 4; ++s) { const bf16x8 A = *(const LAS bf16x8*)(Kn + (32 * (qi + t) + r) * 144 + (16 * s + 8 * hh) * 2); X[t] = MFMA32(A, qf[s], X[t]); } }
        const int ii = 32 * qi + r;
        float m = -1e30f;
#pragma unroll
        for (int t = 0; t < 5; ++t)
#pragma unroll
            for (int i = 0; i < 16; ++i) { const int jj = 32 * (qi + t) + crow(i, hh); const bool ok = (jj >= ii) && (jj <= ii + 128) && (nb > 0 || jj >= 128);
                X[t][i] = ok ? X[t][i] : -1e30f; m = fmaxf(m, X[t][i]); }
        m = fmaxf(m, __shfl_xor(m, 32)); m = fmaxf(m, sink);
        float sum = 0.f;
#pragma unroll
        for (int t = 0; t < 5; ++t)
#pragma unroll
            for (int i = 0; i < 16; ++i) { const float p = __expf(X[t][i] - m); X[t][i] = p; sum += p; }
        sum += __shfl_xor(sum, 32);
        const float inv = 1.0f / (sum + __expf(sink - m));
        f32x16 o[2]; o[0] = zero16(); o[1] = zero16();
#pragma unroll
        for (int t = 0; t < 5; ++t)
#pragma unroll
            for (int s2 = 0; s2 < 2; ++s2) { const bf16x8 xs = pack8(X[t], s2);
#pragma unroll
                for (int dt = 0; dt < 2; ++dt) { const LAS unsigned char* pa = Vt + (32 * dt + r) * 520 + (32 * (qi + t) + 16 * s2 + 4 * hh) * 2;
                    const bf16x8 A = cat4(*(const LAS s16x4*)pa, *(const LAS s16x4*)(pa + 16)); o[dt] = MFMA32(A, xs, o[dt]); } }
#pragma unroll
        for (int dt = 0; dt < 2; ++dt)
#pragma unroll
            for (int g4 = 0; g4 < 4; ++g4) { u32x2 w; w.x = pk2(o[dt][4 * g4] * inv, o[dt][4 * g4 + 1] * inv); w.y = pk2(o[dt][4 * g4 + 2] * inv, o[dt][4 * g4 + 3] * inv);
                *(u32x2*)(MIX + tokq * DM + hq * 64 + 32 * dt + 8 * g4 + 4 * hh) = w; }
    }
    __syncthreads();
}

DI void attn_decode_unit(LAS unsigned char* lds, const bf16_t* Z, const float* ck, const float* cv, bf16_t* MIX, const float* gq, const float* gk, const float* sinks, float* o_k, float* o_v, int b, int kh, int tid) {
    LAS float* Kc = (LAS float*)lds; LAS float* Vc = Kc + 129 * 65; LAS float* qs = Vc + 129 * 64; LAS float* pw = qs + 512;
    const int lane = tid & 63, wid = tid >> 6;
#pragma unroll
    for (int k = 0; k < 4; ++k) {
        const int it = k * 512 + tid, w = it >> 4, c4 = (it & 15) * 4;
        const size_t src = ((size_t)(b * 128 + w) * 2 + kh) * 64 + c4;
        const f32x4 k4 = *(const f32x4*)(ck + src), v4 = *(const f32x4*)(cv + src);
#pragma unroll
        for (int e = 0; e < 4; ++e) { Kc[w * 65 + c4 + e] = k4[e]; Vc[w * 64 + c4 + e] = v4[e]; }
        if (w >= 1) { const size_t dst = ((size_t)(b * 128 + w - 1) * 2 + kh) * 64 + c4; *(f32x4*)(o_k + dst) = k4; *(f32x4*)(o_v + dst) = v4; }
    }
    const bf16_t* zrow = Z + (size_t)(LP + b) * INW;
    const size_t dnew = ((size_t)(b * 128 + 127) * 2 + kh) * 64 + lane;
    if (wid == 0) { const float kx = bf2f(zrow[C_AK + kh * 64 + lane]); const float ss = wave_sum(kx * kx); const float kn = kx * rsqrtf(ss * (1.0f / 64.0f) + EPS) * gk[lane];
        Kc[128 * 65 + lane] = kn; o_k[dnew] = kn; }
    if (wid == 1) { const float vx = bf2f(zrow[C_AV + kh * 64 + lane]); Vc[128 * 64 + lane] = vx; o_v[dnew] = vx; }
    const int hq = kh * 8 + wid;
    { const float qx = bf2f(zrow[hq * 64 + lane]); const float ss = wave_sum(qx * qx); qs[wid * 64 + lane] = qx * rsqrtf(ss * (1.0f / 64.0f) + EPS) * gq[lane] * 0.125f; }
    __syncthreads();
    float s1 = 0.f, s2 = 0.f;
#pragma unroll 8
    for (int d = 0; d < 64; ++d) { const float q = qs[wid * 64 + d]; s1 += q * Kc[lane * 65 + d]; s2 += q * Kc[(lane + 64) * 65 + d]; }
    const float s3 = wave_sum(qs[wid * 64 + lane] * Kc[128 * 65 + lane]);
    const float sink = sinks[hq];
    const float m = fmaxf(wave_max(fmaxf(s1, s2)), fmaxf(s3, sink));
    const float p1 = __expf(s1 - m), p2 = __expf(s2 - m), p3 = __expf(s3 - m);
    const float denom = wave_sum(p1 + p2) + p3 + __expf(sink - m);
    pw[wid * 132 + lane] = p1; pw[wid * 132 + 64 + lane] = p2; if (lane == 0) pw[wid * 132 + 128] = p3;
    __syncthreads();
    float o = 0.f;
#pragma unroll 3
    for (int j = 0; j < 129; ++j) o += pw[wid * 132 + j] * Vc[j * 64 + lane];
    MIX[(size_t)(LP + b) * DM + hq * 64 + lane] = (bf16_t)(pk2(o / denom, 0.f) & 0xffffu);
    __syncthreads();
}

template <class Epi>
DI void skinny_unit(LAS unsigned char* lds, const bf16_t* A, const bf16_t* Wt, int K, int cgi, int k0, const Epi& E, int tid) {
    const int lane = tid & 63, wid = tid >> 6, r = lane & 31, hh = lane >> 5;
    const int c0 = cgi * 32;
    const bf16_t* pa = A + (size_t)r * K + k0 + wid * 256 + 8 * hh;
    const bf16_t* pb = Wt + (size_t)(c0 + r) * K + k0 + wid * 256 + 8 * hh;
    const size_t rs = (size_t)32 * K;
    f32x16 acc[4];
#pragma unroll
    for (int i = 0; i < 4; ++i) acc[i] = zero16();
    bf16x8 fb[3][2], fa[3][2][4];
#define SK_LOAD(buf, c) do { _Pragma("unroll") for (int s = 0; s < 2; ++s) { fb[buf][s] = *(const bf16x8*)(pb + 32 * (c) + 16 * s); \
        _Pragma("unroll") for (int mt = 0; mt < 4; ++mt) fa[buf][s][mt] = *(const bf16x8*)(pa + mt * rs + 32 * (c) + 16 * s); } } while (0)
#define SK_MMA(buf) do { _Pragma("unroll") for (int s = 0; s < 2; ++s) _Pragma("unroll") for (int mt = 0; mt < 4; ++mt) acc[mt] = MFMA32(fa[buf][s][mt], fb[buf][s], acc[mt]); } while (0)
    SK_LOAD(0, 0); SK_LOAD(1, 1);
    SK_LOAD(2, 2); SK_MMA(0);
    SK_LOAD(0, 3); SK_MMA(1);
    SK_LOAD(1, 4); SK_MMA(2);
    SK_LOAD(2, 5); SK_MMA(0);
    SK_LOAD(0, 6); SK_MMA(1);
    SK_LOAD(1, 7); SK_MMA(2);
    SK_MMA(0); SK_MMA(1);
#undef SK_LOAD
#undef SK_MMA
    LAS float* red = (LAS float*)lds;
#pragma unroll
    for (int mt = 0; mt < 4; ++mt)
#pragma unroll
        for (int i = 0; i < 16; ++i) red[(wid * 128 + mt * 32 + crow(i, hh)) * 32 + r] = acc[mt][i];
    __syncthreads();
    const int row = tid >> 2, c8 = (tid & 3) * 8;
    f32x4 sa = {0.f, 0.f, 0.f, 0.f}, sb = {0.f, 0.f, 0.f, 0.f};
#pragma unroll
    for (int w = 0; w < 8; ++w) { sa += *(const LAS f32x4*)(red + (w * 128 + row) * 32 + c8); sb += *(const LAS f32x4*)(red + (w * 128 + row) * 32 + c8 + 4); }
    E(row, c0 + c8, sa); E(row, c0 + c8 + 4, sb);
    __syncthreads();
}
struct SkOut { const float* xs; float* X1s; bf16_t* XGs; const float* g2;
    DI void operator()(int row, int col, f32x4 a) const { const f32x4 v = a + *(const f32x4*)(xs + (size_t)row * DM + col); *(f32x4*)(X1s + (size_t)row * DM + col) = v;
        const f32x4 g = *(const f32x4*)(g2 + col); u32x2 o; o.x = pk2(v[0] * g[0], v[1] * g[1]); o.y = pk2(v[2] * g[2], v[3] * g[3]); *(u32x2*)(XGs + (size_t)row * DM + col) = o; } };
struct SkUp { bf16_t* Us;
    DI void operator()(int row, int col, f32x4 a) const {
#pragma unroll
        for (int e = 0; e < 4; ++e) { a[e] = fmaxf(a[e], 0.f); a[e] *= a[e]; }
        u32x2 o; o.x = pk2(a[0], a[1]); o.y = pk2(a[2], a[3]); *(u32x2*)(Us + (size_t)row * FF + col) = o; } };
struct SkSlab { float* slab;
    DI void operator()(int row, int col, f32x4 a) const { *(f32x4*)(slab + (size_t)row * DM + col) = a; } };

#define RLX_AGENT __ATOMIC_RELAXED, __HIP_MEMORY_SCOPE_AGENT
#define XB_TMO      128
#define XB_XCNT(j)  (256  + 64 * (j))
#define XB_XSUB(j)  (1280 + 64 * (j))
#define XB_XGEN(j)  (2304 + 64 * (j))
#define XB_TOP      3328
#define XB_TOPGEN   3392
#define XCD_BAR_WORDS 3456
#define XB_SPIN_CAP (1u << 18)

__device__ __forceinline__ unsigned xb_ld(unsigned* p)              { return __hip_atomic_load(p, __ATOMIC_RELAXED, __HIP_MEMORY_SCOPE_AGENT); }
__device__ __forceinline__ unsigned xb_add(unsigned* p, unsigned v) { return __hip_atomic_fetch_add(p, v, __ATOMIC_RELAXED, __HIP_MEMORY_SCOPE_AGENT); }
__device__ __forceinline__ unsigned xb_xcc_id() { return (unsigned)__builtin_amdgcn_s_getreg((3 << 11) | 20) & 0xFu; }
#define XB_SPIN(cond, bar) do { unsigned _sp = 0; while (cond) { __builtin_amdgcn_s_sleep(1); \
    if ((++_sp & 255u) == 0u) { if (xb_ld(&(bar)[XB_TMO])) break; if (_sp > XB_SPIN_CAP) { atomicAdd(&(bar)[XB_TMO], 1u); break; } } } } while (0)

struct XcdBarrier {
    unsigned* bar; unsigned x;
    volatile LAS unsigned* st;
};

__device__ __forceinline__ XcdBarrier xcd_barrier_post(unsigned* bar, volatile LAS unsigned* st) {
    XcdBarrier b; b.bar = bar; b.x = xb_xcc_id(); b.st = st;
    if (threadIdx.x == 0) (void)xb_add(&bar[XB_XCNT(b.x)], 1u);
    return b;
}
__device__ __forceinline__ void xcd_barrier_complete(unsigned* bar, unsigned x, unsigned& nloc, unsigned& nx) {
    const unsigned G = gridDim.x * gridDim.y * gridDim.z;
    unsigned sum, cnt, mine, sp = 0u;
    for (;;) {
        sum = 0u; cnt = 0u; mine = 0u;
#pragma unroll
        for (unsigned j = 0; j < 16; ++j) { const unsigned c = xb_ld(&bar[XB_XCNT(j)]); sum += c; cnt += (c > 0u) ? 1u : 0u; mine = (j == x) ? c : mine; }
        if (sum == G) break;
        __builtin_amdgcn_s_sleep(1);
        if ((++sp & 255u) == 0u) { if (xb_ld(&bar[XB_TMO])) break; if (sp > XB_SPIN_CAP) { atomicAdd(&bar[XB_TMO], 1u); break; } }
    }
    nloc = mine > 0u ? mine : 1u; nx = cnt > 0u ? cnt : 1u;
}

__device__ __forceinline__ void xcd_barrier(const XcdBarrier& b) {
    asm volatile("s_waitcnt vmcnt(0)" ::: "memory");
    __syncthreads();
    if (threadIdx.x == 0) {
        unsigned* bar = b.bar;
        __builtin_amdgcn_s_waitcnt(0);
        unsigned nloc = b.st[0], nx = b.st[1];
        if (nloc == 0u) { xcd_barrier_complete(bar, b.x, nloc, nx); b.st[0] = nloc; b.st[1] = nx; }
        const unsigned old = xb_add(&bar[XB_XSUB(b.x)], 1u);
        const unsigned gen = old / nloc;
        if (old + 1u == (gen + 1u) * nloc) {
            __builtin_amdgcn_fence(__ATOMIC_RELEASE, "agent");
            asm volatile("s_waitcnt vmcnt(0)" ::: "memory");
            const unsigned og = xb_add(&bar[XB_TOP], 1u);
            const unsigned tg = og / nx;
            if (og + 1u == (tg + 1u) * nx) xb_add(&bar[XB_TOPGEN], 1u);
            else XB_SPIN(xb_ld(&bar[XB_TOPGEN]) == tg, bar);
            __builtin_amdgcn_fence(__ATOMIC_ACQUIRE, "agent");
            xb_add(&bar[XB_XGEN(b.x)], 1u);
            asm volatile("s_waitcnt vmcnt(0)" ::: "memory");
        } else {
            XB_SPIN(xb_ld(&bar[XB_XGEN(b.x)]) == gen, bar);
            __builtin_amdgcn_fence(__ATOMIC_ACQUIRE, "agent");
            asm volatile("s_waitcnt vmcnt(0)" ::: "memory");
        }
    }
    __syncthreads();
}

struct Args { const float* in[15]; float* out; unsigned char* ws; int ph_lo, ph_hi; };
constexpr int NPH = 9;

__global__ void __launch_bounds__(512, 2) fwd_kernel(Args a) {
    extern __shared__ __attribute__((aligned(16))) unsigned char lds_raw[];
    LAS unsigned char* lds = (LAS unsigned char*)lds_raw;
    cg::grid_group grid = cg::this_grid();
    const int tid = threadIdx.x, lane = tid & 63, wid = __builtin_amdgcn_readfirstlane(tid >> 6);
    const int G = gridDim.x, bx = blockIdx.x;
    unsigned char* ws = a.ws; float* out = a.out;
    const float* x_p = a.in[0]; const float* x_s = a.in[1]; const float* cache_k = a.in[2]; const float* cache_v = a.in[3]; const float* state0 = a.in[4];
    const float* ln1_g = a.in[5]; const float* w_in = a.in[6]; const float* gq = a.in[7]; const float* gk = a.in[8]; const float* sinks = a.in[9];
    const float* rng = a.in[10]; const float* w_out = a.in[11]; const float* ln2_g = a.in[12]; const float* w_up = a.in[13]; const float* w_dn = a.in[14];
    bf16_t* WIN = (bf16_t*)(ws + WS_WIN); bf16_t* WOUT = (bf16_t*)(ws + WS_WOUT); bf16_t* WUP = (bf16_t*)(ws + WS_WUP); bf16_t* WDN = (bf16_t*)(ws + WS_WDN);
    bf16_t* H1 = (bf16_t*)(ws + WS_H1); bf16_t* XG = H1; bf16_t* MIX = (bf16_t*)(ws + WS_MIX); bf16_t* Z = (bf16_t*)(ws + WS_Z); bf16_t* U = (bf16_t*)(ws + WS_U);
    float* PART = (float*)(ws + WS_PART); float* RSTD2 = (float*)(ws + WS_RSTD2); float* KV = (float*)(ws + WS_KV); bf16_t* SP = (bf16_t*)(ws + WS_SP); float* SLAB = (float*)(ws + WS_SP);
    const int lo = a.ph_lo, hi = a.ph_hi;
#define IN(k) (lo <= (k) && (k) < hi)
    volatile LAS unsigned* MISC = (volatile LAS unsigned*)(lds + LDS_BYTES - 64);
    if (tid < 16) MISC[tid] = 0u;
    __syncthreads();
    const XcdBarrier bar = xcd_barrier_post((unsigned*)ws + 1024, MISC + 8);
    if (lo > hi) grid.sync();
#define SEAM(k) do { if (IN(k) && IN((k) + 1)) xcd_barrier(bar); } while (0)

    if (IN(0)) for (int rep_ = 0; rep_ < 1 + ((DUPMASK >> 0) & 1); ++rep_) { if (rep_) xcd_barrier(bar);
        LAS float* scr = (LAS float*)(lds + wid * 17408);
        const int gw = bx * 8 + wid, NGW = G * 8;
        constexpr int I_IN = (DM / 64) * (INW / 32);
        p0_convert(ResIn{w_in, WIN}, gw, NGW, I_IN, scr, lane);
        for (int m = gw; m < MP; m += NGW) {
            if (m < MR) rms_row(m < LP ? x_p + (size_t)m * DM : x_s + (size_t)(m - LP) * DM, ln1_g, H1 + (size_t)m * DM, lane);
            else {
#pragma unroll
                for (int j = 0; j < 8; ++j) *((u32x2*)(H1 + (size_t)m * DM) + lane + 64 * j) = (u32x2){0u, 0u};
            }
        }
    }
    SEAM(0);
    if (IN(1)) for (int rep_ = 0; rep_ < 1 + ((DUPMASK >> 1) & 1); ++rep_) { if (rep_) xcd_barrier(bar);
        pg8::Gemm g{H1, WIN, MP, INW, DM}; pg8::StaticOrder S; S.init(MP, INW, G, bx);
        pg8::EpiIn E{Z};
        pg8::gemm_phase<pg8::EpiIn, pg8::StaticOrder, true, true>(lds, g, S, E);
        {
            constexpr int NT = (MP / 256) * (INW / 256); const int rounds = (NT + G - 1) / G, first_idle = NT - (rounds - 1) * G;
            const int nidle = (first_idle < G) ? (G - first_idle) : G, me = (first_idle < G) ? (bx - first_idle) : bx;
            if (me >= 0) {
                LAS float* scr = (LAS float*)(lds + wid * 17408);
                constexpr int I_OUT = (DM / 64) * (DM / 32), I_UP = (DM / 64) * (FF / 32), I_DN = (FF / 64) * (DM / 32);
                p0_convert(ResRest{w_out, w_up, w_dn, WOUT, WUP, WDN}, me * 8 + wid, nidle * 8, I_OUT + I_UP + I_DN, scr, lane);
            }
        }
    }
    SEAM(1);
    if (IN(2)) for (int rep_ = 0; rep_ < 1 + ((DUPMASK >> 2) & 1); ++rep_) { if (rep_) xcd_barrier(bar);
        for (int u = bx; u < 256; u += G) ret_step1(lds, Z, KV, u >> 2, u & 3, tid);
        for (int u = bx; u < 256; u += G) attn_prompt_unit(lds, Z, MIX, gq, gk, sinks, out + O_KP, out + O_VP, u >> 2, (u >> 1) & 1, u & 1, tid);
        for (int u = bx; u < 256; u += G) attn_decode_unit(lds, Z, cache_k, cache_v, MIX, gq, gk, sinks, out + O_KS, out + O_VS, u >> 1, u & 1, tid);
    }
    SEAM(2);
    if (IN(3)) for (int rep_ = 0; rep_ < 1 + ((DUPMASK >> 3) & 1); ++rep_) { if (rep_) xcd_barrier(bar);
        ret_scan(KV, SP, out + O_SP, bx * 512 + tid, G * 512);
        if (G == 256) {
            if (bx < 128) ret_decode_unit(lds, Z, state0, out + O_SS, MIX, rng, bx >> 2, bx & 3, tid);
            else for (int j = 0; j < 3; ++j) { const int u = 128 + 3 * (bx - 128) + j; ret_decode_unit(lds, Z, state0, out + O_SS, MIX, rng, u >> 2, u & 3, tid); }
        } else for (int u = bx; u < 512; u += G) ret_decode_unit(lds, Z, state0, out + O_SS, MIX, rng, u >> 2, u & 3, tid);
    }
    SEAM(3);
    if (IN(4)) for (int rep_ = 0; rep_ < 1 + ((DUPMASK >> 4) & 1); ++rep_) { if (rep_) xcd_barrier(bar);
        for (int u = bx; u < 256; u += G) ret_step2(lds, Z, SP, MIX, rng, u >> 2, u & 3, tid);
    }
    SEAM(4);
    if (IN(5)) for (int rep_ = 0; rep_ < 1 + ((DUPMASK >> 5) & 1); ++rep_) { if (rep_) xcd_barrier(bar);
        pg8::Gemm g{MIX, WOUT, LP, DM, DM}; pg8::StaticOrder S; S.init(LP, DM, G, bx);
        pg8::EpiOut E{x_p, x_s, out + O_Y, XG, ln2_g, PART};
        pg8::gemm_phase<pg8::EpiOut, pg8::StaticOrder, true, true>(lds, g, S, E);
        const SkOut SE{x_s, out + O_Y + (size_t)LP * DM, XG + (size_t)LP * DM, ln2_g};
        for (int u = G - 1 - bx; u < DM / 32; u += G) skinny_unit(lds, MIX + (size_t)LP * DM, WOUT, DM, u, 0, SE, tid);
    }
    SEAM(5);
    if (IN(6)) for (int rep_ = 0; rep_ < 1 + ((DUPMASK >> 6) & 1); ++rep_) { if (rep_) xcd_barrier(bar);
        for (int row = bx + G * tid; row < LP; row += G * 512) { float s = 0.f;
#pragma unroll
            for (int j = 0; j < 8; ++j) { const f32x4 p = *(const f32x4*)(PART + (size_t)row * 32 + 4 * j); s += (p[0] + p[1]) + (p[2] + p[3]); }
            RSTD2[row] = 1.0f / (s * (1.0f / DM) + EPS); }
        for (int row = LP + bx * 8 + wid; row < MR; row += G * 8) {
            const float* xr = out + O_Y + (size_t)row * DM; float s = 0.f;
#pragma unroll
            for (int j = 0; j < 8; ++j) { const f32x4 v = *((const f32x4*)xr + lane + 64 * j); s += (v[0] * v[0] + v[1] * v[1]) + (v[2] * v[2] + v[3] * v[3]); }
            s = wave_sum(s); if (lane == 0) RSTD2[row] = 1.0f / (s * (1.0f / DM) + EPS); }
        pg8::Gemm g{XG, WUP, LP, FF, DM}; pg8::StaticOrder S; S.init(LP, FF, G, bx);
        pg8::EpiUp E{U};
        pg8::gemm_phase<pg8::EpiUp, pg8::StaticOrder, true, true>(lds, g, S, E);
        const SkUp SE{U + (size_t)LP * FF};
        for (int u = bx; u < FF / 32; u += G) skinny_unit(lds, XG + (size_t)LP * DM, WUP, DM, u, 0, SE, tid);
    }
    SEAM(6);
    if (IN(7)) {
        pg8::Gemm g{U, WDN, LP, DM, FF}; pg8::StaticOrder S; S.init(LP, DM, G, bx);
        pg8::EpiDown E{out + O_Y, RSTD2};
        pg8::gemm_phase<pg8::EpiDown, pg8::StaticOrder, true, true>(lds, g, S, E);
        for (int u = bx; u < 4 * (DM / 32); u += G) { const SkSlab SE{SLAB + (size_t)(u & 3) * NS * DM}; skinny_unit(lds, U + (size_t)LP * FF, WDN, FF, u >> 2, (u & 3) * 2048, SE, tid); }
    }
    SEAM(7);
    if (IN(8)) {
        for (int e = bx * 512 + tid; e < NS * DM / 4; e += G * 512) {
            const int row = e >> 9; float* p = out + O_Y + (size_t)LP * DM + (size_t)e * 4;
            const f32x4 s = (*(const f32x4*)(SLAB + (size_t)e * 4) + *(const f32x4*)(SLAB + (size_t)NS * DM + (size_t)e * 4)) + (*(const f32x4*)(SLAB + (size_t)2 * NS * DM + (size_t)e * 4) + *(const f32x4*)(SLAB + (size_t)3 * NS * DM + (size_t)e * 4));
            *(f32x4*)p = *(const f32x4*)p + s * RSTD2[LP + row];
        }
    }
#undef IN
#undef SEAM
}

#ifndef N_LAUNCHES
#define N_LAUNCHES 1
#endif
extern "C" void kernel_launch(void* const* d_in, const int* in_sizes, int n_in, void* d_out, int out_size, void* d_ws, size_t ws_size, hipStream_t stream) {
    static int grid = 0;
    if (grid == 0) {
        if (n_in != 15 || (size_t)out_size != O_END || ws_size < WS_END) { fprintf(stderr, "kernel_launch: unexpected shapes (n_in %d out %d ws %zu)\n", n_in, out_size, ws_size); grid = -1; return; }
        int dev = 0, cus = 0, per_cu = 0;
        (void)hipGetDevice(&dev); (void)hipDeviceGetAttribute(&cus, hipDeviceAttributeMultiprocessorCount, dev);
        if (hipFuncSetAttribute((const void*)fwd_kernel, hipFuncAttributeMaxDynamicSharedMemorySize, LDS_BYTES) != hipSuccess) { fprintf(stderr, "kernel_launch: hipFuncSetAttribute failed\n"); grid = -1; return; }
        (void)hipOccupancyMaxActiveBlocksPerMultiprocessor(&per_cu, (const void*)fwd_kernel, 512, LDS_BYTES);
        (void)hipGetLastError();
        if (per_cu < 1) { fprintf(stderr, "kernel_launch: occupancy query says %d blocks per CU\n", per_cu); }
        grid = cus > 0 ? cus : 256;
    }
    if (grid < 0) return;
    if (hipMemsetAsync(d_ws, 0, 65536, stream) != hipSuccess) { fprintf(stderr, "kernel_launch: memset failed\n"); return; }
    Args a{};
    for (int i = 0; i < 15; ++i) a.in[i] = (const float*)d_in[i];
    a.out = (float*)d_out; a.ws = (unsigned char*)d_ws;
    if (N_LAUNCHES == 1) {
        a.ph_lo = 0; a.ph_hi = NPH;
        void* args[] = {&a};
        hipError_t e = hipLaunchCooperativeKernel((const void*)fwd_kernel, dim3(grid), dim3(512), args, LDS_BYTES, stream);
        if (e != hipSuccess) fprintf(stderr, "cooperative launch failed: %s (grid %d)\n", hipGetErrorString(e), grid);
    } else {
        for (int p = 0; p < NPH; ++p) { a.ph_lo = p; a.ph_hi = p + 1; hipLaunchKernelGGL(fwd_kernel, dim3(grid), dim3(512), LDS_BYTES, stream, a); }
    }
}
```

```cpp
#include <hip/hip_runtime.h>
#include <hip/hip_cooperative_groups.h>
#include <cstdio>
#include <cstdint>
namespace cg = cooperative_groups;

#ifndef DUPMASK
#define DUPMASK 0
#endif
#define DI __device__ __forceinline__
#define LAS __attribute__((address_space(3)))
typedef float f32x2 __attribute__((ext_vector_type(2)));
typedef float f32x16 __attribute__((ext_vector_type(16)));
typedef short s16x4 __attribute__((ext_vector_type(4)));
typedef unsigned u32x2 __attribute__((ext_vector_type(2)));
typedef __bf16 bf16x2v __attribute__((ext_vector_type(2)));

constexpr int DM = 2048, LP = 8192, NS = 128, MR = LP + NS  , MP = 8448  ;
constexpr int INW = 5376, FF = 8192;
constexpr int C_AQ = 0, C_AK = 1024, C_AV = 1152, C_RQ = 1280, C_RK = 2304, C_RV = 3328, C_RG = 4352;
constexpr float EPS = 1e-6f;

DI unsigned pk2(float lo, float hi) { f32x2 v = {lo, hi}; return __builtin_bit_cast(unsigned, __builtin_convertvector(v, bf16x2v)); }
DI float bflo(unsigned u) { return __uint_as_float(u << 16); }
DI float bfhi(unsigned u) { return __uint_as_float(u & 0xffff0000u); }
DI float bf2f(unsigned short u) { return __uint_as_float(((unsigned)u) << 16); }

namespace pg8 {
#define PG8_LAS __attribute__((address_space(3)))
typedef unsigned short bf16_t;
typedef short bf16x8 __attribute__((ext_vector_type(8)));
typedef float f32x4 __attribute__((ext_vector_type(4)));
typedef unsigned u32x4 __attribute__((ext_vector_type(4)));
constexpr int BM = 256, BK = 64, HALF = 128, HTB = HALF * BK * 2  , STAGE_BYTES = 8 * HTB, NXCD = 8, WGM = 8;

__host__ __device__ __forceinline__ int lds_byte(int r, int c) { const int st = (r >> 4) * 2 + (c >> 5), rr = r & 15, cc = c & 31, ob = rr * 64 + cc * 2; return st * 1024 + (ob ^ (((ob >> 9) & 1) << 5)); }
__host__ __device__ __forceinline__ void stage_rc(int b, int& R, int& C) { const int st = b / 1024, sb = b % 1024, swz = sb ^ (((sb >> 9) & 1) << 5); R = (st >> 1) * 16 + swz / 64; C = (st & 1) * 32 + (swz % 64) / 2; }
__host__ __device__ __forceinline__ int perm32(int rho) { const int n = rho >> 4, i = rho & 15; return 8 * (i >> 2) + 4 * n + (i & 3); }

struct Unit { int pm, pn; };
struct Gemm { const bf16_t* A; const bf16_t* Bt; int M, N, K; };

struct StaticOrder {
    int nM, nN, nwg, G, c;
    __host__ __device__ void init(int M, int N, int G_, int c_) { nM = M / BM; nN = N / BM; nwg = nM * nN; G = G_; c = c_; }
    __host__ __device__ bool next(int i, Unit& u) const {
        const long L = (long)i * G + c; if (L >= nwg) return false;
        int wgid = (int)L; { const int q = nwg / NXCD, r = nwg % NXCD, xcd = wgid % NXCD, off = wgid / NXCD; wgid = (xcd < r ? xcd * (q + 1) : r * (q + 1) + (xcd - r) * q) + off; }
        const int nig = WGM * nN, gid = wgid / nig, fm = gid * WGM, gsz = (nM - fm) < WGM ? (nM - fm) : WGM;
        u.pm = fm + ((wgid % nig) % gsz); u.pn = (wgid % nig) / gsz; return true;
    }
    __device__ __forceinline__ void a_ready(const Unit&) const {}
    __device__ __forceinline__ void done(const Unit&) const {}
};


DI u32x4 pack8f(const f32x4& a, const f32x4& b) { u32x4 w; w.x = pk2(a[0], a[1]); w.y = pk2(a[2], a[3]); w.z = pk2(b[0], b[1]); w.w = pk2(b[2], b[3]); return w; }

struct EpiIn {
    static constexpr bool PERM = true, AFTER_DRAIN = false;
    bf16_t* Z;
    __device__ __forceinline__ void operator()(const f32x4 (&acc)[2][2][4][2], const Unit& u, int wr, int wc, int fr, int fq) const {
        const int row0 = u.pm * BM + wr * 64 + fr, col0 = u.pn * BM + wc * 32 + 8 * fq;
        if (u.pn < 5 || u.pn > 12) {
#pragma unroll
            for (int ai = 0; ai < 2; ++ai)
#pragma unroll
                for (int m = 0; m < 4; ++m) { bf16_t* rowp = Z + (size_t)(row0 + ai * HALF + m * 16) * INW + col0;
#pragma unroll
                    for (int bj = 0; bj < 2; ++bj) *(u32x4*)(rowp + bj * HALF) = pack8f(acc[ai][bj][m][0], acc[ai][bj][m][1]); }
        } else {
            const int head = (u.pn - 5) & 3; const bool isk = u.pn >= 9;
            const float lg = log1pf(-exp2f(-5.0f - (float)head));
            float inv[8];
#pragma unroll
            for (int j = 0; j < 8; ++j) inv[j] = powf(10000.0f, -(float)(wc * 32 + 8 * fq + j) * (1.0f / 128.0f));
#pragma unroll
            for (int ai = 0; ai < 2; ++ai)
#pragma unroll
                for (int m = 0; m < 4; ++m) {
                    const int row = row0 + ai * HALF + m * 16;
                    const int pos = row < LP ? row : LP; const float t = row < LP ? (float)(row & 127) : 0.0f;
                    const float f = isk ? 0.0625f * __expf(-lg * t) : __expf(lg * t);
                    f32x4 o1[2], o2[2];
#pragma unroll
                    for (int n = 0; n < 2; ++n)
#pragma unroll
                        for (int e = 0; e < 4; ++e) {
                            const float ang = (float)pos * inv[n * 4 + e];
                            double rev = (double)ang * 0.15915494309189535; rev -= floor(rev);
                            const float fr_ = (float)rev; const float sn = __builtin_amdgcn_sinf(fr_), cs = __builtin_amdgcn_cosf(fr_);
                            const float x1 = acc[ai][0][m][n][e], x2 = acc[ai][1][m][n][e];
                            o1[n][e] = (x1 * cs - x2 * sn) * f; o2[n][e] = (x2 * cs + x1 * sn) * f;
                        }
                    bf16_t* rowp = Z + (size_t)row * INW + col0;
                    *(u32x4*)(rowp) = pack8f(o1[0], o1[1]); *(u32x4*)(rowp + HALF) = pack8f(o2[0], o2[1]);
                }
        }
    }
};

struct EpiOut {
    static constexpr bool PERM = true, AFTER_DRAIN = false;
    const float* xp; const float* xs; float* X1; bf16_t* XG; const float* g2; float* part;
    __device__ __forceinline__ void operator()(const f32x4 (&acc)[2][2][4][2], const Unit& u, int wr, int wc, int fr, int fq) const {
#pragma unroll
        for (int ai = 0; ai < 2; ++ai) {
            const int rbase = u.pm * BM + ai * HALF; const bool valid = rbase < MR;
#pragma unroll
            for (int m = 0; m < 4; ++m) {
                const int row = rbase + wr * 64 + m * 16 + fr;
                const float* xrow = row < LP ? xp + (size_t)row * DM : xs + (size_t)(row - LP) * DM;
                float ss = 0.f;
#pragma unroll
                for (int bj = 0; bj < 2; ++bj) {
                    const int col = u.pn * BM + bj * HALF + wc * 32 + 8 * fq;
                    f32x4 v0 = {0.f, 0.f, 0.f, 0.f}, v1 = {0.f, 0.f, 0.f, 0.f};
                    if (valid) { v0 = acc[ai][bj][m][0] + *(const f32x4*)(xrow + col); v1 = acc[ai][bj][m][1] + *(const f32x4*)(xrow + col + 4);
                        *(f32x4*)(X1 + (size_t)row * DM + col) = v0; *(f32x4*)(X1 + (size_t)row * DM + col + 4) = v1; }
                    ss += (v0[0] * v0[0] + v0[1] * v0[1]) + (v0[2] * v0[2] + v0[3] * v0[3]) + (v1[0] * v1[0] + v1[1] * v1[1]) + (v1[2] * v1[2] + v1[3] * v1[3]);
                    const f32x4 ga = *(const f32x4*)(g2 + col), gb = *(const f32x4*)(g2 + col + 4);
                    *(u32x4*)(XG + (size_t)row * DM + col) = pack8f(v0 * ga, v1 * gb);
                }
                ss += __shfl_xor(ss, 16); ss += __shfl_xor(ss, 32);
                if (fq == 0) part[(size_t)row * 32 + u.pn * 4 + wc] = ss;
            }
        }
    }
};

struct EpiUp {
    static constexpr bool PERM = true, AFTER_DRAIN = false;
    bf16_t* U;
    __device__ __forceinline__ void operator()(const f32x4 (&acc)[2][2][4][2], const Unit& u, int wr, int wc, int fr, int fq) const {
        const int row0 = u.pm * BM + wr * 64 + fr, col0 = u.pn * BM + wc * 32 + 8 * fq;
#pragma unroll
        for (int ai = 0; ai < 2; ++ai)
#pragma unroll
            for (int m = 0; m < 4; ++m) { bf16_t* rowp = U + (size_t)(row0 + ai * HALF + m * 16) * FF + col0;
#pragma unroll
                for (int bj = 0; bj < 2; ++bj) { f32x4 a = acc[ai][bj][m][0], b = acc[ai][bj][m][1];
#pragma unroll
                    for (int e = 0; e < 4; ++e) { a[e] = fmaxf(a[e], 0.f); a[e] *= a[e]; b[e] = fmaxf(b[e], 0.f); b[e] *= b[e]; }
                    *(u32x4*)(rowp + bj * HALF) = pack8f(a, b); } }
    }
};

struct EpiDown {
    static constexpr bool PERM = true, AFTER_DRAIN = false;
    float* Y; const float* rstd2;
    __device__ __forceinline__ void operator()(const f32x4 (&acc)[2][2][4][2], const Unit& u, int wr, int wc, int fr, int fq) const {
#pragma unroll
        for (int ai = 0; ai < 2; ++ai) {
            const int rbase = u.pm * BM + ai * HALF; if (rbase >= MR) continue;
#pragma unroll
            for (int m = 0; m < 4; ++m) {
                const int row = rbase + wr * 64 + m * 16 + fr; const float r2 = rstd2[row];
#pragma unroll
                for (int bj = 0; bj < 2; ++bj) { float* p = Y + (size_t)row * DM + u.pn * BM + bj * HALF + wc * 32 + 8 * fq;
                    const f32x4 a = *(const f32x4*)p, b = *(const f32x4*)(p + 4);
                    *(f32x4*)p = a + acc[ai][bj][m][0] * r2; *(f32x4*)(p + 4) = b + acc[ai][bj][m][1] * r2; }
            }
        }
    }
};
template <class Epi, class Sched, bool ALIGN_EPI = false, bool SP2 = false>
__device__ __forceinline__ void gemm_phase(PG8_LAS unsigned char* lds, const Gemm g, const Sched& S, const Epi& E) {
    const int tid = threadIdx.x, wid = __builtin_amdgcn_readfirstlane(tid >> 6), lane = tid & 63, wr = wid >> 2, wc = wid & 3, fr = lane & 15, fq = lane >> 4;
    const int K = g.K, nt = K / BK;
    unsigned voffA[2], voffB[2];
#pragma unroll
    for (int i = 0; i < 2; ++i) { int R, C; stage_rc(tid * 16 + i * 8192, R, C); const int Rb = Epi::PERM ? ((R & ~31) + perm32(R & 31)) : R;
        voffA[i] = (unsigned)(R * K + C) * 2u; voffB[i] = (unsigned)(Rb * K + C) * 2u; }
    const size_t kstep = (size_t)(BK * 2);
    const size_t hstep = (size_t)HALF * K * 2;
    const size_t tstep = 2 * hstep;
    const unsigned ldsw = (unsigned)wid * 1024u;
    const int aoff = lds_byte(wr * 64 + fr, fq * 8), boff = lds_byte(wc * 32 + fr, fq * 8);
#define PG8_SA(b, h) (((b) * 2 + (h)) * HTB)
#define PG8_SB(b, h) ((4 + (b) * 2 + (h)) * HTB)
#define PG8_STAGE(bufoff, gbase, voff) do { _Pragma("unroll") for (int _i = 0; _i < 2; ++_i) \
        __builtin_amdgcn_global_load_lds((const unsigned*)((const char*)(gbase) + (voff)[_i]), (PG8_LAS unsigned*)(lds + (bufoff) + ldsw + _i * 8192), 16, 0, 0); } while (0)
#define PG8_LDA(dst, b, h) do { _Pragma("unroll") for (int m = 0; m < 4; ++m) _Pragma("unroll") for (int k = 0; k < 2; ++k) dst[m][k] = *(const PG8_LAS bf16x8*)(lds + PG8_SA(b, h) + aoff + m * 2048 + k * 1024); } while (0)
#define PG8_LDB(dst, b, h) do { _Pragma("unroll") for (int n = 0; n < 2; ++n) _Pragma("unroll") for (int k = 0; k < 2; ++k) dst[n][k] = *(const PG8_LAS bf16x8*)(lds + PG8_SB(b, h) + boff + n * 2048 + k * 1024); } while (0)
#define PG8_MMA(ai, bj, At, Bt) do { __builtin_amdgcn_s_setprio(1); _Pragma("unroll") for (int m = 0; m < 4; ++m) _Pragma("unroll") for (int n = 0; n < 2; ++n) _Pragma("unroll") for (int k = 0; k < 2; ++k) \
        acc[ai][bj][m][n] = __builtin_amdgcn_mfma_f32_16x16x32_bf16(Bt[n][k], At[m][k], acc[ai][bj][m][n], 0, 0, 0); __builtin_amdgcn_s_setprio(0); } while (0)
#define PG8_WAIT_V(n) asm volatile("s_waitcnt vmcnt(" #n ")" ::: "memory")
#define PG8_WAIT_L(n) asm volatile("s_waitcnt lgkmcnt(" #n ")" ::: "memory")
#define PG8_BAR __builtin_amdgcn_s_barrier()
#define PG8_SCHED __builtin_amdgcn_sched_barrier(0)
    Unit cur, nxt; int ui = 0;
    if (!S.next(0, cur)) return;
    f32x4 acc[2][2][4][2];
#pragma unroll
    for (int a = 0; a < 2; ++a)
#pragma unroll
        for (int b = 0; b < 2; ++b)
#pragma unroll
            for (int m = 0; m < 4; ++m)
#pragma unroll
                for (int n = 0; n < 2; ++n) acc[a][b][m][n] = (f32x4){0.f, 0.f, 0.f, 0.f};
    bf16x8 At[4][2], B0[2][2], B1[2][2];
    const char* cA = (const char*)g.A + (size_t)cur.pm * tstep; const char* cB = (const char*)g.Bt + (size_t)cur.pn * tstep;
    S.a_ready(cur);
    if constexpr (SP2) {
        PG8_STAGE(PG8_SB(0, 0), cB, voffB); PG8_STAGE(PG8_SB(0, 1), cB + hstep, voffB); PG8_STAGE(PG8_SA(0, 0), cA, voffA); PG8_STAGE(PG8_SA(0, 1), cA + hstep, voffA);
        if (wr == 1) PG8_BAR;
        PG8_WAIT_V(2); PG8_BAR;
        PG8_STAGE(PG8_SB(1, 0), cB + kstep, voffB); PG8_STAGE(PG8_SA(1, 0), cA + kstep, voffA); PG8_STAGE(PG8_SB(1, 1), cB + hstep + kstep, voffB);
        PG8_WAIT_V(6); PG8_BAR;
    } else {
        PG8_STAGE(PG8_SB(0, 0), cB, voffB); PG8_STAGE(PG8_SA(0, 0), cA, voffA); PG8_STAGE(PG8_SB(0, 1), cB + hstep, voffB); PG8_STAGE(PG8_SA(0, 1), cA + hstep, voffA);
        if (wr == 1) PG8_BAR;
        PG8_WAIT_V(4); PG8_BAR;
        PG8_STAGE(PG8_SB(1, 0), cB + kstep, voffB); PG8_STAGE(PG8_SA(1, 0), cA + kstep, voffA); PG8_STAGE(PG8_SB(1, 1), cB + hstep + kstep, voffB);
        PG8_WAIT_V(6); PG8_BAR;
    }
    for (;;) {
        const bool has_next = S.next(ui + 1, nxt);
        const char* nA = has_next ? (const char*)g.A + (size_t)nxt.pm * tstep : cA; const char* nB = has_next ? (const char*)g.Bt + (size_t)nxt.pn * tstep : cB;
        for (int t = 0; t < nt; t += 2) {
            const bool last = (t == nt - 2);
            const char* a1 = cA + (size_t)(t + 1) * kstep;
            const char* a2 = last ? nA : cA + (size_t)(t + 2) * kstep; const char* b2 = last ? nB : cB + (size_t)(t + 2) * kstep;
            const char* a3 = a2 + kstep; const char* b3 = b2 + kstep;
            if (last && has_next) S.a_ready(nxt);
            if constexpr (SP2) {
            PG8_LDB(B0, 0, 0); PG8_LDB(B1, 0, 1); PG8_SCHED; PG8_LDA(At, 0, 0); PG8_STAGE(PG8_SA(1, 1), a1 + hstep, voffA);
            PG8_WAIT_V(8); PG8_WAIT_L(0); PG8_BAR; PG8_MMA(0, 0, At, B0); PG8_MMA(0, 1, At, B1); PG8_BAR; PG8_SCHED;
            PG8_LDA(At, 0, 1); PG8_STAGE(PG8_SB(0, 0), b2, voffB); PG8_STAGE(PG8_SB(0, 1), b2 + hstep, voffB); PG8_STAGE(PG8_SA(0, 0), a2, voffA);
            PG8_WAIT_V(8); PG8_WAIT_L(0); PG8_BAR; PG8_MMA(1, 0, At, B0); PG8_MMA(1, 1, At, B1); PG8_BAR; PG8_SCHED;
            PG8_LDB(B0, 1, 0); PG8_LDB(B1, 1, 1); PG8_SCHED; PG8_LDA(At, 1, 0); PG8_STAGE(PG8_SA(0, 1), a2 + hstep, voffA);
            PG8_WAIT_V(8); PG8_WAIT_L(0); PG8_BAR; PG8_MMA(0, 0, At, B0); PG8_MMA(0, 1, At, B1); PG8_BAR; PG8_SCHED;
            PG8_LDA(At, 1, 1); PG8_STAGE(PG8_SB(1, 0), b3, voffB); PG8_STAGE(PG8_SB(1, 1), b3 + hstep, voffB); PG8_STAGE(PG8_SA(1, 0), a3, voffA);
            PG8_WAIT_V(8); PG8_WAIT_L(0); PG8_BAR; PG8_MMA(1, 0, At, B0); PG8_MMA(1, 1, At, B1); PG8_BAR; PG8_SCHED;
            } else {
            PG8_LDB(B0, 0, 0); PG8_SCHED; PG8_LDA(At, 0, 0); PG8_STAGE(PG8_SA(1, 1), a1 + hstep, voffA);
            PG8_WAIT_L(8); PG8_BAR; PG8_WAIT_L(0); PG8_MMA(0, 0, At, B0); PG8_BAR; PG8_SCHED;
            PG8_LDB(B1, 0, 1); PG8_STAGE(PG8_SB(0, 0), b2, voffB);
            PG8_BAR; PG8_WAIT_L(0); PG8_MMA(0, 1, At, B1); PG8_BAR;
            PG8_LDA(At, 0, 1); PG8_STAGE(PG8_SA(0, 0), a2, voffA);
            PG8_BAR; PG8_WAIT_L(0); PG8_MMA(1, 0, At, B0); PG8_BAR; PG8_SCHED;
            PG8_STAGE(PG8_SB(0, 1), b2 + hstep, voffB);
            PG8_WAIT_V(6); PG8_BAR; PG8_MMA(1, 1, At, B1); PG8_BAR;
            PG8_LDB(B0, 1, 0); PG8_SCHED; PG8_LDA(At, 1, 0); PG8_STAGE(PG8_SA(0, 1), a2 + hstep, voffA);
            PG8_WAIT_L(8); PG8_BAR; PG8_WAIT_L(0); PG8_MMA(0, 0, At, B0); PG8_BAR; PG8_SCHED;
            PG8_LDB(B1, 1, 1); PG8_STAGE(PG8_SB(1, 0), b3, voffB);
            PG8_BAR; PG8_WAIT_L(0); PG8_MMA(0, 1, At, B1); PG8_BAR;
            PG8_LDA(At, 1, 1); PG8_STAGE(PG8_SA(1, 0), a3, voffA);
            PG8_BAR; PG8_WAIT_L(0); PG8_MMA(1, 0, At, B0); PG8_BAR; PG8_SCHED;
            PG8_STAGE(PG8_SB(1, 1), b3 + hstep, voffB);
            PG8_WAIT_V(6); PG8_BAR; PG8_MMA(1, 1, At, B1); PG8_BAR;
            }
        }
        if constexpr (ALIGN_EPI) { if (wr == 0) PG8_BAR; }
        if constexpr (!Epi::AFTER_DRAIN) { E(acc, cur, wr, wc, fr, fq); S.done(cur); }
        if (!has_next) break;
#pragma unroll
        for (int a = 0; a < 2; ++a)
#pragma unroll
            for (int b = 0; b < 2; ++b)
#pragma unroll
                for (int m = 0; m < 4; ++m)
#pragma unroll
                    for (int n = 0; n < 2; ++n) acc[a][b][m][n] = (f32x4){0.f, 0.f, 0.f, 0.f};
        cur = nxt; cA = nA; cB = nB; ++ui;
        if constexpr (ALIGN_EPI) { if (wr == 1) PG8_BAR; }
    }
    PG8_WAIT_V(0);
    if constexpr (!ALIGN_EPI) { if (wr == 0) PG8_BAR; }
    PG8_BAR;
    if constexpr (Epi::AFTER_DRAIN) { E.fused(acc, cur, wr, wc, fr, fq, lds, wid, lane); S.done(cur); }
#undef PG8_SA
#undef PG8_SB
#undef PG8_STAGE
#undef PG8_LDA
#undef PG8_LDB
#undef PG8_MMA
#undef PG8_WAIT_V
#undef PG8_WAIT_L
#undef PG8_BAR
#undef PG8_SCHED
}
}

using pg8::bf16_t; using pg8::bf16x8; using pg8::f32x4; using pg8::u32x4;
#define MFMA32(a, b, c) __builtin_amdgcn_mfma_f32_32x32x16_bf16((a), (b), (c), 0, 0, 0)
DI int crow(int reg, int h) { return (reg & 3) + 8 * (reg >> 2) + 4 * h; }
DI float wave_sum(float v) {
#pragma unroll
    for (int o = 1; o < 64; o <<= 1) v += __shfl_xor(v, o);
    return v;
}
DI float wave_max(float v) {
#pragma unroll
    for (int o = 1; o < 64; o <<= 1) v = fmaxf(v, __shfl_xor(v, o));
    return v;
}
DI bf16x8 pack8(const f32x16& x, int s) { u32x4 p; p.x = pk2(x[8 * s], x[8 * s + 1]); p.y = pk2(x[8 * s + 2], x[8 * s + 3]); p.z = pk2(x[8 * s + 4], x[8 * s + 5]); p.w = pk2(x[8 * s + 6], x[8 * s + 7]); return __builtin_bit_cast(bf16x8, p); }
DI bf16x8 cat4(s16x4 lo, s16x4 hi) { return __builtin_shufflevector(lo, hi, 0, 1, 2, 3, 4, 5, 6, 7); }
DI f32x16 zero16() { f32x16 z;
#pragma unroll
    for (int i = 0; i < 16; ++i) z[i] = 0.f;
    return z; }
DI float gamma_of(int h) { return 1.0f - exp2f(-5.0f - (float)h); }

constexpr size_t MiB = 1u << 20;
constexpr size_t WS_WIN = 1 * MiB;
constexpr size_t WS_WOUT = 23 * MiB;
constexpr size_t WS_WUP = 31 * MiB;
constexpr size_t WS_WDN = 63 * MiB;
constexpr size_t WS_H1 = 95 * MiB;
constexpr size_t WS_MIX = 128 * MiB;
constexpr size_t WS_PART = 161 * MiB;
constexpr size_t WS_RSTD2 = 163 * MiB;
constexpr size_t WS_Z = 164 * MiB;
constexpr size_t WS_KV = 252 * MiB;
constexpr size_t WS_SP = 316 * MiB;
constexpr size_t WS_U = 164 * MiB;
constexpr size_t WS_END = 348 * MiB;
static_assert(WS_Z + (size_t)MP * INW * 2 <= WS_KV && WS_U + (size_t)MP * FF * 2 <= WS_END && WS_H1 + (size_t)MP * DM * 2 <= WS_MIX && WS_MIX + (size_t)MP * DM * 2 <= WS_PART, "ws map");
constexpr int LDS_BYTES = 147456;

constexpr size_t O_Y = 0, O_KP = (size_t)MR * DM, O_VP = O_KP + 16384, O_SP = O_VP + 16384, O_KS = O_SP + 262144, O_VS = O_KS + 2097152, O_SS = O_VS + 2097152, O_END = O_SS + 33554432;

struct TItem { const float* W; bf16_t* WT; int K, N, item; };
DI void p0_load(const TItem& t, f32x4 (&v)[8], int lane) {
    const int nblk = t.N / 32, kb = t.item / nblk, nb = t.item % nblk, k0 = 64 * kb, n0 = 32 * nb, c = lane & 7, rr = lane >> 3;
#pragma unroll
    for (int i = 0; i < 8; ++i) v[i] = __builtin_nontemporal_load((const f32x4*)(t.W + (size_t)(k0 + 8 * i + rr) * t.N + n0 + 4 * c));
}
DI void p0_store(const TItem& t, const f32x4 (&v)[8], LAS float* scr, int lane) {
    const int nblk = t.N / 32, kb = t.item / nblk, nb = t.item % nblk, k0 = 64 * kb, n0 = 32 * nb, c = lane & 7, rr = lane >> 3;
#pragma unroll
    for (int i = 0; i < 8; ++i) { LAS float* d = scr + (8 * i + rr) * 33 + 4 * c; d[0] = v[i][0]; d[1] = v[i][1]; d[2] = v[i][2]; d[3] = v[i][3]; }
    asm volatile("s_waitcnt lgkmcnt(0)" ::: "memory");
#pragma unroll
    for (int j = 0; j < 4; ++j) { const int n = (lane >> 3) + 8 * j; const LAS float* s = scr + (8 * c) * 33 + n;
        u32x4 o; o.x = pk2(s[0 * 33], s[1 * 33]); o.y = pk2(s[2 * 33], s[3 * 33]); o.z = pk2(s[4 * 33], s[5 * 33]); o.w = pk2(s[6 * 33], s[7 * 33]);
        *(u32x4*)(t.WT + (size_t)(n0 + n) * t.K + k0 + 8 * c) = o; }
    asm volatile("s_waitcnt lgkmcnt(0)" ::: "memory");
}
struct ResIn { const float* w; bf16_t* wt; DI TItem operator()(int it) const { return TItem{w, wt, DM, INW, it}; } };
struct ResRest { const float* w_out; const float* w_up; const float* w_dn; bf16_t* WOUT; bf16_t* WUP; bf16_t* WDN;
    DI TItem operator()(int it) const { constexpr int I_OUT = (DM / 64) * (DM / 32), I_UP = (DM / 64) * (FF / 32); int r = it;
        if (r < I_OUT) return TItem{w_out, WOUT, DM, DM, r}; r -= I_OUT;
        if (r < I_UP) return TItem{w_up, WUP, DM, FF, r}; r -= I_UP;
        return TItem{w_dn, WDN, FF, DM, r}; } };
template <class Resolve>
DI void p0_convert(const Resolve R, int first, int stride, int total, LAS float* scr, int lane) {
    for (int it = first; it < total; it += 2 * stride) {
        const bool two = it + stride < total;
        const TItem t0 = R(it), t1 = R(two ? it + stride : it);
        f32x4 v0[8], v1[8];
        p0_load(t0, v0, lane);
        if (two) p0_load(t1, v1, lane);
        p0_store(t0, v0, scr, lane);
        if (two) p0_store(t1, v1, scr + 64 * 33, lane);
    }
}
DI void rms_row(const float* xrow, const float* g, bf16_t* orow, int lane) {
    f32x4 v[8]; float s = 0.f;
#pragma unroll
    for (int j = 0; j < 8; ++j) { v[j] = *((const f32x4*)xrow + lane + 64 * j); s += (v[j][0] * v[j][0] + v[j][1] * v[j][1]) + (v[j][2] * v[j][2] + v[j][3] * v[j][3]); }
    const float rstd = rsqrtf(wave_sum(s) * (1.0f / DM) + EPS);
#pragma unroll
    for (int j = 0; j < 8; ++j) { const f32x4 gg = *((const f32x4*)g + lane + 64 * j); u32x2 o; o.x = pk2(v[j][0] * rstd * gg[0], v[j][1] * rstd * gg[1]); o.y = pk2(v[j][2] * rstd * gg[2], v[j][3] * rstd * gg[3]);
        *((u32x2*)orow + lane + 64 * j) = o; }
}

DI void stage_T128x256(LAS unsigned char* img, const bf16_t* src, int tid) {
#pragma unroll
    for (int k = 0; k < 4; ++k) {
        const int it = k * 512 + tid, dgl = it & 3, tpl = (it >> 2) & 15, rest = it >> 6, dg = dgl + 4 * (rest & 7), tp = tpl + 16 * (rest >> 3);
        const bf16_t* p = src + (size_t)(2 * tp) * INW + dg * 8;
        const u32x4 a = *(const u32x4*)p, b = *(const u32x4*)(p + INW);
#pragma unroll
        for (int e = 0; e < 8; ++e) {
            const unsigned lo = (e & 1) ? (a[e >> 1] >> 16) : (a[e >> 1] & 0xffffu), hi = (e & 1) ? (b[e >> 1] & 0xffff0000u) : (b[e >> 1] << 16);
            *(LAS unsigned*)(img + (dg * 8 + e) * 264 + tp * 4) = lo | hi;
        }
    }
}

DI void ret_step1(LAS unsigned char* lds, const bf16_t* Z, bf16_t* KV, int n, int h, int tid) {
    LAS unsigned char* Kt = lds; LAS unsigned char* Vt = lds + 256 * 264;
    const int lane = tid & 63, wid = tid >> 6, r = lane & 31, hh = lane >> 5;
    stage_T128x256(Kt, Z + (size_t)(n * 128) * INW + C_RK + h * 256, tid);
    stage_T128x256(Vt, Z + (size_t)(n * 128) * INW + C_RV + h * 256, tid);
    __syncthreads();
    f32x16 acc[8];
#pragma unroll
    for (int i = 0; i < 8; ++i) acc[i] = zero16();
    const int dk0 = wid * 32;
#pragma unroll 2
    for (int s = 0; s < 8; ++s) {
        const LAS unsigned char* pa = Kt + (dk0 + r) * 264 + (16 * s + 8 * hh) * 2;
        const bf16x8 A = cat4(*(const LAS s16x4*)pa, *(const LAS s16x4*)(pa + 8));
#pragma unroll
        for (int dt = 0; dt < 8; ++dt) {
            const LAS unsigned char* pb = Vt + (dt * 32 + r) * 264 + (16 * s + 8 * hh) * 2;
            const bf16x8 B = cat4(*(const LAS s16x4*)pb, *(const LAS s16x4*)(pb + 8));
            acc[dt] = MFMA32(A, B, acc[dt]);
        }
    }
    bf16_t* out = KV + ((size_t)(n * 4 + h) * 256) * 256 + dk0 + 4 * hh;
#pragma unroll
    for (int dt = 0; dt < 8; ++dt)
#pragma unroll
        for (int g4 = 0; g4 < 4; ++g4) { u32x2 o; o.x = pk2(acc[dt][4 * g4], acc[dt][4 * g4 + 1]); o.y = pk2(acc[dt][4 * g4 + 2], acc[dt][4 * g4 + 3]);
            *(u32x2*)(out + (size_t)(dt * 32 + r) * 256 + 8 * g4) = o; }
    __syncthreads();
}

DI void ret_scan(const bf16_t* KV, bf16_t* SP, float* o_state, int gt, int nthreads) {
    for (int e = gt; e < 65536; e += nthreads) {
        const int h = e >> 14, dv = (e >> 6) & 255, dk4 = (e & 63) * 4;
        const float lg = log1pf(-exp2f(-5.0f - (float)h)), Dc = __expf(128.0f * lg), c1 = __expf(127.0f * lg);
        const size_t base = ((size_t)(h * 256 + dv)) * 256 + dk4;
        f32x4 s = {0.f, 0.f, 0.f, 0.f};
        for (int n0 = 0; n0 < 64; n0 += 32) {
            u32x2 q[32];
#pragma unroll
            for (int u = 0; u < 32; ++u) q[u] = *(const u32x2*)(KV + (size_t)(n0 + u) * 262144 + base);
#pragma unroll
            for (int u = 0; u < 32; ++u) { u32x2 o; o.x = pk2(s[0], s[1]); o.y = pk2(s[2], s[3]); *(u32x2*)(SP + (size_t)(n0 + u) * 262144 + base) = o;
                const f32x4 kv = {bflo(q[u].x), bfhi(q[u].x), bflo(q[u].y), bfhi(q[u].y)}; s = s * Dc + kv * c1; }
        }
#pragma unroll
        for (int j = 0; j < 4; ++j) o_state[((size_t)(h * 256 + dk4 + j)) * 256 + dv] = s[j];
    }
}

DI float silu_f(float x) { return x / (1.0f + __expf(-x)); }

DI void ret_step2(LAS unsigned char* lds, const bf16_t* Z, const bf16_t* SP, bf16_t* MIX, const float* rng, int n, int h, int tid) {
    LAS unsigned char* Kr = lds; LAS unsigned char* Vt = lds + 128 * 528; LAS float* red = (LAS float*)(lds + 128 * 528 + 256 * 264);
    const int lane = tid & 63, wid = tid >> 6, r = lane & 31, hh = lane >> 5;
    const bf16_t* zc = Z + (size_t)(n * 128) * INW;
#pragma unroll
    for (int k = 0; k < 8; ++k) { const int it = k * 512 + tid, row = it >> 5, c = it & 31;
        *(LAS u32x4*)(Kr + row * 528 + c * 16) = *(const u32x4*)(zc + (size_t)row * INW + C_RK + h * 256 + c * 8); }
    stage_T128x256(Vt, zc + C_RV + h * 256, tid);
    const int it_ = wid >> 1, dh = wid & 1;
    bf16x8 qf[16];
    { const bf16_t* qp = zc + (size_t)(32 * it_ + r) * INW + C_RQ + h * 256 + 8 * hh;
#pragma unroll
      for (int s = 0; s < 16; ++s) qf[s] = *(const bf16x8*)(qp + 16 * s); }
    f32x16 acc[4];
#pragma unroll
    for (int i = 0; i < 4; ++i) acc[i] = zero16();
    const float gm = gamma_of(h);
    __syncthreads();
    for (int jt = 0; jt <= it_; ++jt) {
        f32x16 X = zero16();
#pragma unroll
        for (int s = 0; s < 16; ++s) { const bf16x8 A = *(const LAS bf16x8*)(Kr + (32 * jt + r) * 528 + (16 * s + 8 * hh) * 2); X = MFMA32(A, qf[s], X); }
        if (jt == it_) {
#pragma unroll
            for (int i = 0; i < 16; ++i) X[i] = (crow(i, hh) > r) ? 0.f : X[i];
        }
#pragma unroll
        for (int s2 = 0; s2 < 2; ++s2) { const bf16x8 xs = pack8(X, s2);
#pragma unroll
            for (int dt = 0; dt < 4; ++dt) { const LAS unsigned char* pa = Vt + (128 * dh + 32 * dt + r) * 264 + (32 * jt + 16 * s2 + 4 * hh) * 2;
                const bf16x8 A = cat4(*(const LAS s16x4*)pa, *(const LAS s16x4*)(pa + 16)); acc[dt] = MFMA32(A, xs, acc[dt]); } }
    }
    { const float ig = 1.0f / gm;
#pragma unroll
      for (int dt = 0; dt < 4; ++dt) acc[dt] = acc[dt] * ig; }
    __syncthreads();
    { const bf16_t* spg = SP + (size_t)(n * 4 + h) * 65536;
#pragma unroll 1
      for (int k0 = 0; k0 < 16; k0 += 4) {
          u32x4 spr[4];
#pragma unroll
          for (int k = 0; k < 4; ++k) { const int it = (k0 + k) * 512 + tid; spr[k] = *(const u32x4*)(spg + (size_t)(it >> 5) * 256 + (it & 31) * 8); }
#pragma unroll
          for (int k = 0; k < 4; ++k) { const int it = (k0 + k) * 512 + tid; *(LAS u32x4*)(lds + (it >> 5) * 528 + (it & 31) * 16) = spr[k]; }
      } }
    __syncthreads();
#pragma unroll
    for (int dt = 0; dt < 4; ++dt)
#pragma unroll
        for (int s = 0; s < 16; ++s) { const bf16x8 A = *(const LAS bf16x8*)(lds + (128 * dh + 32 * dt + r) * 528 + (16 * s + 8 * hh) * 2); acc[dt] = MFMA32(A, qf[s], acc[dt]); }
#pragma unroll
    for (int dt = 0; dt < 4; ++dt) acc[dt] = acc[dt] * gm;
    float ss = 0.f;
#pragma unroll
    for (int dt = 0; dt < 4; ++dt)
#pragma unroll
        for (int i = 0; i < 16; ++i) ss += acc[dt][i] * acc[dt][i];
    ss += __shfl_xor(ss, 32);
    if (hh == 0) red[wid * 32 + r] = ss;
    __syncthreads();
    const float rstd = rsqrtf((red[wid * 32 + r] + red[(wid ^ 1) * 32 + r]) * (1.0f / 256.0f) + EPS);
    const size_t token = (size_t)n * 128 + 32 * it_ + r;
#pragma unroll
    for (int dt = 0; dt < 4; ++dt)
#pragma unroll
        for (int g4 = 0; g4 < 4; ++g4) {
            const int dv = 128 * dh + 32 * dt + 8 * g4 + 4 * hh;
            const u32x2 gz = *(const u32x2*)(Z + token * INW + C_RG + h * 256 + dv);
            const f32x4 gn = *(const f32x4*)(rng + h * 256 + dv);
            const float y0 = acc[dt][4 * g4 + 0] * rstd * gn[0] * silu_f(bflo(gz.x)), y1 = acc[dt][4 * g4 + 1] * rstd * gn[1] * silu_f(bfhi(gz.x));
            const float y2 = acc[dt][4 * g4 + 2] * rstd * gn[2] * silu_f(bflo(gz.y)), y3 = acc[dt][4 * g4 + 3] * rstd * gn[3] * silu_f(bfhi(gz.y));
            u32x2 o; o.x = pk2(y0, y1); o.y = pk2(y2, y3);
            *(u32x2*)(MIX + token * DM + 1024 + h * 256 + dv) = o;
        }
    __syncthreads();
}

DI void ret_decode_unit(LAS unsigned char* lds, const bf16_t* Z, const float* S0, float* S1, bf16_t* MIX, const float* rng, int b, int h, int tid) {
    LAS float* qv = (LAS float*)lds; LAS float* red = qv + 768;
    const int lane = tid & 63, wid = tid >> 6;
    const bf16_t* zrow = Z + (size_t)(LP + b) * INW;
    if (tid < 256) { qv[tid] = bf2f(zrow[C_RQ + h * 256 + tid]); qv[256 + tid] = bf2f(zrow[C_RK + h * 256 + tid]); qv[512 + tid] = bf2f(zrow[C_RV + h * 256 + tid]); }
    __syncthreads();
    const float gm = gamma_of(h);
    const f32x4 v4 = *(const LAS f32x4*)(qv + 512 + 4 * lane);
    f32x4 acc = {0.f, 0.f, 0.f, 0.f};
    const size_t off = ((size_t)(b * 4 + h) * 256 + wid * 32) * 256 + 4 * lane;
    const float* s0 = S0 + off; float* s1 = S1 + off;
#pragma unroll 1
    for (int rr = 0; rr < 32; rr += 16) {
        f32x4 s[16];
#pragma unroll
        for (int u = 0; u < 16; ++u) s[u] = __builtin_nontemporal_load((const f32x4*)(s0 + (size_t)(rr + u) * 256));
#pragma unroll
        for (int u = 0; u < 16; ++u) { const int dk = wid * 32 + rr + u; const float kk = qv[256 + dk], qq = qv[dk];
            const f32x4 sn = s[u] * gm + v4 * kk; __builtin_nontemporal_store(sn, (f32x4*)(s1 + (size_t)(rr + u) * 256)); acc += sn * qq; }
    }
    *(LAS f32x4*)(red + wid * 256 + 4 * lane) = acc;
    __syncthreads();
    if (wid == 0) {
        f32x4 o = {0.f, 0.f, 0.f, 0.f};
#pragma unroll
        for (int w = 0; w < 8; ++w) o += *(const LAS f32x4*)(red + w * 256 + 4 * lane);
        const float ssq = wave_sum((o[0] * o[0] + o[1] * o[1]) + (o[2] * o[2] + o[3] * o[3]));
        const float rstd = rsqrtf(ssq * (1.0f / 256.0f) + EPS);
        const u32x2 gz = *(const u32x2*)(zrow + C_RG + h * 256 + 4 * lane);
        const f32x4 gn = *(const f32x4*)(rng + h * 256 + 4 * lane);
        u32x2 y; y.x = pk2(o[0] * rstd * gn[0] * silu_f(bflo(gz.x)), o[1] * rstd * gn[1] * silu_f(bfhi(gz.x)));
        y.y = pk2(o[2] * rstd * gn[2] * silu_f(bflo(gz.y)), o[3] * rstd * gn[3] * silu_f(bfhi(gz.y)));
        *(u32x2*)(MIX + (size_t)(LP + b) * DM + 1024 + h * 256 + 4 * lane) = y;
    }
    __syncthreads();
}

DI void attn_prompt_unit(LAS unsigned char* lds, const bf16_t* Z, bf16_t* MIX, const float* gq, const float* gk, const float* sinks, float* o_k, float* o_v, int nb, int kh, int hf, int tid) {
    LAS unsigned char* Kn = lds; LAS unsigned char* Vt = lds + 256 * 144;
    const int lane = tid & 63, wid = tid >> 6, r = lane & 31, hh = lane >> 5;
    {
        const int row = tid >> 1, half = tid & 1; const int tok = (nb - 1) * 128 + row;
        u32x4 v[4];
#pragma unroll
        for (int c = 0; c < 4; ++c) v[c] = (u32x4){0u, 0u, 0u, 0u};
        if (tok >= 0) {
#pragma unroll
            for (int c = 0; c < 4; ++c) v[c] = *(const u32x4*)(Z + (size_t)tok * INW + C_AK + kh * 64 + half * 32 + c * 8);
        }
        float f[32]; float ss = 0.f;
#pragma unroll
        for (int c = 0; c < 4; ++c)
#pragma unroll
            for (int e = 0; e < 4; ++e) { f[c * 8 + 2 * e] = bflo(v[c][e]); f[c * 8 + 2 * e + 1] = bfhi(v[c][e]); }
#pragma unroll
        for (int e = 0; e < 32; ++e) ss += f[e] * f[e];
        ss += __shfl_xor(ss, 1);
        const float rstd = rsqrtf(ss * (1.0f / 64.0f) + EPS);
#pragma unroll
        for (int c = 0; c < 8; ++c) { const f32x4 g = *(const f32x4*)(gk + half * 32 + c * 4);
#pragma unroll
            for (int e = 0; e < 4; ++e) f[c * 4 + e] *= rstd * g[e]; }
#pragma unroll
        for (int c = 0; c < 4; ++c) { u32x4 w; w.x = pk2(f[c * 8], f[c * 8 + 1]); w.y = pk2(f[c * 8 + 2], f[c * 8 + 3]); w.z = pk2(f[c * 8 + 4], f[c * 8 + 5]); w.w = pk2(f[c * 8 + 6], f[c * 8 + 7]);
            *(LAS u32x4*)(Kn + row * 144 + half * 64 + c * 16) = w; }
        if (nb == 63 && hf == 0 && row >= 128) { float* o = o_k + ((size_t)(row - 128) * 2 + kh) * 64 + half * 32;
#pragma unroll
            for (int c = 0; c < 8; ++c) *(f32x4*)(o + c * 4) = (f32x4){f[c * 4], f[c * 4 + 1], f[c * 4 + 2], f[c * 4 + 3]}; }
    }
#pragma unroll
    for (int k = 0; k < 2; ++k) {
        const int it = k * 512 + tid, kpl = it & 15, dgl = (it >> 4) & 3, rest = it >> 6, dg = dgl + 4 * (rest & 1), kp = kpl + 16 * (rest >> 1);
        const int tok0 = (nb - 1) * 128 + 2 * kp;
        u32x4 a = {0u, 0u, 0u, 0u}, b = {0u, 0u, 0u, 0u};
        if (tok0 >= 0) { const bf16_t* p = Z + (size_t)tok0 * INW + C_AV + kh * 64 + dg * 8; a = *(const u32x4*)p; b = *(const u32x4*)(p + INW); }
#pragma unroll
        for (int e = 0; e < 8; ++e) {
            const unsigned lo = (e & 1) ? (a[e >> 1] >> 16) : (a[e >> 1] & 0xffffu), hi = (e & 1) ? (b[e >> 1] & 0xffff0000u) : (b[e >> 1] << 16);
            *(LAS unsigned*)(Vt + (dg * 8 + e) * 520 + kp * 4) = lo | hi;
        }
        if (nb == 63 && hf == 0 && kp >= 64) { float* o = o_v + ((size_t)(2 * kp - 128) * 2 + kh) * 64 + dg * 8;
#pragma unroll
            for (int e = 0; e < 4; ++e) { o[2 * e] = bflo(a[e]); o[2 * e + 1] = bfhi(a[e]); o[128 + 2 * e] = bflo(b[e]); o[128 + 2 * e + 1] = bfhi(b[e]); } }
    }
    __syncthreads();
    const int hq = kh * 8 + 4 * hf + (wid >> 1), qh = wid & 1;
    const float sink = sinks[hq];
#pragma unroll 1
    for (int qq = 0; qq < 2; ++qq) {
        const int qi = 2 * qh + qq; const size_t tokq = (size_t)nb * 128 + 32 * qi + r;
        bf16x8 qf[4];
        {   const bf16_t* qp = Z + tokq * INW + hq * 64 + 8 * hh;
            u32x4 raw[4]; float ss = 0.f;
#pragma unroll
            for (int s = 0; s < 4; ++s) { raw[s] = *(const u32x4*)(qp + 16 * s);
#pragma unroll
                for (int e = 0; e < 4; ++e) { const float lo = bflo(raw[s][e]), hi = bfhi(raw[s][e]); ss += lo * lo + hi * hi; } }
            ss += __shfl_xor(ss, 32);
            const float rstd = rsqrtf(ss * (1.0f / 64.0f) + EPS) * 0.125f;
#pragma unroll
            for (int s = 0; s < 4; ++s) { const f32x4 g0 = *(const f32x4*)(gq + 16 * s + 8 * hh), g1 = *(const f32x4*)(gq + 16 * s + 8 * hh + 4); u32x4 w;
                w.x = pk2(bflo(raw[s].x) * rstd * g0[0], bfhi(raw[s].x) * rstd * g0[1]); w.y = pk2(bflo(raw[s].y) * rstd * g0[2], bfhi(raw[s].y) * rstd * g0[3]);
                w.z = pk2(bflo(raw[s].z) * rstd * g1[0], bfhi(raw[s].z) * rstd * g1[1]); w.w = pk2(bflo(raw[s].w) * rstd * g1[2], bfhi(raw[s].w) * rstd * g1[3]);
                qf[s] = __builtin_bit_cast(bf16x8, w); }
        }
        f32x16 X[5];
#pragma unroll
        for (int t = 0; t < 5; ++t) { X[t] = zero16();
#pragma unroll
            for (int s = 0; s < 4; ++s) { const bf16x8 A = *(const LAS bf16x8*)(Kn + (32 * (qi + t) + r) * 144 + (16 * s + 8 * hh) * 2); X[t] = MFMA32(A, qf[s], X[t]); } }
        const int ii = 32 * qi + r;
        float m = -1e30f;
#pragma unroll
        for (int t = 0; t < 5; ++t)
#pragma unroll
            for (int i = 0; i < 16; ++i) { const int jj = 32 * (qi + t) + crow(i, hh); const bool ok = (jj >= ii) && (jj <= ii + 128) && (nb > 0 || jj >= 128);
                X[t][i] = ok ? X[t][i] : -1e30f; m = fmaxf(m, X[t][i]); }
        m = fmaxf(m, __shfl_xor(m, 32)); m = fmaxf(m, sink);
        float sum = 0.f;
#pragma unroll
        for (int t = 0; t < 5; ++t)
#pragma unroll
            for (int i = 0; i < 16; ++i) { const float p = __expf(X[t][i] - m); X[t][i] = p; sum += p; }
        sum += __shfl_xor(sum, 32);
        const float inv = 1.0f / (sum + __expf(sink - m));
        f32x16 o[2]; o[0] = zero16(); o[1] = zero16();
#pragma unroll
        for (int t = 0; t < 5; ++t)
#pragma unroll
            for (int s2 = 0; s2 < 2; ++s2) { const bf16x8 xs = pack8(X[t], s2);
#pragma unroll
                for (int dt = 0; dt < 2; ++dt) { const LAS unsigned char* pa = Vt + (32 * dt + r) * 520 + (32 * (qi + t) + 16 * s2 + 4 * hh) * 2;
                    const bf16x8 A = cat4(*(const LAS s16x4*)pa, *(const LAS s16x4*)(pa + 16)); o[dt] = MFMA32(A, xs, o[dt]); } }
#pragma unroll
        for (int dt = 0; dt < 2; ++dt)
#pragma unroll
            for (int g4 = 0; g4 < 4; ++g4) { u32x2 w; w.x = pk2(o[dt][4 * g4] * inv, o[dt][4 * g4 + 1] * inv); w.y = pk2(o[dt][4 * g4 + 2] * inv, o[dt][4 * g4 + 3] * inv);
                *(u32x2*)(MIX + tokq * DM + hq * 64 + 32 * dt + 8 * g4 + 4 * hh) = w; }
    }
    __syncthreads();
}

DI void attn_decode_unit(LAS unsigned char* lds, const bf16_t* Z, const float* ck, const float* cv, bf16_t* MIX, const float* gq, const float* gk, const float* sinks, float* o_k, float* o_v, int b, int kh, int tid) {
    LAS float* Kc = (LAS float*)lds; LAS float* Vc = Kc + 129 * 65; LAS float* qs = Vc + 129 * 64; LAS float* pw = qs + 512;
    const int lane = tid & 63, wid = tid >> 6;
#pragma unroll
    for (int k = 0; k < 4; ++k) {
        const int it = k * 512 + tid, w = it >> 4, c4 = (it & 15) * 4;
        const size_t src = ((size_t)(b * 128 + w) * 2 + kh) * 64 + c4;
        const f32x4 k4 = *(const f32x4*)(ck + src), v4 = *(const f32x4*)(cv + src);
#pragma unroll
        for (int e = 0; e < 4; ++e) { Kc[w * 65 + c4 + e] = k4[e]; Vc[w * 64 + c4 + e] = v4[e]; }
        if (w >= 1) { const size_t dst = ((size_t)(b * 128 + w - 1) * 2 + kh) * 64 + c4; *(f32x4*)(o_k + dst) = k4; *(f32x4*)(o_v + dst) = v4; }
    }
    const bf16_t* zrow = Z + (size_t)(LP + b) * INW;
    const size_t dnew = ((size_t)(b * 128 + 127) * 2 + kh) * 64 + lane;
    if (wid == 0) { const float kx = bf2f(zrow[C_AK + kh * 64 + lane]); const float ss = wave_sum(kx * kx); const float kn = kx * rsqrtf(ss * (1.0f / 64.0f) + EPS) * gk[lane];
        Kc[128 * 65 + lane] = kn; o_k[dnew] = kn; }
    if (wid == 1) { const float vx = bf2f(zrow[C_AV + kh * 64 + lane]); Vc[128 * 64 + lane] = vx; o_v[dnew] = vx; }
    const int hq = kh * 8 + wid;
    { const float qx = bf2f(zrow[hq * 64 + lane]); const float ss = wave_sum(qx * qx); qs[wid * 64 + lane] = qx * rsqrtf(ss * (1.0f / 64.0f) + EPS) * gq[lane] * 0.125f; }
    __syncthreads();
    float s1 = 0.f, s2 = 0.f;
#pragma unroll 8
    for (int d = 0; d < 64; ++d) { const float q = qs[wid * 64 + d]; s1 += q * Kc[lane * 65 + d]; s2 += q * Kc[(lane + 64) * 65 + d]; }
    const float s3 = wave_sum(qs[wid * 64 + lane] * Kc[128 * 65 + lane]);
    const float sink = sinks[hq];
    const float m = fmaxf(wave_max(fmaxf(s1, s2)), fmaxf(s3, sink));
    const float p1 = __expf(s1 - m), p2 = __expf(s2 - m), p3 = __expf(s3 - m);
    const float denom = wave_sum(p1 + p2) + p3 + __expf(sink - m);
    pw[wid * 132 + lane] = p1; pw[wid * 132 + 64 + lane] = p2; if (lane == 0) pw[wid * 132 + 128] = p3;
    __syncthreads();
    float o = 0.f;
#pragma unroll 3
    for (int j = 0; j < 129; ++j) o += pw[wid * 132 + j] * Vc[j * 64 + lane];
    MIX[(size_t)(LP + b) * DM + hq * 64 + lane] = (bf16_t)(pk2(o / denom, 0.f) & 0xffffu);
    __syncthreads();
}

template <class Epi>
DI void skinny_unit(LAS unsigned char* lds, const bf16_t* A, const bf16_t* Wt, int K, int cgi, int k0, const Epi& E, int tid) {
    const int lane = tid & 63, wid = tid >> 6, r = lane & 31, hh = lane >> 5;
    const int c0 = cgi * 32;
    const bf16_t* pa = A + (size_t)r * K + k0 + wid * 256 + 8 * hh;
    const bf16_t* pb = Wt + (size_t)(c0 + r) * K + k0 + wid * 256 + 8 * hh;
    const size_t rs = (size_t)32 * K;
    f32x16 acc[4];
#pragma unroll
    for (int i = 0; i < 4; ++i) acc[i] = zero16();
    bf16x8 fb[3][2], fa[3][2][4];
#define SK_LOAD(buf, c) do { _Pragma("unroll") for (int s = 0; s < 2; ++s) { fb[buf][s] = *(const bf16x8*)(pb + 32 * (c) + 16 * s); \
        _Pragma("unroll") for (int mt = 0; mt < 4; ++mt) fa[buf][s][mt] = *(const bf16x8*)(pa + mt * rs + 32 * (c) + 16 * s); } } while (0)
#define SK_MMA(buf) do { _Pragma("unroll") for (int s = 0; s < 2; ++s) _Pragma("unroll") for (int mt = 0; mt < 4; ++mt) acc[mt] = MFMA32(fa[buf][s][mt], fb[buf][s], acc[mt]); } while (0)
    SK_LOAD(0, 0); SK_LOAD(1, 1);
    SK_LOAD(2, 2); SK_MMA(0);
    SK_LOAD(0, 3); SK_MMA(1);
    SK_LOAD(1, 4); SK_MMA(2);
    SK_LOAD(2, 5); SK_MMA(0);
    SK_LOAD(0, 6); SK_MMA(1);
    SK_LOAD(1, 7); SK_MMA(2);
    SK_MMA(0); SK_MMA(1);
#undef SK_LOAD
#undef SK_MMA
    LAS float* red = (LAS float*)lds;
#pragma unroll
    for (int mt = 0; mt < 4; ++mt)
#pragma unroll
        for (int i = 0; i < 16; ++i) red[(wid * 128 + mt * 32 + crow(i, hh)) * 32 + r] = acc[mt][i];
    __syncthreads();
    const int row = tid >> 2, c8 = (tid & 3) * 8;
    f32x4 sa = {0.f, 0.f, 0.f, 0.f}, sb = {0.f, 0.f, 0.f, 0.f};
#pragma unroll
    for (int w = 0; w < 8; ++w) { sa += *(const LAS f32x4*)(red + (w * 128 + row) * 32 + c8); sb += *(const LAS f32x4*)(red + (w * 128 + row) * 32 + c8 + 4); }
    E(row, c0 + c8, sa); E(row, c0 + c8 + 4, sb);
    __syncthreads();
}
struct SkOut { const float* xs; float* X1s; bf16_t* XGs; const float* g2;
    DI void operator()(int row, int col, f32x4 a) const { const f32x4 v = a + *(const f32x4*)(xs + (size_t)row * DM + col); *(f32x4*)(X1s + (size_t)row * DM + col) = v;
        const f32x4 g = *(const f32x4*)(g2 + col); u32x2 o; o.x = pk2(v[0] * g[0], v[1] * g[1]); o.y = pk2(v[2] * g[2], v[3] * g[3]); *(u32x2*)(XGs + (size_t)row * DM + col) = o; } };
struct SkUp { bf16_t* Us;
    DI void operator()(int row, int col, f32x4 a) const {
#pragma unroll
        for (int e = 0; e < 4; ++e) { a[e] = fmaxf(a[e], 0.f); a[e] *= a[e]; }
        u32x2 o; o.x = pk2(a[0], a[1]); o.y = pk2(a[2], a[3]); *(u32x2*)(Us + (size_t)row * FF + col) = o; } };
struct SkSlab { float* slab;
    DI void operator()(int row, int col, f32x4 a) const { *(f32x4*)(slab + (size_t)row * DM + col) = a; } };

#define RLX_AGENT __ATOMIC_RELAXED, __HIP_MEMORY_SCOPE_AGENT
#define XB_TMO      128
#define XB_XCNT(j)  (256  + 64 * (j))
#define XB_XSUB(j)  (1280 + 64 * (j))
#define XB_XGEN(j)  (2304 + 64 * (j))
#define XB_TOP      3328
#define XB_TOPGEN   3392
#define XCD_BAR_WORDS 3456
#define XB_SPIN_CAP (1u << 18)

__device__ __forceinline__ unsigned xb_ld(unsigned* p)              { return __hip_atomic_load(p, __ATOMIC_RELAXED, __HIP_MEMORY_SCOPE_AGENT); }
__device__ __forceinline__ unsigned xb_add(unsigned* p, unsigned v) { return __hip_atomic_fetch_add(p, v, __ATOMIC_RELAXED, __HIP_MEMORY_SCOPE_AGENT); }
__device__ __forceinline__ unsigned xb_xcc_id() { return (unsigned)__builtin_amdgcn_s_getreg((3 << 11) | 20) & 0xFu; }
#define XB_SPIN(cond, bar) do { unsigned _sp = 0; while (cond) { __builtin_amdgcn_s_sleep(1); \
    if ((++_sp & 255u) == 0u) { if (xb_ld(&(bar)[XB_TMO])) break; if (_sp > XB_SPIN_CAP) { atomicAdd(&(bar)[XB_TMO], 1u); break; } } } } while (0)

struct XcdBarrier {
    unsigned* bar; unsigned x;
    volatile LAS unsigned* st;
};

__device__ __forceinline__ XcdBarrier xcd_barrier_post(unsigned* bar, volatile LAS unsigned* st) {
    XcdBarrier b; b.bar = bar; b.x = xb_xcc_id(); b.st = st;
    if (threadIdx.x == 0) (void)xb_add(&bar[XB_XCNT(b.x)], 1u);
    return b;
}
__device__ __forceinline__ void xcd_barrier_complete(unsigned* bar, unsigned x, unsigned& nloc, unsigned& nx) {
    const unsigned G = gridDim.x * gridDim.y * gridDim.z;
    unsigned sum, cnt, mine, sp = 0u;
    for (;;) {
        sum = 0u; cnt = 0u; mine = 0u;
#pragma unroll
        for (unsigned j = 0; j < 16; ++j) { const unsigned c = xb_ld(&bar[XB_XCNT(j)]); sum += c; cnt += (c > 0u) ? 1u : 0u; mine = (j == x) ? c : mine; }
        if (sum == G) break;
        __builtin_amdgcn_s_sleep(1);
        if ((++sp & 255u) == 0u) { if (xb_ld(&bar[XB_TMO])) break; if (sp > XB_SPIN_CAP) { atomicAdd(&bar[XB_TMO], 1u); break; } }
    }
    nloc = mine > 0u ? mine : 1u; nx = cnt > 0u ? cnt : 1u;
}

__device__ __forceinline__ void xcd_barrier(const XcdBarrier& b) {
    asm volatile("s_waitcnt vmcnt(0)" ::: "memory");
    __syncthreads();
    if (threadIdx.x == 0) {
        unsigned* bar = b.bar;
        __builtin_amdgcn_s_waitcnt(0);
        unsigned nloc = b.st[0], nx = b.st[1];
        if (nloc == 0u) { xcd_barrier_complete(bar, b.x, nloc, nx); b.st[0] = nloc; b.st[1] = nx; }
        const unsigned old = xb_add(&bar[XB_XSUB(b.x)], 1u);
        const unsigned gen = old / nloc;
        if (old + 1u == (gen + 1u) * nloc) {
            __builtin_amdgcn_fence(__ATOMIC_RELEASE, "agent");
            asm volatile("s_waitcnt vmcnt(0)" ::: "memory");
            const unsigned og = xb_add(&bar[XB_TOP], 1u);
            const unsigned tg = og / nx;
            if (og + 1u == (tg + 1u) * nx) xb_add(&bar[XB_TOPGEN], 1u);
            else XB_SPIN(xb_ld(&bar[XB_TOPGEN]) == tg, bar);
            __builtin_amdgcn_fence(__ATOMIC_ACQUIRE, "agent");
            xb_add(&bar[XB_XGEN(b.x)], 1u);
            asm volatile("s_waitcnt vmcnt(0)" ::: "memory");
        } else {
            XB_SPIN(xb_ld(&bar[XB_XGEN(b.x)]) == gen, bar);
            __builtin_amdgcn_fence(__ATOMIC_ACQUIRE, "agent");
            asm volatile("s_waitcnt vmcnt(0)" ::: "memory");
        }
    }
    __syncthreads();
}

struct Args { const float* in[15]; float* out; unsigned char* ws; int ph_lo, ph_hi; };
constexpr int NPH = 9;
constexpr int NP0_REST = 7424;

__global__ void __launch_bounds__(512, 2) fwd_kernel(Args a) {
    extern __shared__ __attribute__((aligned(16))) unsigned char lds_raw[];
    LAS unsigned char* lds = (LAS unsigned char*)lds_raw;
    cg::grid_group grid = cg::this_grid();
    const int tid = threadIdx.x, lane = tid & 63, wid = __builtin_amdgcn_readfirstlane(tid >> 6);
    const int G = gridDim.x, bx = blockIdx.x;
    unsigned char* ws = a.ws; float* out = a.out;
    const float* x_p = a.in[0]; const float* x_s = a.in[1]; const float* cache_k = a.in[2]; const float* cache_v = a.in[3]; const float* state0 = a.in[4];
    const float* ln1_g = a.in[5]; const float* w_in = a.in[6]; const float* gq = a.in[7]; const float* gk = a.in[8]; const float* sinks = a.in[9];
    const float* rng = a.in[10]; const float* w_out = a.in[11]; const float* ln2_g = a.in[12]; const float* w_up = a.in[13]; const float* w_dn = a.in[14];
    bf16_t* WIN = (bf16_t*)(ws + WS_WIN); bf16_t* WOUT = (bf16_t*)(ws + WS_WOUT); bf16_t* WUP = (bf16_t*)(ws + WS_WUP); bf16_t* WDN = (bf16_t*)(ws + WS_WDN);
    bf16_t* H1 = (bf16_t*)(ws + WS_H1); bf16_t* XG = H1; bf16_t* MIX = (bf16_t*)(ws + WS_MIX); bf16_t* Z = (bf16_t*)(ws + WS_Z); bf16_t* U = (bf16_t*)(ws + WS_U);
    float* PART = (float*)(ws + WS_PART); float* RSTD2 = (float*)(ws + WS_RSTD2); bf16_t* KV = (bf16_t*)(ws + WS_KV); bf16_t* SP = (bf16_t*)(ws + WS_SP); float* SLAB = (float*)(ws + WS_SP);
    const int lo = a.ph_lo, hi = a.ph_hi;
#define IN(k) (lo <= (k) && (k) < hi)
    volatile LAS unsigned* MISC = (volatile LAS unsigned*)(lds + LDS_BYTES - 64);
    if (tid < 16) MISC[tid] = 0u;
    __syncthreads();
    const XcdBarrier bar = xcd_barrier_post((unsigned*)ws + 1024, MISC + 8);
    if (lo > hi) grid.sync();
#define SEAM(k) do { if (IN(k) && IN((k) + 1)) xcd_barrier(bar); } while (0)

    if (IN(0)) for (int rep_ = 0; rep_ < 1 + ((DUPMASK >> 0) & 1); ++rep_) { if (rep_) xcd_barrier(bar);
        LAS float* scr = (LAS float*)(lds + wid * 17408);
        const int gw = bx * 8 + wid, NGW = G * 8;
        constexpr int I_IN = (DM / 64) * (INW / 32);
        p0_convert(ResIn{w_in, WIN}, gw, NGW, I_IN, scr, lane);
        p0_convert(ResRest{w_out, w_up, w_dn, WOUT, WUP, WDN}, gw, NGW, NP0_REST, scr, lane);
        for (int m = gw; m < MP; m += NGW) {
            if (m < MR) rms_row(m < LP ? x_p + (size_t)m * DM : x_s + (size_t)(m - LP) * DM, ln1_g, H1 + (size_t)m * DM, lane);
            else {
#pragma unroll
                for (int j = 0; j < 8; ++j) *((u32x2*)(H1 + (size_t)m * DM) + lane + 64 * j) = (u32x2){0u, 0u};
            }
        }
    }
    SEAM(0);
    if (IN(1)) for (int rep_ = 0; rep_ < 1 + ((DUPMASK >> 1) & 1); ++rep_) { if (rep_) xcd_barrier(bar);
        pg8::Gemm g{H1, WIN, MP, INW, DM}; pg8::StaticOrder S; S.init(MP, INW, G, bx);
        pg8::EpiIn E{Z};
        pg8::gemm_phase<pg8::EpiIn, pg8::StaticOrder, true, true>(lds, g, S, E);
        {
            constexpr int NT = (MP / 256) * (INW / 256); const int rounds = (NT + G - 1) / G, first_idle = NT - (rounds - 1) * G;
            const int nidle = (first_idle < G) ? (G - first_idle) : G, me = (first_idle < G) ? (bx - first_idle) : bx;
            if (me >= 0) {
                LAS float* scr = (LAS float*)(lds + wid * 17408);
                constexpr int I_OUT = (DM / 64) * (DM / 32), I_UP = (DM / 64) * (FF / 32), I_DN = (FF / 64) * (DM / 32);
                p0_convert(ResRest{w_out, w_up, w_dn, WOUT, WUP, WDN}, NP0_REST + me * 8 + wid, nidle * 8, I_OUT + I_UP + I_DN, scr, lane);
            }
        }
    }
    SEAM(1);
    if (IN(2)) for (int rep_ = 0; rep_ < 1 + ((DUPMASK >> 2) & 1); ++rep_) { if (rep_) xcd_barrier(bar);
        if (bx & 1) for (int u = bx; u < 256; u += G) ret_decode_unit(lds, Z, state0, out + O_SS, MIX, rng, u >> 2, u & 3, tid);
        for (int u = bx; u < 256; u += G) ret_step1(lds, Z, KV, u >> 2, u & 3, tid);
        if (!(bx & 1)) for (int u = bx; u < 256; u += G) ret_decode_unit(lds, Z, state0, out + O_SS, MIX, rng, u >> 2, u & 3, tid);
    }
    SEAM(2);
    if (IN(3)) for (int rep_ = 0; rep_ < 1 + ((DUPMASK >> 3) & 1); ++rep_) { if (rep_) xcd_barrier(bar);
        if (tid < 256) ret_scan(KV, SP, out + O_SP, bx * 256 + tid, G * 256);
        if (bx & 1) for (int u = bx; u < 256; u += G) attn_decode_unit(lds, Z, cache_k, cache_v, MIX, gq, gk, sinks, out + O_KS, out + O_VS, u >> 1, u & 1, tid);
        for (int u = 256 + bx; u < 512; u += G) ret_decode_unit(lds, Z, state0, out + O_SS, MIX, rng, u >> 2, u & 3, tid);
        if (!(bx & 1)) for (int u = bx; u < 256; u += G) attn_decode_unit(lds, Z, cache_k, cache_v, MIX, gq, gk, sinks, out + O_KS, out + O_VS, u >> 1, u & 1, tid);
    }
    SEAM(3);
    if (IN(4)) for (int rep_ = 0; rep_ < 1 + ((DUPMASK >> 4) & 1); ++rep_) { if (rep_) xcd_barrier(bar);
        for (int u = bx; u < 256; u += G) ret_step2(lds, Z, SP, MIX, rng, u >> 2, u & 3, tid);
        for (int u = bx; u < 256; u += G) attn_prompt_unit(lds, Z, MIX, gq, gk, sinks, out + O_KP, out + O_VP, u >> 2, (u >> 1) & 1, u & 1, tid);
    }
    SEAM(4);
    if (IN(5)) for (int rep_ = 0; rep_ < 1 + ((DUPMASK >> 5) & 1); ++rep_) { if (rep_) xcd_barrier(bar);
        pg8::Gemm g{MIX, WOUT, LP, DM, DM}; pg8::StaticOrder S; S.init(LP, DM, G, bx);
        pg8::EpiOut E{x_p, x_s, out + O_Y, XG, ln2_g, PART};
        pg8::gemm_phase<pg8::EpiOut, pg8::StaticOrder, true, true>(lds, g, S, E);
        const SkOut SE{x_s, out + O_Y + (size_t)LP * DM, XG + (size_t)LP * DM, ln2_g};
        for (int u = G - 1 - bx; u < DM / 32; u += G) skinny_unit(lds, MIX + (size_t)LP * DM, WOUT, DM, u, 0, SE, tid);
    }
    SEAM(5);
    if (IN(6)) for (int rep_ = 0; rep_ < 1 + ((DUPMASK >> 6) & 1); ++rep_) { if (rep_) xcd_barrier(bar);
        for (int row = bx + G * tid; row < LP; row += G * 512) { float s = 0.f;
#pragma unroll
            for (int j = 0; j < 8; ++j) { const f32x4 p = *(const f32x4*)(PART + (size_t)row * 32 + 4 * j); s += (p[0] + p[1]) + (p[2] + p[3]); }
            RSTD2[row] = 1.0f / (s * (1.0f / DM) + EPS); }
        for (int row = LP + bx * 8 + wid; row < MR; row += G * 8) {
            const float* xr = out + O_Y + (size_t)row * DM; float s = 0.f;
#pragma unroll
            for (int j = 0; j < 8; ++j) { const f32x4 v = *((const f32x4*)xr + lane + 64 * j); s += (v[0] * v[0] + v[1] * v[1]) + (v[2] * v[2] + v[3] * v[3]); }
            s = wave_sum(s); if (lane == 0) RSTD2[row] = 1.0f / (s * (1.0f / DM) + EPS); }
        pg8::Gemm g{XG, WUP, LP, FF, DM}; pg8::StaticOrder S; S.init(LP, FF, G, bx);
        pg8::EpiUp E{U};
        pg8::gemm_phase<pg8::EpiUp, pg8::StaticOrder, true, true>(lds, g, S, E);
        const SkUp SE{U + (size_t)LP * FF};
        for (int u = bx; u < FF / 32; u += G) skinny_unit(lds, XG + (size_t)LP * DM, WUP, DM, u, 0, SE, tid);
    }
    SEAM(6);
    if (IN(7)) {
        pg8::Gemm g{U, WDN, LP, DM, FF}; pg8::StaticOrder S; S.init(LP, DM, G, bx);
        pg8::EpiDown E{out + O_Y, RSTD2};
        pg8::gemm_phase<pg8::EpiDown, pg8::StaticOrder, true, true>(lds, g, S, E);
        for (int u = bx; u < 4 * (DM / 32); u += G) { const SkSlab SE{SLAB + (size_t)(u & 3) * NS * DM}; skinny_unit(lds, U + (size_t)LP * FF, WDN, FF, u >> 2, (u & 3) * 2048, SE, tid); }
    }
    SEAM(7);
    if (IN(8)) {
        for (int e = bx * 512 + tid; e < NS * DM / 4; e += G * 512) {
            const int row = e >> 9; float* p = out + O_Y + (size_t)LP * DM + (size_t)e * 4;
            const f32x4 s = (*(const f32x4*)(SLAB + (size_t)e * 4) + *(const f32x4*)(SLAB + (size_t)NS * DM + (size_t)e * 4)) + (*(const f32x4*)(SLAB + (size_t)2 * NS * DM + (size_t)e * 4) + *(const f32x4*)(SLAB + (size_t)3 * NS * DM + (size_t)e * 4));
            *(f32x4*)p = *(const f32x4*)p + s * RSTD2[LP + row];
        }
    }
#undef IN
#undef SEAM
}

#ifndef N_LAUNCHES
#define N_LAUNCHES 1
#endif
extern "C" void kernel_launch(void* const* d_in, const int* in_sizes, int n_in, void* d_out, int out_size, void* d_ws, size_t ws_size, hipStream_t stream) {
    static int grid = 0;
    if (grid == 0) {
        if (n_in != 15 || (size_t)out_size != O_END || ws_size < WS_END) { fprintf(stderr, "kernel_launch: unexpected shapes (n_in %d out %d ws %zu)\n", n_in, out_size, ws_size); grid = -1; return; }
        int dev = 0, cus = 0, per_cu = 0;
        (void)hipGetDevice(&dev); (void)hipDeviceGetAttribute(&cus, hipDeviceAttributeMultiprocessorCount, dev);
        if (hipFuncSetAttribute((const void*)fwd_kernel, hipFuncAttributeMaxDynamicSharedMemorySize, LDS_BYTES) != hipSuccess) { fprintf(stderr, "kernel_launch: hipFuncSetAttribute failed\n"); grid = -1; return; }
        (void)hipOccupancyMaxActiveBlocksPerMultiprocessor(&per_cu, (const void*)fwd_kernel, 512, LDS_BYTES);
        (void)hipGetLastError();
        if (per_cu < 1) { fprintf(stderr, "kernel_launch: occupancy query says %d blocks per CU\n", per_cu); }
        grid = cus > 0 ? cus : 256;
    }
    if (grid < 0) return;
    if (hipMemsetAsync(d_ws, 0, 65536, stream) != hipSuccess) { fprintf(stderr, "kernel_launch: memset failed\n"); return; }
    Args a{};
    for (int i = 0; i < 15; ++i) a.in[i] = (const float*)d_in[i];
    a.out = (float*)d_out; a.ws = (unsigned char*)d_ws;
    if (N_LAUNCHES == 1) {
        a.ph_lo = 0; a.ph_hi = NPH;
        void* args[] = {&a};
        hipError_t e = hipLaunchCooperativeKernel((const void*)fwd_kernel, dim3(grid), dim3(512), args, LDS_BYTES, stream);
        if (e != hipSuccess) fprintf(stderr, "cooperative launch failed: %s (grid %d)\n", hipGetErrorString(e), grid);
    } else {
        for (int p = 0; p < NPH; ++p) { a.ph_lo = p; a.ph_hi = p + 1; hipLaunchKernelGGL(fwd_kernel, dim3(grid), dim3(512), LDS_BYTES, stream, a); }
    }
}
```

```cpp
#include <hip/hip_runtime.h>
#include <hip/hip_cooperative_groups.h>
#include <cstdio>
#include <cstdint>
namespace cg = cooperative_groups;

#ifndef WGM_IN
#define WGM_IN 2
#endif
#ifndef WGM_OUT
#define WGM_OUT 2
#endif
#ifndef WGM_UP
#define WGM_UP 2
#endif
#ifndef WGM_DN
#define WGM_DN 2
#endif
#ifndef DUPMASK
#define DUPMASK 0
#endif
#define DI __device__ __forceinline__
#define LAS __attribute__((address_space(3)))
typedef float f32x2 __attribute__((ext_vector_type(2)));
typedef float f32x16 __attribute__((ext_vector_type(16)));
typedef short s16x4 __attribute__((ext_vector_type(4)));
typedef unsigned u32x2 __attribute__((ext_vector_type(2)));
typedef __bf16 bf16x2v __attribute__((ext_vector_type(2)));

constexpr int DM = 2048, LP = 8192, NS = 128, MR = LP + NS  , MP = 8448  ;
constexpr int INW = 5376, FF = 8192;
constexpr int C_AQ = 0, C_AK = 1024, C_AV = 1152, C_RQ = 1280, C_RK = 2304, C_RV = 3328, C_RG = 4352;
constexpr float EPS = 1e-6f;

DI unsigned pk2(float lo, float hi) { f32x2 v = {lo, hi}; return __builtin_bit_cast(unsigned, __builtin_convertvector(v, bf16x2v)); }
DI float bflo(unsigned u) { return __uint_as_float(u << 16); }
DI float bfhi(unsigned u) { return __uint_as_float(u & 0xffff0000u); }
DI float bf2f(unsigned short u) { return __uint_as_float(((unsigned)u) << 16); }

namespace pg8 {
#define PG8_LAS __attribute__((address_space(3)))
typedef unsigned short bf16_t;
typedef short bf16x8 __attribute__((ext_vector_type(8)));
typedef float f32x4 __attribute__((ext_vector_type(4)));
typedef unsigned u32x4 __attribute__((ext_vector_type(4)));
constexpr int BM = 256, BK = 64, HALF = 128, HTB = HALF * BK * 2  , STAGE_BYTES = 8 * HTB, NXCD = 8, WGM = 8;

__host__ __device__ __forceinline__ int lds_byte(int r, int c) { const int st = (r >> 4) * 2 + (c >> 5), rr = r & 15, cc = c & 31, ob = rr * 64 + cc * 2; return st * 1024 + (ob ^ (((ob >> 9) & 1) << 5)); }
__host__ __device__ __forceinline__ void stage_rc(int b, int& R, int& C) { const int st = b / 1024, sb = b % 1024, swz = sb ^ (((sb >> 9) & 1) << 5); R = (st >> 1) * 16 + swz / 64; C = (st & 1) * 32 + (swz % 64) / 2; }
__host__ __device__ __forceinline__ int perm32(int rho) { const int n = rho >> 4, i = rho & 15; return 8 * (i >> 2) + 4 * n + (i & 3); }

struct Unit { int pm, pn; };
struct Gemm { const bf16_t* A; const bf16_t* Bt; int M, N, K; };

struct StaticOrder {
    int nM, nN, nwg, G, c, wgm;
    __host__ __device__ void init(int M, int N, int G_, int c_, int wgm_) { nM = M / BM; nN = N / BM; nwg = nM * nN; G = G_; c = c_; wgm = wgm_; }
    __host__ __device__ bool next(int i, Unit& u) const {
        const long L = (long)i * G + c; if (L >= nwg) return false;
        int wgid = (int)L; { const int q = nwg / NXCD, r = nwg % NXCD, xcd = wgid % NXCD, off = wgid / NXCD; wgid = (xcd < r ? xcd * (q + 1) : r * (q + 1) + (xcd - r) * q) + off; }
        const int nig = wgm * nN, gid = wgid / nig, fm = gid * wgm, gsz = (nM - fm) < wgm ? (nM - fm) : wgm;
        u.pm = fm + ((wgid % nig) % gsz); u.pn = (wgid % nig) / gsz; return true;
    }
    __device__ __forceinline__ void a_ready(const Unit&) const {}
    __device__ __forceinline__ void done(const Unit&) const {}
};


DI u32x4 pack8f(const f32x4& a, const f32x4& b) { u32x4 w; w.x = pk2(a[0], a[1]); w.y = pk2(a[2], a[3]); w.z = pk2(b[0], b[1]); w.w = pk2(b[2], b[3]); return w; }

struct EpiIn {
    static constexpr bool PERM = true, AFTER_DRAIN = false;
    bf16_t* Z;
    __device__ __forceinline__ void operator()(const f32x4 (&acc)[2][2][4][2], const Unit& u, int wr, int wc, int fr, int fq) const {
        const int row0 = u.pm * BM + wr * 64 + fr, col0 = u.pn * BM + wc * 32 + 8 * fq;
        if (u.pn < 5 || u.pn > 12) {
#pragma unroll
            for (int ai = 0; ai < 2; ++ai)
#pragma unroll
                for (int m = 0; m < 4; ++m) { bf16_t* rowp = Z + (size_t)(row0 + ai * HALF + m * 16) * INW + col0;
#pragma unroll
                    for (int bj = 0; bj < 2; ++bj) *(u32x4*)(rowp + bj * HALF) = pack8f(acc[ai][bj][m][0], acc[ai][bj][m][1]); }
        } else {
            const int head = (u.pn - 5) & 3; const bool isk = u.pn >= 9;
            const float lg = log1pf(-exp2f(-5.0f - (float)head));
            float inv[8];
#pragma unroll
            for (int j = 0; j < 8; ++j) inv[j] = powf(10000.0f, -(float)(wc * 32 + 8 * fq + j) * (1.0f / 128.0f));
#pragma unroll
            for (int ai = 0; ai < 2; ++ai)
#pragma unroll
                for (int m = 0; m < 4; ++m) {
                    const int row = row0 + ai * HALF + m * 16;
                    const int pos = row < LP ? row : LP; const float t = row < LP ? (float)(row & 127) : 0.0f;
                    const float f = isk ? 0.0625f * __expf(-lg * t) : __expf(lg * t);
                    f32x4 o1[2], o2[2];
#pragma unroll
                    for (int n = 0; n < 2; ++n)
#pragma unroll
                        for (int e = 0; e < 4; ++e) {
                            const float ang = (float)pos * inv[n * 4 + e];
                            double rev = (double)ang * 0.15915494309189535; rev -= floor(rev);
                            const float fr_ = (float)rev; const float sn = __builtin_amdgcn_sinf(fr_), cs = __builtin_amdgcn_cosf(fr_);
                            const float x1 = acc[ai][0][m][n][e], x2 = acc[ai][1][m][n][e];
                            o1[n][e] = (x1 * cs - x2 * sn) * f; o2[n][e] = (x2 * cs + x1 * sn) * f;
                        }
                    bf16_t* rowp = Z + (size_t)row * INW + col0;
                    *(u32x4*)(rowp) = pack8f(o1[0], o1[1]); *(u32x4*)(rowp + HALF) = pack8f(o2[0], o2[1]);
                }
        }
    }
};

struct EpiOut {
    static constexpr bool PERM = true, AFTER_DRAIN = false;
    const float* xp; const float* xs; float* X1; bf16_t* XG; const float* g2; float* part;
    __device__ __forceinline__ void operator()(const f32x4 (&acc)[2][2][4][2], const Unit& u, int wr, int wc, int fr, int fq) const {
#pragma unroll
        for (int ai = 0; ai < 2; ++ai) {
            const int rbase = u.pm * BM + ai * HALF; const bool valid = rbase < MR;
#pragma unroll
            for (int m = 0; m < 4; ++m) {
                const int row = rbase + wr * 64 + m * 16 + fr;
                const float* xrow = row < LP ? xp + (size_t)row * DM : xs + (size_t)(row - LP) * DM;
                float ss = 0.f;
#pragma unroll
                for (int bj = 0; bj < 2; ++bj) {
                    const int col = u.pn * BM + bj * HALF + wc * 32 + 8 * fq;
                    f32x4 v0 = {0.f, 0.f, 0.f, 0.f}, v1 = {0.f, 0.f, 0.f, 0.f};
                    if (valid) { v0 = acc[ai][bj][m][0] + *(const f32x4*)(xrow + col); v1 = acc[ai][bj][m][1] + *(const f32x4*)(xrow + col + 4);
                        *(f32x4*)(X1 + (size_t)row * DM + col) = v0; *(f32x4*)(X1 + (size_t)row * DM + col + 4) = v1; }
                    ss += (v0[0] * v0[0] + v0[1] * v0[1]) + (v0[2] * v0[2] + v0[3] * v0[3]) + (v1[0] * v1[0] + v1[1] * v1[1]) + (v1[2] * v1[2] + v1[3] * v1[3]);
                    const f32x4 ga = *(const f32x4*)(g2 + col), gb = *(const f32x4*)(g2 + col + 4);
                    *(u32x4*)(XG + (size_t)row * DM + col) = pack8f(v0 * ga, v1 * gb);
                }
                ss += __shfl_xor(ss, 16); ss += __shfl_xor(ss, 32);
                if (fq == 0) part[(size_t)row * 32 + u.pn * 4 + wc] = ss;
            }
        }
    }
};

struct EpiUp {
    static constexpr bool PERM = true, AFTER_DRAIN = false;
    bf16_t* U;
    __device__ __forceinline__ void operator()(const f32x4 (&acc)[2][2][4][2], const Unit& u, int wr, int wc, int fr, int fq) const {
        const int row0 = u.pm * BM + wr * 64 + fr, col0 = u.pn * BM + wc * 32 + 8 * fq;
#pragma unroll
        for (int ai = 0; ai < 2; ++ai)
#pragma unroll
            for (int m = 0; m < 4; ++m) { bf16_t* rowp = U + (size_t)(row0 + ai * HALF + m * 16) * FF + col0;
#pragma unroll
                for (int bj = 0; bj < 2; ++bj) { f32x4 a = acc[ai][bj][m][0], b = acc[ai][bj][m][1];
#pragma unroll
                    for (int e = 0; e < 4; ++e) { a[e] = fmaxf(a[e], 0.f); a[e] *= a[e]; b[e] = fmaxf(b[e], 0.f); b[e] *= b[e]; }
                    *(u32x4*)(rowp + bj * HALF) = pack8f(a, b); } }
    }
};

struct EpiDown {
    static constexpr bool PERM = true, AFTER_DRAIN = false;
    float* Y; const float* rstd2;
    __device__ __forceinline__ void operator()(const f32x4 (&acc)[2][2][4][2], const Unit& u, int wr, int wc, int fr, int fq) const {
#pragma unroll
        for (int ai = 0; ai < 2; ++ai) {
            const int rbase = u.pm * BM + ai * HALF; if (rbase >= MR) continue;
#pragma unroll
            for (int m = 0; m < 4; ++m) {
                const int row = rbase + wr * 64 + m * 16 + fr; const float r2 = rstd2[row];
#pragma unroll
                for (int bj = 0; bj < 2; ++bj) { float* p = Y + (size_t)row * DM + u.pn * BM + bj * HALF + wc * 32 + 8 * fq;
                    const f32x4 a = *(const f32x4*)p, b = *(const f32x4*)(p + 4);
                    *(f32x4*)p = a + acc[ai][bj][m][0] * r2; *(f32x4*)(p + 4) = b + acc[ai][bj][m][1] * r2; }
            }
        }
    }
};
template <class Epi, class Sched, bool ALIGN_EPI = false, bool SP2 = false>
__device__ __forceinline__ void gemm_phase(PG8_LAS unsigned char* lds, const Gemm g, const Sched& S, const Epi& E) {
    const int tid = threadIdx.x, wid = __builtin_amdgcn_readfirstlane(tid >> 6), lane = tid & 63, wr = wid >> 2, wc = wid & 3, fr = lane & 15, fq = lane >> 4;
    const int K = g.K, nt = K / BK;
    unsigned voffA[2], voffB[2];
#pragma unroll
    for (int i = 0; i < 2; ++i) { int R, C; stage_rc(tid * 16 + i * 8192, R, C); const int Rb = Epi::PERM ? ((R & ~31) + perm32(R & 31)) : R;
        voffA[i] = (unsigned)(R * K + C) * 2u; voffB[i] = (unsigned)(Rb * K + C) * 2u; }
    const size_t kstep = (size_t)(BK * 2);
    const size_t hstep = (size_t)HALF * K * 2;
    const size_t tstep = 2 * hstep;
    const unsigned ldsw = (unsigned)wid * 1024u;
    const int aoff = lds_byte(wr * 64 + fr, fq * 8), boff = lds_byte(wc * 32 + fr, fq * 8);
#define PG8_SA(b, h) (((b) * 2 + (h)) * HTB)
#define PG8_SB(b, h) ((4 + (b) * 2 + (h)) * HTB)
#define PG8_STAGE(bufoff, gbase, voff) do { _Pragma("unroll") for (int _i = 0; _i < 2; ++_i) \
        __builtin_amdgcn_global_load_lds((const unsigned*)((const char*)(gbase) + (voff)[_i]), (PG8_LAS unsigned*)(lds + (bufoff) + ldsw + _i * 8192), 16, 0, 0); } while (0)
#define PG8_LDA(dst, b, h) do { _Pragma("unroll") for (int m = 0; m < 4; ++m) _Pragma("unroll") for (int k = 0; k < 2; ++k) dst[m][k] = *(const PG8_LAS bf16x8*)(lds + PG8_SA(b, h) + aoff + m * 2048 + k * 1024); } while (0)
#define PG8_LDB(dst, b, h) do { _Pragma("unroll") for (int n = 0; n < 2; ++n) _Pragma("unroll") for (int k = 0; k < 2; ++k) dst[n][k] = *(const PG8_LAS bf16x8*)(lds + PG8_SB(b, h) + boff + n * 2048 + k * 1024); } while (0)
#define PG8_MMA(ai, bj, At, Bt) do { __builtin_amdgcn_s_setprio(1); _Pragma("unroll") for (int m = 0; m < 4; ++m) _Pragma("unroll") for (int n = 0; n < 2; ++n) _Pragma("unroll") for (int k = 0; k < 2; ++k) \
        acc[ai][bj][m][n] = __builtin_amdgcn_mfma_f32_16x16x32_bf16(Bt[n][k], At[m][k], acc[ai][bj][m][n], 0, 0, 0); __builtin_amdgcn_s_setprio(0); } while (0)
#define PG8_WAIT_V(n) asm volatile("s_waitcnt vmcnt(" #n ")" ::: "memory")
#define PG8_WAIT_L(n) asm volatile("s_waitcnt lgkmcnt(" #n ")" ::: "memory")
#define PG8_BAR __builtin_amdgcn_s_barrier()
#define PG8_SCHED __builtin_amdgcn_sched_barrier(0)
    Unit cur, nxt; int ui = 0;
    if (!S.next(0, cur)) return;
    f32x4 acc[2][2][4][2];
#pragma unroll
    for (int a = 0; a < 2; ++a)
#pragma unroll
        for (int b = 0; b < 2; ++b)
#pragma unroll
            for (int m = 0; m < 4; ++m)
#pragma unroll
                for (int n = 0; n < 2; ++n) acc[a][b][m][n] = (f32x4){0.f, 0.f, 0.f, 0.f};
    bf16x8 At[4][2], B0[2][2], B1[2][2];
    const char* cA = (const char*)g.A + (size_t)cur.pm * tstep; const char* cB = (const char*)g.Bt + (size_t)cur.pn * tstep;
    S.a_ready(cur);
    if constexpr (SP2) {
        PG8_STAGE(PG8_SB(0, 0), cB, voffB); PG8_STAGE(PG8_SB(0, 1), cB + hstep, voffB); PG8_STAGE(PG8_SA(0, 0), cA, voffA); PG8_STAGE(PG8_SA(0, 1), cA + hstep, voffA);
        if (wr == 1) PG8_BAR;
        PG8_WAIT_V(2); PG8_BAR;
        PG8_STAGE(PG8_SB(1, 0), cB + kstep, voffB); PG8_STAGE(PG8_SA(1, 0), cA + kstep, voffA); PG8_STAGE(PG8_SB(1, 1), cB + hstep + kstep, voffB);
        PG8_WAIT_V(6); PG8_BAR;
    } else {
        PG8_STAGE(PG8_SB(0, 0), cB, voffB); PG8_STAGE(PG8_SA(0, 0), cA, voffA); PG8_STAGE(PG8_SB(0, 1), cB + hstep, voffB); PG8_STAGE(PG8_SA(0, 1), cA + hstep, voffA);
        if (wr == 1) PG8_BAR;
        PG8_WAIT_V(4); PG8_BAR;
        PG8_STAGE(PG8_SB(1, 0), cB + kstep, voffB); PG8_STAGE(PG8_SA(1, 0), cA + kstep, voffA); PG8_STAGE(PG8_SB(1, 1), cB + hstep + kstep, voffB);
        PG8_WAIT_V(6); PG8_BAR;
    }
    for (;;) {
        const bool has_next = S.next(ui + 1, nxt);
        const char* nA = has_next ? (const char*)g.A + (size_t)nxt.pm * tstep : cA; const char* nB = has_next ? (const char*)g.Bt + (size_t)nxt.pn * tstep : cB;
        for (int t = 0; t < nt; t += 2) {
            const bool last = (t == nt - 2);
            const char* a1 = cA + (size_t)(t + 1) * kstep;
            const char* a2 = last ? nA : cA + (size_t)(t + 2) * kstep; const char* b2 = last ? nB : cB + (size_t)(t + 2) * kstep;
            const char* a3 = a2 + kstep; const char* b3 = b2 + kstep;
            if (last && has_next) S.a_ready(nxt);
            if constexpr (SP2) {
            PG8_LDB(B0, 0, 0); PG8_LDB(B1, 0, 1); PG8_SCHED; PG8_LDA(At, 0, 0); PG8_STAGE(PG8_SA(1, 1), a1 + hstep, voffA);
            PG8_WAIT_V(8); PG8_WAIT_L(0); PG8_BAR; PG8_MMA(0, 0, At, B0); PG8_MMA(0, 1, At, B1); PG8_BAR; PG8_SCHED;
            PG8_LDA(At, 0, 1); PG8_STAGE(PG8_SB(0, 0), b2, voffB); PG8_STAGE(PG8_SB(0, 1), b2 + hstep, voffB); PG8_STAGE(PG8_SA(0, 0), a2, voffA);
            PG8_WAIT_V(8); PG8_WAIT_L(0); PG8_BAR; PG8_MMA(1, 0, At, B0); PG8_MMA(1, 1, At, B1); PG8_BAR; PG8_SCHED;
            PG8_LDB(B0, 1, 0); PG8_LDB(B1, 1, 1); PG8_SCHED; PG8_LDA(At, 1, 0); PG8_STAGE(PG8_SA(0, 1), a2 + hstep, voffA);
            PG8_WAIT_V(8); PG8_WAIT_L(0); PG8_BAR; PG8_MMA(0, 0, At, B0); PG8_MMA(0, 1, At, B1); PG8_BAR; PG8_SCHED;
            PG8_LDA(At, 1, 1); PG8_STAGE(PG8_SB(1, 0), b3, voffB); PG8_STAGE(PG8_SB(1, 1), b3 + hstep, voffB); PG8_STAGE(PG8_SA(1, 0), a3, voffA);
            PG8_WAIT_V(8); PG8_WAIT_L(0); PG8_BAR; PG8_MMA(1, 0, At, B0); PG8_MMA(1, 1, At, B1); PG8_BAR; PG8_SCHED;
            } else {
            PG8_LDB(B0, 0, 0); PG8_SCHED; PG8_LDA(At, 0, 0); PG8_STAGE(PG8_SA(1, 1), a1 + hstep, voffA);
            PG8_WAIT_L(8); PG8_BAR; PG8_WAIT_L(0); PG8_MMA(0, 0, At, B0); PG8_BAR; PG8_SCHED;
            PG8_LDB(B1, 0, 1); PG8_STAGE(PG8_SB(0, 0), b2, voffB);
            PG8_BAR; PG8_WAIT_L(0); PG8_MMA(0, 1, At, B1); PG8_BAR;
            PG8_LDA(At, 0, 1); PG8_STAGE(PG8_SA(0, 0), a2, voffA);
            PG8_BAR; PG8_WAIT_L(0); PG8_MMA(1, 0, At, B0); PG8_BAR; PG8_SCHED;
            PG8_STAGE(PG8_SB(0, 1), b2 + hstep, voffB);
            PG8_WAIT_V(6); PG8_BAR; PG8_MMA(1, 1, At, B1); PG8_BAR;
            PG8_LDB(B0, 1, 0); PG8_SCHED; PG8_LDA(At, 1, 0); PG8_STAGE(PG8_SA(0, 1), a2 + hstep, voffA);
            PG8_WAIT_L(8); PG8_BAR; PG8_WAIT_L(0); PG8_MMA(0, 0, At, B0); PG8_BAR; PG8_SCHED;
            PG8_LDB(B1, 1, 1); PG8_STAGE(PG8_SB(1, 0), b3, voffB);
            PG8_BAR; PG8_WAIT_L(0); PG8_MMA(0, 1, At, B1); PG8_BAR;
            PG8_LDA(At, 1, 1); PG8_STAGE(PG8_SA(1, 0), a3, voffA);
            PG8_BAR; PG8_WAIT_L(0); PG8_MMA(1, 0, At, B0); PG8_BAR; PG8_SCHED;
            PG8_STAGE(PG8_SB(1, 1), b3 + hstep, voffB);
            PG8_WAIT_V(6); PG8_BAR; PG8_MMA(1, 1, At, B1); PG8_BAR;
            }
        }
        if constexpr (ALIGN_EPI) { if (wr == 0) PG8_BAR; }
        if constexpr (!Epi::AFTER_DRAIN) { E(acc, cur, wr, wc, fr, fq); S.done(cur); }
        if (!has_next) break;
#pragma unroll
        for (int a = 0; a < 2; ++a)
#pragma unroll
            for (int b = 0; b < 2; ++b)
#pragma unroll
                for (int m = 0; m < 4; ++m)
#pragma unroll
                    for (int n = 0; n < 2; ++n) acc[a][b][m][n] = (f32x4){0.f, 0.f, 0.f, 0.f};
        cur = nxt; cA = nA; cB = nB; ++ui;
        if constexpr (ALIGN_EPI) { if (wr == 1) PG8_BAR; }
    }
    PG8_WAIT_V(0);
    if constexpr (!ALIGN_EPI) { if (wr == 0) PG8_BAR; }
    PG8_BAR;
    if constexpr (Epi::AFTER_DRAIN) { E.fused(acc, cur, wr, wc, fr, fq, lds, wid, lane); S.done(cur); }
#undef PG8_SA
#undef PG8_SB
#undef PG8_STAGE
#undef PG8_LDA
#undef PG8_LDB
#undef PG8_MMA
#undef PG8_WAIT_V
#undef PG8_WAIT_L
#undef PG8_BAR
#undef PG8_SCHED
}
}

using pg8::bf16_t; using pg8::bf16x8; using pg8::f32x4; using pg8::u32x4;
#define MFMA32(a, b, c) __builtin_amdgcn_mfma_f32_32x32x16_bf16((a), (b), (c), 0, 0, 0)
DI int crow(int reg, int h) { return (reg & 3) + 8 * (reg >> 2) + 4 * h; }
DI float wave_sum(float v) {
#pragma unroll
    for (int o = 1; o < 64; o <<= 1) v += __shfl_xor(v, o);
    return v;
}
DI float wave_max(float v) {
#pragma unroll
    for (int o = 1; o < 64; o <<= 1) v = fmaxf(v, __shfl_xor(v, o));
    return v;
}
DI bf16x8 pack8(const f32x16& x, int s) { u32x4 p; p.x = pk2(x[8 * s], x[8 * s + 1]); p.y = pk2(x[8 * s + 2], x[8 * s + 3]); p.z = pk2(x[8 * s + 4], x[8 * s + 5]); p.w = pk2(x[8 * s + 6], x[8 * s + 7]); return __builtin_bit_cast(bf16x8, p); }
DI bf16x8 cat4(s16x4 lo, s16x4 hi) { return __builtin_shufflevector(lo, hi, 0, 1, 2, 3, 4, 5, 6, 7); }
DI f32x16 zero16() { f32x16 z;
#pragma unroll
    for (int i = 0; i < 16; ++i) z[i] = 0.f;
    return z; }
DI float gamma_of(int h) { return 1.0f - exp2f(-5.0f - (float)h); }

constexpr size_t MiB = 1u << 20;
constexpr size_t WS_WIN = 1 * MiB;
constexpr size_t WS_WOUT = 23 * MiB;
constexpr size_t WS_WUP = 31 * MiB;
constexpr size_t WS_WDN = 63 * MiB;
constexpr size_t WS_H1 = 95 * MiB;
constexpr size_t WS_MIX = 128 * MiB;
constexpr size_t WS_PART = 161 * MiB;
constexpr size_t WS_RSTD2 = 163 * MiB;
constexpr size_t WS_Z = 164 * MiB;
constexpr size_t WS_KV = 252 * MiB;
constexpr size_t WS_SP = 316 * MiB;
constexpr size_t WS_U = 164 * MiB;
constexpr size_t WS_END = 348 * MiB;
static_assert(WS_Z + (size_t)MP * INW * 2 <= WS_KV && WS_U + (size_t)MP * FF * 2 <= WS_END && WS_H1 + (size_t)MP * DM * 2 <= WS_MIX && WS_MIX + (size_t)MP * DM * 2 <= WS_PART, "ws map");
constexpr int LDS_BYTES = 147456;

constexpr size_t O_Y = 0, O_KP = (size_t)MR * DM, O_VP = O_KP + 16384, O_SP = O_VP + 16384, O_KS = O_SP + 262144, O_VS = O_KS + 2097152, O_SS = O_VS + 2097152, O_END = O_SS + 33554432;

struct TItem { const float* W; bf16_t* WT; int K, N, item; };
DI void p0_load(const TItem& t, f32x4 (&v)[8], int lane) {
    const int nblk = t.N / 32, kb = t.item / nblk, nb = t.item % nblk, k0 = 64 * kb, n0 = 32 * nb, c = lane & 7, rr = lane >> 3;
#pragma unroll
    for (int i = 0; i < 8; ++i) v[i] = __builtin_nontemporal_load((const f32x4*)(t.W + (size_t)(k0 + 8 * i + rr) * t.N + n0 + 4 * c));
}
DI void p0_store(const TItem& t, const f32x4 (&v)[8], LAS float* scr, int lane) {
    const int nblk = t.N / 32, kb = t.item / nblk, nb = t.item % nblk, k0 = 64 * kb, n0 = 32 * nb, c = lane & 7, rr = lane >> 3;
#pragma unroll
    for (int i = 0; i < 8; ++i) { LAS float* d = scr + (8 * i + rr) * 33 + 4 * c; d[0] = v[i][0]; d[1] = v[i][1]; d[2] = v[i][2]; d[3] = v[i][3]; }
    asm volatile("s_waitcnt lgkmcnt(0)" ::: "memory");
#pragma unroll
    for (int j = 0; j < 4; ++j) { const int n = (lane >> 3) + 8 * j; const LAS float* s = scr + (8 * c) * 33 + n;
        u32x4 o; o.x = pk2(s[0 * 33], s[1 * 33]); o.y = pk2(s[2 * 33], s[3 * 33]); o.z = pk2(s[4 * 33], s[5 * 33]); o.w = pk2(s[6 * 33], s[7 * 33]);
        *(u32x4*)(t.WT + (size_t)(n0 + n) * t.K + k0 + 8 * c) = o; }
    asm volatile("s_waitcnt lgkmcnt(0)" ::: "memory");
}
struct ResIn { const float* w; bf16_t* wt; DI TItem operator()(int it) const { return TItem{w, wt, DM, INW, it}; } };
struct ResRest { const float* w_out; const float* w_up; const float* w_dn; bf16_t* WOUT; bf16_t* WUP; bf16_t* WDN;
    DI TItem operator()(int it) const { constexpr int I_OUT = (DM / 64) * (DM / 32), I_UP = (DM / 64) * (FF / 32); int r = it;
        if (r < I_OUT) return TItem{w_out, WOUT, DM, DM, r}; r -= I_OUT;
        if (r < I_UP) return TItem{w_up, WUP, DM, FF, r}; r -= I_UP;
        return TItem{w_dn, WDN, FF, DM, r}; } };
template <class Resolve>
DI void p0_convert(const Resolve R, int first, int stride, int total, LAS float* scr, int lane) {
    for (int it = first; it < total; it += 2 * stride) {
        const bool two = it + stride < total;
        const TItem t0 = R(it), t1 = R(two ? it + stride : it);
        f32x4 v0[8], v1[8];
        p0_load(t0, v0, lane);
        if (two) p0_load(t1, v1, lane);
        p0_store(t0, v0, scr, lane);
        if (two) p0_store(t1, v1, scr + 64 * 33, lane);
    }
}
DI void rms_row(const float* xrow, const float* g, bf16_t* orow, int lane) {
    f32x4 v[8]; float s = 0.f;
#pragma unroll
    for (int j = 0; j < 8; ++j) { v[j] = *((const f32x4*)xrow + lane + 64 * j); s += (v[j][0] * v[j][0] + v[j][1] * v[j][1]) + (v[j][2] * v[j][2] + v[j][3] * v[j][3]); }
    const float rstd = rsqrtf(wave_sum(s) * (1.0f / DM) + EPS);
#pragma unroll
    for (int j = 0; j < 8; ++j) { const f32x4 gg = *((const f32x4*)g + lane + 64 * j); u32x2 o; o.x = pk2(v[j][0] * rstd * gg[0], v[j][1] * rstd * gg[1]); o.y = pk2(v[j][2] * rstd * gg[2], v[j][3] * rstd * gg[3]);
        *((u32x2*)orow + lane + 64 * j) = o; }
}

DI void stage_T128x256(LAS unsigned char* img, const bf16_t* src, int tid) {
#pragma unroll
    for (int k = 0; k < 4; ++k) {
        const int it = k * 512 + tid, dgl = it & 3, tpl = (it >> 2) & 15, rest = it >> 6, dg = dgl + 4 * (rest & 7), tp = tpl + 16 * (rest >> 3);
        const bf16_t* p = src + (size_t)(2 * tp) * INW + dg * 8;
        const u32x4 a = *(const u32x4*)p, b = *(const u32x4*)(p + INW);
#pragma unroll
        for (int e = 0; e < 8; ++e) {
            const unsigned lo = (e & 1) ? (a[e >> 1] >> 16) : (a[e >> 1] & 0xffffu), hi = (e & 1) ? (b[e >> 1] & 0xffff0000u) : (b[e >> 1] << 16);
            *(LAS unsigned*)(img + (dg * 8 + e) * 264 + tp * 4) = lo | hi;
        }
    }
}

DI void ret_step1(LAS unsigned char* lds, const bf16_t* Z, bf16_t* KV, int n, int h, int tid) {
    LAS unsigned char* Kt = lds; LAS unsigned char* Vt = lds + 256 * 264;
    const int lane = tid & 63, wid = tid >> 6, r = lane & 31, hh = lane >> 5;
    stage_T128x256(Kt, Z + (size_t)(n * 128) * INW + C_RK + h * 256, tid);
    stage_T128x256(Vt, Z + (size_t)(n * 128) * INW + C_RV + h * 256, tid);
    __syncthreads();
    f32x16 acc[8];
#pragma unroll
    for (int i = 0; i < 8; ++i) acc[i] = zero16();
    const int dk0 = wid * 32;
#pragma unroll 2
    for (int s = 0; s < 8; ++s) {
        const LAS unsigned char* pa = Kt + (dk0 + r) * 264 + (16 * s + 8 * hh) * 2;
        const bf16x8 A = cat4(*(const LAS s16x4*)pa, *(const LAS s16x4*)(pa + 8));
#pragma unroll
        for (int dt = 0; dt < 8; ++dt) {
            const LAS unsigned char* pb = Vt + (dt * 32 + r) * 264 + (16 * s + 8 * hh) * 2;
            const bf16x8 B = cat4(*(const LAS s16x4*)pb, *(const LAS s16x4*)(pb + 8));
            acc[dt] = MFMA32(A, B, acc[dt]);
        }
    }
    bf16_t* out = KV + ((size_t)(n * 4 + h) * 256) * 256 + dk0 + 4 * hh;
#pragma unroll
    for (int dt = 0; dt < 8; ++dt)
#pragma unroll
        for (int g4 = 0; g4 < 4; ++g4) { u32x2 o; o.x = pk2(acc[dt][4 * g4], acc[dt][4 * g4 + 1]); o.y = pk2(acc[dt][4 * g4 + 2], acc[dt][4 * g4 + 3]);
            *(u32x2*)(out + (size_t)(dt * 32 + r) * 256 + 8 * g4) = o; }
    __syncthreads();
}

DI void ret_scan(const bf16_t* KV, bf16_t* SP, float* o_state, int gt, int nthreads) {
    for (int e = gt; e < 65536; e += nthreads) {
        const int h = e >> 14, dv = (e >> 6) & 255, dk4 = (e & 63) * 4;
        const float lg = log1pf(-exp2f(-5.0f - (float)h)), Dc = __expf(128.0f * lg), c1 = __expf(127.0f * lg);
        const size_t base = ((size_t)(h * 256 + dv)) * 256 + dk4;
        f32x4 s = {0.f, 0.f, 0.f, 0.f};
        for (int n0 = 0; n0 < 64; n0 += 32) {
            u32x2 q[32];
#pragma unroll
            for (int u = 0; u < 32; ++u) q[u] = *(const u32x2*)(KV + (size_t)(n0 + u) * 262144 + base);
#pragma unroll
            for (int u = 0; u < 32; ++u) { u32x2 o; o.x = pk2(s[0], s[1]); o.y = pk2(s[2], s[3]); *(u32x2*)(SP + (size_t)(n0 + u) * 262144 + base) = o;
                const f32x4 kv = {bflo(q[u].x), bfhi(q[u].x), bflo(q[u].y), bfhi(q[u].y)}; s = s * Dc + kv * c1; }
        }
#pragma unroll
        for (int j = 0; j < 4; ++j) o_state[((size_t)(h * 256 + dk4 + j)) * 256 + dv] = s[j];
    }
}

DI float silu_f(float x) { return x / (1.0f + __expf(-x)); }

DI void ret_step2(LAS unsigned char* lds, const bf16_t* Z, const bf16_t* SP, bf16_t* MIX, const float* rng, int n, int h, int tid) {
    LAS unsigned char* Kr = lds; LAS unsigned char* Vt = lds + 128 * 528; LAS float* red = (LAS float*)(lds + 128 * 528 + 256 * 264);
    const int lane = tid & 63, wid = tid >> 6, r = lane & 31, hh = lane >> 5;
    const bf16_t* zc = Z + (size_t)(n * 128) * INW;
#pragma unroll
    for (int k = 0; k < 8; ++k) { const int it = k * 512 + tid, row = it >> 5, c = it & 31;
        *(LAS u32x4*)(Kr + row * 528 + c * 16) = *(const u32x4*)(zc + (size_t)row * INW + C_RK + h * 256 + c * 8); }
    stage_T128x256(Vt, zc + C_RV + h * 256, tid);
    const int it_ = wid >> 1, dh = wid & 1;
    bf16x8 qf[16];
    { const bf16_t* qp = zc + (size_t)(32 * it_ + r) * INW + C_RQ + h * 256 + 8 * hh;
#pragma unroll
      for (int s = 0; s < 16; ++s) qf[s] = *(const bf16x8*)(qp + 16 * s); }
    f32x16 acc[4];
#pragma unroll
    for (int i = 0; i < 4; ++i) acc[i] = zero16();
    const float gm = gamma_of(h);
    __syncthreads();
    for (int jt = 0; jt <= it_; ++jt) {
        f32x16 X = zero16();
#pragma unroll
        for (int s = 0; s < 16; ++s) { const bf16x8 A = *(const LAS bf16x8*)(Kr + (32 * jt + r) * 528 + (16 * s + 8 * hh) * 2); X = MFMA32(A, qf[s], X); }
        if (jt == it_) {
#pragma unroll
            for (int i = 0; i < 16; ++i) X[i] = (crow(i, hh) > r) ? 0.f : X[i];
        }
#pragma unroll
        for (int s2 = 0; s2 < 2; ++s2) { const bf16x8 xs = pack8(X, s2);
#pragma unroll
            for (int dt = 0; dt < 4; ++dt) { const LAS unsigned char* pa = Vt + (128 * dh + 32 * dt + r) * 264 + (32 * jt + 16 * s2 + 4 * hh) * 2;
                const bf16x8 A = cat4(*(const LAS s16x4*)pa, *(const LAS s16x4*)(pa + 16)); acc[dt] = MFMA32(A, xs, acc[dt]); } }
    }
    { const float ig = 1.0f / gm;
#pragma unroll
      for (int dt = 0; dt < 4; ++dt) acc[dt] = acc[dt] * ig; }
    __syncthreads();
    { const bf16_t* spg = SP + (size_t)(n * 4 + h) * 65536;
#pragma unroll 1
      for (int k0 = 0; k0 < 16; k0 += 4) {
          u32x4 spr[4];
#pragma unroll
          for (int k = 0; k < 4; ++k) { const int it = (k0 + k) * 512 + tid; spr[k] = *(const u32x4*)(spg + (size_t)(it >> 5) * 256 + (it & 31) * 8); }
#pragma unroll
          for (int k = 0; k < 4; ++k) { const int it = (k0 + k) * 512 + tid; *(LAS u32x4*)(lds + (it >> 5) * 528 + (it & 31) * 16) = spr[k]; }
      } }
    __syncthreads();
#pragma unroll
    for (int dt = 0; dt < 4; ++dt)
#pragma unroll
        for (int s = 0; s < 16; ++s) { const bf16x8 A = *(const LAS bf16x8*)(lds + (128 * dh + 32 * dt + r) * 528 + (16 * s + 8 * hh) * 2); acc[dt] = MFMA32(A, qf[s], acc[dt]); }
#pragma unroll
    for (int dt = 0; dt < 4; ++dt) acc[dt] = acc[dt] * gm;
    float ss = 0.f;
#pragma unroll
    for (int dt = 0; dt < 4; ++dt)
#pragma unroll
        for (int i = 0; i < 16; ++i) ss += acc[dt][i] * acc[dt][i];
    ss += __shfl_xor(ss, 32);
    if (hh == 0) red[wid * 32 + r] = ss;
    __syncthreads();
    const float rstd = rsqrtf((red[wid * 32 + r] + red[(wid ^ 1) * 32 + r]) * (1.0f / 256.0f) + EPS);
    const size_t token = (size_t)n * 128 + 32 * it_ + r;
#pragma unroll
    for (int dt = 0; dt < 4; ++dt)
#pragma unroll
        for (int g4 = 0; g4 < 4; ++g4) {
            const int dv = 128 * dh + 32 * dt + 8 * g4 + 4 * hh;
            const u32x2 gz = *(const u32x2*)(Z + token * INW + C_RG + h * 256 + dv);
            const f32x4 gn = *(const f32x4*)(rng + h * 256 + dv);
            const float y0 = acc[dt][4 * g4 + 0] * rstd * gn[0] * silu_f(bflo(gz.x)), y1 = acc[dt][4 * g4 + 1] * rstd * gn[1] * silu_f(bfhi(gz.x));
            const float y2 = acc[dt][4 * g4 + 2] * rstd * gn[2] * silu_f(bflo(gz.y)), y3 = acc[dt][4 * g4 + 3] * rstd * gn[3] * silu_f(bfhi(gz.y));
            u32x2 o; o.x = pk2(y0, y1); o.y = pk2(y2, y3);
            *(u32x2*)(MIX + token * DM + 1024 + h * 256 + dv) = o;
        }
    __syncthreads();
}

DI void ret_decode_unit(LAS unsigned char* lds, const bf16_t* Z, const float* S0, float* S1, bf16_t* MIX, const float* rng, int b, int h, int tid) {
    LAS float* qv = (LAS float*)lds; LAS float* red = qv + 768;
    const int lane = tid & 63, wid = tid >> 6;
    const bf16_t* zrow = Z + (size_t)(LP + b) * INW;
    if (tid < 256) { qv[tid] = bf2f(zrow[C_RQ + h * 256 + tid]); qv[256 + tid] = bf2f(zrow[C_RK + h * 256 + tid]); qv[512 + tid] = bf2f(zrow[C_RV + h * 256 + tid]); }
    __syncthreads();
    const float gm = gamma_of(h);
    const f32x4 v4 = *(const LAS f32x4*)(qv + 512 + 4 * lane);
    f32x4 acc = {0.f, 0.f, 0.f, 0.f};
    const size_t off = ((size_t)(b * 4 + h) * 256 + wid * 32) * 256 + 4 * lane;
    const float* s0 = S0 + off; float* s1 = S1 + off;
#pragma unroll 1
    for (int rr = 0; rr < 32; rr += 16) {
        f32x4 s[16];
#pragma unroll
        for (int u = 0; u < 16; ++u) s[u] = __builtin_nontemporal_load((const f32x4*)(s0 + (size_t)(rr + u) * 256));
#pragma unroll
        for (int u = 0; u < 16; ++u) { const int dk = wid * 32 + rr + u; const float kk = qv[256 + dk], qq = qv[dk];
            const f32x4 sn = s[u] * gm + v4 * kk; __builtin_nontemporal_store(sn, (f32x4*)(s1 + (size_t)(rr + u) * 256)); acc += sn * qq; }
    }
    *(LAS f32x4*)(red + wid * 256 + 4 * lane) = acc;
    __syncthreads();
    if (wid == 0) {
        f32x4 o = {0.f, 0.f, 0.f, 0.f};
#pragma unroll
        for (int w = 0; w < 8; ++w) o += *(const LAS f32x4*)(red + w * 256 + 4 * lane);
        const float ssq = wave_sum((o[0] * o[0] + o[1] * o[1]) + (o[2] * o[2] + o[3] * o[3]));
        const float rstd = rsqrtf(ssq * (1.0f / 256.0f) + EPS);
        const u32x2 gz = *(const u32x2*)(zrow + C_RG + h * 256 + 4 * lane);
        const f32x4 gn = *(const f32x4*)(rng + h * 256 + 4 * lane);
        u32x2 y; y.x = pk2(o[0] * rstd * gn[0] * silu_f(bflo(gz.x)), o[1] * rstd * gn[1] * silu_f(bfhi(gz.x)));
        y.y = pk2(o[2] * rstd * gn[2] * silu_f(bflo(gz.y)), o[3] * rstd * gn[3] * silu_f(bfhi(gz.y)));
        *(u32x2*)(MIX + (size_t)(LP + b) * DM + 1024 + h * 256 + 4 * lane) = y;
    }
    __syncthreads();
}

DI void attn_prompt_unit(LAS unsigned char* lds, const bf16_t* Z, bf16_t* MIX, const float* gq, const float* gk, const float* sinks, float* o_k, float* o_v, int nb, int kh, int hf, int tid) {
    LAS unsigned char* Kn = lds; LAS unsigned char* Vt = lds + 256 * 144;
    const int lane = tid & 63, wid = tid >> 6, r = lane & 31, hh = lane >> 5;
    {
        const int row = tid >> 1, half = tid & 1; const int tok = (nb - 1) * 128 + row;
        u32x4 v[4];
#pragma unroll
        for (int c = 0; c < 4; ++c) v[c] = (u32x4){0u, 0u, 0u, 0u};
        if (tok >= 0) {
#pragma unroll
            for (int c = 0; c < 4; ++c) v[c] = *(const u32x4*)(Z + (size_t)tok * INW + C_AK + kh * 64 + half * 32 + c * 8);
        }
        float f[32]; float ss = 0.f;
#pragma unroll
        for (int c = 0; c < 4; ++c)
#pragma unroll
            for (int e = 0; e < 4; ++e) { f[c * 8 + 2 * e] = bflo(v[c][e]); f[c * 8 + 2 * e + 1] = bfhi(v[c][e]); }
#pragma unroll
        for (int e = 0; e < 32; ++e) ss += f[e] * f[e];
        ss += __shfl_xor(ss, 1);
        const float rstd = rsqrtf(ss * (1.0f / 64.0f) + EPS);
#pragma unroll
        for (int c = 0; c < 8; ++c) { const f32x4 g = *(const f32x4*)(gk + half * 32 + c * 4);
#pragma unroll
            for (int e = 0; e < 4; ++e) f[c * 4 + e] *= rstd * g[e]; }
#pragma unroll
        for (int c = 0; c < 4; ++c) { u32x4 w; w.x = pk2(f[c * 8], f[c * 8 + 1]); w.y = pk2(f[c * 8 + 2], f[c * 8 + 3]); w.z = pk2(f[c * 8 + 4], f[c * 8 + 5]); w.w = pk2(f[c * 8 + 6], f[c * 8 + 7]);
            *(LAS u32x4*)(Kn + row * 144 + half * 64 + c * 16) = w; }
        if (nb == 63 && hf == 0 && row >= 128) { float* o = o_k + ((size_t)(row - 128) * 2 + kh) * 64 + half * 32;
#pragma unroll
            for (int c = 0; c < 8; ++c) *(f32x4*)(o + c * 4) = (f32x4){f[c * 4], f[c * 4 + 1], f[c * 4 + 2], f[c * 4 + 3]}; }
    }
#pragma unroll
    for (int k = 0; k < 2; ++k) {
        const int it = k * 512 + tid, kpl = it & 15, dgl = (it >> 4) & 3, rest = it >> 6, dg = dgl + 4 * (rest & 1), kp = kpl + 16 * (rest >> 1);
        const int tok0 = (nb - 1) * 128 + 2 * kp;
        u32x4 a = {0u, 0u, 0u, 0u}, b = {0u, 0u, 0u, 0u};
        if (tok0 >= 0) { const bf16_t* p = Z + (size_t)tok0 * INW + C_AV + kh * 64 + dg * 8; a = *(const u32x4*)p; b = *(const u32x4*)(p + INW); }
#pragma unroll
        for (int e = 0; e < 8; ++e) {
            const unsigned lo = (e & 1) ? (a[e >> 1] >> 16) : (a[e >> 1] & 0xffffu), hi = (e & 1) ? (b[e >> 1] & 0xffff0000u) : (b[e >> 1] << 16);
            *(LAS unsigned*)(Vt + (dg * 8 + e) * 520 + kp * 4) = lo | hi;
        }
        if (nb == 63 && hf == 0 && kp >= 64) { float* o = o_v + ((size_t)(2 * kp - 128) * 2 + kh) * 64 + dg * 8;
#pragma unroll
            for (int e = 0; e < 4; ++e) { o[2 * e] = bflo(a[e]); o[2 * e + 1] = bfhi(a[e]); o[128 + 2 * e] = bflo(b[e]); o[128 + 2 * e + 1] = bfhi(b[e]); } }
    }
    __syncthreads();
    const int hq = kh * 8 + 4 * hf + (wid >> 1), qh = wid & 1;
    const float sink = sinks[hq];
#pragma unroll 1
    for (int qq = 0; qq < 2; ++qq) {
        const int qi = 2 * qh + qq; const size_t tokq = (size_t)nb * 128 + 32 * qi + r;
        bf16x8 qf[4];
        {   const bf16_t* qp = Z + tokq * INW + hq * 64 + 8 * hh;
            u32x4 raw[4]; float ss = 0.f;
#pragma unroll
            for (int s = 0; s < 4; ++s) { raw[s] = *(const u32x4*)(qp + 16 * s);
#pragma unroll
                for (int e = 0; e < 4; ++e) { const float lo = bflo(raw[s][e]), hi = bfhi(raw[s][e]); ss += lo * lo + hi * hi; } }
            ss += __shfl_xor(ss, 32);
            const float rstd = rsqrtf(ss * (1.0f / 64.0f) + EPS) * 0.125f;
#pragma unroll
            for (int s = 0; s < 4; ++s) { const f32x4 g0 = *(const f32x4*)(gq + 16 * s + 8 * hh), g1 = *(const f32x4*)(gq + 16 * s + 8 * hh + 4); u32x4 w;
                w.x = pk2(bflo(raw[s].x) * rstd * g0[0], bfhi(raw[s].x) * rstd * g0[1]); w.y = pk2(bflo(raw[s].y) * rstd * g0[2], bfhi(raw[s].y) * rstd * g0[3]);
                w.z = pk2(bflo(raw[s].z) * rstd * g1[0], bfhi(raw[s].z) * rstd * g1[1]); w.w = pk2(bflo(raw[s].w) * rstd * g1[2], bfhi(raw[s].w) * rstd * g1[3]);
                qf[s] = __builtin_bit_cast(bf16x8, w); }
        }
        f32x16 X[5];
#pragma unroll
        for (int t = 0; t < 5; ++t) { X[t] = zero16();
#pragma unroll
            for (int s = 0; s < 4; ++s) { const bf16x8 A = *(const LAS bf16x8*)(Kn + (32 * (qi + t) + r) * 144 + (16 * s + 8 * hh) * 2); X[t] = MFMA32(A, qf[s], X[t]); } }
        const int ii = 32 * qi + r;
        float m = -1e30f;
#pragma unroll
        for (int t = 0; t < 5; ++t)
#pragma unroll
            for (int i = 0; i < 16; ++i) { const int jj = 32 * (qi + t) + crow(i, hh); const bool ok = (jj >= ii) && (jj <= ii + 128) && (nb > 0 || jj >= 128);
                X[t][i] = ok ? X[t][i] : -1e30f; m = fmaxf(m, X[t][i]); }
        m = fmaxf(m, __shfl_xor(m, 32)); m = fmaxf(m, sink);
        float sum = 0.f;
#pragma unroll
        for (int t = 0; t < 5; ++t)
#pragma unroll
            for (int i = 0; i < 16; ++i) { const float p = __expf(X[t][i] - m); X[t][i] = p; sum += p; }
        sum += __shfl_xor(sum, 32);
        const float inv = 1.0f / (sum + __expf(sink - m));
        f32x16 o[2]; o[0] = zero16(); o[1] = zero16();
#pragma unroll
        for (int t = 0; t < 5; ++t)
#pragma unroll
            for (int s2 = 0; s2 < 2; ++s2) { const bf16x8 xs = pack8(X[t], s2);
#pragma unroll
                for (int dt = 0; dt < 2; ++dt) { const LAS unsigned char* pa = Vt + (32 * dt + r) * 520 + (32 * (qi + t) + 16 * s2 + 4 * hh) * 2;
                    const bf16x8 A = cat4(*(const LAS s16x4*)pa, *(const LAS s16x4*)(pa + 16)); o[dt] = MFMA32(A, xs, o[dt]); } }
#pragma unroll
        for (int dt = 0; dt < 2; ++dt)
#pragma unroll
            for (int g4 = 0; g4 < 4; ++g4) { u32x2 w; w.x = pk2(o[dt][4 * g4] * inv, o[dt][4 * g4 + 1] * inv); w.y = pk2(o[dt][4 * g4 + 2] * inv, o[dt][4 * g4 + 3] * inv);
                *(u32x2*)(MIX + tokq * DM + hq * 64 + 32 * dt + 8 * g4 + 4 * hh) = w; }
    }
    __syncthreads();
}

DI void attn_decode_unit(LAS unsigned char* lds, const bf16_t* Z, const float* ck, const float* cv, bf16_t* MIX, const float* gq, const float* gk, const float* sinks, float* o_k, float* o_v, int b, int kh, int tid) {
    LAS float* Kc = (LAS float*)lds; LAS float* Vc = Kc + 129 * 65; LAS float* qs = Vc + 129 * 64; LAS float* pw = qs + 512;
    const int lane = tid & 63, wid = tid >> 6;
#pragma unroll
    for (int k = 0; k < 4; ++k) {
        const int it = k * 512 + tid, w = it >> 4, c4 = (it & 15) * 4;
        const size_t src = ((size_t)(b * 128 + w) * 2 + kh) * 64 + c4;
        const f32x4 k4 = *(const f32x4*)(ck + src), v4 = *(const f32x4*)(cv + src);
#pragma unroll
        for (int e = 0; e < 4; ++e) { Kc[w * 65 + c4 + e] = k4[e]; Vc[w * 64 + c4 + e] = v4[e]; }
        if (w >= 1) { const size_t dst = ((size_t)(b * 128 + w - 1) * 2 + kh) * 64 + c4; *(f32x4*)(o_k + dst) = k4; *(f32x4*)(o_v + dst) = v4; }
    }
    const bf16_t* zrow = Z + (size_t)(LP + b) * INW;
    const size_t dnew = ((size_t)(b * 128 + 127) * 2 + kh) * 64 + lane;
    if (wid == 0) { const float kx = bf2f(zrow[C_AK + kh * 64 + lane]); const float ss = wave_sum(kx * kx); const float kn = kx * rsqrtf(ss * (1.0f / 64.0f) + EPS) * gk[lane];
        Kc[128 * 65 + lane] = kn; o_k[dnew] = kn; }
    if (wid == 1) { const float vx = bf2f(zrow[C_AV + kh * 64 + lane]); Vc[128 * 64 + lane] = vx; o_v[dnew] = vx; }
    const int hq = kh * 8 + wid;
    { const float qx = bf2f(zrow[hq * 64 + lane]); const float ss = wave_sum(qx * qx); qs[wid * 64 + lane] = qx * rsqrtf(ss * (1.0f / 64.0f) + EPS) * gq[lane] * 0.125f; }
    __syncthreads();
    float s1 = 0.f, s2 = 0.f;
#pragma unroll 8
    for (int d = 0; d < 64; ++d) { const float q = qs[wid * 64 + d]; s1 += q * Kc[lane * 65 + d]; s2 += q * Kc[(lane + 64) * 65 + d]; }
    const float s3 = wave_sum(qs[wid * 64 + lane] * Kc[128 * 65 + lane]);
    const float sink = sinks[hq];
    const float m = fmaxf(wave_max(fmaxf(s1, s2)), fmaxf(s3, sink));
    const float p1 = __expf(s1 - m), p2 = __expf(s2 - m), p3 = __expf(s3 - m);
    const float denom = wave_sum(p1 + p2) + p3 + __expf(sink - m);
    pw[wid * 132 + lane] = p1; pw[wid * 132 + 64 + lane] = p2; if (lane == 0) pw[wid * 132 + 128] = p3;
    __syncthreads();
    float o = 0.f;
#pragma unroll 3
    for (int j = 0; j < 129; ++j) o += pw[wid * 132 + j] * Vc[j * 64 + lane];
    MIX[(size_t)(LP + b) * DM + hq * 64 + lane] = (bf16_t)(pk2(o / denom, 0.f) & 0xffffu);
    __syncthreads();
}

template <class Epi>
DI void skinny_unit(LAS unsigned char* lds, const bf16_t* A, const bf16_t* Wt, int K, int cgi, int k0, const Epi& E, int tid) {
    const int lane = tid & 63, wid = tid >> 6, r = lane & 31, hh = lane >> 5;
    const int c0 = cgi * 32;
    const bf16_t* pa = A + (size_t)r * K + k0 + wid * 256 + 8 * hh;
    const bf16_t* pb = Wt + (size_t)(c0 + r) * K + k0 + wid * 256 + 8 * hh;
    const size_t rs = (size_t)32 * K;
    f32x16 acc[4];
#pragma unroll
    for (int i = 0; i < 4; ++i) acc[i] = zero16();
    bf16x8 fb[3][2], fa[3][2][4];
#define SK_LOAD(buf, c) do { _Pragma("unroll") for (int s = 0; s < 2; ++s) { fb[buf][s] = *(const bf16x8*)(pb + 32 * (c) + 16 * s); \
        _Pragma("unroll") for (int mt = 0; mt < 4; ++mt) fa[buf][s][mt] = *(const bf16x8*)(pa + mt * rs + 32 * (c) + 16 * s); } } while (0)
#define SK_MMA(buf) do { _Pragma("unroll") for (int s = 0; s < 2; ++s) _Pragma("unroll") for (int mt = 0; mt < 4; ++mt) acc[mt] = MFMA32(fa[buf][s][mt], fb[buf][s], acc[mt]); } while (0)
    SK_LOAD(0, 0); SK_LOAD(1, 1);
    SK_LOAD(2, 2); SK_MMA(0);
    SK_LOAD(0, 3); SK_MMA(1);
    SK_LOAD(1, 4); SK_MMA(2);
    SK_LOAD(2, 5); SK_MMA(0);
    SK_LOAD(0, 6); SK_MMA(1);
    SK_LOAD(1, 7); SK_MMA(2);
    SK_MMA(0); SK_MMA(1);
#undef SK_LOAD
#undef SK_MMA
    LAS float* red = (LAS float*)lds;
#pragma unroll
    for (int mt = 0; mt < 4; ++mt)
#pragma unroll
        for (int i = 0; i < 16; ++i) red[(wid * 128 + mt * 32 + crow(i, hh)) * 32 + r] = acc[mt][i];
    __syncthreads();
    const int row = tid >> 2, c8 = (tid & 3) * 8;
    f32x4 sa = {0.f, 0.f, 0.f, 0.f}, sb = {0.f, 0.f, 0.f, 0.f};
#pragma unroll
    for (int w = 0; w < 8; ++w) { sa += *(const LAS f32x4*)(red + (w * 128 + row) * 32 + c8); sb += *(const LAS f32x4*)(red + (w * 128 + row) * 32 + c8 + 4); }
    E(row, c0 + c8, sa); E(row, c0 + c8 + 4, sb);
    __syncthreads();
}
struct SkOut { const float* xs; float* X1s; bf16_t* XGs; const float* g2;
    DI void operator()(int row, int col, f32x4 a) const { const f32x4 v = a + *(const f32x4*)(xs + (size_t)row * DM + col); *(f32x4*)(X1s + (size_t)row * DM + col) = v;
        const f32x4 g = *(const f32x4*)(g2 + col); u32x2 o; o.x = pk2(v[0] * g[0], v[1] * g[1]); o.y = pk2(v[2] * g[2], v[3] * g[3]); *(u32x2*)(XGs + (size_t)row * DM + col) = o; } };
struct SkUp { bf16_t* Us;
    DI void operator()(int row, int col, f32x4 a) const {
#pragma unroll
        for (int e = 0; e < 4; ++e) { a[e] = fmaxf(a[e], 0.f); a[e] *= a[e]; }
        u32x2 o; o.x = pk2(a[0], a[1]); o.y = pk2(a[2], a[3]); *(u32x2*)(Us + (size_t)row * FF + col) = o; } };
struct SkSlab { float* slab;
    DI void operator()(int row, int col, f32x4 a) const { *(f32x4*)(slab + (size_t)row * DM + col) = a; } };

#define RLX_AGENT __ATOMIC_RELAXED, __HIP_MEMORY_SCOPE_AGENT
#define XB_TMO      128
#define XB_XCNT(j)  (256  + 64 * (j))
#define XB_XSUB(j)  (1280 + 64 * (j))
#define XB_XGEN(j)  (2304 + 64 * (j))
#define XB_TOP      3328
#define XB_TOPGEN   3392
#define XCD_BAR_WORDS 3456
#define XB_SPIN_CAP (1u << 18)

__device__ __forceinline__ unsigned xb_ld(unsigned* p)              { return __hip_atomic_load(p, __ATOMIC_RELAXED, __HIP_MEMORY_SCOPE_AGENT); }
__device__ __forceinline__ unsigned xb_add(unsigned* p, unsigned v) { return __hip_atomic_fetch_add(p, v, __ATOMIC_RELAXED, __HIP_MEMORY_SCOPE_AGENT); }
__device__ __forceinline__ unsigned xb_xcc_id() { return (unsigned)__builtin_amdgcn_s_getreg((3 << 11) | 20) & 0xFu; }
#define XB_SPIN(cond, bar) do { unsigned _sp = 0; while (cond) { __builtin_amdgcn_s_sleep(1); \
    if ((++_sp & 255u) == 0u) { if (xb_ld(&(bar)[XB_TMO])) break; if (_sp > XB_SPIN_CAP) { atomicAdd(&(bar)[XB_TMO], 1u); break; } } } } while (0)

struct XcdBarrier {
    unsigned* bar; unsigned x;
    volatile LAS unsigned* st;
};

__device__ __forceinline__ XcdBarrier xcd_barrier_post(unsigned* bar, volatile LAS unsigned* st) {
    XcdBarrier b; b.bar = bar; b.x = xb_xcc_id(); b.st = st;
    if (threadIdx.x == 0) (void)xb_add(&bar[XB_XCNT(b.x)], 1u);
    return b;
}
__device__ __forceinline__ void xcd_barrier_complete(unsigned* bar, unsigned x, unsigned& nloc, unsigned& nx) {
    const unsigned G = gridDim.x * gridDim.y * gridDim.z;
    unsigned sum, cnt, mine, sp = 0u;
    for (;;) {
        sum = 0u; cnt = 0u; mine = 0u;
#pragma unroll
        for (unsigned j = 0; j < 16; ++j) { const unsigned c = xb_ld(&bar[XB_XCNT(j)]); sum += c; cnt += (c > 0u) ? 1u : 0u; mine = (j == x) ? c : mine; }
        if (sum == G) break;
        __builtin_amdgcn_s_sleep(1);
        if ((++sp & 255u) == 0u) { if (xb_ld(&bar[XB_TMO])) break; if (sp > XB_SPIN_CAP) { atomicAdd(&bar[XB_TMO], 1u); break; } }
    }
    nloc = mine > 0u ? mine : 1u; nx = cnt > 0u ? cnt : 1u;
}

__device__ __forceinline__ void xcd_barrier(const XcdBarrier& b) {
    asm volatile("s_waitcnt vmcnt(0)" ::: "memory");
    __syncthreads();
    if (threadIdx.x == 0) {
        unsigned* bar = b.bar;
        __builtin_amdgcn_s_waitcnt(0);
        unsigned nloc = b.st[0], nx = b.st[1];
        if (nloc == 0u) { xcd_barrier_complete(bar, b.x, nloc, nx); b.st[0] = nloc; b.st[1] = nx; }
        const unsigned old = xb_add(&bar[XB_XSUB(b.x)], 1u);
        const unsigned gen = old / nloc;
        if (old + 1u == (gen + 1u) * nloc) {
            __builtin_amdgcn_fence(__ATOMIC_RELEASE, "agent");
            asm volatile("s_waitcnt vmcnt(0)" ::: "memory");
            const unsigned og = xb_add(&bar[XB_TOP], 1u);
            const unsigned tg = og / nx;
            if (og + 1u == (tg + 1u) * nx) xb_add(&bar[XB_TOPGEN], 1u);
            else XB_SPIN(xb_ld(&bar[XB_TOPGEN]) == tg, bar);
            __builtin_amdgcn_fence(__ATOMIC_ACQUIRE, "agent");
            xb_add(&bar[XB_XGEN(b.x)], 1u);
            asm volatile("s_waitcnt vmcnt(0)" ::: "memory");
        } else {
            XB_SPIN(xb_ld(&bar[XB_XGEN(b.x)]) == gen, bar);
            __builtin_amdgcn_fence(__ATOMIC_ACQUIRE, "agent");
            asm volatile("s_waitcnt vmcnt(0)" ::: "memory");
        }
    }
    __syncthreads();
}

struct Args { const float* in[15]; float* out; unsigned char* ws; int ph_lo, ph_hi; };
constexpr int NPH = 9;
constexpr int NP0_REST = 7424;

__global__ void __launch_bounds__(512, 2) fwd_kernel(Args a) {
    extern __shared__ __attribute__((aligned(16))) unsigned char lds_raw[];
    LAS unsigned char* lds = (LAS unsigned char*)lds_raw;
    cg::grid_group grid = cg::this_grid();
    const int tid = threadIdx.x, lane = tid & 63, wid = __builtin_amdgcn_readfirstlane(tid >> 6);
    const int G = gridDim.x, bx = blockIdx.x;
    unsigned char* ws = a.ws; float* out = a.out;
    const float* x_p = a.in[0]; const float* x_s = a.in[1]; const float* cache_k = a.in[2]; const float* cache_v = a.in[3]; const float* state0 = a.in[4];
    const float* ln1_g = a.in[5]; const float* w_in = a.in[6]; const float* gq = a.in[7]; const float* gk = a.in[8]; const float* sinks = a.in[9];
    const float* rng = a.in[10]; const float* w_out = a.in[11]; const float* ln2_g = a.in[12]; const float* w_up = a.in[13]; const float* w_dn = a.in[14];
    bf16_t* WIN = (bf16_t*)(ws + WS_WIN); bf16_t* WOUT = (bf16_t*)(ws + WS_WOUT); bf16_t* WUP = (bf16_t*)(ws + WS_WUP); bf16_t* WDN = (bf16_t*)(ws + WS_WDN);
    bf16_t* H1 = (bf16_t*)(ws + WS_H1); bf16_t* XG = H1; bf16_t* MIX = (bf16_t*)(ws + WS_MIX); bf16_t* Z = (bf16_t*)(ws + WS_Z); bf16_t* U = (bf16_t*)(ws + WS_U);
    float* PART = (float*)(ws + WS_PART); float* RSTD2 = (float*)(ws + WS_RSTD2); bf16_t* KV = (bf16_t*)(ws + WS_KV); bf16_t* SP = (bf16_t*)(ws + WS_SP); float* SLAB = (float*)(ws + WS_SP);
    const int lo = a.ph_lo, hi = a.ph_hi;
#define IN(k) (lo <= (k) && (k) < hi)
    volatile LAS unsigned* MISC = (volatile LAS unsigned*)(lds + LDS_BYTES - 64);
    if (tid < 16) MISC[tid] = 0u;
    __syncthreads();
    const XcdBarrier bar = xcd_barrier_post((unsigned*)ws + 1024, MISC + 8);
    if (lo > hi) grid.sync();
#define SEAM(k) do { if (IN(k) && IN((k) + 1)) xcd_barrier(bar); } while (0)

    if (IN(0)) for (int rep_ = 0; rep_ < 1 + ((DUPMASK >> 0) & 1); ++rep_) { if (rep_) xcd_barrier(bar);
        LAS float* scr = (LAS float*)(lds + wid * 17408);
        const int gw = bx * 8 + wid, NGW = G * 8;
        constexpr int I_IN = (DM / 64) * (INW / 32);
        p0_convert(ResIn{w_in, WIN}, gw, NGW, I_IN, scr, lane);
        p0_convert(ResRest{w_out, w_up, w_dn, WOUT, WUP, WDN}, gw, NGW, NP0_REST, scr, lane);
        for (int m = gw; m < MP; m += NGW) {
            if (m < MR) rms_row(m < LP ? x_p + (size_t)m * DM : x_s + (size_t)(m - LP) * DM, ln1_g, H1 + (size_t)m * DM, lane);
            else {
#pragma unroll
                for (int j = 0; j < 8; ++j) *((u32x2*)(H1 + (size_t)m * DM) + lane + 64 * j) = (u32x2){0u, 0u};
            }
        }
    }
    SEAM(0);
    if (IN(1)) for (int rep_ = 0; rep_ < 1 + ((DUPMASK >> 1) & 1); ++rep_) { if (rep_) xcd_barrier(bar);
        pg8::Gemm g{H1, WIN, MP, INW, DM}; pg8::StaticOrder S; S.init(MP, INW, G, bx, WGM_IN);
        pg8::EpiIn E{Z};
        pg8::gemm_phase<pg8::EpiIn, pg8::StaticOrder, true, true>(lds, g, S, E);
        {
            constexpr int NT = (MP / 256) * (INW / 256); const int rounds = (NT + G - 1) / G, first_idle = NT - (rounds - 1) * G;
            const int nidle = (first_idle < G) ? (G - first_idle) : G, me = (first_idle < G) ? (bx - first_idle) : bx;
            if (me >= 0) {
                LAS float* scr = (LAS float*)(lds + wid * 17408);
                constexpr int I_OUT = (DM / 64) * (DM / 32), I_UP = (DM / 64) * (FF / 32), I_DN = (FF / 64) * (DM / 32);
                p0_convert(ResRest{w_out, w_up, w_dn, WOUT, WUP, WDN}, NP0_REST + me * 8 + wid, nidle * 8, I_OUT + I_UP + I_DN, scr, lane);
            }
        }
    }
    SEAM(1);
    if (IN(2)) for (int rep_ = 0; rep_ < 1 + ((DUPMASK >> 2) & 1); ++rep_) { if (rep_) xcd_barrier(bar);
        if (bx & 1) for (int u = bx; u < 256; u += G) ret_decode_unit(lds, Z, state0, out + O_SS, MIX, rng, u >> 2, u & 3, tid);
        for (int u = bx; u < 256; u += G) ret_step1(lds, Z, KV, u >> 2, u & 3, tid);
        if (!(bx & 1)) for (int u = bx; u < 256; u += G) ret_decode_unit(lds, Z, state0, out + O_SS, MIX, rng, u >> 2, u & 3, tid);
    }
    SEAM(2);
    if (IN(3)) for (int rep_ = 0; rep_ < 1 + ((DUPMASK >> 3) & 1); ++rep_) { if (rep_) xcd_barrier(bar);
        if (tid < 256) ret_scan(KV, SP, out + O_SP, bx * 256 + tid, G * 256);
        if (bx & 1) for (int u = bx; u < 256; u += G) attn_decode_unit(lds, Z, cache_k, cache_v, MIX, gq, gk, sinks, out + O_KS, out + O_VS, u >> 1, u & 1, tid);
        for (int u = 256 + bx; u < 512; u += G) ret_decode_unit(lds, Z, state0, out + O_SS, MIX, rng, u >> 2, u & 3, tid);
        if (!(bx & 1)) for (int u = bx; u < 256; u += G) attn_decode_unit(lds, Z, cache_k, cache_v, MIX, gq, gk, sinks, out + O_KS, out + O_VS, u >> 1, u & 1, tid);
    }
    SEAM(3);
    if (IN(4)) for (int rep_ = 0; rep_ < 1 + ((DUPMASK >> 4) & 1); ++rep_) { if (rep_) xcd_barrier(bar);
        for (int u = bx; u < 256; u += G) ret_step2(lds, Z, SP, MIX, rng, u >> 2, u & 3, tid);
        for (int u = bx; u < 256; u += G) attn_prompt_unit(lds, Z, MIX, gq, gk, sinks, out + O_KP, out + O_VP, u >> 2, (u >> 1) & 1, u & 1, tid);
    }
    SEAM(4);
    if (IN(5)) for (int rep_ = 0; rep_ < 1 + ((DUPMASK >> 5) & 1); ++rep_) { if (rep_) xcd_barrier(bar);
        pg8::Gemm g{MIX, WOUT, LP, DM, DM}; pg8::StaticOrder S; S.init(LP, DM, G, bx, WGM_OUT);
        pg8::EpiOut E{x_p, x_s, out + O_Y, XG, ln2_g, PART};
        pg8::gemm_phase<pg8::EpiOut, pg8::StaticOrder, true, true>(lds, g, S, E);
        const SkOut SE{x_s, out + O_Y + (size_t)LP * DM, XG + (size_t)LP * DM, ln2_g};
        for (int u = G - 1 - bx; u < DM / 32; u += G) skinny_unit(lds, MIX + (size_t)LP * DM, WOUT, DM, u, 0, SE, tid);
    }
    SEAM(5);
    if (IN(6)) for (int rep_ = 0; rep_ < 1 + ((DUPMASK >> 6) & 1); ++rep_) { if (rep_) xcd_barrier(bar);
        for (int row = bx + G * tid; row < LP; row += G * 512) { float s = 0.f;
#pragma unroll
            for (int j = 0; j < 8; ++j) { const f32x4 p = *(const f32x4*)(PART + (size_t)row * 32 + 4 * j); s += (p[0] + p[1]) + (p[2] + p[3]); }
            RSTD2[row] = 1.0f / (s * (1.0f / DM) + EPS); }
        for (int row = LP + bx * 8 + wid; row < MR; row += G * 8) {
            const float* xr = out + O_Y + (size_t)row * DM; float s = 0.f;
#pragma unroll
            for (int j = 0; j < 8; ++j) { const f32x4 v = *((const f32x4*)xr + lane + 64 * j); s += (v[0] * v[0] + v[1] * v[1]) + (v[2] * v[2] + v[3] * v[3]); }
            s = wave_sum(s); if (lane == 0) RSTD2[row] = 1.0f / (s * (1.0f / DM) + EPS); }
        pg8::Gemm g{XG, WUP, LP, FF, DM}; pg8::StaticOrder S; S.init(LP, FF, G, bx, WGM_UP);
        pg8::EpiUp E{U};
        pg8::gemm_phase<pg8::EpiUp, pg8::StaticOrder, true, true>(lds, g, S, E);
        const SkUp SE{U + (size_t)LP * FF};
        for (int u = bx; u < FF / 32; u += G) skinny_unit(lds, XG + (size_t)LP * DM, WUP, DM, u, 0, SE, tid);
    }
    SEAM(6);
    if (IN(7)) {
        pg8::Gemm g{U, WDN, LP, DM, FF}; pg8::StaticOrder S; S.init(LP, DM, G, bx, WGM_DN);
        pg8::EpiDown E{out + O_Y, RSTD2};
        pg8::gemm_phase<pg8::EpiDown, pg8::StaticOrder, true, true>(lds, g, S, E);
        for (int u = bx; u < 4 * (DM / 32); u += G) { const SkSlab SE{SLAB + (size_t)(u & 3) * NS * DM}; skinny_unit(lds, U + (size_t)LP * FF, WDN, FF, u >> 2, (u & 3) * 2048, SE, tid); }
    }
    SEAM(7);
    if (IN(8)) {
        for (int e = bx * 512 + tid; e < NS * DM / 4; e += G * 512) {
            const int row = e >> 9; float* p = out + O_Y + (size_t)LP * DM + (size_t)e * 4;
            const f32x4 s = (*(const f32x4*)(SLAB + (size_t)e * 4) + *(const f32x4*)(SLAB + (size_t)NS * DM + (size_t)e * 4)) + (*(const f32x4*)(SLAB + (size_t)2 * NS * DM + (size_t)e * 4) + *(const f32x4*)(SLAB + (size_t)3 * NS * DM + (size_t)e * 4));
            *(f32x4*)p = *(const f32x4*)p + s * RSTD2[LP + row];
        }
    }
#undef IN
#undef SEAM
}

#ifndef N_LAUNCHES
#define N_LAUNCHES 1
#endif
extern "C" void kernel_launch(void* const* d_in, const int* in_sizes, int n_in, void* d_out, int out_size, void* d_ws, size_t ws_size, hipStream_t stream) {
    static int grid = 0;
    if (grid == 0) {
        if (n_in != 15 || (size_t)out_size != O_END || ws_size < WS_END) { fprintf(stderr, "kernel_launch: unexpected shapes (n_in %d out %d ws %zu)\n", n_in, out_size, ws_size); grid = -1; return; }
        int dev = 0, cus = 0, per_cu = 0;
        (void)hipGetDevice(&dev); (void)hipDeviceGetAttribute(&cus, hipDeviceAttributeMultiprocessorCount, dev);
        if (hipFuncSetAttribute((const void*)fwd_kernel, hipFuncAttributeMaxDynamicSharedMemorySize, LDS_BYTES) != hipSuccess) { fprintf(stderr, "kernel_launch: hipFuncSetAttribute failed\n"); grid = -1; return; }
        (void)hipOccupancyMaxActiveBlocksPerMultiprocessor(&per_cu, (const void*)fwd_kernel, 512, LDS_BYTES);
        (void)hipGetLastError();
        if (per_cu < 1) { fprintf(stderr, "kernel_launch: occupancy query says %d blocks per CU\n", per_cu); }
        grid = cus > 0 ? cus : 256;
    }
    if (grid < 0) return;
    if (hipMemsetAsync(d_ws, 0, 65536, stream) != hipSuccess) { fprintf(stderr, "kernel_launch: memset failed\n"); return; }
    Args a{};
    for (int i = 0; i < 15; ++i) a.in[i] = (const float*)d_in[i];
    a.out = (float*)d_out; a.ws = (unsigned char*)d_ws;
    if (N_LAUNCHES == 1) {
        a.ph_lo = 0; a.ph_hi = NPH;
        void* args[] = {&a};
        hipError_t e = hipLaunchCooperativeKernel((const void*)fwd_kernel, dim3(grid), dim3(512), args, LDS_BYTES, stream);
        if (e != hipSuccess) fprintf(stderr, "cooperative launch failed: %s (grid %d)\n", hipGetErrorString(e), grid);
    } else {
        for (int p = 0; p < NPH; ++p) { a.ph_lo = p; a.ph_hi = p + 1; hipLaunchKernelGGL(fwd_kernel, dim3(grid), dim3(512), LDS_BYTES, stream, a); }
    }
}
```

```cpp
#include <hip/hip_runtime.h>
#include <hip/hip_cooperative_groups.h>
#include <cstdio>
#include <cstdint>
namespace cg = cooperative_groups;

#ifndef WGM_IN
#define WGM_IN 2
#endif
#ifndef WGM_OUT
#define WGM_OUT 2
#endif
#ifndef WGM_UP
#define WGM_UP 2
#endif
#ifndef WGM_DN
#define WGM_DN 2
#endif
#ifndef DUPMASK
#define DUPMASK 0
#endif
#define DI __device__ __forceinline__
#define LAS __attribute__((address_space(3)))
typedef float f32x2 __attribute__((ext_vector_type(2)));
typedef float f32x16 __attribute__((ext_vector_type(16)));
typedef short s16x4 __attribute__((ext_vector_type(4)));
typedef unsigned u32x2 __attribute__((ext_vector_type(2)));
typedef __bf16 bf16x2v __attribute__((ext_vector_type(2)));

constexpr int DM = 2048, LP = 8192, NS = 128, MR = LP + NS  , MP = 8448  ;
constexpr int INW = 5376, FF = 8192;
constexpr int C_AQ = 0, C_AK = 1024, C_AV = 1152, C_RQ = 1280, C_RK = 2304, C_RV = 3328, C_RG = 4352;
constexpr float EPS = 1e-6f;

DI unsigned pk2(float lo, float hi) { f32x2 v = {lo, hi}; return __builtin_bit_cast(unsigned, __builtin_convertvector(v, bf16x2v)); }
DI float bflo(unsigned u) { return __uint_as_float(u << 16); }
DI float bfhi(unsigned u) { return __uint_as_float(u & 0xffff0000u); }
DI float bf2f(unsigned short u) { return __uint_as_float(((unsigned)u) << 16); }

namespace pg8 {
#define PG8_LAS __attribute__((address_space(3)))
typedef unsigned short bf16_t;
typedef short bf16x8 __attribute__((ext_vector_type(8)));
typedef float f32x4 __attribute__((ext_vector_type(4)));
typedef unsigned u32x4 __attribute__((ext_vector_type(4)));
constexpr int BM = 256, BK = 64, HALF = 128, HTB = HALF * BK * 2  , STAGE_BYTES = 8 * HTB, NXCD = 8, WGM = 8;

__host__ __device__ __forceinline__ int lds_byte(int r, int c) { const int st = (r >> 4) * 2 + (c >> 5), rr = r & 15, cc = c & 31, ob = rr * 64 + cc * 2; return st * 1024 + (ob ^ (((ob >> 9) & 1) << 5)); }
__host__ __device__ __forceinline__ void stage_rc(int b, int& R, int& C) { const int st = b / 1024, sb = b % 1024, swz = sb ^ (((sb >> 9) & 1) << 5); R = (st >> 1) * 16 + swz / 64; C = (st & 1) * 32 + (swz % 64) / 2; }
__host__ __device__ __forceinline__ int perm32(int rho) { const int n = rho >> 4, i = rho & 15; return 8 * (i >> 2) + 4 * n + (i & 3); }

struct Unit { int pm, pn; };
struct Gemm { const bf16_t* A; const bf16_t* Bt; int M, N, K; };

struct StaticOrder {
    int nM, nN, nwg, G, c, wgm;
    __host__ __device__ void init(int M, int N, int G_, int c_, int wgm_) { nM = M / BM; nN = N / BM; nwg = nM * nN; G = G_; c = c_; wgm = wgm_; }
    __host__ __device__ bool next(int i, Unit& u) const {
        const long L = (long)i * G + c; if (L >= nwg) return false;
        int wgid = (int)L; { const int q = nwg / NXCD, r = nwg % NXCD, xcd = wgid % NXCD, off = wgid / NXCD; wgid = (xcd < r ? xcd * (q + 1) : r * (q + 1) + (xcd - r) * q) + off; }
        const int nig = wgm * nN, gid = wgid / nig, fm = gid * wgm, gsz = (nM - fm) < wgm ? (nM - fm) : wgm;
        u.pm = fm + ((wgid % nig) % gsz); u.pn = (wgid % nig) / gsz; return true;
    }
    __device__ __forceinline__ void a_ready(const Unit&) const {}
    __device__ __forceinline__ void done(const Unit&) const {}
};


DI u32x4 pack8f(const f32x4& a, const f32x4& b) { u32x4 w; w.x = pk2(a[0], a[1]); w.y = pk2(a[2], a[3]); w.z = pk2(b[0], b[1]); w.w = pk2(b[2], b[3]); return w; }

struct EpiIn {
    static constexpr bool PERM = true, AFTER_DRAIN = false;
    bf16_t* Z;
    __device__ __forceinline__ void operator()(const f32x4 (&acc)[2][2][4][2], const Unit& u, int wr, int wc, int fr, int fq) const {
        const int row0 = u.pm * BM + wr * 64 + fr, col0 = u.pn * BM + wc * 32 + 8 * fq;
        if (u.pn < 5 || u.pn > 12) {
#pragma unroll
            for (int ai = 0; ai < 2; ++ai)
#pragma unroll
                for (int m = 0; m < 4; ++m) { bf16_t* rowp = Z + (size_t)(row0 + ai * HALF + m * 16) * INW + col0;
#pragma unroll
                    for (int bj = 0; bj < 2; ++bj) *(u32x4*)(rowp + bj * HALF) = pack8f(acc[ai][bj][m][0], acc[ai][bj][m][1]); }
        } else {
            const int head = (u.pn - 5) & 3; const bool isk = u.pn >= 9;
            const float lg = log1pf(-exp2f(-5.0f - (float)head));
            float inv[8];
#pragma unroll
            for (int j = 0; j < 8; ++j) inv[j] = powf(10000.0f, -(float)(wc * 32 + 8 * fq + j) * (1.0f / 128.0f));
#pragma unroll
            for (int ai = 0; ai < 2; ++ai)
#pragma unroll
                for (int m = 0; m < 4; ++m) {
                    const int row = row0 + ai * HALF + m * 16;
                    const int pos = row < LP ? row : LP; const float t = row < LP ? (float)(row & 127) : 0.0f;
                    const float f = isk ? 0.0625f * __expf(-lg * t) : __expf(lg * t);
                    f32x4 o1[2], o2[2];
#pragma unroll
                    for (int n = 0; n < 2; ++n)
#pragma unroll
                        for (int e = 0; e < 4; ++e) {
                            const float ang = (float)pos * inv[n * 4 + e];
                            double rev = (double)ang * 0.15915494309189535; rev -= floor(rev);
                            const float fr_ = (float)rev; const float sn = __builtin_amdgcn_sinf(fr_), cs = __builtin_amdgcn_cosf(fr_);
                            const float x1 = acc[ai][0][m][n][e], x2 = acc[ai][1][m][n][e];
                            o1[n][e] = (x1 * cs - x2 * sn) * f; o2[n][e] = (x2 * cs + x1 * sn) * f;
                        }
                    bf16_t* rowp = Z + (size_t)row * INW + col0;
                    *(u32x4*)(rowp) = pack8f(o1[0], o1[1]); *(u32x4*)(rowp + HALF) = pack8f(o2[0], o2[1]);
                }
        }
    }
};

struct EpiOut {
    static constexpr bool PERM = true, AFTER_DRAIN = false;
    const float* xp; bf16_t* X1B; float* part;
    __device__ __forceinline__ void operator()(const f32x4 (&acc)[2][2][4][2], const Unit& u, int wr, int wc, int fr, int fq) const {
#pragma unroll
        for (int ai = 0; ai < 2; ++ai)
#pragma unroll
            for (int m = 0; m < 4; ++m) {
                const int row = u.pm * BM + ai * HALF + wr * 64 + m * 16 + fr;
                const float* xrow = xp + (size_t)row * DM;
                float ss = 0.f;
#pragma unroll
                for (int bj = 0; bj < 2; ++bj) {
                    const int col = u.pn * BM + bj * HALF + wc * 32 + 8 * fq;
                    const f32x4 v0 = acc[ai][bj][m][0] + *(const f32x4*)(xrow + col), v1 = acc[ai][bj][m][1] + *(const f32x4*)(xrow + col + 4);
                    ss += (v0[0] * v0[0] + v0[1] * v0[1]) + (v0[2] * v0[2] + v0[3] * v0[3]) + (v1[0] * v1[0] + v1[1] * v1[1]) + (v1[2] * v1[2] + v1[3] * v1[3]);
                    *(u32x4*)(X1B + (size_t)row * DM + col) = pack8f(v0, v1);
                }
                ss += __shfl_xor(ss, 16); ss += __shfl_xor(ss, 32);
                if (fq == 0) part[(size_t)row * 32 + u.pn * 4 + wc] = ss;
            }
    }
};

struct EpiUp {
    static constexpr bool PERM = true, AFTER_DRAIN = false;
    bf16_t* U;
    __device__ __forceinline__ void operator()(const f32x4 (&acc)[2][2][4][2], const Unit& u, int wr, int wc, int fr, int fq) const {
        const int row0 = u.pm * BM + wr * 64 + fr, col0 = u.pn * BM + wc * 32 + 8 * fq;
#pragma unroll
        for (int ai = 0; ai < 2; ++ai)
#pragma unroll
            for (int m = 0; m < 4; ++m) { bf16_t* rowp = U + (size_t)(row0 + ai * HALF + m * 16) * FF + col0;
#pragma unroll
                for (int bj = 0; bj < 2; ++bj) { f32x4 a = acc[ai][bj][m][0], b = acc[ai][bj][m][1];
#pragma unroll
                    for (int e = 0; e < 4; ++e) { a[e] = fmaxf(a[e], 0.f); a[e] *= a[e]; b[e] = fmaxf(b[e], 0.f); b[e] *= b[e]; }
                    *(u32x4*)(rowp + bj * HALF) = pack8f(a, b); } }
    }
};

struct EpiDown {
    static constexpr bool PERM = true, AFTER_DRAIN = false;
    float* Y; const bf16_t* X1B; const float* rstd2;
    __device__ __forceinline__ void operator()(const f32x4 (&acc)[2][2][4][2], const Unit& u, int wr, int wc, int fr, int fq) const {
#pragma unroll
        for (int ai = 0; ai < 2; ++ai)
#pragma unroll
            for (int m = 0; m < 4; ++m) {
                const int row = u.pm * BM + ai * HALF + wr * 64 + m * 16 + fr; const float r2 = rstd2[row];
#pragma unroll
                for (int bj = 0; bj < 2; ++bj) { const size_t o = (size_t)row * DM + u.pn * BM + bj * HALF + wc * 32 + 8 * fq;
                    const u32x4 xb = *(const u32x4*)(X1B + o);
                    const f32x4 a = {bflo(xb.x), bfhi(xb.x), bflo(xb.y), bfhi(xb.y)}, b = {bflo(xb.z), bfhi(xb.z), bflo(xb.w), bfhi(xb.w)};
                    *(f32x4*)(Y + o) = a + acc[ai][bj][m][0] * r2; *(f32x4*)(Y + o + 4) = b + acc[ai][bj][m][1] * r2; }
            }
    }
};
template <class Epi, class Sched, bool ALIGN_EPI = false, bool SP2 = false>
__device__ __forceinline__ void gemm_phase(PG8_LAS unsigned char* lds, const Gemm g, const Sched& S, const Epi& E) {
    const int tid = threadIdx.x, wid = __builtin_amdgcn_readfirstlane(tid >> 6), lane = tid & 63, wr = wid >> 2, wc = wid & 3, fr = lane & 15, fq = lane >> 4;
    const int K = g.K, nt = K / BK;
    unsigned voffA[2], voffB[2];
#pragma unroll
    for (int i = 0; i < 2; ++i) { int R, C; stage_rc(tid * 16 + i * 8192, R, C); const int Rb = Epi::PERM ? ((R & ~31) + perm32(R & 31)) : R;
        voffA[i] = (unsigned)(R * K + C) * 2u; voffB[i] = (unsigned)(Rb * K + C) * 2u; }
    const size_t kstep = (size_t)(BK * 2);
    const size_t hstep = (size_t)HALF * K * 2;
    const size_t tstep = 2 * hstep;
    const unsigned ldsw = (unsigned)wid * 1024u;
    const int aoff = lds_byte(wr * 64 + fr, fq * 8), boff = lds_byte(wc * 32 + fr, fq * 8);
#define PG8_SA(b, h) (((b) * 2 + (h)) * HTB)
#define PG8_SB(b, h) ((4 + (b) * 2 + (h)) * HTB)
#define PG8_STAGE(bufoff, gbase, voff) do { _Pragma("unroll") for (int _i = 0; _i < 2; ++_i) \
        __builtin_amdgcn_global_load_lds((const unsigned*)((const char*)(gbase) + (voff)[_i]), (PG8_LAS unsigned*)(lds + (bufoff) + ldsw + _i * 8192), 16, 0, 0); } while (0)
#define PG8_LDA(dst, b, h) do { _Pragma("unroll") for (int m = 0; m < 4; ++m) _Pragma("unroll") for (int k = 0; k < 2; ++k) dst[m][k] = *(const PG8_LAS bf16x8*)(lds + PG8_SA(b, h) + aoff + m * 2048 + k * 1024); } while (0)
#define PG8_LDB(dst, b, h) do { _Pragma("unroll") for (int n = 0; n < 2; ++n) _Pragma("unroll") for (int k = 0; k < 2; ++k) dst[n][k] = *(const PG8_LAS bf16x8*)(lds + PG8_SB(b, h) + boff + n * 2048 + k * 1024); } while (0)
#define PG8_MMA(ai, bj, At, Bt) do { __builtin_amdgcn_s_setprio(1); _Pragma("unroll") for (int m = 0; m < 4; ++m) _Pragma("unroll") for (int n = 0; n < 2; ++n) _Pragma("unroll") for (int k = 0; k < 2; ++k) \
        acc[ai][bj][m][n] = __builtin_amdgcn_mfma_f32_16x16x32_bf16(Bt[n][k], At[m][k], acc[ai][bj][m][n], 0, 0, 0); __builtin_amdgcn_s_setprio(0); } while (0)
#define PG8_WAIT_V(n) asm volatile("s_waitcnt vmcnt(" #n ")" ::: "memory")
#define PG8_WAIT_L(n) asm volatile("s_waitcnt lgkmcnt(" #n ")" ::: "memory")
#define PG8_BAR __builtin_amdgcn_s_barrier()
#define PG8_SCHED __builtin_amdgcn_sched_barrier(0)
    Unit cur, nxt; int ui = 0;
    if (!S.next(0, cur)) return;
    f32x4 acc[2][2][4][2];
#pragma unroll
    for (int a = 0; a < 2; ++a)
#pragma unroll
        for (int b = 0; b < 2; ++b)
#pragma unroll
            for (int m = 0; m < 4; ++m)
#pragma unroll
                for (int n = 0; n < 2; ++n) acc[a][b][m][n] = (f32x4){0.f, 0.f, 0.f, 0.f};
    bf16x8 At[4][2], B0[2][2], B1[2][2];
    const char* cA = (const char*)g.A + (size_t)cur.pm * tstep; const char* cB = (const char*)g.Bt + (size_t)cur.pn * tstep;
    S.a_ready(cur);
    if constexpr (SP2) {
        PG8_STAGE(PG8_SB(0, 0), cB, voffB); PG8_STAGE(PG8_SB(0, 1), cB + hstep, voffB); PG8_STAGE(PG8_SA(0, 0), cA, voffA); PG8_STAGE(PG8_SA(0, 1), cA + hstep, voffA);
        if (wr == 1) PG8_BAR;
        PG8_WAIT_V(2); PG8_BAR;
        PG8_STAGE(PG8_SB(1, 0), cB + kstep, voffB); PG8_STAGE(PG8_SA(1, 0), cA + kstep, voffA); PG8_STAGE(PG8_SB(1, 1), cB + hstep + kstep, voffB);
        PG8_WAIT_V(6); PG8_BAR;
    } else {
        PG8_STAGE(PG8_SB(0, 0), cB, voffB); PG8_STAGE(PG8_SA(0, 0), cA, voffA); PG8_STAGE(PG8_SB(0, 1), cB + hstep, voffB); PG8_STAGE(PG8_SA(0, 1), cA + hstep, voffA);
        if (wr == 1) PG8_BAR;
        PG8_WAIT_V(4); PG8_BAR;
        PG8_STAGE(PG8_SB(1, 0), cB + kstep, voffB); PG8_STAGE(PG8_SA(1, 0), cA + kstep, voffA); PG8_STAGE(PG8_SB(1, 1), cB + hstep + kstep, voffB);
        PG8_WAIT_V(6); PG8_BAR;
    }
    for (;;) {
        const bool has_next = S.next(ui + 1, nxt);
        const char* nA = has_next ? (const char*)g.A + (size_t)nxt.pm * tstep : cA; const char* nB = has_next ? (const char*)g.Bt + (size_t)nxt.pn * tstep : cB;
        for (int t = 0; t < nt; t += 2) {
            const bool last = (t == nt - 2);
            const char* a1 = cA + (size_t)(t + 1) * kstep;
            const char* a2 = last ? nA : cA + (size_t)(t + 2) * kstep; const char* b2 = last ? nB : cB + (size_t)(t + 2) * kstep;
            const char* a3 = a2 + kstep; const char* b3 = b2 + kstep;
            if (last && has_next) S.a_ready(nxt);
            if constexpr (SP2) {
            PG8_LDB(B0, 0, 0); PG8_LDB(B1, 0, 1); PG8_SCHED; PG8_LDA(At, 0, 0); PG8_STAGE(PG8_SA(1, 1), a1 + hstep, voffA);
            PG8_WAIT_V(8); PG8_WAIT_L(0); PG8_BAR; PG8_MMA(0, 0, At, B0); PG8_MMA(0, 1, At, B1); PG8_BAR; PG8_SCHED;
            PG8_LDA(At, 0, 1); PG8_STAGE(PG8_SB(0, 0), b2, voffB); PG8_STAGE(PG8_SB(0, 1), b2 + hstep, voffB); PG8_STAGE(PG8_SA(0, 0), a2, voffA);
            PG8_WAIT_V(8); PG8_WAIT_L(0); PG8_BAR; PG8_MMA(1, 0, At, B0); PG8_MMA(1, 1, At, B1); PG8_BAR; PG8_SCHED;
            PG8_LDB(B0, 1, 0); PG8_LDB(B1, 1, 1); PG8_SCHED; PG8_LDA(At, 1, 0); PG8_STAGE(PG8_SA(0, 1), a2 + hstep, voffA);
            PG8_WAIT_V(8); PG8_WAIT_L(0); PG8_BAR; PG8_MMA(0, 0, At, B0); PG8_MMA(0, 1, At, B1); PG8_BAR; PG8_SCHED;
            PG8_LDA(At, 1, 1); PG8_STAGE(PG8_SB(1, 0), b3, voffB); PG8_STAGE(PG8_SB(1, 1), b3 + hstep, voffB); PG8_STAGE(PG8_SA(1, 0), a3, voffA);
            PG8_WAIT_V(8); PG8_WAIT_L(0); PG8_BAR; PG8_MMA(1, 0, At, B0); PG8_MMA(1, 1, At, B1); PG8_BAR; PG8_SCHED;
            } else {
            PG8_LDB(B0, 0, 0); PG8_SCHED; PG8_LDA(At, 0, 0); PG8_STAGE(PG8_SA(1, 1), a1 + hstep, voffA);
            PG8_WAIT_L(8); PG8_BAR; PG8_WAIT_L(0); PG8_MMA(0, 0, At, B0); PG8_BAR; PG8_SCHED;
            PG8_LDB(B1, 0, 1); PG8_STAGE(PG8_SB(0, 0), b2, voffB);
            PG8_BAR; PG8_WAIT_L(0); PG8_MMA(0, 1, At, B1); PG8_BAR;
            PG8_LDA(At, 0, 1); PG8_STAGE(PG8_SA(0, 0), a2, voffA);
            PG8_BAR; PG8_WAIT_L(0); PG8_MMA(1, 0, At, B0); PG8_BAR; PG8_SCHED;
            PG8_STAGE(PG8_SB(0, 1), b2 + hstep, voffB);
            PG8_WAIT_V(6); PG8_BAR; PG8_MMA(1, 1, At, B1); PG8_BAR;
            PG8_LDB(B0, 1, 0); PG8_SCHED; PG8_LDA(At, 1, 0); PG8_STAGE(PG8_SA(0, 1), a2 + hstep, voffA);
            PG8_WAIT_L(8); PG8_BAR; PG8_WAIT_L(0); PG8_MMA(0, 0, At, B0); PG8_BAR; PG8_SCHED;
            PG8_LDB(B1, 1, 1); PG8_STAGE(PG8_SB(1, 0), b3, voffB);
            PG8_BAR; PG8_WAIT_L(0); PG8_MMA(0, 1, At, B1); PG8_BAR;
            PG8_LDA(At, 1, 1); PG8_STAGE(PG8_SA(1, 0), a3, voffA);
            PG8_BAR; PG8_WAIT_L(0); PG8_MMA(1, 0, At, B0); PG8_BAR; PG8_SCHED;
            PG8_STAGE(PG8_SB(1, 1), b3 + hstep, voffB);
            PG8_WAIT_V(6); PG8_BAR; PG8_MMA(1, 1, At, B1); PG8_BAR;
            }
        }
        if constexpr (ALIGN_EPI) { if (wr == 0) PG8_BAR; }
        if constexpr (!Epi::AFTER_DRAIN) { E(acc, cur, wr, wc, fr, fq); S.done(cur); }
        if (!has_next) break;
#pragma unroll
        for (int a = 0; a < 2; ++a)
#pragma unroll
            for (int b = 0; b < 2; ++b)
#pragma unroll
                for (int m = 0; m < 4; ++m)
#pragma unroll
                    for (int n = 0; n < 2; ++n) acc[a][b][m][n] = (f32x4){0.f, 0.f, 0.f, 0.f};
        cur = nxt; cA = nA; cB = nB; ++ui;
        if constexpr (ALIGN_EPI) { if (wr == 1) PG8_BAR; }
    }
    PG8_WAIT_V(0);
    if constexpr (!ALIGN_EPI) { if (wr == 0) PG8_BAR; }
    PG8_BAR;
    if constexpr (Epi::AFTER_DRAIN) { E.fused(acc, cur, wr, wc, fr, fq, lds, wid, lane); S.done(cur); }
#undef PG8_SA
#undef PG8_SB
#undef PG8_STAGE
#undef PG8_LDA
#undef PG8_LDB
#undef PG8_MMA
#undef PG8_WAIT_V
#undef PG8_WAIT_L
#undef PG8_BAR
#undef PG8_SCHED
}
}

using pg8::bf16_t; using pg8::bf16x8; using pg8::f32x4; using pg8::u32x4;
#define MFMA32(a, b, c) __builtin_amdgcn_mfma_f32_32x32x16_bf16((a), (b), (c), 0, 0, 0)
DI int crow(int reg, int h) { return (reg & 3) + 8 * (reg >> 2) + 4 * h; }
DI float wave_sum(float v) {
#pragma unroll
    for (int o = 1; o < 64; o <<= 1) v += __shfl_xor(v, o);
    return v;
}
DI float wave_max(float v) {
#pragma unroll
    for (int o = 1; o < 64; o <<= 1) v = fmaxf(v, __shfl_xor(v, o));
    return v;
}
DI bf16x8 pack8(const f32x16& x, int s) { u32x4 p; p.x = pk2(x[8 * s], x[8 * s + 1]); p.y = pk2(x[8 * s + 2], x[8 * s + 3]); p.z = pk2(x[8 * s + 4], x[8 * s + 5]); p.w = pk2(x[8 * s + 6], x[8 * s + 7]); return __builtin_bit_cast(bf16x8, p); }
DI bf16x8 cat4(s16x4 lo, s16x4 hi) { return __builtin_shufflevector(lo, hi, 0, 1, 2, 3, 4, 5, 6, 7); }
DI f32x16 zero16() { f32x16 z;
#pragma unroll
    for (int i = 0; i < 16; ++i) z[i] = 0.f;
    return z; }
DI float gamma_of(int h) { return 1.0f - exp2f(-5.0f - (float)h); }

constexpr size_t MiB = 1u << 20;
constexpr size_t WS_WIN = 1 * MiB;
constexpr size_t WS_WOUT = 23 * MiB;
constexpr size_t WS_WUP = 31 * MiB;
constexpr size_t WS_WDN = 63 * MiB;
constexpr size_t WS_H1 = 95 * MiB;
constexpr size_t WS_MIX = 128 * MiB;
constexpr size_t WS_PART = 161 * MiB;
constexpr size_t WS_RSTD2 = 163 * MiB;
constexpr size_t WS_Z = 164 * MiB;
constexpr size_t WS_KV = 252 * MiB;
constexpr size_t WS_SP = 316 * MiB;
constexpr size_t WS_U = 164 * MiB;
constexpr size_t WS_END = 348 * MiB;
static_assert(WS_Z + (size_t)MP * INW * 2 <= WS_KV && WS_U + (size_t)MP * FF * 2 <= WS_END && WS_H1 + (size_t)MP * DM * 2 <= WS_MIX && WS_MIX + (size_t)MP * DM * 2 <= WS_PART, "ws map");
constexpr int LDS_BYTES = 147456;

constexpr size_t O_Y = 0, O_KP = (size_t)MR * DM, O_VP = O_KP + 16384, O_SP = O_VP + 16384, O_KS = O_SP + 262144, O_VS = O_KS + 2097152, O_SS = O_VS + 2097152, O_END = O_SS + 33554432;

struct TItem { const float* W; bf16_t* WT; int K, N, item; const float* rs; };
DI void p0_load(const TItem& t, f32x4 (&v)[8], int lane) {
    const int nblk = t.N / 32, kb = t.item / nblk, nb = t.item % nblk, k0 = 64 * kb, n0 = 32 * nb, c = lane & 7, rr = lane >> 3;
#pragma unroll
    for (int i = 0; i < 8; ++i) v[i] = __builtin_nontemporal_load((const f32x4*)(t.W + (size_t)(k0 + 8 * i + rr) * t.N + n0 + 4 * c));
    if (t.rs) {
#pragma unroll
        for (int i = 0; i < 8; ++i) v[i] = v[i] * t.rs[k0 + 8 * i + rr];
    }
}
DI void p0_store(const TItem& t, const f32x4 (&v)[8], LAS float* scr, int lane) {
    const int nblk = t.N / 32, kb = t.item / nblk, nb = t.item % nblk, k0 = 64 * kb, n0 = 32 * nb, c = lane & 7, rr = lane >> 3;
#pragma unroll
    for (int i = 0; i < 8; ++i) { LAS float* d = scr + (8 * i + rr) * 33 + 4 * c; d[0] = v[i][0]; d[1] = v[i][1]; d[2] = v[i][2]; d[3] = v[i][3]; }
    asm volatile("s_waitcnt lgkmcnt(0)" ::: "memory");
#pragma unroll
    for (int j = 0; j < 4; ++j) { const int n = (lane >> 3) + 8 * j; const LAS float* s = scr + (8 * c) * 33 + n;
        u32x4 o; o.x = pk2(s[0 * 33], s[1 * 33]); o.y = pk2(s[2 * 33], s[3 * 33]); o.z = pk2(s[4 * 33], s[5 * 33]); o.w = pk2(s[6 * 33], s[7 * 33]);
        *(u32x4*)(t.WT + (size_t)(n0 + n) * t.K + k0 + 8 * c) = o; }
    asm volatile("s_waitcnt lgkmcnt(0)" ::: "memory");
}
struct ResIn { const float* w; bf16_t* wt; DI TItem operator()(int it) const { return TItem{w, wt, DM, INW, it, nullptr}; } };
struct ResRest { const float* w_out; const float* w_up; const float* w_dn; bf16_t* WOUT; bf16_t* WUP; bf16_t* WDN; const float* g2;
    DI TItem operator()(int it) const { constexpr int I_OUT = (DM / 64) * (DM / 32), I_UP = (DM / 64) * (FF / 32); int r = it;
        if (r < I_OUT) return TItem{w_out, WOUT, DM, DM, r, nullptr}; r -= I_OUT;
        if (r < I_UP) return TItem{w_up, WUP, DM, FF, r, g2}; r -= I_UP;
        return TItem{w_dn, WDN, FF, DM, r, nullptr}; } };
template <class Resolve>
DI void p0_convert(const Resolve R, int first, int stride, int total, LAS float* scr, int lane) {
    for (int it = first; it < total; it += 2 * stride) {
        const bool two = it + stride < total;
        const TItem t0 = R(it), t1 = R(two ? it + stride : it);
        f32x4 v0[8], v1[8];
        p0_load(t0, v0, lane);
        if (two) p0_load(t1, v1, lane);
        p0_store(t0, v0, scr, lane);
        if (two) p0_store(t1, v1, scr + 64 * 33, lane);
    }
}
DI void rms_row(const float* xrow, const float* g, bf16_t* orow, int lane) {
    f32x4 v[8]; float s = 0.f;
#pragma unroll
    for (int j = 0; j < 8; ++j) { v[j] = *((const f32x4*)xrow + lane + 64 * j); s += (v[j][0] * v[j][0] + v[j][1] * v[j][1]) + (v[j][2] * v[j][2] + v[j][3] * v[j][3]); }
    const float rstd = rsqrtf(wave_sum(s) * (1.0f / DM) + EPS);
#pragma unroll
    for (int j = 0; j < 8; ++j) { const f32x4 gg = *((const f32x4*)g + lane + 64 * j); u32x2 o; o.x = pk2(v[j][0] * rstd * gg[0], v[j][1] * rstd * gg[1]); o.y = pk2(v[j][2] * rstd * gg[2], v[j][3] * rstd * gg[3]);
        *((u32x2*)orow + lane + 64 * j) = o; }
}

DI void stage_T128x256(LAS unsigned char* img, const bf16_t* src, int tid) {
#pragma unroll
    for (int k = 0; k < 4; ++k) {
        const int it = k * 512 + tid, dgl = it & 3, tpl = (it >> 2) & 15, rest = it >> 6, dg = dgl + 4 * (rest & 7), tp = tpl + 16 * (rest >> 3);
        const bf16_t* p = src + (size_t)(2 * tp) * INW + dg * 8;
        const u32x4 a = *(const u32x4*)p, b = *(const u32x4*)(p + INW);
#pragma unroll
        for (int e = 0; e < 8; ++e) {
            const unsigned lo = (e & 1) ? (a[e >> 1] >> 16) : (a[e >> 1] & 0xffffu), hi = (e & 1) ? (b[e >> 1] & 0xffff0000u) : (b[e >> 1] << 16);
            *(LAS unsigned*)(img + (dg * 8 + e) * 264 + tp * 4) = lo | hi;
        }
    }
}

DI void ret_step1(LAS unsigned char* lds, const bf16_t* Z, bf16_t* KV, int n, int h, int tid) {
    LAS unsigned char* Kt = lds; LAS unsigned char* Vt = lds + 256 * 264;
    const int lane = tid & 63, wid = tid >> 6, r = lane & 31, hh = lane >> 5;
    stage_T128x256(Kt, Z + (size_t)(n * 128) * INW + C_RK + h * 256, tid);
    stage_T128x256(Vt, Z + (size_t)(n * 128) * INW + C_RV + h * 256, tid);
    __syncthreads();
    f32x16 acc[8];
#pragma unroll
    for (int i = 0; i < 8; ++i) acc[i] = zero16();
    const int dk0 = wid * 32;
#pragma unroll 2
    for (int s = 0; s < 8; ++s) {
        const LAS unsigned char* pa = Kt + (dk0 + r) * 264 + (16 * s + 8 * hh) * 2;
        const bf16x8 A = cat4(*(const LAS s16x4*)pa, *(const LAS s16x4*)(pa + 8));
#pragma unroll
        for (int dt = 0; dt < 8; ++dt) {
            const LAS unsigned char* pb = Vt + (dt * 32 + r) * 264 + (16 * s + 8 * hh) * 2;
            const bf16x8 B = cat4(*(const LAS s16x4*)pb, *(const LAS s16x4*)(pb + 8));
            acc[dt] = MFMA32(A, B, acc[dt]);
        }
    }
    bf16_t* out = KV + ((size_t)(n * 4 + h) * 256) * 256 + dk0 + 4 * hh;
#pragma unroll
    for (int dt = 0; dt < 8; ++dt)
#pragma unroll
        for (int g4 = 0; g4 < 4; ++g4) { u32x2 o; o.x = pk2(acc[dt][4 * g4], acc[dt][4 * g4 + 1]); o.y = pk2(acc[dt][4 * g4 + 2], acc[dt][4 * g4 + 3]);
            *(u32x2*)(out + (size_t)(dt * 32 + r) * 256 + 8 * g4) = o; }
    __syncthreads();
}

DI void ret_scan(const bf16_t* KV, bf16_t* SP, float* o_state, int gt, int nthreads) {
    for (int e = gt; e < 65536; e += nthreads) {
        const int h = e >> 14, dv = (e >> 6) & 255, dk4 = (e & 63) * 4;
        const float lg = log1pf(-exp2f(-5.0f - (float)h)), Dc = __expf(128.0f * lg), c1 = __expf(127.0f * lg);
        const size_t base = ((size_t)(h * 256 + dv)) * 256 + dk4;
        f32x4 s = {0.f, 0.f, 0.f, 0.f};
        for (int n0 = 0; n0 < 64; n0 += 32) {
            u32x2 q[32];
#pragma unroll
            for (int u = 0; u < 32; ++u) q[u] = *(const u32x2*)(KV + (size_t)(n0 + u) * 262144 + base);
#pragma unroll
            for (int u = 0; u < 32; ++u) { u32x2 o; o.x = pk2(s[0], s[1]); o.y = pk2(s[2], s[3]); *(u32x2*)(SP + (size_t)(n0 + u) * 262144 + base) = o;
                const f32x4 kv = {bflo(q[u].x), bfhi(q[u].x), bflo(q[u].y), bfhi(q[u].y)}; s = s * Dc + kv * c1; }
        }
#pragma unroll
        for (int j = 0; j < 4; ++j) o_state[((size_t)(h * 256 + dk4 + j)) * 256 + dv] = s[j];
    }
}

DI float silu_f(float x) { return x / (1.0f + __expf(-x)); }

DI void ret_step2(LAS unsigned char* lds, const bf16_t* Z, const bf16_t* SP, bf16_t* MIX, const float* rng, int n, int h, int tid) {
    LAS unsigned char* Kr = lds; LAS unsigned char* Vt = lds + 128 * 528; LAS float* red = (LAS float*)(lds + 128 * 528 + 256 * 264);
    const int lane = tid & 63, wid = tid >> 6, r = lane & 31, hh = lane >> 5;
    const bf16_t* zc = Z + (size_t)(n * 128) * INW;
#pragma unroll
    for (int k = 0; k < 8; ++k) { const int it = k * 512 + tid, row = it >> 5, c = it & 31;
        *(LAS u32x4*)(Kr + row * 528 + c * 16) = *(const u32x4*)(zc + (size_t)row * INW + C_RK + h * 256 + c * 8); }
    stage_T128x256(Vt, zc + C_RV + h * 256, tid);
    const int it_ = wid >> 1, dh = wid & 1;
    bf16x8 qf[16];
    { const bf16_t* qp = zc + (size_t)(32 * it_ + r) * INW + C_RQ + h * 256 + 8 * hh;
#pragma unroll
      for (int s = 0; s < 16; ++s) qf[s] = *(const bf16x8*)(qp + 16 * s); }
    f32x16 acc[4];
#pragma unroll
    for (int i = 0; i < 4; ++i) acc[i] = zero16();
    const float gm = gamma_of(h);
    __syncthreads();
    for (int jt = 0; jt <= it_; ++jt) {
        f32x16 X = zero16();
#pragma unroll
        for (int s = 0; s < 16; ++s) { const bf16x8 A = *(const LAS bf16x8*)(Kr + (32 * jt + r) * 528 + (16 * s + 8 * hh) * 2); X = MFMA32(A, qf[s], X); }
        if (jt == it_) {
#pragma unroll
            for (int i = 0; i < 16; ++i) X[i] = (crow(i, hh) > r) ? 0.f : X[i];
        }
#pragma unroll
        for (int s2 = 0; s2 < 2; ++s2) { const bf16x8 xs = pack8(X, s2);
#pragma unroll
            for (int dt = 0; dt < 4; ++dt) { const LAS unsigned char* pa = Vt + (128 * dh + 32 * dt + r) * 264 + (32 * jt + 16 * s2 + 4 * hh) * 2;
                const bf16x8 A = cat4(*(const LAS s16x4*)pa, *(const LAS s16x4*)(pa + 16)); acc[dt] = MFMA32(A, xs, acc[dt]); } }
    }
    { const float ig = 1.0f / gm;
#pragma unroll
      for (int dt = 0; dt < 4; ++dt) acc[dt] = acc[dt] * ig; }
    __syncthreads();
    { const bf16_t* spg = SP + (size_t)(n * 4 + h) * 65536;
#pragma unroll 1
      for (int k0 = 0; k0 < 16; k0 += 4) {
          u32x4 spr[4];
#pragma unroll
          for (int k = 0; k < 4; ++k) { const int it = (k0 + k) * 512 + tid; spr[k] = *(const u32x4*)(spg + (size_t)(it >> 5) * 256 + (it & 31) * 8); }
#pragma unroll
          for (int k = 0; k < 4; ++k) { const int it = (k0 + k) * 512 + tid; *(LAS u32x4*)(lds + (it >> 5) * 528 + (it & 31) * 16) = spr[k]; }
      } }
    __syncthreads();
#pragma unroll
    for (int dt = 0; dt < 4; ++dt)
#pragma unroll
        for (int s = 0; s < 16; ++s) { const bf16x8 A = *(const LAS bf16x8*)(lds + (128 * dh + 32 * dt + r) * 528 + (16 * s + 8 * hh) * 2); acc[dt] = MFMA32(A, qf[s], acc[dt]); }
#pragma unroll
    for (int dt = 0; dt < 4; ++dt) acc[dt] = acc[dt] * gm;
    float ss = 0.f;
#pragma unroll
    for (int dt = 0; dt < 4; ++dt)
#pragma unroll
        for (int i = 0; i < 16; ++i) ss += acc[dt][i] * acc[dt][i];
    ss += __shfl_xor(ss, 32);
    if (hh == 0) red[wid * 32 + r] = ss;
    __syncthreads();
    const float rstd = rsqrtf((red[wid * 32 + r] + red[(wid ^ 1) * 32 + r]) * (1.0f / 256.0f) + EPS);
    const size_t token = (size_t)n * 128 + 32 * it_ + r;
#pragma unroll
    for (int dt = 0; dt < 4; ++dt)
#pragma unroll
        for (int g4 = 0; g4 < 4; ++g4) {
            const int dv = 128 * dh + 32 * dt + 8 * g4 + 4 * hh;
            const u32x2 gz = *(const u32x2*)(Z + token * INW + C_RG + h * 256 + dv);
            const f32x4 gn = *(const f32x4*)(rng + h * 256 + dv);
            const float y0 = acc[dt][4 * g4 + 0] * rstd * gn[0] * silu_f(bflo(gz.x)), y1 = acc[dt][4 * g4 + 1] * rstd * gn[1] * silu_f(bfhi(gz.x));
            const float y2 = acc[dt][4 * g4 + 2] * rstd * gn[2] * silu_f(bflo(gz.y)), y3 = acc[dt][4 * g4 + 3] * rstd * gn[3] * silu_f(bfhi(gz.y));
            u32x2 o; o.x = pk2(y0, y1); o.y = pk2(y2, y3);
            *(u32x2*)(MIX + token * DM + 1024 + h * 256 + dv) = o;
        }
    __syncthreads();
}

DI void ret_decode_unit(LAS unsigned char* lds, const bf16_t* Z, const float* S0, float* S1, bf16_t* MIX, const float* rng, int b, int h, int tid) {
    LAS float* qv = (LAS float*)lds; LAS float* red = qv + 768;
    const int lane = tid & 63, wid = tid >> 6;
    const bf16_t* zrow = Z + (size_t)(LP + b) * INW;
    if (tid < 256) { qv[tid] = bf2f(zrow[C_RQ + h * 256 + tid]); qv[256 + tid] = bf2f(zrow[C_RK + h * 256 + tid]); qv[512 + tid] = bf2f(zrow[C_RV + h * 256 + tid]); }
    __syncthreads();
    const float gm = gamma_of(h);
    const f32x4 v4 = *(const LAS f32x4*)(qv + 512 + 4 * lane);
    f32x4 acc = {0.f, 0.f, 0.f, 0.f};
    const size_t off = ((size_t)(b * 4 + h) * 256 + wid * 32) * 256 + 4 * lane;
    const float* s0 = S0 + off; float* s1 = S1 + off;
#pragma unroll 1
    for (int rr = 0; rr < 32; rr += 16) {
        f32x4 s[16];
#pragma unroll
        for (int u = 0; u < 16; ++u) s[u] = __builtin_nontemporal_load((const f32x4*)(s0 + (size_t)(rr + u) * 256));
#pragma unroll
        for (int u = 0; u < 16; ++u) { const int dk = wid * 32 + rr + u; const float kk = qv[256 + dk], qq = qv[dk];
            const f32x4 sn = s[u] * gm + v4 * kk; __builtin_nontemporal_store(sn, (f32x4*)(s1 + (size_t)(rr + u) * 256)); acc += sn * qq; }
    }
    *(LAS f32x4*)(red + wid * 256 + 4 * lane) = acc;
    __syncthreads();
    if (wid == 0) {
        f32x4 o = {0.f, 0.f, 0.f, 0.f};
#pragma unroll
        for (int w = 0; w < 8; ++w) o += *(const LAS f32x4*)(red + w * 256 + 4 * lane);
        const float ssq = wave_sum((o[0] * o[0] + o[1] * o[1]) + (o[2] * o[2] + o[3] * o[3]));
        const float rstd = rsqrtf(ssq * (1.0f / 256.0f) + EPS);
        const u32x2 gz = *(const u32x2*)(zrow + C_RG + h * 256 + 4 * lane);
        const f32x4 gn = *(const f32x4*)(rng + h * 256 + 4 * lane);
        u32x2 y; y.x = pk2(o[0] * rstd * gn[0] * silu_f(bflo(gz.x)), o[1] * rstd * gn[1] * silu_f(bfhi(gz.x)));
        y.y = pk2(o[2] * rstd * gn[2] * silu_f(bflo(gz.y)), o[3] * rstd * gn[3] * silu_f(bfhi(gz.y)));
        *(u32x2*)(MIX + (size_t)(LP + b) * DM + 1024 + h * 256 + 4 * lane) = y;
    }
    __syncthreads();
}

DI void attn_prompt_unit(LAS unsigned char* lds, const bf16_t* Z, bf16_t* MIX, const float* gq, const float* gk, const float* sinks, float* o_k, float* o_v, int nb, int kh, int hf, int tid) {
    LAS unsigned char* Kn = lds; LAS unsigned char* Vt = lds + 256 * 144;
    const int lane = tid & 63, wid = tid >> 6, r = lane & 31, hh = lane >> 5;
    {
        const int row = tid >> 1, half = tid & 1; const int tok = (nb - 1) * 128 + row;
        u32x4 v[4];
#pragma unroll
        for (int c = 0; c < 4; ++c) v[c] = (u32x4){0u, 0u, 0u, 0u};
        if (tok >= 0) {
#pragma unroll
            for (int c = 0; c < 4; ++c) v[c] = *(const u32x4*)(Z + (size_t)tok * INW + C_AK + kh * 64 + half * 32 + c * 8);
        }
        float f[32]; float ss = 0.f;
#pragma unroll
        for (int c = 0; c < 4; ++c)
#pragma unroll
            for (int e = 0; e < 4; ++e) { f[c * 8 + 2 * e] = bflo(v[c][e]); f[c * 8 + 2 * e + 1] = bfhi(v[c][e]); }
#pragma unroll
        for (int e = 0; e < 32; ++e) ss += f[e] * f[e];
        ss += __shfl_xor(ss, 1);
        const float rstd = rsqrtf(ss * (1.0f / 64.0f) + EPS);
#pragma unroll
        for (int c = 0; c < 8; ++c) { const f32x4 g = *(const f32x4*)(gk + half * 32 + c * 4);
#pragma unroll
            for (int e = 0; e < 4; ++e) f[c * 4 + e] *= rstd * g[e]; }
#pragma unroll
        for (int c = 0; c < 4; ++c) { u32x4 w; w.x = pk2(f[c * 8], f[c * 8 + 1]); w.y = pk2(f[c * 8 + 2], f[c * 8 + 3]); w.z = pk2(f[c * 8 + 4], f[c * 8 + 5]); w.w = pk2(f[c * 8 + 6], f[c * 8 + 7]);
            *(LAS u32x4*)(Kn + row * 144 + half * 64 + c * 16) = w; }
        if (nb == 63 && hf == 0 && row >= 128) { float* o = o_k + ((size_t)(row - 128) * 2 + kh) * 64 + half * 32;
#pragma unroll
            for (int c = 0; c < 8; ++c) *(f32x4*)(o + c * 4) = (f32x4){f[c * 4], f[c * 4 + 1], f[c * 4 + 2], f[c * 4 + 3]}; }
    }
#pragma unroll
    for (int k = 0; k < 2; ++k) {
        const int it = k * 512 + tid, kpl = it & 15, dgl = (it >> 4) & 3, rest = it >> 6, dg = dgl + 4 * (rest & 1), kp = kpl + 16 * (rest >> 1);
        const int tok0 = (nb - 1) * 128 + 2 * kp;
        u32x4 a = {0u, 0u, 0u, 0u}, b = {0u, 0u, 0u, 0u};
        if (tok0 >= 0) { const bf16_t* p = Z + (size_t)tok0 * INW + C_AV + kh * 64 + dg * 8; a = *(const u32x4*)p; b = *(const u32x4*)(p + INW); }
#pragma unroll
        for (int e = 0; e < 8; ++e) {
            const unsigned lo = (e & 1) ? (a[e >> 1] >> 16) : (a[e >> 1] & 0xffffu), hi = (e & 1) ? (b[e >> 1] & 0xffff0000u) : (b[e >> 1] << 16);
            *(LAS unsigned*)(Vt + (dg * 8 + e) * 520 + kp * 4) = lo | hi;
        }
        if (nb == 63 && hf == 0 && kp >= 64) { float* o = o_v + ((size_t)(2 * kp - 128) * 2 + kh) * 64 + dg * 8;
#pragma unroll
            for (int e = 0; e < 4; ++e) { o[2 * e] = bflo(a[e]); o[2 * e + 1] = bfhi(a[e]); o[128 + 2 * e] = bflo(b[e]); o[128 + 2 * e + 1] = bfhi(b[e]); } }
    }
    __syncthreads();
    const int hq = kh * 8 + 4 * hf + (wid >> 1), qh = wid & 1;
    const float sink = sinks[hq];
#pragma unroll 1
    for (int qq = 0; qq < 2; ++qq) {
        const int qi = 2 * qh + qq; const size_t tokq = (size_t)nb * 128 + 32 * qi + r;
        bf16x8 qf[4];
        {   const bf16_t* qp = Z + tokq * INW + hq * 64 + 8 * hh;
            u32x4 raw[4]; float ss = 0.f;
#pragma unroll
            for (int s = 0; s < 4; ++s) { raw[s] = *(const u32x4*)(qp + 16 * s);
#pragma unroll
                for (int e = 0; e < 4; ++e) { const float lo = bflo(raw[s][e]), hi = bfhi(raw[s][e]); ss += lo * lo + hi * hi; } }
            ss += __shfl_xor(ss, 32);
            const float rstd = rsqrtf(ss * (1.0f / 64.0f) + EPS) * 0.125f;
#pragma unroll
            for (int s = 0; s < 4; ++s) { const f32x4 g0 = *(const f32x4*)(gq + 16 * s + 8 * hh), g1 = *(const f32x4*)(gq + 16 * s + 8 * hh + 4); u32x4 w;
                w.x = pk2(bflo(raw[s].x) * rstd * g0[0], bfhi(raw[s].x) * rstd * g0[1]); w.y = pk2(bflo(raw[s].y) * rstd * g0[2], bfhi(raw[s].y) * rstd * g0[3]);
                w.z = pk2(bflo(raw[s].z) * rstd * g1[0], bfhi(raw[s].z) * rstd * g1[1]); w.w = pk2(bflo(raw[s].w) * rstd * g1[2], bfhi(raw[s].w) * rstd * g1[3]);
                qf[s] = __builtin_bit_cast(bf16x8, w); }
        }
        f32x16 X[5];
#pragma unroll
        for (int t = 0; t < 5; ++t) { X[t] = zero16();
#pragma unroll
            for (int s = 0; s < 4; ++s) { const bf16x8 A = *(const LAS bf16x8*)(Kn + (32 * (qi + t) + r) * 144 + (16 * s + 8 * hh) * 2); X[t] = MFMA32(A, qf[s], X[t]); } }
        const int ii = 32 * qi + r;
        float m = -1e30f;
#pragma unroll
        for (int t = 0; t < 5; ++t)
#pragma unroll
            for (int i = 0; i < 16; ++i) { const int jj = 32 * (qi + t) + crow(i, hh); const bool ok = (jj >= ii) && (jj <= ii + 128) && (nb > 0 || jj >= 128);
                X[t][i] = ok ? X[t][i] : -1e30f; m = fmaxf(m, X[t][i]); }
        m = fmaxf(m, __shfl_xor(m, 32)); m = fmaxf(m, sink);
        float sum = 0.f;
#pragma unroll
        for (int t = 0; t < 5; ++t)
#pragma unroll
            for (int i = 0; i < 16; ++i) { const float p = __expf(X[t][i] - m); X[t][i] = p; sum += p; }
        sum += __shfl_xor(sum, 32);
        const float inv = 1.0f / (sum + __expf(sink - m));
        f32x16 o[2]; o[0] = zero16(); o[1] = zero16();
#pragma unroll
        for (int t = 0; t < 5; ++t)
#pragma unroll
            for (int s2 = 0; s2 < 2; ++s2) { const bf16x8 xs = pack8(X[t], s2);
#pragma unroll
                for (int dt = 0; dt < 2; ++dt) { const LAS unsigned char* pa = Vt + (32 * dt + r) * 520 + (32 * (qi + t) + 16 * s2 + 4 * hh) * 2;
                    const bf16x8 A = cat4(*(const LAS s16x4*)pa, *(const LAS s16x4*)(pa + 16)); o[dt] = MFMA32(A, xs, o[dt]); } }
#pragma unroll
        for (int dt = 0; dt < 2; ++dt)
#pragma unroll
            for (int g4 = 0; g4 < 4; ++g4) { u32x2 w; w.x = pk2(o[dt][4 * g4] * inv, o[dt][4 * g4 + 1] * inv); w.y = pk2(o[dt][4 * g4 + 2] * inv, o[dt][4 * g4 + 3] * inv);
                *(u32x2*)(MIX + tokq * DM + hq * 64 + 32 * dt + 8 * g4 + 4 * hh) = w; }
    }
    __syncthreads();
}

DI void attn_decode_unit(LAS unsigned char* lds, const bf16_t* Z, const float* ck, const float* cv, bf16_t* MIX, const float* gq, const float* gk, const float* sinks, float* o_k, float* o_v, int b, int kh, int tid) {
    LAS float* Kc = (LAS float*)lds; LAS float* Vc = Kc + 129 * 65; LAS float* qs = Vc + 129 * 64; LAS float* pw = qs + 512;
    const int lane = tid & 63, wid = tid >> 6;
#pragma unroll
    for (int k = 0; k < 4; ++k) {
        const int it = k * 512 + tid, w = it >> 4, c4 = (it & 15) * 4;
        const size_t src = ((size_t)(b * 128 + w) * 2 + kh) * 64 + c4;
        const f32x4 k4 = *(const f32x4*)(ck + src), v4 = *(const f32x4*)(cv + src);
#pragma unroll
        for (int e = 0; e < 4; ++e) { Kc[w * 65 + c4 + e] = k4[e]; Vc[w * 64 + c4 + e] = v4[e]; }
        if (w >= 1) { const size_t dst = ((size_t)(b * 128 + w - 1) * 2 + kh) * 64 + c4; *(f32x4*)(o_k + dst) = k4; *(f32x4*)(o_v + dst) = v4; }
    }
    const bf16_t* zrow = Z + (size_t)(LP + b) * INW;
    const size_t dnew = ((size_t)(b * 128 + 127) * 2 + kh) * 64 + lane;
    if (wid == 0) { const float kx = bf2f(zrow[C_AK + kh * 64 + lane]); const float ss = wave_sum(kx * kx); const float kn = kx * rsqrtf(ss * (1.0f / 64.0f) + EPS) * gk[lane];
        Kc[128 * 65 + lane] = kn; o_k[dnew] = kn; }
    if (wid == 1) { const float vx = bf2f(zrow[C_AV + kh * 64 + lane]); Vc[128 * 64 + lane] = vx; o_v[dnew] = vx; }
    const int hq = kh * 8 + wid;
    { const float qx = bf2f(zrow[hq * 64 + lane]); const float ss = wave_sum(qx * qx); qs[wid * 64 + lane] = qx * rsqrtf(ss * (1.0f / 64.0f) + EPS) * gq[lane] * 0.125f; }
    __syncthreads();
    float s1 = 0.f, s2 = 0.f;
#pragma unroll 8
    for (int d = 0; d < 64; ++d) { const float q = qs[wid * 64 + d]; s1 += q * Kc[lane * 65 + d]; s2 += q * Kc[(lane + 64) * 65 + d]; }
    const float s3 = wave_sum(qs[wid * 64 + lane] * Kc[128 * 65 + lane]);
    const float sink = sinks[hq];
    const float m = fmaxf(wave_max(fmaxf(s1, s2)), fmaxf(s3, sink));
    const float p1 = __expf(s1 - m), p2 = __expf(s2 - m), p3 = __expf(s3 - m);
    const float denom = wave_sum(p1 + p2) + p3 + __expf(sink - m);
    pw[wid * 132 + lane] = p1; pw[wid * 132 + 64 + lane] = p2; if (lane == 0) pw[wid * 132 + 128] = p3;
    __syncthreads();
    float o = 0.f;
#pragma unroll 3
    for (int j = 0; j < 129; ++j) o += pw[wid * 132 + j] * Vc[j * 64 + lane];
    MIX[(size_t)(LP + b) * DM + hq * 64 + lane] = (bf16_t)(pk2(o / denom, 0.f) & 0xffffu);
    __syncthreads();
}

template <class Epi>
DI void skinny_unit(LAS unsigned char* lds, const bf16_t* A, const bf16_t* Wt, int K, int cgi, int k0, const Epi& E, int tid) {
    const int lane = tid & 63, wid = tid >> 6, r = lane & 31, hh = lane >> 5;
    const int c0 = cgi * 32;
    const bf16_t* pa = A + (size_t)r * K + k0 + wid * 256 + 8 * hh;
    const bf16_t* pb = Wt + (size_t)(c0 + r) * K + k0 + wid * 256 + 8 * hh;
    const size_t rs = (size_t)32 * K;
    f32x16 acc[4];
#pragma unroll
    for (int i = 0; i < 4; ++i) acc[i] = zero16();
    bf16x8 fb[3][2], fa[3][2][4];
#define SK_LOAD(buf, c) do { _Pragma("unroll") for (int s = 0; s < 2; ++s) { fb[buf][s] = *(const bf16x8*)(pb + 32 * (c) + 16 * s); \
        _Pragma("unroll") for (int mt = 0; mt < 4; ++mt) fa[buf][s][mt] = *(const bf16x8*)(pa + mt * rs + 32 * (c) + 16 * s); } } while (0)
#define SK_MMA(buf) do { _Pragma("unroll") for (int s = 0; s < 2; ++s) _Pragma("unroll") for (int mt = 0; mt < 4; ++mt) acc[mt] = MFMA32(fa[buf][s][mt], fb[buf][s], acc[mt]); } while (0)
    SK_LOAD(0, 0); SK_LOAD(1, 1);
    SK_LOAD(2, 2); SK_MMA(0);
    SK_LOAD(0, 3); SK_MMA(1);
    SK_LOAD(1, 4); SK_MMA(2);
    SK_LOAD(2, 5); SK_MMA(0);
    SK_LOAD(0, 6); SK_MMA(1);
    SK_LOAD(1, 7); SK_MMA(2);
    SK_MMA(0); SK_MMA(1);
#undef SK_LOAD
#undef SK_MMA
    LAS float* red = (LAS float*)lds;
#pragma unroll
    for (int mt = 0; mt < 4; ++mt)
#pragma unroll
        for (int i = 0; i < 16; ++i) red[(wid * 128 + mt * 32 + crow(i, hh)) * 32 + r] = acc[mt][i];
    __syncthreads();
    const int row = tid >> 2, c8 = (tid & 3) * 8;
    f32x4 sa = {0.f, 0.f, 0.f, 0.f}, sb = {0.f, 0.f, 0.f, 0.f};
#pragma unroll
    for (int w = 0; w < 8; ++w) { sa += *(const LAS f32x4*)(red + (w * 128 + row) * 32 + c8); sb += *(const LAS f32x4*)(red + (w * 128 + row) * 32 + c8 + 4); }
    E(row, c0 + c8, sa); E(row, c0 + c8 + 4, sb);
    __syncthreads();
}
struct SkOut { const float* xs; float* X1s; bf16_t* XBs;
    DI void operator()(int row, int col, f32x4 a) const { const f32x4 v = a + *(const f32x4*)(xs + (size_t)row * DM + col); *(f32x4*)(X1s + (size_t)row * DM + col) = v;
        u32x2 o; o.x = pk2(v[0], v[1]); o.y = pk2(v[2], v[3]); *(u32x2*)(XBs + (size_t)row * DM + col) = o; } };
struct SkUp { bf16_t* Us;
    DI void operator()(int row, int col, f32x4 a) const {
#pragma unroll
        for (int e = 0; e < 4; ++e) { a[e] = fmaxf(a[e], 0.f); a[e] *= a[e]; }
        u32x2 o; o.x = pk2(a[0], a[1]); o.y = pk2(a[2], a[3]); *(u32x2*)(Us + (size_t)row * FF + col) = o; } };
struct SkSlab { float* slab;
    DI void operator()(int row, int col, f32x4 a) const { *(f32x4*)(slab + (size_t)row * DM + col) = a; } };

#define RLX_AGENT __ATOMIC_RELAXED, __HIP_MEMORY_SCOPE_AGENT
#define XB_TMO      128
#define XB_XCNT(j)  (256  + 64 * (j))
#define XB_XSUB(j)  (1280 + 64 * (j))
#define XB_XGEN(j)  (2304 + 64 * (j))
#define XB_TOP      3328
#define XB_TOPGEN   3392
#define XCD_BAR_WORDS 3456
#define XB_SPIN_CAP (1u << 18)

__device__ __forceinline__ unsigned xb_ld(unsigned* p)              { return __hip_atomic_load(p, __ATOMIC_RELAXED, __HIP_MEMORY_SCOPE_AGENT); }
__device__ __forceinline__ unsigned xb_add(unsigned* p, unsigned v) { return __hip_atomic_fetch_add(p, v, __ATOMIC_RELAXED, __HIP_MEMORY_SCOPE_AGENT); }
__device__ __forceinline__ unsigned xb_xcc_id() { return (unsigned)__builtin_amdgcn_s_getreg((3 << 11) | 20) & 0xFu; }
#define XB_SPIN(cond, bar) do { unsigned _sp = 0; while (cond) { __builtin_amdgcn_s_sleep(1); \
    if ((++_sp & 255u) == 0u) { if (xb_ld(&(bar)[XB_TMO])) break; if (_sp > XB_SPIN_CAP) { atomicAdd(&(bar)[XB_TMO], 1u); break; } } } } while (0)

struct XcdBarrier {
    unsigned* bar; unsigned x;
    volatile LAS unsigned* st;
};

__device__ __forceinline__ XcdBarrier xcd_barrier_post(unsigned* bar, volatile LAS unsigned* st) {
    XcdBarrier b; b.bar = bar; b.x = xb_xcc_id(); b.st = st;
    if (threadIdx.x == 0) (void)xb_add(&bar[XB_XCNT(b.x)], 1u);
    return b;
}
__device__ __forceinline__ void xcd_barrier_complete(unsigned* bar, unsigned x, unsigned& nloc, unsigned& nx) {
    const unsigned G = gridDim.x * gridDim.y * gridDim.z;
    unsigned sum, cnt, mine, sp = 0u;
    for (;;) {
        sum = 0u; cnt = 0u; mine = 0u;
#pragma unroll
        for (unsigned j = 0; j < 16; ++j) { const unsigned c = xb_ld(&bar[XB_XCNT(j)]); sum += c; cnt += (c > 0u) ? 1u : 0u; mine = (j == x) ? c : mine; }
        if (sum == G) break;
        __builtin_amdgcn_s_sleep(1);
        if ((++sp & 255u) == 0u) { if (xb_ld(&bar[XB_TMO])) break; if (sp > XB_SPIN_CAP) { atomicAdd(&bar[XB_TMO], 1u); break; } }
    }
    nloc = mine > 0u ? mine : 1u; nx = cnt > 0u ? cnt : 1u;
}

__device__ __forceinline__ void xcd_barrier(const XcdBarrier& b) {
    asm volatile("s_waitcnt vmcnt(0)" ::: "memory");
    __syncthreads();
    if (threadIdx.x == 0) {
        unsigned* bar = b.bar;
        __builtin_amdgcn_s_waitcnt(0);
        unsigned nloc = b.st[0], nx = b.st[1];
        if (nloc == 0u) { xcd_barrier_complete(bar, b.x, nloc, nx); b.st[0] = nloc; b.st[1] = nx; }
        const unsigned old = xb_add(&bar[XB_XSUB(b.x)], 1u);
        const unsigned gen = old / nloc;
        if (old + 1u == (gen + 1u) * nloc) {
            __builtin_amdgcn_fence(__ATOMIC_RELEASE, "agent");
            asm volatile("s_waitcnt vmcnt(0)" ::: "memory");
            const unsigned og = xb_add(&bar[XB_TOP], 1u);
            const unsigned tg = og / nx;
            if (og + 1u == (tg + 1u) * nx) xb_add(&bar[XB_TOPGEN], 1u);
            else XB_SPIN(xb_ld(&bar[XB_TOPGEN]) == tg, bar);
            __builtin_amdgcn_fence(__ATOMIC_ACQUIRE, "agent");
            xb_add(&bar[XB_XGEN(b.x)], 1u);
            asm volatile("s_waitcnt vmcnt(0)" ::: "memory");
        } else {
            XB_SPIN(xb_ld(&bar[XB_XGEN(b.x)]) == gen, bar);
            __builtin_amdgcn_fence(__ATOMIC_ACQUIRE, "agent");
            asm volatile("s_waitcnt vmcnt(0)" ::: "memory");
        }
    }
    __syncthreads();
}

struct Args { const float* in[15]; float* out; unsigned char* ws; int ph_lo, ph_hi; };
constexpr int NPH = 9;
constexpr int NP0_REST = 7424;

__global__ void __launch_bounds__(512, 2) fwd_kernel(Args a) {
    extern __shared__ __attribute__((aligned(16))) unsigned char lds_raw[];
    LAS unsigned char* lds = (LAS unsigned char*)lds_raw;
    cg::grid_group grid = cg::this_grid();
    const int tid = threadIdx.x, lane = tid & 63, wid = __builtin_amdgcn_readfirstlane(tid >> 6);
    const int G = gridDim.x, bx = blockIdx.x;
    unsigned char* ws = a.ws; float* out = a.out;
    const float* x_p = a.in[0]; const float* x_s = a.in[1]; const float* cache_k = a.in[2]; const float* cache_v = a.in[3]; const float* state0 = a.in[4];
    const float* ln1_g = a.in[5]; const float* w_in = a.in[6]; const float* gq = a.in[7]; const float* gk = a.in[8]; const float* sinks = a.in[9];
    const float* rng = a.in[10]; const float* w_out = a.in[11]; const float* ln2_g = a.in[12]; const float* w_up = a.in[13]; const float* w_dn = a.in[14];
    bf16_t* WIN = (bf16_t*)(ws + WS_WIN); bf16_t* WOUT = (bf16_t*)(ws + WS_WOUT); bf16_t* WUP = (bf16_t*)(ws + WS_WUP); bf16_t* WDN = (bf16_t*)(ws + WS_WDN);
    bf16_t* H1 = (bf16_t*)(ws + WS_H1); bf16_t* XG = H1; bf16_t* MIX = (bf16_t*)(ws + WS_MIX); bf16_t* Z = (bf16_t*)(ws + WS_Z); bf16_t* U = (bf16_t*)(ws + WS_U);
    float* PART = (float*)(ws + WS_PART); float* RSTD2 = (float*)(ws + WS_RSTD2); bf16_t* KV = (bf16_t*)(ws + WS_KV); bf16_t* SP = (bf16_t*)(ws + WS_SP); float* SLAB = (float*)(ws + WS_SP);
    const int lo = a.ph_lo, hi = a.ph_hi;
#define IN(k) (lo <= (k) && (k) < hi)
    volatile LAS unsigned* MISC = (volatile LAS unsigned*)(lds + LDS_BYTES - 64);
    if (tid < 16) MISC[tid] = 0u;
    __syncthreads();
    const XcdBarrier bar = xcd_barrier_post((unsigned*)ws + 1024, MISC + 8);
    if (lo > hi) grid.sync();
#define SEAM(k) do { if (IN(k) && IN((k) + 1)) xcd_barrier(bar); } while (0)

    if (IN(0)) for (int rep_ = 0; rep_ < 1 + ((DUPMASK >> 0) & 1); ++rep_) { if (rep_) xcd_barrier(bar);
        LAS float* scr = (LAS float*)(lds + wid * 17408);
        const int gw = bx * 8 + wid, NGW = G * 8;
        constexpr int I_IN = (DM / 64) * (INW / 32);
        p0_convert(ResIn{w_in, WIN}, gw, NGW, I_IN, scr, lane);
        p0_convert(ResRest{w_out, w_up, w_dn, WOUT, WUP, WDN, ln2_g}, gw, NGW, NP0_REST, scr, lane);
        for (int m = gw; m < MP; m += NGW) {
            if (m < MR) rms_row(m < LP ? x_p + (size_t)m * DM : x_s + (size_t)(m - LP) * DM, ln1_g, H1 + (size_t)m * DM, lane);
            else {
#pragma unroll
                for (int j = 0; j < 8; ++j) *((u32x2*)(H1 + (size_t)m * DM) + lane + 64 * j) = (u32x2){0u, 0u};
            }
        }
    }
    SEAM(0);
    if (IN(1)) for (int rep_ = 0; rep_ < 1 + ((DUPMASK >> 1) & 1); ++rep_) { if (rep_) xcd_barrier(bar);
        pg8::Gemm g{H1, WIN, MP, INW, DM}; pg8::StaticOrder S; S.init(MP, INW, G, bx, WGM_IN);
        pg8::EpiIn E{Z};
        pg8::gemm_phase<pg8::EpiIn, pg8::StaticOrder, true, true>(lds, g, S, E);
        {
            constexpr int NT = (MP / 256) * (INW / 256); const int rounds = (NT + G - 1) / G, first_idle = NT - (rounds - 1) * G;
            const int nidle = (first_idle < G) ? (G - first_idle) : G, me = (first_idle < G) ? (bx - first_idle) : bx;
            if (me >= 0) {
                LAS float* scr = (LAS float*)(lds + wid * 17408);
                constexpr int I_OUT = (DM / 64) * (DM / 32), I_UP = (DM / 64) * (FF / 32), I_DN = (FF / 64) * (DM / 32);
                p0_convert(ResRest{w_out, w_up, w_dn, WOUT, WUP, WDN, ln2_g}, NP0_REST + me * 8 + wid, nidle * 8, I_OUT + I_UP + I_DN, scr, lane);
            }
        }
    }
    SEAM(1);
    if (IN(2)) for (int rep_ = 0; rep_ < 1 + ((DUPMASK >> 2) & 1); ++rep_) { if (rep_) xcd_barrier(bar);
        if (bx & 1) for (int u = bx; u < 256; u += G) ret_decode_unit(lds, Z, state0, out + O_SS, MIX, rng, u >> 2, u & 3, tid);
        for (int u = bx; u < 256; u += G) ret_step1(lds, Z, KV, u >> 2, u & 3, tid);
        if (!(bx & 1)) for (int u = bx; u < 256; u += G) ret_decode_unit(lds, Z, state0, out + O_SS, MIX, rng, u >> 2, u & 3, tid);
    }
    SEAM(2);
    if (IN(3)) for (int rep_ = 0; rep_ < 1 + ((DUPMASK >> 3) & 1); ++rep_) { if (rep_) xcd_barrier(bar);
        if (tid < 256) ret_scan(KV, SP, out + O_SP, bx * 256 + tid, G * 256);
        if (bx & 1) for (int u = bx; u < 256; u += G) attn_decode_unit(lds, Z, cache_k, cache_v, MIX, gq, gk, sinks, out + O_KS, out + O_VS, u >> 1, u & 1, tid);
        for (int u = 256 + bx; u < 512; u += G) ret_decode_unit(lds, Z, state0, out + O_SS, MIX, rng, u >> 2, u & 3, tid);
        if (!(bx & 1)) for (int u = bx; u < 256; u += G) attn_decode_unit(lds, Z, cache_k, cache_v, MIX, gq, gk, sinks, out + O_KS, out + O_VS, u >> 1, u & 1, tid);
    }
    SEAM(3);
    if (IN(4)) for (int rep_ = 0; rep_ < 1 + ((DUPMASK >> 4) & 1); ++rep_) { if (rep_) xcd_barrier(bar);
        for (int u = bx; u < 256; u += G) ret_step2(lds, Z, SP, MIX, rng, u >> 2, u & 3, tid);
        for (int u = bx; u < 256; u += G) attn_prompt_unit(lds, Z, MIX, gq, gk, sinks, out + O_KP, out + O_VP, u >> 2, (u >> 1) & 1, u & 1, tid);
    }
    SEAM(4);
    if (IN(5)) for (int rep_ = 0; rep_ < 1 + ((DUPMASK >> 5) & 1); ++rep_) { if (rep_) xcd_barrier(bar);
        pg8::Gemm g{MIX, WOUT, LP, DM, DM}; pg8::StaticOrder S; S.init(LP, DM, G, bx, WGM_OUT);
        pg8::EpiOut E{x_p, XG, PART};
        pg8::gemm_phase<pg8::EpiOut, pg8::StaticOrder, true, true>(lds, g, S, E);
        const SkOut SE{x_s, out + O_Y + (size_t)LP * DM, XG + (size_t)LP * DM};
        for (int u = G - 1 - bx; u < DM / 32; u += G) skinny_unit(lds, MIX + (size_t)LP * DM, WOUT, DM, u, 0, SE, tid);
    }
    SEAM(5);
    if (IN(6)) for (int rep_ = 0; rep_ < 1 + ((DUPMASK >> 6) & 1); ++rep_) { if (rep_) xcd_barrier(bar);
        for (int row = bx + G * tid; row < LP; row += G * 512) { float s = 0.f;
#pragma unroll
            for (int j = 0; j < 8; ++j) { const f32x4 p = *(const f32x4*)(PART + (size_t)row * 32 + 4 * j); s += (p[0] + p[1]) + (p[2] + p[3]); }
            RSTD2[row] = 1.0f / (s * (1.0f / DM) + EPS); }
        for (int row = LP + bx * 8 + wid; row < MR; row += G * 8) {
            const float* xr = out + O_Y + (size_t)row * DM; float s = 0.f;
#pragma unroll
            for (int j = 0; j < 8; ++j) { const f32x4 v = *((const f32x4*)xr + lane + 64 * j); s += (v[0] * v[0] + v[1] * v[1]) + (v[2] * v[2] + v[3] * v[3]); }
            s = wave_sum(s); if (lane == 0) RSTD2[row] = 1.0f / (s * (1.0f / DM) + EPS); }
        pg8::Gemm g{XG, WUP, LP, FF, DM}; pg8::StaticOrder S; S.init(LP, FF, G, bx, WGM_UP);
        pg8::EpiUp E{U};
        pg8::gemm_phase<pg8::EpiUp, pg8::StaticOrder, true, true>(lds, g, S, E);
        const SkUp SE{U + (size_t)LP * FF};
        for (int u = bx; u < FF / 32; u += G) skinny_unit(lds, XG + (size_t)LP * DM, WUP, DM, u, 0, SE, tid);
    }
    SEAM(6);
    if (IN(7)) {
        pg8::Gemm g{U, WDN, LP, DM, FF}; pg8::StaticOrder S; S.init(LP, DM, G, bx, WGM_DN);
        pg8::EpiDown E{out + O_Y, XG, RSTD2};
        pg8::gemm_phase<pg8::EpiDown, pg8::StaticOrder, true, true>(lds, g, S, E);
        for (int u = bx; u < 4 * (DM / 32); u += G) { const SkSlab SE{SLAB + (size_t)(u & 3) * NS * DM}; skinny_unit(lds, U + (size_t)LP * FF, WDN, FF, u >> 2, (u & 3) * 2048, SE, tid); }
    }
    SEAM(7);
    if (IN(8)) {
        for (int e = bx * 512 + tid; e < NS * DM / 4; e += G * 512) {
            const int row = e >> 9; float* p = out + O_Y + (size_t)LP * DM + (size_t)e * 4;
            const f32x4 s = (*(const f32x4*)(SLAB + (size_t)e * 4) + *(const f32x4*)(SLAB + (size_t)NS * DM + (size_t)e * 4)) + (*(const f32x4*)(SLAB + (size_t)2 * NS * DM + (size_t)e * 4) + *(const f32x4*)(SLAB + (size_t)3 * NS * DM + (size_t)e * 4));
            *(f32x4*)p = *(const f32x4*)p + s * RSTD2[LP + row];
        }
    }
#undef IN
#undef SEAM
}

#ifndef N_LAUNCHES
#define N_LAUNCHES 1
#endif
extern "C" void kernel_launch(void* const* d_in, const int* in_sizes, int n_in, void* d_out, int out_size, void* d_ws, size_t ws_size, hipStream_t stream) {
    static int grid = 0;
    if (grid == 0) {
        if (n_in != 15 || (size_t)out_size != O_END || ws_size < WS_END) { fprintf(stderr, "kernel_launch: unexpected shapes (n_in %d out %d ws %zu)\n", n_in, out_size, ws_size); grid = -1; return; }
        int dev = 0, cus = 0, per_cu = 0;
        (void)hipGetDevice(&dev); (void)hipDeviceGetAttribute(&cus, hipDeviceAttributeMultiprocessorCount, dev);
        if (hipFuncSetAttribute((const void*)fwd_kernel, hipFuncAttributeMaxDynamicSharedMemorySize, LDS_BYTES) != hipSuccess) { fprintf(stderr, "kernel_launch: hipFuncSetAttribute failed\n"); grid = -1; return; }
        (void)hipOccupancyMaxActiveBlocksPerMultiprocessor(&per_cu, (const void*)fwd_kernel, 512, LDS_BYTES);
        (void)hipGetLastError();
        if (per_cu < 1) { fprintf(stderr, "kernel_launch: occupancy query says %d blocks per CU\n", per_cu); }
        grid = cus > 0 ? cus : 256;
    }
    if (grid < 0) return;
    if (hipMemsetAsync(d_ws, 0, 65536, stream) != hipSuccess) { fprintf(stderr, "kernel_launch: memset failed\n"); return; }
    Args a{};
    for (int i = 0; i < 15; ++i) a.in[i] = (const float*)d_in[i];
    a.out = (float*)d_out; a.ws = (unsigned char*)d_ws;
    if (N_LAUNCHES == 1) {
        a.ph_lo = 0; a.ph_hi = NPH;
        void* args[] = {&a};
        hipError_t e = hipLaunchCooperativeKernel((const void*)fwd_kernel, dim3(grid), dim3(512), args, LDS_BYTES, stream);
        if (e != hipSuccess) fprintf(stderr, "cooperative launch failed: %s (grid %d)\n", hipGetErrorString(e), grid);
    } else {
        for (int p = 0; p < NPH; ++p) { a.ph_lo = p; a.ph_hi = p + 1; hipLaunchKernelGGL(fwd_kernel, dim3(grid), dim3(512), LDS_BYTES, stream, a); }
    }
}
```

```cpp
#include <hip/hip_runtime.h>
#include <hip/hip_cooperative_groups.h>
#include <cstdio>
#include <cstdint>
namespace cg = cooperative_groups;

#ifndef WGM_IN
#define WGM_IN 2
#endif
#ifndef WGM_OUT
#define WGM_OUT 2
#endif
#ifndef WGM_UP
#define WGM_UP 2
#endif
#ifndef WGM_DN
#define WGM_DN 2
#endif
#ifndef DUPMASK
#define DUPMASK 0
#endif
#define DI __device__ __forceinline__
#define LAS __attribute__((address_space(3)))
typedef float f32x2 __attribute__((ext_vector_type(2)));
typedef float f32x16 __attribute__((ext_vector_type(16)));
typedef short s16x4 __attribute__((ext_vector_type(4)));
typedef unsigned u32x2 __attribute__((ext_vector_type(2)));
typedef __bf16 bf16x2v __attribute__((ext_vector_type(2)));

constexpr int DM = 2048, LP = 8192, NS = 128, MR = LP + NS  , MP = 8448  ;
constexpr int INW = 5376, FF = 8192;
constexpr int C_AQ = 0, C_AK = 1024, C_AV = 1152, C_RQ = 1280, C_RK = 2304, C_RV = 3328, C_RG = 4352;
constexpr float EPS = 1e-6f;

DI unsigned pk2(float lo, float hi) { f32x2 v = {lo, hi}; return __builtin_bit_cast(unsigned, __builtin_convertvector(v, bf16x2v)); }
DI float bflo(unsigned u) { return __uint_as_float(u << 16); }
DI float bfhi(unsigned u) { return __uint_as_float(u & 0xffff0000u); }
DI float bf2f(unsigned short u) { return __uint_as_float(((unsigned)u) << 16); }

namespace pg8 {
#define PG8_LAS __attribute__((address_space(3)))
typedef unsigned short bf16_t;
typedef short bf16x8 __attribute__((ext_vector_type(8)));
typedef float f32x4 __attribute__((ext_vector_type(4)));
typedef unsigned u32x4 __attribute__((ext_vector_type(4)));
constexpr int BM = 256, BK = 64, HALF = 128, HTB = HALF * BK * 2  , STAGE_BYTES = 8 * HTB, NXCD = 8, WGM = 8;

__host__ __device__ __forceinline__ int lds_byte(int r, int c) { const int st = (r >> 4) * 2 + (c >> 5), rr = r & 15, cc = c & 31, ob = rr * 64 + cc * 2; return st * 1024 + (ob ^ (((ob >> 9) & 1) << 5)); }
__host__ __device__ __forceinline__ void stage_rc(int b, int& R, int& C) { const int st = b / 1024, sb = b % 1024, swz = sb ^ (((sb >> 9) & 1) << 5); R = (st >> 1) * 16 + swz / 64; C = (st & 1) * 32 + (swz % 64) / 2; }
__host__ __device__ __forceinline__ int perm32(int rho) { const int n = rho >> 4, i = rho & 15; return 8 * (i >> 2) + 4 * n + (i & 3); }

struct Unit { int pm, pn; };
struct Gemm { const bf16_t* A; const bf16_t* Bt; int M, N, K; };

struct StaticOrder {
    int nM, nN, nwg, G, c, wgm;
    __host__ __device__ void init(int M, int N, int G_, int c_, int wgm_) { nM = M / BM; nN = N / BM; nwg = nM * nN; G = G_; c = c_; wgm = wgm_; }
    __host__ __device__ bool next(int i, Unit& u) const {
        const long L = (long)i * G + c; if (L >= nwg) return false;
        int wgid = (int)L; { const int q = nwg / NXCD, r = nwg % NXCD, xcd = wgid % NXCD, off = wgid / NXCD; wgid = (xcd < r ? xcd * (q + 1) : r * (q + 1) + (xcd - r) * q) + off; }
        const int nig = wgm * nN, gid = wgid / nig, fm = gid * wgm, gsz = (nM - fm) < wgm ? (nM - fm) : wgm;
        u.pm = fm + ((wgid % nig) % gsz); u.pn = (wgid % nig) / gsz; return true;
    }
    __device__ __forceinline__ void a_ready(const Unit&) const {}
    __device__ __forceinline__ void done(const Unit&) const {}
};


DI u32x4 pack8f(const f32x4& a, const f32x4& b) { u32x4 w; w.x = pk2(a[0], a[1]); w.y = pk2(a[2], a[3]); w.z = pk2(b[0], b[1]); w.w = pk2(b[2], b[3]); return w; }

struct EpiIn {
    static constexpr bool PERM = true, AFTER_DRAIN = false;
    bf16_t* Z;
    __device__ __forceinline__ void operator()(const f32x4 (&acc)[2][2][4][2], const Unit& u, int wr, int wc, int fr, int fq) const {
        const int row0 = u.pm * BM + wr * 64 + fr, col0 = u.pn * BM + wc * 32 + 8 * fq;
        if (u.pn < 5 || u.pn > 12) {
#pragma unroll
            for (int ai = 0; ai < 2; ++ai)
#pragma unroll
                for (int m = 0; m < 4; ++m) { bf16_t* rowp = Z + (size_t)(row0 + ai * HALF + m * 16) * INW + col0;
#pragma unroll
                    for (int bj = 0; bj < 2; ++bj) *(u32x4*)(rowp + bj * HALF) = pack8f(acc[ai][bj][m][0], acc[ai][bj][m][1]); }
        } else {
            const int head = (u.pn - 5) & 3; const bool isk = u.pn >= 9;
            const float lg = log1pf(-exp2f(-5.0f - (float)head));
            float inv[8];
#pragma unroll
            for (int j = 0; j < 8; ++j) inv[j] = powf(10000.0f, -(float)(wc * 32 + 8 * fq + j) * (1.0f / 128.0f));
#pragma unroll
            for (int ai = 0; ai < 2; ++ai)
#pragma unroll
                for (int m = 0; m < 4; ++m) {
                    const int row = row0 + ai * HALF + m * 16;
                    const int pos = row < LP ? row : LP; const float t = row < LP ? (float)(row & 127) : 0.0f;
                    const float f = isk ? 0.0625f * __expf(-lg * t) : __expf(lg * t);
                    f32x4 o1[2], o2[2];
#pragma unroll
                    for (int n = 0; n < 2; ++n)
#pragma unroll
                        for (int e = 0; e < 4; ++e) {
                            const float ang = (float)pos * inv[n * 4 + e];
                            double rev = (double)ang * 0.15915494309189535; rev -= floor(rev);
                            const float fr_ = (float)rev; const float sn = __builtin_amdgcn_sinf(fr_), cs = __builtin_amdgcn_cosf(fr_);
                            const float x1 = acc[ai][0][m][n][e], x2 = acc[ai][1][m][n][e];
                            o1[n][e] = (x1 * cs - x2 * sn) * f; o2[n][e] = (x2 * cs + x1 * sn) * f;
                        }
                    bf16_t* rowp = Z + (size_t)row * INW + col0;
                    *(u32x4*)(rowp) = pack8f(o1[0], o1[1]); *(u32x4*)(rowp + HALF) = pack8f(o2[0], o2[1]);
                }
        }
    }
};

struct EpiOut {
    static constexpr bool PERM = true, AFTER_DRAIN = false;
    const float* xp; bf16_t* X1B; float* part;
    __device__ __forceinline__ void operator()(const f32x4 (&acc)[2][2][4][2], const Unit& u, int wr, int wc, int fr, int fq) const {
#pragma unroll
        for (int ai = 0; ai < 2; ++ai)
#pragma unroll
            for (int m = 0; m < 4; ++m) {
                const int row = u.pm * BM + ai * HALF + wr * 64 + m * 16 + fr;
                const float* xrow = xp + (size_t)row * DM;
                float ss = 0.f;
#pragma unroll
                for (int bj = 0; bj < 2; ++bj) {
                    const int col = u.pn * BM + bj * HALF + wc * 32 + 8 * fq;
                    const f32x4 v0 = acc[ai][bj][m][0] + *(const f32x4*)(xrow + col), v1 = acc[ai][bj][m][1] + *(const f32x4*)(xrow + col + 4);
                    ss += (v0[0] * v0[0] + v0[1] * v0[1]) + (v0[2] * v0[2] + v0[3] * v0[3]) + (v1[0] * v1[0] + v1[1] * v1[1]) + (v1[2] * v1[2] + v1[3] * v1[3]);
                    *(u32x4*)(X1B + (size_t)row * DM + col) = pack8f(v0, v1);
                }
                ss += __shfl_xor(ss, 16); ss += __shfl_xor(ss, 32);
                if (fq == 0) part[(size_t)row * 32 + u.pn * 4 + wc] = ss;
            }
    }
};

struct EpiUp {
    static constexpr bool PERM = true, AFTER_DRAIN = false;
    bf16_t* U;
    __device__ __forceinline__ void operator()(const f32x4 (&acc)[2][2][4][2], const Unit& u, int wr, int wc, int fr, int fq) const {
        const int row0 = u.pm * BM + wr * 64 + fr, col0 = u.pn * BM + wc * 32 + 8 * fq;
#pragma unroll
        for (int ai = 0; ai < 2; ++ai)
#pragma unroll
            for (int m = 0; m < 4; ++m) { bf16_t* rowp = U + (size_t)(row0 + ai * HALF + m * 16) * FF + col0;
#pragma unroll
                for (int bj = 0; bj < 2; ++bj) { f32x4 a = acc[ai][bj][m][0], b = acc[ai][bj][m][1];
#pragma unroll
                    for (int e = 0; e < 4; ++e) { a[e] = fmaxf(a[e], 0.f); a[e] *= a[e]; b[e] = fmaxf(b[e], 0.f); b[e] *= b[e]; }
                    *(u32x4*)(rowp + bj * HALF) = pack8f(a, b); } }
    }
};

struct EpiDown {
    static constexpr bool PERM = true, AFTER_DRAIN = false;
    float* Y; const bf16_t* X1B; const float* rstd2;
    __device__ __forceinline__ void operator()(const f32x4 (&acc)[2][2][4][2], const Unit& u, int wr, int wc, int fr, int fq) const {
#pragma unroll
        for (int ai = 0; ai < 2; ++ai)
#pragma unroll
            for (int m = 0; m < 4; ++m) {
                const int row = u.pm * BM + ai * HALF + wr * 64 + m * 16 + fr; const float r2 = rstd2[row];
#pragma unroll
                for (int bj = 0; bj < 2; ++bj) { const size_t o = (size_t)row * DM + u.pn * BM + bj * HALF + wc * 32 + 8 * fq;
                    const u32x4 xb = *(const u32x4*)(X1B + o);
                    const f32x4 a = {bflo(xb.x), bfhi(xb.x), bflo(xb.y), bfhi(xb.y)}, b = {bflo(xb.z), bfhi(xb.z), bflo(xb.w), bfhi(xb.w)};
                    *(f32x4*)(Y + o) = a + acc[ai][bj][m][0] * r2; *(f32x4*)(Y + o + 4) = b + acc[ai][bj][m][1] * r2; }
            }
    }
};
template <class Epi, class Sched, bool ALIGN_EPI = false, bool SP2 = false>
__device__ __forceinline__ void gemm_phase(PG8_LAS unsigned char* lds, const Gemm g, const Sched& S, const Epi& E) {
    const int tid = threadIdx.x, wid = __builtin_amdgcn_readfirstlane(tid >> 6), lane = tid & 63, wr = wid >> 2, wc = wid & 3, fr = lane & 15, fq = lane >> 4;
    const int K = g.K, nt = K / BK;
    unsigned voffA[2], voffB[2];
#pragma unroll
    for (int i = 0; i < 2; ++i) { int R, C; stage_rc(tid * 16 + i * 8192, R, C); const int Rb = Epi::PERM ? ((R & ~31) + perm32(R & 31)) : R;
        voffA[i] = (unsigned)(R * K + C) * 2u; voffB[i] = (unsigned)(Rb * K + C) * 2u; }
    const size_t kstep = (size_t)(BK * 2);
    const size_t hstep = (size_t)HALF * K * 2;
    const size_t tstep = 2 * hstep;
    const unsigned ldsw = (unsigned)wid * 1024u;
    const int aoff = lds_byte(wr * 64 + fr, fq * 8), boff = lds_byte(wc * 32 + fr, fq * 8);
#define PG8_SA(b, h) (((b) * 2 + (h)) * HTB)
#define PG8_SB(b, h) ((4 + (b) * 2 + (h)) * HTB)
#define PG8_STAGE(bufoff, gbase, voff) do { _Pragma("unroll") for (int _i = 0; _i < 2; ++_i) \
        __builtin_amdgcn_global_load_lds((const unsigned*)((const char*)(gbase) + (voff)[_i]), (PG8_LAS unsigned*)(lds + (bufoff) + ldsw + _i * 8192), 16, 0, 0); } while (0)
#define PG8_LDA(dst, b, h) do { _Pragma("unroll") for (int m = 0; m < 4; ++m) _Pragma("unroll") for (int k = 0; k < 2; ++k) dst[m][k] = *(const PG8_LAS bf16x8*)(lds + PG8_SA(b, h) + aoff + m * 2048 + k * 1024); } while (0)
#define PG8_LDB(dst, b, h) do { _Pragma("unroll") for (int n = 0; n < 2; ++n) _Pragma("unroll") for (int k = 0; k < 2; ++k) dst[n][k] = *(const PG8_LAS bf16x8*)(lds + PG8_SB(b, h) + boff + n * 2048 + k * 1024); } while (0)
#define PG8_MMA(ai, bj, At, Bt) do { __builtin_amdgcn_s_setprio(1); _Pragma("unroll") for (int m = 0; m < 4; ++m) _Pragma("unroll") for (int n = 0; n < 2; ++n) _Pragma("unroll") for (int k = 0; k < 2; ++k) \
        acc[ai][bj][m][n] = __builtin_amdgcn_mfma_f32_16x16x32_bf16(Bt[n][k], At[m][k], acc[ai][bj][m][n], 0, 0, 0); __builtin_amdgcn_s_setprio(0); } while (0)
#define PG8_WAIT_V(n) asm volatile("s_waitcnt vmcnt(" #n ")" ::: "memory")
#define PG8_WAIT_L(n) asm volatile("s_waitcnt lgkmcnt(" #n ")" ::: "memory")
#define PG8_BAR __builtin_amdgcn_s_barrier()
#define PG8_SCHED __builtin_amdgcn_sched_barrier(0)
    Unit cur, nxt; int ui = 0;
    if (!S.next(0, cur)) return;
    f32x4 acc[2][2][4][2];
#pragma unroll
    for (int a = 0; a < 2; ++a)
#pragma unroll
        for (int b = 0; b < 2; ++b)
#pragma unroll
            for (int m = 0; m < 4; ++m)
#pragma unroll
                for (int n = 0; n < 2; ++n) acc[a][b][m][n] = (f32x4){0.f, 0.f, 0.f, 0.f};
    bf16x8 At[4][2], B0[2][2], B1[2][2];
    const char* cA = (const char*)g.A + (size_t)cur.pm * tstep; const char* cB = (const char*)g.Bt + (size_t)cur.pn * tstep;
    S.a_ready(cur);
    if constexpr (SP2) {
        PG8_STAGE(PG8_SB(0, 0), cB, voffB); PG8_STAGE(PG8_SB(0, 1), cB + hstep, voffB); PG8_STAGE(PG8_SA(0, 0), cA, voffA); PG8_STAGE(PG8_SA(0, 1), cA + hstep, voffA);
        if (wr == 1) PG8_BAR;
        PG8_WAIT_V(2); PG8_BAR;
        PG8_STAGE(PG8_SB(1, 0), cB + kstep, voffB); PG8_STAGE(PG8_SA(1, 0), cA + kstep, voffA); PG8_STAGE(PG8_SB(1, 1), cB + hstep + kstep, voffB);
        PG8_WAIT_V(6); PG8_BAR;
    } else {
        PG8_STAGE(PG8_SB(0, 0), cB, voffB); PG8_STAGE(PG8_SA(0, 0), cA, voffA); PG8_STAGE(PG8_SB(0, 1), cB + hstep, voffB); PG8_STAGE(PG8_SA(0, 1), cA + hstep, voffA);
        if (wr == 1) PG8_BAR;
        PG8_WAIT_V(4); PG8_BAR;
        PG8_STAGE(PG8_SB(1, 0), cB + kstep, voffB); PG8_STAGE(PG8_SA(1, 0), cA + kstep, voffA); PG8_STAGE(PG8_SB(1, 1), cB + hstep + kstep, voffB);
        PG8_WAIT_V(6); PG8_BAR;
    }
    for (;;) {
        const bool has_next = S.next(ui + 1, nxt);
        const char* nA = has_next ? (const char*)g.A + (size_t)nxt.pm * tstep : cA; const char* nB = has_next ? (const char*)g.Bt + (size_t)nxt.pn * tstep : cB;
        for (int t = 0; t < nt; t += 2) {
            const bool last = (t == nt - 2);
            const char* a1 = cA + (size_t)(t + 1) * kstep;
            const char* a2 = last ? nA : cA + (size_t)(t + 2) * kstep; const char* b2 = last ? nB : cB + (size_t)(t + 2) * kstep;
            const char* a3 = a2 + kstep; const char* b3 = b2 + kstep;
            if (last && has_next) S.a_ready(nxt);
            if constexpr (SP2) {
            PG8_LDB(B0, 0, 0); PG8_LDB(B1, 0, 1); PG8_SCHED; PG8_LDA(At, 0, 0); PG8_STAGE(PG8_SA(1, 1), a1 + hstep, voffA);
            PG8_WAIT_V(8); PG8_WAIT_L(0); PG8_BAR; PG8_MMA(0, 0, At, B0); PG8_MMA(0, 1, At, B1); PG8_BAR; PG8_SCHED;
            PG8_LDA(At, 0, 1); PG8_STAGE(PG8_SB(0, 0), b2, voffB); PG8_STAGE(PG8_SB(0, 1), b2 + hstep, voffB); PG8_STAGE(PG8_SA(0, 0), a2, voffA);
            PG8_WAIT_V(8); PG8_WAIT_L(0); PG8_BAR; PG8_MMA(1, 0, At, B0); PG8_MMA(1, 1, At, B1); PG8_BAR; PG8_SCHED;
            PG8_LDB(B0, 1, 0); PG8_LDB(B1, 1, 1); PG8_SCHED; PG8_LDA(At, 1, 0); PG8_STAGE(PG8_SA(0, 1), a2 + hstep, voffA);
            PG8_WAIT_V(8); PG8_WAIT_L(0); PG8_BAR; PG8_MMA(0, 0, At, B0); PG8_MMA(0, 1, At, B1); PG8_BAR; PG8_SCHED;
            PG8_LDA(At, 1, 1); PG8_STAGE(PG8_SB(1, 0), b3, voffB); PG8_STAGE(PG8_SB(1, 1), b3 + hstep, voffB); PG8_STAGE(PG8_SA(1, 0), a3, voffA);
            PG8_WAIT_V(8); PG8_WAIT_L(0); PG8_BAR; PG8_MMA(1, 0, At, B0); PG8_MMA(1, 1, At, B1); PG8_BAR; PG8_SCHED;
            } else {
            PG8_LDB(B0, 0, 0); PG8_SCHED; PG8_LDA(At, 0, 0); PG8_STAGE(PG8_SA(1, 1), a1 + hstep, voffA);
            PG8_WAIT_L(8); PG8_BAR; PG8_WAIT_L(0); PG8_MMA(0, 0, At, B0); PG8_BAR; PG8_SCHED;
            PG8_LDB(B1, 0, 1); PG8_STAGE(PG8_SB(0, 0), b2, voffB);
            PG8_BAR; PG8_WAIT_L(0); PG8_MMA(0, 1, At, B1); PG8_BAR;
            PG8_LDA(At, 0, 1); PG8_STAGE(PG8_SA(0, 0), a2, voffA);
            PG8_BAR; PG8_WAIT_L(0); PG8_MMA(1, 0, At, B0); PG8_BAR; PG8_SCHED;
            PG8_STAGE(PG8_SB(0, 1), b2 + hstep, voffB);
            PG8_WAIT_V(6); PG8_BAR; PG8_MMA(1, 1, At, B1); PG8_BAR;
            PG8_LDB(B0, 1, 0); PG8_SCHED; PG8_LDA(At, 1, 0); PG8_STAGE(PG8_SA(0, 1), a2 + hstep, voffA);
            PG8_WAIT_L(8); PG8_BAR; PG8_WAIT_L(0); PG8_MMA(0, 0, At, B0); PG8_BAR; PG8_SCHED;
            PG8_LDB(B1, 1, 1); PG8_STAGE(PG8_SB(1, 0), b3, voffB);
            PG8_BAR; PG8_WAIT_L(0); PG8_MMA(0, 1, At, B1); PG8_BAR;
            PG8_LDA(At, 1, 1); PG8_STAGE(PG8_SA(1, 0), a3, voffA);
            PG8_BAR; PG8_WAIT_L(0); PG8_MMA(1, 0, At, B0); PG8_BAR; PG8_SCHED;
            PG8_STAGE(PG8_SB(1, 1), b3 + hstep, voffB);
            PG8_WAIT_V(6); PG8_BAR; PG8_MMA(1, 1, At, B1); PG8_BAR;
            }
        }
        if constexpr (ALIGN_EPI) { if (wr == 0) PG8_BAR; }
        if constexpr (!Epi::AFTER_DRAIN) { E(acc, cur, wr, wc, fr, fq); S.done(cur); }
        if (!has_next) break;
#pragma unroll
        for (int a = 0; a < 2; ++a)
#pragma unroll
            for (int b = 0; b < 2; ++b)
#pragma unroll
                for (int m = 0; m < 4; ++m)
#pragma unroll
                    for (int n = 0; n < 2; ++n) acc[a][b][m][n] = (f32x4){0.f, 0.f, 0.f, 0.f};
        cur = nxt; cA = nA; cB = nB; ++ui;
        if constexpr (ALIGN_EPI) { if (wr == 1) PG8_BAR; }
    }
    PG8_WAIT_V(0);
    if constexpr (!ALIGN_EPI) { if (wr == 0) PG8_BAR; }
    PG8_BAR;
    if constexpr (Epi::AFTER_DRAIN) { E.fused(acc, cur, wr, wc, fr, fq, lds, wid, lane); S.done(cur); }
#undef PG8_SA
#undef PG8_SB
#undef PG8_STAGE
#undef PG8_LDA
#undef PG8_LDB
#undef PG8_MMA
#undef PG8_WAIT_V
#undef PG8_WAIT_L
#undef PG8_BAR
#undef PG8_SCHED
}
}

using pg8::bf16_t; using pg8::bf16x8; using pg8::f32x4; using pg8::u32x4;
#define MFMA32(a, b, c) __builtin_amdgcn_mfma_f32_32x32x16_bf16((a), (b), (c), 0, 0, 0)
DI int crow(int reg, int h) { return (reg & 3) + 8 * (reg >> 2) + 4 * h; }
DI float wave_sum(float v) {
#pragma unroll
    for (int o = 1; o < 64; o <<= 1) v += __shfl_xor(v, o);
    return v;
}
DI float wave_max(float v) {
#pragma unroll
    for (int o = 1; o < 64; o <<= 1) v = fmaxf(v, __shfl_xor(v, o));
    return v;
}
DI bf16x8 pack8(const f32x16& x, int s) { u32x4 p; p.x = pk2(x[8 * s], x[8 * s + 1]); p.y = pk2(x[8 * s + 2], x[8 * s + 3]); p.z = pk2(x[8 * s + 4], x[8 * s + 5]); p.w = pk2(x[8 * s + 6], x[8 * s + 7]); return __builtin_bit_cast(bf16x8, p); }
DI bf16x8 cat4(s16x4 lo, s16x4 hi) { return __builtin_shufflevector(lo, hi, 0, 1, 2, 3, 4, 5, 6, 7); }
DI f32x16 zero16() { f32x16 z;
#pragma unroll
    for (int i = 0; i < 16; ++i) z[i] = 0.f;
    return z; }
DI float gamma_of(int h) { return 1.0f - exp2f(-5.0f - (float)h); }

constexpr size_t MiB = 1u << 20;
constexpr size_t WS_WIN = 1 * MiB;
constexpr size_t WS_WOUT = 23 * MiB;
constexpr size_t WS_WUP = 31 * MiB;
constexpr size_t WS_WDN = 63 * MiB;
constexpr size_t WS_H1 = 95 * MiB;
constexpr size_t WS_MIX = 128 * MiB;
constexpr size_t WS_PART = 161 * MiB;
constexpr size_t WS_RSTD2 = 163 * MiB;
constexpr size_t WS_Z = 164 * MiB;
constexpr size_t WS_KV = 252 * MiB;
constexpr size_t WS_SP = 316 * MiB;
constexpr size_t WS_U = 164 * MiB;
constexpr size_t WS_END = 348 * MiB;
static_assert(WS_Z + (size_t)MP * INW * 2 <= WS_KV && WS_U + (size_t)MP * FF * 2 <= WS_END && WS_H1 + (size_t)MP * DM * 2 <= WS_MIX && WS_MIX + (size_t)MP * DM * 2 <= WS_PART, "ws map");
constexpr int LDS_BYTES = 147456;

constexpr size_t O_Y = 0, O_KP = (size_t)MR * DM, O_VP = O_KP + 16384, O_SP = O_VP + 16384, O_KS = O_SP + 262144, O_VS = O_KS + 2097152, O_SS = O_VS + 2097152, O_END = O_SS + 33554432;

struct TItem { const float* W; bf16_t* WT; int K, N, item; const float* rs; };
DI void p0_load(const TItem& t, f32x4 (&v)[8], int lane) {
    const int nblk = t.N / 32, kb = t.item / nblk, nb = t.item % nblk, k0 = 64 * kb, n0 = 32 * nb, c = lane & 7, rr = lane >> 3;
#pragma unroll
    for (int i = 0; i < 8; ++i) v[i] = __builtin_nontemporal_load((const f32x4*)(t.W + (size_t)(k0 + 8 * i + rr) * t.N + n0 + 4 * c));
    if (t.rs) {
#pragma unroll
        for (int i = 0; i < 8; ++i) v[i] = v[i] * t.rs[k0 + 8 * i + rr];
    }
}
DI void p0_store(const TItem& t, const f32x4 (&v)[8], LAS float* scr, int lane) {
    const int nblk = t.N / 32, kb = t.item / nblk, nb = t.item % nblk, k0 = 64 * kb, n0 = 32 * nb, c = lane & 7, rr = lane >> 3;
#pragma unroll
    for (int i = 0; i < 8; ++i) { LAS float* d = scr + (8 * i + rr) * 33 + 4 * c; d[0] = v[i][0]; d[1] = v[i][1]; d[2] = v[i][2]; d[3] = v[i][3]; }
    asm volatile("s_waitcnt lgkmcnt(0)" ::: "memory");
#pragma unroll
    for (int j = 0; j < 4; ++j) { const int n = (lane >> 3) + 8 * j; const LAS float* s = scr + (8 * c) * 33 + n;
        u32x4 o; o.x = pk2(s[0 * 33], s[1 * 33]); o.y = pk2(s[2 * 33], s[3 * 33]); o.z = pk2(s[4 * 33], s[5 * 33]); o.w = pk2(s[6 * 33], s[7 * 33]);
        *(u32x4*)(t.WT + (size_t)(n0 + n) * t.K + k0 + 8 * c) = o; }
    asm volatile("s_waitcnt lgkmcnt(0)" ::: "memory");
}
struct ResIn { const float* w; bf16_t* wt; DI TItem operator()(int it) const { return TItem{w, wt, DM, INW, it, nullptr}; } };
struct ResRest { const float* w_out; const float* w_up; const float* w_dn; bf16_t* WOUT; bf16_t* WUP; bf16_t* WDN; const float* g2;
    DI TItem operator()(int it) const { constexpr int I_OUT = (DM / 64) * (DM / 32), I_UP = (DM / 64) * (FF / 32); int r = it;
        if (r < I_OUT) return TItem{w_out, WOUT, DM, DM, r, nullptr}; r -= I_OUT;
        if (r < I_UP) return TItem{w_up, WUP, DM, FF, r, g2}; r -= I_UP;
        return TItem{w_dn, WDN, FF, DM, r, nullptr}; } };
template <class Resolve>
DI void p0_convert(const Resolve R, int first, int stride, int total, LAS float* scr, int lane) {
    for (int it = first; it < total; it += 2 * stride) {
        const bool two = it + stride < total;
        const TItem t0 = R(it), t1 = R(two ? it + stride : it);
        f32x4 v0[8], v1[8];
        p0_load(t0, v0, lane);
        if (two) p0_load(t1, v1, lane);
        p0_store(t0, v0, scr, lane);
        if (two) p0_store(t1, v1, scr + 64 * 33, lane);
    }
}
DI void rms_row(const float* xrow, const float* g, bf16_t* orow, int lane) {
    f32x4 v[8]; float s = 0.f;
#pragma unroll
    for (int j = 0; j < 8; ++j) { v[j] = *((const f32x4*)xrow + lane + 64 * j); s += (v[j][0] * v[j][0] + v[j][1] * v[j][1]) + (v[j][2] * v[j][2] + v[j][3] * v[j][3]); }
    const float rstd = rsqrtf(wave_sum(s) * (1.0f / DM) + EPS);
#pragma unroll
    for (int j = 0; j < 8; ++j) { const f32x4 gg = *((const f32x4*)g + lane + 64 * j); u32x2 o; o.x = pk2(v[j][0] * rstd * gg[0], v[j][1] * rstd * gg[1]); o.y = pk2(v[j][2] * rstd * gg[2], v[j][3] * rstd * gg[3]);
        *((u32x2*)orow + lane + 64 * j) = o; }
}

DI void stage_T128x256(LAS unsigned char* img, const bf16_t* src, int tid) {
#pragma unroll
    for (int k = 0; k < 4; ++k) {
        const int it = k * 512 + tid, dgl = it & 3, tpl = (it >> 2) & 15, rest = it >> 6, dg = dgl + 4 * (rest & 7), tp = tpl + 16 * (rest >> 3);
        const bf16_t* p = src + (size_t)(2 * tp) * INW + dg * 8;
        const u32x4 a = *(const u32x4*)p, b = *(const u32x4*)(p + INW);
#pragma unroll
        for (int e = 0; e < 8; ++e) {
            const unsigned lo = (e & 1) ? (a[e >> 1] >> 16) : (a[e >> 1] & 0xffffu), hi = (e & 1) ? (b[e >> 1] & 0xffff0000u) : (b[e >> 1] << 16);
            *(LAS unsigned*)(img + (dg * 8 + e) * 264 + tp * 4) = lo | hi;
        }
    }
}

DI void ret_step1(LAS unsigned char* lds, const bf16_t* Z, bf16_t* KV, int n, int h, int tid) {
    LAS unsigned char* Kt = lds; LAS unsigned char* Vt = lds + 256 * 264;
    const int lane = tid & 63, wid = tid >> 6, r = lane & 31, hh = lane >> 5;
    stage_T128x256(Kt, Z + (size_t)(n * 128) * INW + C_RK + h * 256, tid);
    stage_T128x256(Vt, Z + (size_t)(n * 128) * INW + C_RV + h * 256, tid);
    __syncthreads();
    f32x16 acc[8];
#pragma unroll
    for (int i = 0; i < 8; ++i) acc[i] = zero16();
    const int dk0 = wid * 32;
#pragma unroll 2
    for (int s = 0; s < 8; ++s) {
        const LAS unsigned char* pa = Kt + (dk0 + r) * 264 + (16 * s + 8 * hh) * 2;
        const bf16x8 A = cat4(*(const LAS s16x4*)pa, *(const LAS s16x4*)(pa + 8));
#pragma unroll
        for (int dt = 0; dt < 8; ++dt) {
            const LAS unsigned char* pb = Vt + (dt * 32 + r) * 264 + (16 * s + 8 * hh) * 2;
            const bf16x8 B = cat4(*(const LAS s16x4*)pb, *(const LAS s16x4*)(pb + 8));
            acc[dt] = MFMA32(A, B, acc[dt]);
        }
    }
    bf16_t* out = KV + ((size_t)(n * 4 + h) * 256) * 256 + dk0 + 4 * hh;
#pragma unroll
    for (int dt = 0; dt < 8; ++dt)
#pragma unroll
        for (int g4 = 0; g4 < 4; ++g4) { u32x2 o; o.x = pk2(acc[dt][4 * g4], acc[dt][4 * g4 + 1]); o.y = pk2(acc[dt][4 * g4 + 2], acc[dt][4 * g4 + 3]);
            *(u32x2*)(out + (size_t)(dt * 32 + r) * 256 + 8 * g4) = o; }
    __syncthreads();
}

DI void ret_scan(const bf16_t* KV, bf16_t* SP, float* o_state, int gt, int nthreads) {
    for (int e = gt; e < 65536; e += nthreads) {
        const int h = e >> 14, dv = (e >> 6) & 255, dk4 = (e & 63) * 4;
        const float lg = log1pf(-exp2f(-5.0f - (float)h)), Dc = __expf(128.0f * lg), c1 = __expf(127.0f * lg);
        const size_t base = ((size_t)(h * 256 + dv)) * 256 + dk4;
        f32x4 s = {0.f, 0.f, 0.f, 0.f};
        for (int n0 = 0; n0 < 64; n0 += 32) {
            u32x2 q[32];
#pragma unroll
            for (int u = 0; u < 32; ++u) q[u] = *(const u32x2*)(KV + (size_t)(n0 + u) * 262144 + base);
#pragma unroll
            for (int u = 0; u < 32; ++u) { u32x2 o; o.x = pk2(s[0], s[1]); o.y = pk2(s[2], s[3]); *(u32x2*)(SP + (size_t)(n0 + u) * 262144 + base) = o;
                const f32x4 kv = {bflo(q[u].x), bfhi(q[u].x), bflo(q[u].y), bfhi(q[u].y)}; s = s * Dc + kv * c1; }
        }
#pragma unroll
        for (int j = 0; j < 4; ++j) o_state[((size_t)(h * 256 + dk4 + j)) * 256 + dv] = s[j];
    }
}

DI float silu_f(float x) { return x / (1.0f + __expf(-x)); }

DI void ret_step2(LAS unsigned char* lds, const bf16_t* Z, const bf16_t* SP, bf16_t* MIX, const float* rng, int n, int h, int tid) {
    LAS unsigned char* Kr = lds; LAS unsigned char* Vt = lds + 128 * 528; LAS float* red = (LAS float*)(lds + 128 * 528 + 256 * 264);
    const int lane = tid & 63, wid = tid >> 6, r = lane & 31, hh = lane >> 5;
    const bf16_t* zc = Z + (size_t)(n * 128) * INW;
#pragma unroll
    for (int k = 0; k < 8; ++k) { const int it = k * 512 + tid, row = it >> 5, c = it & 31;
        *(LAS u32x4*)(Kr + row * 528 + c * 16) = *(const u32x4*)(zc + (size_t)row * INW + C_RK + h * 256 + c * 8); }
    stage_T128x256(Vt, zc + C_RV + h * 256, tid);
    const int it_ = wid >> 1, dh = wid & 1;
    bf16x8 qf[16];
    { const bf16_t* qp = zc + (size_t)(32 * it_ + r) * INW + C_RQ + h * 256 + 8 * hh;
#pragma unroll
      for (int s = 0; s < 16; ++s) qf[s] = *(const bf16x8*)(qp + 16 * s); }
    f32x16 acc[4];
#pragma unroll
    for (int i = 0; i < 4; ++i) acc[i] = zero16();
    const float gm = gamma_of(h);
    __syncthreads();
    for (int jt = 0; jt <= it_; ++jt) {
        f32x16 X = zero16();
#pragma unroll
        for (int s = 0; s < 16; ++s) { const bf16x8 A = *(const LAS bf16x8*)(Kr + (32 * jt + r) * 528 + (16 * s + 8 * hh) * 2); X = MFMA32(A, qf[s], X); }
        if (jt == it_) {
#pragma unroll
            for (int i = 0; i < 16; ++i) X[i] = (crow(i, hh) > r) ? 0.f : X[i];
        }
#pragma unroll
        for (int s2 = 0; s2 < 2; ++s2) { const bf16x8 xs = pack8(X, s2);
#pragma unroll
            for (int dt = 0; dt < 4; ++dt) { const LAS unsigned char* pa = Vt + (128 * dh + 32 * dt + r) * 264 + (32 * jt + 16 * s2 + 4 * hh) * 2;
                const bf16x8 A = cat4(*(const LAS s16x4*)pa, *(const LAS s16x4*)(pa + 16)); acc[dt] = MFMA32(A, xs, acc[dt]); } }
    }
    { const float ig = 1.0f / gm;
#pragma unroll
      for (int dt = 0; dt < 4; ++dt) acc[dt] = acc[dt] * ig; }
    __syncthreads();
    { const bf16_t* spg = SP + (size_t)(n * 4 + h) * 65536;
#pragma unroll 1
      for (int k0 = 0; k0 < 16; k0 += 4) {
          u32x4 spr[4];
#pragma unroll
          for (int k = 0; k < 4; ++k) { const int it = (k0 + k) * 512 + tid; spr[k] = *(const u32x4*)(spg + (size_t)(it >> 5) * 256 + (it & 31) * 8); }
#pragma unroll
          for (int k = 0; k < 4; ++k) { const int it = (k0 + k) * 512 + tid; *(LAS u32x4*)(lds + (it >> 5) * 528 + (it & 31) * 16) = spr[k]; }
      } }
    __syncthreads();
#pragma unroll
    for (int dt = 0; dt < 4; ++dt)
#pragma unroll
        for (int s = 0; s < 16; ++s) { const bf16x8 A = *(const LAS bf16x8*)(lds + (128 * dh + 32 * dt + r) * 528 + (16 * s + 8 * hh) * 2); acc[dt] = MFMA32(A, qf[s], acc[dt]); }
#pragma unroll
    for (int dt = 0; dt < 4; ++dt) acc[dt] = acc[dt] * gm;
    float ss = 0.f;
#pragma unroll
    for (int dt = 0; dt < 4; ++dt)
#pragma unroll
        for (int i = 0; i < 16; ++i) ss += acc[dt][i] * acc[dt][i];
    ss += __shfl_xor(ss, 32);
    if (hh == 0) red[wid * 32 + r] = ss;
    __syncthreads();
    const float rstd = rsqrtf((red[wid * 32 + r] + red[(wid ^ 1) * 32 + r]) * (1.0f / 256.0f) + EPS);
    const size_t token = (size_t)n * 128 + 32 * it_ + r;
#pragma unroll
    for (int dt = 0; dt < 4; ++dt)
#pragma unroll
        for (int g4 = 0; g4 < 4; ++g4) {
            const int dv = 128 * dh + 32 * dt + 8 * g4 + 4 * hh;
            const u32x2 gz = *(const u32x2*)(Z + token * INW + C_RG + h * 256 + dv);
            const f32x4 gn = *(const f32x4*)(rng + h * 256 + dv);
            const float y0 = acc[dt][4 * g4 + 0] * rstd * gn[0] * silu_f(bflo(gz.x)), y1 = acc[dt][4 * g4 + 1] * rstd * gn[1] * silu_f(bfhi(gz.x));
            const float y2 = acc[dt][4 * g4 + 2] * rstd * gn[2] * silu_f(bflo(gz.y)), y3 = acc[dt][4 * g4 + 3] * rstd * gn[3] * silu_f(bfhi(gz.y));
            u32x2 o; o.x = pk2(y0, y1); o.y = pk2(y2, y3);
            *(u32x2*)(MIX + token * DM + 1024 + h * 256 + dv) = o;
        }
    __syncthreads();
}

DI void ret_decode_unit(LAS unsigned char* lds, const bf16_t* Z, const float* S0, float* S1, bf16_t* MIX, const float* rng, int b, int h, int tid) {
    LAS float* qv = (LAS float*)lds; LAS float* red = qv + 768;
    const int lane = tid & 63, wid = tid >> 6;
    const bf16_t* zrow = Z + (size_t)(LP + b) * INW;
    if (tid < 256) { qv[tid] = bf2f(zrow[C_RQ + h * 256 + tid]); qv[256 + tid] = bf2f(zrow[C_RK + h * 256 + tid]); qv[512 + tid] = bf2f(zrow[C_RV + h * 256 + tid]); }
    __syncthreads();
    const float gm = gamma_of(h);
    const f32x4 v4 = *(const LAS f32x4*)(qv + 512 + 4 * lane);
    f32x4 acc = {0.f, 0.f, 0.f, 0.f};
    const size_t off = ((size_t)(b * 4 + h) * 256 + wid * 32) * 256 + 4 * lane;
    const float* s0 = S0 + off; float* s1 = S1 + off;
#pragma unroll 1
    for (int rr = 0; rr < 32; rr += 16) {
        f32x4 s[16];
#pragma unroll
        for (int u = 0; u < 16; ++u) s[u] = __builtin_nontemporal_load((const f32x4*)(s0 + (size_t)(rr + u) * 256));
#pragma unroll
        for (int u = 0; u < 16; ++u) { const int dk = wid * 32 + rr + u; const float kk = qv[256 + dk], qq = qv[dk];
            const f32x4 sn = s[u] * gm + v4 * kk; __builtin_nontemporal_store(sn, (f32x4*)(s1 + (size_t)(rr + u) * 256)); acc += sn * qq; }
    }
    *(LAS f32x4*)(red + wid * 256 + 4 * lane) = acc;
    __syncthreads();
    if (wid == 0) {
        f32x4 o = {0.f, 0.f, 0.f, 0.f};
#pragma unroll
        for (int w = 0; w < 8; ++w) o += *(const LAS f32x4*)(red + w * 256 + 4 * lane);
        const float ssq = wave_sum((o[0] * o[0] + o[1] * o[1]) + (o[2] * o[2] + o[3] * o[3]));
        const float rstd = rsqrtf(ssq * (1.0f / 256.0f) + EPS);
        const u32x2 gz = *(const u32x2*)(zrow + C_RG + h * 256 + 4 * lane);
        const f32x4 gn = *(const f32x4*)(rng + h * 256 + 4 * lane);
        u32x2 y; y.x = pk2(o[0] * rstd * gn[0] * silu_f(bflo(gz.x)), o[1] * rstd * gn[1] * silu_f(bfhi(gz.x)));
        y.y = pk2(o[2] * rstd * gn[2] * silu_f(bflo(gz.y)), o[3] * rstd * gn[3] * silu_f(bfhi(gz.y)));
        *(u32x2*)(MIX + (size_t)(LP + b) * DM + 1024 + h * 256 + 4 * lane) = y;
    }
    __syncthreads();
}

DI void attn_prompt_unit(LAS unsigned char* lds, const bf16_t* Z, bf16_t* MIX, const float* gq, const float* gk, const float* sinks, float* o_k, float* o_v, int nb, int kh, int hf, int tid) {
    LAS unsigned char* Kn = lds; LAS unsigned char* Vt = lds + 256 * 144;
    const int lane = tid & 63, wid = tid >> 6, r = lane & 31, hh = lane >> 5;
    {
        const int row = tid >> 1, half = tid & 1; const int tok = (nb - 1) * 128 + row;
        u32x4 v[4];
#pragma unroll
        for (int c = 0; c < 4; ++c) v[c] = (u32x4){0u, 0u, 0u, 0u};
        if (tok >= 0) {
#pragma unroll
            for (int c = 0; c < 4; ++c) v[c] = *(const u32x4*)(Z + (size_t)tok * INW + C_AK + kh * 64 + half * 32 + c * 8);
        }
        float f[32]; float ss = 0.f;
#pragma unroll
        for (int c = 0; c < 4; ++c)
#pragma unroll
            for (int e = 0; e < 4; ++e) { f[c * 8 + 2 * e] = bflo(v[c][e]); f[c * 8 + 2 * e + 1] = bfhi(v[c][e]); }
#pragma unroll
        for (int e = 0; e < 32; ++e) ss += f[e] * f[e];
        ss += __shfl_xor(ss, 1);
        const float rstd = rsqrtf(ss * (1.0f / 64.0f) + EPS);
#pragma unroll
        for (int c = 0; c < 8; ++c) { const f32x4 g = *(const f32x4*)(gk + half * 32 + c * 4);
#pragma unroll
            for (int e = 0; e < 4; ++e) f[c * 4 + e] *= rstd * g[e]; }
#pragma unroll
        for (int c = 0; c < 4; ++c) { u32x4 w; w.x = pk2(f[c * 8], f[c * 8 + 1]); w.y = pk2(f[c * 8 + 2], f[c * 8 + 3]); w.z = pk2(f[c * 8 + 4], f[c * 8 + 5]); w.w = pk2(f[c * 8 + 6], f[c * 8 + 7]);
            *(LAS u32x4*)(Kn + row * 144 + half * 64 + c * 16) = w; }
        if (nb == 63 && hf == 0 && row >= 128) { float* o = o_k + ((size_t)(row - 128) * 2 + kh) * 64 + half * 32;
#pragma unroll
            for (int c = 0; c < 8; ++c) *(f32x4*)(o + c * 4) = (f32x4){f[c * 4], f[c * 4 + 1], f[c * 4 + 2], f[c * 4 + 3]}; }
    }
#pragma unroll
    for (int k = 0; k < 2; ++k) {
        const int it = k * 512 + tid, kpl = it & 15, dgl = (it >> 4) & 3, rest = it >> 6, dg = dgl + 4 * (rest & 1), kp = kpl + 16 * (rest >> 1);
        const int tok0 = (nb - 1) * 128 + 2 * kp;
        u32x4 a = {0u, 0u, 0u, 0u}, b = {0u, 0u, 0u, 0u};
        if (tok0 >= 0) { const bf16_t* p = Z + (size_t)tok0 * INW + C_AV + kh * 64 + dg * 8; a = *(const u32x4*)p; b = *(const u32x4*)(p + INW); }
#pragma unroll
        for (int e = 0; e < 8; ++e) {
            const unsigned lo = (e & 1) ? (a[e >> 1] >> 16) : (a[e >> 1] & 0xffffu), hi = (e & 1) ? (b[e >> 1] & 0xffff0000u) : (b[e >> 1] << 16);
            *(LAS unsigned*)(Vt + (dg * 8 + e) * 520 + kp * 4) = lo | hi;
        }
        if (nb == 63 && hf == 0 && kp >= 64) { float* o = o_v + ((size_t)(2 * kp - 128) * 2 + kh) * 64 + dg * 8;
#pragma unroll
            for (int e = 0; e < 4; ++e) { o[2 * e] = bflo(a[e]); o[2 * e + 1] = bfhi(a[e]); o[128 + 2 * e] = bflo(b[e]); o[128 + 2 * e + 1] = bfhi(b[e]); } }
    }
    __syncthreads();
    const int hq = kh * 8 + 4 * hf + (wid >> 1), qh = wid & 1;
    const float sink = sinks[hq];
#pragma unroll 1
    for (int qq = 0; qq < 2; ++qq) {
        const int qi = 2 * qh + qq; const size_t tokq = (size_t)nb * 128 + 32 * qi + r;
        bf16x8 qf[4];
        {   const bf16_t* qp = Z + tokq * INW + hq * 64 + 8 * hh;
            u32x4 raw[4]; float ss = 0.f;
#pragma unroll
            for (int s = 0; s < 4; ++s) { raw[s] = *(const u32x4*)(qp + 16 * s);
#pragma unroll
                for (int e = 0; e < 4; ++e) { const float lo = bflo(raw[s][e]), hi = bfhi(raw[s][e]); ss += lo * lo + hi * hi; } }
            ss += __shfl_xor(ss, 32);
            const float rstd = rsqrtf(ss * (1.0f / 64.0f) + EPS) * 0.125f;
#pragma unroll
            for (int s = 0; s < 4; ++s) { const f32x4 g0 = *(const f32x4*)(gq + 16 * s + 8 * hh), g1 = *(const f32x4*)(gq + 16 * s + 8 * hh + 4); u32x4 w;
                w.x = pk2(bflo(raw[s].x) * rstd * g0[0], bfhi(raw[s].x) * rstd * g0[1]); w.y = pk2(bflo(raw[s].y) * rstd * g0[2], bfhi(raw[s].y) * rstd * g0[3]);
                w.z = pk2(bflo(raw[s].z) * rstd * g1[0], bfhi(raw[s].z) * rstd * g1[1]); w.w = pk2(bflo(raw[s].w) * rstd * g1[2], bfhi(raw[s].w) * rstd * g1[3]);
                qf[s] = __builtin_bit_cast(bf16x8, w); }
        }
        f32x16 X[5];
#pragma unroll
        for (int t = 0; t < 5; ++t) { X[t] = zero16();
#pragma unroll
            for (int s = 0; s < 4; ++s) { const bf16x8 A = *(const LAS bf16x8*)(Kn + (32 * (qi + t) + r) * 144 + (16 * s + 8 * hh) * 2); X[t] = MFMA32(A, qf[s], X[t]); } }
        const int ii = 32 * qi + r;
        float m = -1e30f;
#pragma unroll
        for (int t = 0; t < 5; ++t)
#pragma unroll
            for (int i = 0; i < 16; ++i) { const int jj = 32 * (qi + t) + crow(i, hh); const bool ok = (jj >= ii) && (jj <= ii + 128) && (nb > 0 || jj >= 128);
                X[t][i] = ok ? X[t][i] : -1e30f; m = fmaxf(m, X[t][i]); }
        m = fmaxf(m, __shfl_xor(m, 32)); m = fmaxf(m, sink);
        float sum = 0.f;
#pragma unroll
        for (int t = 0; t < 5; ++t)
#pragma unroll
            for (int i = 0; i < 16; ++i) { const float p = __expf(X[t][i] - m); X[t][i] = p; sum += p; }
        sum += __shfl_xor(sum, 32);
        const float inv = 1.0f / (sum + __expf(sink - m));
        f32x16 o[2]; o[0] = zero16(); o[1] = zero16();
#pragma unroll
        for (int t = 0; t < 5; ++t)
#pragma unroll
            for (int s2 = 0; s2 < 2; ++s2) { const bf16x8 xs = pack8(X[t], s2);
#pragma unroll
                for (int dt = 0; dt < 2; ++dt) { const LAS unsigned char* pa = Vt + (32 * dt + r) * 520 + (32 * (qi + t) + 16 * s2 + 4 * hh) * 2;
                    const bf16x8 A = cat4(*(const LAS s16x4*)pa, *(const LAS s16x4*)(pa + 16)); o[dt] = MFMA32(A, xs, o[dt]); } }
#pragma unroll
        for (int dt = 0; dt < 2; ++dt)
#pragma unroll
            for (int g4 = 0; g4 < 4; ++g4) { u32x2 w; w.x = pk2(o[dt][4 * g4] * inv, o[dt][4 * g4 + 1] * inv); w.y = pk2(o[dt][4 * g4 + 2] * inv, o[dt][4 * g4 + 3] * inv);
                *(u32x2*)(MIX + tokq * DM + hq * 64 + 32 * dt + 8 * g4 + 4 * hh) = w; }
    }
    __syncthreads();
}

DI void attn_decode_unit(LAS unsigned char* lds, const bf16_t* Z, const float* ck, const float* cv, bf16_t* MIX, const float* gq, const float* gk, const float* sinks, float* o_k, float* o_v, int b, int kh, int tid) {
    LAS float* Kc = (LAS float*)lds; LAS float* Vc = Kc + 129 * 65; LAS float* qs = Vc + 129 * 64; LAS float* pw = qs + 512;
    const int lane = tid & 63, wid = tid >> 6;
#pragma unroll
    for (int k = 0; k < 4; ++k) {
        const int it = k * 512 + tid, w = it >> 4, c4 = (it & 15) * 4;
        const size_t src = ((size_t)(b * 128 + w) * 2 + kh) * 64 + c4;
        const f32x4 k4 = *(const f32x4*)(ck + src), v4 = *(const f32x4*)(cv + src);
#pragma unroll
        for (int e = 0; e < 4; ++e) { Kc[w * 65 + c4 + e] = k4[e]; Vc[w * 64 + c4 + e] = v4[e]; }
        if (w >= 1) { const size_t dst = ((size_t)(b * 128 + w - 1) * 2 + kh) * 64 + c4; *(f32x4*)(o_k + dst) = k4; *(f32x4*)(o_v + dst) = v4; }
    }
    const bf16_t* zrow = Z + (size_t)(LP + b) * INW;
    const size_t dnew = ((size_t)(b * 128 + 127) * 2 + kh) * 64 + lane;
    if (wid == 0) { const float kx = bf2f(zrow[C_AK + kh * 64 + lane]); const float ss = wave_sum(kx * kx); const float kn = kx * rsqrtf(ss * (1.0f / 64.0f) + EPS) * gk[lane];
        Kc[128 * 65 + lane] = kn; o_k[dnew] = kn; }
    if (wid == 1) { const float vx = bf2f(zrow[C_AV + kh * 64 + lane]); Vc[128 * 64 + lane] = vx; o_v[dnew] = vx; }
    const int hq = kh * 8 + wid;
    { const float qx = bf2f(zrow[hq * 64 + lane]); const float ss = wave_sum(qx * qx); qs[wid * 64 + lane] = qx * rsqrtf(ss * (1.0f / 64.0f) + EPS) * gq[lane] * 0.125f; }
    __syncthreads();
    float s1 = 0.f, s2 = 0.f;
#pragma unroll 8
    for (int d = 0; d < 64; ++d) { const float q = qs[wid * 64 + d]; s1 += q * Kc[lane * 65 + d]; s2 += q * Kc[(lane + 64) * 65 + d]; }
    const float s3 = wave_sum(qs[wid * 64 + lane] * Kc[128 * 65 + lane]);
    const float sink = sinks[hq];
    const float m = fmaxf(wave_max(fmaxf(s1, s2)), fmaxf(s3, sink));
    const float p1 = __expf(s1 - m), p2 = __expf(s2 - m), p3 = __expf(s3 - m);
    const float denom = wave_sum(p1 + p2) + p3 + __expf(sink - m);
    pw[wid * 132 + lane] = p1; pw[wid * 132 + 64 + lane] = p2; if (lane == 0) pw[wid * 132 + 128] = p3;
    __syncthreads();
    float o = 0.f;
#pragma unroll 3
    for (int j = 0; j < 129; ++j) o += pw[wid * 132 + j] * Vc[j * 64 + lane];
    MIX[(size_t)(LP + b) * DM + hq * 64 + lane] = (bf16_t)(pk2(o / denom, 0.f) & 0xffffu);
    __syncthreads();
}

template <int MT, class Epi>
DI void skinny_unit(LAS unsigned char* lds, const bf16_t* A, const bf16_t* Wt, int K, int cgi, int k0, int row0, const Epi& E, int tid) {
    const int lane = tid & 63, wid = tid >> 6, r = lane & 31, hh = lane >> 5;
    const int c0 = cgi * 32;
    const bf16_t* pa = A + (size_t)(row0 + r) * K + k0 + wid * 256 + 8 * hh;
    const bf16_t* pb = Wt + (size_t)(c0 + r) * K + k0 + wid * 256 + 8 * hh;
    const size_t rs = (size_t)32 * K;
    f32x16 acc[MT];
#pragma unroll
    for (int i = 0; i < MT; ++i) acc[i] = zero16();
    bf16x8 fb[3][2], fa[3][2][MT];
#define SK_LOAD(buf, c) do { _Pragma("unroll") for (int s = 0; s < 2; ++s) { fb[buf][s] = *(const bf16x8*)(pb + 32 * (c) + 16 * s); \
        _Pragma("unroll") for (int mt = 0; mt < MT; ++mt) fa[buf][s][mt] = *(const bf16x8*)(pa + mt * rs + 32 * (c) + 16 * s); } } while (0)
#define SK_MMA(buf) do { _Pragma("unroll") for (int s = 0; s < 2; ++s) _Pragma("unroll") for (int mt = 0; mt < MT; ++mt) acc[mt] = MFMA32(fa[buf][s][mt], fb[buf][s], acc[mt]); } while (0)
    SK_LOAD(0, 0); SK_LOAD(1, 1);
    SK_LOAD(2, 2); SK_MMA(0);
    SK_LOAD(0, 3); SK_MMA(1);
    SK_LOAD(1, 4); SK_MMA(2);
    SK_LOAD(2, 5); SK_MMA(0);
    SK_LOAD(0, 6); SK_MMA(1);
    SK_LOAD(1, 7); SK_MMA(2);
    SK_MMA(0); SK_MMA(1);
#undef SK_LOAD
#undef SK_MMA
    constexpr int NR = 32 * MT;
    LAS float* red = (LAS float*)lds;
#pragma unroll
    for (int mt = 0; mt < MT; ++mt)
#pragma unroll
        for (int i = 0; i < 16; ++i) red[(wid * NR + mt * 32 + crow(i, hh)) * 32 + r] = acc[mt][i];
    __syncthreads();
    if (MT == 4) {
        const int row = tid >> 2, c8 = (tid & 3) * 8;
        f32x4 sa = {0.f, 0.f, 0.f, 0.f}, sb = {0.f, 0.f, 0.f, 0.f};
#pragma unroll
        for (int w = 0; w < 8; ++w) { sa += *(const LAS f32x4*)(red + (w * NR + row) * 32 + c8); sb += *(const LAS f32x4*)(red + (w * NR + row) * 32 + c8 + 4); }
        E(row0 + row, c0 + c8, sa); E(row0 + row, c0 + c8 + 4, sb);
    } else if (tid < 8 * NR) {
        const int row = tid >> 3, c4 = (tid & 7) * 4;
        f32x4 sa = {0.f, 0.f, 0.f, 0.f};
#pragma unroll
        for (int w = 0; w < 8; ++w) sa += *(const LAS f32x4*)(red + (w * NR + row) * 32 + c4);
        E(row0 + row, c0 + c4, sa);
    }
    __syncthreads();
}
struct SkOut { const float* xs; float* X1s; bf16_t* XBs;
    DI void operator()(int row, int col, f32x4 a) const { const f32x4 v = a + *(const f32x4*)(xs + (size_t)row * DM + col); *(f32x4*)(X1s + (size_t)row * DM + col) = v;
        u32x2 o; o.x = pk2(v[0], v[1]); o.y = pk2(v[2], v[3]); *(u32x2*)(XBs + (size_t)row * DM + col) = o; } };
struct SkUp { bf16_t* Us;
    DI void operator()(int row, int col, f32x4 a) const {
#pragma unroll
        for (int e = 0; e < 4; ++e) { a[e] = fmaxf(a[e], 0.f); a[e] *= a[e]; }
        u32x2 o; o.x = pk2(a[0], a[1]); o.y = pk2(a[2], a[3]); *(u32x2*)(Us + (size_t)row * FF + col) = o; } };
struct SkSlab { float* slab;
    DI void operator()(int row, int col, f32x4 a) const { *(f32x4*)(slab + (size_t)row * DM + col) = a; } };

#define RLX_AGENT __ATOMIC_RELAXED, __HIP_MEMORY_SCOPE_AGENT
#define XB_TMO      128
#define XB_XCNT(j)  (256  + 64 * (j))
#define XB_XSUB(j)  (1280 + 64 * (j))
#define XB_XGEN(j)  (2304 + 64 * (j))
#define XB_TOP      3328
#define XB_TOPGEN   3392
#define XCD_BAR_WORDS 3456
#define XB_SPIN_CAP (1u << 18)

__device__ __forceinline__ unsigned xb_ld(unsigned* p)              { return __hip_atomic_load(p, __ATOMIC_RELAXED, __HIP_MEMORY_SCOPE_AGENT); }
__device__ __forceinline__ unsigned xb_add(unsigned* p, unsigned v) { return __hip_atomic_fetch_add(p, v, __ATOMIC_RELAXED, __HIP_MEMORY_SCOPE_AGENT); }
__device__ __forceinline__ unsigned xb_xcc_id() { return (unsigned)__builtin_amdgcn_s_getreg((3 << 11) | 20) & 0xFu; }
#define XB_SPIN(cond, bar) do { unsigned _sp = 0; while (cond) { __builtin_amdgcn_s_sleep(1); \
    if ((++_sp & 255u) == 0u) { if (xb_ld(&(bar)[XB_TMO])) break; if (_sp > XB_SPIN_CAP) { atomicAdd(&(bar)[XB_TMO], 1u); break; } } } } while (0)

struct XcdBarrier {
    unsigned* bar; unsigned x;
    volatile LAS unsigned* st;
};

__device__ __forceinline__ XcdBarrier xcd_barrier_post(unsigned* bar, volatile LAS unsigned* st) {
    XcdBarrier b; b.bar = bar; b.x = xb_xcc_id(); b.st = st;
    if (threadIdx.x == 0) (void)xb_add(&bar[XB_XCNT(b.x)], 1u);
    return b;
}
__device__ __forceinline__ void xcd_barrier_complete(unsigned* bar, unsigned x, unsigned& nloc, unsigned& nx) {
    const unsigned G = gridDim.x * gridDim.y * gridDim.z;
    unsigned sum, cnt, mine, sp = 0u;
    for (;;) {
        sum = 0u; cnt = 0u; mine = 0u;
#pragma unroll
        for (unsigned j = 0; j < 16; ++j) { const unsigned c = xb_ld(&bar[XB_XCNT(j)]); sum += c; cnt += (c > 0u) ? 1u : 0u; mine = (j == x) ? c : mine; }
        if (sum == G) break;
        __builtin_amdgcn_s_sleep(1);
        if ((++sp & 255u) == 0u) { if (xb_ld(&bar[XB_TMO])) break; if (sp > XB_SPIN_CAP) { atomicAdd(&bar[XB_TMO], 1u); break; } }
    }
    nloc = mine > 0u ? mine : 1u; nx = cnt > 0u ? cnt : 1u;
}

__device__ __forceinline__ void xcd_barrier(const XcdBarrier& b) {
    asm volatile("s_waitcnt vmcnt(0)" ::: "memory");
    __syncthreads();
    if (threadIdx.x == 0) {
        unsigned* bar = b.bar;
        __builtin_amdgcn_s_waitcnt(0);
        unsigned nloc = b.st[0], nx = b.st[1];
        if (nloc == 0u) { xcd_barrier_complete(bar, b.x, nloc, nx); b.st[0] = nloc; b.st[1] = nx; }
        const unsigned old = xb_add(&bar[XB_XSUB(b.x)], 1u);
        const unsigned gen = old / nloc;
        if (old + 1u == (gen + 1u) * nloc) {
            __builtin_amdgcn_fence(__ATOMIC_RELEASE, "agent");
            asm volatile("s_waitcnt vmcnt(0)" ::: "memory");
            const unsigned og = xb_add(&bar[XB_TOP], 1u);
            const unsigned tg = og / nx;
            if (og + 1u == (tg + 1u) * nx) xb_add(&bar[XB_TOPGEN], 1u);
            else XB_SPIN(xb_ld(&bar[XB_TOPGEN]) == tg, bar);
            __builtin_amdgcn_fence(__ATOMIC_ACQUIRE, "agent");
            xb_add(&bar[XB_XGEN(b.x)], 1u);
            asm volatile("s_waitcnt vmcnt(0)" ::: "memory");
        } else {
            XB_SPIN(xb_ld(&bar[XB_XGEN(b.x)]) == gen, bar);
            __builtin_amdgcn_fence(__ATOMIC_ACQUIRE, "agent");
            asm volatile("s_waitcnt vmcnt(0)" ::: "memory");
        }
    }
    __syncthreads();
}

struct Args { const float* in[15]; float* out; unsigned char* ws; int ph_lo, ph_hi; };
constexpr int NPH = 9;
constexpr int NP0_REST = 7424;

__global__ void __launch_bounds__(512, 2) fwd_kernel(Args a) {
    extern __shared__ __attribute__((aligned(16))) unsigned char lds_raw[];
    LAS unsigned char* lds = (LAS unsigned char*)lds_raw;
    cg::grid_group grid = cg::this_grid();
    const int tid = threadIdx.x, lane = tid & 63, wid = __builtin_amdgcn_readfirstlane(tid >> 6);
    const int G = gridDim.x, bx = blockIdx.x;
    unsigned char* ws = a.ws; float* out = a.out;
    const float* x_p = a.in[0]; const float* x_s = a.in[1]; const float* cache_k = a.in[2]; const float* cache_v = a.in[3]; const float* state0 = a.in[4];
    const float* ln1_g = a.in[5]; const float* w_in = a.in[6]; const float* gq = a.in[7]; const float* gk = a.in[8]; const float* sinks = a.in[9];
    const float* rng = a.in[10]; const float* w_out = a.in[11]; const float* ln2_g = a.in[12]; const float* w_up = a.in[13]; const float* w_dn = a.in[14];
    bf16_t* WIN = (bf16_t*)(ws + WS_WIN); bf16_t* WOUT = (bf16_t*)(ws + WS_WOUT); bf16_t* WUP = (bf16_t*)(ws + WS_WUP); bf16_t* WDN = (bf16_t*)(ws + WS_WDN);
    bf16_t* H1 = (bf16_t*)(ws + WS_H1); bf16_t* XG = H1; bf16_t* MIX = (bf16_t*)(ws + WS_MIX); bf16_t* Z = (bf16_t*)(ws + WS_Z); bf16_t* U = (bf16_t*)(ws + WS_U);
    float* PART = (float*)(ws + WS_PART); float* RSTD2 = (float*)(ws + WS_RSTD2); bf16_t* KV = (bf16_t*)(ws + WS_KV); bf16_t* SP = (bf16_t*)(ws + WS_SP); float* SLAB = (float*)(ws + WS_SP);
    const int lo = a.ph_lo, hi = a.ph_hi;
#define IN(k) (lo <= (k) && (k) < hi)
    volatile LAS unsigned* MISC = (volatile LAS unsigned*)(lds + LDS_BYTES - 64);
    if (tid < 16) MISC[tid] = 0u;
    __syncthreads();
    const XcdBarrier bar = xcd_barrier_post((unsigned*)ws + 1024, MISC + 8);
    if (lo > hi) grid.sync();
#define SEAM(k) do { if (IN(k) && IN((k) + 1)) xcd_barrier(bar); } while (0)

    if (IN(0)) for (int rep_ = 0; rep_ < 1 + ((DUPMASK >> 0) & 1); ++rep_) { if (rep_) xcd_barrier(bar);
        LAS float* scr = (LAS float*)(lds + wid * 17408);
        const int gw = bx * 8 + wid, NGW = G * 8;
        constexpr int I_IN = (DM / 64) * (INW / 32);
        p0_convert(ResIn{w_in, WIN}, gw, NGW, I_IN, scr, lane);
        p0_convert(ResRest{w_out, w_up, w_dn, WOUT, WUP, WDN, ln2_g}, gw, NGW, NP0_REST, scr, lane);
        for (int m = gw; m < MP; m += NGW) {
            if (m < MR) rms_row(m < LP ? x_p + (size_t)m * DM : x_s + (size_t)(m - LP) * DM, ln1_g, H1 + (size_t)m * DM, lane);
            else {
#pragma unroll
                for (int j = 0; j < 8; ++j) *((u32x2*)(H1 + (size_t)m * DM) + lane + 64 * j) = (u32x2){0u, 0u};
            }
        }
    }
    SEAM(0);
    if (IN(1)) for (int rep_ = 0; rep_ < 1 + ((DUPMASK >> 1) & 1); ++rep_) { if (rep_) xcd_barrier(bar);
        pg8::Gemm g{H1, WIN, MP, INW, DM}; pg8::StaticOrder S; S.init(MP, INW, G, bx, WGM_IN);
        pg8::EpiIn E{Z};
        pg8::gemm_phase<pg8::EpiIn, pg8::StaticOrder, true, true>(lds, g, S, E);
        {
            constexpr int NT = (MP / 256) * (INW / 256); const int rounds = (NT + G - 1) / G, first_idle = NT - (rounds - 1) * G;
            const int nidle = (first_idle < G) ? (G - first_idle) : G, me = (first_idle < G) ? (bx - first_idle) : bx;
            if (me >= 0) {
                LAS float* scr = (LAS float*)(lds + wid * 17408);
                constexpr int I_OUT = (DM / 64) * (DM / 32), I_UP = (DM / 64) * (FF / 32), I_DN = (FF / 64) * (DM / 32);
                p0_convert(ResRest{w_out, w_up, w_dn, WOUT, WUP, WDN, ln2_g}, NP0_REST + me * 8 + wid, nidle * 8, I_OUT + I_UP + I_DN, scr, lane);
            }
        }
    }
    SEAM(1);
    if (IN(2)) for (int rep_ = 0; rep_ < 1 + ((DUPMASK >> 2) & 1); ++rep_) { if (rep_) xcd_barrier(bar);
        if (bx & 1) for (int u = bx; u < 256; u += G) ret_decode_unit(lds, Z, state0, out + O_SS, MIX, rng, u >> 2, u & 3, tid);
        for (int u = bx; u < 256; u += G) ret_step1(lds, Z, KV, u >> 2, u & 3, tid);
        if (!(bx & 1)) for (int u = bx; u < 256; u += G) ret_decode_unit(lds, Z, state0, out + O_SS, MIX, rng, u >> 2, u & 3, tid);
    }
    SEAM(2);
    if (IN(3)) for (int rep_ = 0; rep_ < 1 + ((DUPMASK >> 3) & 1); ++rep_) { if (rep_) xcd_barrier(bar);
        if (tid < 256) ret_scan(KV, SP, out + O_SP, bx * 256 + tid, G * 256);
        if (bx & 1) for (int u = bx; u < 256; u += G) attn_decode_unit(lds, Z, cache_k, cache_v, MIX, gq, gk, sinks, out + O_KS, out + O_VS, u >> 1, u & 1, tid);
        for (int u = 256 + bx; u < 512; u += G) ret_decode_unit(lds, Z, state0, out + O_SS, MIX, rng, u >> 2, u & 3, tid);
        if (!(bx & 1)) for (int u = bx; u < 256; u += G) attn_decode_unit(lds, Z, cache_k, cache_v, MIX, gq, gk, sinks, out + O_KS, out + O_VS, u >> 1, u & 1, tid);
    }
    SEAM(3);
    if (IN(4)) for (int rep_ = 0; rep_ < 1 + ((DUPMASK >> 4) & 1); ++rep_) { if (rep_) xcd_barrier(bar);
        for (int u = bx; u < 256; u += G) ret_step2(lds, Z, SP, MIX, rng, u >> 2, u & 3, tid);
        for (int u = bx; u < 256; u += G) attn_prompt_unit(lds, Z, MIX, gq, gk, sinks, out + O_KP, out + O_VP, u >> 2, (u >> 1) & 1, u & 1, tid);
    }
    SEAM(4);
    if (IN(5)) for (int rep_ = 0; rep_ < 1 + ((DUPMASK >> 5) & 1); ++rep_) { if (rep_) xcd_barrier(bar);
        pg8::Gemm g{MIX, WOUT, LP, DM, DM}; pg8::StaticOrder S; S.init(LP, DM, G, bx, WGM_OUT);
        pg8::EpiOut E{x_p, XG, PART};
        pg8::gemm_phase<pg8::EpiOut, pg8::StaticOrder, true, true>(lds, g, S, E);
        const SkOut SE{x_s, out + O_Y + (size_t)LP * DM, XG + (size_t)LP * DM};
        for (int u = bx; u < 4 * (DM / 32); u += G) skinny_unit<1>(lds, MIX + (size_t)LP * DM, WOUT, DM, u >> 2, 0, (u & 3) * 32, SE, tid);
    }
    SEAM(5);
    if (IN(6)) for (int rep_ = 0; rep_ < 1 + ((DUPMASK >> 6) & 1); ++rep_) { if (rep_) xcd_barrier(bar);
        for (int row = bx + G * tid; row < LP; row += G * 512) { float s = 0.f;
#pragma unroll
            for (int j = 0; j < 8; ++j) { const f32x4 p = *(const f32x4*)(PART + (size_t)row * 32 + 4 * j); s += (p[0] + p[1]) + (p[2] + p[3]); }
            RSTD2[row] = 1.0f / (s * (1.0f / DM) + EPS); }
        for (int row = LP + bx * 8 + wid; row < MR; row += G * 8) {
            const float* xr = out + O_Y + (size_t)row * DM; float s = 0.f;
#pragma unroll
            for (int j = 0; j < 8; ++j) { const f32x4 v = *((const f32x4*)xr + lane + 64 * j); s += (v[0] * v[0] + v[1] * v[1]) + (v[2] * v[2] + v[3] * v[3]); }
            s = wave_sum(s); if (lane == 0) RSTD2[row] = 1.0f / (s * (1.0f / DM) + EPS); }
        pg8::Gemm g{XG, WUP, LP, FF, DM}; pg8::StaticOrder S; S.init(LP, FF, G, bx, WGM_UP);
        pg8::EpiUp E{U};
        pg8::gemm_phase<pg8::EpiUp, pg8::StaticOrder, true, true>(lds, g, S, E);
        const SkUp SE{U + (size_t)LP * FF};
        for (int u = bx; u < FF / 32; u += G) skinny_unit<4>(lds, XG + (size_t)LP * DM, WUP, DM, u, 0, 0, SE, tid);
    }
    SEAM(6);
    if (IN(7)) {
        if (bx & 1) for (int u = bx; u < 4 * (DM / 32); u += G) { const SkSlab SE{SLAB + (size_t)(u & 3) * NS * DM}; skinny_unit<4>(lds, U + (size_t)LP * FF, WDN, FF, u >> 2, (u & 3) * 2048, 0, SE, tid); }
        pg8::Gemm g{U, WDN, LP, DM, FF}; pg8::StaticOrder S; S.init(LP, DM, G, bx, WGM_DN);
        pg8::EpiDown E{out + O_Y, XG, RSTD2};
        pg8::gemm_phase<pg8::EpiDown, pg8::StaticOrder, true, true>(lds, g, S, E);
        if (!(bx & 1)) for (int u = bx; u < 4 * (DM / 32); u += G) { const SkSlab SE{SLAB + (size_t)(u & 3) * NS * DM}; skinny_unit<4>(lds, U + (size_t)LP * FF, WDN, FF, u >> 2, (u & 3) * 2048, 0, SE, tid); }
    }
    SEAM(7);
    if (IN(8)) {
        for (int e = bx * 512 + tid; e < NS * DM / 4; e += G * 512) {
            const int row = e >> 9; float* p = out + O_Y + (size_t)LP * DM + (size_t)e * 4;
            const f32x4 s = (*(const f32x4*)(SLAB + (size_t)e * 4) + *(const f32x4*)(SLAB + (size_t)NS * DM + (size_t)e * 4)) + (*(const f32x4*)(SLAB + (size_t)2 * NS * DM + (size_t)e * 4) + *(const f32x4*)(SLAB + (size_t)3 * NS * DM + (size_t)e * 4));
            *(f32x4*)p = *(const f32x4*)p + s * RSTD2[LP + row];
        }
    }
#undef IN
#undef SEAM
}

#ifndef N_LAUNCHES
#define N_LAUNCHES 1
#endif
extern "C" void kernel_launch(void* const* d_in, const int* in_sizes, int n_in, void* d_out, int out_size, void* d_ws, size_t ws_size, hipStream_t stream) {
    static int grid = 0;
    if (grid == 0) {
        if (n_in != 15 || (size_t)out_size != O_END || ws_size < WS_END) { fprintf(stderr, "kernel_launch: unexpected shapes (n_in %d out %d ws %zu)\n", n_in, out_size, ws_size); grid = -1; return; }
        int dev = 0, cus = 0, per_cu = 0;
        (void)hipGetDevice(&dev); (void)hipDeviceGetAttribute(&cus, hipDeviceAttributeMultiprocessorCount, dev);
        if (hipFuncSetAttribute((const void*)fwd_kernel, hipFuncAttributeMaxDynamicSharedMemorySize, LDS_BYTES) != hipSuccess) { fprintf(stderr, "kernel_launch: hipFuncSetAttribute failed\n"); grid = -1; return; }
        (void)hipOccupancyMaxActiveBlocksPerMultiprocessor(&per_cu, (const void*)fwd_kernel, 512, LDS_BYTES);
        (void)hipGetLastError();
        if (per_cu < 1) { fprintf(stderr, "kernel_launch: occupancy query says %d blocks per CU\n", per_cu); }
        grid = cus > 0 ? cus : 256;
    }
    if (grid < 0) return;
    if (hipMemsetAsync(d_ws, 0, 65536, stream) != hipSuccess) { fprintf(stderr, "kernel_launch: memset failed\n"); return; }
    Args a{};
    for (int i = 0; i < 15; ++i) a.in[i] = (const float*)d_in[i];
    a.out = (float*)d_out; a.ws = (unsigned char*)d_ws;
    if (N_LAUNCHES == 1) {
        a.ph_lo = 0; a.ph_hi = NPH;
        void* args[] = {&a};
        hipError_t e = hipLaunchCooperativeKernel((const void*)fwd_kernel, dim3(grid), dim3(512), args, LDS_BYTES, stream);
        if (e != hipSuccess) fprintf(stderr, "cooperative launch failed: %s (grid %d)\n", hipGetErrorString(e), grid);
    } else {
        for (int p = 0; p < NPH; ++p) { a.ph_lo = p; a.ph_hi = p + 1; hipLaunchKernelGGL(fwd_kernel, dim3(grid), dim3(512), LDS_BYTES, stream, a); }
    }
}
```

```cpp
#include <hip/hip_runtime.h>
#include <hip/hip_cooperative_groups.h>
#include <cstdio>
#include <cstdint>
namespace cg = cooperative_groups;

#ifndef WGM_IN
#define WGM_IN 2
#endif
#ifndef WGM_OUT
#define WGM_OUT 2
#endif
#ifndef WGM_UP
#define WGM_UP 2
#endif
#ifndef WGM_DN
#define WGM_DN 2
#endif
#ifndef DUPMASK
#define DUPMASK 0
#endif
#define DI __device__ __forceinline__
#define LAS __attribute__((address_space(3)))
typedef float f32x2 __attribute__((ext_vector_type(2)));
typedef float f32x16 __attribute__((ext_vector_type(16)));
typedef short s16x4 __attribute__((ext_vector_type(4)));
typedef unsigned u32x2 __attribute__((ext_vector_type(2)));
typedef __bf16 bf16x2v __attribute__((ext_vector_type(2)));

constexpr int DM = 2048, LP = 8192, NS = 128, MR = LP + NS  , MP = 8448  ;
constexpr int INW = 5376, FF = 8192;
constexpr int C_AQ = 0, C_AK = 1024, C_AV = 1152, C_RQ = 1280, C_RK = 2304, C_RV = 3328, C_RG = 4352;
constexpr float EPS = 1e-6f;

DI unsigned pk2(float lo, float hi) { f32x2 v = {lo, hi}; return __builtin_bit_cast(unsigned, __builtin_convertvector(v, bf16x2v)); }
DI float bflo(unsigned u) { return __uint_as_float(u << 16); }
DI float bfhi(unsigned u) { return __uint_as_float(u & 0xffff0000u); }
DI float bf2f(unsigned short u) { return __uint_as_float(((unsigned)u) << 16); }

namespace pg8 {
#define PG8_LAS __attribute__((address_space(3)))
typedef unsigned short bf16_t;
typedef short bf16x8 __attribute__((ext_vector_type(8)));
typedef float f32x4 __attribute__((ext_vector_type(4)));
typedef unsigned u32x4 __attribute__((ext_vector_type(4)));
constexpr int BM = 256, BK = 64, HALF = 128, HTB = HALF * BK * 2  , STAGE_BYTES = 8 * HTB, NXCD = 8, WGM = 8;

__host__ __device__ __forceinline__ int lds_byte(int r, int c) { const int st = (r >> 4) * 2 + (c >> 5), rr = r & 15, cc = c & 31, ob = rr * 64 + cc * 2; return st * 1024 + (ob ^ (((ob >> 9) & 1) << 5)); }
__host__ __device__ __forceinline__ void stage_rc(int b, int& R, int& C) { const int st = b / 1024, sb = b % 1024, swz = sb ^ (((sb >> 9) & 1) << 5); R = (st >> 1) * 16 + swz / 64; C = (st & 1) * 32 + (swz % 64) / 2; }
__host__ __device__ __forceinline__ int perm32(int rho) { const int n = rho >> 4, i = rho & 15; return 8 * (i >> 2) + 4 * n + (i & 3); }

struct Unit { int pm, pn; };
struct Gemm { const bf16_t* A; const bf16_t* Bt; int M, N, K; };

struct StaticOrder {
    int nM, nN, nwg, G, c, wgm;
    __host__ __device__ void init(int M, int N, int G_, int c_, int wgm_) { nM = M / BM; nN = N / BM; nwg = nM * nN; G = G_; c = c_; wgm = wgm_; }
    __host__ __device__ bool next(int i, Unit& u) const {
        const long L = (long)i * G + c; if (L >= nwg) return false;
        int wgid = (int)L; { const int q = nwg / NXCD, r = nwg % NXCD, xcd = wgid % NXCD, off = wgid / NXCD; wgid = (xcd < r ? xcd * (q + 1) : r * (q + 1) + (xcd - r) * q) + off; }
        const int nig = wgm * nN, gid = wgid / nig, fm = gid * wgm, gsz = (nM - fm) < wgm ? (nM - fm) : wgm;
        u.pm = fm + ((wgid % nig) % gsz); u.pn = (wgid % nig) / gsz; return true;
    }
    __device__ __forceinline__ void a_ready(const Unit&) const {}
    __device__ __forceinline__ void done(const Unit&) const {}
};


DI u32x4 pack8f(const f32x4& a, const f32x4& b) { u32x4 w; w.x = pk2(a[0], a[1]); w.y = pk2(a[2], a[3]); w.z = pk2(b[0], b[1]); w.w = pk2(b[2], b[3]); return w; }

struct EpiIn {
    static constexpr bool PERM = true, AFTER_DRAIN = false;
    bf16_t* Z;
    __device__ __forceinline__ void operator()(const f32x4 (&acc)[2][2][4][2], const Unit& u, int wr, int wc, int fr, int fq) const {
        const int row0 = u.pm * BM + wr * 64 + fr, col0 = u.pn * BM + wc * 32 + 8 * fq;
        if (u.pn < 5 || u.pn > 12) {
#pragma unroll
            for (int ai = 0; ai < 2; ++ai)
#pragma unroll
                for (int m = 0; m < 4; ++m) { bf16_t* rowp = Z + (size_t)(row0 + ai * HALF + m * 16) * INW + col0;
#pragma unroll
                    for (int bj = 0; bj < 2; ++bj) *(u32x4*)(rowp + bj * HALF) = pack8f(acc[ai][bj][m][0], acc[ai][bj][m][1]); }
        } else {
            const int head = (u.pn - 5) & 3; const bool isk = u.pn >= 9;
            const float lg = log1pf(-exp2f(-5.0f - (float)head));
            float inv[8];
#pragma unroll
            for (int j = 0; j < 8; ++j) inv[j] = powf(10000.0f, -(float)(wc * 32 + 8 * fq + j) * (1.0f / 128.0f));
#pragma unroll
            for (int ai = 0; ai < 2; ++ai)
#pragma unroll
                for (int m = 0; m < 4; ++m) {
                    const int row = row0 + ai * HALF + m * 16;
                    const int pos = row < LP ? row : LP; const float t = row < LP ? (float)(row & 127) : 0.0f;
                    const float f = isk ? 0.0625f * __expf(-lg * t) : __expf(lg * t);
                    f32x4 o1[2], o2[2];
#pragma unroll
                    for (int n = 0; n < 2; ++n)
#pragma unroll
                        for (int e = 0; e < 4; ++e) {
                            const float ang = (float)pos * inv[n * 4 + e];
                            double rev = (double)ang * 0.15915494309189535; rev -= floor(rev);
                            const float fr_ = (float)rev; const float sn = __builtin_amdgcn_sinf(fr_), cs = __builtin_amdgcn_cosf(fr_);
                            const float x1 = acc[ai][0][m][n][e], x2 = acc[ai][1][m][n][e];
                            o1[n][e] = (x1 * cs - x2 * sn) * f; o2[n][e] = (x2 * cs + x1 * sn) * f;
                        }
                    bf16_t* rowp = Z + (size_t)row * INW + col0;
                    *(u32x4*)(rowp) = pack8f(o1[0], o1[1]); *(u32x4*)(rowp + HALF) = pack8f(o2[0], o2[1]);
                }
        }
    }
};

struct EpiOut {
    static constexpr bool PERM = true, AFTER_DRAIN = false;
    const float* xp; bf16_t* X1B; float* part;
    __device__ __forceinline__ void operator()(const f32x4 (&acc)[2][2][4][2], const Unit& u, int wr, int wc, int fr, int fq) const {
#pragma unroll
        for (int ai = 0; ai < 2; ++ai)
#pragma unroll
            for (int m = 0; m < 4; ++m) {
                const int row = u.pm * BM + ai * HALF + wr * 64 + m * 16 + fr;
                const float* xrow = xp + (size_t)row * DM;
                float ss = 0.f;
#pragma unroll
                for (int bj = 0; bj < 2; ++bj) {
                    const int col = u.pn * BM + bj * HALF + wc * 32 + 8 * fq;
                    const f32x4 v0 = acc[ai][bj][m][0] + *(const f32x4*)(xrow + col), v1 = acc[ai][bj][m][1] + *(const f32x4*)(xrow + col + 4);
                    ss += (v0[0] * v0[0] + v0[1] * v0[1]) + (v0[2] * v0[2] + v0[3] * v0[3]) + (v1[0] * v1[0] + v1[1] * v1[1]) + (v1[2] * v1[2] + v1[3] * v1[3]);
                    *(u32x4*)(X1B + (size_t)row * DM + col) = pack8f(v0, v1);
                }
                ss += __shfl_xor(ss, 16); ss += __shfl_xor(ss, 32);
                if (fq == 0) part[(size_t)row * 32 + u.pn * 4 + wc] = ss;
            }
    }
};

struct EpiUp {
    static constexpr bool PERM = true, AFTER_DRAIN = false;
    bf16_t* U;
    __device__ __forceinline__ void operator()(const f32x4 (&acc)[2][2][4][2], const Unit& u, int wr, int wc, int fr, int fq) const {
        const int row0 = u.pm * BM + wr * 64 + fr, col0 = u.pn * BM + wc * 32 + 8 * fq;
#pragma unroll
        for (int ai = 0; ai < 2; ++ai)
#pragma unroll
            for (int m = 0; m < 4; ++m) { bf16_t* rowp = U + (size_t)(row0 + ai * HALF + m * 16) * FF + col0;
#pragma unroll
                for (int bj = 0; bj < 2; ++bj) { f32x4 a = acc[ai][bj][m][0], b = acc[ai][bj][m][1];
#pragma unroll
                    for (int e = 0; e < 4; ++e) { a[e] = fmaxf(a[e], 0.f); a[e] *= a[e]; b[e] = fmaxf(b[e], 0.f); b[e] *= b[e]; }
                    *(u32x4*)(rowp + bj * HALF) = pack8f(a, b); } }
    }
};

struct EpiDown {
    static constexpr bool PERM = true, AFTER_DRAIN = false;
    float* Y; const bf16_t* X1B; const float* rstd2;
    __device__ __forceinline__ void operator()(const f32x4 (&acc)[2][2][4][2], const Unit& u, int wr, int wc, int fr, int fq) const {
#pragma unroll
        for (int ai = 0; ai < 2; ++ai)
#pragma unroll
            for (int m = 0; m < 4; ++m) {
                const int row = u.pm * BM + ai * HALF + wr * 64 + m * 16 + fr; const float r2 = rstd2[row];
#pragma unroll
                for (int bj = 0; bj < 2; ++bj) { const size_t o = (size_t)row * DM + u.pn * BM + bj * HALF + wc * 32 + 8 * fq;
                    const u32x4 xb = *(const u32x4*)(X1B + o);
                    const f32x4 a = {bflo(xb.x), bfhi(xb.x), bflo(xb.y), bfhi(xb.y)}, b = {bflo(xb.z), bfhi(xb.z), bflo(xb.w), bfhi(xb.w)};
                    *(f32x4*)(Y + o) = a + acc[ai][bj][m][0] * r2; *(f32x4*)(Y + o + 4) = b + acc[ai][bj][m][1] * r2; }
            }
    }
};
template <class Epi, class Sched, bool ALIGN_EPI = false, bool SP2 = false>
__device__ __forceinline__ void gemm_phase(PG8_LAS unsigned char* lds, const Gemm g, const Sched& S, const Epi& E) {
    const int tid = threadIdx.x, wid = __builtin_amdgcn_readfirstlane(tid >> 6), lane = tid & 63, wr = wid >> 2, wc = wid & 3, fr = lane & 15, fq = lane >> 4;
    const int K = g.K, nt = K / BK;
    unsigned voffA[2], voffB[2];
#pragma unroll
    for (int i = 0; i < 2; ++i) { int R, C; stage_rc(tid * 16 + i * 8192, R, C); const int Rb = Epi::PERM ? ((R & ~31) + perm32(R & 31)) : R;
        voffA[i] = (unsigned)(R * K + C) * 2u; voffB[i] = (unsigned)(Rb * K + C) * 2u; }
    const size_t kstep = (size_t)(BK * 2);
    const size_t hstep = (size_t)HALF * K * 2;
    const size_t tstep = 2 * hstep;
    const unsigned ldsw = (unsigned)wid * 1024u;
    const int aoff = lds_byte(wr * 64 + fr, fq * 8), boff = lds_byte(wc * 32 + fr, fq * 8);
#define PG8_SA(b, h) (((b) * 2 + (h)) * HTB)
#define PG8_SB(b, h) ((4 + (b) * 2 + (h)) * HTB)
#define PG8_STAGE(bufoff, gbase, voff) do { _Pragma("unroll") for (int _i = 0; _i < 2; ++_i) \
        __builtin_amdgcn_global_load_lds((const unsigned*)((const char*)(gbase) + (voff)[_i]), (PG8_LAS unsigned*)(lds + (bufoff) + ldsw + _i * 8192), 16, 0, 0); } while (0)
#define PG8_LDA(dst, b, h) do { _Pragma("unroll") for (int m = 0; m < 4; ++m) _Pragma("unroll") for (int k = 0; k < 2; ++k) dst[m][k] = *(const PG8_LAS bf16x8*)(lds + PG8_SA(b, h) + aoff + m * 2048 + k * 1024); } while (0)
#define PG8_LDB(dst, b, h) do { _Pragma("unroll") for (int n = 0; n < 2; ++n) _Pragma("unroll") for (int k = 0; k < 2; ++k) dst[n][k] = *(const PG8_LAS bf16x8*)(lds + PG8_SB(b, h) + boff + n * 2048 + k * 1024); } while (0)
#define PG8_MMA(ai, bj, At, Bt) do { __builtin_amdgcn_s_setprio(1); _Pragma("unroll") for (int m = 0; m < 4; ++m) _Pragma("unroll") for (int n = 0; n < 2; ++n) _Pragma("unroll") for (int k = 0; k < 2; ++k) \
        acc[ai][bj][m][n] = __builtin_amdgcn_mfma_f32_16x16x32_bf16(Bt[n][k], At[m][k], acc[ai][bj][m][n], 0, 0, 0); __builtin_amdgcn_s_setprio(0); } while (0)
#define PG8_WAIT_V(n) asm volatile("s_waitcnt vmcnt(" #n ")" ::: "memory")
#define PG8_WAIT_L(n) asm volatile("s_waitcnt lgkmcnt(" #n ")" ::: "memory")
#define PG8_BAR __builtin_amdgcn_s_barrier()
#define PG8_SCHED __builtin_amdgcn_sched_barrier(0)
    Unit cur, nxt; int ui = 0;
    if (!S.next(0, cur)) return;
    f32x4 acc[2][2][4][2];
#pragma unroll
    for (int a = 0; a < 2; ++a)
#pragma unroll
        for (int b = 0; b < 2; ++b)
#pragma unroll
            for (int m = 0; m < 4; ++m)
#pragma unroll
                for (int n = 0; n < 2; ++n) acc[a][b][m][n] = (f32x4){0.f, 0.f, 0.f, 0.f};
    bf16x8 At[4][2], B0[2][2], B1[2][2];
    const char* cA = (const char*)g.A + (size_t)cur.pm * tstep; const char* cB = (const char*)g.Bt + (size_t)cur.pn * tstep;
    S.a_ready(cur);
    if constexpr (SP2) {
        PG8_STAGE(PG8_SB(0, 0), cB, voffB); PG8_STAGE(PG8_SB(0, 1), cB + hstep, voffB); PG8_STAGE(PG8_SA(0, 0), cA, voffA); PG8_STAGE(PG8_SA(0, 1), cA + hstep, voffA);
        if (wr == 1) PG8_BAR;
        PG8_WAIT_V(2); PG8_BAR;
        PG8_STAGE(PG8_SB(1, 0), cB + kstep, voffB); PG8_STAGE(PG8_SA(1, 0), cA + kstep, voffA); PG8_STAGE(PG8_SB(1, 1), cB + hstep + kstep, voffB);
        PG8_WAIT_V(6); PG8_BAR;
    } else {
        PG8_STAGE(PG8_SB(0, 0), cB, voffB); PG8_STAGE(PG8_SA(0, 0), cA, voffA); PG8_STAGE(PG8_SB(0, 1), cB + hstep, voffB); PG8_STAGE(PG8_SA(0, 1), cA + hstep, voffA);
        if (wr == 1) PG8_BAR;
        PG8_WAIT_V(4); PG8_BAR;
        PG8_STAGE(PG8_SB(1, 0), cB + kstep, voffB); PG8_STAGE(PG8_SA(1, 0), cA + kstep, voffA); PG8_STAGE(PG8_SB(1, 1), cB + hstep + kstep, voffB);
        PG8_WAIT_V(6); PG8_BAR;
    }
    for (;;) {
        const bool has_next = S.next(ui + 1, nxt);
        const char* nA = has_next ? (const char*)g.A + (size_t)nxt.pm * tstep : cA; const char* nB = has_next ? (const char*)g.Bt + (size_t)nxt.pn * tstep : cB;
        for (int t = 0; t < nt; t += 2) {
            const bool last = (t == nt - 2);
            const char* a1 = cA + (size_t)(t + 1) * kstep;
            const char* a2 = last ? nA : cA + (size_t)(t + 2) * kstep; const char* b2 = last ? nB : cB + (size_t)(t + 2) * kstep;
            const char* a3 = a2 + kstep; const char* b3 = b2 + kstep;
            if (last && has_next) S.a_ready(nxt);
            if constexpr (SP2) {
            PG8_LDB(B0, 0, 0); PG8_LDB(B1, 0, 1); PG8_SCHED; PG8_LDA(At, 0, 0); PG8_STAGE(PG8_SA(1, 1), a1 + hstep, voffA);
            PG8_WAIT_V(8); PG8_WAIT_L(0); PG8_BAR; PG8_MMA(0, 0, At, B0); PG8_MMA(0, 1, At, B1); PG8_BAR; PG8_SCHED;
            PG8_LDA(At, 0, 1); PG8_STAGE(PG8_SB(0, 0), b2, voffB); PG8_STAGE(PG8_SB(0, 1), b2 + hstep, voffB); PG8_STAGE(PG8_SA(0, 0), a2, voffA);
            PG8_WAIT_V(8); PG8_WAIT_L(0); PG8_BAR; PG8_MMA(1, 0, At, B0); PG8_MMA(1, 1, At, B1); PG8_BAR; PG8_SCHED;
            PG8_LDB(B0, 1, 0); PG8_LDB(B1, 1, 1); PG8_SCHED; PG8_LDA(At, 1, 0); PG8_STAGE(PG8_SA(0, 1), a2 + hstep, voffA);
            PG8_WAIT_V(8); PG8_WAIT_L(0); PG8_BAR; PG8_MMA(0, 0, At, B0); PG8_MMA(0, 1, At, B1); PG8_BAR; PG8_SCHED;
            PG8_LDA(At, 1, 1); PG8_STAGE(PG8_SB(1, 0), b3, voffB); PG8_STAGE(PG8_SB(1, 1), b3 + hstep, voffB); PG8_STAGE(PG8_SA(1, 0), a3, voffA);
            PG8_WAIT_V(8); PG8_WAIT_L(0); PG8_BAR; PG8_MMA(1, 0, At, B0); PG8_MMA(1, 1, At, B1); PG8_BAR; PG8_SCHED;
            } else {
            PG8_LDB(B0, 0, 0); PG8_SCHED; PG8_LDA(At, 0, 0); PG8_STAGE(PG8_SA(1, 1), a1 + hstep, voffA);
            PG8_WAIT_L(8); PG8_BAR; PG8_WAIT_L(0); PG8_MMA(0, 0, At, B0); PG8_BAR; PG8_SCHED;
            PG8_LDB(B1, 0, 1); PG8_STAGE(PG8_SB(0, 0), b2, voffB);
            PG8_BAR; PG8_WAIT_L(0); PG8_MMA(0, 1, At, B1); PG8_BAR;
            PG8_LDA(At, 0, 1); PG8_STAGE(PG8_SA(0, 0), a2, voffA);
            PG8_BAR; PG8_WAIT_L(0); PG8_MMA(1, 0, At, B0); PG8_BAR; PG8_SCHED;
            PG8_STAGE(PG8_SB(0, 1), b2 + hstep, voffB);
            PG8_WAIT_V(6); PG8_BAR; PG8_MMA(1, 1, At, B1); PG8_BAR;
            PG8_LDB(B0, 1, 0); PG8_SCHED; PG8_LDA(At, 1, 0); PG8_STAGE(PG8_SA(0, 1), a2 + hstep, voffA);
            PG8_WAIT_L(8); PG8_BAR; PG8_WAIT_L(0); PG8_MMA(0, 0, At, B0); PG8_BAR; PG8_SCHED;
            PG8_LDB(B1, 1, 1); PG8_STAGE(PG8_SB(1, 0), b3, voffB);
            PG8_BAR; PG8_WAIT_L(0); PG8_MMA(0, 1, At, B1); PG8_BAR;
            PG8_LDA(At, 1, 1); PG8_STAGE(PG8_SA(1, 0), a3, voffA);
            PG8_BAR; PG8_WAIT_L(0); PG8_MMA(1, 0, At, B0); PG8_BAR; PG8_SCHED;
            PG8_STAGE(PG8_SB(1, 1), b3 + hstep, voffB);
            PG8_WAIT_V(6); PG8_BAR; PG8_MMA(1, 1, At, B1); PG8_BAR;
            }
        }
        if constexpr (ALIGN_EPI) { if (wr == 0) PG8_BAR; }
        if constexpr (!Epi::AFTER_DRAIN) { E(acc, cur, wr, wc, fr, fq); S.done(cur); }
        if (!has_next) break;
#pragma unroll
        for (int a = 0; a < 2; ++a)
#pragma unroll
            for (int b = 0; b < 2; ++b)
#pragma unroll
                for (int m = 0; m < 4; ++m)
#pragma unroll
                    for (int n = 0; n < 2; ++n) acc[a][b][m][n] = (f32x4){0.f, 0.f, 0.f, 0.f};
        cur = nxt; cA = nA; cB = nB; ++ui;
        if constexpr (ALIGN_EPI) { if (wr == 1) PG8_BAR; }
    }
    PG8_WAIT_V(0);
    if constexpr (!ALIGN_EPI) { if (wr == 0) PG8_BAR; }
    PG8_BAR;
    if constexpr (Epi::AFTER_DRAIN) { E.fused(acc, cur, wr, wc, fr, fq, lds, wid, lane); S.done(cur); }
#undef PG8_SA
#undef PG8_SB
#undef PG8_STAGE
#undef PG8_LDA
#undef PG8_LDB
#undef PG8_MMA
#undef PG8_WAIT_V
#undef PG8_WAIT_L
#undef PG8_BAR
#undef PG8_SCHED
}
}

using pg8::bf16_t; using pg8::bf16x8; using pg8::f32x4; using pg8::u32x4;
#define MFMA32(a, b, c) __builtin_amdgcn_mfma_f32_32x32x16_bf16((a), (b), (c), 0, 0, 0)
DI int crow(int reg, int h) { return (reg & 3) + 8 * (reg >> 2) + 4 * h; }
DI float wave_sum(float v) {
#pragma unroll
    for (int o = 1; o < 64; o <<= 1) v += __shfl_xor(v, o);
    return v;
}
DI float wave_max(float v) {
#pragma unroll
    for (int o = 1; o < 64; o <<= 1) v = fmaxf(v, __shfl_xor(v, o));
    return v;
}
DI bf16x8 pack8(const f32x16& x, int s) { u32x4 p; p.x = pk2(x[8 * s], x[8 * s + 1]); p.y = pk2(x[8 * s + 2], x[8 * s + 3]); p.z = pk2(x[8 * s + 4], x[8 * s + 5]); p.w = pk2(x[8 * s + 6], x[8 * s + 7]); return __builtin_bit_cast(bf16x8, p); }
DI bf16x8 cat4(s16x4 lo, s16x4 hi) { return __builtin_shufflevector(lo, hi, 0, 1, 2, 3, 4, 5, 6, 7); }
DI f32x16 zero16() { f32x16 z;
#pragma unroll
    for (int i = 0; i < 16; ++i) z[i] = 0.f;
    return z; }
DI float gamma_of(int h) { return 1.0f - exp2f(-5.0f - (float)h); }

constexpr size_t MiB = 1u << 20;
constexpr size_t WS_WIN = 1 * MiB;
constexpr size_t WS_WOUT = 23 * MiB;
constexpr size_t WS_WUP = 31 * MiB;
constexpr size_t WS_WDN = 63 * MiB;
constexpr size_t WS_H1 = 95 * MiB;
constexpr size_t WS_MIX = 128 * MiB;
constexpr size_t WS_PART = 161 * MiB;
constexpr size_t WS_RSTD2 = 163 * MiB;
constexpr size_t WS_Z = 164 * MiB;
constexpr size_t WS_KV = 252 * MiB;
constexpr size_t WS_SP = 316 * MiB;
constexpr size_t WS_U = 164 * MiB;
constexpr size_t WS_END = 348 * MiB;
static_assert(WS_Z + (size_t)MP * INW * 2 <= WS_KV && WS_U + (size_t)MP * FF * 2 <= WS_END && WS_H1 + (size_t)MP * DM * 2 <= WS_MIX && WS_MIX + (size_t)MP * DM * 2 <= WS_PART, "ws map");
constexpr int LDS_BYTES = 147456;

constexpr size_t O_Y = 0, O_KP = (size_t)MR * DM, O_VP = O_KP + 16384, O_SP = O_VP + 16384, O_KS = O_SP + 262144, O_VS = O_KS + 2097152, O_SS = O_VS + 2097152, O_END = O_SS + 33554432;

struct TItem { const float* W; bf16_t* WT; int K, N, item; const float* rs; };
DI void p0_load(const TItem& t, f32x4 (&v)[8], int lane) {
    const int nblk = t.N / 32, kb = t.item / nblk, nb = t.item % nblk, k0 = 64 * kb, n0 = 32 * nb, c = lane & 7, rr = lane >> 3;
#pragma unroll
    for (int i = 0; i < 8; ++i) v[i] = __builtin_nontemporal_load((const f32x4*)(t.W + (size_t)(k0 + 8 * i + rr) * t.N + n0 + 4 * c));
    if (t.rs) {
#pragma unroll
        for (int i = 0; i < 8; ++i) v[i] = v[i] * t.rs[k0 + 8 * i + rr];
    }
}
DI void p0_store(const TItem& t, const f32x4 (&v)[8], LAS float* scr, int lane) {
    const int nblk = t.N / 32, kb = t.item / nblk, nb = t.item % nblk, k0 = 64 * kb, n0 = 32 * nb, c = lane & 7, rr = lane >> 3;
#pragma unroll
    for (int i = 0; i < 8; ++i) { LAS float* d = scr + (8 * i + rr) * 33 + 4 * c; d[0] = v[i][0]; d[1] = v[i][1]; d[2] = v[i][2]; d[3] = v[i][3]; }
    asm volatile("s_waitcnt lgkmcnt(0)" ::: "memory");
#pragma unroll
    for (int j = 0; j < 4; ++j) { const int n = (lane >> 3) + 8 * j; const LAS float* s = scr + (8 * c) * 33 + n;
        u32x4 o; o.x = pk2(s[0 * 33], s[1 * 33]); o.y = pk2(s[2 * 33], s[3 * 33]); o.z = pk2(s[4 * 33], s[5 * 33]); o.w = pk2(s[6 * 33], s[7 * 33]);
        *(u32x4*)(t.WT + (size_t)(n0 + n) * t.K + k0 + 8 * c) = o; }
    asm volatile("s_waitcnt lgkmcnt(0)" ::: "memory");
}
struct ResIn { const float* w; bf16_t* wt; DI TItem operator()(int it) const { return TItem{w, wt, DM, INW, it, nullptr}; } };
struct ResRest { const float* w_out; const float* w_up; const float* w_dn; bf16_t* WOUT; bf16_t* WUP; bf16_t* WDN; const float* g2;
    DI TItem operator()(int it) const { constexpr int I_OUT = (DM / 64) * (DM / 32), I_UP = (DM / 64) * (FF / 32); int r = it;
        if (r < I_OUT) return TItem{w_out, WOUT, DM, DM, r, nullptr}; r -= I_OUT;
        if (r < I_UP) return TItem{w_up, WUP, DM, FF, r, g2}; r -= I_UP;
        return TItem{w_dn, WDN, FF, DM, r, nullptr}; } };
template <class Resolve>
DI void p0_convert(const Resolve R, int first, int stride, int total, LAS float* scr, int lane) {
    for (int it = first; it < total; it += 2 * stride) {
        const bool two = it + stride < total;
        const TItem t0 = R(it), t1 = R(two ? it + stride : it);
        f32x4 v0[8], v1[8];
        p0_load(t0, v0, lane);
        if (two) p0_load(t1, v1, lane);
        p0_store(t0, v0, scr, lane);
        if (two) p0_store(t1, v1, scr + 64 * 33, lane);
    }
}
DI void rms_row(const float* xrow, const float* g, bf16_t* orow, int lane) {
    f32x4 v[8]; float s = 0.f;
#pragma unroll
    for (int j = 0; j < 8; ++j) { v[j] = *((const f32x4*)xrow + lane + 64 * j); s += (v[j][0] * v[j][0] + v[j][1] * v[j][1]) + (v[j][2] * v[j][2] + v[j][3] * v[j][3]); }
    const float rstd = rsqrtf(wave_sum(s) * (1.0f / DM) + EPS);
#pragma unroll
    for (int j = 0; j < 8; ++j) { const f32x4 gg = *((const f32x4*)g + lane + 64 * j); u32x2 o; o.x = pk2(v[j][0] * rstd * gg[0], v[j][1] * rstd * gg[1]); o.y = pk2(v[j][2] * rstd * gg[2], v[j][3] * rstd * gg[3]);
        *((u32x2*)orow + lane + 64 * j) = o; }
}

DI void stage_T128x256(LAS unsigned char* img, const bf16_t* src, int tid) {
#pragma unroll
    for (int k = 0; k < 4; ++k) {
        const int it = k * 512 + tid, dgl = it & 3, tpl = (it >> 2) & 15, rest = it >> 6, dg = dgl + 4 * (rest & 7), tp = tpl + 16 * (rest >> 3);
        const bf16_t* p = src + (size_t)(2 * tp) * INW + dg * 8;
        const u32x4 a = *(const u32x4*)p, b = *(const u32x4*)(p + INW);
#pragma unroll
        for (int e = 0; e < 8; ++e) {
            const unsigned lo = (e & 1) ? (a[e >> 1] >> 16) : (a[e >> 1] & 0xffffu), hi = (e & 1) ? (b[e >> 1] & 0xffff0000u) : (b[e >> 1] << 16);
            *(LAS unsigned*)(img + (dg * 8 + e) * 264 + tp * 4) = lo | hi;
        }
    }
}

DI void ret_step1(LAS unsigned char* lds, const bf16_t* Z, bf16_t* KV, int n, int h, int tid) {
    LAS unsigned char* Kt = lds; LAS unsigned char* Vt = lds + 256 * 264;
    const int lane = tid & 63, wid = tid >> 6, r = lane & 31, hh = lane >> 5;
    stage_T128x256(Kt, Z + (size_t)(n * 128) * INW + C_RK + h * 256, tid);
    stage_T128x256(Vt, Z + (size_t)(n * 128) * INW + C_RV + h * 256, tid);
    __syncthreads();
    f32x16 acc[8];
#pragma unroll
    for (int i = 0; i < 8; ++i) acc[i] = zero16();
    const int dk0 = wid * 32;
#pragma unroll 2
    for (int s = 0; s < 8; ++s) {
        const LAS unsigned char* pa = Kt + (dk0 + r) * 264 + (16 * s + 8 * hh) * 2;
        const bf16x8 A = cat4(*(const LAS s16x4*)pa, *(const LAS s16x4*)(pa + 8));
#pragma unroll
        for (int dt = 0; dt < 8; ++dt) {
            const LAS unsigned char* pb = Vt + (dt * 32 + r) * 264 + (16 * s + 8 * hh) * 2;
            const bf16x8 B = cat4(*(const LAS s16x4*)pb, *(const LAS s16x4*)(pb + 8));
            acc[dt] = MFMA32(A, B, acc[dt]);
        }
    }
    bf16_t* out = KV + ((size_t)(n * 4 + h) * 256) * 256 + dk0 + 4 * hh;
#pragma unroll
    for (int dt = 0; dt < 8; ++dt)
#pragma unroll
        for (int g4 = 0; g4 < 4; ++g4) { u32x2 o; o.x = pk2(acc[dt][4 * g4], acc[dt][4 * g4 + 1]); o.y = pk2(acc[dt][4 * g4 + 2], acc[dt][4 * g4 + 3]);
            *(u32x2*)(out + (size_t)(dt * 32 + r) * 256 + 8 * g4) = o; }
    __syncthreads();
}

DI void ret_scan(const bf16_t* KV, bf16_t* SP, float* o_state, int gt, int nthreads) {
    for (int e = gt; e < 65536; e += nthreads) {
        const int h = e >> 14, dv = (e >> 6) & 255, dk4 = (e & 63) * 4;
        const float lg = log1pf(-exp2f(-5.0f - (float)h)), Dc = __expf(128.0f * lg), c1 = __expf(127.0f * lg);
        const size_t base = ((size_t)(h * 256 + dv)) * 256 + dk4;
        f32x4 s = {0.f, 0.f, 0.f, 0.f};
        for (int n0 = 0; n0 < 64; n0 += 32) {
            u32x2 q[32];
#pragma unroll
            for (int u = 0; u < 32; ++u) q[u] = *(const u32x2*)(KV + (size_t)(n0 + u) * 262144 + base);
#pragma unroll
            for (int u = 0; u < 32; ++u) { u32x2 o; o.x = pk2(s[0], s[1]); o.y = pk2(s[2], s[3]); *(u32x2*)(SP + (size_t)(n0 + u) * 262144 + base) = o;
                const f32x4 kv = {bflo(q[u].x), bfhi(q[u].x), bflo(q[u].y), bfhi(q[u].y)}; s = s * Dc + kv * c1; }
        }
#pragma unroll
        for (int j = 0; j < 4; ++j) o_state[((size_t)(h * 256 + dk4 + j)) * 256 + dv] = s[j];
    }
}

DI float silu_f(float x) { return x / (1.0f + __expf(-x)); }

DI void ret_step2(LAS unsigned char* lds, const bf16_t* Z, const bf16_t* SP, bf16_t* MIX, const float* rng, int n, int h, int tid) {
    LAS unsigned char* Kr = lds; LAS unsigned char* Vt = lds + 128 * 528; LAS float* red = (LAS float*)(lds + 128 * 528 + 256 * 264);
    const int lane = tid & 63, wid = tid >> 6, r = lane & 31, hh = lane >> 5;
    const bf16_t* zc = Z + (size_t)(n * 128) * INW;
#pragma unroll
    for (int k = 0; k < 8; ++k) { const int it = k * 512 + tid, row = it >> 5, c = it & 31;
        *(LAS u32x4*)(Kr + row * 528 + c * 16) = *(const u32x4*)(zc + (size_t)row * INW + C_RK + h * 256 + c * 8); }
    stage_T128x256(Vt, zc + C_RV + h * 256, tid);
    const int it_ = wid >> 1, dh = wid & 1;
    bf16x8 qf[16];
    { const bf16_t* qp = zc + (size_t)(32 * it_ + r) * INW + C_RQ + h * 256 + 8 * hh;
#pragma unroll
      for (int s = 0; s < 16; ++s) qf[s] = *(const bf16x8*)(qp + 16 * s); }
    f32x16 acc[4];
#pragma unroll
    for (int i = 0; i < 4; ++i) acc[i] = zero16();
    const float gm = gamma_of(h);
    __syncthreads();
    for (int jt = 0; jt <= it_; ++jt) {
        f32x16 X = zero16();
#pragma unroll
        for (int s = 0; s < 16; ++s) { const bf16x8 A = *(const LAS bf16x8*)(Kr + (32 * jt + r) * 528 + (16 * s + 8 * hh) * 2); X = MFMA32(A, qf[s], X); }
        if (jt == it_) {
#pragma unroll
            for (int i = 0; i < 16; ++i) X[i] = (crow(i, hh) > r) ? 0.f : X[i];
        }
#pragma unroll
        for (int s2 = 0; s2 < 2; ++s2) { const bf16x8 xs = pack8(X, s2);
#pragma unroll
            for (int dt = 0; dt < 4; ++dt) { const LAS unsigned char* pa = Vt + (128 * dh + 32 * dt + r) * 264 + (32 * jt + 16 * s2 + 4 * hh) * 2;
                const bf16x8 A = cat4(*(const LAS s16x4*)pa, *(const LAS s16x4*)(pa + 16)); acc[dt] = MFMA32(A, xs, acc[dt]); } }
    }
    { const float ig = 1.0f / gm;
#pragma unroll
      for (int dt = 0; dt < 4; ++dt) acc[dt] = acc[dt] * ig; }
    __syncthreads();
    { const bf16_t* spg = SP + (size_t)(n * 4 + h) * 65536;
#pragma unroll 1
      for (int k0 = 0; k0 < 16; k0 += 4) {
          u32x4 spr[4];
#pragma unroll
          for (int k = 0; k < 4; ++k) { const int it = (k0 + k) * 512 + tid; spr[k] = *(const u32x4*)(spg + (size_t)(it >> 5) * 256 + (it & 31) * 8); }
#pragma unroll
          for (int k = 0; k < 4; ++k) { const int it = (k0 + k) * 512 + tid; *(LAS u32x4*)(lds + (it >> 5) * 528 + (it & 31) * 16) = spr[k]; }
      } }
    __syncthreads();
#pragma unroll
    for (int dt = 0; dt < 4; ++dt)
#pragma unroll
        for (int s = 0; s < 16; ++s) { const bf16x8 A = *(const LAS bf16x8*)(lds + (128 * dh + 32 * dt + r) * 528 + (16 * s + 8 * hh) * 2); acc[dt] = MFMA32(A, qf[s], acc[dt]); }
#pragma unroll
    for (int dt = 0; dt < 4; ++dt) acc[dt] = acc[dt] * gm;
    float ss = 0.f;
#pragma unroll
    for (int dt = 0; dt < 4; ++dt)
#pragma unroll
        for (int i = 0; i < 16; ++i) ss += acc[dt][i] * acc[dt][i];
    ss += __shfl_xor(ss, 32);
    if (hh == 0) red[wid * 32 + r] = ss;
    __syncthreads();
    const float rstd = rsqrtf((red[wid * 32 + r] + red[(wid ^ 1) * 32 + r]) * (1.0f / 256.0f) + EPS);
    const size_t token = (size_t)n * 128 + 32 * it_ + r;
#pragma unroll
    for (int dt = 0; dt < 4; ++dt)
#pragma unroll
        for (int g4 = 0; g4 < 4; ++g4) {
            const int dv = 128 * dh + 32 * dt + 8 * g4 + 4 * hh;
            const u32x2 gz = *(const u32x2*)(Z + token * INW + C_RG + h * 256 + dv);
            const f32x4 gn = *(const f32x4*)(rng + h * 256 + dv);
            const float y0 = acc[dt][4 * g4 + 0] * rstd * gn[0] * silu_f(bflo(gz.x)), y1 = acc[dt][4 * g4 + 1] * rstd * gn[1] * silu_f(bfhi(gz.x));
            const float y2 = acc[dt][4 * g4 + 2] * rstd * gn[2] * silu_f(bflo(gz.y)), y3 = acc[dt][4 * g4 + 3] * rstd * gn[3] * silu_f(bfhi(gz.y));
            u32x2 o; o.x = pk2(y0, y1); o.y = pk2(y2, y3);
            *(u32x2*)(MIX + token * DM + 1024 + h * 256 + dv) = o;
        }
    __syncthreads();
}

DI void ret_decode_unit(LAS unsigned char* lds, const bf16_t* Z, const float* S0, float* S1, bf16_t* MIX, const float* rng, int b, int h, int tid) {
    LAS float* qv = (LAS float*)lds; LAS float* red = qv + 768;
    const int lane = tid & 63, wid = tid >> 6;
    const bf16_t* zrow = Z + (size_t)(LP + b) * INW;
    if (tid < 256) { qv[tid] = bf2f(zrow[C_RQ + h * 256 + tid]); qv[256 + tid] = bf2f(zrow[C_RK + h * 256 + tid]); qv[512 + tid] = bf2f(zrow[C_RV + h * 256 + tid]); }
    __syncthreads();
    const float gm = gamma_of(h);
    const f32x4 v4 = *(const LAS f32x4*)(qv + 512 + 4 * lane);
    f32x4 acc = {0.f, 0.f, 0.f, 0.f};
    const size_t off = ((size_t)(b * 4 + h) * 256 + wid * 32) * 256 + 4 * lane;
    const float* s0 = S0 + off; float* s1 = S1 + off;
#pragma unroll 1
    for (int rr = 0; rr < 32; rr += 16) {
        f32x4 s[16];
#pragma unroll
        for (int u = 0; u < 16; ++u) s[u] = __builtin_nontemporal_load((const f32x4*)(s0 + (size_t)(rr + u) * 256));
#pragma unroll
        for (int u = 0; u < 16; ++u) { const int dk = wid * 32 + rr + u; const float kk = qv[256 + dk], qq = qv[dk];
            const f32x4 sn = s[u] * gm + v4 * kk; __builtin_nontemporal_store(sn, (f32x4*)(s1 + (size_t)(rr + u) * 256)); acc += sn * qq; }
    }
    *(LAS f32x4*)(red + wid * 256 + 4 * lane) = acc;
    __syncthreads();
    if (wid == 0) {
        f32x4 o = {0.f, 0.f, 0.f, 0.f};
#pragma unroll
        for (int w = 0; w < 8; ++w) o += *(const LAS f32x4*)(red + w * 256 + 4 * lane);
        const float ssq = wave_sum((o[0] * o[0] + o[1] * o[1]) + (o[2] * o[2] + o[3] * o[3]));
        const float rstd = rsqrtf(ssq * (1.0f / 256.0f) + EPS);
        const u32x2 gz = *(const u32x2*)(zrow + C_RG + h * 256 + 4 * lane);
        const f32x4 gn = *(const f32x4*)(rng + h * 256 + 4 * lane);
        u32x2 y; y.x = pk2(o[0] * rstd * gn[0] * silu_f(bflo(gz.x)), o[1] * rstd * gn[1] * silu_f(bfhi(gz.x)));
        y.y = pk2(o[2] * rstd * gn[2] * silu_f(bflo(gz.y)), o[3] * rstd * gn[3] * silu_f(bfhi(gz.y)));
        *(u32x2*)(MIX + (size_t)(LP + b) * DM + 1024 + h * 256 + 4 * lane) = y;
    }
    __syncthreads();
}

DI void attn_prompt_unit(LAS unsigned char* lds, const bf16_t* Z, bf16_t* MIX, const float* gq, const float* gk, const float* sinks, float* o_k, float* o_v, int nb, int kh, int hf, int tid) {
    LAS unsigned char* Kn = lds; LAS unsigned char* Vt = lds + 256 * 144;
    const int lane = tid & 63, wid = tid >> 6, r = lane & 31, hh = lane >> 5;
    {
        const int row = tid >> 1, half = tid & 1; const int tok = (nb - 1) * 128 + row;
        u32x4 v[4];
#pragma unroll
        for (int c = 0; c < 4; ++c) v[c] = (u32x4){0u, 0u, 0u, 0u};
        if (tok >= 0) {
#pragma unroll
            for (int c = 0; c < 4; ++c) v[c] = *(const u32x4*)(Z + (size_t)tok * INW + C_AK + kh * 64 + half * 32 + c * 8);
        }
        float f[32]; float ss = 0.f;
#pragma unroll
        for (int c = 0; c < 4; ++c)
#pragma unroll
            for (int e = 0; e < 4; ++e) { f[c * 8 + 2 * e] = bflo(v[c][e]); f[c * 8 + 2 * e + 1] = bfhi(v[c][e]); }
#pragma unroll
        for (int e = 0; e < 32; ++e) ss += f[e] * f[e];
        ss += __shfl_xor(ss, 1);
        const float rstd = rsqrtf(ss * (1.0f / 64.0f) + EPS);
#pragma unroll
        for (int c = 0; c < 8; ++c) { const f32x4 g = *(const f32x4*)(gk + half * 32 + c * 4);
#pragma unroll
            for (int e = 0; e < 4; ++e) f[c * 4 + e] *= rstd * g[e]; }
#pragma unroll
        for (int c = 0; c < 4; ++c) { u32x4 w; w.x = pk2(f[c * 8], f[c * 8 + 1]); w.y = pk2(f[c * 8 + 2], f[c * 8 + 3]); w.z = pk2(f[c * 8 + 4], f[c * 8 + 5]); w.w = pk2(f[c * 8 + 6], f[c * 8 + 7]);
            *(LAS u32x4*)(Kn + row * 144 + half * 64 + c * 16) = w; }
        if (nb == 63 && hf == 0 && row >= 128) { float* o = o_k + ((size_t)(row - 128) * 2 + kh) * 64 + half * 32;
#pragma unroll
            for (int c = 0; c < 8; ++c) *(f32x4*)(o + c * 4) = (f32x4){f[c * 4], f[c * 4 + 1], f[c * 4 + 2], f[c * 4 + 3]}; }
    }
#pragma unroll
    for (int k = 0; k < 2; ++k) {
        const int it = k * 512 + tid, kpl = it & 15, dgl = (it >> 4) & 3, rest = it >> 6, dg = dgl + 4 * (rest & 1), kp = kpl + 16 * (rest >> 1);
        const int tok0 = (nb - 1) * 128 + 2 * kp;
        u32x4 a = {0u, 0u, 0u, 0u}, b = {0u, 0u, 0u, 0u};
        if (tok0 >= 0) { const bf16_t* p = Z + (size_t)tok0 * INW + C_AV + kh * 64 + dg * 8; a = *(const u32x4*)p; b = *(const u32x4*)(p + INW); }
#pragma unroll
        for (int e = 0; e < 8; ++e) {
            const unsigned lo = (e & 1) ? (a[e >> 1] >> 16) : (a[e >> 1] & 0xffffu), hi = (e & 1) ? (b[e >> 1] & 0xffff0000u) : (b[e >> 1] << 16);
            *(LAS unsigned*)(Vt + (dg * 8 + e) * 520 + kp * 4) = lo | hi;
        }
        if (nb == 63 && hf == 0 && kp >= 64) { float* o = o_v + ((size_t)(2 * kp - 128) * 2 + kh) * 64 + dg * 8;
#pragma unroll
            for (int e = 0; e < 4; ++e) { o[2 * e] = bflo(a[e]); o[2 * e + 1] = bfhi(a[e]); o[128 + 2 * e] = bflo(b[e]); o[128 + 2 * e + 1] = bfhi(b[e]); } }
    }
    __syncthreads();
    const int hq = kh * 8 + 4 * hf + (wid >> 1), qh = wid & 1;
    const float sink = sinks[hq];
#pragma unroll 1
    for (int qq = 0; qq < 2; ++qq) {
        const int qi = 2 * qh + qq; const size_t tokq = (size_t)nb * 128 + 32 * qi + r;
        bf16x8 qf[4];
        {   const bf16_t* qp = Z + tokq * INW + hq * 64 + 8 * hh;
            u32x4 raw[4]; float ss = 0.f;
#pragma unroll
            for (int s = 0; s < 4; ++s) { raw[s] = *(const u32x4*)(qp + 16 * s);
#pragma unroll
                for (int e = 0; e < 4; ++e) { const float lo = bflo(raw[s][e]), hi = bfhi(raw[s][e]); ss += lo * lo + hi * hi; } }
            ss += __shfl_xor(ss, 32);
            const float rstd = rsqrtf(ss * (1.0f / 64.0f) + EPS) * 0.125f;
#pragma unroll
            for (int s = 0; s < 4; ++s) { const f32x4 g0 = *(const f32x4*)(gq + 16 * s + 8 * hh), g1 = *(const f32x4*)(gq + 16 * s + 8 * hh + 4); u32x4 w;
                w.x = pk2(bflo(raw[s].x) * rstd * g0[0], bfhi(raw[s].x) * rstd * g0[1]); w.y = pk2(bflo(raw[s].y) * rstd * g0[2], bfhi(raw[s].y) * rstd * g0[3]);
                w.z = pk2(bflo(raw[s].z) * rstd * g1[0], bfhi(raw[s].z) * rstd * g1[1]); w.w = pk2(bflo(raw[s].w) * rstd * g1[2], bfhi(raw[s].w) * rstd * g1[3]);
                qf[s] = __builtin_bit_cast(bf16x8, w); }
        }
        f32x16 X[5];
#pragma unroll
        for (int t = 0; t < 5; ++t) { X[t] = zero16();
#pragma unroll
            for (int s = 0; s < 4; ++s) { const bf16x8 A = *(const LAS bf16x8*)(Kn + (32 * (qi + t) + r) * 144 + (16 * s + 8 * hh) * 2); X[t] = MFMA32(A, qf[s], X[t]); } }
        const int ii = 32 * qi + r;
        float m = -1e30f;
#pragma unroll
        for (int t = 0; t < 5; ++t)
#pragma unroll
            for (int i = 0; i < 16; ++i) { const int jj = 32 * (qi + t) + crow(i, hh); const bool ok = (jj >= ii) && (jj <= ii + 128) && (nb > 0 || jj >= 128);
                X[t][i] = ok ? X[t][i] : -1e30f; m = fmaxf(m, X[t][i]); }
        m = fmaxf(m, __shfl_xor(m, 32)); m = fmaxf(m, sink);
        float sum = 0.f;
#pragma unroll
        for (int t = 0; t < 5; ++t)
#pragma unroll
            for (int i = 0; i < 16; ++i) { const float p = __expf(X[t][i] - m); X[t][i] = p; sum += p; }
        sum += __shfl_xor(sum, 32);
        const float inv = 1.0f / (sum + __expf(sink - m));
        f32x16 o[2]; o[0] = zero16(); o[1] = zero16();
#pragma unroll
        for (int t = 0; t < 5; ++t)
#pragma unroll
            for (int s2 = 0; s2 < 2; ++s2) { const bf16x8 xs = pack8(X[t], s2);
#pragma unroll
                for (int dt = 0; dt < 2; ++dt) { const LAS unsigned char* pa = Vt + (32 * dt + r) * 520 + (32 * (qi + t) + 16 * s2 + 4 * hh) * 2;
                    const bf16x8 A = cat4(*(const LAS s16x4*)pa, *(const LAS s16x4*)(pa + 16)); o[dt] = MFMA32(A, xs, o[dt]); } }
#pragma unroll
        for (int dt = 0; dt < 2; ++dt)
#pragma unroll
            for (int g4 = 0; g4 < 4; ++g4) { u32x2 w; w.x = pk2(o[dt][4 * g4] * inv, o[dt][4 * g4 + 1] * inv); w.y = pk2(o[dt][4 * g4 + 2] * inv, o[dt][4 * g4 + 3] * inv);
                *(u32x2*)(MIX + tokq * DM + hq * 64 + 32 * dt + 8 * g4 + 4 * hh) = w; }
    }
    __syncthreads();
}

DI void attn_decode_unit(LAS unsigned char* lds, const bf16_t* Z, const float* ck, const float* cv, bf16_t* MIX, const float* gq, const float* gk, const float* sinks, float* o_k, float* o_v, int b, int kh, int tid) {
    LAS float* Kc = (LAS float*)lds; LAS float* Vc = Kc + 129 * 65; LAS float* qs = Vc + 129 * 64; LAS float* pw = qs + 512;
    const int lane = tid & 63, wid = tid >> 6;
#pragma unroll
    for (int k = 0; k < 4; ++k) {
        const int it = k * 512 + tid, w = it >> 4, c4 = (it & 15) * 4;
        const size_t src = ((size_t)(b * 128 + w) * 2 + kh) * 64 + c4;
        const f32x4 k4 = *(const f32x4*)(ck + src), v4 = *(const f32x4*)(cv + src);
#pragma unroll
        for (int e = 0; e < 4; ++e) { Kc[w * 65 + c4 + e] = k4[e]; Vc[w * 64 + c4 + e] = v4[e]; }
        if (w >= 1) { const size_t dst = ((size_t)(b * 128 + w - 1) * 2 + kh) * 64 + c4; *(f32x4*)(o_k + dst) = k4; *(f32x4*)(o_v + dst) = v4; }
    }
    const bf16_t* zrow = Z + (size_t)(LP + b) * INW;
    const size_t dnew = ((size_t)(b * 128 + 127) * 2 + kh) * 64 + lane;
    if (wid == 0) { const float kx = bf2f(zrow[C_AK + kh * 64 + lane]); const float ss = wave_sum(kx * kx); const float kn = kx * rsqrtf(ss * (1.0f / 64.0f) + EPS) * gk[lane];
        Kc[128 * 65 + lane] = kn; o_k[dnew] = kn; }
    if (wid == 1) { const float vx = bf2f(zrow[C_AV + kh * 64 + lane]); Vc[128 * 64 + lane] = vx; o_v[dnew] = vx; }
    const int hq = kh * 8 + wid;
    { const float qx = bf2f(zrow[hq * 64 + lane]); const float ss = wave_sum(qx * qx); qs[wid * 64 + lane] = qx * rsqrtf(ss * (1.0f / 64.0f) + EPS) * gq[lane] * 0.125f; }
    __syncthreads();
    float s1 = 0.f, s2 = 0.f;
#pragma unroll 8
    for (int d = 0; d < 64; ++d) { const float q = qs[wid * 64 + d]; s1 += q * Kc[lane * 65 + d]; s2 += q * Kc[(lane + 64) * 65 + d]; }
    const float s3 = wave_sum(qs[wid * 64 + lane] * Kc[128 * 65 + lane]);
    const float sink = sinks[hq];
    const float m = fmaxf(wave_max(fmaxf(s1, s2)), fmaxf(s3, sink));
    const float p1 = __expf(s1 - m), p2 = __expf(s2 - m), p3 = __expf(s3 - m);
    const float denom = wave_sum(p1 + p2) + p3 + __expf(sink - m);
    pw[wid * 132 + lane] = p1; pw[wid * 132 + 64 + lane] = p2; if (lane == 0) pw[wid * 132 + 128] = p3;
    __syncthreads();
    float o = 0.f;
#pragma unroll 3
    for (int j = 0; j < 129; ++j) o += pw[wid * 132 + j] * Vc[j * 64 + lane];
    MIX[(size_t)(LP + b) * DM + hq * 64 + lane] = (bf16_t)(pk2(o / denom, 0.f) & 0xffffu);
    __syncthreads();
}

template <int MT, class Epi>
DI void skinny_unit(LAS unsigned char* lds, const bf16_t* A, const bf16_t* Wt, int K, int cgi, int k0, int row0, const Epi& E, int tid) {
    const int lane = tid & 63, wid = tid >> 6, r = lane & 31, hh = lane >> 5;
    const int c0 = cgi * 32;
    const bf16_t* pa = A + (size_t)(row0 + r) * K + k0 + wid * 256 + 8 * hh;
    const bf16_t* pb = Wt + (size_t)(c0 + r) * K + k0 + wid * 256 + 8 * hh;
    const size_t rs = (size_t)32 * K;
    f32x16 acc[MT];
#pragma unroll
    for (int i = 0; i < MT; ++i) acc[i] = zero16();
    bf16x8 fb[3][2], fa[3][2][MT];
#define SK_LOAD(buf, c) do { _Pragma("unroll") for (int s = 0; s < 2; ++s) { fb[buf][s] = *(const bf16x8*)(pb + 32 * (c) + 16 * s); \
        _Pragma("unroll") for (int mt = 0; mt < MT; ++mt) fa[buf][s][mt] = *(const bf16x8*)(pa + mt * rs + 32 * (c) + 16 * s); } } while (0)
#define SK_MMA(buf) do { _Pragma("unroll") for (int s = 0; s < 2; ++s) _Pragma("unroll") for (int mt = 0; mt < MT; ++mt) acc[mt] = MFMA32(fa[buf][s][mt], fb[buf][s], acc[mt]); } while (0)
    SK_LOAD(0, 0); SK_LOAD(1, 1);
    SK_LOAD(2, 2); SK_MMA(0);
    SK_LOAD(0, 3); SK_MMA(1);
    SK_LOAD(1, 4); SK_MMA(2);
    SK_LOAD(2, 5); SK_MMA(0);
    SK_LOAD(0, 6); SK_MMA(1);
    SK_LOAD(1, 7); SK_MMA(2);
    SK_MMA(0); SK_MMA(1);
#undef SK_LOAD
#undef SK_MMA
    constexpr int NR = 32 * MT;
    LAS float* red = (LAS float*)lds;
#pragma unroll
    for (int mt = 0; mt < MT; ++mt)
#pragma unroll
        for (int i = 0; i < 16; ++i) red[(wid * NR + mt * 32 + crow(i, hh)) * 32 + r] = acc[mt][i];
    __syncthreads();
    if (MT == 4) {
        const int row = tid >> 2, c8 = (tid & 3) * 8;
        f32x4 sa = {0.f, 0.f, 0.f, 0.f}, sb = {0.f, 0.f, 0.f, 0.f};
#pragma unroll
        for (int w = 0; w < 8; ++w) { sa += *(const LAS f32x4*)(red + (w * NR + row) * 32 + c8); sb += *(const LAS f32x4*)(red + (w * NR + row) * 32 + c8 + 4); }
        E(row0 + row, c0 + c8, sa); E(row0 + row, c0 + c8 + 4, sb);
    } else if (tid < 8 * NR) {
        const int row = tid >> 3, c4 = (tid & 7) * 4;
        f32x4 sa = {0.f, 0.f, 0.f, 0.f};
#pragma unroll
        for (int w = 0; w < 8; ++w) sa += *(const LAS f32x4*)(red + (w * NR + row) * 32 + c4);
        E(row0 + row, c0 + c4, sa);
    }
    __syncthreads();
}
struct SkOut { const float* xs; float* X1s; bf16_t* XBs;
    DI void operator()(int row, int col, f32x4 a) const { const f32x4 v = a + *(const f32x4*)(xs + (size_t)row * DM + col); *(f32x4*)(X1s + (size_t)row * DM + col) = v;
        u32x2 o; o.x = pk2(v[0], v[1]); o.y = pk2(v[2], v[3]); *(u32x2*)(XBs + (size_t)row * DM + col) = o; } };
struct SkUp { bf16_t* Us;
    DI void operator()(int row, int col, f32x4 a) const {
#pragma unroll
        for (int e = 0; e < 4; ++e) { a[e] = fmaxf(a[e], 0.f); a[e] *= a[e]; }
        u32x2 o; o.x = pk2(a[0], a[1]); o.y = pk2(a[2], a[3]); *(u32x2*)(Us + (size_t)row * FF + col) = o; } };
struct SkSlab { float* slab;
    DI void operator()(int row, int col, f32x4 a) const { *(f32x4*)(slab + (size_t)row * DM + col) = a; } };

#define RLX_AGENT __ATOMIC_RELAXED, __HIP_MEMORY_SCOPE_AGENT
#define XB_TMO      128
#define XB_XCNT(j)  (256  + 64 * (j))
#define XB_XSUB(j)  (1280 + 64 * (j))
#define XB_XGEN(j)  (2304 + 64 * (j))
#define XB_TOP      3328
#define XB_TOPGEN   3392
#define XCD_BAR_WORDS 3456
#define XB_SPIN_CAP (1u << 18)

__device__ __forceinline__ unsigned xb_ld(unsigned* p)              { return __hip_atomic_load(p, __ATOMIC_RELAXED, __HIP_MEMORY_SCOPE_AGENT); }
__device__ __forceinline__ unsigned xb_add(unsigned* p, unsigned v) { return __hip_atomic_fetch_add(p, v, __ATOMIC_RELAXED, __HIP_MEMORY_SCOPE_AGENT); }
__device__ __forceinline__ unsigned xb_xcc_id() { return (unsigned)__builtin_amdgcn_s_getreg((3 << 11) | 20) & 0xFu; }
#define XB_SPIN(cond, bar) do { unsigned _sp = 0; while (cond) { __builtin_amdgcn_s_sleep(1); \
    if ((++_sp & 255u) == 0u) { if (xb_ld(&(bar)[XB_TMO])) break; if (_sp > XB_SPIN_CAP) { atomicAdd(&(bar)[XB_TMO], 1u); break; } } } } while (0)

struct XcdBarrier {
    unsigned* bar; unsigned x;
    volatile LAS unsigned* st;
};

__device__ __forceinline__ XcdBarrier xcd_barrier_post(unsigned* bar, volatile LAS unsigned* st) {
    XcdBarrier b; b.bar = bar; b.x = xb_xcc_id(); b.st = st;
    if (threadIdx.x == 0) (void)xb_add(&bar[XB_XCNT(b.x)], 1u);
    return b;
}
__device__ __forceinline__ void xcd_barrier_complete(unsigned* bar, unsigned x, unsigned& nloc, unsigned& nx) {
    const unsigned G = gridDim.x * gridDim.y * gridDim.z;
    unsigned sum, cnt, mine, sp = 0u;
    for (;;) {
        sum = 0u; cnt = 0u; mine = 0u;
#pragma unroll
        for (unsigned j = 0; j < 16; ++j) { const unsigned c = xb_ld(&bar[XB_XCNT(j)]); sum += c; cnt += (c > 0u) ? 1u : 0u; mine = (j == x) ? c : mine; }
        if (sum == G) break;
        __builtin_amdgcn_s_sleep(1);
        if ((++sp & 255u) == 0u) { if (xb_ld(&bar[XB_TMO])) break; if (sp > XB_SPIN_CAP) { atomicAdd(&bar[XB_TMO], 1u); break; } }
    }
    nloc = mine > 0u ? mine : 1u; nx = cnt > 0u ? cnt : 1u;
}

__device__ __forceinline__ void xcd_barrier(const XcdBarrier& b) {
    asm volatile("s_waitcnt vmcnt(0)" ::: "memory");
    __syncthreads();
    if (threadIdx.x == 0) {
        unsigned* bar = b.bar;
        __builtin_amdgcn_s_waitcnt(0);
        unsigned nloc = b.st[0], nx = b.st[1];
        if (nloc == 0u) { xcd_barrier_complete(bar, b.x, nloc, nx); b.st[0] = nloc; b.st[1] = nx; }
        const unsigned old = xb_add(&bar[XB_XSUB(b.x)], 1u);
        const unsigned gen = old / nloc;
        if (old + 1u == (gen + 1u) * nloc) {
            __builtin_amdgcn_fence(__ATOMIC_RELEASE, "agent");
            asm volatile("s_waitcnt vmcnt(0)" ::: "memory");
            const unsigned og = xb_add(&bar[XB_TOP], 1u);
            const unsigned tg = og / nx;
            if (og + 1u == (tg + 1u) * nx) xb_add(&bar[XB_TOPGEN], 1u);
            else XB_SPIN(xb_ld(&bar[XB_TOPGEN]) == tg, bar);
            __builtin_amdgcn_fence(__ATOMIC_ACQUIRE, "agent");
            xb_add(&bar[XB_XGEN(b.x)], 1u);
            asm volatile("s_waitcnt vmcnt(0)" ::: "memory");
        } else {
            XB_SPIN(xb_ld(&bar[XB_XGEN(b.x)]) == gen, bar);
            __builtin_amdgcn_fence(__ATOMIC_ACQUIRE, "agent");
            asm volatile("s_waitcnt vmcnt(0)" ::: "memory");
        }
    }
    __syncthreads();
}

struct Args { const float* in[15]; float* out; unsigned char* ws; int ph_lo, ph_hi; };
constexpr int NPH = 9;
constexpr int NP0_REST = 7424;

__global__ void __launch_bounds__(512, 2) fwd_kernel(Args a) {
    extern __shared__ __attribute__((aligned(16))) unsigned char lds_raw[];
    LAS unsigned char* lds = (LAS unsigned char*)lds_raw;
    cg::grid_group grid = cg::this_grid();
    const int tid = threadIdx.x, lane = tid & 63, wid = __builtin_amdgcn_readfirstlane(tid >> 6);
    const int G = gridDim.x, bx = blockIdx.x;
    unsigned char* ws = a.ws; float* out = a.out;
    const float* x_p = a.in[0]; const float* x_s = a.in[1]; const float* cache_k = a.in[2]; const float* cache_v = a.in[3]; const float* state0 = a.in[4];
    const float* ln1_g = a.in[5]; const float* w_in = a.in[6]; const float* gq = a.in[7]; const float* gk = a.in[8]; const float* sinks = a.in[9];
    const float* rng = a.in[10]; const float* w_out = a.in[11]; const float* ln2_g = a.in[12]; const float* w_up = a.in[13]; const float* w_dn = a.in[14];
    bf16_t* WIN = (bf16_t*)(ws + WS_WIN); bf16_t* WOUT = (bf16_t*)(ws + WS_WOUT); bf16_t* WUP = (bf16_t*)(ws + WS_WUP); bf16_t* WDN = (bf16_t*)(ws + WS_WDN);
    bf16_t* H1 = (bf16_t*)(ws + WS_H1); bf16_t* XG = H1; bf16_t* MIX = (bf16_t*)(ws + WS_MIX); bf16_t* Z = (bf16_t*)(ws + WS_Z); bf16_t* U = (bf16_t*)(ws + WS_U);
    float* PART = (float*)(ws + WS_PART); float* RSTD2 = (float*)(ws + WS_RSTD2); bf16_t* KV = (bf16_t*)(ws + WS_KV); bf16_t* SP = (bf16_t*)(ws + WS_SP); float* SLAB = (float*)(ws + WS_SP);
    const int lo = a.ph_lo, hi = a.ph_hi;
#define IN(k) (lo <= (k) && (k) < hi)
    volatile LAS unsigned* MISC = (volatile LAS unsigned*)(lds + LDS_BYTES - 64);
    if (tid < 16) MISC[tid] = 0u;
    __syncthreads();
    const XcdBarrier bar = xcd_barrier_post((unsigned*)ws + 1024, MISC + 8);
    if (lo > hi) grid.sync();
#define SEAM(k) do { if (IN(k) && IN((k) + 1)) xcd_barrier(bar); } while (0)

    if (IN(0)) for (int rep_ = 0; rep_ < 1 + ((DUPMASK >> 0) & 1); ++rep_) { if (rep_) xcd_barrier(bar);
        LAS float* scr = (LAS float*)(lds + wid * 17408);
        const int gw = bx * 8 + wid, NGW = G * 8;
        constexpr int I_IN = (DM / 64) * (INW / 32);
        p0_convert(ResIn{w_in, WIN}, gw, NGW, I_IN, scr, lane);
        for (int m = gw; m < MP; m += NGW) {
            if (m < MR) rms_row(m < LP ? x_p + (size_t)m * DM : x_s + (size_t)(m - LP) * DM, ln1_g, H1 + (size_t)m * DM, lane);
            else {
#pragma unroll
                for (int j = 0; j < 8; ++j) *((u32x2*)(H1 + (size_t)m * DM) + lane + 64 * j) = (u32x2){0u, 0u};
            }
        }
    }
    SEAM(0);
    if (IN(1)) for (int rep_ = 0; rep_ < 1 + ((DUPMASK >> 1) & 1); ++rep_) { if (rep_) xcd_barrier(bar);
        pg8::Gemm g{H1, WIN, MP, INW, DM}; pg8::StaticOrder S; S.init(MP, INW, G, bx, WGM_IN);
        pg8::EpiIn E{Z};
        pg8::gemm_phase<pg8::EpiIn, pg8::StaticOrder, true, true>(lds, g, S, E);
        {
            constexpr int NT = (MP / 256) * (INW / 256); const int rounds = (NT + G - 1) / G, first_idle = NT - (rounds - 1) * G;
            const int nidle = (first_idle < G) ? (G - first_idle) : G, me = (first_idle < G) ? (bx - first_idle) : bx;
            if (me >= 0) {
                LAS float* scr = (LAS float*)(lds + wid * 17408);
                constexpr int I_OUT = (DM / 64) * (DM / 32), I_UP = (DM / 64) * (FF / 32), I_DN = (FF / 64) * (DM / 32);
                p0_convert(ResRest{w_out, w_up, w_dn, WOUT, WUP, WDN, ln2_g}, NP0_REST + me * 8 + wid, nidle * 8, I_OUT + I_UP + I_DN, scr, lane);
            }
        }
    }
    SEAM(1);
    if (IN(2)) for (int rep_ = 0; rep_ < 1 + ((DUPMASK >> 2) & 1); ++rep_) { if (rep_) xcd_barrier(bar);
        if (bx & 1) for (int u = bx; u < 256; u += G) ret_decode_unit(lds, Z, state0, out + O_SS, MIX, rng, u >> 2, u & 3, tid);
        for (int u = bx; u < 256; u += G) ret_step1(lds, Z, KV, u >> 2, u & 3, tid);
        if (!(bx & 1)) for (int u = bx; u < 256; u += G) ret_decode_unit(lds, Z, state0, out + O_SS, MIX, rng, u >> 2, u & 3, tid);
    }
    SEAM(2);
    if (IN(3)) for (int rep_ = 0; rep_ < 1 + ((DUPMASK >> 3) & 1); ++rep_) { if (rep_) xcd_barrier(bar);
        if (tid < 256) ret_scan(KV, SP, out + O_SP, bx * 256 + tid, G * 256);
        if (bx & 1) for (int u = bx; u < 256; u += G) attn_decode_unit(lds, Z, cache_k, cache_v, MIX, gq, gk, sinks, out + O_KS, out + O_VS, u >> 1, u & 1, tid);
        for (int u = 256 + bx; u < 512; u += G) ret_decode_unit(lds, Z, state0, out + O_SS, MIX, rng, u >> 2, u & 3, tid);
        if (!(bx & 1)) for (int u = bx; u < 256; u += G) attn_decode_unit(lds, Z, cache_k, cache_v, MIX, gq, gk, sinks, out + O_KS, out + O_VS, u >> 1, u & 1, tid);
    }
    SEAM(3);
    if (IN(4)) for (int rep_ = 0; rep_ < 1 + ((DUPMASK >> 4) & 1); ++rep_) { if (rep_) xcd_barrier(bar);
        for (int u = bx; u < 256; u += G) ret_step2(lds, Z, SP, MIX, rng, u >> 2, u & 3, tid);
        for (int u = bx; u < 256; u += G) attn_prompt_unit(lds, Z, MIX, gq, gk, sinks, out + O_KP, out + O_VP, u >> 2, (u >> 1) & 1, u & 1, tid);
        {
            LAS float* scr = (LAS float*)(lds + wid * 17408);
            p0_convert(ResRest{w_out, w_up, w_dn, WOUT, WUP, WDN, ln2_g}, bx * 8 + wid, G * 8, NP0_REST, scr, lane);
        }
    }
    SEAM(4);
    if (IN(5)) for (int rep_ = 0; rep_ < 1 + ((DUPMASK >> 5) & 1); ++rep_) { if (rep_) xcd_barrier(bar);
        pg8::Gemm g{MIX, WOUT, LP, DM, DM}; pg8::StaticOrder S; S.init(LP, DM, G, bx, WGM_OUT);
        pg8::EpiOut E{x_p, XG, PART};
        pg8::gemm_phase<pg8::EpiOut, pg8::StaticOrder, true, true>(lds, g, S, E);
        const SkOut SE{x_s, out + O_Y + (size_t)LP * DM, XG + (size_t)LP * DM};
        for (int u = bx; u < 4 * (DM / 32); u += G) skinny_unit<1>(lds, MIX + (size_t)LP * DM, WOUT, DM, u >> 2, 0, (u & 3) * 32, SE, tid);
    }
    SEAM(5);
    if (IN(6)) for (int rep_ = 0; rep_ < 1 + ((DUPMASK >> 6) & 1); ++rep_) { if (rep_) xcd_barrier(bar);
        for (int row = bx + G * tid; row < LP; row += G * 512) { float s = 0.f;
#pragma unroll
            for (int j = 0; j < 8; ++j) { const f32x4 p = *(const f32x4*)(PART + (size_t)row * 32 + 4 * j); s += (p[0] + p[1]) + (p[2] + p[3]); }
            RSTD2[row] = 1.0f / (s * (1.0f / DM) + EPS); }
        for (int row = LP + bx * 8 + wid; row < MR; row += G * 8) {
            const float* xr = out + O_Y + (size_t)row * DM; float s = 0.f;
#pragma unroll
            for (int j = 0; j < 8; ++j) { const f32x4 v = *((const f32x4*)xr + lane + 64 * j); s += (v[0] * v[0] + v[1] * v[1]) + (v[2] * v[2] + v[3] * v[3]); }
            s = wave_sum(s); if (lane == 0) RSTD2[row] = 1.0f / (s * (1.0f / DM) + EPS); }
        pg8::Gemm g{XG, WUP, LP, FF, DM}; pg8::StaticOrder S; S.init(LP, FF, G, bx, WGM_UP);
        pg8::EpiUp E{U};
        pg8::gemm_phase<pg8::EpiUp, pg8::StaticOrder, true, true>(lds, g, S, E);
        const SkUp SE{U + (size_t)LP * FF};
        for (int u = bx; u < FF / 32; u += G) skinny_unit<4>(lds, XG + (size_t)LP * DM, WUP, DM, u, 0, 0, SE, tid);
    }
    SEAM(6);
    if (IN(7)) {
        if (bx & 1) for (int u = bx; u < 4 * (DM / 32); u += G) { const SkSlab SE{SLAB + (size_t)(u & 3) * NS * DM}; skinny_unit<4>(lds, U + (size_t)LP * FF, WDN, FF, u >> 2, (u & 3) * 2048, 0, SE, tid); }
        pg8::Gemm g{U, WDN, LP, DM, FF}; pg8::StaticOrder S; S.init(LP, DM, G, bx, WGM_DN);
        pg8::EpiDown E{out + O_Y, XG, RSTD2};
        pg8::gemm_phase<pg8::EpiDown, pg8::StaticOrder, true, true>(lds, g, S, E);
        if (!(bx & 1)) for (int u = bx; u < 4 * (DM / 32); u += G) { const SkSlab SE{SLAB + (size_t)(u & 3) * NS * DM}; skinny_unit<4>(lds, U + (size_t)LP * FF, WDN, FF, u >> 2, (u & 3) * 2048, 0, SE, tid); }
    }
    SEAM(7);
    if (IN(8)) {
        for (int e = bx * 512 + tid; e < NS * DM / 4; e += G * 512) {
            const int row = e >> 9; float* p = out + O_Y + (size_t)LP * DM + (size_t)e * 4;
            const f32x4 s = (*(const f32x4*)(SLAB + (size_t)e * 4) + *(const f32x4*)(SLAB + (size_t)NS * DM + (size_t)e * 4)) + (*(const f32x4*)(SLAB + (size_t)2 * NS * DM + (size_t)e * 4) + *(const f32x4*)(SLAB + (size_t)3 * NS * DM + (size_t)e * 4));
            *(f32x4*)p = *(const f32x4*)p + s * RSTD2[LP + row];
        }
    }
#undef IN
#undef SEAM
}

#ifndef N_LAUNCHES
#define N_LAUNCHES 1
#endif
extern "C" void kernel_launch(void* const* d_in, const int* in_sizes, int n_in, void* d_out, int out_size, void* d_ws, size_t ws_size, hipStream_t stream) {
    static int grid = 0;
    if (grid == 0) {
        if (n_in != 15 || (size_t)out_size != O_END || ws_size < WS_END) { fprintf(stderr, "kernel_launch: unexpected shapes (n_in %d out %d ws %zu)\n", n_in, out_size, ws_size); grid = -1; return; }
        int dev = 0, cus = 0, per_cu = 0;
        (void)hipGetDevice(&dev); (void)hipDeviceGetAttribute(&cus, hipDeviceAttributeMultiprocessorCount, dev);
        if (hipFuncSetAttribute((const void*)fwd_kernel, hipFuncAttributeMaxDynamicSharedMemorySize, LDS_BYTES) != hipSuccess) { fprintf(stderr, "kernel_launch: hipFuncSetAttribute failed\n"); grid = -1; return; }
        (void)hipOccupancyMaxActiveBlocksPerMultiprocessor(&per_cu, (const void*)fwd_kernel, 512, LDS_BYTES);
        (void)hipGetLastError();
        if (per_cu < 1) { fprintf(stderr, "kernel_launch: occupancy query says %d blocks per CU\n", per_cu); }
        grid = cus > 0 ? cus : 256;
    }
    if (grid < 0) return;
    if (hipMemsetAsync(d_ws, 0, 65536, stream) != hipSuccess) { fprintf(stderr, "kernel_launch: memset failed\n"); return; }
    Args a{};
    for (int i = 0; i < 15; ++i) a.in[i] = (const float*)d_in[i];
    a.out = (float*)d_out; a.ws = (unsigned char*)d_ws;
    if (N_LAUNCHES == 1) {
        a.ph_lo = 0; a.ph_hi = NPH;
        void* args[] = {&a};
        hipError_t e = hipLaunchCooperativeKernel((const void*)fwd_kernel, dim3(grid), dim3(512), args, LDS_BYTES, stream);
        if (e != hipSuccess) fprintf(stderr, "cooperative launch failed: %s (grid %d)\n", hipGetErrorString(e), grid);
    } else {
        for (int p = 0; p < NPH; ++p) { a.ph_lo = p; a.ph_hi = p + 1; hipLaunchKernelGGL(fwd_kernel, dim3(grid), dim3(512), LDS_BYTES, stream, a); }
    }
}
```

```cpp
#include <hip/hip_runtime.h>
#include <hip/hip_cooperative_groups.h>
#include <cstdio>
#include <cstdint>
namespace cg = cooperative_groups;

#ifndef WGM_IN
#define WGM_IN 2
#endif
#ifndef WGM_OUT
#define WGM_OUT 2
#endif
#ifndef WGM_UP
#define WGM_UP 2
#endif
#ifndef WGM_DN
#define WGM_DN 2
#endif
#ifndef DUPMASK
#define DUPMASK 0
#endif
#define DI __device__ __forceinline__
#define LAS __attribute__((address_space(3)))
typedef float f32x2 __attribute__((ext_vector_type(2)));
typedef float f32x16 __attribute__((ext_vector_type(16)));
typedef short s16x4 __attribute__((ext_vector_type(4)));
typedef unsigned u32x2 __attribute__((ext_vector_type(2)));
typedef __bf16 bf16x2v __attribute__((ext_vector_type(2)));

constexpr int DM = 2048, LP = 8192, NS = 128, MR = LP + NS  , MP = 8448  ;
constexpr int INW = 5376, FF = 8192;
constexpr int C_AQ = 0, C_AK = 1024, C_AV = 1152, C_RQ = 1280, C_RK = 2304, C_RV = 3328, C_RG = 4352;
constexpr float EPS = 1e-6f;

DI unsigned pk2(float lo, float hi) { f32x2 v = {lo, hi}; return __builtin_bit_cast(unsigned, __builtin_convertvector(v, bf16x2v)); }
DI float bflo(unsigned u) { return __uint_as_float(u << 16); }
DI float bfhi(unsigned u) { return __uint_as_float(u & 0xffff0000u); }
DI float bf2f(unsigned short u) { return __uint_as_float(((unsigned)u) << 16); }

namespace pg8 {
#define PG8_LAS __attribute__((address_space(3)))
typedef unsigned short bf16_t;
typedef short bf16x8 __attribute__((ext_vector_type(8)));
typedef float f32x4 __attribute__((ext_vector_type(4)));
typedef unsigned u32x4 __attribute__((ext_vector_type(4)));
constexpr int BM = 256, BK = 64, HALF = 128, HTB = HALF * BK * 2  , STAGE_BYTES = 8 * HTB, NXCD = 8, WGM = 8;

__host__ __device__ __forceinline__ int lds_byte(int r, int c) { const int st = (r >> 4) * 2 + (c >> 5), rr = r & 15, cc = c & 31, ob = rr * 64 + cc * 2; return st * 1024 + (ob ^ (((ob >> 9) & 1) << 5)); }
__host__ __device__ __forceinline__ void stage_rc(int b, int& R, int& C) { const int st = b / 1024, sb = b % 1024, swz = sb ^ (((sb >> 9) & 1) << 5); R = (st >> 1) * 16 + swz / 64; C = (st & 1) * 32 + (swz % 64) / 2; }
__host__ __device__ __forceinline__ int perm32(int rho) { const int n = rho >> 4, i = rho & 15; return 8 * (i >> 2) + 4 * n + (i & 3); }

struct Unit { int pm, pn; };
struct Gemm { const bf16_t* A; const bf16_t* Bt; int M, N, K; };

struct StaticOrder {
    int nM, nN, nwg, G, c, wgm;
    __host__ __device__ void init(int M, int N, int G_, int c_, int wgm_) { nM = M / BM; nN = N / BM; nwg = nM * nN; G = G_; c = c_; wgm = wgm_; }
    __host__ __device__ bool next(int i, Unit& u) const {
        const long L = (long)i * G + c; if (L >= nwg) return false;
        int wgid = (int)L; { const int q = nwg / NXCD, r = nwg % NXCD, xcd = wgid % NXCD, off = wgid / NXCD; wgid = (xcd < r ? xcd * (q + 1) : r * (q + 1) + (xcd - r) * q) + off; }
        const int nig = wgm * nN, gid = wgid / nig, fm = gid * wgm, gsz = (nM - fm) < wgm ? (nM - fm) : wgm;
        u.pm = fm + ((wgid % nig) % gsz); u.pn = (wgid % nig) / gsz; return true;
    }
    __device__ __forceinline__ void a_ready(const Unit&) const {}
    __device__ __forceinline__ void done(const Unit&) const {}
};


DI u32x4 pack8f(const f32x4& a, const f32x4& b) { u32x4 w; w.x = pk2(a[0], a[1]); w.y = pk2(a[2], a[3]); w.z = pk2(b[0], b[1]); w.w = pk2(b[2], b[3]); return w; }

struct EpiIn {
    static constexpr bool PERM = true, AFTER_DRAIN = false;
    bf16_t* Z;
    __device__ __forceinline__ void operator()(const f32x4 (&acc)[2][2][4][2], const Unit& u, int wr, int wc, int fr, int fq) const {
        const int row0 = u.pm * BM + wr * 64 + fr, col0 = u.pn * BM + wc * 32 + 8 * fq;
        if (u.pn < 5 || u.pn > 12) {
#pragma unroll
            for (int ai = 0; ai < 2; ++ai)
#pragma unroll
                for (int m = 0; m < 4; ++m) { bf16_t* rowp = Z + (size_t)(row0 + ai * HALF + m * 16) * INW + col0;
#pragma unroll
                    for (int bj = 0; bj < 2; ++bj) *(u32x4*)(rowp + bj * HALF) = pack8f(acc[ai][bj][m][0], acc[ai][bj][m][1]); }
        } else {
            const int head = (u.pn - 5) & 3; const bool isk = u.pn >= 9;
            const float lg = log1pf(-exp2f(-5.0f - (float)head));
            float inv[8];
#pragma unroll
            for (int j = 0; j < 8; ++j) inv[j] = powf(10000.0f, -(float)(wc * 32 + 8 * fq + j) * (1.0f / 128.0f));
#pragma unroll
            for (int ai = 0; ai < 2; ++ai)
#pragma unroll
                for (int m = 0; m < 4; ++m) {
                    const int row = row0 + ai * HALF + m * 16;
                    const int pos = row < LP ? row : LP; const float t = row < LP ? (float)(row & 127) : 0.0f;
                    const float f = isk ? 0.0625f * __expf(-lg * t) : __expf(lg * t);
                    f32x4 o1[2], o2[2];
#pragma unroll
                    for (int n = 0; n < 2; ++n)
#pragma unroll
                        for (int e = 0; e < 4; ++e) {
                            const float ang = (float)pos * inv[n * 4 + e];
                            double rev = (double)ang * 0.15915494309189535; rev -= floor(rev);
                            const float fr_ = (float)rev; const float sn = __builtin_amdgcn_sinf(fr_), cs = __builtin_amdgcn_cosf(fr_);
                            const float x1 = acc[ai][0][m][n][e], x2 = acc[ai][1][m][n][e];
                            o1[n][e] = (x1 * cs - x2 * sn) * f; o2[n][e] = (x2 * cs + x1 * sn) * f;
                        }
                    bf16_t* rowp = Z + (size_t)row * INW + col0;
                    *(u32x4*)(rowp) = pack8f(o1[0], o1[1]); *(u32x4*)(rowp + HALF) = pack8f(o2[0], o2[1]);
                }
        }
    }
};

struct EpiOut {
    static constexpr bool PERM = true, AFTER_DRAIN = false;
    const float* xp; bf16_t* X1B; float* part;
    __device__ __forceinline__ void operator()(const f32x4 (&acc)[2][2][4][2], const Unit& u, int wr, int wc, int fr, int fq) const {
#pragma unroll
        for (int ai = 0; ai < 2; ++ai)
#pragma unroll
            for (int m = 0; m < 4; ++m) {
                const int row = u.pm * BM + ai * HALF + wr * 64 + m * 16 + fr;
                const float* xrow = xp + (size_t)row * DM;
                float ss = 0.f;
#pragma unroll
                for (int bj = 0; bj < 2; ++bj) {
                    const int col = u.pn * BM + bj * HALF + wc * 32 + 8 * fq;
                    const f32x4 v0 = acc[ai][bj][m][0] + *(const f32x4*)(xrow + col), v1 = acc[ai][bj][m][1] + *(const f32x4*)(xrow + col + 4);
                    ss += (v0[0] * v0[0] + v0[1] * v0[1]) + (v0[2] * v0[2] + v0[3] * v0[3]) + (v1[0] * v1[0] + v1[1] * v1[1]) + (v1[2] * v1[2] + v1[3] * v1[3]);
                    *(u32x4*)(X1B + (size_t)row * DM + col) = pack8f(v0, v1);
                }
                ss += __shfl_xor(ss, 16); ss += __shfl_xor(ss, 32);
                if (fq == 0) part[(size_t)row * 32 + u.pn * 4 + wc] = ss;
            }
    }
};

struct EpiUp {
    static constexpr bool PERM = true, AFTER_DRAIN = false;
    bf16_t* U;
    __device__ __forceinline__ void operator()(const f32x4 (&acc)[2][2][4][2], const Unit& u, int wr, int wc, int fr, int fq) const {
        const int row0 = u.pm * BM + wr * 64 + fr, col0 = u.pn * BM + wc * 32 + 8 * fq;
#pragma unroll
        for (int ai = 0; ai < 2; ++ai)
#pragma unroll
            for (int m = 0; m < 4; ++m) { bf16_t* rowp = U + (size_t)(row0 + ai * HALF + m * 16) * FF + col0;
#pragma unroll
                for (int bj = 0; bj < 2; ++bj) { f32x4 a = acc[ai][bj][m][0], b = acc[ai][bj][m][1];
#pragma unroll
                    for (int e = 0; e < 4; ++e) { a[e] = fmaxf(a[e], 0.f); a[e] *= a[e]; b[e] = fmaxf(b[e], 0.f); b[e] *= b[e]; }
                    *(u32x4*)(rowp + bj * HALF) = pack8f(a, b); } }
    }
};

struct EpiDown {
    static constexpr bool PERM = true, AFTER_DRAIN = false;
    float* Y; const bf16_t* X1B; const float* rstd2;
    __device__ __forceinline__ void operator()(const f32x4 (&acc)[2][2][4][2], const Unit& u, int wr, int wc, int fr, int fq) const {
#pragma unroll
        for (int ai = 0; ai < 2; ++ai)
#pragma unroll
            for (int m = 0; m < 4; ++m) {
                const int row = u.pm * BM + ai * HALF + wr * 64 + m * 16 + fr; const float r2 = rstd2[row];
#pragma unroll
                for (int bj = 0; bj < 2; ++bj) { const size_t o = (size_t)row * DM + u.pn * BM + bj * HALF + wc * 32 + 8 * fq;
                    const u32x4 xb = *(const u32x4*)(X1B + o);
                    const f32x4 a = {bflo(xb.x), bfhi(xb.x), bflo(xb.y), bfhi(xb.y)}, b = {bflo(xb.z), bfhi(xb.z), bflo(xb.w), bfhi(xb.w)};
                    *(f32x4*)(Y + o) = a + acc[ai][bj][m][0] * r2; *(f32x4*)(Y + o + 4) = b + acc[ai][bj][m][1] * r2; }
            }
    }
};
template <class Epi, class Sched, bool ALIGN_EPI = false, bool SP2 = false>
__device__ __forceinline__ void gemm_phase(PG8_LAS unsigned char* lds, const Gemm g, const Sched& S, const Epi& E) {
    const int tid = threadIdx.x, wid = __builtin_amdgcn_readfirstlane(tid >> 6), lane = tid & 63, wr = wid >> 2, wc = wid & 3, fr = lane & 15, fq = lane >> 4;
    const int K = g.K, nt = K / BK;
    unsigned voffA[2], voffB[2];
#pragma unroll
    for (int i = 0; i < 2; ++i) { int R, C; stage_rc(tid * 16 + i * 8192, R, C); const int Rb = Epi::PERM ? ((R & ~31) + perm32(R & 31)) : R;
        voffA[i] = (unsigned)(R * K + C) * 2u; voffB[i] = (unsigned)(Rb * K + C) * 2u; }
    const size_t kstep = (size_t)(BK * 2);
    const size_t hstep = (size_t)HALF * K * 2;
    const size_t tstep = 2 * hstep;
    const unsigned ldsw = (unsigned)wid * 1024u;
    const int aoff = lds_byte(wr * 64 + fr, fq * 8), boff = lds_byte(wc * 32 + fr, fq * 8);
#define PG8_SA(b, h) (((b) * 2 + (h)) * HTB)
#define PG8_SB(b, h) ((4 + (b) * 2 + (h)) * HTB)
#define PG8_STAGE(bufoff, gbase, voff) do { _Pragma("unroll") for (int _i = 0; _i < 2; ++_i) \
        __builtin_amdgcn_global_load_lds((const unsigned*)((const char*)(gbase) + (voff)[_i]), (PG8_LAS unsigned*)(lds + (bufoff) + ldsw + _i * 8192), 16, 0, 0); } while (0)
#define PG8_LDA(dst, b, h) do { _Pragma("unroll") for (int m = 0; m < 4; ++m) _Pragma("unroll") for (int k = 0; k < 2; ++k) dst[m][k] = *(const PG8_LAS bf16x8*)(lds + PG8_SA(b, h) + aoff + m * 2048 + k * 1024); } while (0)
#define PG8_LDB(dst, b, h) do { _Pragma("unroll") for (int n = 0; n < 2; ++n) _Pragma("unroll") for (int k = 0; k < 2; ++k) dst[n][k] = *(const PG8_LAS bf16x8*)(lds + PG8_SB(b, h) + boff + n * 2048 + k * 1024); } while (0)
#define PG8_MMA(ai, bj, At, Bt) do { __builtin_amdgcn_s_setprio(1); _Pragma("unroll") for (int m = 0; m < 4; ++m) _Pragma("unroll") for (int n = 0; n < 2; ++n) _Pragma("unroll") for (int k = 0; k < 2; ++k) \
        acc[ai][bj][m][n] = __builtin_amdgcn_mfma_f32_16x16x32_bf16(Bt[n][k], At[m][k], acc[ai][bj][m][n], 0, 0, 0); __builtin_amdgcn_s_setprio(0); } while (0)
#define PG8_WAIT_V(n) asm volatile("s_waitcnt vmcnt(" #n ")" ::: "memory")
#define PG8_WAIT_L(n) asm volatile("s_waitcnt lgkmcnt(" #n ")" ::: "memory")
#define PG8_BAR __builtin_amdgcn_s_barrier()
#define PG8_SCHED __builtin_amdgcn_sched_barrier(0)
    Unit cur, nxt; int ui = 0;
    if (!S.next(0, cur)) return;
    f32x4 acc[2][2][4][2];
#pragma unroll
    for (int a = 0; a < 2; ++a)
#pragma unroll
        for (int b = 0; b < 2; ++b)
#pragma unroll
            for (int m = 0; m < 4; ++m)
#pragma unroll
                for (int n = 0; n < 2; ++n) acc[a][b][m][n] = (f32x4){0.f, 0.f, 0.f, 0.f};
    bf16x8 At[4][2], B0[2][2], B1[2][2];
    const char* cA = (const char*)g.A + (size_t)cur.pm * tstep; const char* cB = (const char*)g.Bt + (size_t)cur.pn * tstep;
    S.a_ready(cur);
    if constexpr (SP2) {
        PG8_STAGE(PG8_SB(0, 0), cB, voffB); PG8_STAGE(PG8_SB(0, 1), cB + hstep, voffB); PG8_STAGE(PG8_SA(0, 0), cA, voffA); PG8_STAGE(PG8_SA(0, 1), cA + hstep, voffA);
        if (wr == 1) PG8_BAR;
        PG8_WAIT_V(2); PG8_BAR;
        PG8_STAGE(PG8_SB(1, 0), cB + kstep, voffB); PG8_STAGE(PG8_SA(1, 0), cA + kstep, voffA); PG8_STAGE(PG8_SB(1, 1), cB + hstep + kstep, voffB);
        PG8_WAIT_V(6); PG8_BAR;
    } else {
        PG8_STAGE(PG8_SB(0, 0), cB, voffB); PG8_STAGE(PG8_SA(0, 0), cA, voffA); PG8_STAGE(PG8_SB(0, 1), cB + hstep, voffB); PG8_STAGE(PG8_SA(0, 1), cA + hstep, voffA);
        if (wr == 1) PG8_BAR;
        PG8_WAIT_V(4); PG8_BAR;
        PG8_STAGE(PG8_SB(1, 0), cB + kstep, voffB); PG8_STAGE(PG8_SA(1, 0), cA + kstep, voffA); PG8_STAGE(PG8_SB(1, 1), cB + hstep + kstep, voffB);
        PG8_WAIT_V(6); PG8_BAR;
    }
    for (;;) {
        const bool has_next = S.next(ui + 1, nxt);
        const char* nA = has_next ? (const char*)g.A + (size_t)nxt.pm * tstep : cA; const char* nB = has_next ? (const char*)g.Bt + (size_t)nxt.pn * tstep : cB;
        for (int t = 0; t < nt; t += 2) {
            const bool last = (t == nt - 2);
            const char* a1 = cA + (size_t)(t + 1) * kstep;
            const char* a2 = last ? nA : cA + (size_t)(t + 2) * kstep; const char* b2 = last ? nB : cB + (size_t)(t + 2) * kstep;
            const char* a3 = a2 + kstep; const char* b3 = b2 + kstep;
            if (last && has_next) S.a_ready(nxt);
            if constexpr (SP2) {
            PG8_LDB(B0, 0, 0); PG8_LDB(B1, 0, 1); PG8_SCHED; PG8_LDA(At, 0, 0); PG8_STAGE(PG8_SA(1, 1), a1 + hstep, voffA);
            PG8_WAIT_V(8); PG8_WAIT_L(0); PG8_BAR; PG8_MMA(0, 0, At, B0); PG8_MMA(0, 1, At, B1); PG8_BAR; PG8_SCHED;
            PG8_LDA(At, 0, 1); PG8_STAGE(PG8_SB(0, 0), b2, voffB); PG8_STAGE(PG8_SB(0, 1), b2 + hstep, voffB); PG8_STAGE(PG8_SA(0, 0), a2, voffA);
            PG8_WAIT_V(8); PG8_WAIT_L(0); PG8_BAR; PG8_MMA(1, 0, At, B0); PG8_MMA(1, 1, At, B1); PG8_BAR; PG8_SCHED;
            PG8_LDB(B0, 1, 0); PG8_LDB(B1, 1, 1); PG8_SCHED; PG8_LDA(At, 1, 0); PG8_STAGE(PG8_SA(0, 1), a2 + hstep, voffA);
            PG8_WAIT_V(8); PG8_WAIT_L(0); PG8_BAR; PG8_MMA(0, 0, At, B0); PG8_MMA(0, 1, At, B1); PG8_BAR; PG8_SCHED;
            PG8_LDA(At, 1, 1); PG8_STAGE(PG8_SB(1, 0), b3, voffB); PG8_STAGE(PG8_SB(1, 1), b3 + hstep, voffB); PG8_STAGE(PG8_SA(1, 0), a3, voffA);
            PG8_WAIT_V(8); PG8_WAIT_L(0); PG8_BAR; PG8_MMA(1, 0, At, B0); PG8_MMA(1, 1, At, B1); PG8_BAR; PG8_SCHED;
            } else {
            PG8_LDB(B0, 0, 0); PG8_SCHED; PG8_LDA(At, 0, 0); PG8_STAGE(PG8_SA(1, 1), a1 + hstep, voffA);
            PG8_WAIT_L(8); PG8_BAR; PG8_WAIT_L(0); PG8_MMA(0, 0, At, B0); PG8_BAR; PG8_SCHED;
            PG8_LDB(B1, 0, 1); PG8_STAGE(PG8_SB(0, 0), b2, voffB);
            PG8_BAR; PG8_WAIT_L(0); PG8_MMA(0, 1, At, B1); PG8_BAR;
            PG8_LDA(At, 0, 1); PG8_STAGE(PG8_SA(0, 0), a2, voffA);
            PG8_BAR; PG8_WAIT_L(0); PG8_MMA(1, 0, At, B0); PG8_BAR; PG8_SCHED;
            PG8_STAGE(PG8_SB(0, 1), b2 + hstep, voffB);
            PG8_WAIT_V(6); PG8_BAR; PG8_MMA(1, 1, At, B1); PG8_BAR;
            PG8_LDB(B0, 1, 0); PG8_SCHED; PG8_LDA(At, 1, 0); PG8_STAGE(PG8_SA(0, 1), a2 + hstep, voffA);
            PG8_WAIT_L(8); PG8_BAR; PG8_WAIT_L(0); PG8_MMA(0, 0, At, B0); PG8_BAR; PG8_SCHED;
            PG8_LDB(B1, 1, 1); PG8_STAGE(PG8_SB(1, 0), b3, voffB);
            PG8_BAR; PG8_WAIT_L(0); PG8_MMA(0, 1, At, B1); PG8_BAR;
            PG8_LDA(At, 1, 1); PG8_STAGE(PG8_SA(1, 0), a3, voffA);
            PG8_BAR; PG8_WAIT_L(0); PG8_MMA(1, 0, At, B0); PG8_BAR; PG8_SCHED;
            PG8_STAGE(PG8_SB(1, 1), b3 + hstep, voffB);
            PG8_WAIT_V(6); PG8_BAR; PG8_MMA(1, 1, At, B1); PG8_BAR;
            }
        }
        if constexpr (ALIGN_EPI) { if (wr == 0) PG8_BAR; }
        if constexpr (!Epi::AFTER_DRAIN) { E(acc, cur, wr, wc, fr, fq); S.done(cur); }
        if (!has_next) break;
#pragma unroll
        for (int a = 0; a < 2; ++a)
#pragma unroll
            for (int b = 0; b < 2; ++b)
#pragma unroll
                for (int m = 0; m < 4; ++m)
#pragma unroll
                    for (int n = 0; n < 2; ++n) acc[a][b][m][n] = (f32x4){0.f, 0.f, 0.f, 0.f};
        cur = nxt; cA = nA; cB = nB; ++ui;
        if constexpr (ALIGN_EPI) { if (wr == 1) PG8_BAR; }
    }
    PG8_WAIT_V(0);
    if constexpr (!ALIGN_EPI) { if (wr == 0) PG8_BAR; }
    PG8_BAR;
    if constexpr (Epi::AFTER_DRAIN) { E.fused(acc, cur, wr, wc, fr, fq, lds, wid, lane); S.done(cur); }
#undef PG8_SA
#undef PG8_SB
#undef PG8_STAGE
#undef PG8_LDA
#undef PG8_LDB
#undef PG8_MMA
#undef PG8_WAIT_V
#undef PG8_WAIT_L
#undef PG8_BAR
#undef PG8_SCHED
}
}

using pg8::bf16_t; using pg8::bf16x8; using pg8::f32x4; using pg8::u32x4;
#define MFMA32(a, b, c) __builtin_amdgcn_mfma_f32_32x32x16_bf16((a), (b), (c), 0, 0, 0)
DI int crow(int reg, int h) { return (reg & 3) + 8 * (reg >> 2) + 4 * h; }
DI float wave_sum(float v) {
#pragma unroll
    for (int o = 1; o < 64; o <<= 1) v += __shfl_xor(v, o);
    return v;
}
DI float wave_max(float v) {
#pragma unroll
    for (int o = 1; o < 64; o <<= 1) v = fmaxf(v, __shfl_xor(v, o));
    return v;
}
DI bf16x8 pack8(const f32x16& x, int s) { u32x4 p; p.x = pk2(x[8 * s], x[8 * s + 1]); p.y = pk2(x[8 * s + 2], x[8 * s + 3]); p.z = pk2(x[8 * s + 4], x[8 * s + 5]); p.w = pk2(x[8 * s + 6], x[8 * s + 7]); return __builtin_bit_cast(bf16x8, p); }
DI bf16x8 cat4(s16x4 lo, s16x4 hi) { return __builtin_shufflevector(lo, hi, 0, 1, 2, 3, 4, 5, 6, 7); }
DI f32x16 zero16() { f32x16 z;
#pragma unroll
    for (int i = 0; i < 16; ++i) z[i] = 0.f;
    return z; }
DI float gamma_of(int h) { return 1.0f - exp2f(-5.0f - (float)h); }

constexpr size_t MiB = 1u << 20;
constexpr size_t WS_WIN = 1 * MiB;
constexpr size_t WS_WOUT = 23 * MiB;
constexpr size_t WS_WUP = 31 * MiB;
constexpr size_t WS_WDN = 63 * MiB;
constexpr size_t WS_H1 = 95 * MiB;
constexpr size_t WS_MIX = 128 * MiB;
constexpr size_t WS_PART = 161 * MiB;
constexpr size_t WS_RSTD2 = 163 * MiB;
constexpr size_t WS_Z = 164 * MiB;
constexpr size_t WS_KV = 252 * MiB;
constexpr size_t WS_SP = 316 * MiB;
constexpr size_t WS_U = 164 * MiB;
constexpr size_t WS_END = 348 * MiB;
static_assert(WS_Z + (size_t)MP * INW * 2 <= WS_KV && WS_U + (size_t)MP * FF * 2 <= WS_END && WS_H1 + (size_t)MP * DM * 2 <= WS_MIX && WS_MIX + (size_t)MP * DM * 2 <= WS_PART, "ws map");
constexpr int LDS_BYTES = 147456;

constexpr size_t O_Y = 0, O_KP = (size_t)MR * DM, O_VP = O_KP + 16384, O_SP = O_VP + 16384, O_KS = O_SP + 262144, O_VS = O_KS + 2097152, O_SS = O_VS + 2097152, O_END = O_SS + 33554432;

struct TItem { const float* W; bf16_t* WT; int K, N, item; const float* rs; };
DI void p0_load(const TItem& t, f32x4 (&v)[8], int lane) {
    const int nblk = t.N / 32, kb = t.item / nblk, nb = t.item % nblk, k0 = 64 * kb, n0 = 32 * nb, c = lane & 7, rr = lane >> 3;
#pragma unroll
    for (int i = 0; i < 8; ++i) v[i] = __builtin_nontemporal_load((const f32x4*)(t.W + (size_t)(k0 + 8 * i + rr) * t.N + n0 + 4 * c));
    if (t.rs) {
#pragma unroll
        for (int i = 0; i < 8; ++i) v[i] = v[i] * t.rs[k0 + 8 * i + rr];
    }
}
DI void p0_store(const TItem& t, const f32x4 (&v)[8], LAS float* scr, int lane) {
    const int nblk = t.N / 32, kb = t.item / nblk, nb = t.item % nblk, k0 = 64 * kb, n0 = 32 * nb, c = lane & 7, rr = lane >> 3;
#pragma unroll
    for (int i = 0; i < 8; ++i) { LAS float* d = scr + (8 * i + rr) * 33 + 4 * c; d[0] = v[i][0]; d[1] = v[i][1]; d[2] = v[i][2]; d[3] = v[i][3]; }
    asm volatile("s_waitcnt lgkmcnt(0)" ::: "memory");
#pragma unroll
    for (int j = 0; j < 4; ++j) { const int n = (lane >> 3) + 8 * j; const LAS float* s = scr + (8 * c) * 33 + n;
        u32x4 o; o.x = pk2(s[0 * 33], s[1 * 33]); o.y = pk2(s[2 * 33], s[3 * 33]); o.z = pk2(s[4 * 33], s[5 * 33]); o.w = pk2(s[6 * 33], s[7 * 33]);
        *(u32x4*)(t.WT + (size_t)(n0 + n) * t.K + k0 + 8 * c) = o; }
    asm volatile("s_waitcnt lgkmcnt(0)" ::: "memory");
}
struct ResIn { const float* w; bf16_t* wt; DI TItem operator()(int it) const { return TItem{w, wt, DM, INW, it, nullptr}; } };
struct ResRest { const float* w_out; const float* w_up; const float* w_dn; bf16_t* WOUT; bf16_t* WUP; bf16_t* WDN; const float* g2;
    DI TItem operator()(int it) const { constexpr int I_OUT = (DM / 64) * (DM / 32), I_UP = (DM / 64) * (FF / 32); int r = it;
        if (r < I_OUT) return TItem{w_out, WOUT, DM, DM, r, nullptr}; r -= I_OUT;
        if (r < I_UP) return TItem{w_up, WUP, DM, FF, r, g2}; r -= I_UP;
        return TItem{w_dn, WDN, FF, DM, r, nullptr}; } };
template <class Resolve>
DI void p0_convert(const Resolve R, int first, int stride, int total, LAS float* scr, int lane) {
    for (int it = first; it < total; it += 2 * stride) {
        const bool two = it + stride < total;
        const TItem t0 = R(it), t1 = R(two ? it + stride : it);
        f32x4 v0[8], v1[8];
        p0_load(t0, v0, lane);
        if (two) p0_load(t1, v1, lane);
        p0_store(t0, v0, scr, lane);
        if (two) p0_store(t1, v1, scr + 64 * 33, lane);
    }
}
DI void rms_row(const float* xrow, const float* g, bf16_t* orow, int lane) {
    f32x4 v[8]; float s = 0.f;
#pragma unroll
    for (int j = 0; j < 8; ++j) { v[j] = *((const f32x4*)xrow + lane + 64 * j); s += (v[j][0] * v[j][0] + v[j][1] * v[j][1]) + (v[j][2] * v[j][2] + v[j][3] * v[j][3]); }
    const float rstd = rsqrtf(wave_sum(s) * (1.0f / DM) + EPS);
#pragma unroll
    for (int j = 0; j < 8; ++j) { const f32x4 gg = *((const f32x4*)g + lane + 64 * j); u32x2 o; o.x = pk2(v[j][0] * rstd * gg[0], v[j][1] * rstd * gg[1]); o.y = pk2(v[j][2] * rstd * gg[2], v[j][3] * rstd * gg[3]);
        *((u32x2*)orow + lane + 64 * j) = o; }
}

DI void stage_T128x256(LAS unsigned char* img, const bf16_t* src, int tid) {
#pragma unroll
    for (int k = 0; k < 4; ++k) {
        const int it = k * 512 + tid, dgl = it & 3, tpl = (it >> 2) & 15, rest = it >> 6, dg = dgl + 4 * (rest & 7), tp = tpl + 16 * (rest >> 3);
        const bf16_t* p = src + (size_t)(2 * tp) * INW + dg * 8;
        const u32x4 a = *(const u32x4*)p, b = *(const u32x4*)(p + INW);
#pragma unroll
        for (int e = 0; e < 8; ++e) {
            const unsigned lo = (e & 1) ? (a[e >> 1] >> 16) : (a[e >> 1] & 0xffffu), hi = (e & 1) ? (b[e >> 1] & 0xffff0000u) : (b[e >> 1] << 16);
            *(LAS unsigned*)(img + (dg * 8 + e) * 264 + tp * 4) = lo | hi;
        }
    }
}

DI void ret_step1(LAS unsigned char* lds, const bf16_t* Z, bf16_t* KV, int n, int h, int tid) {
    LAS unsigned char* Kt = lds; LAS unsigned char* Vt = lds + 256 * 264;
    const int lane = tid & 63, wid = tid >> 6, r = lane & 31, hh = lane >> 5;
    stage_T128x256(Kt, Z + (size_t)(n * 128) * INW + C_RK + h * 256, tid);
    stage_T128x256(Vt, Z + (size_t)(n * 128) * INW + C_RV + h * 256, tid);
    __syncthreads();
    f32x16 acc[8];
#pragma unroll
    for (int i = 0; i < 8; ++i) acc[i] = zero16();
    const int dk0 = wid * 32;
#pragma unroll 2
    for (int s = 0; s < 8; ++s) {
        const LAS unsigned char* pa = Kt + (dk0 + r) * 264 + (16 * s + 8 * hh) * 2;
        const bf16x8 A = cat4(*(const LAS s16x4*)pa, *(const LAS s16x4*)(pa + 8));
#pragma unroll
        for (int dt = 0; dt < 8; ++dt) {
            const LAS unsigned char* pb = Vt + (dt * 32 + r) * 264 + (16 * s + 8 * hh) * 2;
            const bf16x8 B = cat4(*(const LAS s16x4*)pb, *(const LAS s16x4*)(pb + 8));
            acc[dt] = MFMA32(A, B, acc[dt]);
        }
    }
    bf16_t* out = KV + ((size_t)(n * 4 + h) * 256) * 256 + dk0 + 4 * hh;
#pragma unroll
    for (int dt = 0; dt < 8; ++dt)
#pragma unroll
        for (int g4 = 0; g4 < 4; ++g4) { u32x2 o; o.x = pk2(acc[dt][4 * g4], acc[dt][4 * g4 + 1]); o.y = pk2(acc[dt][4 * g4 + 2], acc[dt][4 * g4 + 3]);
            *(u32x2*)(out + (size_t)(dt * 32 + r) * 256 + 8 * g4) = o; }
    __syncthreads();
}

DI void ret_scan(const bf16_t* KV, bf16_t* SP, float* o_state, int gt, int nthreads) {
    for (int e = gt; e < 65536; e += nthreads) {
        const int h = e >> 14, dv = (e >> 6) & 255, dk4 = (e & 63) * 4;
        const float lg = log1pf(-exp2f(-5.0f - (float)h)), Dc = __expf(128.0f * lg), c1 = __expf(127.0f * lg);
        const size_t base = ((size_t)(h * 256 + dv)) * 256 + dk4;
        f32x4 s = {0.f, 0.f, 0.f, 0.f};
        for (int n0 = 0; n0 < 64; n0 += 32) {
            u32x2 q[32];
#pragma unroll
            for (int u = 0; u < 32; ++u) q[u] = *(const u32x2*)(KV + (size_t)(n0 + u) * 262144 + base);
#pragma unroll
            for (int u = 0; u < 32; ++u) { u32x2 o; o.x = pk2(s[0], s[1]); o.y = pk2(s[2], s[3]); *(u32x2*)(SP + (size_t)(n0 + u) * 262144 + base) = o;
                const f32x4 kv = {bflo(q[u].x), bfhi(q[u].x), bflo(q[u].y), bfhi(q[u].y)}; s = s * Dc + kv * c1; }
        }
#pragma unroll
        for (int j = 0; j < 4; ++j) o_state[((size_t)(h * 256 + dk4 + j)) * 256 + dv] = s[j];
    }
}

DI float silu_f(float x) { return x / (1.0f + __expf(-x)); }

DI void ret_step2(LAS unsigned char* lds, const bf16_t* Z, const bf16_t* SP, bf16_t* MIX, const float* rng, int n, int h, int tid) {
    LAS unsigned char* Kr = lds; LAS unsigned char* Vt = lds + 128 * 528; LAS float* red = (LAS float*)(lds + 128 * 528 + 256 * 264);
    const int lane = tid & 63, wid = tid >> 6, r = lane & 31, hh = lane >> 5;
    const bf16_t* zc = Z + (size_t)(n * 128) * INW;
#pragma unroll
    for (int k = 0; k < 8; ++k) { const int it = k * 512 + tid, row = it >> 5, c = it & 31;
        *(LAS u32x4*)(Kr + row * 528 + c * 16) = *(const u32x4*)(zc + (size_t)row * INW + C_RK + h * 256 + c * 8); }
    stage_T128x256(Vt, zc + C_RV + h * 256, tid);
    const int it_ = wid >> 1, dh = wid & 1;
    bf16x8 qf[16];
    { const bf16_t* qp = zc + (size_t)(32 * it_ + r) * INW + C_RQ + h * 256 + 8 * hh;
#pragma unroll
      for (int s = 0; s < 16; ++s) qf[s] = *(const bf16x8*)(qp + 16 * s); }
    f32x16 acc[4];
#pragma unroll
    for (int i = 0; i < 4; ++i) acc[i] = zero16();
    const float gm = gamma_of(h);
    __syncthreads();
    for (int jt = 0; jt <= it_; ++jt) {
        f32x16 X = zero16();
#pragma unroll
        for (int s = 0; s < 16; ++s) { const bf16x8 A = *(const LAS bf16x8*)(Kr + (32 * jt + r) * 528 + (16 * s + 8 * hh) * 2); X = MFMA32(A, qf[s], X); }
        if (jt == it_) {
#pragma unroll
            for (int i = 0; i < 16; ++i) X[i] = (crow(i, hh) > r) ? 0.f : X[i];
        }
#pragma unroll
        for (int s2 = 0; s2 < 2; ++s2) { const bf16x8 xs = pack8(X, s2);
#pragma unroll
            for (int dt = 0; dt < 4; ++dt) { const LAS unsigned char* pa = Vt + (128 * dh + 32 * dt + r) * 264 + (32 * jt + 16 * s2 + 4 * hh) * 2;
                const bf16x8 A = cat4(*(const LAS s16x4*)pa, *(const LAS s16x4*)(pa + 16)); acc[dt] = MFMA32(A, xs, acc[dt]); } }
    }
    { const float ig = 1.0f / gm;
#pragma unroll
      for (int dt = 0; dt < 4; ++dt) acc[dt] = acc[dt] * ig; }
    __syncthreads();
    { const bf16_t* spg = SP + (size_t)(n * 4 + h) * 65536;
#pragma unroll 1
      for (int k0 = 0; k0 < 16; k0 += 4) {
          u32x4 spr[4];
#pragma unroll
          for (int k = 0; k < 4; ++k) { const int it = (k0 + k) * 512 + tid; spr[k] = *(const u32x4*)(spg + (size_t)(it >> 5) * 256 + (it & 31) * 8); }
#pragma unroll
          for (int k = 0; k < 4; ++k) { const int it = (k0 + k) * 512 + tid; *(LAS u32x4*)(lds + (it >> 5) * 528 + (it & 31) * 16) = spr[k]; }
      } }
    __syncthreads();
#pragma unroll
    for (int dt = 0; dt < 4; ++dt)
#pragma unroll
        for (int s = 0; s < 16; ++s) { const bf16x8 A = *(const LAS bf16x8*)(lds + (128 * dh + 32 * dt + r) * 528 + (16 * s + 8 * hh) * 2); acc[dt] = MFMA32(A, qf[s], acc[dt]); }
#pragma unroll
    for (int dt = 0; dt < 4; ++dt) acc[dt] = acc[dt] * gm;
    float ss = 0.f;
#pragma unroll
    for (int dt = 0; dt < 4; ++dt)
#pragma unroll
        for (int i = 0; i < 16; ++i) ss += acc[dt][i] * acc[dt][i];
    ss += __shfl_xor(ss, 32);
    if (hh == 0) red[wid * 32 + r] = ss;
    __syncthreads();
    const float rstd = rsqrtf((red[wid * 32 + r] + red[(wid ^ 1) * 32 + r]) * (1.0f / 256.0f) + EPS);
    const size_t token = (size_t)n * 128 + 32 * it_ + r;
#pragma unroll
    for (int dt = 0; dt < 4; ++dt)
#pragma unroll
        for (int g4 = 0; g4 < 4; ++g4) {
            const int dv = 128 * dh + 32 * dt + 8 * g4 + 4 * hh;
            const u32x2 gz = *(const u32x2*)(Z + token * INW + C_RG + h * 256 + dv);
            const f32x4 gn = *(const f32x4*)(rng + h * 256 + dv);
            const float y0 = acc[dt][4 * g4 + 0] * rstd * gn[0] * silu_f(bflo(gz.x)), y1 = acc[dt][4 * g4 + 1] * rstd * gn[1] * silu_f(bfhi(gz.x));
            const float y2 = acc[dt][4 * g4 + 2] * rstd * gn[2] * silu_f(bflo(gz.y)), y3 = acc[dt][4 * g4 + 3] * rstd * gn[3] * silu_f(bfhi(gz.y));
            u32x2 o; o.x = pk2(y0, y1); o.y = pk2(y2, y3);
            *(u32x2*)(MIX + token * DM + 1024 + h * 256 + dv) = o;
        }
    __syncthreads();
}

DI void ret_decode_unit(LAS unsigned char* lds, const bf16_t* Z, const float* S0, float* S1, bf16_t* MIX, const float* rng, int b, int h, int tid) {
    LAS float* qv = (LAS float*)lds; LAS float* red = qv + 768;
    const int lane = tid & 63, wid = tid >> 6;
    const bf16_t* zrow = Z + (size_t)(LP + b) * INW;
    if (tid < 256) { qv[tid] = bf2f(zrow[C_RQ + h * 256 + tid]); qv[256 + tid] = bf2f(zrow[C_RK + h * 256 + tid]); qv[512 + tid] = bf2f(zrow[C_RV + h * 256 + tid]); }
    __syncthreads();
    const float gm = gamma_of(h);
    const f32x4 v4 = *(const LAS f32x4*)(qv + 512 + 4 * lane);
    f32x4 acc = {0.f, 0.f, 0.f, 0.f};
    const size_t off = ((size_t)(b * 4 + h) * 256 + wid * 32) * 256 + 4 * lane;
    const float* s0 = S0 + off; float* s1 = S1 + off;
#pragma unroll 1
    for (int rr = 0; rr < 32; rr += 16) {
        f32x4 s[16];
#pragma unroll
        for (int u = 0; u < 16; ++u) s[u] = __builtin_nontemporal_load((const f32x4*)(s0 + (size_t)(rr + u) * 256));
#pragma unroll
        for (int u = 0; u < 16; ++u) { const int dk = wid * 32 + rr + u; const float kk = qv[256 + dk], qq = qv[dk];
            const f32x4 sn = s[u] * gm + v4 * kk; __builtin_nontemporal_store(sn, (f32x4*)(s1 + (size_t)(rr + u) * 256)); acc += sn * qq; }
    }
    *(LAS f32x4*)(red + wid * 256 + 4 * lane) = acc;
    __syncthreads();
    if (wid == 0) {
        f32x4 o = {0.f, 0.f, 0.f, 0.f};
#pragma unroll
        for (int w = 0; w < 8; ++w) o += *(const LAS f32x4*)(red + w * 256 + 4 * lane);
        const float ssq = wave_sum((o[0] * o[0] + o[1] * o[1]) + (o[2] * o[2] + o[3] * o[3]));
        const float rstd = rsqrtf(ssq * (1.0f / 256.0f) + EPS);
        const u32x2 gz = *(const u32x2*)(zrow + C_RG + h * 256 + 4 * lane);
        const f32x4 gn = *(const f32x4*)(rng + h * 256 + 4 * lane);
        u32x2 y; y.x = pk2(o[0] * rstd * gn[0] * silu_f(bflo(gz.x)), o[1] * rstd * gn[1] * silu_f(bfhi(gz.x)));
        y.y = pk2(o[2] * rstd * gn[2] * silu_f(bflo(gz.y)), o[3] * rstd * gn[3] * silu_f(bfhi(gz.y)));
        *(u32x2*)(MIX + (size_t)(LP + b) * DM + 1024 + h * 256 + 4 * lane) = y;
    }
    __syncthreads();
}

DI void attn_prompt_unit(LAS unsigned char* lds, const bf16_t* Z, bf16_t* MIX, const float* gq, const float* gk, const float* sinks, float* o_k, float* o_v, int nb, int kh, int hf, int tid) {
    LAS unsigned char* Kn = lds; LAS unsigned char* Vt = lds + 256 * 144;
    const int lane = tid & 63, wid = tid >> 6, r = lane & 31, hh = lane >> 5;
    {
        const int row = tid >> 1, half = tid & 1; const int tok = (nb - 1) * 128 + row;
        u32x4 v[4];
#pragma unroll
        for (int c = 0; c < 4; ++c) v[c] = (u32x4){0u, 0u, 0u, 0u};
        if (tok >= 0) {
#pragma unroll
            for (int c = 0; c < 4; ++c) v[c] = *(const u32x4*)(Z + (size_t)tok * INW + C_AK + kh * 64 + half * 32 + c * 8);
        }
        float f[32]; float ss = 0.f;
#pragma unroll
        for (int c = 0; c < 4; ++c)
#pragma unroll
            for (int e = 0; e < 4; ++e) { f[c * 8 + 2 * e] = bflo(v[c][e]); f[c * 8 + 2 * e + 1] = bfhi(v[c][e]); }
#pragma unroll
        for (int e = 0; e < 32; ++e) ss += f[e] * f[e];
        ss += __shfl_xor(ss, 1);
        const float rstd = rsqrtf(ss * (1.0f / 64.0f) + EPS);
#pragma unroll
        for (int c = 0; c < 8; ++c) { const f32x4 g = *(const f32x4*)(gk + half * 32 + c * 4);
#pragma unroll
            for (int e = 0; e < 4; ++e) f[c * 4 + e] *= rstd * g[e]; }
#pragma unroll
        for (int c = 0; c < 4; ++c) { u32x4 w; w.x = pk2(f[c * 8], f[c * 8 + 1]); w.y = pk2(f[c * 8 + 2], f[c * 8 + 3]); w.z = pk2(f[c * 8 + 4], f[c * 8 + 5]); w.w = pk2(f[c * 8 + 6], f[c * 8 + 7]);
            *(LAS u32x4*)(Kn + row * 144 + half * 64 + c * 16) = w; }
        if (nb == 63 && hf == 0 && row >= 128) { float* o = o_k + ((size_t)(row - 128) * 2 + kh) * 64 + half * 32;
#pragma unroll
            for (int c = 0; c < 8; ++c) *(f32x4*)(o + c * 4) = (f32x4){f[c * 4], f[c * 4 + 1], f[c * 4 + 2], f[c * 4 + 3]}; }
    }
#pragma unroll
    for (int k = 0; k < 2; ++k) {
        const int it = k * 512 + tid, kpl = it & 15, dgl = (it >> 4) & 3, rest = it >> 6, dg = dgl + 4 * (rest & 1), kp = kpl + 16 * (rest >> 1);
        const int tok0 = (nb - 1) * 128 + 2 * kp;
        u32x4 a = {0u, 0u, 0u, 0u}, b = {0u, 0u, 0u, 0u};
        if (tok0 >= 0) { const bf16_t* p = Z + (size_t)tok0 * INW + C_AV + kh * 64 + dg * 8; a = *(const u32x4*)p; b = *(const u32x4*)(p + INW); }
#pragma unroll
        for (int e = 0; e < 8; ++e) {
            const unsigned lo = (e & 1) ? (a[e >> 1] >> 16) : (a[e >> 1] & 0xffffu), hi = (e & 1) ? (b[e >> 1] & 0xffff0000u) : (b[e >> 1] << 16);
            *(LAS unsigned*)(Vt + (dg * 8 + e) * 520 + kp * 4) = lo | hi;
        }
        if (nb == 63 && hf == 0 && kp >= 64) { float* o = o_v + ((size_t)(2 * kp - 128) * 2 + kh) * 64 + dg * 8;
#pragma unroll
            for (int e = 0; e < 4; ++e) { o[2 * e] = bflo(a[e]); o[2 * e + 1] = bfhi(a[e]); o[128 + 2 * e] = bflo(b[e]); o[128 + 2 * e + 1] = bfhi(b[e]); } }
    }
    __syncthreads();
    const int hq = kh * 8 + 4 * hf + (wid >> 1), qh = wid & 1;
    const float sink = sinks[hq];
#pragma unroll 1
    for (int qq = 0; qq < 2; ++qq) {
        const int qi = 2 * qh + qq; const size_t tokq = (size_t)nb * 128 + 32 * qi + r;
        bf16x8 qf[4];
        {   const bf16_t* qp = Z + tokq * INW + hq * 64 + 8 * hh;
            u32x4 raw[4]; float ss = 0.f;
#pragma unroll
            for (int s = 0; s < 4; ++s) { raw[s] = *(const u32x4*)(qp + 16 * s);
#pragma unroll
                for (int e = 0; e < 4; ++e) { const float lo = bflo(raw[s][e]), hi = bfhi(raw[s][e]); ss += lo * lo + hi * hi; } }
            ss += __shfl_xor(ss, 32);
            const float rstd = rsqrtf(ss * (1.0f / 64.0f) + EPS) * 0.125f;
#pragma unroll
            for (int s = 0; s < 4; ++s) { const f32x4 g0 = *(const f32x4*)(gq + 16 * s + 8 * hh), g1 = *(const f32x4*)(gq + 16 * s + 8 * hh + 4); u32x4 w;
                w.x = pk2(bflo(raw[s].x) * rstd * g0[0], bfhi(raw[s].x) * rstd * g0[1]); w.y = pk2(bflo(raw[s].y) * rstd * g0[2], bfhi(raw[s].y) * rstd * g0[3]);
                w.z = pk2(bflo(raw[s].z) * rstd * g1[0], bfhi(raw[s].z) * rstd * g1[1]); w.w = pk2(bflo(raw[s].w) * rstd * g1[2], bfhi(raw[s].w) * rstd * g1[3]);
                qf[s] = __builtin_bit_cast(bf16x8, w); }
        }
        f32x16 X[5];
#pragma unroll
        for (int t = 0; t < 5; ++t) { X[t] = zero16();
#pragma unroll
            for (int s = 0; s < 4; ++s) { const bf16x8 A = *(const LAS bf16x8*)(Kn + (32 * (qi + t) + r) * 144 + (16 * s + 8 * hh) * 2); X[t] = MFMA32(A, qf[s], X[t]); } }
        const int ii = 32 * qi + r;
        float m = -1e30f;
#pragma unroll
        for (int t = 0; t < 5; ++t)
#pragma unroll
            for (int i = 0; i < 16; ++i) { const int jj = 32 * (qi + t) + crow(i, hh); const bool ok = (jj >= ii) && (jj <= ii + 128) && (nb > 0 || jj >= 128);
                X[t][i] = ok ? X[t][i] : -1e30f; m = fmaxf(m, X[t][i]); }
        m = fmaxf(m, __shfl_xor(m, 32)); m = fmaxf(m, sink);
        float sum = 0.f;
#pragma unroll
        for (int t = 0; t < 5; ++t)
#pragma unroll
            for (int i = 0; i < 16; ++i) { const float p = __expf(X[t][i] - m); X[t][i] = p; sum += p; }
        sum += __shfl_xor(sum, 32);
        const float inv = 1.0f / (sum + __expf(sink - m));
        f32x16 o[2]; o[0] = zero16(); o[1] = zero16();
#pragma unroll
        for (int t = 0; t < 5; ++t)
#pragma unroll
            for (int s2 = 0; s2 < 2; ++s2) { const bf16x8 xs = pack8(X[t], s2);
#pragma unroll
                for (int dt = 0; dt < 2; ++dt) { const LAS unsigned char* pa = Vt + (32 * dt + r) * 520 + (32 * (qi + t) + 16 * s2 + 4 * hh) * 2;
                    const bf16x8 A = cat4(*(const LAS s16x4*)pa, *(const LAS s16x4*)(pa + 16)); o[dt] = MFMA32(A, xs, o[dt]); } }
#pragma unroll
        for (int dt = 0; dt < 2; ++dt)
#pragma unroll
            for (int g4 = 0; g4 < 4; ++g4) { u32x2 w; w.x = pk2(o[dt][4 * g4] * inv, o[dt][4 * g4 + 1] * inv); w.y = pk2(o[dt][4 * g4 + 2] * inv, o[dt][4 * g4 + 3] * inv);
                *(u32x2*)(MIX + tokq * DM + hq * 64 + 32 * dt + 8 * g4 + 4 * hh) = w; }
    }
    __syncthreads();
}

DI void attn_decode_unit(LAS unsigned char* lds, const bf16_t* Z, const float* ck, const float* cv, bf16_t* MIX, const float* gq, const float* gk, const float* sinks, float* o_k, float* o_v, int b, int kh, int tid) {
    LAS float* Kc = (LAS float*)lds; LAS float* Vc = Kc + 129 * 65; LAS float* qs = Vc + 129 * 64; LAS float* pw = qs + 512;
    const int lane = tid & 63, wid = tid >> 6;
#pragma unroll
    for (int k = 0; k < 4; ++k) {
        const int it = k * 512 + tid, w = it >> 4, c4 = (it & 15) * 4;
        const size_t src = ((size_t)(b * 128 + w) * 2 + kh) * 64 + c4;
        const f32x4 k4 = *(const f32x4*)(ck + src), v4 = *(const f32x4*)(cv + src);
#pragma unroll
        for (int e = 0; e < 4; ++e) { Kc[w * 65 + c4 + e] = k4[e]; Vc[w * 64 + c4 + e] = v4[e]; }
        if (w >= 1) { const size_t dst = ((size_t)(b * 128 + w - 1) * 2 + kh) * 64 + c4; *(f32x4*)(o_k + dst) = k4; *(f32x4*)(o_v + dst) = v4; }
    }
    const bf16_t* zrow = Z + (size_t)(LP + b) * INW;
    const size_t dnew = ((size_t)(b * 128 + 127) * 2 + kh) * 64 + lane;
    if (wid == 0) { const float kx = bf2f(zrow[C_AK + kh * 64 + lane]); const float ss = wave_sum(kx * kx); const float kn = kx * rsqrtf(ss * (1.0f / 64.0f) + EPS) * gk[lane];
        Kc[128 * 65 + lane] = kn; o_k[dnew] = kn; }
    if (wid == 1) { const float vx = bf2f(zrow[C_AV + kh * 64 + lane]); Vc[128 * 64 + lane] = vx; o_v[dnew] = vx; }
    const int hq = kh * 8 + wid;
    { const float qx = bf2f(zrow[hq * 64 + lane]); const float ss = wave_sum(qx * qx); qs[wid * 64 + lane] = qx * rsqrtf(ss * (1.0f / 64.0f) + EPS) * gq[lane] * 0.125f; }
    __syncthreads();
    float s1 = 0.f, s2 = 0.f;
#pragma unroll 8
    for (int d = 0; d < 64; ++d) { const float q = qs[wid * 64 + d]; s1 += q * Kc[lane * 65 + d]; s2 += q * Kc[(lane + 64) * 65 + d]; }
    const float s3 = wave_sum(qs[wid * 64 + lane] * Kc[128 * 65 + lane]);
    const float sink = sinks[hq];
    const float m = fmaxf(wave_max(fmaxf(s1, s2)), fmaxf(s3, sink));
    const float p1 = __expf(s1 - m), p2 = __expf(s2 - m), p3 = __expf(s3 - m);
    const float denom = wave_sum(p1 + p2) + p3 + __expf(sink - m);
    pw[wid * 132 + lane] = p1; pw[wid * 132 + 64 + lane] = p2; if (lane == 0) pw[wid * 132 + 128] = p3;
    __syncthreads();
    float o = 0.f;
#pragma unroll 3
    for (int j = 0; j < 129; ++j) o += pw[wid * 132 + j] * Vc[j * 64 + lane];
    MIX[(size_t)(LP + b) * DM + hq * 64 + lane] = (bf16_t)(pk2(o / denom, 0.f) & 0xffffu);
    __syncthreads();
}

template <int MT, class Epi>
DI void skinny_unit(LAS unsigned char* lds, const bf16_t* A, const bf16_t* Wt, int K, int cgi, int k0, int row0, const Epi& E, int tid) {
    const int lane = tid & 63, wid = tid >> 6, fr = lane & 15, fq = lane >> 4;
    const int c0 = cgi * 32;
    constexpr int NMT = 2 * MT;
    const bf16_t* pa = A + (size_t)(row0 + fr) * K + k0 + wid * 256 + 8 * fq;
    const bf16_t* pb = Wt + (size_t)(c0 + fr) * K + k0 + wid * 256 + 8 * fq;
    const size_t rs = (size_t)16 * K;
    f32x4 acc[NMT][2];
#pragma unroll
    for (int i = 0; i < NMT; ++i) { acc[i][0] = (f32x4){0.f, 0.f, 0.f, 0.f}; acc[i][1] = (f32x4){0.f, 0.f, 0.f, 0.f}; }
    bf16x8 fb[3][2], fa[3][NMT];
#define SK_LOAD(buf, c) do { _Pragma("unroll") for (int nt = 0; nt < 2; ++nt) fb[buf][nt] = *(const bf16x8*)(pb + nt * rs + 32 * (c)); \
        _Pragma("unroll") for (int mt = 0; mt < NMT; ++mt) fa[buf][mt] = *(const bf16x8*)(pa + mt * rs + 32 * (c)); } while (0)
#define SK_MMA(buf) do { _Pragma("unroll") for (int mt = 0; mt < NMT; ++mt) _Pragma("unroll") for (int nt = 0; nt < 2; ++nt) \
        acc[mt][nt] = __builtin_amdgcn_mfma_f32_16x16x32_bf16(fa[buf][mt], fb[buf][nt], acc[mt][nt], 0, 0, 0); } while (0)
    SK_LOAD(0, 0); SK_LOAD(1, 1);
    SK_LOAD(2, 2); SK_MMA(0);
    SK_LOAD(0, 3); SK_MMA(1);
    SK_LOAD(1, 4); SK_MMA(2);
    SK_LOAD(2, 5); SK_MMA(0);
    SK_LOAD(0, 6); SK_MMA(1);
    SK_LOAD(1, 7); SK_MMA(2);
    SK_MMA(0); SK_MMA(1);
#undef SK_LOAD
#undef SK_MMA
    constexpr int NR = 32 * MT;
    LAS float* red = (LAS float*)lds;
#pragma unroll
    for (int mt = 0; mt < NMT; ++mt)
#pragma unroll
        for (int nt = 0; nt < 2; ++nt)
#pragma unroll
            for (int j = 0; j < 4; ++j) red[(wid * NR + mt * 16 + 4 * fq + j) * 32 + nt * 16 + fr] = acc[mt][nt][j];
    __syncthreads();
    if (MT == 4) {
        const int row = tid >> 2, c8 = (tid & 3) * 8;
        f32x4 sa = {0.f, 0.f, 0.f, 0.f}, sb = {0.f, 0.f, 0.f, 0.f};
#pragma unroll
        for (int w = 0; w < 8; ++w) { sa += *(const LAS f32x4*)(red + (w * NR + row) * 32 + c8); sb += *(const LAS f32x4*)(red + (w * NR + row) * 32 + c8 + 4); }
        E(row0 + row, c0 + c8, sa); E(row0 + row, c0 + c8 + 4, sb);
    } else if (tid < 8 * NR) {
        const int row = tid >> 3, c4 = (tid & 7) * 4;
        f32x4 sa = {0.f, 0.f, 0.f, 0.f};
#pragma unroll
        for (int w = 0; w < 8; ++w) sa += *(const LAS f32x4*)(red + (w * NR + row) * 32 + c4);
        E(row0 + row, c0 + c4, sa);
    }
    __syncthreads();
}
struct SkOut { const float* xs; float* X1s; bf16_t* XBs;
    DI void operator()(int row, int col, f32x4 a) const { const f32x4 v = a + *(const f32x4*)(xs + (size_t)row * DM + col); *(f32x4*)(X1s + (size_t)row * DM + col) = v;
        u32x2 o; o.x = pk2(v[0], v[1]); o.y = pk2(v[2], v[3]); *(u32x2*)(XBs + (size_t)row * DM + col) = o; } };
struct SkUp { bf16_t* Us;
    DI void operator()(int row, int col, f32x4 a) const {
#pragma unroll
        for (int e = 0; e < 4; ++e) { a[e] = fmaxf(a[e], 0.f); a[e] *= a[e]; }
        u32x2 o; o.x = pk2(a[0], a[1]); o.y = pk2(a[2], a[3]); *(u32x2*)(Us + (size_t)row * FF + col) = o; } };
struct SkSlab { float* slab;
    DI void operator()(int row, int col, f32x4 a) const { *(f32x4*)(slab + (size_t)row * DM + col) = a; } };

#define RLX_AGENT __ATOMIC_RELAXED, __HIP_MEMORY_SCOPE_AGENT
#define XB_TMO      128
#define XB_XCNT(j)  (256  + 64 * (j))
#define XB_XSUB(j)  (1280 + 64 * (j))
#define XB_XGEN(j)  (2304 + 64 * (j))
#define XB_TOP      3328
#define XB_TOPGEN   3392
#define XCD_BAR_WORDS 3456
#define XB_SPIN_CAP (1u << 18)

__device__ __forceinline__ unsigned xb_ld(unsigned* p)              { return __hip_atomic_load(p, __ATOMIC_RELAXED, __HIP_MEMORY_SCOPE_AGENT); }
__device__ __forceinline__ unsigned xb_add(unsigned* p, unsigned v) { return __hip_atomic_fetch_add(p, v, __ATOMIC_RELAXED, __HIP_MEMORY_SCOPE_AGENT); }
__device__ __forceinline__ unsigned xb_xcc_id() { return (unsigned)__builtin_amdgcn_s_getreg((3 << 11) | 20) & 0xFu; }
#define XB_SPIN(cond, bar) do { unsigned _sp = 0; while (cond) { __builtin_amdgcn_s_sleep(1); \
    if ((++_sp & 255u) == 0u) { if (xb_ld(&(bar)[XB_TMO])) break; if (_sp > XB_SPIN_CAP) { atomicAdd(&(bar)[XB_TMO], 1u); break; } } } } while (0)

struct XcdBarrier {
    unsigned* bar; unsigned x;
    volatile LAS unsigned* st;
};

__device__ __forceinline__ XcdBarrier xcd_barrier_post(unsigned* bar, volatile LAS unsigned* st) {
    XcdBarrier b; b.bar = bar; b.x = xb_xcc_id(); b.st = st;
    if (threadIdx.x == 0) (void)xb_add(&bar[XB_XCNT(b.x)], 1u);
    return b;
}
__device__ __forceinline__ void xcd_barrier_complete(unsigned* bar, unsigned x, unsigned& nloc, unsigned& nx) {
    const unsigned G = gridDim.x * gridDim.y * gridDim.z;
    unsigned sum, cnt, mine, sp = 0u;
    for (;;) {
        sum = 0u; cnt = 0u; mine = 0u;
#pragma unroll
        for (unsigned j = 0; j < 16; ++j) { const unsigned c = xb_ld(&bar[XB_XCNT(j)]); sum += c; cnt += (c > 0u) ? 1u : 0u; mine = (j == x) ? c : mine; }
        if (sum == G) break;
        __builtin_amdgcn_s_sleep(1);
        if ((++sp & 255u) == 0u) { if (xb_ld(&bar[XB_TMO])) break; if (sp > XB_SPIN_CAP) { atomicAdd(&bar[XB_TMO], 1u); break; } }
    }
    nloc = mine > 0u ? mine : 1u; nx = cnt > 0u ? cnt : 1u;
}

__device__ __forceinline__ void xcd_barrier(const XcdBarrier& b) {
    asm volatile("s_waitcnt vmcnt(0)" ::: "memory");
    __syncthreads();
    if (threadIdx.x == 0) {
        unsigned* bar = b.bar;
        __builtin_amdgcn_s_waitcnt(0);
        unsigned nloc = b.st[0], nx = b.st[1];
        if (nloc == 0u) { xcd_barrier_complete(bar, b.x, nloc, nx); b.st[0] = nloc; b.st[1] = nx; }
        const unsigned old = xb_add(&bar[XB_XSUB(b.x)], 1u);
        const unsigned gen = old / nloc;
        if (old + 1u == (gen + 1u) * nloc) {
            __builtin_amdgcn_fence(__ATOMIC_RELEASE, "agent");
            asm volatile("s_waitcnt vmcnt(0)" ::: "memory");
            const unsigned og = xb_add(&bar[XB_TOP], 1u);
            const unsigned tg = og / nx;
            if (og + 1u == (tg + 1u) * nx) xb_add(&bar[XB_TOPGEN], 1u);
            else XB_SPIN(xb_ld(&bar[XB_TOPGEN]) == tg, bar);
            __builtin_amdgcn_fence(__ATOMIC_ACQUIRE, "agent");
            xb_add(&bar[XB_XGEN(b.x)], 1u);
            asm volatile("s_waitcnt vmcnt(0)" ::: "memory");
        } else {
            XB_SPIN(xb_ld(&bar[XB_XGEN(b.x)]) == gen, bar);
            __builtin_amdgcn_fence(__ATOMIC_ACQUIRE, "agent");
            asm volatile("s_waitcnt vmcnt(0)" ::: "memory");
        }
    }
    __syncthreads();
}

struct Args { const float* in[15]; float* out; unsigned char* ws; int ph_lo, ph_hi; };
constexpr int NPH = 9;
constexpr int NP0_REST = 7424;

__global__ void __launch_bounds__(512, 2) fwd_kernel(Args a) {
    extern __shared__ __attribute__((aligned(16))) unsigned char lds_raw[];
    LAS unsigned char* lds = (LAS unsigned char*)lds_raw;
    cg::grid_group grid = cg::this_grid();
    const int tid = threadIdx.x, lane = tid & 63, wid = __builtin_amdgcn_readfirstlane(tid >> 6);
    const int G = gridDim.x, bx = blockIdx.x;
    unsigned char* ws = a.ws; float* out = a.out;
    const float* x_p = a.in[0]; const float* x_s = a.in[1]; const float* cache_k = a.in[2]; const float* cache_v = a.in[3]; const float* state0 = a.in[4];
    const float* ln1_g = a.in[5]; const float* w_in = a.in[6]; const float* gq = a.in[7]; const float* gk = a.in[8]; const float* sinks = a.in[9];
    const float* rng = a.in[10]; const float* w_out = a.in[11]; const float* ln2_g = a.in[12]; const float* w_up = a.in[13]; const float* w_dn = a.in[14];
    bf16_t* WIN = (bf16_t*)(ws + WS_WIN); bf16_t* WOUT = (bf16_t*)(ws + WS_WOUT); bf16_t* WUP = (bf16_t*)(ws + WS_WUP); bf16_t* WDN = (bf16_t*)(ws + WS_WDN);
    bf16_t* H1 = (bf16_t*)(ws + WS_H1); bf16_t* XG = H1; bf16_t* MIX = (bf16_t*)(ws + WS_MIX); bf16_t* Z = (bf16_t*)(ws + WS_Z); bf16_t* U = (bf16_t*)(ws + WS_U);
    float* PART = (float*)(ws + WS_PART); float* RSTD2 = (float*)(ws + WS_RSTD2); bf16_t* KV = (bf16_t*)(ws + WS_KV); bf16_t* SP = (bf16_t*)(ws + WS_SP); float* SLAB = (float*)(ws + WS_SP);
    const int lo = a.ph_lo, hi = a.ph_hi;
#define IN(k) (lo <= (k) && (k) < hi)
    volatile LAS unsigned* MISC = (volatile LAS unsigned*)(lds + LDS_BYTES - 64);
    if (tid < 16) MISC[tid] = 0u;
    __syncthreads();
    const XcdBarrier bar = xcd_barrier_post((unsigned*)ws + 1024, MISC + 8);
    if (lo > hi) grid.sync();
#define SEAM(k) do { if (IN(k) && IN((k) + 1)) xcd_barrier(bar); } while (0)

    if (IN(0)) for (int rep_ = 0; rep_ < 1 + ((DUPMASK >> 0) & 1); ++rep_) { if (rep_) xcd_barrier(bar);
        LAS float* scr = (LAS float*)(lds + wid * 17408);
        const int gw = bx * 8 + wid, NGW = G * 8;
        constexpr int I_IN = (DM / 64) * (INW / 32);
        p0_convert(ResIn{w_in, WIN}, gw, NGW, I_IN, scr, lane);
        for (int m = gw; m < MP; m += NGW) {
            if (m < MR) rms_row(m < LP ? x_p + (size_t)m * DM : x_s + (size_t)(m - LP) * DM, ln1_g, H1 + (size_t)m * DM, lane);
            else {
#pragma unroll
                for (int j = 0; j < 8; ++j) *((u32x2*)(H1 + (size_t)m * DM) + lane + 64 * j) = (u32x2){0u, 0u};
            }
        }
    }
    SEAM(0);
    if (IN(1)) for (int rep_ = 0; rep_ < 1 + ((DUPMASK >> 1) & 1); ++rep_) { if (rep_) xcd_barrier(bar);
        pg8::Gemm g{H1, WIN, MP, INW, DM}; pg8::StaticOrder S; S.init(MP, INW, G, bx, WGM_IN);
        pg8::EpiIn E{Z};
        pg8::gemm_phase<pg8::EpiIn, pg8::StaticOrder, true, true>(lds, g, S, E);
        {
            constexpr int NT = (MP / 256) * (INW / 256); const int rounds = (NT + G - 1) / G, first_idle = NT - (rounds - 1) * G;
            const int nidle = (first_idle < G) ? (G - first_idle) : G, me = (first_idle < G) ? (bx - first_idle) : bx;
            if (me >= 0) {
                LAS float* scr = (LAS float*)(lds + wid * 17408);
                constexpr int I_OUT = (DM / 64) * (DM / 32), I_UP = (DM / 64) * (FF / 32), I_DN = (FF / 64) * (DM / 32);
                p0_convert(ResRest{w_out, w_up, w_dn, WOUT, WUP, WDN, ln2_g}, NP0_REST + me * 8 + wid, nidle * 8, I_OUT + I_UP + I_DN, scr, lane);
            }
        }
    }
    SEAM(1);
    if (IN(2)) for (int rep_ = 0; rep_ < 1 + ((DUPMASK >> 2) & 1); ++rep_) { if (rep_) xcd_barrier(bar);
        if (bx & 1) for (int u = bx; u < 256; u += G) ret_decode_unit(lds, Z, state0, out + O_SS, MIX, rng, u >> 2, u & 3, tid);
        for (int u = bx; u < 256; u += G) ret_step1(lds, Z, KV, u >> 2, u & 3, tid);
        if (!(bx & 1)) for (int u = bx; u < 256; u += G) ret_decode_unit(lds, Z, state0, out + O_SS, MIX, rng, u >> 2, u & 3, tid);
    }
    SEAM(2);
    if (IN(3)) for (int rep_ = 0; rep_ < 1 + ((DUPMASK >> 3) & 1); ++rep_) { if (rep_) xcd_barrier(bar);
        if (tid < 256) ret_scan(KV, SP, out + O_SP, bx * 256 + tid, G * 256);
        if (bx & 1) for (int u = bx; u < 256; u += G) attn_decode_unit(lds, Z, cache_k, cache_v, MIX, gq, gk, sinks, out + O_KS, out + O_VS, u >> 1, u & 1, tid);
        for (int u = 256 + bx; u < 512; u += G) ret_decode_unit(lds, Z, state0, out + O_SS, MIX, rng, u >> 2, u & 3, tid);
        if (!(bx & 1)) for (int u = bx; u < 256; u += G) attn_decode_unit(lds, Z, cache_k, cache_v, MIX, gq, gk, sinks, out + O_KS, out + O_VS, u >> 1, u & 1, tid);
    }
    SEAM(3);
    if (IN(4)) for (int rep_ = 0; rep_ < 1 + ((DUPMASK >> 4) & 1); ++rep_) { if (rep_) xcd_barrier(bar);
        for (int u = bx; u < 256; u += G) ret_step2(lds, Z, SP, MIX, rng, u >> 2, u & 3, tid);
        for (int u = bx; u < 256; u += G) attn_prompt_unit(lds, Z, MIX, gq, gk, sinks, out + O_KP, out + O_VP, u >> 2, (u >> 1) & 1, u & 1, tid);
        {
            LAS float* scr = (LAS float*)(lds + wid * 17408);
            p0_convert(ResRest{w_out, w_up, w_dn, WOUT, WUP, WDN, ln2_g}, bx * 8 + wid, G * 8, NP0_REST, scr, lane);
        }
    }
    SEAM(4);
    if (IN(5)) for (int rep_ = 0; rep_ < 1 + ((DUPMASK >> 5) & 1); ++rep_) { if (rep_) xcd_barrier(bar);
        pg8::Gemm g{MIX, WOUT, LP, DM, DM}; pg8::StaticOrder S; S.init(LP, DM, G, bx, WGM_OUT);
        pg8::EpiOut E{x_p, XG, PART};
        pg8::gemm_phase<pg8::EpiOut, pg8::StaticOrder, true, true>(lds, g, S, E);
        const SkOut SE{x_s, out + O_Y + (size_t)LP * DM, XG + (size_t)LP * DM};
        for (int u = bx; u < 4 * (DM / 32); u += G) skinny_unit<1>(lds, MIX + (size_t)LP * DM, WOUT, DM, u >> 2, 0, (u & 3) * 32, SE, tid);
    }
    SEAM(5);
    if (IN(6)) for (int rep_ = 0; rep_ < 1 + ((DUPMASK >> 6) & 1); ++rep_) { if (rep_) xcd_barrier(bar);
        for (int row = bx + G * tid; row < LP; row += G * 512) { float s = 0.f;
#pragma unroll
            for (int j = 0; j < 8; ++j) { const f32x4 p = *(const f32x4*)(PART + (size_t)row * 32 + 4 * j); s += (p[0] + p[1]) + (p[2] + p[3]); }
            RSTD2[row] = 1.0f / (s * (1.0f / DM) + EPS); }
        for (int row = LP + bx * 8 + wid; row < MR; row += G * 8) {
            const float* xr = out + O_Y + (size_t)row * DM; float s = 0.f;
#pragma unroll
            for (int j = 0; j < 8; ++j) { const f32x4 v = *((const f32x4*)xr + lane + 64 * j); s += (v[0] * v[0] + v[1] * v[1]) + (v[2] * v[2] + v[3] * v[3]); }
            s = wave_sum(s); if (lane == 0) RSTD2[row] = 1.0f / (s * (1.0f / DM) + EPS); }
        pg8::Gemm g{XG, WUP, LP, FF, DM}; pg8::StaticOrder S; S.init(LP, FF, G, bx, WGM_UP);
        pg8::EpiUp E{U};
        pg8::gemm_phase<pg8::EpiUp, pg8::StaticOrder, true, true>(lds, g, S, E);
        const SkUp SE{U + (size_t)LP * FF};
        for (int u = bx; u < FF / 32; u += G) skinny_unit<4>(lds, XG + (size_t)LP * DM, WUP, DM, u, 0, 0, SE, tid);
    }
    SEAM(6);
    if (IN(7)) {
        if (bx & 1) for (int u = bx; u < 4 * (DM / 32); u += G) { const SkSlab SE{SLAB + (size_t)(u & 3) * NS * DM}; skinny_unit<4>(lds, U + (size_t)LP * FF, WDN, FF, u >> 2, (u & 3) * 2048, 0, SE, tid); }
        pg8::Gemm g{U, WDN, LP, DM, FF}; pg8::StaticOrder S; S.init(LP, DM, G, bx, WGM_DN);
        pg8::EpiDown E{out + O_Y, XG, RSTD2};
        pg8::gemm_phase<pg8::EpiDown, pg8::StaticOrder, true, true>(lds, g, S, E);
        if (!(bx & 1)) for (int u = bx; u < 4 * (DM / 32); u += G) { const SkSlab SE{SLAB + (size_t)(u & 3) * NS * DM}; skinny_unit<4>(lds, U + (size_t)LP * FF, WDN, FF, u >> 2, (u & 3) * 2048, 0, SE, tid); }
    }
    SEAM(7);
    if (IN(8)) {
        for (int e = bx * 512 + tid; e < NS * DM / 4; e += G * 512) {
            const int row = e >> 9; float* p = out + O_Y + (size_t)LP * DM + (size_t)e * 4;
            const f32x4 s = (*(const f32x4*)(SLAB + (size_t)e * 4) + *(const f32x4*)(SLAB + (size_t)NS * DM + (size_t)e * 4)) + (*(const f32x4*)(SLAB + (size_t)2 * NS * DM + (size_t)e * 4) + *(const f32x4*)(SLAB + (size_t)3 * NS * DM + (size_t)e * 4));
            *(f32x4*)p = *(const f32x4*)p + s * RSTD2[LP + row];
        }
    }
#undef IN
#undef SEAM
}

#ifndef N_LAUNCHES
#define N_LAUNCHES 1
#endif
extern "C" void kernel_launch(void* const* d_in, const int* in_sizes, int n_in, void* d_out, int out_size, void* d_ws, size_t ws_size, hipStream_t stream) {
    static int grid = 0;
    if (grid == 0) {
        if (n_in != 15 || (size_t)out_size != O_END || ws_size < WS_END) { fprintf(stderr, "kernel_launch: unexpected shapes (n_in %d out %d ws %zu)\n", n_in, out_size, ws_size); grid = -1; return; }
        int dev = 0, cus = 0, per_cu = 0;
        (void)hipGetDevice(&dev); (void)hipDeviceGetAttribute(&cus, hipDeviceAttributeMultiprocessorCount, dev);
        if (hipFuncSetAttribute((const void*)fwd_kernel, hipFuncAttributeMaxDynamicSharedMemorySize, LDS_BYTES) != hipSuccess) { fprintf(stderr, "kernel_launch: hipFuncSetAttribute failed\n"); grid = -1; return; }
        (void)hipOccupancyMaxActiveBlocksPerMultiprocessor(&per_cu, (const void*)fwd_kernel, 512, LDS_BYTES);
        (void)hipGetLastError();
        if (per_cu < 1) { fprintf(stderr, "kernel_launch: occupancy query says %d blocks per CU\n", per_cu); }
        grid = cus > 0 ? cus : 256;
    }
    if (grid < 0) return;
    if (hipMemsetAsync(d_ws, 0, 65536, stream) != hipSuccess) { fprintf(stderr, "kernel_launch: memset failed\n"); return; }
    Args a{};
    for (int i = 0; i < 15; ++i) a.in[i] = (const float*)d_in[i];
    a.out = (float*)d_out; a.ws = (unsigned char*)d_ws;
    if (N_LAUNCHES == 1) {
        a.ph_lo = 0; a.ph_hi = NPH;
        void* args[] = {&a};
        hipError_t e = hipLaunchCooperativeKernel((const void*)fwd_kernel, dim3(grid), dim3(512), args, LDS_BYTES, stream);
        if (e != hipSuccess) fprintf(stderr, "cooperative launch failed: %s (grid %d)\n", hipGetErrorString(e), grid);
    } else {
        for (int p = 0; p < NPH; ++p) { a.ph_lo = p; a.ph_hi = p + 1; hipLaunchKernelGGL(fwd_kernel, dim3(grid), dim3(512), LDS_BYTES, stream, a); }
    }
}
```

```cpp
#include <hip/hip_runtime.h>
#include <hip/hip_cooperative_groups.h>
#include <cstdio>
#include <cstdint>
namespace cg = cooperative_groups;

#ifndef WGM_IN
#define WGM_IN 2
#endif
#ifndef WGM_OUT
#define WGM_OUT 2
#endif
#ifndef WGM_UP
#define WGM_UP 2
#endif
#ifndef WGM_DN
#define WGM_DN 2
#endif
#ifndef DUPMASK
#define DUPMASK 0
#endif
#define DI __device__ __forceinline__
#define LAS __attribute__((address_space(3)))
typedef float f32x2 __attribute__((ext_vector_type(2)));
typedef float f32x16 __attribute__((ext_vector_type(16)));
typedef short s16x4 __attribute__((ext_vector_type(4)));
typedef unsigned u32x2 __attribute__((ext_vector_type(2)));
typedef __bf16 bf16x2v __attribute__((ext_vector_type(2)));

constexpr int DM = 2048, LP = 8192, NS = 128, MR = LP + NS  , MP = 8448  ;
constexpr int INW = 5376, FF = 8192;
constexpr int C_AQ = 0, C_AK = 1024, C_AV = 1152, C_RQ = 1280, C_RK = 2304, C_RV = 3328, C_RG = 4352;
constexpr float EPS = 1e-6f;

DI unsigned pk2(float lo, float hi) { f32x2 v = {lo, hi}; return __builtin_bit_cast(unsigned, __builtin_convertvector(v, bf16x2v)); }
DI float bflo(unsigned u) { return __uint_as_float(u << 16); }
DI float bfhi(unsigned u) { return __uint_as_float(u & 0xffff0000u); }
DI float bf2f(unsigned short u) { return __uint_as_float(((unsigned)u) << 16); }

namespace pg8 {
#define PG8_LAS __attribute__((address_space(3)))
typedef unsigned short bf16_t;
typedef short bf16x8 __attribute__((ext_vector_type(8)));
typedef float f32x4 __attribute__((ext_vector_type(4)));
typedef unsigned u32x4 __attribute__((ext_vector_type(4)));
constexpr int BM = 256, BK = 64, HALF = 128, HTB = HALF * BK * 2  , STAGE_BYTES = 8 * HTB, NXCD = 8, WGM = 8;

__host__ __device__ __forceinline__ int lds_byte(int r, int c) { const int st = (r >> 4) * 2 + (c >> 5), rr = r & 15, cc = c & 31, ob = rr * 64 + cc * 2; return st * 1024 + (ob ^ (((ob >> 9) & 1) << 5)); }
__host__ __device__ __forceinline__ void stage_rc(int b, int& R, int& C) { const int st = b / 1024, sb = b % 1024, swz = sb ^ (((sb >> 9) & 1) << 5); R = (st >> 1) * 16 + swz / 64; C = (st & 1) * 32 + (swz % 64) / 2; }
__host__ __device__ __forceinline__ int perm32(int rho) { const int n = rho >> 4, i = rho & 15; return 8 * (i >> 2) + 4 * n + (i & 3); }

struct Unit { int pm, pn; };
struct Gemm { const bf16_t* A; const bf16_t* Bt; int M, N, K; };

struct StaticOrder {
    int nM, nN, nwg, G, c, wgm;
    __host__ __device__ void init(int M, int N, int G_, int c_, int wgm_) { nM = M / BM; nN = N / BM; nwg = nM * nN; G = G_; c = c_; wgm = wgm_; }
    __host__ __device__ bool next(int i, Unit& u) const {
        const long L = (long)i * G + c; if (L >= nwg) return false;
        int wgid = (int)L; { const int q = nwg / NXCD, r = nwg % NXCD, xcd = wgid % NXCD, off = wgid / NXCD; wgid = (xcd < r ? xcd * (q + 1) : r * (q + 1) + (xcd - r) * q) + off; }
        const int nig = wgm * nN, gid = wgid / nig, fm = gid * wgm, gsz = (nM - fm) < wgm ? (nM - fm) : wgm;
        u.pm = fm + ((wgid % nig) % gsz); u.pn = (wgid % nig) / gsz; return true;
    }
    __device__ __forceinline__ void a_ready(const Unit&) const {}
    __device__ __forceinline__ void done(const Unit&) const {}
};


DI u32x4 pack8f(const f32x4& a, const f32x4& b) { u32x4 w; w.x = pk2(a[0], a[1]); w.y = pk2(a[2], a[3]); w.z = pk2(b[0], b[1]); w.w = pk2(b[2], b[3]); return w; }

struct EpiIn {
    static constexpr bool PERM = true, AFTER_DRAIN = false;
    bf16_t* Z;
    __device__ __forceinline__ void operator()(const f32x4 (&acc)[2][2][4][2], const Unit& u, int wr, int wc, int fr, int fq) const {
        const int row0 = u.pm * BM + wr * 64 + fr, col0 = u.pn * BM + wc * 32 + 8 * fq;
        if (u.pn < 5 || u.pn > 12) {
#pragma unroll
            for (int ai = 0; ai < 2; ++ai)
#pragma unroll
                for (int m = 0; m < 4; ++m) { bf16_t* rowp = Z + (size_t)(row0 + ai * HALF + m * 16) * INW + col0;
#pragma unroll
                    for (int bj = 0; bj < 2; ++bj) *(u32x4*)(rowp + bj * HALF) = pack8f(acc[ai][bj][m][0], acc[ai][bj][m][1]); }
        } else {
            const int head = (u.pn - 5) & 3; const bool isk = u.pn >= 9;
            const float lg = log1pf(-exp2f(-5.0f - (float)head));
            float inv[8];
#pragma unroll
            for (int j = 0; j < 8; ++j) inv[j] = powf(10000.0f, -(float)(wc * 32 + 8 * fq + j) * (1.0f / 128.0f));
#pragma unroll
            for (int ai = 0; ai < 2; ++ai)
#pragma unroll
                for (int m = 0; m < 4; ++m) {
                    const int row = row0 + ai * HALF + m * 16;
                    const int pos = row < LP ? row : LP; const float t = row < LP ? (float)(row & 127) : 0.0f;
                    const float f = isk ? 0.0625f * __expf(-lg * t) : __expf(lg * t);
                    f32x4 o1[2], o2[2];
#pragma unroll
                    for (int n = 0; n < 2; ++n)
#pragma unroll
                        for (int e = 0; e < 4; ++e) {
                            const float ang = (float)pos * inv[n * 4 + e];
                            double rev = (double)ang * 0.15915494309189535; rev -= floor(rev);
                            const float fr_ = (float)rev; const float sn = __builtin_amdgcn_sinf(fr_), cs = __builtin_amdgcn_cosf(fr_);
                            const float x1 = acc[ai][0][m][n][e], x2 = acc[ai][1][m][n][e];
                            o1[n][e] = (x1 * cs - x2 * sn) * f; o2[n][e] = (x2 * cs + x1 * sn) * f;
                        }
                    bf16_t* rowp = Z + (size_t)row * INW + col0;
                    *(u32x4*)(rowp) = pack8f(o1[0], o1[1]); *(u32x4*)(rowp + HALF) = pack8f(o2[0], o2[1]);
                }
        }
    }
};

struct EpiOut {
    static constexpr bool PERM = true, AFTER_DRAIN = false;
    const float* xp; bf16_t* X1B; float* part;
    __device__ __forceinline__ void operator()(const f32x4 (&acc)[2][2][4][2], const Unit& u, int wr, int wc, int fr, int fq) const {
#pragma unroll
        for (int ai = 0; ai < 2; ++ai)
#pragma unroll
            for (int m = 0; m < 4; ++m) {
                const int row = u.pm * BM + ai * HALF + wr * 64 + m * 16 + fr;
                const float* xrow = xp + (size_t)row * DM;
                float ss = 0.f;
#pragma unroll
                for (int bj = 0; bj < 2; ++bj) {
                    const int col = u.pn * BM + bj * HALF + wc * 32 + 8 * fq;
                    const f32x4 v0 = acc[ai][bj][m][0] + *(const f32x4*)(xrow + col), v1 = acc[ai][bj][m][1] + *(const f32x4*)(xrow + col + 4);
                    ss += (v0[0] * v0[0] + v0[1] * v0[1]) + (v0[2] * v0[2] + v0[3] * v0[3]) + (v1[0] * v1[0] + v1[1] * v1[1]) + (v1[2] * v1[2] + v1[3] * v1[3]);
                    *(u32x4*)(X1B + (size_t)row * DM + col) = pack8f(v0, v1);
                }
                ss += __shfl_xor(ss, 16); ss += __shfl_xor(ss, 32);
                if (fq == 0) part[(size_t)row * 32 + u.pn * 4 + wc] = ss;
            }
    }
};

struct EpiUp {
    static constexpr bool PERM = true, AFTER_DRAIN = false;
    bf16_t* U;
    __device__ __forceinline__ void operator()(const f32x4 (&acc)[2][2][4][2], const Unit& u, int wr, int wc, int fr, int fq) const {
        const int row0 = u.pm * BM + wr * 64 + fr, col0 = u.pn * BM + wc * 32 + 8 * fq;
#pragma unroll
        for (int ai = 0; ai < 2; ++ai)
#pragma unroll
            for (int m = 0; m < 4; ++m) { bf16_t* rowp = U + (size_t)(row0 + ai * HALF + m * 16) * FF + col0;
#pragma unroll
                for (int bj = 0; bj < 2; ++bj) { f32x4 a = acc[ai][bj][m][0], b = acc[ai][bj][m][1];
#pragma unroll
                    for (int e = 0; e < 4; ++e) { a[e] = fmaxf(a[e], 0.f); a[e] *= a[e]; b[e] = fmaxf(b[e], 0.f); b[e] *= b[e]; }
                    *(u32x4*)(rowp + bj * HALF) = pack8f(a, b); } }
    }
};

struct EpiDown {
    static constexpr bool PERM = true, AFTER_DRAIN = false;
    float* Y; const bf16_t* X1B; const float* rstd2;
    __device__ __forceinline__ void operator()(const f32x4 (&acc)[2][2][4][2], const Unit& u, int wr, int wc, int fr, int fq) const {
#pragma unroll
        for (int ai = 0; ai < 2; ++ai)
#pragma unroll
            for (int m = 0; m < 4; ++m) {
                const int row = u.pm * BM + ai * HALF + wr * 64 + m * 16 + fr; const float r2 = rstd2[row];
#pragma unroll
                for (int bj = 0; bj < 2; ++bj) { const size_t o = (size_t)row * DM + u.pn * BM + bj * HALF + wc * 32 + 8 * fq;
                    const u32x4 xb = *(const u32x4*)(X1B + o);
                    const f32x4 a = {bflo(xb.x), bfhi(xb.x), bflo(xb.y), bfhi(xb.y)}, b = {bflo(xb.z), bfhi(xb.z), bflo(xb.w), bfhi(xb.w)};
                    *(f32x4*)(Y + o) = a + acc[ai][bj][m][0] * r2; *(f32x4*)(Y + o + 4) = b + acc[ai][bj][m][1] * r2; }
            }
    }
};
template <class Epi, class Sched, bool ALIGN_EPI = false, bool SP2 = false>
__device__ __forceinline__ void gemm_phase(PG8_LAS unsigned char* lds, const Gemm g, const Sched& S, const Epi& E) {
    const int tid = threadIdx.x, wid = __builtin_amdgcn_readfirstlane(tid >> 6), lane = tid & 63, wr = wid >> 2, wc = wid & 3, fr = lane & 15, fq = lane >> 4;
    const int K = g.K, nt = K / BK;
    unsigned voffA[2], voffB[2];
#pragma unroll
    for (int i = 0; i < 2; ++i) { int R, C; stage_rc(tid * 16 + i * 8192, R, C); const int Rb = Epi::PERM ? ((R & ~31) + perm32(R & 31)) : R;
        voffA[i] = (unsigned)(R * K + C) * 2u; voffB[i] = (unsigned)(Rb * K + C) * 2u; }
    const size_t kstep = (size_t)(BK * 2);
    const size_t hstep = (size_t)HALF * K * 2;
    const size_t tstep = 2 * hstep;
    const unsigned ldsw = (unsigned)wid * 1024u;
    const int aoff = lds_byte(wr * 64 + fr, fq * 8), boff = lds_byte(wc * 32 + fr, fq * 8);
#define PG8_SA(b, h) (((b) * 2 + (h)) * HTB)
#define PG8_SB(b, h) ((4 + (b) * 2 + (h)) * HTB)
#define PG8_STAGE(bufoff, gbase, voff) do { _Pragma("unroll") for (int _i = 0; _i < 2; ++_i) \
        __builtin_amdgcn_global_load_lds((const unsigned*)((const char*)(gbase) + (voff)[_i]), (PG8_LAS unsigned*)(lds + (bufoff) + ldsw + _i * 8192), 16, 0, 0); } while (0)
#define PG8_LDA(dst, b, h) do { _Pragma("unroll") for (int m = 0; m < 4; ++m) _Pragma("unroll") for (int k = 0; k < 2; ++k) dst[m][k] = *(const PG8_LAS bf16x8*)(lds + PG8_SA(b, h) + aoff + m * 2048 + k * 1024); } while (0)
#define PG8_LDB(dst, b, h) do { _Pragma("unroll") for (int n = 0; n < 2; ++n) _Pragma("unroll") for (int k = 0; k < 2; ++k) dst[n][k] = *(const PG8_LAS bf16x8*)(lds + PG8_SB(b, h) + boff + n * 2048 + k * 1024); } while (0)
#define PG8_MMA(ai, bj, At, Bt) do { __builtin_amdgcn_s_setprio(1); _Pragma("unroll") for (int m = 0; m < 4; ++m) _Pragma("unroll") for (int n = 0; n < 2; ++n) _Pragma("unroll") for (int k = 0; k < 2; ++k) \
        acc[ai][bj][m][n] = __builtin_amdgcn_mfma_f32_16x16x32_bf16(Bt[n][k], At[m][k], acc[ai][bj][m][n], 0, 0, 0); __builtin_amdgcn_s_setprio(0); } while (0)
#define PG8_WAIT_V(n) asm volatile("s_waitcnt vmcnt(" #n ")" ::: "memory")
#define PG8_WAIT_L(n) asm volatile("s_waitcnt lgkmcnt(" #n ")" ::: "memory")
#define PG8_BAR __builtin_amdgcn_s_barrier()
#define PG8_SCHED __builtin_amdgcn_sched_barrier(0)
    Unit cur, nxt; int ui = 0;
    if (!S.next(0, cur)) return;
    f32x4 acc[2][2][4][2];
#pragma unroll
    for (int a = 0; a < 2; ++a)
#pragma unroll
        for (int b = 0; b < 2; ++b)
#pragma unroll
            for (int m = 0; m < 4; ++m)
#pragma unroll
                for (int n = 0; n < 2; ++n) acc[a][b][m][n] = (f32x4){0.f, 0.f, 0.f, 0.f};
    bf16x8 At[4][2], B0[2][2], B1[2][2];
    const char* cA = (const char*)g.A + (size_t)cur.pm * tstep; const char* cB = (const char*)g.Bt + (size_t)cur.pn * tstep;
    S.a_ready(cur);
    if constexpr (SP2) {
        PG8_STAGE(PG8_SB(0, 0), cB, voffB); PG8_STAGE(PG8_SB(0, 1), cB + hstep, voffB); PG8_STAGE(PG8_SA(0, 0), cA, voffA); PG8_STAGE(PG8_SA(0, 1), cA + hstep, voffA);
        if (wr == 1) PG8_BAR;
        PG8_WAIT_V(2); PG8_BAR;
        PG8_STAGE(PG8_SB(1, 0), cB + kstep, voffB); PG8_STAGE(PG8_SA(1, 0), cA + kstep, voffA); PG8_STAGE(PG8_SB(1, 1), cB + hstep + kstep, voffB);
        PG8_WAIT_V(6); PG8_BAR;
    } else {
        PG8_STAGE(PG8_SB(0, 0), cB, voffB); PG8_STAGE(PG8_SA(0, 0), cA, voffA); PG8_STAGE(PG8_SB(0, 1), cB + hstep, voffB); PG8_STAGE(PG8_SA(0, 1), cA + hstep, voffA);
        if (wr == 1) PG8_BAR;
        PG8_WAIT_V(4); PG8_BAR;
        PG8_STAGE(PG8_SB(1, 0), cB + kstep, voffB); PG8_STAGE(PG8_SA(1, 0), cA + kstep, voffA); PG8_STAGE(PG8_SB(1, 1), cB + hstep + kstep, voffB);
        PG8_WAIT_V(6); PG8_BAR;
    }
    for (;;) {
        const bool has_next = S.next(ui + 1, nxt);
        const char* nA = has_next ? (const char*)g.A + (size_t)nxt.pm * tstep : cA; const char* nB = has_next ? (const char*)g.Bt + (size_t)nxt.pn * tstep : cB;
        for (int t = 0; t < nt; t += 2) {
            const bool last = (t == nt - 2);
            const char* a1 = cA + (size_t)(t + 1) * kstep;
            const char* a2 = last ? nA : cA + (size_t)(t + 2) * kstep; const char* b2 = last ? nB : cB + (size_t)(t + 2) * kstep;
            const char* a3 = a2 + kstep; const char* b3 = b2 + kstep;
            if (last && has_next) S.a_ready(nxt);
            if constexpr (SP2) {
            PG8_LDB(B0, 0, 0); PG8_LDB(B1, 0, 1); PG8_SCHED; PG8_LDA(At, 0, 0); PG8_STAGE(PG8_SA(1, 1), a1 + hstep, voffA);
            PG8_WAIT_V(8); PG8_WAIT_L(0); PG8_BAR; PG8_MMA(0, 0, At, B0); PG8_MMA(0, 1, At, B1); PG8_BAR; PG8_SCHED;
            PG8_LDA(At, 0, 1); PG8_STAGE(PG8_SB(0, 0), b2, voffB); PG8_STAGE(PG8_SB(0, 1), b2 + hstep, voffB); PG8_STAGE(PG8_SA(0, 0), a2, voffA);
            PG8_WAIT_V(8); PG8_WAIT_L(0); PG8_BAR; PG8_MMA(1, 0, At, B0); PG8_MMA(1, 1, At, B1); PG8_BAR; PG8_SCHED;
            PG8_LDB(B0, 1, 0); PG8_LDB(B1, 1, 1); PG8_SCHED; PG8_LDA(At, 1, 0); PG8_STAGE(PG8_SA(0, 1), a2 + hstep, voffA);
            PG8_WAIT_V(8); PG8_WAIT_L(0); PG8_BAR; PG8_MMA(0, 0, At, B0); PG8_MMA(0, 1, At, B1); PG8_BAR; PG8_SCHED;
            PG8_LDA(At, 1, 1); PG8_STAGE(PG8_SB(1, 0), b3, voffB); PG8_STAGE(PG8_SB(1, 1), b3 + hstep, voffB); PG8_STAGE(PG8_SA(1, 0), a3, voffA);
            PG8_WAIT_V(8); PG8_WAIT_L(0); PG8_BAR; PG8_MMA(1, 0, At, B0); PG8_MMA(1, 1, At, B1); PG8_BAR; PG8_SCHED;
            } else {
            PG8_LDB(B0, 0, 0); PG8_SCHED; PG8_LDA(At, 0, 0); PG8_STAGE(PG8_SA(1, 1), a1 + hstep, voffA);
            PG8_WAIT_L(8); PG8_BAR; PG8_WAIT_L(0); PG8_MMA(0, 0, At, B0); PG8_BAR; PG8_SCHED;
            PG8_LDB(B1, 0, 1); PG8_STAGE(PG8_SB(0, 0), b2, voffB);
            PG8_BAR; PG8_WAIT_L(0); PG8_MMA(0, 1, At, B1); PG8_BAR;
            PG8_LDA(At, 0, 1); PG8_STAGE(PG8_SA(0, 0), a2, voffA);
            PG8_BAR; PG8_WAIT_L(0); PG8_MMA(1, 0, At, B0); PG8_BAR; PG8_SCHED;
            PG8_STAGE(PG8_SB(0, 1), b2 + hstep, voffB);
            PG8_WAIT_V(6); PG8_BAR; PG8_MMA(1, 1, At, B1); PG8_BAR;
            PG8_LDB(B0, 1, 0); PG8_SCHED; PG8_LDA(At, 1, 0); PG8_STAGE(PG8_SA(0, 1), a2 + hstep, voffA);
            PG8_WAIT_L(8); PG8_BAR; PG8_WAIT_L(0); PG8_MMA(0, 0, At, B0); PG8_BAR; PG8_SCHED;
            PG8_LDB(B1, 1, 1); PG8_STAGE(PG8_SB(1, 0), b3, voffB);
            PG8_BAR; PG8_WAIT_L(0); PG8_MMA(0, 1, At, B1); PG8_BAR;
            PG8_LDA(At, 1, 1); PG8_STAGE(PG8_SA(1, 0), a3, voffA);
            PG8_BAR; PG8_WAIT_L(0); PG8_MMA(1, 0, At, B0); PG8_BAR; PG8_SCHED;
            PG8_STAGE(PG8_SB(1, 1), b3 + hstep, voffB);
            PG8_WAIT_V(6); PG8_BAR; PG8_MMA(1, 1, At, B1); PG8_BAR;
            }
        }
        if constexpr (ALIGN_EPI) { if (wr == 0) PG8_BAR; }
        if constexpr (!Epi::AFTER_DRAIN) { E(acc, cur, wr, wc, fr, fq); S.done(cur); }
        if (!has_next) break;
#pragma unroll
        for (int a = 0; a < 2; ++a)
#pragma unroll
            for (int b = 0; b < 2; ++b)
#pragma unroll
                for (int m = 0; m < 4; ++m)
#pragma unroll
                    for (int n = 0; n < 2; ++n) acc[a][b][m][n] = (f32x4){0.f, 0.f, 0.f, 0.f};
        cur = nxt; cA = nA; cB = nB; ++ui;
        if constexpr (ALIGN_EPI) { if (wr == 1) PG8_BAR; }
    }
    PG8_WAIT_V(0);
    if constexpr (!ALIGN_EPI) { if (wr == 0) PG8_BAR; }
    PG8_BAR;
    if constexpr (Epi::AFTER_DRAIN) { E.fused(acc, cur, wr, wc, fr, fq, lds, wid, lane); S.done(cur); }
#undef PG8_SA
#undef PG8_SB
#undef PG8_STAGE
#undef PG8_LDA
#undef PG8_LDB
#undef PG8_MMA
#undef PG8_WAIT_V
#undef PG8_WAIT_L
#undef PG8_BAR
#undef PG8_SCHED
}
}

using pg8::bf16_t; using pg8::bf16x8; using pg8::f32x4; using pg8::u32x4;
#define MFMA32(a, b, c) __builtin_amdgcn_mfma_f32_32x32x16_bf16((a), (b), (c), 0, 0, 0)
DI int crow(int reg, int h) { return (reg & 3) + 8 * (reg >> 2) + 4 * h; }
DI float wave_sum(float v) {
#pragma unroll
    for (int o = 1; o < 64; o <<= 1) v += __shfl_xor(v, o);
    return v;
}
DI float wave_max(float v) {
#pragma unroll
    for (int o = 1; o < 64; o <<= 1) v = fmaxf(v, __shfl_xor(v, o));
    return v;
}
DI bf16x8 pack8(const f32x16& x, int s) { u32x4 p; p.x = pk2(x[8 * s], x[8 * s + 1]); p.y = pk2(x[8 * s + 2], x[8 * s + 3]); p.z = pk2(x[8 * s + 4], x[8 * s + 5]); p.w = pk2(x[8 * s + 6], x[8 * s + 7]); return __builtin_bit_cast(bf16x8, p); }
DI bf16x8 cat4(s16x4 lo, s16x4 hi) { return __builtin_shufflevector(lo, hi, 0, 1, 2, 3, 4, 5, 6, 7); }
DI f32x16 zero16() { f32x16 z;
#pragma unroll
    for (int i = 0; i < 16; ++i) z[i] = 0.f;
    return z; }
DI float gamma_of(int h) { return 1.0f - exp2f(-5.0f - (float)h); }

constexpr size_t MiB = 1u << 20;
constexpr size_t WS_WIN = 1 * MiB;
constexpr size_t WS_WOUT = 23 * MiB;
constexpr size_t WS_WUP = 31 * MiB;
constexpr size_t WS_WDN = 63 * MiB;
constexpr size_t WS_H1 = 95 * MiB;
constexpr size_t WS_MIX = 128 * MiB;
constexpr size_t WS_PART = 161 * MiB;
constexpr size_t WS_RSTD2 = 163 * MiB;
constexpr size_t WS_Z = 164 * MiB;
constexpr size_t WS_KV = 252 * MiB;
constexpr size_t WS_SP = 316 * MiB;
constexpr size_t WS_U = 164 * MiB;
constexpr size_t WS_END = 348 * MiB;
static_assert(WS_Z + (size_t)MP * INW * 2 <= WS_KV && WS_U + (size_t)MP * FF * 2 <= WS_END && WS_H1 + (size_t)MP * DM * 2 <= WS_MIX && WS_MIX + (size_t)MP * DM * 2 <= WS_PART, "ws map");
constexpr int LDS_BYTES = 147456;

constexpr size_t O_Y = 0, O_KP = (size_t)MR * DM, O_VP = O_KP + 16384, O_SP = O_VP + 16384, O_KS = O_SP + 262144, O_VS = O_KS + 2097152, O_SS = O_VS + 2097152, O_END = O_SS + 33554432;

struct TItem { const float* W; bf16_t* WT; int K, N, item; const float* rs; };
DI void p0_load(const TItem& t, f32x4 (&v)[8], int lane) {
    const int nblk = t.N / 32, kb = t.item / nblk, nb = t.item % nblk, k0 = 64 * kb, n0 = 32 * nb, c = lane & 7, rr = lane >> 3;
#pragma unroll
    for (int i = 0; i < 8; ++i) v[i] = __builtin_nontemporal_load((const f32x4*)(t.W + (size_t)(k0 + 8 * i + rr) * t.N + n0 + 4 * c));
    if (t.rs) {
#pragma unroll
        for (int i = 0; i < 8; ++i) v[i] = v[i] * t.rs[k0 + 8 * i + rr];
    }
}
DI void p0_store(const TItem& t, const f32x4 (&v)[8], LAS float* scr, int lane) {
    const int nblk = t.N / 32, kb = t.item / nblk, nb = t.item % nblk, k0 = 64 * kb, n0 = 32 * nb, c = lane & 7, rr = lane >> 3;
#pragma unroll
    for (int i = 0; i < 8; ++i) { LAS float* d = scr + (8 * i + rr) * 33 + 4 * c; d[0] = v[i][0]; d[1] = v[i][1]; d[2] = v[i][2]; d[3] = v[i][3]; }
    asm volatile("s_waitcnt lgkmcnt(0)" ::: "memory");
#pragma unroll
    for (int j = 0; j < 4; ++j) { const int n = (lane >> 3) + 8 * j; const LAS float* s = scr + (8 * c) * 33 + n;
        u32x4 o; o.x = pk2(s[0 * 33], s[1 * 33]); o.y = pk2(s[2 * 33], s[3 * 33]); o.z = pk2(s[4 * 33], s[5 * 33]); o.w = pk2(s[6 * 33], s[7 * 33]);
        *(u32x4*)(t.WT + (size_t)(n0 + n) * t.K + k0 + 8 * c) = o; }
    asm volatile("s_waitcnt lgkmcnt(0)" ::: "memory");
}
struct ResIn { const float* w; bf16_t* wt; DI TItem operator()(int it) const { return TItem{w, wt, DM, INW, it, nullptr}; } };
struct ResRest { const float* w_out; const float* w_up; const float* w_dn; bf16_t* WOUT; bf16_t* WUP; bf16_t* WDN; const float* g2;
    DI TItem operator()(int it) const { constexpr int I_OUT = (DM / 64) * (DM / 32), I_UP = (DM / 64) * (FF / 32); int r = it;
        if (r < I_OUT) return TItem{w_out, WOUT, DM, DM, r, nullptr}; r -= I_OUT;
        if (r < I_UP) return TItem{w_up, WUP, DM, FF, r, g2}; r -= I_UP;
        return TItem{w_dn, WDN, FF, DM, r, nullptr}; } };
template <class Resolve>
DI void p0_convert(const Resolve R, int first, int stride, int total, LAS float* scr, int lane) {
    for (int it = first; it < total; it += 2 * stride) {
        const bool two = it + stride < total;
        const TItem t0 = R(it), t1 = R(two ? it + stride : it);
        f32x4 v0[8], v1[8];
        p0_load(t0, v0, lane);
        if (two) p0_load(t1, v1, lane);
        p0_store(t0, v0, scr, lane);
        if (two) p0_store(t1, v1, scr + 64 * 33, lane);
    }
}
DI void rms_row(const float* xrow, const float* g, bf16_t* orow, int lane) {
    f32x4 v[8]; float s = 0.f;
#pragma unroll
    for (int j = 0; j < 8; ++j) { v[j] = *((const f32x4*)xrow + lane + 64 * j); s += (v[j][0] * v[j][0] + v[j][1] * v[j][1]) + (v[j][2] * v[j][2] + v[j][3] * v[j][3]); }
    const float rstd = rsqrtf(wave_sum(s) * (1.0f / DM) + EPS);
#pragma unroll
    for (int j = 0; j < 8; ++j) { const f32x4 gg = *((const f32x4*)g + lane + 64 * j); u32x2 o; o.x = pk2(v[j][0] * rstd * gg[0], v[j][1] * rstd * gg[1]); o.y = pk2(v[j][2] * rstd * gg[2], v[j][3] * rstd * gg[3]);
        *((u32x2*)orow + lane + 64 * j) = o; }
}

DI void stage_T128x256(LAS unsigned char* img, const bf16_t* src, int tid) {
#pragma unroll
    for (int k = 0; k < 4; ++k) {
        const int it = k * 512 + tid, dgl = it & 3, tpl = (it >> 2) & 15, rest = it >> 6, dg = dgl + 4 * (rest & 7), tp = tpl + 16 * (rest >> 3);
        const bf16_t* p = src + (size_t)(2 * tp) * INW + dg * 8;
        const u32x4 a = *(const u32x4*)p, b = *(const u32x4*)(p + INW);
#pragma unroll
        for (int e = 0; e < 8; ++e) {
            const unsigned lo = (e & 1) ? (a[e >> 1] >> 16) : (a[e >> 1] & 0xffffu), hi = (e & 1) ? (b[e >> 1] & 0xffff0000u) : (b[e >> 1] << 16);
            *(LAS unsigned*)(img + (dg * 8 + e) * 264 + tp * 4) = lo | hi;
        }
    }
}

DI void ret_step1(LAS unsigned char* lds, const bf16_t* Z, bf16_t* KV, int n, int h, int tid) {
    LAS unsigned char* Kt = lds; LAS unsigned char* Vt = lds + 256 * 264;
    const int lane = tid & 63, wid = tid >> 6, r = lane & 31, hh = lane >> 5;
    stage_T128x256(Kt, Z + (size_t)(n * 128) * INW + C_RK + h * 256, tid);
    stage_T128x256(Vt, Z + (size_t)(n * 128) * INW + C_RV + h * 256, tid);
    __syncthreads();
    f32x16 acc[8];
#pragma unroll
    for (int i = 0; i < 8; ++i) acc[i] = zero16();
    const int dk0 = wid * 32;
#pragma unroll 2
    for (int s = 0; s < 8; ++s) {
        const LAS unsigned char* pa = Kt + (dk0 + r) * 264 + (16 * s + 8 * hh) * 2;
        const bf16x8 A = cat4(*(const LAS s16x4*)pa, *(const LAS s16x4*)(pa + 8));
#pragma unroll
        for (int dt = 0; dt < 8; ++dt) {
            const LAS unsigned char* pb = Vt + (dt * 32 + r) * 264 + (16 * s + 8 * hh) * 2;
            const bf16x8 B = cat4(*(const LAS s16x4*)pb, *(const LAS s16x4*)(pb + 8));
            acc[dt] = MFMA32(A, B, acc[dt]);
        }
    }
    bf16_t* out = KV + ((size_t)(n * 4 + h) * 256) * 256 + dk0 + 4 * hh;
#pragma unroll
    for (int dt = 0; dt < 8; ++dt)
#pragma unroll
        for (int g4 = 0; g4 < 4; ++g4) { u32x2 o; o.x = pk2(acc[dt][4 * g4], acc[dt][4 * g4 + 1]); o.y = pk2(acc[dt][4 * g4 + 2], acc[dt][4 * g4 + 3]);
            *(u32x2*)(out + (size_t)(dt * 32 + r) * 256 + 8 * g4) = o; }
    __syncthreads();
}

DI void ret_scan(const bf16_t* KV, bf16_t* SP, float* o_state, int gt, int nthreads) {
    for (int e = gt; e < 65536; e += nthreads) {
        const int h = e >> 14, dv = (e >> 6) & 255, dk4 = (e & 63) * 4;
        const float lg = log1pf(-exp2f(-5.0f - (float)h)), Dc = __expf(128.0f * lg), c1 = __expf(127.0f * lg);
        const size_t base = ((size_t)(h * 256 + dv)) * 256 + dk4;
        f32x4 s = {0.f, 0.f, 0.f, 0.f};
        for (int n0 = 0; n0 < 64; n0 += 32) {
            u32x2 q[32];
#pragma unroll
            for (int u = 0; u < 32; ++u) q[u] = *(const u32x2*)(KV + (size_t)(n0 + u) * 262144 + base);
#pragma unroll
            for (int u = 0; u < 32; ++u) { u32x2 o; o.x = pk2(s[0], s[1]); o.y = pk2(s[2], s[3]); *(u32x2*)(SP + (size_t)(n0 + u) * 262144 + base) = o;
                const f32x4 kv = {bflo(q[u].x), bfhi(q[u].x), bflo(q[u].y), bfhi(q[u].y)}; s = s * Dc + kv * c1; }
        }
#pragma unroll
        for (int j = 0; j < 4; ++j) o_state[((size_t)(h * 256 + dk4 + j)) * 256 + dv] = s[j];
    }
}

DI float silu_f(float x) { return x / (1.0f + __expf(-x)); }

DI void ret_step2(LAS unsigned char* lds, const bf16_t* Z, const bf16_t* SP, bf16_t* MIX, const float* rng, int n, int h, int tid) {
    LAS unsigned char* Kr = lds; LAS unsigned char* Vt = lds + 128 * 528; LAS float* red = (LAS float*)(lds + 128 * 528 + 256 * 264);
    const int lane = tid & 63, wid = tid >> 6, r = lane & 31, hh = lane >> 5;
    const bf16_t* zc = Z + (size_t)(n * 128) * INW;
#pragma unroll
    for (int k = 0; k < 8; ++k) { const int it = k * 512 + tid, row = it >> 5, c = it & 31;
        *(LAS u32x4*)(Kr + row * 528 + c * 16) = *(const u32x4*)(zc + (size_t)row * INW + C_RK + h * 256 + c * 8); }
    stage_T128x256(Vt, zc + C_RV + h * 256, tid);
    const int it_ = wid >> 1, dh = wid & 1;
    bf16x8 qf[16];
    { const bf16_t* qp = zc + (size_t)(32 * it_ + r) * INW + C_RQ + h * 256 + 8 * hh;
#pragma unroll
      for (int s = 0; s < 16; ++s) qf[s] = *(const bf16x8*)(qp + 16 * s); }
    f32x16 acc[4];
#pragma unroll
    for (int i = 0; i < 4; ++i) acc[i] = zero16();
    const float gm = gamma_of(h);
    __syncthreads();
    for (int jt = 0; jt <= it_; ++jt) {
        f32x16 X = zero16();
#pragma unroll
        for (int s = 0; s < 16; ++s) { const bf16x8 A = *(const LAS bf16x8*)(Kr + (32 * jt + r) * 528 + (16 * s + 8 * hh) * 2); X = MFMA32(A, qf[s], X); }
        if (jt == it_) {
#pragma unroll
            for (int i = 0; i < 16; ++i) X[i] = (crow(i, hh) > r) ? 0.f : X[i];
        }
#pragma unroll
        for (int s2 = 0; s2 < 2; ++s2) { const bf16x8 xs = pack8(X, s2);
#pragma unroll
            for (int dt = 0; dt < 4; ++dt) { const LAS unsigned char* pa = Vt + (128 * dh + 32 * dt + r) * 264 + (32 * jt + 16 * s2 + 4 * hh) * 2;
                const bf16x8 A = cat4(*(const LAS s16x4*)pa, *(const LAS s16x4*)(pa + 16)); acc[dt] = MFMA32(A, xs, acc[dt]); } }
    }
    { const float ig = 1.0f / gm;
#pragma unroll
      for (int dt = 0; dt < 4; ++dt) acc[dt] = acc[dt] * ig; }
    __syncthreads();
    { const bf16_t* spg = SP + (size_t)(n * 4 + h) * 65536;
#pragma unroll 1
      for (int k0 = 0; k0 < 16; k0 += 4) {
          u32x4 spr[4];
#pragma unroll
          for (int k = 0; k < 4; ++k) { const int it = (k0 + k) * 512 + tid; spr[k] = *(const u32x4*)(spg + (size_t)(it >> 5) * 256 + (it & 31) * 8); }
#pragma unroll
          for (int k = 0; k < 4; ++k) { const int it = (k0 + k) * 512 + tid; *(LAS u32x4*)(lds + (it >> 5) * 528 + (it & 31) * 16) = spr[k]; }
      } }
    __syncthreads();
#pragma unroll
    for (int dt = 0; dt < 4; ++dt)
#pragma unroll
        for (int s = 0; s < 16; ++s) { const bf16x8 A = *(const LAS bf16x8*)(lds + (128 * dh + 32 * dt + r) * 528 + (16 * s + 8 * hh) * 2); acc[dt] = MFMA32(A, qf[s], acc[dt]); }
#pragma unroll
    for (int dt = 0; dt < 4; ++dt) acc[dt] = acc[dt] * gm;
    float ss = 0.f;
#pragma unroll
    for (int dt = 0; dt < 4; ++dt)
#pragma unroll
        for (int i = 0; i < 16; ++i) ss += acc[dt][i] * acc[dt][i];
    ss += __shfl_xor(ss, 32);
    if (hh == 0) red[wid * 32 + r] = ss;
    __syncthreads();
    const float rstd = rsqrtf((red[wid * 32 + r] + red[(wid ^ 1) * 32 + r]) * (1.0f / 256.0f) + EPS);
    const size_t token = (size_t)n * 128 + 32 * it_ + r;
#pragma unroll
    for (int dt = 0; dt < 4; ++dt)
#pragma unroll
        for (int g4 = 0; g4 < 4; ++g4) {
            const int dv = 128 * dh + 32 * dt + 8 * g4 + 4 * hh;
            const u32x2 gz = *(const u32x2*)(Z + token * INW + C_RG + h * 256 + dv);
            const f32x4 gn = *(const f32x4*)(rng + h * 256 + dv);
            const float y0 = acc[dt][4 * g4 + 0] * rstd * gn[0] * silu_f(bflo(gz.x)), y1 = acc[dt][4 * g4 + 1] * rstd * gn[1] * silu_f(bfhi(gz.x));
            const float y2 = acc[dt][4 * g4 + 2] * rstd * gn[2] * silu_f(bflo(gz.y)), y3 = acc[dt][4 * g4 + 3] * rstd * gn[3] * silu_f(bfhi(gz.y));
            u32x2 o; o.x = pk2(y0, y1); o.y = pk2(y2, y3);
            *(u32x2*)(MIX + token * DM + 1024 + h * 256 + dv) = o;
        }
    __syncthreads();
}

DI void ret_decode_unit(LAS unsigned char* lds, const bf16_t* Z, const float* S0, float* S1, bf16_t* MIX, const float* rng, int b, int h, int tid) {
    LAS float* qv = (LAS float*)lds; LAS float* red = qv + 768;
    const int lane = tid & 63, wid = tid >> 6;
    const bf16_t* zrow = Z + (size_t)(LP + b) * INW;
    if (tid < 256) { qv[tid] = bf2f(zrow[C_RQ + h * 256 + tid]); qv[256 + tid] = bf2f(zrow[C_RK + h * 256 + tid]); qv[512 + tid] = bf2f(zrow[C_RV + h * 256 + tid]); }
    __syncthreads();
    const float gm = gamma_of(h);
    const f32x4 v4 = *(const LAS f32x4*)(qv + 512 + 4 * lane);
    f32x4 acc = {0.f, 0.f, 0.f, 0.f};
    const size_t off = ((size_t)(b * 4 + h) * 256 + wid * 32) * 256 + 4 * lane;
    const float* s0 = S0 + off; float* s1 = S1 + off;
#pragma unroll 1
    for (int rr = 0; rr < 32; rr += 16) {
        f32x4 s[16];
#pragma unroll
        for (int u = 0; u < 16; ++u) s[u] = __builtin_nontemporal_load((const f32x4*)(s0 + (size_t)(rr + u) * 256));
#pragma unroll
        for (int u = 0; u < 16; ++u) { const int dk = wid * 32 + rr + u; const float kk = qv[256 + dk], qq = qv[dk];
            const f32x4 sn = s[u] * gm + v4 * kk; __builtin_nontemporal_store(sn, (f32x4*)(s1 + (size_t)(rr + u) * 256)); acc += sn * qq; }
    }
    *(LAS f32x4*)(red + wid * 256 + 4 * lane) = acc;
    __syncthreads();
    if (wid == 0) {
        f32x4 o = {0.f, 0.f, 0.f, 0.f};
#pragma unroll
        for (int w = 0; w < 8; ++w) o += *(const LAS f32x4*)(red + w * 256 + 4 * lane);
        const float ssq = wave_sum((o[0] * o[0] + o[1] * o[1]) + (o[2] * o[2] + o[3] * o[3]));
        const float rstd = rsqrtf(ssq * (1.0f / 256.0f) + EPS);
        const u32x2 gz = *(const u32x2*)(zrow + C_RG + h * 256 + 4 * lane);
        const f32x4 gn = *(const f32x4*)(rng + h * 256 + 4 * lane);
        u32x2 y; y.x = pk2(o[0] * rstd * gn[0] * silu_f(bflo(gz.x)), o[1] * rstd * gn[1] * silu_f(bfhi(gz.x)));
        y.y = pk2(o[2] * rstd * gn[2] * silu_f(bflo(gz.y)), o[3] * rstd * gn[3] * silu_f(bfhi(gz.y)));
        *(u32x2*)(MIX + (size_t)(LP + b) * DM + 1024 + h * 256 + 4 * lane) = y;
    }
    __syncthreads();
}

DI void attn_prompt_unit(LAS unsigned char* lds, const bf16_t* Z, bf16_t* MIX, const float* gq, const float* gk, const float* sinks, float* o_k, float* o_v, int nb, int kh, int hf, int tid) {
    LAS unsigned char* Kn = lds; LAS unsigned char* Vt = lds + 256 * 144;
    const int lane = tid & 63, wid = tid >> 6, r = lane & 31, hh = lane >> 5;
    {
        const int row = tid >> 1, half = tid & 1; const int tok = (nb - 1) * 128 + row;
        u32x4 v[4];
#pragma unroll
        for (int c = 0; c < 4; ++c) v[c] = (u32x4){0u, 0u, 0u, 0u};
        if (tok >= 0) {
#pragma unroll
            for (int c = 0; c < 4; ++c) v[c] = *(const u32x4*)(Z + (size_t)tok * INW + C_AK + kh * 64 + half * 32 + c * 8);
        }
        float f[32]; float ss = 0.f;
#pragma unroll
        for (int c = 0; c < 4; ++c)
#pragma unroll
            for (int e = 0; e < 4; ++e) { f[c * 8 + 2 * e] = bflo(v[c][e]); f[c * 8 + 2 * e + 1] = bfhi(v[c][e]); }
#pragma unroll
        for (int e = 0; e < 32; ++e) ss += f[e] * f[e];
        ss += __shfl_xor(ss, 1);
        const float rstd = rsqrtf(ss * (1.0f / 64.0f) + EPS);
#pragma unroll
        for (int c = 0; c < 8; ++c) { const f32x4 g = *(const f32x4*)(gk + half * 32 + c * 4);
#pragma unroll
            for (int e = 0; e < 4; ++e) f[c * 4 + e] *= rstd * g[e]; }
#pragma unroll
        for (int c = 0; c < 4; ++c) { u32x4 w; w.x = pk2(f[c * 8], f[c * 8 + 1]); w.y = pk2(f[c * 8 + 2], f[c * 8 + 3]); w.z = pk2(f[c * 8 + 4], f[c * 8 + 5]); w.w = pk2(f[c * 8 + 6], f[c * 8 + 7]);
            *(LAS u32x4*)(Kn + row * 144 + half * 64 + c * 16) = w; }
        if (nb == 63 && hf == 0 && row >= 128) { float* o = o_k + ((size_t)(row - 128) * 2 + kh) * 64 + half * 32;
#pragma unroll
            for (int c = 0; c < 8; ++c) *(f32x4*)(o + c * 4) = (f32x4){f[c * 4], f[c * 4 + 1], f[c * 4 + 2], f[c * 4 + 3]}; }
    }
#pragma unroll
    for (int k = 0; k < 2; ++k) {
        const int it = k * 512 + tid, kpl = it & 15, dgl = (it >> 4) & 3, rest = it >> 6, dg = dgl + 4 * (rest & 1), kp = kpl + 16 * (rest >> 1);
        const int tok0 = (nb - 1) * 128 + 2 * kp;
        u32x4 a = {0u, 0u, 0u, 0u}, b = {0u, 0u, 0u, 0u};
        if (tok0 >= 0) { const bf16_t* p = Z + (size_t)tok0 * INW + C_AV + kh * 64 + dg * 8; a = *(const u32x4*)p; b = *(const u32x4*)(p + INW); }
#pragma unroll
        for (int e = 0; e < 8; ++e) {
            const unsigned lo = (e & 1) ? (a[e >> 1] >> 16) : (a[e >> 1] & 0xffffu), hi = (e & 1) ? (b[e >> 1] & 0xffff0000u) : (b[e >> 1] << 16);
            *(LAS unsigned*)(Vt + (dg * 8 + e) * 520 + kp * 4) = lo | hi;
        }
        if (nb == 63 && hf == 0 && kp >= 64) { float* o = o_v + ((size_t)(2 * kp - 128) * 2 + kh) * 64 + dg * 8;
#pragma unroll
            for (int e = 0; e < 4; ++e) { o[2 * e] = bflo(a[e]); o[2 * e + 1] = bfhi(a[e]); o[128 + 2 * e] = bflo(b[e]); o[128 + 2 * e + 1] = bfhi(b[e]); } }
    }
    __syncthreads();
    const int hq = kh * 8 + 4 * hf + (wid >> 1), qh = wid & 1;
    const float sink = sinks[hq];
#pragma unroll 1
    for (int qq = 0; qq < 2; ++qq) {
        const int qi = 2 * qh + qq; const size_t tokq = (size_t)nb * 128 + 32 * qi + r;
        bf16x8 qf[4];
        {   const bf16_t* qp = Z + tokq * INW + hq * 64 + 8 * hh;
            u32x4 raw[4]; float ss = 0.f;
#pragma unroll
            for (int s = 0; s < 4; ++s) { raw[s] = *(const u32x4*)(qp + 16 * s);
#pragma unroll
                for (int e = 0; e < 4; ++e) { const float lo = bflo(raw[s][e]), hi = bfhi(raw[s][e]); ss += lo * lo + hi * hi; } }
            ss += __shfl_xor(ss, 32);
            const float rstd = rsqrtf(ss * (1.0f / 64.0f) + EPS) * 0.125f;
#pragma unroll
            for (int s = 0; s < 4; ++s) { const f32x4 g0 = *(const f32x4*)(gq + 16 * s + 8 * hh), g1 = *(const f32x4*)(gq + 16 * s + 8 * hh + 4); u32x4 w;
                w.x = pk2(bflo(raw[s].x) * rstd * g0[0], bfhi(raw[s].x) * rstd * g0[1]); w.y = pk2(bflo(raw[s].y) * rstd * g0[2], bfhi(raw[s].y) * rstd * g0[3]);
                w.z = pk2(bflo(raw[s].z) * rstd * g1[0], bfhi(raw[s].z) * rstd * g1[1]); w.w = pk2(bflo(raw[s].w) * rstd * g1[2], bfhi(raw[s].w) * rstd * g1[3]);
                qf[s] = __builtin_bit_cast(bf16x8, w); }
        }
        f32x16 X[5];
#pragma unroll
        for (int t = 0; t < 5; ++t) { X[t] = zero16();
#pragma unroll
            for (int s = 0; s < 4; ++s) { const bf16x8 A = *(const LAS bf16x8*)(Kn + (32 * (qi + t) + r) * 144 + (16 * s + 8 * hh) * 2); X[t] = MFMA32(A, qf[s], X[t]); } }
        const int ii = 32 * qi + r;
        float m = -1e30f;
#pragma unroll
        for (int t = 0; t < 5; ++t)
#pragma unroll
            for (int i = 0; i < 16; ++i) { const int jj = 32 * (qi + t) + crow(i, hh); const bool ok = (jj >= ii) && (jj <= ii + 128) && (nb > 0 || jj >= 128);
                X[t][i] = ok ? X[t][i] : -1e30f; m = fmaxf(m, X[t][i]); }
        m = fmaxf(m, __shfl_xor(m, 32)); m = fmaxf(m, sink);
        float sum = 0.f;
#pragma unroll
        for (int t = 0; t < 5; ++t)
#pragma unroll
            for (int i = 0; i < 16; ++i) { const float p = __expf(X[t][i] - m); X[t][i] = p; sum += p; }
        sum += __shfl_xor(sum, 32);
        const float inv = 1.0f / (sum + __expf(sink - m));
        f32x16 o[2]; o[0] = zero16(); o[1] = zero16();
#pragma unroll
        for (int t = 0; t < 5; ++t)
#pragma unroll
            for (int s2 = 0; s2 < 2; ++s2) { const bf16x8 xs = pack8(X[t], s2);
#pragma unroll
                for (int dt = 0; dt < 2; ++dt) { const LAS unsigned char* pa = Vt + (32 * dt + r) * 520 + (32 * (qi + t) + 16 * s2 + 4 * hh) * 2;
                    const bf16x8 A = cat4(*(const LAS s16x4*)pa, *(const LAS s16x4*)(pa + 16)); o[dt] = MFMA32(A, xs, o[dt]); } }
#pragma unroll
        for (int dt = 0; dt < 2; ++dt)
#pragma unroll
            for (int g4 = 0; g4 < 4; ++g4) { u32x2 w; w.x = pk2(o[dt][4 * g4] * inv, o[dt][4 * g4 + 1] * inv); w.y = pk2(o[dt][4 * g4 + 2] * inv, o[dt][4 * g4 + 3] * inv);
                *(u32x2*)(MIX + tokq * DM + hq * 64 + 32 * dt + 8 * g4 + 4 * hh) = w; }
    }
    __syncthreads();
}

DI void attn_decode_unit(LAS unsigned char* lds, const bf16_t* Z, const float* ck, const float* cv, bf16_t* MIX, const float* gq, const float* gk, const float* sinks, float* o_k, float* o_v, int b, int kh, int tid) {
    LAS float* Kc = (LAS float*)lds; LAS float* Vc = Kc + 129 * 65; LAS float* qs = Vc + 129 * 64; LAS float* pw = qs + 512;
    const int lane = tid & 63, wid = tid >> 6;
#pragma unroll
    for (int k = 0; k < 4; ++k) {
        const int it = k * 512 + tid, w = it >> 4, c4 = (it & 15) * 4;
        const size_t src = ((size_t)(b * 128 + w) * 2 + kh) * 64 + c4;
        const f32x4 k4 = *(const f32x4*)(ck + src), v4 = *(const f32x4*)(cv + src);
#pragma unroll
        for (int e = 0; e < 4; ++e) { Kc[w * 65 + c4 + e] = k4[e]; Vc[w * 64 + c4 + e] = v4[e]; }
        if (w >= 1) { const size_t dst = ((size_t)(b * 128 + w - 1) * 2 + kh) * 64 + c4; *(f32x4*)(o_k + dst) = k4; *(f32x4*)(o_v + dst) = v4; }
    }
    const bf16_t* zrow = Z + (size_t)(LP + b) * INW;
    const size_t dnew = ((size_t)(b * 128 + 127) * 2 + kh) * 64 + lane;
    if (wid == 0) { const float kx = bf2f(zrow[C_AK + kh * 64 + lane]); const float ss = wave_sum(kx * kx); const float kn = kx * rsqrtf(ss * (1.0f / 64.0f) + EPS) * gk[lane];
        Kc[128 * 65 + lane] = kn; o_k[dnew] = kn; }
    if (wid == 1) { const float vx = bf2f(zrow[C_AV + kh * 64 + lane]); Vc[128 * 64 + lane] = vx; o_v[dnew] = vx; }
    const int hq = kh * 8 + wid;
    { const float qx = bf2f(zrow[hq * 64 + lane]); const float ss = wave_sum(qx * qx); qs[wid * 64 + lane] = qx * rsqrtf(ss * (1.0f / 64.0f) + EPS) * gq[lane] * 0.125f; }
    __syncthreads();
    float s1 = 0.f, s2 = 0.f;
#pragma unroll 8
    for (int d = 0; d < 64; ++d) { const float q = qs[wid * 64 + d]; s1 += q * Kc[lane * 65 + d]; s2 += q * Kc[(lane + 64) * 65 + d]; }
    const float s3 = wave_sum(qs[wid * 64 + lane] * Kc[128 * 65 + lane]);
    const float sink = sinks[hq];
    const float m = fmaxf(wave_max(fmaxf(s1, s2)), fmaxf(s3, sink));
    const float p1 = __expf(s1 - m), p2 = __expf(s2 - m), p3 = __expf(s3 - m);
    const float denom = wave_sum(p1 + p2) + p3 + __expf(sink - m);
    pw[wid * 132 + lane] = p1; pw[wid * 132 + 64 + lane] = p2; if (lane == 0) pw[wid * 132 + 128] = p3;
    __syncthreads();
    float o = 0.f;
#pragma unroll 3
    for (int j = 0; j < 129; ++j) o += pw[wid * 132 + j] * Vc[j * 64 + lane];
    MIX[(size_t)(LP + b) * DM + hq * 64 + lane] = (bf16_t)(pk2(o / denom, 0.f) & 0xffffu);
    __syncthreads();
}

template <int MT, class Epi>
DI void skinny_unit(LAS unsigned char* lds, const bf16_t* A, const bf16_t* Wt, int K, int cgi, int k0, int row0, const Epi& E, int tid) {
    const int lane = tid & 63, wid = tid >> 6, fr = lane & 15, fq = lane >> 4;
    const int c0 = cgi * 32;
    constexpr int NMT = 2 * MT;
    const bf16_t* pa = A + (size_t)(row0 + fr) * K + k0 + wid * 256 + 8 * fq;
    const bf16_t* pb = Wt + (size_t)(c0 + fr) * K + k0 + wid * 256 + 8 * fq;
    const size_t rs = (size_t)16 * K;
    f32x4 acc[NMT][2];
#pragma unroll
    for (int i = 0; i < NMT; ++i) { acc[i][0] = (f32x4){0.f, 0.f, 0.f, 0.f}; acc[i][1] = (f32x4){0.f, 0.f, 0.f, 0.f}; }
    bf16x8 fb[3][2], fa[3][NMT];
#define SK_LOAD(buf, c) do { _Pragma("unroll") for (int nt = 0; nt < 2; ++nt) fb[buf][nt] = *(const bf16x8*)(pb + nt * rs + 32 * (c)); \
        _Pragma("unroll") for (int mt = 0; mt < NMT; ++mt) fa[buf][mt] = *(const bf16x8*)(pa + mt * rs + 32 * (c)); } while (0)
#define SK_MMA(buf) do { _Pragma("unroll") for (int mt = 0; mt < NMT; ++mt) _Pragma("unroll") for (int nt = 0; nt < 2; ++nt) \
        acc[mt][nt] = __builtin_amdgcn_mfma_f32_16x16x32_bf16(fa[buf][mt], fb[buf][nt], acc[mt][nt], 0, 0, 0); } while (0)
    SK_LOAD(0, 0); SK_LOAD(1, 1);
    SK_LOAD(2, 2); SK_MMA(0);
    SK_LOAD(0, 3); SK_MMA(1);
    SK_LOAD(1, 4); SK_MMA(2);
    SK_LOAD(2, 5); SK_MMA(0);
    SK_LOAD(0, 6); SK_MMA(1);
    SK_LOAD(1, 7); SK_MMA(2);
    SK_MMA(0); SK_MMA(1);
#undef SK_LOAD
#undef SK_MMA
    constexpr int NR = 32 * MT;
    LAS float* red = (LAS float*)lds;
#pragma unroll
    for (int mt = 0; mt < NMT; ++mt)
#pragma unroll
        for (int nt = 0; nt < 2; ++nt)
#pragma unroll
            for (int j = 0; j < 4; ++j) red[(wid * NR + mt * 16 + 4 * fq + j) * 32 + nt * 16 + fr] = acc[mt][nt][j];
    __syncthreads();
    if (MT == 4) {
        const int row = tid >> 2, c8 = (tid & 3) * 8;
        f32x4 sa = {0.f, 0.f, 0.f, 0.f}, sb = {0.f, 0.f, 0.f, 0.f};
#pragma unroll
        for (int w = 0; w < 8; ++w) { sa += *(const LAS f32x4*)(red + (w * NR + row) * 32 + c8); sb += *(const LAS f32x4*)(red + (w * NR + row) * 32 + c8 + 4); }
        E(row0 + row, c0 + c8, sa); E(row0 + row, c0 + c8 + 4, sb);
    } else if (tid < 8 * NR) {
        const int row = tid >> 3, c4 = (tid & 7) * 4;
        f32x4 sa = {0.f, 0.f, 0.f, 0.f};
#pragma unroll
        for (int w = 0; w < 8; ++w) sa += *(const LAS f32x4*)(red + (w * NR + row) * 32 + c4);
        E(row0 + row, c0 + c4, sa);
    }
    __syncthreads();
}
struct SkOut { const float* xs; float* X1s; bf16_t* XBs;
    DI void operator()(int row, int col, f32x4 a) const { const f32x4 v = a + *(const f32x4*)(xs + (size_t)row * DM + col); *(f32x4*)(X1s + (size_t)row * DM + col) = v;
        u32x2 o; o.x = pk2(v[0], v[1]); o.y = pk2(v[2], v[3]); *(u32x2*)(XBs + (size_t)row * DM + col) = o; } };
struct SkUp { bf16_t* Us;
    DI void operator()(int row, int col, f32x4 a) const {
#pragma unroll
        for (int e = 0; e < 4; ++e) { a[e] = fmaxf(a[e], 0.f); a[e] *= a[e]; }
        u32x2 o; o.x = pk2(a[0], a[1]); o.y = pk2(a[2], a[3]); *(u32x2*)(Us + (size_t)row * FF + col) = o; } };
struct SkSlab { float* slab;
    DI void operator()(int row, int col, f32x4 a) const { *(f32x4*)(slab + (size_t)row * DM + col) = a; } };

#define RLX_AGENT __ATOMIC_RELAXED, __HIP_MEMORY_SCOPE_AGENT
#define XB_TMO      128
#define XB_XCNT(j)  (256  + 64 * (j))
#define XB_XSUB(j)  (1280 + 64 * (j))
#define XB_XGEN(j)  (2304 + 64 * (j))
#define XB_TOP      3328
#define XB_TOPGEN   3392
#define XCD_BAR_WORDS 3456
#define XB_SPIN_CAP (1u << 18)

__device__ __forceinline__ unsigned xb_ld(unsigned* p)              { return __hip_atomic_load(p, __ATOMIC_RELAXED, __HIP_MEMORY_SCOPE_AGENT); }
__device__ __forceinline__ unsigned xb_add(unsigned* p, unsigned v) { return __hip_atomic_fetch_add(p, v, __ATOMIC_RELAXED, __HIP_MEMORY_SCOPE_AGENT); }
__device__ __forceinline__ unsigned xb_xcc_id() { return (unsigned)__builtin_amdgcn_s_getreg((3 << 11) | 20) & 0xFu; }
#define XB_SPIN(cond, bar) do { unsigned _sp = 0; while (cond) { __builtin_amdgcn_s_sleep(1); \
    if ((++_sp & 255u) == 0u) { if (xb_ld(&(bar)[XB_TMO])) break; if (_sp > XB_SPIN_CAP) { atomicAdd(&(bar)[XB_TMO], 1u); break; } } } } while (0)

struct XcdBarrier {
    unsigned* bar; unsigned x;
    volatile LAS unsigned* st;
};

__device__ __forceinline__ XcdBarrier xcd_barrier_post(unsigned* bar, volatile LAS unsigned* st) {
    XcdBarrier b; b.bar = bar; b.x = xb_xcc_id(); b.st = st;
    if (threadIdx.x == 0) (void)xb_add(&bar[XB_XCNT(b.x)], 1u);
    return b;
}
__device__ __forceinline__ void xcd_barrier_complete(unsigned* bar, unsigned x, unsigned& nloc, unsigned& nx) {
    const unsigned G = gridDim.x * gridDim.y * gridDim.z;
    unsigned sum, cnt, mine, sp = 0u;
    for (;;) {
        sum = 0u; cnt = 0u; mine = 0u;
#pragma unroll
        for (unsigned j = 0; j < 16; ++j) { const unsigned c = xb_ld(&bar[XB_XCNT(j)]); sum += c; cnt += (c > 0u) ? 1u : 0u; mine = (j == x) ? c : mine; }
        if (sum == G) break;
        __builtin_amdgcn_s_sleep(1);
        if ((++sp & 255u) == 0u) { if (xb_ld(&bar[XB_TMO])) break; if (sp > XB_SPIN_CAP) { atomicAdd(&bar[XB_TMO], 1u); break; } }
    }
    nloc = mine > 0u ? mine : 1u; nx = cnt > 0u ? cnt : 1u;
}

__device__ __forceinline__ void xcd_barrier(const XcdBarrier& b) {
    asm volatile("s_waitcnt vmcnt(0)" ::: "memory");
    __syncthreads();
    if (threadIdx.x == 0) {
        unsigned* bar = b.bar;
        __builtin_amdgcn_s_waitcnt(0);
        unsigned nloc = b.st[0], nx = b.st[1];
        if (nloc == 0u) { xcd_barrier_complete(bar, b.x, nloc, nx); b.st[0] = nloc; b.st[1] = nx; }
        const unsigned old = xb_add(&bar[XB_XSUB(b.x)], 1u);
        const unsigned gen = old / nloc;
        if (old + 1u == (gen + 1u) * nloc) {
            __builtin_amdgcn_fence(__ATOMIC_RELEASE, "agent");
            asm volatile("s_waitcnt vmcnt(0)" ::: "memory");
            const unsigned og = xb_add(&bar[XB_TOP], 1u);
            const unsigned tg = og / nx;
            if (og + 1u == (tg + 1u) * nx) xb_add(&bar[XB_TOPGEN], 1u);
            else XB_SPIN(xb_ld(&bar[XB_TOPGEN]) == tg, bar);
            __builtin_amdgcn_fence(__ATOMIC_ACQUIRE, "agent");
            xb_add(&bar[XB_XGEN(b.x)], 1u);
            asm volatile("s_waitcnt vmcnt(0)" ::: "memory");
        } else {
            XB_SPIN(xb_ld(&bar[XB_XGEN(b.x)]) == gen, bar);
            __builtin_amdgcn_fence(__ATOMIC_ACQUIRE, "agent");
            asm volatile("s_waitcnt vmcnt(0)" ::: "memory");
        }
    }
    __syncthreads();
}

struct Args { const float* in[15]; float* out; unsigned char* ws; int ph_lo, ph_hi; };
constexpr int NPH = 9;
constexpr int NP0_REST = 9216;

__global__ void __launch_bounds__(512, 2) fwd_kernel(Args a) {
    extern __shared__ __attribute__((aligned(16))) unsigned char lds_raw[];
    LAS unsigned char* lds = (LAS unsigned char*)lds_raw;
    cg::grid_group grid = cg::this_grid();
    const int tid = threadIdx.x, lane = tid & 63, wid = __builtin_amdgcn_readfirstlane(tid >> 6);
    const int G = gridDim.x, bx = blockIdx.x;
    unsigned char* ws = a.ws; float* out = a.out;
    const float* x_p = a.in[0]; const float* x_s = a.in[1]; const float* cache_k = a.in[2]; const float* cache_v = a.in[3]; const float* state0 = a.in[4];
    const float* ln1_g = a.in[5]; const float* w_in = a.in[6]; const float* gq = a.in[7]; const float* gk = a.in[8]; const float* sinks = a.in[9];
    const float* rng = a.in[10]; const float* w_out = a.in[11]; const float* ln2_g = a.in[12]; const float* w_up = a.in[13]; const float* w_dn = a.in[14];
    bf16_t* WIN = (bf16_t*)(ws + WS_WIN); bf16_t* WOUT = (bf16_t*)(ws + WS_WOUT); bf16_t* WUP = (bf16_t*)(ws + WS_WUP); bf16_t* WDN = (bf16_t*)(ws + WS_WDN);
    bf16_t* H1 = (bf16_t*)(ws + WS_H1); bf16_t* XG = H1; bf16_t* MIX = (bf16_t*)(ws + WS_MIX); bf16_t* Z = (bf16_t*)(ws + WS_Z); bf16_t* U = (bf16_t*)(ws + WS_U);
    float* PART = (float*)(ws + WS_PART); float* RSTD2 = (float*)(ws + WS_RSTD2); bf16_t* KV = (bf16_t*)(ws + WS_KV); bf16_t* SP = (bf16_t*)(ws + WS_SP); float* SLAB = (float*)(ws + WS_SP);
    const int lo = a.ph_lo, hi = a.ph_hi;
#define IN(k) (lo <= (k) && (k) < hi)
    volatile LAS unsigned* MISC = (volatile LAS unsigned*)(lds + LDS_BYTES - 64);
    if (tid < 16) MISC[tid] = 0u;
    __syncthreads();
    const XcdBarrier bar = xcd_barrier_post((unsigned*)ws + 1024, MISC + 8);
    if (lo > hi) grid.sync();
#define SEAM(k) do { if (IN(k) && IN((k) + 1)) xcd_barrier(bar); } while (0)

    if (IN(0)) for (int rep_ = 0; rep_ < 1 + ((DUPMASK >> 0) & 1); ++rep_) { if (rep_) xcd_barrier(bar);
        LAS float* scr = (LAS float*)(lds + wid * 17408);
        const int gw = bx * 8 + wid, NGW = G * 8;
        constexpr int I_IN = (DM / 64) * (INW / 32);
        p0_convert(ResIn{w_in, WIN}, gw, NGW, I_IN, scr, lane);
        for (int m = gw; m < MP; m += NGW) {
            if (m < MR) rms_row(m < LP ? x_p + (size_t)m * DM : x_s + (size_t)(m - LP) * DM, ln1_g, H1 + (size_t)m * DM, lane);
            else {
#pragma unroll
                for (int j = 0; j < 8; ++j) *((u32x2*)(H1 + (size_t)m * DM) + lane + 64 * j) = (u32x2){0u, 0u};
            }
        }
    }
    SEAM(0);
    if (IN(1)) for (int rep_ = 0; rep_ < 1 + ((DUPMASK >> 1) & 1); ++rep_) { if (rep_) xcd_barrier(bar);
        pg8::Gemm g{H1, WIN, MP, INW, DM}; pg8::StaticOrder S; S.init(MP, INW, G, bx, WGM_IN);
        pg8::EpiIn E{Z};
        pg8::gemm_phase<pg8::EpiIn, pg8::StaticOrder, true, true>(lds, g, S, E);
        {
            constexpr int NT = (MP / 256) * (INW / 256); const int rounds = (NT + G - 1) / G, first_idle = NT - (rounds - 1) * G;
            const int nidle = (first_idle < G) ? (G - first_idle) : G, me = (first_idle < G) ? (bx - first_idle) : bx;
            if (me >= 0) {
                LAS float* scr = (LAS float*)(lds + wid * 17408);
                constexpr int I_OUT = (DM / 64) * (DM / 32), I_UP = (DM / 64) * (FF / 32), I_DN = (FF / 64) * (DM / 32);
                p0_convert(ResRest{w_out, w_up, w_dn, WOUT, WUP, WDN, ln2_g}, NP0_REST + me * 8 + wid, nidle * 8, I_OUT + I_UP + I_DN, scr, lane);
            }
        }
    }
    SEAM(1);
    if (IN(2)) for (int rep_ = 0; rep_ < 1 + ((DUPMASK >> 2) & 1); ++rep_) { if (rep_) xcd_barrier(bar);
        if (bx & 1) for (int u = bx; u < 256; u += G) ret_decode_unit(lds, Z, state0, out + O_SS, MIX, rng, u >> 2, u & 3, tid);
        for (int u = bx; u < 256; u += G) ret_step1(lds, Z, KV, u >> 2, u & 3, tid);
        if (!(bx & 1)) for (int u = bx; u < 256; u += G) ret_decode_unit(lds, Z, state0, out + O_SS, MIX, rng, u >> 2, u & 3, tid);
    }
    SEAM(2);
    if (IN(3)) for (int rep_ = 0; rep_ < 1 + ((DUPMASK >> 3) & 1); ++rep_) { if (rep_) xcd_barrier(bar);
        if (tid < 256) ret_scan(KV, SP, out + O_SP, bx * 256 + tid, G * 256);
        if (bx & 1) for (int u = bx; u < 256; u += G) attn_decode_unit(lds, Z, cache_k, cache_v, MIX, gq, gk, sinks, out + O_KS, out + O_VS, u >> 1, u & 1, tid);
        for (int u = 256 + bx; u < 512; u += G) ret_decode_unit(lds, Z, state0, out + O_SS, MIX, rng, u >> 2, u & 3, tid);
        if (!(bx & 1)) for (int u = bx; u < 256; u += G) attn_decode_unit(lds, Z, cache_k, cache_v, MIX, gq, gk, sinks, out + O_KS, out + O_VS, u >> 1, u & 1, tid);
    }
    SEAM(3);
    if (IN(4)) for (int rep_ = 0; rep_ < 1 + ((DUPMASK >> 4) & 1); ++rep_) { if (rep_) xcd_barrier(bar);
        for (int u = bx; u < 256; u += G) ret_step2(lds, Z, SP, MIX, rng, u >> 2, u & 3, tid);
        for (int u = bx; u < 256; u += G) attn_prompt_unit(lds, Z, MIX, gq, gk, sinks, out + O_KP, out + O_VP, u >> 2, (u >> 1) & 1, u & 1, tid);
        {
            LAS float* scr = (LAS float*)(lds + wid * 17408);
            p0_convert(ResRest{w_out, w_up, w_dn, WOUT, WUP, WDN, ln2_g}, bx * 8 + wid, G * 8, NP0_REST, scr, lane);
        }
    }
    SEAM(4);
    if (IN(5)) for (int rep_ = 0; rep_ < 1 + ((DUPMASK >> 5) & 1); ++rep_) { if (rep_) xcd_barrier(bar);
        pg8::Gemm g{MIX, WOUT, LP, DM, DM}; pg8::StaticOrder S; S.init(LP, DM, G, bx, WGM_OUT);
        pg8::EpiOut E{x_p, XG, PART};
        pg8::gemm_phase<pg8::EpiOut, pg8::StaticOrder, true, true>(lds, g, S, E);
        const SkOut SE{x_s, out + O_Y + (size_t)LP * DM, XG + (size_t)LP * DM};
        for (int u = bx; u < 4 * (DM / 32); u += G) skinny_unit<1>(lds, MIX + (size_t)LP * DM, WOUT, DM, u >> 2, 0, (u & 3) * 32, SE, tid);
    }
    SEAM(5);
    if (IN(6)) for (int rep_ = 0; rep_ < 1 + ((DUPMASK >> 6) & 1); ++rep_) { if (rep_) xcd_barrier(bar);
        for (int row = bx + G * tid; row < LP; row += G * 512) { float s = 0.f;
#pragma unroll
            for (int j = 0; j < 8; ++j) { const f32x4 p = *(const f32x4*)(PART + (size_t)row * 32 + 4 * j); s += (p[0] + p[1]) + (p[2] + p[3]); }
            RSTD2[row] = 1.0f / (s * (1.0f / DM) + EPS); }
        for (int row = LP + bx * 8 + wid; row < MR; row += G * 8) {
            const float* xr = out + O_Y + (size_t)row * DM; float s = 0.f;
#pragma unroll
            for (int j = 0; j < 8; ++j) { const f32x4 v = *((const f32x4*)xr + lane + 64 * j); s += (v[0] * v[0] + v[1] * v[1]) + (v[2] * v[2] + v[3] * v[3]); }
            s = wave_sum(s); if (lane == 0) RSTD2[row] = 1.0f / (s * (1.0f / DM) + EPS); }
        pg8::Gemm g{XG, WUP, LP, FF, DM}; pg8::StaticOrder S; S.init(LP, FF, G, bx, WGM_UP);
        pg8::EpiUp E{U};
        pg8::gemm_phase<pg8::EpiUp, pg8::StaticOrder, true, true>(lds, g, S, E);
        const SkUp SE{U + (size_t)LP * FF};
        for (int u = bx; u < FF / 32; u += G) skinny_unit<4>(lds, XG + (size_t)LP * DM, WUP, DM, u, 0, 0, SE, tid);
    }
    SEAM(6);
    if (IN(7)) {
        if (bx & 1) for (int u = bx; u < 4 * (DM / 32); u += G) { const SkSlab SE{SLAB + (size_t)(u & 3) * NS * DM}; skinny_unit<4>(lds, U + (size_t)LP * FF, WDN, FF, u >> 2, (u & 3) * 2048, 0, SE, tid); }
        pg8::Gemm g{U, WDN, LP, DM, FF}; pg8::StaticOrder S; S.init(LP, DM, G, bx, WGM_DN);
        pg8::EpiDown E{out + O_Y, XG, RSTD2};
        pg8::gemm_phase<pg8::EpiDown, pg8::StaticOrder, true, true>(lds, g, S, E);
        if (!(bx & 1)) for (int u = bx; u < 4 * (DM / 32); u += G) { const SkSlab SE{SLAB + (size_t)(u & 3) * NS * DM}; skinny_unit<4>(lds, U + (size_t)LP * FF, WDN, FF, u >> 2, (u & 3) * 2048, 0, SE, tid); }
    }
    SEAM(7);
    if (IN(8)) {
        for (int e = bx * 512 + tid; e < NS * DM / 4; e += G * 512) {
            const int row = e >> 9; float* p = out + O_Y + (size_t)LP * DM + (size_t)e * 4;
            const f32x4 s = (*(const f32x4*)(SLAB + (size_t)e * 4) + *(const f32x4*)(SLAB + (size_t)NS * DM + (size_t)e * 4)) + (*(const f32x4*)(SLAB + (size_t)2 * NS * DM + (size_t)e * 4) + *(const f32x4*)(SLAB + (size_t)3 * NS * DM + (size_t)e * 4));
            *(f32x4*)p = *(const f32x4*)p + s * RSTD2[LP + row];
        }
    }
#undef IN
#undef SEAM
}

#ifndef N_LAUNCHES
#define N_LAUNCHES 1
#endif
extern "C" void kernel_launch(void* const* d_in, const int* in_sizes, int n_in, void* d_out, int out_size, void* d_ws, size_t ws_size, hipStream_t stream) {
    static int grid = 0;
    if (grid == 0) {
        if (n_in != 15 || (size_t)out_size != O_END || ws_size < WS_END) { fprintf(stderr, "kernel_launch: unexpected shapes (n_in %d out %d ws %zu)\n", n_in, out_size, ws_size); grid = -1; return; }
        int dev = 0, cus = 0, per_cu = 0;
        (void)hipGetDevice(&dev); (void)hipDeviceGetAttribute(&cus, hipDeviceAttributeMultiprocessorCount, dev);
        if (hipFuncSetAttribute((const void*)fwd_kernel, hipFuncAttributeMaxDynamicSharedMemorySize, LDS_BYTES) != hipSuccess) { fprintf(stderr, "kernel_launch: hipFuncSetAttribute failed\n"); grid = -1; return; }
        (void)hipOccupancyMaxActiveBlocksPerMultiprocessor(&per_cu, (const void*)fwd_kernel, 512, LDS_BYTES);
        (void)hipGetLastError();
        if (per_cu < 1) { fprintf(stderr, "kernel_launch: occupancy query says %d blocks per CU\n", per_cu); }
        grid = cus > 0 ? cus : 256;
    }
    if (grid < 0) return;
    if (hipMemsetAsync(d_ws, 0, 65536, stream) != hipSuccess) { fprintf(stderr, "kernel_launch: memset failed\n"); return; }
    Args a{};
    for (int i = 0; i < 15; ++i) a.in[i] = (const float*)d_in[i];
    a.out = (float*)d_out; a.ws = (unsigned char*)d_ws;
    if (N_LAUNCHES == 1) {
        a.ph_lo = 0; a.ph_hi = NPH;
        void* args[] = {&a};
        hipError_t e = hipLaunchCooperativeKernel((const void*)fwd_kernel, dim3(grid), dim3(512), args, LDS_BYTES, stream);
        if (e != hipSuccess) fprintf(stderr, "cooperative launch failed: %s (grid %d)\n", hipGetErrorString(e), grid);
    } else {
        for (int p = 0; p < NPH; ++p) { a.ph_lo = p; a.ph_hi = p + 1; hipLaunchKernelGGL(fwd_kernel, dim3(grid), dim3(512), LDS_BYTES, stream, a); }
    }
}
```

```cpp
#include <hip/hip_runtime.h>
#include <hip/hip_cooperative_groups.h>
#include <cstdio>
#include <cstdint>
namespace cg = cooperative_groups;

#ifndef WGM_IN
#define WGM_IN 2
#endif
#ifndef WGM_OUT
#define WGM_OUT 2
#endif
#ifndef WGM_UP
#define WGM_UP 2
#endif
#ifndef WGM_DN
#define WGM_DN 2
#endif
#ifndef DUPMASK
#define DUPMASK 0
#endif
#define DI __device__ __forceinline__
#define LAS __attribute__((address_space(3)))
typedef float f32x2 __attribute__((ext_vector_type(2)));
typedef float f32x16 __attribute__((ext_vector_type(16)));
typedef short s16x4 __attribute__((ext_vector_type(4)));
typedef unsigned u32x2 __attribute__((ext_vector_type(2)));
typedef __bf16 bf16x2v __attribute__((ext_vector_type(2)));

constexpr int DM = 2048, LP = 8192, NS = 128, MR = LP + NS  , MP = 8448  ;
constexpr int INW = 5376, FF = 8192;
constexpr int C_AQ = 0, C_AK = 1024, C_AV = 1152, C_RQ = 1280, C_RK = 2304, C_RV = 3328, C_RG = 4352;
constexpr float EPS = 1e-6f;

DI unsigned pk2(float lo, float hi) { f32x2 v = {lo, hi}; return __builtin_bit_cast(unsigned, __builtin_convertvector(v, bf16x2v)); }
DI float bflo(unsigned u) { return __uint_as_float(u << 16); }
DI float bfhi(unsigned u) { return __uint_as_float(u & 0xffff0000u); }
DI float bf2f(unsigned short u) { return __uint_as_float(((unsigned)u) << 16); }

namespace pg8 {
#define PG8_LAS __attribute__((address_space(3)))
typedef unsigned short bf16_t;
typedef short bf16x8 __attribute__((ext_vector_type(8)));
typedef float f32x4 __attribute__((ext_vector_type(4)));
typedef unsigned u32x4 __attribute__((ext_vector_type(4)));
constexpr int BM = 256, BK = 64, HALF = 128, HTB = HALF * BK * 2  , STAGE_BYTES = 8 * HTB, NXCD = 8, WGM = 8;

__host__ __device__ __forceinline__ int lds_byte(int r, int c) { const int st = (r >> 4) * 2 + (c >> 5), rr = r & 15, cc = c & 31, ob = rr * 64 + cc * 2; return st * 1024 + (ob ^ (((ob >> 9) & 1) << 5)); }
__host__ __device__ __forceinline__ void stage_rc(int b, int& R, int& C) { const int st = b / 1024, sb = b % 1024, swz = sb ^ (((sb >> 9) & 1) << 5); R = (st >> 1) * 16 + swz / 64; C = (st & 1) * 32 + (swz % 64) / 2; }
__host__ __device__ __forceinline__ int perm32(int rho) { const int n = rho >> 4, i = rho & 15; return 8 * (i >> 2) + 4 * n + (i & 3); }

struct Unit { int pm, pn; };
struct Gemm { const bf16_t* A; const bf16_t* Bt; int M, N, K; };

struct StaticOrder {
    int nM, nN, nwg, G, c, wgm;
    __host__ __device__ void init(int M, int N, int G_, int c_, int wgm_) { nM = M / BM; nN = N / BM; nwg = nM * nN; G = G_; c = c_; wgm = wgm_; }
    __host__ __device__ bool next(int i, Unit& u) const {
        const long L = (long)i * G + c; if (L >= nwg) return false;
        int wgid = (int)L; { const int q = nwg / NXCD, r = nwg % NXCD, xcd = wgid % NXCD, off = wgid / NXCD; wgid = (xcd < r ? xcd * (q + 1) : r * (q + 1) + (xcd - r) * q) + off; }
        const int nig = wgm * nN, gid = wgid / nig, fm = gid * wgm, gsz = (nM - fm) < wgm ? (nM - fm) : wgm;
        u.pm = fm + ((wgid % nig) % gsz); u.pn = (wgid % nig) / gsz; return true;
    }
    __device__ __forceinline__ void a_ready(const Unit&) const {}
    __device__ __forceinline__ void done(const Unit&) const {}
};


DI u32x4 pack8f(const f32x4& a, const f32x4& b) { u32x4 w; w.x = pk2(a[0], a[1]); w.y = pk2(a[2], a[3]); w.z = pk2(b[0], b[1]); w.w = pk2(b[2], b[3]); return w; }

struct EpiIn {
    static constexpr bool PERM = true, AFTER_DRAIN = false;
    bf16_t* Z;
    __device__ __forceinline__ void operator()(const f32x4 (&acc)[2][2][4][2], const Unit& u, int wr, int wc, int fr, int fq) const {
        const int row0 = u.pm * BM + wr * 64 + fr, col0 = u.pn * BM + wc * 32 + 8 * fq;
        if (u.pn < 5 || u.pn > 12) {
#pragma unroll
            for (int ai = 0; ai < 2; ++ai)
#pragma unroll
                for (int m = 0; m < 4; ++m) { bf16_t* rowp = Z + (size_t)(row0 + ai * HALF + m * 16) * INW + col0;
#pragma unroll
                    for (int bj = 0; bj < 2; ++bj) *(u32x4*)(rowp + bj * HALF) = pack8f(acc[ai][bj][m][0], acc[ai][bj][m][1]); }
        } else {
            const int head = (u.pn - 5) & 3; const bool isk = u.pn >= 9;
            const float lg = log1pf(-exp2f(-5.0f - (float)head));
            float inv[8];
#pragma unroll
            for (int j = 0; j < 8; ++j) inv[j] = powf(10000.0f, -(float)(wc * 32 + 8 * fq + j) * (1.0f / 128.0f));
#pragma unroll
            for (int ai = 0; ai < 2; ++ai)
#pragma unroll
                for (int m = 0; m < 4; ++m) {
                    const int row = row0 + ai * HALF + m * 16;
                    const int pos = row < LP ? row : LP; const float t = row < LP ? (float)(row & 127) : 0.0f;
                    const float f = isk ? 0.0625f * __expf(-lg * t) : __expf(lg * t);
                    f32x4 o1[2], o2[2];
#pragma unroll
                    for (int n = 0; n < 2; ++n)
#pragma unroll
                        for (int e = 0; e < 4; ++e) {
                            const float ang = (float)pos * inv[n * 4 + e];
                            double rev = (double)ang * 0.15915494309189535; rev -= floor(rev);
                            const float fr_ = (float)rev; const float sn = __builtin_amdgcn_sinf(fr_), cs = __builtin_amdgcn_cosf(fr_);
                            const float x1 = acc[ai][0][m][n][e], x2 = acc[ai][1][m][n][e];
                            o1[n][e] = (x1 * cs - x2 * sn) * f; o2[n][e] = (x2 * cs + x1 * sn) * f;
                        }
                    bf16_t* rowp = Z + (size_t)row * INW + col0;
                    *(u32x4*)(rowp) = pack8f(o1[0], o1[1]); *(u32x4*)(rowp + HALF) = pack8f(o2[0], o2[1]);
                }
        }
    }
};

struct EpiOut {
    static constexpr bool PERM = true, AFTER_DRAIN = false;
    const float* xp; bf16_t* X1B; float* part;
    __device__ __forceinline__ void operator()(const f32x4 (&acc)[2][2][4][2], const Unit& u, int wr, int wc, int fr, int fq) const {
#pragma unroll
        for (int ai = 0; ai < 2; ++ai)
#pragma unroll
            for (int m = 0; m < 4; ++m) {
                const int row = u.pm * BM + ai * HALF + wr * 64 + m * 16 + fr;
                const float* xrow = xp + (size_t)row * DM;
                float ss = 0.f;
#pragma unroll
                for (int bj = 0; bj < 2; ++bj) {
                    const int col = u.pn * BM + bj * HALF + wc * 32 + 8 * fq;
                    const f32x4 v0 = acc[ai][bj][m][0] + *(const f32x4*)(xrow + col), v1 = acc[ai][bj][m][1] + *(const f32x4*)(xrow + col + 4);
                    ss += (v0[0] * v0[0] + v0[1] * v0[1]) + (v0[2] * v0[2] + v0[3] * v0[3]) + (v1[0] * v1[0] + v1[1] * v1[1]) + (v1[2] * v1[2] + v1[3] * v1[3]);
                    *(u32x4*)(X1B + (size_t)row * DM + col) = pack8f(v0, v1);
                }
                ss += __shfl_xor(ss, 16); ss += __shfl_xor(ss, 32);
                if (fq == 0) part[(size_t)row * 32 + u.pn * 4 + wc] = ss;
            }
    }
};

struct EpiUp {
    static constexpr bool PERM = true, AFTER_DRAIN = false;
    bf16_t* U;
    __device__ __forceinline__ void operator()(const f32x4 (&acc)[2][2][4][2], const Unit& u, int wr, int wc, int fr, int fq) const {
        const int row0 = u.pm * BM + wr * 64 + fr, col0 = u.pn * BM + wc * 32 + 8 * fq;
#pragma unroll
        for (int ai = 0; ai < 2; ++ai)
#pragma unroll
            for (int m = 0; m < 4; ++m) { bf16_t* rowp = U + (size_t)(row0 + ai * HALF + m * 16) * FF + col0;
#pragma unroll
                for (int bj = 0; bj < 2; ++bj) { f32x4 a = acc[ai][bj][m][0], b = acc[ai][bj][m][1];
#pragma unroll
                    for (int e = 0; e < 4; ++e) { a[e] = fmaxf(a[e], 0.f); a[e] *= a[e]; b[e] = fmaxf(b[e], 0.f); b[e] *= b[e]; }
                    *(u32x4*)(rowp + bj * HALF) = pack8f(a, b); } }
    }
};

struct EpiDown {
    static constexpr bool PERM = true, AFTER_DRAIN = false;
    float* Y; const bf16_t* X1B; const float* rstd2;
    __device__ __forceinline__ void operator()(const f32x4 (&acc)[2][2][4][2], const Unit& u, int wr, int wc, int fr, int fq) const {
#pragma unroll
        for (int ai = 0; ai < 2; ++ai)
#pragma unroll
            for (int m = 0; m < 4; ++m) {
                const int row = u.pm * BM + ai * HALF + wr * 64 + m * 16 + fr; const float r2 = rstd2[row];
#pragma unroll
                for (int bj = 0; bj < 2; ++bj) { const size_t o = (size_t)row * DM + u.pn * BM + bj * HALF + wc * 32 + 8 * fq;
                    const u32x4 xb = *(const u32x4*)(X1B + o);
                    const f32x4 a = {bflo(xb.x), bfhi(xb.x), bflo(xb.y), bfhi(xb.y)}, b = {bflo(xb.z), bfhi(xb.z), bflo(xb.w), bfhi(xb.w)};
                    *(f32x4*)(Y + o) = a + acc[ai][bj][m][0] * r2; *(f32x4*)(Y + o + 4) = b + acc[ai][bj][m][1] * r2; }
            }
    }
};
template <class Epi, class Sched, bool ALIGN_EPI = false, bool SP2 = false>
__device__ __forceinline__ void gemm_phase(PG8_LAS unsigned char* lds, const Gemm g, const Sched& S, const Epi& E) {
    const int tid = threadIdx.x, wid = __builtin_amdgcn_readfirstlane(tid >> 6), lane = tid & 63, wr = wid >> 2, wc = wid & 3, fr = lane & 15, fq = lane >> 4;
    const int K = g.K, nt = K / BK;
    unsigned voffA[2], voffB[2];
#pragma unroll
    for (int i = 0; i < 2; ++i) { int R, C; stage_rc(tid * 16 + i * 8192, R, C); const int Rb = Epi::PERM ? ((R & ~31) + perm32(R & 31)) : R;
        voffA[i] = (unsigned)(R * K + C) * 2u; voffB[i] = (unsigned)(Rb * K + C) * 2u; }
    const size_t kstep = (size_t)(BK * 2);
    const size_t hstep = (size_t)HALF * K * 2;
    const size_t tstep = 2 * hstep;
    const unsigned ldsw = (unsigned)wid * 1024u;
    const int aoff = lds_byte(wr * 64 + fr, fq * 8), boff = lds_byte(wc * 32 + fr, fq * 8);
#define PG8_SA(b, h) (((b) * 2 + (h)) * HTB)
#define PG8_SB(b, h) ((4 + (b) * 2 + (h)) * HTB)
#define PG8_STAGE(bufoff, gbase, voff) do { _Pragma("unroll") for (int _i = 0; _i < 2; ++_i) \
        __builtin_amdgcn_global_load_lds((const unsigned*)((const char*)(gbase) + (voff)[_i]), (PG8_LAS unsigned*)(lds + (bufoff) + ldsw + _i * 8192), 16, 0, 0); } while (0)
#define PG8_LDA(dst, b, h) do { _Pragma("unroll") for (int m = 0; m < 4; ++m) _Pragma("unroll") for (int k = 0; k < 2; ++k) dst[m][k] = *(const PG8_LAS bf16x8*)(lds + PG8_SA(b, h) + aoff + m * 2048 + k * 1024); } while (0)
#define PG8_LDB(dst, b, h) do { _Pragma("unroll") for (int n = 0; n < 2; ++n) _Pragma("unroll") for (int k = 0; k < 2; ++k) dst[n][k] = *(const PG8_LAS bf16x8*)(lds + PG8_SB(b, h) + boff + n * 2048 + k * 1024); } while (0)
#define PG8_MMA(ai, bj, At, Bt) do { __builtin_amdgcn_s_setprio(1); _Pragma("unroll") for (int m = 0; m < 4; ++m) _Pragma("unroll") for (int n = 0; n < 2; ++n) _Pragma("unroll") for (int k = 0; k < 2; ++k) \
        acc[ai][bj][m][n] = __builtin_amdgcn_mfma_f32_16x16x32_bf16(Bt[n][k], At[m][k], acc[ai][bj][m][n], 0, 0, 0); __builtin_amdgcn_s_setprio(0); } while (0)
#define PG8_WAIT_V(n) asm volatile("s_waitcnt vmcnt(" #n ")" ::: "memory")
#define PG8_WAIT_L(n) asm volatile("s_waitcnt lgkmcnt(" #n ")" ::: "memory")
#define PG8_BAR __builtin_amdgcn_s_barrier()
#define PG8_SCHED __builtin_amdgcn_sched_barrier(0)
    Unit cur, nxt; int ui = 0;
    if (!S.next(0, cur)) return;
    f32x4 acc[2][2][4][2];
#pragma unroll
    for (int a = 0; a < 2; ++a)
#pragma unroll
        for (int b = 0; b < 2; ++b)
#pragma unroll
            for (int m = 0; m < 4; ++m)
#pragma unroll
                for (int n = 0; n < 2; ++n) acc[a][b][m][n] = (f32x4){0.f, 0.f, 0.f, 0.f};
    bf16x8 At[4][2], B0[2][2], B1[2][2];
    const char* cA = (const char*)g.A + (size_t)cur.pm * tstep; const char* cB = (const char*)g.Bt + (size_t)cur.pn * tstep;
    S.a_ready(cur);
    if constexpr (SP2) {
        PG8_STAGE(PG8_SB(0, 0), cB, voffB); PG8_STAGE(PG8_SB(0, 1), cB + hstep, voffB); PG8_STAGE(PG8_SA(0, 0), cA, voffA); PG8_STAGE(PG8_SA(0, 1), cA + hstep, voffA);
        if (wr == 1) PG8_BAR;
        PG8_WAIT_V(2); PG8_BAR;
        PG8_STAGE(PG8_SB(1, 0), cB + kstep, voffB); PG8_STAGE(PG8_SA(1, 0), cA + kstep, voffA); PG8_STAGE(PG8_SB(1, 1), cB + hstep + kstep, voffB);
        PG8_WAIT_V(6); PG8_BAR;
    } else {
        PG8_STAGE(PG8_SB(0, 0), cB, voffB); PG8_STAGE(PG8_SA(0, 0), cA, voffA); PG8_STAGE(PG8_SB(0, 1), cB + hstep, voffB); PG8_STAGE(PG8_SA(0, 1), cA + hstep, voffA);
        if (wr == 1) PG8_BAR;
        PG8_WAIT_V(4); PG8_BAR;
        PG8_STAGE(PG8_SB(1, 0), cB + kstep, voffB); PG8_STAGE(PG8_SA(1, 0), cA + kstep, voffA); PG8_STAGE(PG8_SB(1, 1), cB + hstep + kstep, voffB);
        PG8_WAIT_V(6); PG8_BAR;
    }
    for (;;) {
        const bool has_next = S.next(ui + 1, nxt);
        const char* nA = has_next ? (const char*)g.A + (size_t)nxt.pm * tstep : cA; const char* nB = has_next ? (const char*)g.Bt + (size_t)nxt.pn * tstep : cB;
        for (int t = 0; t < nt; t += 2) {
            const bool last = (t == nt - 2);
            const char* a1 = cA + (size_t)(t + 1) * kstep;
            const char* a2 = last ? nA : cA + (size_t)(t + 2) * kstep; const char* b2 = last ? nB : cB + (size_t)(t + 2) * kstep;
            const char* a3 = a2 + kstep; const char* b3 = b2 + kstep;
            if (last && has_next) S.a_ready(nxt);
            if constexpr (SP2) {
            PG8_LDB(B0, 0, 0); PG8_LDB(B1, 0, 1); PG8_SCHED; PG8_LDA(At, 0, 0); PG8_STAGE(PG8_SA(1, 1), a1 + hstep, voffA);
            PG8_WAIT_V(8); PG8_WAIT_L(0); PG8_BAR; PG8_MMA(0, 0, At, B0); PG8_MMA(0, 1, At, B1); PG8_BAR; PG8_SCHED;
            PG8_LDA(At, 0, 1); PG8_STAGE(PG8_SB(0, 0), b2, voffB); PG8_STAGE(PG8_SB(0, 1), b2 + hstep, voffB); PG8_STAGE(PG8_SA(0, 0), a2, voffA);
            PG8_WAIT_V(8); PG8_WAIT_L(0); PG8_BAR; PG8_MMA(1, 0, At, B0); PG8_MMA(1, 1, At, B1); PG8_BAR; PG8_SCHED;
            PG8_LDB(B0, 1, 0); PG8_LDB(B1, 1, 1); PG8_SCHED; PG8_LDA(At, 1, 0); PG8_STAGE(PG8_SA(0, 1), a2 + hstep, voffA);
            PG8_WAIT_V(8); PG8_WAIT_L(0); PG8_BAR; PG8_MMA(0, 0, At, B0); PG8_MMA(0, 1, At, B1); PG8_BAR; PG8_SCHED;
            PG8_LDA(At, 1, 1); PG8_STAGE(PG8_SB(1, 0), b3, voffB); PG8_STAGE(PG8_SB(1, 1), b3 + hstep, voffB); PG8_STAGE(PG8_SA(1, 0), a3, voffA);
            PG8_WAIT_V(8); PG8_WAIT_L(0); PG8_BAR; PG8_MMA(1, 0, At, B0); PG8_MMA(1, 1, At, B1); PG8_BAR; PG8_SCHED;
            } else {
            PG8_LDB(B0, 0, 0); PG8_SCHED; PG8_LDA(At, 0, 0); PG8_STAGE(PG8_SA(1, 1), a1 + hstep, voffA);
            PG8_WAIT_L(8); PG8_BAR; PG8_WAIT_L(0); PG8_MMA(0, 0, At, B0); PG8_BAR; PG8_SCHED;
            PG8_LDB(B1, 0, 1); PG8_STAGE(PG8_SB(0, 0), b2, voffB);
            PG8_BAR; PG8_WAIT_L(0); PG8_MMA(0, 1, At, B1); PG8_BAR;
            PG8_LDA(At, 0, 1); PG8_STAGE(PG8_SA(0, 0), a2, voffA);
            PG8_BAR; PG8_WAIT_L(0); PG8_MMA(1, 0, At, B0); PG8_BAR; PG8_SCHED;
            PG8_STAGE(PG8_SB(0, 1), b2 + hstep, voffB);
            PG8_WAIT_V(6); PG8_BAR; PG8_MMA(1, 1, At, B1); PG8_BAR;
            PG8_LDB(B0, 1, 0); PG8_SCHED; PG8_LDA(At, 1, 0); PG8_STAGE(PG8_SA(0, 1), a2 + hstep, voffA);
            PG8_WAIT_L(8); PG8_BAR; PG8_WAIT_L(0); PG8_MMA(0, 0, At, B0); PG8_BAR; PG8_SCHED;
            PG8_LDB(B1, 1, 1); PG8_STAGE(PG8_SB(1, 0), b3, voffB);
            PG8_BAR; PG8_WAIT_L(0); PG8_MMA(0, 1, At, B1); PG8_BAR;
            PG8_LDA(At, 1, 1); PG8_STAGE(PG8_SA(1, 0), a3, voffA);
            PG8_BAR; PG8_WAIT_L(0); PG8_MMA(1, 0, At, B0); PG8_BAR; PG8_SCHED;
            PG8_STAGE(PG8_SB(1, 1), b3 + hstep, voffB);
            PG8_WAIT_V(6); PG8_BAR; PG8_MMA(1, 1, At, B1); PG8_BAR;
            }
        }
        if constexpr (ALIGN_EPI) { if (wr == 0) PG8_BAR; }
        if constexpr (!Epi::AFTER_DRAIN) { E(acc, cur, wr, wc, fr, fq); S.done(cur); }
        if (!has_next) break;
#pragma unroll
        for (int a = 0; a < 2; ++a)
#pragma unroll
            for (int b = 0; b < 2; ++b)
#pragma unroll
                for (int m = 0; m < 4; ++m)
#pragma unroll
                    for (int n = 0; n < 2; ++n) acc[a][b][m][n] = (f32x4){0.f, 0.f, 0.f, 0.f};
        cur = nxt; cA = nA; cB = nB; ++ui;
        if constexpr (ALIGN_EPI) { if (wr == 1) PG8_BAR; }
    }
    PG8_WAIT_V(0);
    if constexpr (!ALIGN_EPI) { if (wr == 0) PG8_BAR; }
    PG8_BAR;
    if constexpr (Epi::AFTER_DRAIN) { E.fused(acc, cur, wr, wc, fr, fq, lds, wid, lane); S.done(cur); }
#undef PG8_SA
#undef PG8_SB
#undef PG8_STAGE
#undef PG8_LDA
#undef PG8_LDB
#undef PG8_MMA
#undef PG8_WAIT_V
#undef PG8_WAIT_L
#undef PG8_BAR
#undef PG8_SCHED
}
}

using pg8::bf16_t; using pg8::bf16x8; using pg8::f32x4; using pg8::u32x4;
#define MFMA32(a, b, c) __builtin_amdgcn_mfma_f32_32x32x16_bf16((a), (b), (c), 0, 0, 0)
DI int crow(int reg, int h) { return (reg & 3) + 8 * (reg >> 2) + 4 * h; }
DI float wave_sum(float v) {
#pragma unroll
    for (int o = 1; o < 64; o <<= 1) v += __shfl_xor(v, o);
    return v;
}
DI float wave_max(float v) {
#pragma unroll
    for (int o = 1; o < 64; o <<= 1) v = fmaxf(v, __shfl_xor(v, o));
    return v;
}
DI bf16x8 pack8(const f32x16& x, int s) { u32x4 p; p.x = pk2(x[8 * s], x[8 * s + 1]); p.y = pk2(x[8 * s + 2], x[8 * s + 3]); p.z = pk2(x[8 * s + 4], x[8 * s + 5]); p.w = pk2(x[8 * s + 6], x[8 * s + 7]); return __builtin_bit_cast(bf16x8, p); }
DI bf16x8 cat4(s16x4 lo, s16x4 hi) { return __builtin_shufflevector(lo, hi, 0, 1, 2, 3, 4, 5, 6, 7); }
DI f32x16 zero16() { f32x16 z;
#pragma unroll
    for (int i = 0; i < 16; ++i) z[i] = 0.f;
    return z; }
DI float gamma_of(int h) { return 1.0f - exp2f(-5.0f - (float)h); }

constexpr size_t MiB = 1u << 20;
constexpr size_t WS_WIN = 1 * MiB;
constexpr size_t WS_WOUT = 23 * MiB;
constexpr size_t WS_WUP = 31 * MiB;
constexpr size_t WS_WDN = 63 * MiB;
constexpr size_t WS_H1 = 95 * MiB;
constexpr size_t WS_MIX = 128 * MiB;
constexpr size_t WS_PART = 161 * MiB;
constexpr size_t WS_RSTD2 = 163 * MiB;
constexpr size_t WS_Z = 164 * MiB;
constexpr size_t WS_KV = 252 * MiB;
constexpr size_t WS_SP = 316 * MiB;
constexpr size_t WS_U = 164 * MiB;
constexpr size_t WS_END = 348 * MiB;
static_assert(WS_Z + (size_t)MP * INW * 2 <= WS_KV && WS_U + (size_t)MP * FF * 2 <= WS_END && WS_H1 + (size_t)MP * DM * 2 <= WS_MIX && WS_MIX + (size_t)MP * DM * 2 <= WS_PART, "ws map");
constexpr int LDS_BYTES = 147456;

constexpr size_t O_Y = 0, O_KP = (size_t)MR * DM, O_VP = O_KP + 16384, O_SP = O_VP + 16384, O_KS = O_SP + 262144, O_VS = O_KS + 2097152, O_SS = O_VS + 2097152, O_END = O_SS + 33554432;

struct TItem { const float* W; bf16_t* WT; int K, N, item; const float* rs; };
DI void p0_load(const TItem& t, f32x4 (&v)[8], int lane) {
    const int nblk = t.N / 32, kb = t.item / nblk, nb = t.item % nblk, k0 = 64 * kb, n0 = 32 * nb, c = lane & 7, rr = lane >> 3;
#pragma unroll
    for (int i = 0; i < 8; ++i) v[i] = __builtin_nontemporal_load((const f32x4*)(t.W + (size_t)(k0 + 8 * i + rr) * t.N + n0 + 4 * c));
    if (t.rs) {
#pragma unroll
        for (int i = 0; i < 8; ++i) v[i] = v[i] * t.rs[k0 + 8 * i + rr];
    }
}
DI void p0_store(const TItem& t, const f32x4 (&v)[8], LAS float* scr, int lane) {
    const int nblk = t.N / 32, kb = t.item / nblk, nb = t.item % nblk, k0 = 64 * kb, n0 = 32 * nb, c = lane & 7, rr = lane >> 3;
#pragma unroll
    for (int i = 0; i < 8; ++i) { LAS float* d = scr + (8 * i + rr) * 33 + 4 * c; d[0] = v[i][0]; d[1] = v[i][1]; d[2] = v[i][2]; d[3] = v[i][3]; }
    asm volatile("s_waitcnt lgkmcnt(0)" ::: "memory");
#pragma unroll
    for (int j = 0; j < 4; ++j) { const int n = (lane >> 3) + 8 * j; const LAS float* s = scr + (8 * c) * 33 + n;
        u32x4 o; o.x = pk2(s[0 * 33], s[1 * 33]); o.y = pk2(s[2 * 33], s[3 * 33]); o.z = pk2(s[4 * 33], s[5 * 33]); o.w = pk2(s[6 * 33], s[7 * 33]);
        *(u32x4*)(t.WT + (size_t)(n0 + n) * t.K + k0 + 8 * c) = o; }
    asm volatile("s_waitcnt lgkmcnt(0)" ::: "memory");
}
struct ResIn { const float* w; bf16_t* wt; DI TItem operator()(int it) const { return TItem{w, wt, DM, INW, it, nullptr}; } };
struct ResRest { const float* w_out; const float* w_up; const float* w_dn; bf16_t* WOUT; bf16_t* WUP; bf16_t* WDN; const float* g2;
    DI TItem operator()(int it) const { constexpr int I_OUT = (DM / 64) * (DM / 32), I_UP = (DM / 64) * (FF / 32); int r = it;
        if (r < I_OUT) return TItem{w_out, WOUT, DM, DM, r, nullptr}; r -= I_OUT;
        if (r < I_UP) return TItem{w_up, WUP, DM, FF, r, g2}; r -= I_UP;
        return TItem{w_dn, WDN, FF, DM, r, nullptr}; } };
template <class Resolve>
DI void p0_convert(const Resolve R, int first, int stride, int total, LAS float* scr, int lane) {
    for (int it = first; it < total; it += 2 * stride) {
        const bool two = it + stride < total;
        const TItem t0 = R(it), t1 = R(two ? it + stride : it);
        f32x4 v0[8], v1[8];
        p0_load(t0, v0, lane);
        if (two) p0_load(t1, v1, lane);
        p0_store(t0, v0, scr, lane);
        if (two) p0_store(t1, v1, scr + 64 * 33, lane);
    }
}
DI void rms_row(const float* xrow, const float* g, bf16_t* orow, int lane) {
    f32x4 v[8]; float s = 0.f;
#pragma unroll
    for (int j = 0; j < 8; ++j) { v[j] = *((const f32x4*)xrow + lane + 64 * j); s += (v[j][0] * v[j][0] + v[j][1] * v[j][1]) + (v[j][2] * v[j][2] + v[j][3] * v[j][3]); }
    const float rstd = rsqrtf(wave_sum(s) * (1.0f / DM) + EPS);
#pragma unroll
    for (int j = 0; j < 8; ++j) { const f32x4 gg = *((const f32x4*)g + lane + 64 * j); u32x2 o; o.x = pk2(v[j][0] * rstd * gg[0], v[j][1] * rstd * gg[1]); o.y = pk2(v[j][2] * rstd * gg[2], v[j][3] * rstd * gg[3]);
        *((u32x2*)orow + lane + 64 * j) = o; }
}

DI void stage_T128x256(LAS unsigned char* img, const bf16_t* src, int tid) {
#pragma unroll
    for (int k = 0; k < 4; ++k) {
        const int it = k * 512 + tid, dgl = it & 3, tpl = (it >> 2) & 15, rest = it >> 6, dg = dgl + 4 * (rest & 7), tp = tpl + 16 * (rest >> 3);
        const bf16_t* p = src + (size_t)(2 * tp) * INW + dg * 8;
        const u32x4 a = *(const u32x4*)p, b = *(const u32x4*)(p + INW);
#pragma unroll
        for (int e = 0; e < 8; ++e) {
            const unsigned lo = (e & 1) ? (a[e >> 1] >> 16) : (a[e >> 1] & 0xffffu), hi = (e & 1) ? (b[e >> 1] & 0xffff0000u) : (b[e >> 1] << 16);
            *(LAS unsigned*)(img + (dg * 8 + e) * 264 + tp * 4) = lo | hi;
        }
    }
}

DI void ret_step1(LAS unsigned char* lds, const bf16_t* Z, bf16_t* KV, int n, int h, int tid) {
    LAS unsigned char* Kt = lds; LAS unsigned char* Vt = lds + 256 * 264;
    const int lane = tid & 63, wid = tid >> 6, r = lane & 31, hh = lane >> 5;
    stage_T128x256(Kt, Z + (size_t)(n * 128) * INW + C_RK + h * 256, tid);
    stage_T128x256(Vt, Z + (size_t)(n * 128) * INW + C_RV + h * 256, tid);
    __syncthreads();
    f32x16 acc[8];
#pragma unroll
    for (int i = 0; i < 8; ++i) acc[i] = zero16();
    const int dk0 = wid * 32;
#pragma unroll 2
    for (int s = 0; s < 8; ++s) {
        const LAS unsigned char* pa = Kt + (dk0 + r) * 264 + (16 * s + 8 * hh) * 2;
        const bf16x8 A = cat4(*(const LAS s16x4*)pa, *(const LAS s16x4*)(pa + 8));
#pragma unroll
        for (int dt = 0; dt < 8; ++dt) {
            const LAS unsigned char* pb = Vt + (dt * 32 + r) * 264 + (16 * s + 8 * hh) * 2;
            const bf16x8 B = cat4(*(const LAS s16x4*)pb, *(const LAS s16x4*)(pb + 8));
            acc[dt] = MFMA32(A, B, acc[dt]);
        }
    }
    bf16_t* out = KV + ((size_t)(n * 4 + h) * 256) * 256 + dk0 + 4 * hh;
#pragma unroll
    for (int dt = 0; dt < 8; ++dt)
#pragma unroll
        for (int g4 = 0; g4 < 4; ++g4) { u32x2 o; o.x = pk2(acc[dt][4 * g4], acc[dt][4 * g4 + 1]); o.y = pk2(acc[dt][4 * g4 + 2], acc[dt][4 * g4 + 3]);
            *(u32x2*)(out + (size_t)(dt * 32 + r) * 256 + 8 * g4) = o; }
    __syncthreads();
}

DI void ret_scan(const bf16_t* KV, bf16_t* SP, float* o_state, int gt, int nthreads) {
    for (int e = gt; e < 65536; e += nthreads) {
        const int h = e >> 14, dv = (e >> 6) & 255, dk4 = (e & 63) * 4;
        const float lg = log1pf(-exp2f(-5.0f - (float)h)), Dc = __expf(128.0f * lg), c1 = __expf(127.0f * lg);
        const size_t base = ((size_t)(h * 256 + dv)) * 256 + dk4;
        f32x4 s = {0.f, 0.f, 0.f, 0.f};
        for (int n0 = 0; n0 < 64; n0 += 32) {
            u32x2 q[32];
#pragma unroll
            for (int u = 0; u < 32; ++u) q[u] = *(const u32x2*)(KV + (size_t)(n0 + u) * 262144 + base);
#pragma unroll
            for (int u = 0; u < 32; ++u) { u32x2 o; o.x = pk2(s[0], s[1]); o.y = pk2(s[2], s[3]); *(u32x2*)(SP + (size_t)(n0 + u) * 262144 + base) = o;
                const f32x4 kv = {bflo(q[u].x), bfhi(q[u].x), bflo(q[u].y), bfhi(q[u].y)}; s = s * Dc + kv * c1; }
        }
#pragma unroll
        for (int j = 0; j < 4; ++j) o_state[((size_t)(h * 256 + dk4 + j)) * 256 + dv] = s[j];
    }
}

DI float silu_f(float x) { return x / (1.0f + __expf(-x)); }

DI void ret_step2(LAS unsigned char* lds, const bf16_t* Z, const bf16_t* SP, bf16_t* MIX, const float* rng, int n, int h, int tid) {
    LAS unsigned char* Kr = lds; LAS unsigned char* Vt = lds + 128 * 528; LAS float* red = (LAS float*)(lds + 128 * 528 + 256 * 264);
    const int lane = tid & 63, wid = tid >> 6, r = lane & 31, hh = lane >> 5;
    const bf16_t* zc = Z + (size_t)(n * 128) * INW;
#pragma unroll
    for (int k = 0; k < 8; ++k) { const int it = k * 512 + tid, row = it >> 5, c = it & 31;
        *(LAS u32x4*)(Kr + row * 528 + c * 16) = *(const u32x4*)(zc + (size_t)row * INW + C_RK + h * 256 + c * 8); }
    stage_T128x256(Vt, zc + C_RV + h * 256, tid);
    const int it_ = wid >> 1, dh = wid & 1;
    bf16x8 qf[16];
    { const bf16_t* qp = zc + (size_t)(32 * it_ + r) * INW + C_RQ + h * 256 + 8 * hh;
#pragma unroll
      for (int s = 0; s < 16; ++s) qf[s] = *(const bf16x8*)(qp + 16 * s); }
    f32x16 acc[4];
#pragma unroll
    for (int i = 0; i < 4; ++i) acc[i] = zero16();
    const float gm = gamma_of(h);
    __syncthreads();
    for (int jt = 0; jt <= it_; ++jt) {
        f32x16 X = zero16();
#pragma unroll
        for (int s = 0; s < 16; ++s) { const bf16x8 A = *(const LAS bf16x8*)(Kr + (32 * jt + r) * 528 + (16 * s + 8 * hh) * 2); X = MFMA32(A, qf[s], X); }
        if (jt == it_) {
#pragma unroll
            for (int i = 0; i < 16; ++i) X[i] = (crow(i, hh) > r) ? 0.f : X[i];
        }
#pragma unroll
        for (int s2 = 0; s2 < 2; ++s2) { const bf16x8 xs = pack8(X, s2);
#pragma unroll
            for (int dt = 0; dt < 4; ++dt) { const LAS unsigned char* pa = Vt + (128 * dh + 32 * dt + r) * 264 + (32 * jt + 16 * s2 + 4 * hh) * 2;
                const bf16x8 A = cat4(*(const LAS s16x4*)pa, *(const LAS s16x4*)(pa + 16)); acc[dt] = MFMA32(A, xs, acc[dt]); } }
    }
    { const float ig = 1.0f / gm;
#pragma unroll
      for (int dt = 0; dt < 4; ++dt) acc[dt] = acc[dt] * ig; }
    __syncthreads();
    {
        const bf16_t* spg = SP + (size_t)(n * 4 + h) * 65536;
        const bf16_t* ge = spg + (size_t)(tid >> 5) * 256 + ((tid & 31) ^ (tid >> 5)) * 8;
        const bf16_t* go = spg + (size_t)(tid >> 5) * 256 + ((tid & 31) ^ (16 + (tid >> 5))) * 8;
        LAS unsigned char* ld = lds + wid * 1024;
#pragma unroll 1
        for (int k = 0; k < 16; k += 2) {
            __builtin_amdgcn_global_load_lds((const unsigned*)(ge + (size_t)k * 4096), (LAS unsigned*)(ld + k * 8192), 16, 0, 0);
            __builtin_amdgcn_global_load_lds((const unsigned*)(go + (size_t)(k + 1) * 4096), (LAS unsigned*)(ld + (k + 1) * 8192), 16, 0, 0);
        }
        asm volatile("s_waitcnt vmcnt(0)" ::: "memory");
    }
    __syncthreads();
#pragma unroll
    for (int dt = 0; dt < 4; ++dt)
#pragma unroll
        for (int s = 0; s < 16; ++s) { const int rw = 128 * dh + 32 * dt + r; const bf16x8 A = *(const LAS bf16x8*)(lds + rw * 512 + (((2 * s + hh) ^ (rw & 31)) * 16)); acc[dt] = MFMA32(A, qf[s], acc[dt]); }
#pragma unroll
    for (int dt = 0; dt < 4; ++dt) acc[dt] = acc[dt] * gm;
    float ss = 0.f;
#pragma unroll
    for (int dt = 0; dt < 4; ++dt)
#pragma unroll
        for (int i = 0; i < 16; ++i) ss += acc[dt][i] * acc[dt][i];
    ss += __shfl_xor(ss, 32);
    if (hh == 0) red[wid * 32 + r] = ss;
    __syncthreads();
    const float rstd = rsqrtf((red[wid * 32 + r] + red[(wid ^ 1) * 32 + r]) * (1.0f / 256.0f) + EPS);
#pragma unroll
    for (int dt = 0; dt < 4; ++dt)
#pragma unroll
        for (int g4 = 0; g4 < 4; ++g4) { const int dv = 128 * dh + 32 * dt + 8 * g4 + 4 * hh;
            *(LAS f32x4*)(lds + (32 * it_ + r) * 1040 + dv * 4) = (f32x4){acc[dt][4 * g4] * rstd, acc[dt][4 * g4 + 1] * rstd, acc[dt][4 * g4 + 2] * rstd, acc[dt][4 * g4 + 3] * rstd}; }
    __syncthreads();
#pragma unroll 2
    for (int k = 0; k < 8; ++k) {
        const int it = k * 512 + tid, tk = it >> 5, c8 = (it & 31) * 8; const size_t token = (size_t)n * 128 + tk;
        const u32x4 gz = *(const u32x4*)(Z + token * INW + C_RG + h * 256 + c8);
        const f32x4 g0 = *(const f32x4*)(rng + h * 256 + c8), g1 = *(const f32x4*)(rng + h * 256 + c8 + 4);
        const f32x4 p0 = *(const LAS f32x4*)(lds + tk * 1040 + c8 * 4), p1 = *(const LAS f32x4*)(lds + tk * 1040 + c8 * 4 + 16);
        u32x4 o;
        o.x = pk2(p0[0] * g0[0] * silu_f(bflo(gz.x)), p0[1] * g0[1] * silu_f(bfhi(gz.x))); o.y = pk2(p0[2] * g0[2] * silu_f(bflo(gz.y)), p0[3] * g0[3] * silu_f(bfhi(gz.y)));
        o.z = pk2(p1[0] * g1[0] * silu_f(bflo(gz.z)), p1[1] * g1[1] * silu_f(bfhi(gz.z))); o.w = pk2(p1[2] * g1[2] * silu_f(bflo(gz.w)), p1[3] * g1[3] * silu_f(bfhi(gz.w)));
        *(u32x4*)(MIX + token * DM + 1024 + h * 256 + c8) = o;
    }
    __syncthreads();
}

DI void ret_decode_unit(LAS unsigned char* lds, const bf16_t* Z, const float* S0, float* S1, bf16_t* MIX, const float* rng, int b, int h, int tid) {
    LAS float* qv = (LAS float*)lds; LAS float* red = qv + 768;
    const int lane = tid & 63, wid = tid >> 6;
    const bf16_t* zrow = Z + (size_t)(LP + b) * INW;
    if (tid < 256) { qv[tid] = bf2f(zrow[C_RQ + h * 256 + tid]); qv[256 + tid] = bf2f(zrow[C_RK + h * 256 + tid]); qv[512 + tid] = bf2f(zrow[C_RV + h * 256 + tid]); }
    __syncthreads();
    const float gm = gamma_of(h);
    const f32x4 v4 = *(const LAS f32x4*)(qv + 512 + 4 * lane);
    f32x4 acc = {0.f, 0.f, 0.f, 0.f};
    const size_t off = ((size_t)(b * 4 + h) * 256 + wid * 32) * 256 + 4 * lane;
    const float* s0 = S0 + off; float* s1 = S1 + off;
#pragma unroll 1
    for (int rr = 0; rr < 32; rr += 16) {
        f32x4 s[16];
#pragma unroll
        for (int u = 0; u < 16; ++u) s[u] = __builtin_nontemporal_load((const f32x4*)(s0 + (size_t)(rr + u) * 256));
#pragma unroll
        for (int u = 0; u < 16; ++u) { const int dk = wid * 32 + rr + u; const float kk = qv[256 + dk], qq = qv[dk];
            const f32x4 sn = s[u] * gm + v4 * kk; __builtin_nontemporal_store(sn, (f32x4*)(s1 + (size_t)(rr + u) * 256)); acc += sn * qq; }
    }
    *(LAS f32x4*)(red + wid * 256 + 4 * lane) = acc;
    __syncthreads();
    if (wid == 0) {
        f32x4 o = {0.f, 0.f, 0.f, 0.f};
#pragma unroll
        for (int w = 0; w < 8; ++w) o += *(const LAS f32x4*)(red + w * 256 + 4 * lane);
        const float ssq = wave_sum((o[0] * o[0] + o[1] * o[1]) + (o[2] * o[2] + o[3] * o[3]));
        const float rstd = rsqrtf(ssq * (1.0f / 256.0f) + EPS);
        const u32x2 gz = *(const u32x2*)(zrow + C_RG + h * 256 + 4 * lane);
        const f32x4 gn = *(const f32x4*)(rng + h * 256 + 4 * lane);
        u32x2 y; y.x = pk2(o[0] * rstd * gn[0] * silu_f(bflo(gz.x)), o[1] * rstd * gn[1] * silu_f(bfhi(gz.x)));
        y.y = pk2(o[2] * rstd * gn[2] * silu_f(bflo(gz.y)), o[3] * rstd * gn[3] * silu_f(bfhi(gz.y)));
        *(u32x2*)(MIX + (size_t)(LP + b) * DM + 1024 + h * 256 + 4 * lane) = y;
    }
    __syncthreads();
}

DI void attn_prompt_unit(LAS unsigned char* lds, const bf16_t* Z, bf16_t* MIX, const float* gq, const float* gk, const float* sinks, float* o_k, float* o_v, int nb, int kh, int hf, int tid) {
    LAS unsigned char* Kn = lds; LAS unsigned char* Vt = lds + 256 * 144;
    const int lane = tid & 63, wid = tid >> 6, r = lane & 31, hh = lane >> 5;
    {
        const int row = tid >> 1, half = tid & 1; const int tok = (nb - 1) * 128 + row;
        u32x4 v[4];
#pragma unroll
        for (int c = 0; c < 4; ++c) v[c] = (u32x4){0u, 0u, 0u, 0u};
        if (tok >= 0) {
#pragma unroll
            for (int c = 0; c < 4; ++c) v[c] = *(const u32x4*)(Z + (size_t)tok * INW + C_AK + kh * 64 + half * 32 + c * 8);
        }
        float f[32]; float ss = 0.f;
#pragma unroll
        for (int c = 0; c < 4; ++c)
#pragma unroll
            for (int e = 0; e < 4; ++e) { f[c * 8 + 2 * e] = bflo(v[c][e]); f[c * 8 + 2 * e + 1] = bfhi(v[c][e]); }
#pragma unroll
        for (int e = 0; e < 32; ++e) ss += f[e] * f[e];
        ss += __shfl_xor(ss, 1);
        const float rstd = rsqrtf(ss * (1.0f / 64.0f) + EPS);
#pragma unroll
        for (int c = 0; c < 8; ++c) { const f32x4 g = *(const f32x4*)(gk + half * 32 + c * 4);
#pragma unroll
            for (int e = 0; e < 4; ++e) f[c * 4 + e] *= rstd * g[e]; }
#pragma unroll
        for (int c = 0; c < 4; ++c) { u32x4 w; w.x = pk2(f[c * 8], f[c * 8 + 1]); w.y = pk2(f[c * 8 + 2], f[c * 8 + 3]); w.z = pk2(f[c * 8 + 4], f[c * 8 + 5]); w.w = pk2(f[c * 8 + 6], f[c * 8 + 7]);
            *(LAS u32x4*)(Kn + row * 144 + half * 64 + c * 16) = w; }
        if (nb == 63 && hf == 0 && row >= 128) { float* o = o_k + ((size_t)(row - 128) * 2 + kh) * 64 + half * 32;
#pragma unroll
            for (int c = 0; c < 8; ++c) *(f32x4*)(o + c * 4) = (f32x4){f[c * 4], f[c * 4 + 1], f[c * 4 + 2], f[c * 4 + 3]}; }
    }
#pragma unroll
    for (int k = 0; k < 2; ++k) {
        const int it = k * 512 + tid, kpl = it & 15, dgl = (it >> 4) & 3, rest = it >> 6, dg = dgl + 4 * (rest & 1), kp = kpl + 16 * (rest >> 1);
        const int tok0 = (nb - 1) * 128 + 2 * kp;
        u32x4 a = {0u, 0u, 0u, 0u}, b = {0u, 0u, 0u, 0u};
        if (tok0 >= 0) { const bf16_t* p = Z + (size_t)tok0 * INW + C_AV + kh * 64 + dg * 8; a = *(const u32x4*)p; b = *(const u32x4*)(p + INW); }
#pragma unroll
        for (int e = 0; e < 8; ++e) {
            const unsigned lo = (e & 1) ? (a[e >> 1] >> 16) : (a[e >> 1] & 0xffffu), hi = (e & 1) ? (b[e >> 1] & 0xffff0000u) : (b[e >> 1] << 16);
            *(LAS unsigned*)(Vt + (dg * 8 + e) * 520 + kp * 4) = lo | hi;
        }
        if (nb == 63 && hf == 0 && kp >= 64) { float* o = o_v + ((size_t)(2 * kp - 128) * 2 + kh) * 64 + dg * 8;
#pragma unroll
            for (int e = 0; e < 4; ++e) { o[2 * e] = bflo(a[e]); o[2 * e + 1] = bfhi(a[e]); o[128 + 2 * e] = bflo(b[e]); o[128 + 2 * e + 1] = bfhi(b[e]); } }
    }
    __syncthreads();
    const int hq = kh * 8 + 4 * hf + (wid >> 1), qh = wid & 1;
    const float sink = sinks[hq];
#pragma unroll 1
    for (int qq = 0; qq < 2; ++qq) {
        const int qi = 2 * qh + qq; const size_t tokq = (size_t)nb * 128 + 32 * qi + r;
        bf16x8 qf[4];
        {   const bf16_t* qp = Z + tokq * INW + hq * 64 + 8 * hh;
            u32x4 raw[4]; float ss = 0.f;
#pragma unroll
            for (int s = 0; s < 4; ++s) { raw[s] = *(const u32x4*)(qp + 16 * s);
#pragma unroll
                for (int e = 0; e < 4; ++e) { const float lo = bflo(raw[s][e]), hi = bfhi(raw[s][e]); ss += lo * lo + hi * hi; } }
            ss += __shfl_xor(ss, 32);
            const float rstd = rsqrtf(ss * (1.0f / 64.0f) + EPS) * 0.125f;
#pragma unroll
            for (int s = 0; s < 4; ++s) { const f32x4 g0 = *(const f32x4*)(gq + 16 * s + 8 * hh), g1 = *(const f32x4*)(gq + 16 * s + 8 * hh + 4); u32x4 w;
                w.x = pk2(bflo(raw[s].x) * rstd * g0[0], bfhi(raw[s].x) * rstd * g0[1]); w.y = pk2(bflo(raw[s].y) * rstd * g0[2], bfhi(raw[s].y) * rstd * g0[3]);
                w.z = pk2(bflo(raw[s].z) * rstd * g1[0], bfhi(raw[s].z) * rstd * g1[1]); w.w = pk2(bflo(raw[s].w) * rstd * g1[2], bfhi(raw[s].w) * rstd * g1[3]);
                qf[s] = __builtin_bit_cast(bf16x8, w); }
        }
        f32x16 X[5];
#pragma unroll
        for (int t = 0; t < 5; ++t) { X[t] = zero16();
#pragma unroll
            for (int s = 0; s < 4; ++s) { const bf16x8 A = *(const LAS bf16x8*)(Kn + (32 * (qi + t) + r) * 144 + (16 * s + 8 * hh) * 2); X[t] = MFMA32(A, qf[s], X[t]); } }
        const int ii = 32 * qi + r;
        float m = -1e30f;
#pragma unroll
        for (int t = 0; t < 5; ++t)
#pragma unroll
            for (int i = 0; i < 16; ++i) { const int jj = 32 * (qi + t) + crow(i, hh); const bool ok = (jj >= ii) && (jj <= ii + 128) && (nb > 0 || jj >= 128);
                X[t][i] = ok ? X[t][i] : -1e30f; m = fmaxf(m, X[t][i]); }
        m = fmaxf(m, __shfl_xor(m, 32)); m = fmaxf(m, sink);
        float sum = 0.f;
#pragma unroll
        for (int t = 0; t < 5; ++t)
#pragma unroll
            for (int i = 0; i < 16; ++i) { const float p = __expf(X[t][i] - m); X[t][i] = p; sum += p; }
        sum += __shfl_xor(sum, 32);
        const float inv = 1.0f / (sum + __expf(sink - m));
        f32x16 o[2]; o[0] = zero16(); o[1] = zero16();
#pragma unroll
        for (int t = 0; t < 5; ++t)
#pragma unroll
            for (int s2 = 0; s2 < 2; ++s2) { const bf16x8 xs = pack8(X[t], s2);
#pragma unroll
                for (int dt = 0; dt < 2; ++dt) { const LAS unsigned char* pa = Vt + (32 * dt + r) * 520 + (32 * (qi + t) + 16 * s2 + 4 * hh) * 2;
                    const bf16x8 A = cat4(*(const LAS s16x4*)pa, *(const LAS s16x4*)(pa + 16)); o[dt] = MFMA32(A, xs, o[dt]); } }
#pragma unroll
        for (int dt = 0; dt < 2; ++dt)
#pragma unroll
            for (int g4 = 0; g4 < 4; ++g4) { u32x2 w; w.x = pk2(o[dt][4 * g4] * inv, o[dt][4 * g4 + 1] * inv); w.y = pk2(o[dt][4 * g4 + 2] * inv, o[dt][4 * g4 + 3] * inv);
                *(u32x2*)(MIX + tokq * DM + hq * 64 + 32 * dt + 8 * g4 + 4 * hh) = w; }
    }
    __syncthreads();
}

DI void attn_decode_unit(LAS unsigned char* lds, const bf16_t* Z, const float* ck, const float* cv, bf16_t* MIX, const float* gq, const float* gk, const float* sinks, float* o_k, float* o_v, int b, int kh, int tid) {
    LAS float* Kc = (LAS float*)lds; LAS float* Vc = Kc + 129 * 65; LAS float* qs = Vc + 129 * 64; LAS float* pw = qs + 512;
    const int lane = tid & 63, wid = tid >> 6;
#pragma unroll
    for (int k = 0; k < 4; ++k) {
        const int it = k * 512 + tid, w = it >> 4, c4 = (it & 15) * 4;
        const size_t src = ((size_t)(b * 128 + w) * 2 + kh) * 64 + c4;
        const f32x4 k4 = *(const f32x4*)(ck + src), v4 = *(const f32x4*)(cv + src);
#pragma unroll
        for (int e = 0; e < 4; ++e) { Kc[w * 65 + c4 + e] = k4[e]; Vc[w * 64 + c4 + e] = v4[e]; }
        if (w >= 1) { const size_t dst = ((size_t)(b * 128 + w - 1) * 2 + kh) * 64 + c4; *(f32x4*)(o_k + dst) = k4; *(f32x4*)(o_v + dst) = v4; }
    }
    const bf16_t* zrow = Z + (size_t)(LP + b) * INW;
    const size_t dnew = ((size_t)(b * 128 + 127) * 2 + kh) * 64 + lane;
    if (wid == 0) { const float kx = bf2f(zrow[C_AK + kh * 64 + lane]); const float ss = wave_sum(kx * kx); const float kn = kx * rsqrtf(ss * (1.0f / 64.0f) + EPS) * gk[lane];
        Kc[128 * 65 + lane] = kn; o_k[dnew] = kn; }
    if (wid == 1) { const float vx = bf2f(zrow[C_AV + kh * 64 + lane]); Vc[128 * 64 + lane] = vx; o_v[dnew] = vx; }
    const int hq = kh * 8 + wid;
    { const float qx = bf2f(zrow[hq * 64 + lane]); const float ss = wave_sum(qx * qx); qs[wid * 64 + lane] = qx * rsqrtf(ss * (1.0f / 64.0f) + EPS) * gq[lane] * 0.125f; }
    __syncthreads();
    float s1 = 0.f, s2 = 0.f;
#pragma unroll 8
    for (int d = 0; d < 64; ++d) { const float q = qs[wid * 64 + d]; s1 += q * Kc[lane * 65 + d]; s2 += q * Kc[(lane + 64) * 65 + d]; }
    const float s3 = wave_sum(qs[wid * 64 + lane] * Kc[128 * 65 + lane]);
    const float sink = sinks[hq];
    const float m = fmaxf(wave_max(fmaxf(s1, s2)), fmaxf(s3, sink));
    const float p1 = __expf(s1 - m), p2 = __expf(s2 - m), p3 = __expf(s3 - m);
    const float denom = wave_sum(p1 + p2) + p3 + __expf(sink - m);
    pw[wid * 132 + lane] = p1; pw[wid * 132 + 64 + lane] = p2; if (lane == 0) pw[wid * 132 + 128] = p3;
    __syncthreads();
    float o = 0.f;
#pragma unroll 3
    for (int j = 0; j < 129; ++j) o += pw[wid * 132 + j] * Vc[j * 64 + lane];
    MIX[(size_t)(LP + b) * DM + hq * 64 + lane] = (bf16_t)(pk2(o / denom, 0.f) & 0xffffu);
    __syncthreads();
}

template <int MT, class Epi>
DI void skinny_unit(LAS unsigned char* lds, const bf16_t* A, const bf16_t* Wt, int K, int cgi, int k0, int row0, const Epi& E, int tid) {
    const int lane = tid & 63, wid = tid >> 6, fr = lane & 15, fq = lane >> 4;
    const int c0 = cgi * 32;
    constexpr int NMT = 2 * MT;
    const bf16_t* pa = A + (size_t)(row0 + fr) * K + k0 + wid * 256 + 8 * fq;
    const bf16_t* pb = Wt + (size_t)(c0 + fr) * K + k0 + wid * 256 + 8 * fq;
    const size_t rs = (size_t)16 * K;
    f32x4 acc[NMT][2];
#pragma unroll
    for (int i = 0; i < NMT; ++i) { acc[i][0] = (f32x4){0.f, 0.f, 0.f, 0.f}; acc[i][1] = (f32x4){0.f, 0.f, 0.f, 0.f}; }
    bf16x8 fb[3][2], fa[3][NMT];
#define SK_LOAD(buf, c) do { _Pragma("unroll") for (int nt = 0; nt < 2; ++nt) fb[buf][nt] = *(const bf16x8*)(pb + nt * rs + 32 * (c)); \
        _Pragma("unroll") for (int mt = 0; mt < NMT; ++mt) fa[buf][mt] = *(const bf16x8*)(pa + mt * rs + 32 * (c)); } while (0)
#define SK_MMA(buf) do { _Pragma("unroll") for (int mt = 0; mt < NMT; ++mt) _Pragma("unroll") for (int nt = 0; nt < 2; ++nt) \
        acc[mt][nt] = __builtin_amdgcn_mfma_f32_16x16x32_bf16(fa[buf][mt], fb[buf][nt], acc[mt][nt], 0, 0, 0); } while (0)
    SK_LOAD(0, 0); SK_LOAD(1, 1);
    SK_LOAD(2, 2); SK_MMA(0);
    SK_LOAD(0, 3); SK_MMA(1);
    SK_LOAD(1, 4); SK_MMA(2);
    SK_LOAD(2, 5); SK_MMA(0);
    SK_LOAD(0, 6); SK_MMA(1);
    SK_LOAD(1, 7); SK_MMA(2);
    SK_MMA(0); SK_MMA(1);
#undef SK_LOAD
#undef SK_MMA
    constexpr int NR = 32 * MT;
    LAS float* red = (LAS float*)lds;
#pragma unroll
    for (int mt = 0; mt < NMT; ++mt)
#pragma unroll
        for (int nt = 0; nt < 2; ++nt)
#pragma unroll
            for (int j = 0; j < 4; ++j) red[(wid * NR + mt * 16 + 4 * fq + j) * 32 + nt * 16 + fr] = acc[mt][nt][j];
    __syncthreads();
    if (MT == 4) {
        const int row = tid >> 2, c8 = (tid & 3) * 8;
        f32x4 sa = {0.f, 0.f, 0.f, 0.f}, sb = {0.f, 0.f, 0.f, 0.f};
#pragma unroll
        for (int w = 0; w < 8; ++w) { sa += *(const LAS f32x4*)(red + (w * NR + row) * 32 + c8); sb += *(const LAS f32x4*)(red + (w * NR + row) * 32 + c8 + 4); }
        E(row0 + row, c0 + c8, sa); E(row0 + row, c0 + c8 + 4, sb);
    } else if (tid < 8 * NR) {
        const int row = tid >> 3, c4 = (tid & 7) * 4;
        f32x4 sa = {0.f, 0.f, 0.f, 0.f};
#pragma unroll
        for (int w = 0; w < 8; ++w) sa += *(const LAS f32x4*)(red + (w * NR + row) * 32 + c4);
        E(row0 + row, c0 + c4, sa);
    }
    __syncthreads();
}
struct SkOut { const float* xs; float* X1s; bf16_t* XBs;
    DI void operator()(int row, int col, f32x4 a) const { const f32x4 v = a + *(const f32x4*)(xs + (size_t)row * DM + col); *(f32x4*)(X1s + (size_t)row * DM + col) = v;
        u32x2 o; o.x = pk2(v[0], v[1]); o.y = pk2(v[2], v[3]); *(u32x2*)(XBs + (size_t)row * DM + col) = o; } };
struct SkUp { bf16_t* Us;
    DI void operator()(int row, int col, f32x4 a) const {
#pragma unroll
        for (int e = 0; e < 4; ++e) { a[e] = fmaxf(a[e], 0.f); a[e] *= a[e]; }
        u32x2 o; o.x = pk2(a[0], a[1]); o.y = pk2(a[2], a[3]); *(u32x2*)(Us + (size_t)row * FF + col) = o; } };
struct SkSlab { float* slab;
    DI void operator()(int row, int col, f32x4 a) const { *(f32x4*)(slab + (size_t)row * DM + col) = a; } };

#define RLX_AGENT __ATOMIC_RELAXED, __HIP_MEMORY_SCOPE_AGENT
#define XB_TMO      128
#define XB_XCNT(j)  (256  + 64 * (j))
#define XB_XSUB(j)  (1280 + 64 * (j))
#define XB_XGEN(j)  (2304 + 64 * (j))
#define XB_TOP      3328
#define XB_TOPGEN   3392
#define XCD_BAR_WORDS 3456
#define XB_SPIN_CAP (1u << 18)

__device__ __forceinline__ unsigned xb_ld(unsigned* p)              { return __hip_atomic_load(p, __ATOMIC_RELAXED, __HIP_MEMORY_SCOPE_AGENT); }
__device__ __forceinline__ unsigned xb_add(unsigned* p, unsigned v) { return __hip_atomic_fetch_add(p, v, __ATOMIC_RELAXED, __HIP_MEMORY_SCOPE_AGENT); }
__device__ __forceinline__ unsigned xb_xcc_id() { return (unsigned)__builtin_amdgcn_s_getreg((3 << 11) | 20) & 0xFu; }
#define XB_SPIN(cond, bar) do { unsigned _sp = 0; while (cond) { __builtin_amdgcn_s_sleep(1); \
    if ((++_sp & 255u) == 0u) { if (xb_ld(&(bar)[XB_TMO])) break; if (_sp > XB_SPIN_CAP) { atomicAdd(&(bar)[XB_TMO], 1u); break; } } } } while (0)

struct XcdBarrier {
    unsigned* bar; unsigned x;
    volatile LAS unsigned* st;
};

__device__ __forceinline__ XcdBarrier xcd_barrier_post(unsigned* bar, volatile LAS unsigned* st) {
    XcdBarrier b; b.bar = bar; b.x = xb_xcc_id(); b.st = st;
    if (threadIdx.x == 0) (void)xb_add(&bar[XB_XCNT(b.x)], 1u);
    return b;
}
__device__ __forceinline__ void xcd_barrier_complete(unsigned* bar, unsigned x, unsigned& nloc, unsigned& nx) {
    const unsigned G = gridDim.x * gridDim.y * gridDim.z;
    unsigned sum, cnt, mine, sp = 0u;
    for (;;) {
        sum = 0u; cnt = 0u; mine = 0u;
#pragma unroll
        for (unsigned j = 0; j < 16; ++j) { const unsigned c = xb_ld(&bar[XB_XCNT(j)]); sum += c; cnt += (c > 0u) ? 1u : 0u; mine = (j == x) ? c : mine; }
        if (sum == G) break;
        __builtin_amdgcn_s_sleep(1);
        if ((++sp & 255u) == 0u) { if (xb_ld(&bar[XB_TMO])) break; if (sp > XB_SPIN_CAP) { atomicAdd(&bar[XB_TMO], 1u); break; } }
    }
    nloc = mine > 0u ? mine : 1u; nx = cnt > 0u ? cnt : 1u;
}

__device__ __forceinline__ void xcd_barrier(const XcdBarrier& b) {
    asm volatile("s_waitcnt vmcnt(0)" ::: "memory");
    __syncthreads();
    if (threadIdx.x == 0) {
        unsigned* bar = b.bar;
        __builtin_amdgcn_s_waitcnt(0);
        unsigned nloc = b.st[0], nx = b.st[1];
        if (nloc == 0u) { xcd_barrier_complete(bar, b.x, nloc, nx); b.st[0] = nloc; b.st[1] = nx; }
        const unsigned old = xb_add(&bar[XB_XSUB(b.x)], 1u);
        const unsigned gen = old / nloc;
        if (old + 1u == (gen + 1u) * nloc) {
            __builtin_amdgcn_fence(__ATOMIC_RELEASE, "agent");
            asm volatile("s_waitcnt vmcnt(0)" ::: "memory");
            const unsigned og = xb_add(&bar[XB_TOP], 1u);
            const unsigned tg = og / nx;
            if (og + 1u == (tg + 1u) * nx) xb_add(&bar[XB_TOPGEN], 1u);
            else XB_SPIN(xb_ld(&bar[XB_TOPGEN]) == tg, bar);
            __builtin_amdgcn_fence(__ATOMIC_ACQUIRE, "agent");
            xb_add(&bar[XB_XGEN(b.x)], 1u);
            asm volatile("s_waitcnt vmcnt(0)" ::: "memory");
        } else {
            XB_SPIN(xb_ld(&bar[XB_XGEN(b.x)]) == gen, bar);
            __builtin_amdgcn_fence(__ATOMIC_ACQUIRE, "agent");
            asm volatile("s_waitcnt vmcnt(0)" ::: "memory");
        }
    }
    __syncthreads();
}

struct Args { const float* in[15]; float* out; unsigned char* ws; int ph_lo, ph_hi; };
constexpr int NPH = 9;
constexpr int NP0_REST = 9216;

__global__ void __launch_bounds__(512, 2) fwd_kernel(Args a) {
    extern __shared__ __attribute__((aligned(16))) unsigned char lds_raw[];
    LAS unsigned char* lds = (LAS unsigned char*)lds_raw;
    cg::grid_group grid = cg::this_grid();
    const int tid = threadIdx.x, lane = tid & 63, wid = __builtin_amdgcn_readfirstlane(tid >> 6);
    const int G = gridDim.x, bx = blockIdx.x;
    unsigned char* ws = a.ws; float* out = a.out;
    const float* x_p = a.in[0]; const float* x_s = a.in[1]; const float* cache_k = a.in[2]; const float* cache_v = a.in[3]; const float* state0 = a.in[4];
    const float* ln1_g = a.in[5]; const float* w_in = a.in[6]; const float* gq = a.in[7]; const float* gk = a.in[8]; const float* sinks = a.in[9];
    const float* rng = a.in[10]; const float* w_out = a.in[11]; const float* ln2_g = a.in[12]; const float* w_up = a.in[13]; const float* w_dn = a.in[14];
    bf16_t* WIN = (bf16_t*)(ws + WS_WIN); bf16_t* WOUT = (bf16_t*)(ws + WS_WOUT); bf16_t* WUP = (bf16_t*)(ws + WS_WUP); bf16_t* WDN = (bf16_t*)(ws + WS_WDN);
    bf16_t* H1 = (bf16_t*)(ws + WS_H1); bf16_t* XG = H1; bf16_t* MIX = (bf16_t*)(ws + WS_MIX); bf16_t* Z = (bf16_t*)(ws + WS_Z); bf16_t* U = (bf16_t*)(ws + WS_U);
    float* PART = (float*)(ws + WS_PART); float* RSTD2 = (float*)(ws + WS_RSTD2); bf16_t* KV = (bf16_t*)(ws + WS_KV); bf16_t* SP = (bf16_t*)(ws + WS_SP); float* SLAB = (float*)(ws + WS_SP);
    const int lo = a.ph_lo, hi = a.ph_hi;
#define IN(k) (lo <= (k) && (k) < hi)
    volatile LAS unsigned* MISC = (volatile LAS unsigned*)(lds + LDS_BYTES - 64);
    if (tid < 16) MISC[tid] = 0u;
    __syncthreads();
    const XcdBarrier bar = xcd_barrier_post((unsigned*)ws + 1024, MISC + 8);
    if (lo > hi) grid.sync();
#define SEAM(k) do { if (IN(k) && IN((k) + 1)) xcd_barrier(bar); } while (0)

    if (IN(0)) for (int rep_ = 0; rep_ < 1 + ((DUPMASK >> 0) & 1); ++rep_) { if (rep_) xcd_barrier(bar);
        LAS float* scr = (LAS float*)(lds + wid * 17408);
        const int gw = bx * 8 + wid, NGW = G * 8;
        constexpr int I_IN = (DM / 64) * (INW / 32);
        p0_convert(ResIn{w_in, WIN}, gw, NGW, I_IN, scr, lane);
        for (int m = gw; m < MP; m += NGW) {
            if (m < MR) rms_row(m < LP ? x_p + (size_t)m * DM : x_s + (size_t)(m - LP) * DM, ln1_g, H1 + (size_t)m * DM, lane);
            else {
#pragma unroll
                for (int j = 0; j < 8; ++j) *((u32x2*)(H1 + (size_t)m * DM) + lane + 64 * j) = (u32x2){0u, 0u};
            }
        }
    }
    SEAM(0);
    if (IN(1)) for (int rep_ = 0; rep_ < 1 + ((DUPMASK >> 1) & 1); ++rep_) { if (rep_) xcd_barrier(bar);
        pg8::Gemm g{H1, WIN, MP, INW, DM}; pg8::StaticOrder S; S.init(MP, INW, G, bx, WGM_IN);
        pg8::EpiIn E{Z};
        pg8::gemm_phase<pg8::EpiIn, pg8::StaticOrder, true, true>(lds, g, S, E);
        {
            constexpr int NT = (MP / 256) * (INW / 256); const int rounds = (NT + G - 1) / G, first_idle = NT - (rounds - 1) * G;
            const int nidle = (first_idle < G) ? (G - first_idle) : G, me = (first_idle < G) ? (bx - first_idle) : bx;
            if (me >= 0) {
                LAS float* scr = (LAS float*)(lds + wid * 17408);
                constexpr int I_OUT = (DM / 64) * (DM / 32), I_UP = (DM / 64) * (FF / 32), I_DN = (FF / 64) * (DM / 32);
                p0_convert(ResRest{w_out, w_up, w_dn, WOUT, WUP, WDN, ln2_g}, NP0_REST + me * 8 + wid, nidle * 8, I_OUT + I_UP + I_DN, scr, lane);
            }
        }
    }
    SEAM(1);
    if (IN(2)) for (int rep_ = 0; rep_ < 1 + ((DUPMASK >> 2) & 1); ++rep_) { if (rep_) xcd_barrier(bar);
        if (bx & 1) for (int u = bx; u < 256; u += G) ret_decode_unit(lds, Z, state0, out + O_SS, MIX, rng, u >> 2, u & 3, tid);
        for (int u = bx; u < 256; u += G) ret_step1(lds, Z, KV, u >> 2, u & 3, tid);
        if (!(bx & 1)) for (int u = bx; u < 256; u += G) ret_decode_unit(lds, Z, state0, out + O_SS, MIX, rng, u >> 2, u & 3, tid);
    }
    SEAM(2);
    if (IN(3)) for (int rep_ = 0; rep_ < 1 + ((DUPMASK >> 3) & 1); ++rep_) { if (rep_) xcd_barrier(bar);
        if (tid < 256) ret_scan(KV, SP, out + O_SP, bx * 256 + tid, G * 256);
        if (bx & 1) for (int u = bx; u < 256; u += G) attn_decode_unit(lds, Z, cache_k, cache_v, MIX, gq, gk, sinks, out + O_KS, out + O_VS, u >> 1, u & 1, tid);
        for (int u = 256 + bx; u < 512; u += G) ret_decode_unit(lds, Z, state0, out + O_SS, MIX, rng, u >> 2, u & 3, tid);
        if (!(bx & 1)) for (int u = bx; u < 256; u += G) attn_decode_unit(lds, Z, cache_k, cache_v, MIX, gq, gk, sinks, out + O_KS, out + O_VS, u >> 1, u & 1, tid);
    }
    SEAM(3);
    if (IN(4)) for (int rep_ = 0; rep_ < 1 + ((DUPMASK >> 4) & 1); ++rep_) { if (rep_) xcd_barrier(bar);
        for (int u = bx; u < 256; u += G) ret_step2(lds, Z, SP, MIX, rng, u >> 2, u & 3, tid);
        for (int u = bx; u < 256; u += G) attn_prompt_unit(lds, Z, MIX, gq, gk, sinks, out + O_KP, out + O_VP, u >> 2, (u >> 1) & 1, u & 1, tid);
        {
            LAS float* scr = (LAS float*)(lds + wid * 17408);
            p0_convert(ResRest{w_out, w_up, w_dn, WOUT, WUP, WDN, ln2_g}, bx * 8 + wid, G * 8, NP0_REST, scr, lane);
        }
    }
    SEAM(4);
    if (IN(5)) for (int rep_ = 0; rep_ < 1 + ((DUPMASK >> 5) & 1); ++rep_) { if (rep_) xcd_barrier(bar);
        pg8::Gemm g{MIX, WOUT, LP, DM, DM}; pg8::StaticOrder S; S.init(LP, DM, G, bx, WGM_OUT);
        pg8::EpiOut E{x_p, XG, PART};
        pg8::gemm_phase<pg8::EpiOut, pg8::StaticOrder, true, true>(lds, g, S, E);
        const SkOut SE{x_s, out + O_Y + (size_t)LP * DM, XG + (size_t)LP * DM};
        for (int u = bx; u < 4 * (DM / 32); u += G) skinny_unit<1>(lds, MIX + (size_t)LP * DM, WOUT, DM, u >> 2, 0, (u & 3) * 32, SE, tid);
    }
    SEAM(5);
    if (IN(6)) for (int rep_ = 0; rep_ < 1 + ((DUPMASK >> 6) & 1); ++rep_) { if (rep_) xcd_barrier(bar);
        for (int row = bx + G * tid; row < LP; row += G * 512) { float s = 0.f;
#pragma unroll
            for (int j = 0; j < 8; ++j) { const f32x4 p = *(const f32x4*)(PART + (size_t)row * 32 + 4 * j); s += (p[0] + p[1]) + (p[2] + p[3]); }
            RSTD2[row] = 1.0f / (s * (1.0f / DM) + EPS); }
        for (int row = LP + bx * 8 + wid; row < MR; row += G * 8) {
            const float* xr = out + O_Y + (size_t)row * DM; float s = 0.f;
#pragma unroll
            for (int j = 0; j < 8; ++j) { const f32x4 v = *((const f32x4*)xr + lane + 64 * j); s += (v[0] * v[0] + v[1] * v[1]) + (v[2] * v[2] + v[3] * v[3]); }
            s = wave_sum(s); if (lane == 0) RSTD2[row] = 1.0f / (s * (1.0f / DM) + EPS); }
        pg8::Gemm g{XG, WUP, LP, FF, DM}; pg8::StaticOrder S; S.init(LP, FF, G, bx, WGM_UP);
        pg8::EpiUp E{U};
        pg8::gemm_phase<pg8::EpiUp, pg8::StaticOrder, true, true>(lds, g, S, E);
        const SkUp SE{U + (size_t)LP * FF};
        for (int u = bx; u < FF / 32; u += G) skinny_unit<4>(lds, XG + (size_t)LP * DM, WUP, DM, u, 0, 0, SE, tid);
    }
    SEAM(6);
    if (IN(7)) {
        if (bx & 1) for (int u = bx; u < 4 * (DM / 32); u += G) { const SkSlab SE{SLAB + (size_t)(u & 3) * NS * DM}; skinny_unit<4>(lds, U + (size_t)LP * FF, WDN, FF, u >> 2, (u & 3) * 2048, 0, SE, tid); }
        pg8::Gemm g{U, WDN, LP, DM, FF}; pg8::StaticOrder S; S.init(LP, DM, G, bx, WGM_DN);
        pg8::EpiDown E{out + O_Y, XG, RSTD2};
        pg8::gemm_phase<pg8::EpiDown, pg8::StaticOrder, true, true>(lds, g, S, E);
        if (!(bx & 1)) for (int u = bx; u < 4 * (DM / 32); u += G) { const SkSlab SE{SLAB + (size_t)(u & 3) * NS * DM}; skinny_unit<4>(lds, U + (size_t)LP * FF, WDN, FF, u >> 2, (u & 3) * 2048, 0, SE, tid); }
    }
    SEAM(7);
    if (IN(8)) {
        for (int e = bx * 512 + tid; e < NS * DM / 4; e += G * 512) {
            const int row = e >> 9; float* p = out + O_Y + (size_t)LP * DM + (size_t)e * 4;
            const f32x4 s = (*(const f32x4*)(SLAB + (size_t)e * 4) + *(const f32x4*)(SLAB + (size_t)NS * DM + (size_t)e * 4)) + (*(const f32x4*)(SLAB + (size_t)2 * NS * DM + (size_t)e * 4) + *(const f32x4*)(SLAB + (size_t)3 * NS * DM + (size_t)e * 4));
            *(f32x4*)p = *(const f32x4*)p + s * RSTD2[LP + row];
        }
    }
#undef IN
#undef SEAM
}

#ifndef N_LAUNCHES
#define N_LAUNCHES 1
#endif
extern "C" void kernel_launch(void* const* d_in, const int* in_sizes, int n_in, void* d_out, int out_size, void* d_ws, size_t ws_size, hipStream_t stream) {
    static int grid = 0;
    if (grid == 0) {
        if (n_in != 15 || (size_t)out_size != O_END || ws_size < WS_END) { fprintf(stderr, "kernel_launch: unexpected shapes (n_in %d out %d ws %zu)\n", n_in, out_size, ws_size); grid = -1; return; }
        int dev = 0, cus = 0, per_cu = 0;
        (void)hipGetDevice(&dev); (void)hipDeviceGetAttribute(&cus, hipDeviceAttributeMultiprocessorCount, dev);
        if (hipFuncSetAttribute((const void*)fwd_kernel, hipFuncAttributeMaxDynamicSharedMemorySize, LDS_BYTES) != hipSuccess) { fprintf(stderr, "kernel_launch: hipFuncSetAttribute failed\n"); grid = -1; return; }
        (void)hipOccupancyMaxActiveBlocksPerMultiprocessor(&per_cu, (const void*)fwd_kernel, 512, LDS_BYTES);
        (void)hipGetLastError();
        if (per_cu < 1) { fprintf(stderr, "kernel_launch: occupancy query says %d blocks per CU\n", per_cu); }
        grid = cus > 0 ? cus : 256;
    }
    if (grid < 0) return;
    if (hipMemsetAsync(d_ws, 0, 65536, stream) != hipSuccess) { fprintf(stderr, "kernel_launch: memset failed\n"); return; }
    Args a{};
    for (int i = 0; i < 15; ++i) a.in[i] = (const float*)d_in[i];
    a.out = (float*)d_out; a.ws = (unsigned char*)d_ws;
    if (N_LAUNCHES == 1) {
        a.ph_lo = 0; a.ph_hi = NPH;
        void* args[] = {&a};
        hipError_t e = hipLaunchCooperativeKernel((const void*)fwd_kernel, dim3(grid), dim3(512), args, LDS_BYTES, stream);
        if (e != hipSuccess) fprintf(stderr, "cooperative launch failed: %s (grid %d)\n", hipGetErrorString(e), grid);
    } else {
        for (int p = 0; p < NPH; ++p) { a.ph_lo = p; a.ph_hi = p + 1; hipLaunchKernelGGL(fwd_kernel, dim3(grid), dim3(512), LDS_BYTES, stream, a); }
    }
}
```

```cpp
#include <hip/hip_runtime.h>
#include <hip/hip_cooperative_groups.h>
#include <cstdio>
#include <cstdint>
namespace cg = cooperative_groups;

#ifndef WGM_IN
#define WGM_IN 2
#endif
#ifndef WGM_OUT
#define WGM_OUT 2
#endif
#ifndef WGM_UP
#define WGM_UP 2
#endif
#ifndef WGM_DN
#define WGM_DN 2
#endif
#ifndef DUPMASK
#define DUPMASK 0
#endif
#define DI __device__ __forceinline__
#define LAS __attribute__((address_space(3)))
typedef float f32x2 __attribute__((ext_vector_type(2)));
typedef float f32x16 __attribute__((ext_vector_type(16)));
typedef short s16x4 __attribute__((ext_vector_type(4)));
typedef unsigned u32x2 __attribute__((ext_vector_type(2)));
typedef __bf16 bf16x2v __attribute__((ext_vector_type(2)));

constexpr int DM = 2048, LP = 8192, NS = 128, MR = LP + NS  , MP = 8448  ;
constexpr int INW = 5376, FF = 8192;
constexpr int C_AQ = 0, C_AK = 1024, C_AV = 1152, C_RQ = 1280, C_RK = 2304, C_RV = 3328, C_RG = 4352;
constexpr float EPS = 1e-6f;

DI unsigned pk2(float lo, float hi) { f32x2 v = {lo, hi}; return __builtin_bit_cast(unsigned, __builtin_convertvector(v, bf16x2v)); }
DI float bflo(unsigned u) { return __uint_as_float(u << 16); }
DI float bfhi(unsigned u) { return __uint_as_float(u & 0xffff0000u); }
DI float bf2f(unsigned short u) { return __uint_as_float(((unsigned)u) << 16); }

namespace pg8 {
#define PG8_LAS __attribute__((address_space(3)))
typedef unsigned short bf16_t;
typedef short bf16x8 __attribute__((ext_vector_type(8)));
typedef float f32x4 __attribute__((ext_vector_type(4)));
typedef unsigned u32x4 __attribute__((ext_vector_type(4)));
constexpr int BM = 256, BK = 64, HALF = 128, HTB = HALF * BK * 2  , STAGE_BYTES = 8 * HTB, NXCD = 8, WGM = 8;

__host__ __device__ __forceinline__ int lds_byte(int r, int c) { const int st = (r >> 4) * 2 + (c >> 5), rr = r & 15, cc = c & 31, ob = rr * 64 + cc * 2; return st * 1024 + (ob ^ (((ob >> 9) & 1) << 5)); }
__host__ __device__ __forceinline__ void stage_rc(int b, int& R, int& C) { const int st = b / 1024, sb = b % 1024, swz = sb ^ (((sb >> 9) & 1) << 5); R = (st >> 1) * 16 + swz / 64; C = (st & 1) * 32 + (swz % 64) / 2; }
__host__ __device__ __forceinline__ int perm32(int rho) { const int n = rho >> 4, i = rho & 15; return 8 * (i >> 2) + 4 * n + (i & 3); }

struct Unit { int pm, pn; };
struct Gemm { const bf16_t* A; const bf16_t* Bt; int M, N, K; };

struct StaticOrder {
    int nM, nN, nwg, G, c, wgm;
    __host__ __device__ void init(int M, int N, int G_, int c_, int wgm_) { nM = M / BM; nN = N / BM; nwg = nM * nN; G = G_; c = c_; wgm = wgm_; }
    __host__ __device__ bool next(int i, Unit& u) const {
        const long L = (long)i * G + c; if (L >= nwg) return false;
        int wgid = (int)L; { const int q = nwg / NXCD, r = nwg % NXCD, xcd = wgid % NXCD, off = wgid / NXCD; wgid = (xcd < r ? xcd * (q + 1) : r * (q + 1) + (xcd - r) * q) + off; }
        const int nig = wgm * nN, gid = wgid / nig, fm = gid * wgm, gsz = (nM - fm) < wgm ? (nM - fm) : wgm;
        u.pm = fm + ((wgid % nig) % gsz); u.pn = (wgid % nig) / gsz; return true;
    }
    __device__ __forceinline__ void a_ready(const Unit&) const {}
    __device__ __forceinline__ void done(const Unit&) const {}
};


DI u32x4 pack8f(const f32x4& a, const f32x4& b) { u32x4 w; w.x = pk2(a[0], a[1]); w.y = pk2(a[2], a[3]); w.z = pk2(b[0], b[1]); w.w = pk2(b[2], b[3]); return w; }

struct EpiIn {
    static constexpr bool PERM = true, AFTER_DRAIN = false;
    bf16_t* Z;
    __device__ __forceinline__ void operator()(const f32x4 (&acc)[2][2][4][2], const Unit& u, int wr, int wc, int fr, int fq) const {
        const int row0 = u.pm * BM + wr * 64 + fr, col0 = u.pn * BM + wc * 32 + 8 * fq;
        if (u.pn < 5 || u.pn > 12) {
#pragma unroll
            for (int ai = 0; ai < 2; ++ai)
#pragma unroll
                for (int m = 0; m < 4; ++m) { bf16_t* rowp = Z + (size_t)(row0 + ai * HALF + m * 16) * INW + col0;
#pragma unroll
                    for (int bj = 0; bj < 2; ++bj) *(u32x4*)(rowp + bj * HALF) = pack8f(acc[ai][bj][m][0], acc[ai][bj][m][1]); }
        } else {
            const int head = (u.pn - 5) & 3; const bool isk = u.pn >= 9;
            const float lg = log1pf(-exp2f(-5.0f - (float)head));
            float inv[8];
#pragma unroll
            for (int j = 0; j < 8; ++j) inv[j] = powf(10000.0f, -(float)(wc * 32 + 8 * fq + j) * (1.0f / 128.0f));
#pragma unroll
            for (int ai = 0; ai < 2; ++ai)
#pragma unroll
                for (int m = 0; m < 4; ++m) {
                    const int row = row0 + ai * HALF + m * 16;
                    const int pos = row < LP ? row : LP; const float t = row < LP ? (float)(row & 127) : 0.0f;
                    const float f = isk ? 0.0625f * __expf(-lg * t) : __expf(lg * t);
                    f32x4 o1[2], o2[2];
#pragma unroll
                    for (int n = 0; n < 2; ++n)
#pragma unroll
                        for (int e = 0; e < 4; ++e) {
                            const float ang = (float)pos * inv[n * 4 + e];
                            double rev = (double)ang * 0.15915494309189535; rev -= floor(rev);
                            const float fr_ = (float)rev; const float sn = __builtin_amdgcn_sinf(fr_), cs = __builtin_amdgcn_cosf(fr_);
                            const float x1 = acc[ai][0][m][n][e], x2 = acc[ai][1][m][n][e];
                            o1[n][e] = (x1 * cs - x2 * sn) * f; o2[n][e] = (x2 * cs + x1 * sn) * f;
                        }
                    bf16_t* rowp = Z + (size_t)row * INW + col0;
                    *(u32x4*)(rowp) = pack8f(o1[0], o1[1]); *(u32x4*)(rowp + HALF) = pack8f(o2[0], o2[1]);
                }
        }
    }
};

struct EpiOut {
    static constexpr bool PERM = true, AFTER_DRAIN = false;
    const float* xp; bf16_t* X1B; float* part;
    __device__ __forceinline__ void operator()(const f32x4 (&acc)[2][2][4][2], const Unit& u, int wr, int wc, int fr, int fq) const {
#pragma unroll
        for (int ai = 0; ai < 2; ++ai)
#pragma unroll
            for (int m = 0; m < 4; ++m) {
                const int row = u.pm * BM + ai * HALF + wr * 64 + m * 16 + fr;
                const float* xrow = xp + (size_t)row * DM;
                float ss = 0.f;
#pragma unroll
                for (int bj = 0; bj < 2; ++bj) {
                    const int col = u.pn * BM + bj * HALF + wc * 32 + 8 * fq;
                    const f32x4 v0 = acc[ai][bj][m][0] + *(const f32x4*)(xrow + col), v1 = acc[ai][bj][m][1] + *(const f32x4*)(xrow + col + 4);
                    ss += (v0[0] * v0[0] + v0[1] * v0[1]) + (v0[2] * v0[2] + v0[3] * v0[3]) + (v1[0] * v1[0] + v1[1] * v1[1]) + (v1[2] * v1[2] + v1[3] * v1[3]);
                    *(u32x4*)(X1B + (size_t)row * DM + col) = pack8f(v0, v1);
                }
                ss += __shfl_xor(ss, 16); ss += __shfl_xor(ss, 32);
                if (fq == 0) part[(size_t)row * 32 + u.pn * 4 + wc] = ss;
            }
    }
};

struct EpiUp {
    static constexpr bool PERM = true, AFTER_DRAIN = false;
    bf16_t* U;
    __device__ __forceinline__ void operator()(const f32x4 (&acc)[2][2][4][2], const Unit& u, int wr, int wc, int fr, int fq) const {
        const int row0 = u.pm * BM + wr * 64 + fr, col0 = u.pn * BM + wc * 32 + 8 * fq;
#pragma unroll
        for (int ai = 0; ai < 2; ++ai)
#pragma unroll
            for (int m = 0; m < 4; ++m) { bf16_t* rowp = U + (size_t)(row0 + ai * HALF + m * 16) * FF + col0;
#pragma unroll
                for (int bj = 0; bj < 2; ++bj) { f32x4 a = acc[ai][bj][m][0], b = acc[ai][bj][m][1];
#pragma unroll
                    for (int e = 0; e < 4; ++e) { a[e] = fmaxf(a[e], 0.f); a[e] *= a[e]; b[e] = fmaxf(b[e], 0.f); b[e] *= b[e]; }
                    *(u32x4*)(rowp + bj * HALF) = pack8f(a, b); } }
    }
};

struct EpiDown {
    static constexpr bool PERM = true, AFTER_DRAIN = false;
    float* Y; const bf16_t* X1B; const float* rstd2;
    __device__ __forceinline__ void operator()(const f32x4 (&acc)[2][2][4][2], const Unit& u, int wr, int wc, int fr, int fq) const {
#pragma unroll
        for (int ai = 0; ai < 2; ++ai)
#pragma unroll
            for (int m = 0; m < 4; ++m) {
                const int row = u.pm * BM + ai * HALF + wr * 64 + m * 16 + fr; const float r2 = rstd2[row];
#pragma unroll
                for (int bj = 0; bj < 2; ++bj) { const size_t o = (size_t)row * DM + u.pn * BM + bj * HALF + wc * 32 + 8 * fq;
                    const u32x4 xb = *(const u32x4*)(X1B + o);
                    const f32x4 a = {bflo(xb.x), bfhi(xb.x), bflo(xb.y), bfhi(xb.y)}, b = {bflo(xb.z), bfhi(xb.z), bflo(xb.w), bfhi(xb.w)};
                    *(f32x4*)(Y + o) = a + acc[ai][bj][m][0] * r2; *(f32x4*)(Y + o + 4) = b + acc[ai][bj][m][1] * r2; }
            }
    }
};
template <class Epi, class Sched, bool ALIGN_EPI = false, bool SP2 = false>
__device__ __forceinline__ void gemm_phase(PG8_LAS unsigned char* lds, const Gemm g, const Sched& S, const Epi& E) {
    const int tid = threadIdx.x, wid = __builtin_amdgcn_readfirstlane(tid >> 6), lane = tid & 63, wr = wid >> 2, wc = wid & 3, fr = lane & 15, fq = lane >> 4;
    const int K = g.K, nt = K / BK;
    unsigned voffA[2], voffB[2];
#pragma unroll
    for (int i = 0; i < 2; ++i) { int R, C; stage_rc(tid * 16 + i * 8192, R, C); const int Rb = Epi::PERM ? ((R & ~31) + perm32(R & 31)) : R;
        voffA[i] = (unsigned)(R * K + C) * 2u; voffB[i] = (unsigned)(Rb * K + C) * 2u; }
    const size_t kstep = (size_t)(BK * 2);
    const size_t hstep = (size_t)HALF * K * 2;
    const size_t tstep = 2 * hstep;
    const unsigned ldsw = (unsigned)wid * 1024u;
    const int aoff = lds_byte(wr * 64 + fr, fq * 8), boff = lds_byte(wc * 32 + fr, fq * 8);
#define PG8_SA(b, h) (((b) * 2 + (h)) * HTB)
#define PG8_SB(b, h) ((4 + (b) * 2 + (h)) * HTB)
#define PG8_STAGE(bufoff, gbase, voff) do { _Pragma("unroll") for (int _i = 0; _i < 2; ++_i) \
        __builtin_amdgcn_global_load_lds((const unsigned*)((const char*)(gbase) + (voff)[_i]), (PG8_LAS unsigned*)(lds + (bufoff) + ldsw + _i * 8192), 16, 0, 0); } while (0)
#define PG8_LDA(dst, b, h) do { _Pragma("unroll") for (int m = 0; m < 4; ++m) _Pragma("unroll") for (int k = 0; k < 2; ++k) dst[m][k] = *(const PG8_LAS bf16x8*)(lds + PG8_SA(b, h) + aoff + m * 2048 + k * 1024); } while (0)
#define PG8_LDB(dst, b, h) do { _Pragma("unroll") for (int n = 0; n < 2; ++n) _Pragma("unroll") for (int k = 0; k < 2; ++k) dst[n][k] = *(const PG8_LAS bf16x8*)(lds + PG8_SB(b, h) + boff + n * 2048 + k * 1024); } while (0)
#define PG8_MMA(ai, bj, At, Bt) do { __builtin_amdgcn_s_setprio(1); _Pragma("unroll") for (int m = 0; m < 4; ++m) _Pragma("unroll") for (int n = 0; n < 2; ++n) _Pragma("unroll") for (int k = 0; k < 2; ++k) \
        acc[ai][bj][m][n] = __builtin_amdgcn_mfma_f32_16x16x32_bf16(Bt[n][k], At[m][k], acc[ai][bj][m][n], 0, 0, 0); __builtin_amdgcn_s_setprio(0); } while (0)
#define PG8_WAIT_V(n) asm volatile("s_waitcnt vmcnt(" #n ")" ::: "memory")
#define PG8_WAIT_L(n) asm volatile("s_waitcnt lgkmcnt(" #n ")" ::: "memory")
#define PG8_BAR __builtin_amdgcn_s_barrier()
#define PG8_SCHED __builtin_amdgcn_sched_barrier(0)
    Unit cur, nxt; int ui = 0;
    if (!S.next(0, cur)) return;
    f32x4 acc[2][2][4][2];
#pragma unroll
    for (int a = 0; a < 2; ++a)
#pragma unroll
        for (int b = 0; b < 2; ++b)
#pragma unroll
            for (int m = 0; m < 4; ++m)
#pragma unroll
                for (int n = 0; n < 2; ++n) acc[a][b][m][n] = (f32x4){0.f, 0.f, 0.f, 0.f};
    bf16x8 At[4][2], B0[2][2], B1[2][2];
    const char* cA = (const char*)g.A + (size_t)cur.pm * tstep; const char* cB = (const char*)g.Bt + (size_t)cur.pn * tstep;
    S.a_ready(cur);
    if constexpr (SP2) {
        PG8_STAGE(PG8_SB(0, 0), cB, voffB); PG8_STAGE(PG8_SB(0, 1), cB + hstep, voffB); PG8_STAGE(PG8_SA(0, 0), cA, voffA); PG8_STAGE(PG8_SA(0, 1), cA + hstep, voffA);
        if (wr == 1) PG8_BAR;
        PG8_WAIT_V(2); PG8_BAR;
        PG8_STAGE(PG8_SB(1, 0), cB + kstep, voffB); PG8_STAGE(PG8_SA(1, 0), cA + kstep, voffA); PG8_STAGE(PG8_SB(1, 1), cB + hstep + kstep, voffB);
        PG8_WAIT_V(6); PG8_BAR;
    } else {
        PG8_STAGE(PG8_SB(0, 0), cB, voffB); PG8_STAGE(PG8_SA(0, 0), cA, voffA); PG8_STAGE(PG8_SB(0, 1), cB + hstep, voffB); PG8_STAGE(PG8_SA(0, 1), cA + hstep, voffA);
        if (wr == 1) PG8_BAR;
        PG8_WAIT_V(4); PG8_BAR;
        PG8_STAGE(PG8_SB(1, 0), cB + kstep, voffB); PG8_STAGE(PG8_SA(1, 0), cA + kstep, voffA); PG8_STAGE(PG8_SB(1, 1), cB + hstep + kstep, voffB);
        PG8_WAIT_V(6); PG8_BAR;
    }
    for (;;) {
        const bool has_next = S.next(ui + 1, nxt);
        const char* nA = has_next ? (const char*)g.A + (size_t)nxt.pm * tstep : cA; const char* nB = has_next ? (const char*)g.Bt + (size_t)nxt.pn * tstep : cB;
        for (int t = 0; t < nt; t += 2) {
            const bool last = (t == nt - 2);
            const char* a1 = cA + (size_t)(t + 1) * kstep;
            const char* a2 = last ? nA : cA + (size_t)(t + 2) * kstep; const char* b2 = last ? nB : cB + (size_t)(t + 2) * kstep;
            const char* a3 = a2 + kstep; const char* b3 = b2 + kstep;
            if (last && has_next) S.a_ready(nxt);
            if constexpr (SP2) {
            PG8_LDB(B0, 0, 0); PG8_LDB(B1, 0, 1); PG8_SCHED; PG8_LDA(At, 0, 0); PG8_STAGE(PG8_SA(1, 1), a1 + hstep, voffA);
            PG8_WAIT_V(8); PG8_WAIT_L(0); PG8_BAR; PG8_MMA(0, 0, At, B0); PG8_MMA(0, 1, At, B1); PG8_BAR; PG8_SCHED;
            PG8_LDA(At, 0, 1); PG8_STAGE(PG8_SB(0, 0), b2, voffB); PG8_STAGE(PG8_SB(0, 1), b2 + hstep, voffB); PG8_STAGE(PG8_SA(0, 0), a2, voffA);
            PG8_WAIT_V(8); PG8_WAIT_L(0); PG8_BAR; PG8_MMA(1, 0, At, B0); PG8_MMA(1, 1, At, B1); PG8_BAR; PG8_SCHED;
            PG8_LDB(B0, 1, 0); PG8_LDB(B1, 1, 1); PG8_SCHED; PG8_LDA(At, 1, 0); PG8_STAGE(PG8_SA(0, 1), a2 + hstep, voffA);
            PG8_WAIT_V(8); PG8_WAIT_L(0); PG8_BAR; PG8_MMA(0, 0, At, B0); PG8_MMA(0, 1, At, B1); PG8_BAR; PG8_SCHED;
            PG8_LDA(At, 1, 1); PG8_STAGE(PG8_SB(1, 0), b3, voffB); PG8_STAGE(PG8_SB(1, 1), b3 + hstep, voffB); PG8_STAGE(PG8_SA(1, 0), a3, voffA);
            PG8_WAIT_V(8); PG8_WAIT_L(0); PG8_BAR; PG8_MMA(1, 0, At, B0); PG8_MMA(1, 1, At, B1); PG8_BAR; PG8_SCHED;
            } else {
            PG8_LDB(B0, 0, 0); PG8_SCHED; PG8_LDA(At, 0, 0); PG8_STAGE(PG8_SA(1, 1), a1 + hstep, voffA);
            PG8_WAIT_L(8); PG8_BAR; PG8_WAIT_L(0); PG8_MMA(0, 0, At, B0); PG8_BAR; PG8_SCHED;
            PG8_LDB(B1, 0, 1); PG8_STAGE(PG8_SB(0, 0), b2, voffB);
            PG8_BAR; PG8_WAIT_L(0); PG8_MMA(0, 1, At, B1); PG8_BAR;
            PG8_LDA(At, 0, 1); PG8_STAGE(PG8_SA(0, 0), a2, voffA);
            PG8_BAR; PG8_WAIT_L(0); PG8_MMA(1, 0, At, B0); PG8_BAR; PG8_SCHED;
            PG8_STAGE(PG8_SB(0, 1), b2 + hstep, voffB);
            PG8_WAIT_V(6); PG8_BAR; PG8_MMA(1, 1, At, B1); PG8_BAR;
            PG8_LDB(B0, 1, 0); PG8_SCHED; PG8_LDA(At, 1, 0); PG8_STAGE(PG8_SA(0, 1), a2 + hstep, voffA);
            PG8_WAIT_L(8); PG8_BAR; PG8_WAIT_L(0); PG8_MMA(0, 0, At, B0); PG8_BAR; PG8_SCHED;
            PG8_LDB(B1, 1, 1); PG8_STAGE(PG8_SB(1, 0), b3, voffB);
            PG8_BAR; PG8_WAIT_L(0); PG8_MMA(0, 1, At, B1); PG8_BAR;
            PG8_LDA(At, 1, 1); PG8_STAGE(PG8_SA(1, 0), a3, voffA);
            PG8_BAR; PG8_WAIT_L(0); PG8_MMA(1, 0, At, B0); PG8_BAR; PG8_SCHED;
            PG8_STAGE(PG8_SB(1, 1), b3 + hstep, voffB);
            PG8_WAIT_V(6); PG8_BAR; PG8_MMA(1, 1, At, B1); PG8_BAR;
            }
        }
        if constexpr (ALIGN_EPI) { if (wr == 0) PG8_BAR; }
        if constexpr (!Epi::AFTER_DRAIN) { E(acc, cur, wr, wc, fr, fq); S.done(cur); }
        if (!has_next) break;
#pragma unroll
        for (int a = 0; a < 2; ++a)
#pragma unroll
            for (int b = 0; b < 2; ++b)
#pragma unroll
                for (int m = 0; m < 4; ++m)
#pragma unroll
                    for (int n = 0; n < 2; ++n) acc[a][b][m][n] = (f32x4){0.f, 0.f, 0.f, 0.f};
        cur = nxt; cA = nA; cB = nB; ++ui;
        if constexpr (ALIGN_EPI) { if (wr == 1) PG8_BAR; }
    }
    PG8_WAIT_V(0);
    if constexpr (!ALIGN_EPI) { if (wr == 0) PG8_BAR; }
    PG8_BAR;
    if constexpr (Epi::AFTER_DRAIN) { E.fused(acc, cur, wr, wc, fr, fq, lds, wid, lane); S.done(cur); }
#undef PG8_SA
#undef PG8_SB
#undef PG8_STAGE
#undef PG8_LDA
#undef PG8_LDB
#undef PG8_MMA
#undef PG8_WAIT_V
#undef PG8_WAIT_L
#undef PG8_BAR
#undef PG8_SCHED
}
}

using pg8::bf16_t; using pg8::bf16x8; using pg8::f32x4; using pg8::u32x4;
#define MFMA32(a, b, c) __builtin_amdgcn_mfma_f32_32x32x16_bf16((a), (b), (c), 0, 0, 0)
DI int crow(int reg, int h) { return (reg & 3) + 8 * (reg >> 2) + 4 * h; }
DI float wave_sum(float v) {
#pragma unroll
    for (int o = 1; o < 64; o <<= 1) v += __shfl_xor(v, o);
    return v;
}
DI float wave_max(float v) {
#pragma unroll
    for (int o = 1; o < 64; o <<= 1) v = fmaxf(v, __shfl_xor(v, o));
    return v;
}
DI bf16x8 pack8(const f32x16& x, int s) { u32x4 p; p.x = pk2(x[8 * s], x[8 * s + 1]); p.y = pk2(x[8 * s + 2], x[8 * s + 3]); p.z = pk2(x[8 * s + 4], x[8 * s + 5]); p.w = pk2(x[8 * s + 6], x[8 * s + 7]); return __builtin_bit_cast(bf16x8, p); }
DI bf16x8 cat4(s16x4 lo, s16x4 hi) { return __builtin_shufflevector(lo, hi, 0, 1, 2, 3, 4, 5, 6, 7); }
DI f32x16 zero16() { f32x16 z;
#pragma unroll
    for (int i = 0; i < 16; ++i) z[i] = 0.f;
    return z; }
DI float gamma_of(int h) { return 1.0f - exp2f(-5.0f - (float)h); }

constexpr size_t MiB = 1u << 20;
constexpr size_t WS_WIN = 1 * MiB;
constexpr size_t WS_WOUT = 23 * MiB;
constexpr size_t WS_WUP = 31 * MiB;
constexpr size_t WS_WDN = 63 * MiB;
constexpr size_t WS_H1 = 95 * MiB;
constexpr size_t WS_MIX = 128 * MiB;
constexpr size_t WS_PART = 161 * MiB;
constexpr size_t WS_RSTD2 = 163 * MiB;
constexpr size_t WS_Z = 164 * MiB;
constexpr size_t WS_KV = 252 * MiB;
constexpr size_t WS_SP = 316 * MiB;
constexpr size_t WS_U = 164 * MiB;
constexpr size_t WS_END = 348 * MiB;
static_assert(WS_Z + (size_t)MP * INW * 2 <= WS_KV && WS_U + (size_t)MP * FF * 2 <= WS_END && WS_H1 + (size_t)MP * DM * 2 <= WS_MIX && WS_MIX + (size_t)MP * DM * 2 <= WS_PART, "ws map");
constexpr int LDS_BYTES = 147456;

constexpr size_t O_Y = 0, O_KP = (size_t)MR * DM, O_VP = O_KP + 16384, O_SP = O_VP + 16384, O_KS = O_SP + 262144, O_VS = O_KS + 2097152, O_SS = O_VS + 2097152, O_END = O_SS + 33554432;

struct TItem { const float* W; bf16_t* WT; int K, N, item; const float* rs; };
DI void p0_load(const TItem& t, f32x4 (&v)[8], int lane) {
    const int nblk = t.N / 32, kb = t.item / nblk, nb = t.item % nblk, k0 = 64 * kb, n0 = 32 * nb, c = lane & 7, rr = lane >> 3;
#pragma unroll
    for (int i = 0; i < 8; ++i) v[i] = __builtin_nontemporal_load((const f32x4*)(t.W + (size_t)(k0 + 8 * i + rr) * t.N + n0 + 4 * c));
    if (t.rs) {
#pragma unroll
        for (int i = 0; i < 8; ++i) v[i] = v[i] * t.rs[k0 + 8 * i + rr];
    }
}
DI void p0_store(const TItem& t, const f32x4 (&v)[8], LAS float* scr, int lane) {
    const int nblk = t.N / 32, kb = t.item / nblk, nb = t.item % nblk, k0 = 64 * kb, n0 = 32 * nb, c = lane & 7, rr = lane >> 3;
#pragma unroll
    for (int i = 0; i < 8; ++i) { LAS float* d = scr + (8 * i + rr) * 33 + 4 * c; d[0] = v[i][0]; d[1] = v[i][1]; d[2] = v[i][2]; d[3] = v[i][3]; }
    asm volatile("s_waitcnt lgkmcnt(0)" ::: "memory");
#pragma unroll
    for (int j = 0; j < 4; ++j) { const int n = (lane >> 3) + 8 * j; const LAS float* s = scr + (8 * c) * 33 + n;
        u32x4 o; o.x = pk2(s[0 * 33], s[1 * 33]); o.y = pk2(s[2 * 33], s[3 * 33]); o.z = pk2(s[4 * 33], s[5 * 33]); o.w = pk2(s[6 * 33], s[7 * 33]);
        *(u32x4*)(t.WT + (size_t)(n0 + n) * t.K + k0 + 8 * c) = o; }
    asm volatile("s_waitcnt lgkmcnt(0)" ::: "memory");
}
struct ResIn { const float* w; bf16_t* wt; DI TItem operator()(int it) const { return TItem{w, wt, DM, INW, it, nullptr}; } };
struct ResRest { const float* w_out; const float* w_up; const float* w_dn; bf16_t* WOUT; bf16_t* WUP; bf16_t* WDN; const float* g2;
    DI TItem operator()(int it) const { constexpr int I_OUT = (DM / 64) * (DM / 32), I_UP = (DM / 64) * (FF / 32); int r = it;
        if (r < I_OUT) return TItem{w_out, WOUT, DM, DM, r, nullptr}; r -= I_OUT;
        if (r < I_UP) return TItem{w_up, WUP, DM, FF, r, g2}; r -= I_UP;
        return TItem{w_dn, WDN, FF, DM, r, nullptr}; } };
template <class Resolve>
DI void p0_convert(const Resolve R, int first, int stride, int total, LAS float* scr, int lane) {
    for (int it = first; it < total; it += 2 * stride) {
        const bool two = it + stride < total;
        const TItem t0 = R(it), t1 = R(two ? it + stride : it);
        f32x4 v0[8], v1[8];
        p0_load(t0, v0, lane);
        if (two) p0_load(t1, v1, lane);
        p0_store(t0, v0, scr, lane);
        if (two) p0_store(t1, v1, scr + 64 * 33, lane);
    }
}
DI void rms_row(const float* xrow, const float* g, bf16_t* orow, int lane) {
    f32x4 v[8]; float s = 0.f;
#pragma unroll
    for (int j = 0; j < 8; ++j) { v[j] = *((const f32x4*)xrow + lane + 64 * j); s += (v[j][0] * v[j][0] + v[j][1] * v[j][1]) + (v[j][2] * v[j][2] + v[j][3] * v[j][3]); }
    const float rstd = rsqrtf(wave_sum(s) * (1.0f / DM) + EPS);
#pragma unroll
    for (int j = 0; j < 8; ++j) { const f32x4 gg = *((const f32x4*)g + lane + 64 * j); u32x2 o; o.x = pk2(v[j][0] * rstd * gg[0], v[j][1] * rstd * gg[1]); o.y = pk2(v[j][2] * rstd * gg[2], v[j][3] * rstd * gg[3]);
        *((u32x2*)orow + lane + 64 * j) = o; }
}

DI void stage_T128x256(LAS unsigned char* img, const bf16_t* src, int tid) {
#pragma unroll
    for (int k = 0; k < 4; ++k) {
        const int it = k * 512 + tid, dgl = it & 3, tpl = (it >> 2) & 15, rest = it >> 6, dg = dgl + 4 * (rest & 7), tp = tpl + 16 * (rest >> 3);
        const bf16_t* p = src + (size_t)(2 * tp) * INW + dg * 8;
        const u32x4 a = *(const u32x4*)p, b = *(const u32x4*)(p + INW);
#pragma unroll
        for (int e = 0; e < 8; ++e) {
            const unsigned lo = (e & 1) ? (a[e >> 1] >> 16) : (a[e >> 1] & 0xffffu), hi = (e & 1) ? (b[e >> 1] & 0xffff0000u) : (b[e >> 1] << 16);
            *(LAS unsigned*)(img + (dg * 8 + e) * 264 + tp * 4) = lo | hi;
        }
    }
}

DI void ret_step1(LAS unsigned char* lds, const bf16_t* Z, bf16_t* KV, int n, int h, int tid) {
    LAS unsigned char* Kt = lds; LAS unsigned char* Vt = lds + 256 * 264;
    const int lane = tid & 63, wid = tid >> 6, r = lane & 31, hh = lane >> 5;
    stage_T128x256(Kt, Z + (size_t)(n * 128) * INW + C_RK + h * 256, tid);
    stage_T128x256(Vt, Z + (size_t)(n * 128) * INW + C_RV + h * 256, tid);
    __syncthreads();
    f32x16 acc[8];
#pragma unroll
    for (int i = 0; i < 8; ++i) acc[i] = zero16();
    const int dk0 = wid * 32;
#pragma unroll 2
    for (int s = 0; s < 8; ++s) {
        const LAS unsigned char* pa = Kt + (dk0 + r) * 264 + (16 * s + 8 * hh) * 2;
        const bf16x8 A = cat4(*(const LAS s16x4*)pa, *(const LAS s16x4*)(pa + 8));
#pragma unroll
        for (int dt = 0; dt < 8; ++dt) {
            const LAS unsigned char* pb = Vt + (dt * 32 + r) * 264 + (16 * s + 8 * hh) * 2;
            const bf16x8 B = cat4(*(const LAS s16x4*)pb, *(const LAS s16x4*)(pb + 8));
            acc[dt] = MFMA32(A, B, acc[dt]);
        }
    }
    bf16_t* out = KV + ((size_t)(n * 4 + h) * 256) * 256 + dk0 + 4 * hh;
#pragma unroll
    for (int dt = 0; dt < 8; ++dt)
#pragma unroll
        for (int g4 = 0; g4 < 4; ++g4) { u32x2 o; o.x = pk2(acc[dt][4 * g4], acc[dt][4 * g4 + 1]); o.y = pk2(acc[dt][4 * g4 + 2], acc[dt][4 * g4 + 3]);
            *(u32x2*)(out + (size_t)(dt * 32 + r) * 256 + 8 * g4) = o; }
    __syncthreads();
}

DI void ret_scan(const bf16_t* KV, bf16_t* SP, float* o_state, int gt, int nthreads) {
    for (int e = gt; e < 65536; e += nthreads) {
        const int h = e >> 14, dv = (e >> 6) & 255, dk4 = (e & 63) * 4;
        const float lg = log1pf(-exp2f(-5.0f - (float)h)), Dc = __expf(128.0f * lg), c1 = __expf(127.0f * lg);
        const size_t base = ((size_t)(h * 256 + dv)) * 256 + dk4;
        f32x4 s = {0.f, 0.f, 0.f, 0.f};
        for (int n0 = 0; n0 < 64; n0 += 32) {
            u32x2 q[32];
#pragma unroll
            for (int u = 0; u < 32; ++u) q[u] = *(const u32x2*)(KV + (size_t)(n0 + u) * 262144 + base);
#pragma unroll
            for (int u = 0; u < 32; ++u) { u32x2 o; o.x = pk2(s[0], s[1]); o.y = pk2(s[2], s[3]); *(u32x2*)(SP + (size_t)(n0 + u) * 262144 + base) = o;
                const f32x4 kv = {bflo(q[u].x), bfhi(q[u].x), bflo(q[u].y), bfhi(q[u].y)}; s = s * Dc + kv * c1; }
        }
#pragma unroll
        for (int j = 0; j < 4; ++j) o_state[((size_t)(h * 256 + dk4 + j)) * 256 + dv] = s[j];
    }
}

DI float silu_f(float x) { return x * __builtin_amdgcn_rcpf(1.0f + __builtin_amdgcn_exp2f(-1.4426950408889634f * x)); }

DI void ret_step2(LAS unsigned char* lds, const bf16_t* Z, const bf16_t* SP, bf16_t* MIX, const float* rng, int n, int h, int tid) {
    LAS unsigned char* Kr = lds; LAS unsigned char* Vt = lds + 128 * 528; LAS float* red = (LAS float*)(lds + 128 * 528 + 256 * 264);
    const int lane = tid & 63, wid = tid >> 6, r = lane & 31, hh = lane >> 5;
    const bf16_t* zc = Z + (size_t)(n * 128) * INW;
#pragma unroll
    for (int k = 0; k < 8; ++k) { const int it = k * 512 + tid, row = it >> 5, c = it & 31;
        *(LAS u32x4*)(Kr + row * 528 + c * 16) = *(const u32x4*)(zc + (size_t)row * INW + C_RK + h * 256 + c * 8); }
    stage_T128x256(Vt, zc + C_RV + h * 256, tid);
    const int it_ = wid >> 1, dh = wid & 1;
    bf16x8 qf[16];
    { const bf16_t* qp = zc + (size_t)(32 * it_ + r) * INW + C_RQ + h * 256 + 8 * hh;
#pragma unroll
      for (int s = 0; s < 16; ++s) qf[s] = *(const bf16x8*)(qp + 16 * s); }
    f32x16 acc[4];
#pragma unroll
    for (int i = 0; i < 4; ++i) acc[i] = zero16();
    const float gm = gamma_of(h);
    __syncthreads();
    for (int jt = 0; jt <= it_; ++jt) {
        f32x16 X = zero16();
#pragma unroll
        for (int s = 0; s < 16; ++s) { const bf16x8 A = *(const LAS bf16x8*)(Kr + (32 * jt + r) * 528 + (16 * s + 8 * hh) * 2); X = MFMA32(A, qf[s], X); }
        if (jt == it_) {
#pragma unroll
            for (int i = 0; i < 16; ++i) X[i] = (crow(i, hh) > r) ? 0.f : X[i];
        }
#pragma unroll
        for (int s2 = 0; s2 < 2; ++s2) { const bf16x8 xs = pack8(X, s2);
#pragma unroll
            for (int dt = 0; dt < 4; ++dt) { const LAS unsigned char* pa = Vt + (128 * dh + 32 * dt + r) * 264 + (32 * jt + 16 * s2 + 4 * hh) * 2;
                const bf16x8 A = cat4(*(const LAS s16x4*)pa, *(const LAS s16x4*)(pa + 16)); acc[dt] = MFMA32(A, xs, acc[dt]); } }
    }
    { const float ig = 1.0f / gm;
#pragma unroll
      for (int dt = 0; dt < 4; ++dt) acc[dt] = acc[dt] * ig; }
    __syncthreads();
    {
        const bf16_t* spg = SP + (size_t)(n * 4 + h) * 65536;
        const bf16_t* ge = spg + (size_t)(tid >> 5) * 256 + ((tid & 31) ^ (tid >> 5)) * 8;
        const bf16_t* go = spg + (size_t)(tid >> 5) * 256 + ((tid & 31) ^ (16 + (tid >> 5))) * 8;
        LAS unsigned char* ld = lds + wid * 1024;
#pragma unroll 1
        for (int k = 0; k < 16; k += 2) {
            __builtin_amdgcn_global_load_lds((const unsigned*)(ge + (size_t)k * 4096), (LAS unsigned*)(ld + k * 8192), 16, 0, 0);
            __builtin_amdgcn_global_load_lds((const unsigned*)(go + (size_t)(k + 1) * 4096), (LAS unsigned*)(ld + (k + 1) * 8192), 16, 0, 0);
        }
        asm volatile("s_waitcnt vmcnt(0)" ::: "memory");
    }
    __syncthreads();
#pragma unroll
    for (int dt = 0; dt < 4; ++dt)
#pragma unroll
        for (int s = 0; s < 16; ++s) { const int rw = 128 * dh + 32 * dt + r; const bf16x8 A = *(const LAS bf16x8*)(lds + rw * 512 + (((2 * s + hh) ^ (rw & 31)) * 16)); acc[dt] = MFMA32(A, qf[s], acc[dt]); }
#pragma unroll
    for (int dt = 0; dt < 4; ++dt) acc[dt] = acc[dt] * gm;
    float ss = 0.f;
#pragma unroll
    for (int dt = 0; dt < 4; ++dt)
#pragma unroll
        for (int i = 0; i < 16; ++i) ss += acc[dt][i] * acc[dt][i];
    ss += __shfl_xor(ss, 32);
    if (hh == 0) red[wid * 32 + r] = ss;
    __syncthreads();
    const float rstd = rsqrtf((red[wid * 32 + r] + red[(wid ^ 1) * 32 + r]) * (1.0f / 256.0f) + EPS);
#pragma unroll
    for (int dt = 0; dt < 4; ++dt)
#pragma unroll
        for (int g4 = 0; g4 < 4; ++g4) { const int dv = 128 * dh + 32 * dt + 8 * g4 + 4 * hh;
            *(LAS f32x4*)(lds + (32 * it_ + r) * 1040 + dv * 4) = (f32x4){acc[dt][4 * g4] * rstd, acc[dt][4 * g4 + 1] * rstd, acc[dt][4 * g4 + 2] * rstd, acc[dt][4 * g4 + 3] * rstd}; }
    __syncthreads();
#pragma unroll 1
    for (int k = 0; k < 8; ++k) {
        const int it = k * 512 + tid, tk = it >> 5, c8 = (it & 31) * 8; const size_t token = (size_t)n * 128 + tk;
        const u32x4 gz = *(const u32x4*)(Z + token * INW + C_RG + h * 256 + c8);
        const f32x4 g0 = *(const f32x4*)(rng + h * 256 + c8), g1 = *(const f32x4*)(rng + h * 256 + c8 + 4);
        const f32x4 p0 = *(const LAS f32x4*)(lds + tk * 1040 + c8 * 4), p1 = *(const LAS f32x4*)(lds + tk * 1040 + c8 * 4 + 16);
        u32x4 o;
        o.x = pk2(p0[0] * g0[0] * silu_f(bflo(gz.x)), p0[1] * g0[1] * silu_f(bfhi(gz.x))); o.y = pk2(p0[2] * g0[2] * silu_f(bflo(gz.y)), p0[3] * g0[3] * silu_f(bfhi(gz.y)));
        o.z = pk2(p1[0] * g1[0] * silu_f(bflo(gz.z)), p1[1] * g1[1] * silu_f(bfhi(gz.z))); o.w = pk2(p1[2] * g1[2] * silu_f(bflo(gz.w)), p1[3] * g1[3] * silu_f(bfhi(gz.w)));
        *(u32x4*)(MIX + token * DM + 1024 + h * 256 + c8) = o;
    }
    __syncthreads();
}

DI void ret_decode_unit(LAS unsigned char* lds, const bf16_t* Z, const float* S0, float* S1, bf16_t* MIX, const float* rng, int b, int h, int tid) {
    LAS float* qv = (LAS float*)lds; LAS float* red = qv + 768;
    const int lane = tid & 63, wid = tid >> 6;
    const bf16_t* zrow = Z + (size_t)(LP + b) * INW;
    if (tid < 256) { qv[tid] = bf2f(zrow[C_RQ + h * 256 + tid]); qv[256 + tid] = bf2f(zrow[C_RK + h * 256 + tid]); qv[512 + tid] = bf2f(zrow[C_RV + h * 256 + tid]); }
    __syncthreads();
    const float gm = gamma_of(h);
    const f32x4 v4 = *(const LAS f32x4*)(qv + 512 + 4 * lane);
    f32x4 acc = {0.f, 0.f, 0.f, 0.f};
    const size_t off = ((size_t)(b * 4 + h) * 256 + wid * 32) * 256 + 4 * lane;
    const float* s0 = S0 + off; float* s1 = S1 + off;
#pragma unroll 1
    for (int rr = 0; rr < 32; rr += 16) {
        f32x4 s[16];
#pragma unroll
        for (int u = 0; u < 16; ++u) s[u] = __builtin_nontemporal_load((const f32x4*)(s0 + (size_t)(rr + u) * 256));
#pragma unroll
        for (int u = 0; u < 16; ++u) { const int dk = wid * 32 + rr + u; const float kk = qv[256 + dk], qq = qv[dk];
            const f32x4 sn = s[u] * gm + v4 * kk; __builtin_nontemporal_store(sn, (f32x4*)(s1 + (size_t)(rr + u) * 256)); acc += sn * qq; }
    }
    *(LAS f32x4*)(red + wid * 256 + 4 * lane) = acc;
    __syncthreads();
    if (wid == 0) {
        f32x4 o = {0.f, 0.f, 0.f, 0.f};
#pragma unroll
        for (int w = 0; w < 8; ++w) o += *(const LAS f32x4*)(red + w * 256 + 4 * lane);
        const float ssq = wave_sum((o[0] * o[0] + o[1] * o[1]) + (o[2] * o[2] + o[3] * o[3]));
        const float rstd = rsqrtf(ssq * (1.0f / 256.0f) + EPS);
        const u32x2 gz = *(const u32x2*)(zrow + C_RG + h * 256 + 4 * lane);
        const f32x4 gn = *(const f32x4*)(rng + h * 256 + 4 * lane);
        u32x2 y; y.x = pk2(o[0] * rstd * gn[0] * silu_f(bflo(gz.x)), o[1] * rstd * gn[1] * silu_f(bfhi(gz.x)));
        y.y = pk2(o[2] * rstd * gn[2] * silu_f(bflo(gz.y)), o[3] * rstd * gn[3] * silu_f(bfhi(gz.y)));
        *(u32x2*)(MIX + (size_t)(LP + b) * DM + 1024 + h * 256 + 4 * lane) = y;
    }
    __syncthreads();
}

DI void attn_prompt_unit(LAS unsigned char* lds, const bf16_t* Z, bf16_t* MIX, const float* gq, const float* gk, const float* sinks, float* o_k, float* o_v, int nb, int kh, int hf, int tid) {
    LAS unsigned char* Kn = lds; LAS unsigned char* Vt = lds + 256 * 144;
    const int lane = tid & 63, wid = tid >> 6, r = lane & 31, hh = lane >> 5;
    {
        const int row = tid >> 1, half = tid & 1; const int tok = (nb - 1) * 128 + row;
        u32x4 v[4];
#pragma unroll
        for (int c = 0; c < 4; ++c) v[c] = (u32x4){0u, 0u, 0u, 0u};
        if (tok >= 0) {
#pragma unroll
            for (int c = 0; c < 4; ++c) v[c] = *(const u32x4*)(Z + (size_t)tok * INW + C_AK + kh * 64 + half * 32 + c * 8);
        }
        float f[32]; float ss = 0.f;
#pragma unroll
        for (int c = 0; c < 4; ++c)
#pragma unroll
            for (int e = 0; e < 4; ++e) { f[c * 8 + 2 * e] = bflo(v[c][e]); f[c * 8 + 2 * e + 1] = bfhi(v[c][e]); }
#pragma unroll
        for (int e = 0; e < 32; ++e) ss += f[e] * f[e];
        ss += __shfl_xor(ss, 1);
        const float rstd = rsqrtf(ss * (1.0f / 64.0f) + EPS);
#pragma unroll
        for (int c = 0; c < 8; ++c) { const f32x4 g = *(const f32x4*)(gk + half * 32 + c * 4);
#pragma unroll
            for (int e = 0; e < 4; ++e) f[c * 4 + e] *= rstd * g[e]; }
#pragma unroll
        for (int c = 0; c < 4; ++c) { u32x4 w; w.x = pk2(f[c * 8], f[c * 8 + 1]); w.y = pk2(f[c * 8 + 2], f[c * 8 + 3]); w.z = pk2(f[c * 8 + 4], f[c * 8 + 5]); w.w = pk2(f[c * 8 + 6], f[c * 8 + 7]);
            *(LAS u32x4*)(Kn + row * 144 + half * 64 + c * 16) = w; }
        if (nb == 63 && hf == 0 && row >= 128) { float* o = o_k + ((size_t)(row - 128) * 2 + kh) * 64 + half * 32;
#pragma unroll
            for (int c = 0; c < 8; ++c) *(f32x4*)(o + c * 4) = (f32x4){f[c * 4], f[c * 4 + 1], f[c * 4 + 2], f[c * 4 + 3]}; }
    }
#pragma unroll
    for (int k = 0; k < 2; ++k) {
        const int it = k * 512 + tid, kpl = it & 15, dgl = (it >> 4) & 3, rest = it >> 6, dg = dgl + 4 * (rest & 1), kp = kpl + 16 * (rest >> 1);
        const int tok0 = (nb - 1) * 128 + 2 * kp;
        u32x4 a = {0u, 0u, 0u, 0u}, b = {0u, 0u, 0u, 0u};
        if (tok0 >= 0) { const bf16_t* p = Z + (size_t)tok0 * INW + C_AV + kh * 64 + dg * 8; a = *(const u32x4*)p; b = *(const u32x4*)(p + INW); }
#pragma unroll
        for (int e = 0; e < 8; ++e) {
            const unsigned lo = (e & 1) ? (a[e >> 1] >> 16) : (a[e >> 1] & 0xffffu), hi = (e & 1) ? (b[e >> 1] & 0xffff0000u) : (b[e >> 1] << 16);
            *(LAS unsigned*)(Vt + (dg * 8 + e) * 520 + kp * 4) = lo | hi;
        }
        if (nb == 63 && hf == 0 && kp >= 64) { float* o = o_v + ((size_t)(2 * kp - 128) * 2 + kh) * 64 + dg * 8;
#pragma unroll
            for (int e = 0; e < 4; ++e) { o[2 * e] = bflo(a[e]); o[2 * e + 1] = bfhi(a[e]); o[128 + 2 * e] = bflo(b[e]); o[128 + 2 * e + 1] = bfhi(b[e]); } }
    }
    __syncthreads();
    const int hq = kh * 8 + 4 * hf + (wid >> 1), qh = wid & 1;
    const float sink = sinks[hq] * 1.4426950408889634f;
#pragma unroll 1
    for (int qq = 0; qq < 2; ++qq) {
        const int qi = 2 * qh + qq; const size_t tokq = (size_t)nb * 128 + 32 * qi + r;
        bf16x8 qf[4];
        {   const bf16_t* qp = Z + tokq * INW + hq * 64 + 8 * hh;
            u32x4 raw[4]; float ss = 0.f;
#pragma unroll
            for (int s = 0; s < 4; ++s) { raw[s] = *(const u32x4*)(qp + 16 * s);
#pragma unroll
                for (int e = 0; e < 4; ++e) { const float lo = bflo(raw[s][e]), hi = bfhi(raw[s][e]); ss += lo * lo + hi * hi; } }
            ss += __shfl_xor(ss, 32);
            const float rstd = rsqrtf(ss * (1.0f / 64.0f) + EPS) * (0.125f * 1.4426950408889634f);
#pragma unroll
            for (int s = 0; s < 4; ++s) { const f32x4 g0 = *(const f32x4*)(gq + 16 * s + 8 * hh), g1 = *(const f32x4*)(gq + 16 * s + 8 * hh + 4); u32x4 w;
                w.x = pk2(bflo(raw[s].x) * rstd * g0[0], bfhi(raw[s].x) * rstd * g0[1]); w.y = pk2(bflo(raw[s].y) * rstd * g0[2], bfhi(raw[s].y) * rstd * g0[3]);
                w.z = pk2(bflo(raw[s].z) * rstd * g1[0], bfhi(raw[s].z) * rstd * g1[1]); w.w = pk2(bflo(raw[s].w) * rstd * g1[2], bfhi(raw[s].w) * rstd * g1[3]);
                qf[s] = __builtin_bit_cast(bf16x8, w); }
        }
        f32x16 X[5];
#pragma unroll
        for (int t = 0; t < 5; ++t) { X[t] = zero16();
#pragma unroll
            for (int s = 0; s < 4; ++s) { const bf16x8 A = *(const LAS bf16x8*)(Kn + (32 * (qi + t) + r) * 144 + (16 * s + 8 * hh) * 2); X[t] = MFMA32(A, qf[s], X[t]); } }
        float m = -1e30f;
#pragma unroll
        for (int i = 0; i < 16; ++i) { X[0][i] = (crow(i, hh) >= r) ? X[0][i] : -1e30f; X[4][i] = (crow(i, hh) <= r) ? X[4][i] : -1e30f; }
#pragma unroll
        for (int t = 0; t < 5; ++t) { const bool out_t = (nb == 0) && (qi + t < 4);
#pragma unroll
            for (int i = 0; i < 16; ++i) { X[t][i] = out_t ? -1e30f : X[t][i]; m = fmaxf(m, X[t][i]); } }
        m = fmaxf(m, __shfl_xor(m, 32)); m = fmaxf(m, sink);
        float sum = 0.f;
#pragma unroll
        for (int t = 0; t < 5; ++t)
#pragma unroll
            for (int i = 0; i < 16; ++i) { const float p = __builtin_amdgcn_exp2f(X[t][i] - m); X[t][i] = p; sum += p; }
        sum += __shfl_xor(sum, 32);
        const float inv = 1.0f / (sum + __builtin_amdgcn_exp2f(sink - m));
        f32x16 o[2]; o[0] = zero16(); o[1] = zero16();
#pragma unroll
        for (int t = 0; t < 5; ++t)
#pragma unroll
            for (int s2 = 0; s2 < 2; ++s2) { const bf16x8 xs = pack8(X[t], s2);
#pragma unroll
                for (int dt = 0; dt < 2; ++dt) { const LAS unsigned char* pa = Vt + (32 * dt + r) * 520 + (32 * (qi + t) + 16 * s2 + 4 * hh) * 2;
                    const bf16x8 A = cat4(*(const LAS s16x4*)pa, *(const LAS s16x4*)(pa + 16)); o[dt] = MFMA32(A, xs, o[dt]); } }
#pragma unroll
        for (int dt = 0; dt < 2; ++dt)
#pragma unroll
            for (int g4 = 0; g4 < 4; ++g4) { u32x2 w; w.x = pk2(o[dt][4 * g4] * inv, o[dt][4 * g4 + 1] * inv); w.y = pk2(o[dt][4 * g4 + 2] * inv, o[dt][4 * g4 + 3] * inv);
                *(u32x2*)(MIX + tokq * DM + hq * 64 + 32 * dt + 8 * g4 + 4 * hh) = w; }
    }
    __syncthreads();
}

DI void attn_decode_unit(LAS unsigned char* lds, const bf16_t* Z, const float* ck, const float* cv, bf16_t* MIX, const float* gq, const float* gk, const float* sinks, float* o_k, float* o_v, int b, int kh, int tid) {
    LAS float* Kc = (LAS float*)lds; LAS float* Vc = Kc + 129 * 68; LAS float* qs = Vc + 129 * 64; LAS float* pw = qs + 512;
    const int lane = tid & 63, wid = tid >> 6;
#pragma unroll
    for (int k = 0; k < 4; ++k) {
        const int it = k * 512 + tid, w = it >> 4, c4 = (it & 15) * 4;
        const size_t src = ((size_t)(b * 128 + w) * 2 + kh) * 64 + c4;
        const f32x4 k4 = *(const f32x4*)(ck + src), v4 = *(const f32x4*)(cv + src);
        *(LAS f32x4*)(Kc + w * 68 + c4) = k4; *(LAS f32x4*)(Vc + w * 64 + c4) = v4;
        if (w >= 1) { const size_t dst = ((size_t)(b * 128 + w - 1) * 2 + kh) * 64 + c4; *(f32x4*)(o_k + dst) = k4; *(f32x4*)(o_v + dst) = v4; }
    }
    const bf16_t* zrow = Z + (size_t)(LP + b) * INW;
    const size_t dnew = ((size_t)(b * 128 + 127) * 2 + kh) * 64 + lane;
    if (wid == 0) { const float kx = bf2f(zrow[C_AK + kh * 64 + lane]); const float ss = wave_sum(kx * kx); const float kn = kx * rsqrtf(ss * (1.0f / 64.0f) + EPS) * gk[lane];
        Kc[128 * 68 + lane] = kn; o_k[dnew] = kn; }
    if (wid == 1) { const float vx = bf2f(zrow[C_AV + kh * 64 + lane]); Vc[128 * 64 + lane] = vx; o_v[dnew] = vx; }
    const int hq = kh * 8 + wid;
    { const float qx = bf2f(zrow[hq * 64 + lane]); const float ss = wave_sum(qx * qx); qs[wid * 64 + lane] = qx * rsqrtf(ss * (1.0f / 64.0f) + EPS) * gq[lane] * 0.125f; }
    __syncthreads();
    float s1 = 0.f, s2 = 0.f;
#pragma unroll 4
    for (int d4 = 0; d4 < 16; ++d4) { const f32x4 q = *(const LAS f32x4*)(qs + wid * 64 + 4 * d4), k1 = *(const LAS f32x4*)(Kc + lane * 68 + 4 * d4), k2 = *(const LAS f32x4*)(Kc + (lane + 64) * 68 + 4 * d4);
        s1 += (q[0] * k1[0] + q[1] * k1[1]) + (q[2] * k1[2] + q[3] * k1[3]); s2 += (q[0] * k2[0] + q[1] * k2[1]) + (q[2] * k2[2] + q[3] * k2[3]); }
    const float s3 = wave_sum(qs[wid * 64 + lane] * Kc[128 * 68 + lane]);
    const float sink = sinks[hq];
    const float m = fmaxf(wave_max(fmaxf(s1, s2)), fmaxf(s3, sink));
    const float p1 = __expf(s1 - m), p2 = __expf(s2 - m), p3 = __expf(s3 - m);
    const float denom = wave_sum(p1 + p2) + p3 + __expf(sink - m);
    pw[wid * 132 + lane] = p1; pw[wid * 132 + 64 + lane] = p2; if (lane == 0) pw[wid * 132 + 128] = p3;
    __syncthreads();
    float o = pw[wid * 132 + 128] * Vc[128 * 64 + lane];
#pragma unroll 4
    for (int j4 = 0; j4 < 32; ++j4) { const f32x4 p4 = *(const LAS f32x4*)(pw + wid * 132 + 4 * j4);
        o += (p4[0] * Vc[(4 * j4) * 64 + lane] + p4[1] * Vc[(4 * j4 + 1) * 64 + lane]) + (p4[2] * Vc[(4 * j4 + 2) * 64 + lane] + p4[3] * Vc[(4 * j4 + 3) * 64 + lane]); }
    MIX[(size_t)(LP + b) * DM + hq * 64 + lane] = (bf16_t)(pk2(o / denom, 0.f) & 0xffffu);
    __syncthreads();
}

template <int MT, class Epi>
DI void skinny_unit(LAS unsigned char* lds, const bf16_t* A, const bf16_t* Wt, int K, int cgi, int k0, int row0, const Epi& E, int tid) {
    const int lane = tid & 63, wid = tid >> 6, fr = lane & 15, fq = lane >> 4;
    const int c0 = cgi * 32;
    constexpr int NMT = 2 * MT;
    const bf16_t* pa = A + (size_t)(row0 + fr) * K + k0 + wid * 256 + 8 * fq;
    const bf16_t* pb = Wt + (size_t)(c0 + fr) * K + k0 + wid * 256 + 8 * fq;
    const size_t rs = (size_t)16 * K;
    f32x4 acc[NMT][2];
#pragma unroll
    for (int i = 0; i < NMT; ++i) { acc[i][0] = (f32x4){0.f, 0.f, 0.f, 0.f}; acc[i][1] = (f32x4){0.f, 0.f, 0.f, 0.f}; }
    bf16x8 fb[3][2], fa[3][NMT];
#define SK_LOAD(buf, c) do { _Pragma("unroll") for (int nt = 0; nt < 2; ++nt) fb[buf][nt] = *(const bf16x8*)(pb + nt * rs + 32 * (c)); \
        _Pragma("unroll") for (int mt = 0; mt < NMT; ++mt) fa[buf][mt] = *(const bf16x8*)(pa + mt * rs + 32 * (c)); } while (0)
#define SK_MMA(buf) do { _Pragma("unroll") for (int mt = 0; mt < NMT; ++mt) _Pragma("unroll") for (int nt = 0; nt < 2; ++nt) \
        acc[mt][nt] = __builtin_amdgcn_mfma_f32_16x16x32_bf16(fa[buf][mt], fb[buf][nt], acc[mt][nt], 0, 0, 0); } while (0)
    SK_LOAD(0, 0); SK_LOAD(1, 1);
    SK_LOAD(2, 2); SK_MMA(0);
    SK_LOAD(0, 3); SK_MMA(1);
    SK_LOAD(1, 4); SK_MMA(2);
    SK_LOAD(2, 5); SK_MMA(0);
    SK_LOAD(0, 6); SK_MMA(1);
    SK_LOAD(1, 7); SK_MMA(2);
    SK_MMA(0); SK_MMA(1);
#undef SK_LOAD
#undef SK_MMA
    constexpr int NR = 32 * MT;
    LAS float* red = (LAS float*)lds;
#pragma unroll
    for (int mt = 0; mt < NMT; ++mt)
#pragma unroll
        for (int nt = 0; nt < 2; ++nt)
#pragma unroll
            for (int j = 0; j < 4; ++j) red[(wid * NR + mt * 16 + 4 * fq + j) * 32 + nt * 16 + fr] = acc[mt][nt][j];
    __syncthreads();
    if (MT == 4) {
        const int row = tid >> 2, c8 = (tid & 3) * 8;
        f32x4 sa = {0.f, 0.f, 0.f, 0.f}, sb = {0.f, 0.f, 0.f, 0.f};
#pragma unroll
        for (int w = 0; w < 8; ++w) { sa += *(const LAS f32x4*)(red + (w * NR + row) * 32 + c8); sb += *(const LAS f32x4*)(red + (w * NR + row) * 32 + c8 + 4); }
        E(row0 + row, c0 + c8, sa); E(row0 + row, c0 + c8 + 4, sb);
    } else if (tid < 8 * NR) {
        const int row = tid >> 3, c4 = (tid & 7) * 4;
        f32x4 sa = {0.f, 0.f, 0.f, 0.f};
#pragma unroll
        for (int w = 0; w < 8; ++w) sa += *(const LAS f32x4*)(red + (w * NR + row) * 32 + c4);
        E(row0 + row, c0 + c4, sa);
    }
    __syncthreads();
}
struct SkOut { const float* xs; float* X1s; bf16_t* XBs;
    DI void operator()(int row, int col, f32x4 a) const { const f32x4 v = a + *(const f32x4*)(xs + (size_t)row * DM + col); *(f32x4*)(X1s + (size_t)row * DM + col) = v;
        u32x2 o; o.x = pk2(v[0], v[1]); o.y = pk2(v[2], v[3]); *(u32x2*)(XBs + (size_t)row * DM + col) = o; } };
struct SkUp { bf16_t* Us;
    DI void operator()(int row, int col, f32x4 a) const {
#pragma unroll
        for (int e = 0; e < 4; ++e) { a[e] = fmaxf(a[e], 0.f); a[e] *= a[e]; }
        u32x2 o; o.x = pk2(a[0], a[1]); o.y = pk2(a[2], a[3]); *(u32x2*)(Us + (size_t)row * FF + col) = o; } };
struct SkSlab { float* slab;
    DI void operator()(int row, int col, f32x4 a) const { *(f32x4*)(slab + (size_t)row * DM + col) = a; } };

#define RLX_AGENT __ATOMIC_RELAXED, __HIP_MEMORY_SCOPE_AGENT
#define XB_TMO      128
#define XB_XCNT(j)  (256  + 64 * (j))
#define XB_XSUB(j)  (1280 + 64 * (j))
#define XB_XGEN(j)  (2304 + 64 * (j))
#define XB_TOP      3328
#define XB_TOPGEN   3392
#define XCD_BAR_WORDS 3456
#define XB_SPIN_CAP (1u << 18)

__device__ __forceinline__ unsigned xb_ld(unsigned* p)              { return __hip_atomic_load(p, __ATOMIC_RELAXED, __HIP_MEMORY_SCOPE_AGENT); }
__device__ __forceinline__ unsigned xb_add(unsigned* p, unsigned v) { return __hip_atomic_fetch_add(p, v, __ATOMIC_RELAXED, __HIP_MEMORY_SCOPE_AGENT); }
__device__ __forceinline__ unsigned xb_xcc_id() { return (unsigned)__builtin_amdgcn_s_getreg((3 << 11) | 20) & 0xFu; }
#define XB_SPIN(cond, bar) do { unsigned _sp = 0; while (cond) { __builtin_amdgcn_s_sleep(1); \
    if ((++_sp & 255u) == 0u) { if (xb_ld(&(bar)[XB_TMO])) break; if (_sp > XB_SPIN_CAP) { atomicAdd(&(bar)[XB_TMO], 1u); break; } } } } while (0)

struct XcdBarrier {
    unsigned* bar; unsigned x;
    volatile LAS unsigned* st;
};

__device__ __forceinline__ XcdBarrier xcd_barrier_post(unsigned* bar, volatile LAS unsigned* st) {
    XcdBarrier b; b.bar = bar; b.x = xb_xcc_id(); b.st = st;
    if (threadIdx.x == 0) (void)xb_add(&bar[XB_XCNT(b.x)], 1u);
    return b;
}
__device__ __forceinline__ void xcd_barrier_complete(unsigned* bar, unsigned x, unsigned& nloc, unsigned& nx) {
    const unsigned G = gridDim.x * gridDim.y * gridDim.z;
    unsigned sum, cnt, mine, sp = 0u;
    for (;;) {
        sum = 0u; cnt = 0u; mine = 0u;
#pragma unroll
        for (unsigned j = 0; j < 16; ++j) { const unsigned c = xb_ld(&bar[XB_XCNT(j)]); sum += c; cnt += (c > 0u) ? 1u : 0u; mine = (j == x) ? c : mine; }
        if (sum == G) break;
        __builtin_amdgcn_s_sleep(1);
        if ((++sp & 255u) == 0u) { if (xb_ld(&bar[XB_TMO])) break; if (sp > XB_SPIN_CAP) { atomicAdd(&bar[XB_TMO], 1u); break; } }
    }
    nloc = mine > 0u ? mine : 1u; nx = cnt > 0u ? cnt : 1u;
}

__device__ __forceinline__ void xcd_barrier(const XcdBarrier& b) {
    asm volatile("s_waitcnt vmcnt(0)" ::: "memory");
    __syncthreads();
    if (threadIdx.x == 0) {
        unsigned* bar = b.bar;
        __builtin_amdgcn_s_waitcnt(0);
        unsigned nloc = b.st[0], nx = b.st[1];
        if (nloc == 0u) { xcd_barrier_complete(bar, b.x, nloc, nx); b.st[0] = nloc; b.st[1] = nx; }
        const unsigned old = xb_add(&bar[XB_XSUB(b.x)], 1u);
        const unsigned gen = old / nloc;
        if (old + 1u == (gen + 1u) * nloc) {
            __builtin_amdgcn_fence(__ATOMIC_RELEASE, "agent");
            asm volatile("s_waitcnt vmcnt(0)" ::: "memory");
            const unsigned og = xb_add(&bar[XB_TOP], 1u);
            const unsigned tg = og / nx;
            if (og + 1u == (tg + 1u) * nx) xb_add(&bar[XB_TOPGEN], 1u);
            else XB_SPIN(xb_ld(&bar[XB_TOPGEN]) == tg, bar);
            __builtin_amdgcn_fence(__ATOMIC_ACQUIRE, "agent");
            xb_add(&bar[XB_XGEN(b.x)], 1u);
            asm volatile("s_waitcnt vmcnt(0)" ::: "memory");
        } else {
            XB_SPIN(xb_ld(&bar[XB_XGEN(b.x)]) == gen, bar);
            __builtin_amdgcn_fence(__ATOMIC_ACQUIRE, "agent");
            asm volatile("s_waitcnt vmcnt(0)" ::: "memory");
        }
    }
    __syncthreads();
}

struct Args { const float* in[15]; float* out; unsigned char* ws; int ph_lo, ph_hi; };
constexpr int NPH = 9;
constexpr int NP0_REST = 9216;

__global__ void __launch_bounds__(512, 2) fwd_kernel(Args a) {
    extern __shared__ __attribute__((aligned(16))) unsigned char lds_raw[];
    LAS unsigned char* lds = (LAS unsigned char*)lds_raw;
    cg::grid_group grid = cg::this_grid();
    const int tid = threadIdx.x, lane = tid & 63, wid = __builtin_amdgcn_readfirstlane(tid >> 6);
    const int G = gridDim.x, bx = blockIdx.x;
    unsigned char* ws = a.ws; float* out = a.out;
    const float* x_p = a.in[0]; const float* x_s = a.in[1]; const float* cache_k = a.in[2]; const float* cache_v = a.in[3]; const float* state0 = a.in[4];
    const float* ln1_g = a.in[5]; const float* w_in = a.in[6]; const float* gq = a.in[7]; const float* gk = a.in[8]; const float* sinks = a.in[9];
    const float* rng = a.in[10]; const float* w_out = a.in[11]; const float* ln2_g = a.in[12]; const float* w_up = a.in[13]; const float* w_dn = a.in[14];
    bf16_t* WIN = (bf16_t*)(ws + WS_WIN); bf16_t* WOUT = (bf16_t*)(ws + WS_WOUT); bf16_t* WUP = (bf16_t*)(ws + WS_WUP); bf16_t* WDN = (bf16_t*)(ws + WS_WDN);
    bf16_t* H1 = (bf16_t*)(ws + WS_H1); bf16_t* XG = H1; bf16_t* MIX = (bf16_t*)(ws + WS_MIX); bf16_t* Z = (bf16_t*)(ws + WS_Z); bf16_t* U = (bf16_t*)(ws + WS_U);
    float* PART = (float*)(ws + WS_PART); float* RSTD2 = (float*)(ws + WS_RSTD2); bf16_t* KV = (bf16_t*)(ws + WS_KV); bf16_t* SP = (bf16_t*)(ws + WS_SP); float* SLAB = (float*)(ws + WS_SP);
    const int lo = a.ph_lo, hi = a.ph_hi;
#define IN(k) (lo <= (k) && (k) < hi)
    volatile LAS unsigned* MISC = (volatile LAS unsigned*)(lds + LDS_BYTES - 64);
    if (tid < 16) MISC[tid] = 0u;
    __syncthreads();
    const XcdBarrier bar = xcd_barrier_post((unsigned*)ws + 1024, MISC + 8);
    if (lo > hi) grid.sync();
#define SEAM(k) do { if (IN(k) && IN((k) + 1)) xcd_barrier(bar); } while (0)

    if (IN(0)) for (int rep_ = 0; rep_ < 1 + ((DUPMASK >> 0) & 1); ++rep_) { if (rep_) xcd_barrier(bar);
        LAS float* scr = (LAS float*)(lds + wid * 17408);
        const int gw = bx * 8 + wid, NGW = G * 8;
        constexpr int I_IN = (DM / 64) * (INW / 32);
        p0_convert(ResIn{w_in, WIN}, gw, NGW, I_IN, scr, lane);
        for (int m = gw; m < MP; m += NGW) {
            if (m < MR) rms_row(m < LP ? x_p + (size_t)m * DM : x_s + (size_t)(m - LP) * DM, ln1_g, H1 + (size_t)m * DM, lane);
            else {
#pragma unroll
                for (int j = 0; j < 8; ++j) *((u32x2*)(H1 + (size_t)m * DM) + lane + 64 * j) = (u32x2){0u, 0u};
            }
        }
    }
    SEAM(0);
    if (IN(1)) for (int rep_ = 0; rep_ < 1 + ((DUPMASK >> 1) & 1); ++rep_) { if (rep_) xcd_barrier(bar);
        pg8::Gemm g{H1, WIN, MP, INW, DM}; pg8::StaticOrder S; S.init(MP, INW, G, bx, WGM_IN);
        pg8::EpiIn E{Z};
        pg8::gemm_phase<pg8::EpiIn, pg8::StaticOrder, true, true>(lds, g, S, E);
        {
            constexpr int NT = (MP / 256) * (INW / 256); const int rounds = (NT + G - 1) / G, first_idle = NT - (rounds - 1) * G;
            const int nidle = (first_idle < G) ? (G - first_idle) : G, me = (first_idle < G) ? (bx - first_idle) : bx;
            if (me >= 0) {
                LAS float* scr = (LAS float*)(lds + wid * 17408);
                constexpr int I_OUT = (DM / 64) * (DM / 32), I_UP = (DM / 64) * (FF / 32), I_DN = (FF / 64) * (DM / 32);
                p0_convert(ResRest{w_out, w_up, w_dn, WOUT, WUP, WDN, ln2_g}, NP0_REST + me * 8 + wid, nidle * 8, I_OUT + I_UP + I_DN, scr, lane);
            }
        }
    }
    SEAM(1);
    if (IN(2)) for (int rep_ = 0; rep_ < 1 + ((DUPMASK >> 2) & 1); ++rep_) { if (rep_) xcd_barrier(bar);
        if (bx & 1) for (int u = bx; u < 256; u += G) ret_decode_unit(lds, Z, state0, out + O_SS, MIX, rng, u >> 2, u & 3, tid);
        for (int u = bx; u < 256; u += G) ret_step1(lds, Z, KV, u >> 2, u & 3, tid);
        if (!(bx & 1)) for (int u = bx; u < 256; u += G) ret_decode_unit(lds, Z, state0, out + O_SS, MIX, rng, u >> 2, u & 3, tid);
    }
    SEAM(2);
    if (IN(3)) for (int rep_ = 0; rep_ < 1 + ((DUPMASK >> 3) & 1); ++rep_) { if (rep_) xcd_barrier(bar);
        if (tid < 256) ret_scan(KV, SP, out + O_SP, bx * 256 + tid, G * 256);
        if (bx & 1) for (int u = bx; u < 256; u += G) attn_decode_unit(lds, Z, cache_k, cache_v, MIX, gq, gk, sinks, out + O_KS, out + O_VS, u >> 1, u & 1, tid);
        for (int u = 256 + bx; u < 512; u += G) ret_decode_unit(lds, Z, state0, out + O_SS, MIX, rng, u >> 2, u & 3, tid);
        if (!(bx & 1)) for (int u = bx; u < 256; u += G) attn_decode_unit(lds, Z, cache_k, cache_v, MIX, gq, gk, sinks, out + O_KS, out + O_VS, u >> 1, u & 1, tid);
    }
    SEAM(3);
    if (IN(4)) for (int rep_ = 0; rep_ < 1 + ((DUPMASK >> 4) & 1); ++rep_) { if (rep_) xcd_barrier(bar);
        for (int u = bx; u < 256; u += G) ret_step2(lds, Z, SP, MIX, rng, u >> 2, u & 3, tid);
        for (int u = bx; u < 256; u += G) attn_prompt_unit(lds, Z, MIX, gq, gk, sinks, out + O_KP, out + O_VP, u >> 2, (u >> 1) & 1, u & 1, tid);
        {
            LAS float* scr = (LAS float*)(lds + wid * 17408);
            p0_convert(ResRest{w_out, w_up, w_dn, WOUT, WUP, WDN, ln2_g}, bx * 8 + wid, G * 8, NP0_REST, scr, lane);
        }
    }
    SEAM(4);
    if (IN(5)) for (int rep_ = 0; rep_ < 1 + ((DUPMASK >> 5) & 1); ++rep_) { if (rep_) xcd_barrier(bar);
        pg8::Gemm g{MIX, WOUT, LP, DM, DM}; pg8::StaticOrder S; S.init(LP, DM, G, bx, WGM_OUT);
        pg8::EpiOut E{x_p, XG, PART};
        pg8::gemm_phase<pg8::EpiOut, pg8::StaticOrder, true, true>(lds, g, S, E);
        const SkOut SE{x_s, out + O_Y + (size_t)LP * DM, XG + (size_t)LP * DM};
        for (int u = bx; u < 4 * (DM / 32); u += G) skinny_unit<1>(lds, MIX + (size_t)LP * DM, WOUT, DM, u >> 2, 0, (u & 3) * 32, SE, tid);
    }
    SEAM(5);
    if (IN(6)) for (int rep_ = 0; rep_ < 1 + ((DUPMASK >> 6) & 1); ++rep_) { if (rep_) xcd_barrier(bar);
        for (int row = bx + G * tid; row < LP; row += G * 512) { float s = 0.f;
#pragma unroll
            for (int j = 0; j < 8; ++j) { const f32x4 p = *(const f32x4*)(PART + (size_t)row * 32 + 4 * j); s += (p[0] + p[1]) + (p[2] + p[3]); }
            RSTD2[row] = 1.0f / (s * (1.0f / DM) + EPS); }
        for (int row = LP + bx * 8 + wid; row < MR; row += G * 8) {
            const float* xr = out + O_Y + (size_t)row * DM; float s = 0.f;
#pragma unroll
            for (int j = 0; j < 8; ++j) { const f32x4 v = *((const f32x4*)xr + lane + 64 * j); s += (v[0] * v[0] + v[1] * v[1]) + (v[2] * v[2] + v[3] * v[3]); }
            s = wave_sum(s); if (lane == 0) RSTD2[row] = 1.0f / (s * (1.0f / DM) + EPS); }
        pg8::Gemm g{XG, WUP, LP, FF, DM}; pg8::StaticOrder S; S.init(LP, FF, G, bx, WGM_UP);
        pg8::EpiUp E{U};
        pg8::gemm_phase<pg8::EpiUp, pg8::StaticOrder, true, true>(lds, g, S, E);
        const SkUp SE{U + (size_t)LP * FF};
        for (int u = bx; u < FF / 32; u += G) skinny_unit<4>(lds, XG + (size_t)LP * DM, WUP, DM, u, 0, 0, SE, tid);
    }
    SEAM(6);
    if (IN(7)) {
        if (bx & 1) for (int u = bx; u < 4 * (DM / 32); u += G) { const SkSlab SE{SLAB + (size_t)(u & 3) * NS * DM}; skinny_unit<4>(lds, U + (size_t)LP * FF, WDN, FF, u >> 2, (u & 3) * 2048, 0, SE, tid); }
        pg8::Gemm g{U, WDN, LP, DM, FF}; pg8::StaticOrder S; S.init(LP, DM, G, bx, WGM_DN);
        pg8::EpiDown E{out + O_Y, XG, RSTD2};
        pg8::gemm_phase<pg8::EpiDown, pg8::StaticOrder, true, true>(lds, g, S, E);
        if (!(bx & 1)) for (int u = bx; u < 4 * (DM / 32); u += G) { const SkSlab SE{SLAB + (size_t)(u & 3) * NS * DM}; skinny_unit<4>(lds, U + (size_t)LP * FF, WDN, FF, u >> 2, (u & 3) * 2048, 0, SE, tid); }
    }
    SEAM(7);
    if (IN(8)) {
        for (int e = bx * 512 + tid; e < NS * DM / 4; e += G * 512) {
            const int row = e >> 9; float* p = out + O_Y + (size_t)LP * DM + (size_t)e * 4;
            const f32x4 s = (*(const f32x4*)(SLAB + (size_t)e * 4) + *(const f32x4*)(SLAB + (size_t)NS * DM + (size_t)e * 4)) + (*(const f32x4*)(SLAB + (size_t)2 * NS * DM + (size_t)e * 4) + *(const f32x4*)(SLAB + (size_t)3 * NS * DM + (size_t)e * 4));
            *(f32x4*)p = *(const f32x4*)p + s * RSTD2[LP + row];
        }
    }
#undef IN
#undef SEAM
}

#ifndef N_LAUNCHES
#define N_LAUNCHES 1
#endif
extern "C" void kernel_launch(void* const* d_in, const int* in_sizes, int n_in, void* d_out, int out_size, void* d_ws, size_t ws_size, hipStream_t stream) {
    static int grid = 0;
    if (grid == 0) {
        if (n_in != 15 || (size_t)out_size != O_END || ws_size < WS_END) { fprintf(stderr, "kernel_launch: unexpected shapes (n_in %d out %d ws %zu)\n", n_in, out_size, ws_size); grid = -1; return; }
        int dev = 0, cus = 0, per_cu = 0;
        (void)hipGetDevice(&dev); (void)hipDeviceGetAttribute(&cus, hipDeviceAttributeMultiprocessorCount, dev);
        if (hipFuncSetAttribute((const void*)fwd_kernel, hipFuncAttributeMaxDynamicSharedMemorySize, LDS_BYTES) != hipSuccess) { fprintf(stderr, "kernel_launch: hipFuncSetAttribute failed\n"); grid = -1; return; }
        (void)hipOccupancyMaxActiveBlocksPerMultiprocessor(&per_cu, (const void*)fwd_kernel, 512, LDS_BYTES);
        (void)hipGetLastError();
        if (per_cu < 1) { fprintf(stderr, "kernel_launch: occupancy query says %d blocks per CU\n", per_cu); }
        grid = cus > 0 ? cus : 256;
    }
    if (grid < 0) return;
    if (hipMemsetAsync(d_ws, 0, 65536, stream) != hipSuccess) { fprintf(stderr, "kernel_launch: memset failed\n"); return; }
    Args a{};
    for (int i = 0; i < 15; ++i) a.in[i] = (const float*)d_in[i];
    a.out = (float*)d_out; a.ws = (unsigned char*)d_ws;
    if (N_LAUNCHES == 1) {
        a.ph_lo = 0; a.ph_hi = NPH;
        void* args[] = {&a};
        hipError_t e = hipLaunchCooperativeKernel((const void*)fwd_kernel, dim3(grid), dim3(512), args, LDS_BYTES, stream);
        if (e != hipSuccess) fprintf(stderr, "cooperative launch failed: %s (grid %d)\n", hipGetErrorString(e), grid);
    } else {
        for (int p = 0; p < NPH; ++p) { a.ph_lo = p; a.ph_hi = p + 1; hipLaunchKernelGGL(fwd_kernel, dim3(grid), dim3(512), LDS_BYTES, stream, a); }
    }
}
```

```cpp
#include <hip/hip_runtime.h>
#include <hip/hip_cooperative_groups.h>
#include <cstdio>
#include <cstdint>
namespace cg = cooperative_groups;

#ifndef WGM_IN
#define WGM_IN 3
#endif
#ifndef WGM_OUT
#define WGM_OUT 2
#endif
#ifndef WGM_UP
#define WGM_UP 2
#endif
#ifndef WGM_DN
#define WGM_DN 2
#endif
#ifndef DUPMASK
#define DUPMASK 0
#endif
#define DI __device__ __forceinline__
#define LAS __attribute__((address_space(3)))
typedef float f32x2 __attribute__((ext_vector_type(2)));
typedef float f32x16 __attribute__((ext_vector_type(16)));
typedef short s16x4 __attribute__((ext_vector_type(4)));
typedef unsigned u32x2 __attribute__((ext_vector_type(2)));
typedef __bf16 bf16x2v __attribute__((ext_vector_type(2)));

constexpr int DM = 2048, LP = 8192, NS = 128, MR = LP + NS  , MP = 8448  ;
constexpr int INW = 5376, FF = 8192;
constexpr int C_AQ = 0, C_AK = 1024, C_AV = 1152, C_RQ = 1280, C_RK = 2304, C_RV = 3328, C_RG = 4352;
constexpr float EPS = 1e-6f;

DI unsigned pk2(float lo, float hi) { f32x2 v = {lo, hi}; return __builtin_bit_cast(unsigned, __builtin_convertvector(v, bf16x2v)); }
DI float bflo(unsigned u) { return __uint_as_float(u << 16); }
DI float bfhi(unsigned u) { return __uint_as_float(u & 0xffff0000u); }
DI float bf2f(unsigned short u) { return __uint_as_float(((unsigned)u) << 16); }

namespace pg8 {
#define PG8_LAS __attribute__((address_space(3)))
typedef unsigned short bf16_t;
typedef short bf16x8 __attribute__((ext_vector_type(8)));
typedef float f32x4 __attribute__((ext_vector_type(4)));
typedef unsigned u32x4 __attribute__((ext_vector_type(4)));
constexpr int BM = 256, BK = 64, HALF = 128, HTB = HALF * BK * 2  , STAGE_BYTES = 8 * HTB, NXCD = 8, WGM = 8;

__host__ __device__ __forceinline__ int lds_byte(int r, int c) { const int st = (r >> 4) * 2 + (c >> 5), rr = r & 15, cc = c & 31, ob = rr * 64 + cc * 2; return st * 1024 + (ob ^ (((ob >> 9) & 1) << 5)); }
__host__ __device__ __forceinline__ void stage_rc(int b, int& R, int& C) { const int st = b / 1024, sb = b % 1024, swz = sb ^ (((sb >> 9) & 1) << 5); R = (st >> 1) * 16 + swz / 64; C = (st & 1) * 32 + (swz % 64) / 2; }
__host__ __device__ __forceinline__ int perm32(int rho) { const int n = rho >> 4, i = rho & 15; return 8 * (i >> 2) + 4 * n + (i & 3); }

struct Unit { int pm, pn; };
struct Gemm { const bf16_t* A; const bf16_t* Bt; int M, N, K; };

struct StaticOrder {
    int nM, nN, nwg, G, c, wgm;
    __host__ __device__ void init(int M, int N, int G_, int c_, int wgm_) { nM = M / BM; nN = N / BM; nwg = nM * nN; G = G_; c = c_; wgm = wgm_; }
    __host__ __device__ bool next(int i, Unit& u) const {
        const long L = (long)i * G + c; if (L >= nwg) return false;
        int wgid = (int)L; { const int q = nwg / NXCD, r = nwg % NXCD, xcd = wgid % NXCD, off = wgid / NXCD; wgid = (xcd < r ? xcd * (q + 1) : r * (q + 1) + (xcd - r) * q) + off; }
        const int nig = wgm * nN, gid = wgid / nig, fm = gid * wgm, gsz = (nM - fm) < wgm ? (nM - fm) : wgm;
        u.pm = fm + ((wgid % nig) % gsz); u.pn = (wgid % nig) / gsz; return true;
    }
    __device__ __forceinline__ void a_ready(const Unit&) const {}
    __device__ __forceinline__ void done(const Unit&) const {}
};


DI u32x4 pack8f(const f32x4& a, const f32x4& b) { u32x4 w; w.x = pk2(a[0], a[1]); w.y = pk2(a[2], a[3]); w.z = pk2(b[0], b[1]); w.w = pk2(b[2], b[3]); return w; }

struct EpiIn {
    static constexpr bool PERM = true, AFTER_DRAIN = false;
    bf16_t* Z;
    __device__ __forceinline__ void operator()(const f32x4 (&acc)[2][2][4][2], const Unit& u, int wr, int wc, int fr, int fq) const {
        const int row0 = u.pm * BM + wr * 64 + fr, col0 = u.pn * BM + wc * 32 + 8 * fq;
        if (u.pn < 5 || u.pn > 12) {
#pragma unroll
            for (int ai = 0; ai < 2; ++ai)
#pragma unroll
                for (int m = 0; m < 4; ++m) { bf16_t* rowp = Z + (size_t)(row0 + ai * HALF + m * 16) * INW + col0;
#pragma unroll
                    for (int bj = 0; bj < 2; ++bj) *(u32x4*)(rowp + bj * HALF) = pack8f(acc[ai][bj][m][0], acc[ai][bj][m][1]); }
        } else {
            const int head = (u.pn - 5) & 3; const bool isk = u.pn >= 9;
            const float lg = log1pf(-exp2f(-5.0f - (float)head));
            float inv[8];
#pragma unroll
            for (int j = 0; j < 8; ++j) inv[j] = powf(10000.0f, -(float)(wc * 32 + 8 * fq + j) * (1.0f / 128.0f));
#pragma unroll
            for (int ai = 0; ai < 2; ++ai)
#pragma unroll
                for (int m = 0; m < 4; ++m) {
                    const int row = row0 + ai * HALF + m * 16;
                    const int pos = row < LP ? row : LP; const float t = row < LP ? (float)(row & 127) : 0.0f;
                    const float f = isk ? 0.0625f * __expf(-lg * t) : __expf(lg * t);
                    f32x4 o1[2], o2[2];
#pragma unroll
                    for (int n = 0; n < 2; ++n)
#pragma unroll
                        for (int e = 0; e < 4; ++e) {
                            const float ang = (float)pos * inv[n * 4 + e];
                            double rev = (double)ang * 0.15915494309189535; rev -= floor(rev);
                            const float fr_ = (float)rev; const float sn = __builtin_amdgcn_sinf(fr_), cs = __builtin_amdgcn_cosf(fr_);
                            const float x1 = acc[ai][0][m][n][e], x2 = acc[ai][1][m][n][e];
                            o1[n][e] = (x1 * cs - x2 * sn) * f; o2[n][e] = (x2 * cs + x1 * sn) * f;
                        }
                    bf16_t* rowp = Z + (size_t)row * INW + col0;
                    *(u32x4*)(rowp) = pack8f(o1[0], o1[1]); *(u32x4*)(rowp + HALF) = pack8f(o2[0], o2[1]);
                }
        }
    }
};

struct EpiOut {
    static constexpr bool PERM = true, AFTER_DRAIN = false;
    const float* xp; bf16_t* X1B; float* part;
    __device__ __forceinline__ void operator()(const f32x4 (&acc)[2][2][4][2], const Unit& u, int wr, int wc, int fr, int fq) const {
#pragma unroll
        for (int ai = 0; ai < 2; ++ai)
#pragma unroll
            for (int m = 0; m < 4; ++m) {
                const int row = u.pm * BM + ai * HALF + wr * 64 + m * 16 + fr;
                const float* xrow = xp + (size_t)row * DM;
                float ss = 0.f;
#pragma unroll
                for (int bj = 0; bj < 2; ++bj) {
                    const int col = u.pn * BM + bj * HALF + wc * 32 + 8 * fq;
                    const f32x4 v0 = acc[ai][bj][m][0] + *(const f32x4*)(xrow + col), v1 = acc[ai][bj][m][1] + *(const f32x4*)(xrow + col + 4);
                    ss += (v0[0] * v0[0] + v0[1] * v0[1]) + (v0[2] * v0[2] + v0[3] * v0[3]) + (v1[0] * v1[0] + v1[1] * v1[1]) + (v1[2] * v1[2] + v1[3] * v1[3]);
                    *(u32x4*)(X1B + (size_t)row * DM + col) = pack8f(v0, v1);
                }
                ss += __shfl_xor(ss, 16); ss += __shfl_xor(ss, 32);
                if (fq == 0) part[(size_t)row * 32 + u.pn * 4 + wc] = ss;
            }
    }
};

struct EpiUp {
    static constexpr bool PERM = true, AFTER_DRAIN = false;
    bf16_t* U;
    __device__ __forceinline__ void operator()(const f32x4 (&acc)[2][2][4][2], const Unit& u, int wr, int wc, int fr, int fq) const {
        const int row0 = u.pm * BM + wr * 64 + fr, col0 = u.pn * BM + wc * 32 + 8 * fq;
#pragma unroll
        for (int ai = 0; ai < 2; ++ai)
#pragma unroll
            for (int m = 0; m < 4; ++m) { bf16_t* rowp = U + (size_t)(row0 + ai * HALF + m * 16) * FF + col0;
#pragma unroll
                for (int bj = 0; bj < 2; ++bj) { f32x4 a = acc[ai][bj][m][0], b = acc[ai][bj][m][1];
#pragma unroll
                    for (int e = 0; e < 4; ++e) { a[e] = fmaxf(a[e], 0.f); a[e] *= a[e]; b[e] = fmaxf(b[e], 0.f); b[e] *= b[e]; }
                    *(u32x4*)(rowp + bj * HALF) = pack8f(a, b); } }
    }
};

struct EpiDown {
    static constexpr bool PERM = true, AFTER_DRAIN = false;
    float* Y; const bf16_t* X1B; const float* rstd2;
    __device__ __forceinline__ void operator()(const f32x4 (&acc)[2][2][4][2], const Unit& u, int wr, int wc, int fr, int fq) const {
#pragma unroll
        for (int ai = 0; ai < 2; ++ai)
#pragma unroll
            for (int m = 0; m < 4; ++m) {
                const int row = u.pm * BM + ai * HALF + wr * 64 + m * 16 + fr; const float r2 = rstd2[row];
#pragma unroll
                for (int bj = 0; bj < 2; ++bj) { const size_t o = (size_t)row * DM + u.pn * BM + bj * HALF + wc * 32 + 8 * fq;
                    const u32x4 xb = *(const u32x4*)(X1B + o);
                    const f32x4 a = {bflo(xb.x), bfhi(xb.x), bflo(xb.y), bfhi(xb.y)}, b = {bflo(xb.z), bfhi(xb.z), bflo(xb.w), bfhi(xb.w)};
                    *(f32x4*)(Y + o) = a + acc[ai][bj][m][0] * r2; *(f32x4*)(Y + o + 4) = b + acc[ai][bj][m][1] * r2; }
            }
    }
};
template <class Epi, class Sched, bool ALIGN_EPI = false, bool SP2 = false>
__device__ __forceinline__ void gemm_phase(PG8_LAS unsigned char* lds, const Gemm g, const Sched& S, const Epi& E) {
    const int tid = threadIdx.x, wid = __builtin_amdgcn_readfirstlane(tid >> 6), lane = tid & 63, wr = wid >> 2, wc = wid & 3, fr = lane & 15, fq = lane >> 4;
    const int K = g.K, nt = K / BK;
    unsigned voffA[2], voffB[2];
#pragma unroll
    for (int i = 0; i < 2; ++i) { int R, C; stage_rc(tid * 16 + i * 8192, R, C); const int Rb = Epi::PERM ? ((R & ~31) + perm32(R & 31)) : R;
        voffA[i] = (unsigned)(R * K + C) * 2u; voffB[i] = (unsigned)(Rb * K + C) * 2u; }
    const size_t kstep = (size_t)(BK * 2);
    const size_t hstep = (size_t)HALF * K * 2;
    const size_t tstep = 2 * hstep;
    const unsigned ldsw = (unsigned)wid * 1024u;
    const int aoff = lds_byte(wr * 64 + fr, fq * 8), boff = lds_byte(wc * 32 + fr, fq * 8);
#define PG8_SA(b, h) (((b) * 2 + (h)) * HTB)
#define PG8_SB(b, h) ((4 + (b) * 2 + (h)) * HTB)
#define PG8_STAGE(bufoff, gbase, voff) do { _Pragma("unroll") for (int _i = 0; _i < 2; ++_i) \
        __builtin_amdgcn_global_load_lds((const unsigned*)((const char*)(gbase) + (voff)[_i]), (PG8_LAS unsigned*)(lds + (bufoff) + ldsw + _i * 8192), 16, 0, 0); } while (0)
#define PG8_LDA(dst, b, h) do { _Pragma("unroll") for (int m = 0; m < 4; ++m) _Pragma("unroll") for (int k = 0; k < 2; ++k) dst[m][k] = *(const PG8_LAS bf16x8*)(lds + PG8_SA(b, h) + aoff + m * 2048 + k * 1024); } while (0)
#define PG8_LDB(dst, b, h) do { _Pragma("unroll") for (int n = 0; n < 2; ++n) _Pragma("unroll") for (int k = 0; k < 2; ++k) dst[n][k] = *(const PG8_LAS bf16x8*)(lds + PG8_SB(b, h) + boff + n * 2048 + k * 1024); } while (0)
#define PG8_MMA(ai, bj, At, Bt) do { __builtin_amdgcn_s_setprio(1); _Pragma("unroll") for (int m = 0; m < 4; ++m) _Pragma("unroll") for (int n = 0; n < 2; ++n) _Pragma("unroll") for (int k = 0; k < 2; ++k) \
        acc[ai][bj][m][n] = __builtin_amdgcn_mfma_f32_16x16x32_bf16(Bt[n][k], At[m][k], acc[ai][bj][m][n], 0, 0, 0); __builtin_amdgcn_s_setprio(0); } while (0)
#define PG8_WAIT_V(n) asm volatile("s_waitcnt vmcnt(" #n ")" ::: "memory")
#define PG8_WAIT_L(n) asm volatile("s_waitcnt lgkmcnt(" #n ")" ::: "memory")
#define PG8_BAR __builtin_amdgcn_s_barrier()
#define PG8_SCHED __builtin_amdgcn_sched_barrier(0)
    Unit cur, nxt; int ui = 0;
    if (!S.next(0, cur)) return;
    f32x4 acc[2][2][4][2];
#pragma unroll
    for (int a = 0; a < 2; ++a)
#pragma unroll
        for (int b = 0; b < 2; ++b)
#pragma unroll
            for (int m = 0; m < 4; ++m)
#pragma unroll
                for (int n = 0; n < 2; ++n) acc[a][b][m][n] = (f32x4){0.f, 0.f, 0.f, 0.f};
    bf16x8 At[4][2], B0[2][2], B1[2][2];
    const char* cA = (const char*)g.A + (size_t)cur.pm * tstep; const char* cB = (const char*)g.Bt + (size_t)cur.pn * tstep;
    S.a_ready(cur);
    if constexpr (SP2) {
        PG8_STAGE(PG8_SB(0, 0), cB, voffB); PG8_STAGE(PG8_SB(0, 1), cB + hstep, voffB); PG8_STAGE(PG8_SA(0, 0), cA, voffA); PG8_STAGE(PG8_SA(0, 1), cA + hstep, voffA);
        if (wr == 1) PG8_BAR;
        PG8_WAIT_V(2); PG8_BAR;
        PG8_STAGE(PG8_SB(1, 0), cB + kstep, voffB); PG8_STAGE(PG8_SA(1, 0), cA + kstep, voffA); PG8_STAGE(PG8_SB(1, 1), cB + hstep + kstep, voffB);
        PG8_WAIT_V(6); PG8_BAR;
    } else {
        PG8_STAGE(PG8_SB(0, 0), cB, voffB); PG8_STAGE(PG8_SA(0, 0), cA, voffA); PG8_STAGE(PG8_SB(0, 1), cB + hstep, voffB); PG8_STAGE(PG8_SA(0, 1), cA + hstep, voffA);
        if (wr == 1) PG8_BAR;
        PG8_WAIT_V(4); PG8_BAR;
        PG8_STAGE(PG8_SB(1, 0), cB + kstep, voffB); PG8_STAGE(PG8_SA(1, 0), cA + kstep, voffA); PG8_STAGE(PG8_SB(1, 1), cB + hstep + kstep, voffB);
        PG8_WAIT_V(6); PG8_BAR;
    }
    for (;;) {
        const bool has_next = S.next(ui + 1, nxt);
        const char* nA = has_next ? (const char*)g.A + (size_t)nxt.pm * tstep : cA; const char* nB = has_next ? (const char*)g.Bt + (size_t)nxt.pn * tstep : cB;
        for (int t = 0; t < nt; t += 2) {
            const bool last = (t == nt - 2);
            const char* a1 = cA + (size_t)(t + 1) * kstep;
            const char* a2 = last ? nA : cA + (size_t)(t + 2) * kstep; const char* b2 = last ? nB : cB + (size_t)(t + 2) * kstep;
            const char* a3 = a2 + kstep; const char* b3 = b2 + kstep;
            if (last && has_next) S.a_ready(nxt);
            if constexpr (SP2) {
            PG8_LDB(B0, 0, 0); PG8_LDB(B1, 0, 1); PG8_SCHED; PG8_LDA(At, 0, 0); PG8_STAGE(PG8_SA(1, 1), a1 + hstep, voffA);
            PG8_WAIT_V(8); PG8_WAIT_L(0); PG8_BAR; PG8_MMA(0, 0, At, B0); PG8_MMA(0, 1, At, B1); PG8_BAR; PG8_SCHED;
            PG8_LDA(At, 0, 1); PG8_STAGE(PG8_SB(0, 0), b2, voffB); PG8_STAGE(PG8_SB(0, 1), b2 + hstep, voffB); PG8_STAGE(PG8_SA(0, 0), a2, voffA);
            PG8_WAIT_V(8); PG8_WAIT_L(0); PG8_BAR; PG8_MMA(1, 0, At, B0); PG8_MMA(1, 1, At, B1); PG8_BAR; PG8_SCHED;
            PG8_LDB(B0, 1, 0); PG8_LDB(B1, 1, 1); PG8_SCHED; PG8_LDA(At, 1, 0); PG8_STAGE(PG8_SA(0, 1), a2 + hstep, voffA);
            PG8_WAIT_V(8); PG8_WAIT_L(0); PG8_BAR; PG8_MMA(0, 0, At, B0); PG8_MMA(0, 1, At, B1); PG8_BAR; PG8_SCHED;
            PG8_LDA(At, 1, 1); PG8_STAGE(PG8_SB(1, 0), b3, voffB); PG8_STAGE(PG8_SB(1, 1), b3 + hstep, voffB); PG8_STAGE(PG8_SA(1, 0), a3, voffA);
            PG8_WAIT_V(8); PG8_WAIT_L(0); PG8_BAR; PG8_MMA(1, 0, At, B0); PG8_MMA(1, 1, At, B1); PG8_BAR; PG8_SCHED;
            } else {
            PG8_LDB(B0, 0, 0); PG8_SCHED; PG8_LDA(At, 0, 0); PG8_STAGE(PG8_SA(1, 1), a1 + hstep, voffA);
            PG8_WAIT_L(8); PG8_BAR; PG8_WAIT_L(0); PG8_MMA(0, 0, At, B0); PG8_BAR; PG8_SCHED;
            PG8_LDB(B1, 0, 1); PG8_STAGE(PG8_SB(0, 0), b2, voffB);
            PG8_BAR; PG8_WAIT_L(0); PG8_MMA(0, 1, At, B1); PG8_BAR;
            PG8_LDA(At, 0, 1); PG8_STAGE(PG8_SA(0, 0), a2, voffA);
            PG8_BAR; PG8_WAIT_L(0); PG8_MMA(1, 0, At, B0); PG8_BAR; PG8_SCHED;
            PG8_STAGE(PG8_SB(0, 1), b2 + hstep, voffB);
            PG8_WAIT_V(6); PG8_BAR; PG8_MMA(1, 1, At, B1); PG8_BAR;
            PG8_LDB(B0, 1, 0); PG8_SCHED; PG8_LDA(At, 1, 0); PG8_STAGE(PG8_SA(0, 1), a2 + hstep, voffA);
            PG8_WAIT_L(8); PG8_BAR; PG8_WAIT_L(0); PG8_MMA(0, 0, At, B0); PG8_BAR; PG8_SCHED;
            PG8_LDB(B1, 1, 1); PG8_STAGE(PG8_SB(1, 0), b3, voffB);
            PG8_BAR; PG8_WAIT_L(0); PG8_MMA(0, 1, At, B1); PG8_BAR;
            PG8_LDA(At, 1, 1); PG8_STAGE(PG8_SA(1, 0), a3, voffA);
            PG8_BAR; PG8_WAIT_L(0); PG8_MMA(1, 0, At, B0); PG8_BAR; PG8_SCHED;
            PG8_STAGE(PG8_SB(1, 1), b3 + hstep, voffB);
            PG8_WAIT_V(6); PG8_BAR; PG8_MMA(1, 1, At, B1); PG8_BAR;
            }
        }
        if constexpr (ALIGN_EPI) { if (wr == 0) PG8_BAR; }
        if constexpr (!Epi::AFTER_DRAIN) { E(acc, cur, wr, wc, fr, fq); S.done(cur); }
        if (!has_next) break;
#pragma unroll
        for (int a = 0; a < 2; ++a)
#pragma unroll
            for (int b = 0; b < 2; ++b)
#pragma unroll
                for (int m = 0; m < 4; ++m)
#pragma unroll
                    for (int n = 0; n < 2; ++n) acc[a][b][m][n] = (f32x4){0.f, 0.f, 0.f, 0.f};
        cur = nxt; cA = nA; cB = nB; ++ui;
        if constexpr (ALIGN_EPI) { if (wr == 1) PG8_BAR; }
    }
    PG8_WAIT_V(0);
    if constexpr (!ALIGN_EPI) { if (wr == 0) PG8_BAR; }
    PG8_BAR;
    if constexpr (Epi::AFTER_DRAIN) { E.fused(acc, cur, wr, wc, fr, fq, lds, wid, lane); S.done(cur); }
#undef PG8_SA
#undef PG8_SB
#undef PG8_STAGE
#undef PG8_LDA
#undef PG8_LDB
#undef PG8_MMA
#undef PG8_WAIT_V
#undef PG8_WAIT_L
#undef PG8_BAR
#undef PG8_SCHED
}
}

using pg8::bf16_t; using pg8::bf16x8; using pg8::f32x4; using pg8::u32x4;
#define MFMA32(a, b, c) __builtin_amdgcn_mfma_f32_32x32x16_bf16((a), (b), (c), 0, 0, 0)
DI int crow(int reg, int h) { return (reg & 3) + 8 * (reg >> 2) + 4 * h; }
DI float wave_sum(float v) {
#pragma unroll
    for (int o = 1; o < 64; o <<= 1) v += __shfl_xor(v, o);
    return v;
}
DI float wave_max(float v) {
#pragma unroll
    for (int o = 1; o < 64; o <<= 1) v = fmaxf(v, __shfl_xor(v, o));
    return v;
}
DI bf16x8 pack8(const f32x16& x, int s) { u32x4 p; p.x = pk2(x[8 * s], x[8 * s + 1]); p.y = pk2(x[8 * s + 2], x[8 * s + 3]); p.z = pk2(x[8 * s + 4], x[8 * s + 5]); p.w = pk2(x[8 * s + 6], x[8 * s + 7]); return __builtin_bit_cast(bf16x8, p); }
DI bf16x8 cat4(s16x4 lo, s16x4 hi) { return __builtin_shufflevector(lo, hi, 0, 1, 2, 3, 4, 5, 6, 7); }
DI f32x16 zero16() { f32x16 z;
#pragma unroll
    for (int i = 0; i < 16; ++i) z[i] = 0.f;
    return z; }
DI float gamma_of(int h) { return 1.0f - exp2f(-5.0f - (float)h); }

constexpr size_t MiB = 1u << 20;
constexpr size_t WS_WIN = 1 * MiB;
constexpr size_t WS_WOUT = 23 * MiB;
constexpr size_t WS_WUP = 31 * MiB;
constexpr size_t WS_WDN = 63 * MiB;
constexpr size_t WS_H1 = 95 * MiB;
constexpr size_t WS_MIX = 128 * MiB;
constexpr size_t WS_PART = 161 * MiB;
constexpr size_t WS_RSTD2 = 163 * MiB;
constexpr size_t WS_Z = 164 * MiB;
constexpr size_t WS_KV = 252 * MiB;
constexpr size_t WS_SP = 316 * MiB;
constexpr size_t WS_U = 164 * MiB;
constexpr size_t WS_END = 348 * MiB;
static_assert(WS_Z + (size_t)MP * INW * 2 <= WS_KV && WS_U + (size_t)MP * FF * 2 <= WS_END && WS_H1 + (size_t)MP * DM * 2 <= WS_MIX && WS_MIX + (size_t)MP * DM * 2 <= WS_PART, "ws map");
constexpr int LDS_BYTES = 147456;

constexpr size_t O_Y = 0, O_KP = (size_t)MR * DM, O_VP = O_KP + 16384, O_SP = O_VP + 16384, O_KS = O_SP + 262144, O_VS = O_KS + 2097152, O_SS = O_VS + 2097152, O_END = O_SS + 33554432;

struct TItem { const float* W; bf16_t* WT; int K, N, item; const float* rs; };
DI void p0_load(const TItem& t, f32x4 (&v)[8], int lane) {
    const int nblk = t.N / 32, kb = t.item / nblk, nb = t.item % nblk, k0 = 64 * kb, n0 = 32 * nb, c = lane & 7, rr = lane >> 3;
#pragma unroll
    for (int i = 0; i < 8; ++i) v[i] = __builtin_nontemporal_load((const f32x4*)(t.W + (size_t)(k0 + 8 * i + rr) * t.N + n0 + 4 * c));
    if (t.rs) {
#pragma unroll
        for (int i = 0; i < 8; ++i) v[i] = v[i] * t.rs[k0 + 8 * i + rr];
    }
}
DI void p0_store(const TItem& t, const f32x4 (&v)[8], LAS float* scr, int lane) {
    const int nblk = t.N / 32, kb = t.item / nblk, nb = t.item % nblk, k0 = 64 * kb, n0 = 32 * nb, c = lane & 7, rr = lane >> 3;
#pragma unroll
    for (int i = 0; i < 8; ++i) { LAS float* d = scr + (8 * i + rr) * 33 + 4 * c; d[0] = v[i][0]; d[1] = v[i][1]; d[2] = v[i][2]; d[3] = v[i][3]; }
    asm volatile("s_waitcnt lgkmcnt(0)" ::: "memory");
#pragma unroll
    for (int j = 0; j < 4; ++j) { const int n = (lane >> 3) + 8 * j; const LAS float* s = scr + (8 * c) * 33 + n;
        u32x4 o; o.x = pk2(s[0 * 33], s[1 * 33]); o.y = pk2(s[2 * 33], s[3 * 33]); o.z = pk2(s[4 * 33], s[5 * 33]); o.w = pk2(s[6 * 33], s[7 * 33]);
        *(u32x4*)(t.WT + (size_t)(n0 + n) * t.K + k0 + 8 * c) = o; }
    asm volatile("s_waitcnt lgkmcnt(0)" ::: "memory");
}
struct ResIn { const float* w; bf16_t* wt; DI TItem operator()(int it) const { return TItem{w, wt, DM, INW, it, nullptr}; } };
struct ResRest { const float* w_out; const float* w_up; const float* w_dn; bf16_t* WOUT; bf16_t* WUP; bf16_t* WDN; const float* g2;
    DI TItem operator()(int it) const { constexpr int I_OUT = (DM / 64) * (DM / 32), I_UP = (DM / 64) * (FF / 32); int r = it;
        if (r < I_OUT) return TItem{w_out, WOUT, DM, DM, r, nullptr}; r -= I_OUT;
        if (r < I_UP) return TItem{w_up, WUP, DM, FF, r, g2}; r -= I_UP;
        return TItem{w_dn, WDN, FF, DM, r, nullptr}; } };
template <class Resolve>
DI void p0_convert(const Resolve R, int first, int stride, int total, LAS float* scr, int lane) {
    for (int it = first; it < total; it += 2 * stride) {
        const bool two = it + stride < total;
        const TItem t0 = R(it), t1 = R(two ? it + stride : it);
        f32x4 v0[8], v1[8];
        p0_load(t0, v0, lane);
        if (two) p0_load(t1, v1, lane);
        p0_store(t0, v0, scr, lane);
        if (two) p0_store(t1, v1, scr + 64 * 33, lane);
    }
}
DI void rms_row(const float* xrow, const float* g, bf16_t* orow, int lane) {
    f32x4 v[8]; float s = 0.f;
#pragma unroll
    for (int j = 0; j < 8; ++j) { v[j] = *((const f32x4*)xrow + lane + 64 * j); s += (v[j][0] * v[j][0] + v[j][1] * v[j][1]) + (v[j][2] * v[j][2] + v[j][3] * v[j][3]); }
    const float rstd = rsqrtf(wave_sum(s) * (1.0f / DM) + EPS);
#pragma unroll
    for (int j = 0; j < 8; ++j) { const f32x4 gg = *((const f32x4*)g + lane + 64 * j); u32x2 o; o.x = pk2(v[j][0] * rstd * gg[0], v[j][1] * rstd * gg[1]); o.y = pk2(v[j][2] * rstd * gg[2], v[j][3] * rstd * gg[3]);
        *((u32x2*)orow + lane + 64 * j) = o; }
}

DI void stage_T128x256(LAS unsigned char* img, const bf16_t* src, int tid) {
#pragma unroll
    for (int k = 0; k < 4; ++k) {
        const int it = k * 512 + tid, dgl = it & 3, tpl = (it >> 2) & 15, rest = it >> 6, dg = dgl + 4 * (rest & 7), tp = tpl + 16 * (rest >> 3);
        const bf16_t* p = src + (size_t)(2 * tp) * INW + dg * 8;
        const u32x4 a = *(const u32x4*)p, b = *(const u32x4*)(p + INW);
#pragma unroll
        for (int e = 0; e < 8; ++e) {
            const unsigned lo = (e & 1) ? (a[e >> 1] >> 16) : (a[e >> 1] & 0xffffu), hi = (e & 1) ? (b[e >> 1] & 0xffff0000u) : (b[e >> 1] << 16);
            *(LAS unsigned*)(img + (dg * 8 + e) * 264 + tp * 4) = lo | hi;
        }
    }
}

DI void ret_step1(LAS unsigned char* lds, const bf16_t* Z, bf16_t* KV, int n, int h, int tid) {
    LAS unsigned char* Kt = lds; LAS unsigned char* Vt = lds + 256 * 264;
    const int lane = tid & 63, wid = tid >> 6, r = lane & 31, hh = lane >> 5;
    stage_T128x256(Kt, Z + (size_t)(n * 128) * INW + C_RK + h * 256, tid);
    stage_T128x256(Vt, Z + (size_t)(n * 128) * INW + C_RV + h * 256, tid);
    __syncthreads();
    f32x16 acc[8];
#pragma unroll
    for (int i = 0; i < 8; ++i) acc[i] = zero16();
    const int dk0 = wid * 32;
#pragma unroll 2
    for (int s = 0; s < 8; ++s) {
        const LAS unsigned char* pa = Kt + (dk0 + r) * 264 + (16 * s + 8 * hh) * 2;
        const bf16x8 A = cat4(*(const LAS s16x4*)pa, *(const LAS s16x4*)(pa + 8));
#pragma unroll
        for (int dt = 0; dt < 8; ++dt) {
            const LAS unsigned char* pb = Vt + (dt * 32 + r) * 264 + (16 * s + 8 * hh) * 2;
            const bf16x8 B = cat4(*(const LAS s16x4*)pb, *(const LAS s16x4*)(pb + 8));
            acc[dt] = MFMA32(A, B, acc[dt]);
        }
    }
    bf16_t* out = KV + ((size_t)(n * 4 + h) * 256) * 256 + dk0 + 4 * hh;
#pragma unroll
    for (int dt = 0; dt < 8; ++dt)
#pragma unroll
        for (int g4 = 0; g4 < 4; ++g4) { u32x2 o; o.x = pk2(acc[dt][4 * g4], acc[dt][4 * g4 + 1]); o.y = pk2(acc[dt][4 * g4 + 2], acc[dt][4 * g4 + 3]);
            *(u32x2*)(out + (size_t)(dt * 32 + r) * 256 + 8 * g4) = o; }
    __syncthreads();
}

DI void ret_scan(const bf16_t* KV, bf16_t* SP, float* o_state, int gt, int nthreads) {
    for (int e = gt; e < 65536; e += nthreads) {
        const int h = e >> 14, dv = (e >> 6) & 255, dk4 = (e & 63) * 4;
        const float lg = log1pf(-exp2f(-5.0f - (float)h)), Dc = __expf(128.0f * lg), c1 = __expf(127.0f * lg);
        const size_t base = ((size_t)(h * 256 + dv)) * 256 + dk4;
        f32x4 s = {0.f, 0.f, 0.f, 0.f};
        for (int n0 = 0; n0 < 64; n0 += 32) {
            u32x2 q[32];
#pragma unroll
            for (int u = 0; u < 32; ++u) q[u] = *(const u32x2*)(KV + (size_t)(n0 + u) * 262144 + base);
#pragma unroll
            for (int u = 0; u < 32; ++u) { u32x2 o; o.x = pk2(s[0], s[1]); o.y = pk2(s[2], s[3]); *(u32x2*)(SP + (size_t)(n0 + u) * 262144 + base) = o;
                const f32x4 kv = {bflo(q[u].x), bfhi(q[u].x), bflo(q[u].y), bfhi(q[u].y)}; s = s * Dc + kv * c1; }
        }
#pragma unroll
        for (int j = 0; j < 4; ++j) o_state[((size_t)(h * 256 + dk4 + j)) * 256 + dv] = s[j];
    }
}

DI float silu_f(float x) { return x * __builtin_amdgcn_rcpf(1.0f + __builtin_amdgcn_exp2f(-1.4426950408889634f * x)); }

DI void ret_step2(LAS unsigned char* lds, const bf16_t* Z, const bf16_t* SP, bf16_t* MIX, const float* rng, int n, int h, int tid) {
    LAS unsigned char* Kr = lds; LAS unsigned char* Vt = lds + 128 * 528; LAS float* red = (LAS float*)(lds + 128 * 528 + 256 * 264);
    const int lane = tid & 63, wid = tid >> 6, r = lane & 31, hh = lane >> 5;
    const bf16_t* zc = Z + (size_t)(n * 128) * INW;
#pragma unroll
    for (int k = 0; k < 8; ++k) { const int it = k * 512 + tid, row = it >> 5, c = it & 31;
        *(LAS u32x4*)(Kr + row * 528 + c * 16) = *(const u32x4*)(zc + (size_t)row * INW + C_RK + h * 256 + c * 8); }
    stage_T128x256(Vt, zc + C_RV + h * 256, tid);
    const int it_ = wid >> 1, dh = wid & 1;
    bf16x8 qf[16];
    { const bf16_t* qp = zc + (size_t)(32 * it_ + r) * INW + C_RQ + h * 256 + 8 * hh;
#pragma unroll
      for (int s = 0; s < 16; ++s) qf[s] = *(const bf16x8*)(qp + 16 * s); }
    f32x16 acc[4];
#pragma unroll
    for (int i = 0; i < 4; ++i) acc[i] = zero16();
    const float gm = gamma_of(h);
    __syncthreads();
    for (int jt = 0; jt <= it_; ++jt) {
        f32x16 X = zero16();
#pragma unroll
        for (int s = 0; s < 16; ++s) { const bf16x8 A = *(const LAS bf16x8*)(Kr + (32 * jt + r) * 528 + (16 * s + 8 * hh) * 2); X = MFMA32(A, qf[s], X); }
        if (jt == it_) {
#pragma unroll
            for (int i = 0; i < 16; ++i) X[i] = (crow(i, hh) > r) ? 0.f : X[i];
        }
#pragma unroll
        for (int s2 = 0; s2 < 2; ++s2) { const bf16x8 xs = pack8(X, s2);
#pragma unroll
            for (int dt = 0; dt < 4; ++dt) { const LAS unsigned char* pa = Vt + (128 * dh + 32 * dt + r) * 264 + (32 * jt + 16 * s2 + 4 * hh) * 2;
                const bf16x8 A = cat4(*(const LAS s16x4*)pa, *(const LAS s16x4*)(pa + 16)); acc[dt] = MFMA32(A, xs, acc[dt]); } }
    }
    { const float ig = 1.0f / gm;
#pragma unroll
      for (int dt = 0; dt < 4; ++dt) acc[dt] = acc[dt] * ig; }
    __syncthreads();
    {
        const bf16_t* spg = SP + (size_t)(n * 4 + h) * 65536;
        const bf16_t* ge = spg + (size_t)(tid >> 5) * 256 + ((tid & 31) ^ (tid >> 5)) * 8;
        const bf16_t* go = spg + (size_t)(tid >> 5) * 256 + ((tid & 31) ^ (16 + (tid >> 5))) * 8;
        LAS unsigned char* ld = lds + wid * 1024;
#pragma unroll 1
        for (int k = 0; k < 16; k += 2) {
            __builtin_amdgcn_global_load_lds((const unsigned*)(ge + (size_t)k * 4096), (LAS unsigned*)(ld + k * 8192), 16, 0, 0);
            __builtin_amdgcn_global_load_lds((const unsigned*)(go + (size_t)(k + 1) * 4096), (LAS unsigned*)(ld + (k + 1) * 8192), 16, 0, 0);
        }
        asm volatile("s_waitcnt vmcnt(0)" ::: "memory");
    }
    __syncthreads();
#pragma unroll
    for (int dt = 0; dt < 4; ++dt)
#pragma unroll
        for (int s = 0; s < 16; ++s) { const int rw = 128 * dh + 32 * dt + r; const bf16x8 A = *(const LAS bf16x8*)(lds + rw * 512 + (((2 * s + hh) ^ (rw & 31)) * 16)); acc[dt] = MFMA32(A, qf[s], acc[dt]); }
#pragma unroll
    for (int dt = 0; dt < 4; ++dt) acc[dt] = acc[dt] * gm;
    float ss = 0.f;
#pragma unroll
    for (int dt = 0; dt < 4; ++dt)
#pragma unroll
        for (int i = 0; i < 16; ++i) ss += acc[dt][i] * acc[dt][i];
    ss += __shfl_xor(ss, 32);
    if (hh == 0) red[wid * 32 + r] = ss;
    __syncthreads();
    const float rstd = rsqrtf((red[wid * 32 + r] + red[(wid ^ 1) * 32 + r]) * (1.0f / 256.0f) + EPS);
#pragma unroll
    for (int dt = 0; dt < 4; ++dt)
#pragma unroll
        for (int g4 = 0; g4 < 4; ++g4) { const int dv = 128 * dh + 32 * dt + 8 * g4 + 4 * hh;
            *(LAS f32x4*)(lds + (32 * it_ + r) * 1040 + dv * 4) = (f32x4){acc[dt][4 * g4] * rstd, acc[dt][4 * g4 + 1] * rstd, acc[dt][4 * g4 + 2] * rstd, acc[dt][4 * g4 + 3] * rstd}; }
    __syncthreads();
#pragma unroll 1
    for (int k = 0; k < 8; ++k) {
        const int it = k * 512 + tid, tk = it >> 5, c8 = (it & 31) * 8; const size_t token = (size_t)n * 128 + tk;
        const u32x4 gz = *(const u32x4*)(Z + token * INW + C_RG + h * 256 + c8);
        const f32x4 g0 = *(const f32x4*)(rng + h * 256 + c8), g1 = *(const f32x4*)(rng + h * 256 + c8 + 4);
        const f32x4 p0 = *(const LAS f32x4*)(lds + tk * 1040 + c8 * 4), p1 = *(const LAS f32x4*)(lds + tk * 1040 + c8 * 4 + 16);
        u32x4 o;
        o.x = pk2(p0[0] * g0[0] * silu_f(bflo(gz.x)), p0[1] * g0[1] * silu_f(bfhi(gz.x))); o.y = pk2(p0[2] * g0[2] * silu_f(bflo(gz.y)), p0[3] * g0[3] * silu_f(bfhi(gz.y)));
        o.z = pk2(p1[0] * g1[0] * silu_f(bflo(gz.z)), p1[1] * g1[1] * silu_f(bfhi(gz.z))); o.w = pk2(p1[2] * g1[2] * silu_f(bflo(gz.w)), p1[3] * g1[3] * silu_f(bfhi(gz.w)));
        *(u32x4*)(MIX + token * DM + 1024 + h * 256 + c8) = o;
    }
    __syncthreads();
}

DI void ret_decode_unit(LAS unsigned char* lds, const bf16_t* Z, const float* S0, float* S1, bf16_t* MIX, const float* rng, int b, int h, int tid) {
    LAS float* qv = (LAS float*)lds; LAS float* red = qv + 768;
    const int lane = tid & 63, wid = tid >> 6;
    const bf16_t* zrow = Z + (size_t)(LP + b) * INW;
    if (tid < 256) { qv[tid] = bf2f(zrow[C_RQ + h * 256 + tid]); qv[256 + tid] = bf2f(zrow[C_RK + h * 256 + tid]); qv[512 + tid] = bf2f(zrow[C_RV + h * 256 + tid]); }
    __syncthreads();
    const float gm = gamma_of(h);
    const f32x4 v4 = *(const LAS f32x4*)(qv + 512 + 4 * lane);
    f32x4 acc = {0.f, 0.f, 0.f, 0.f};
    const size_t off = ((size_t)(b * 4 + h) * 256 + wid * 32) * 256 + 4 * lane;
    const float* s0 = S0 + off; float* s1 = S1 + off;
#pragma unroll 1
    for (int rr = 0; rr < 32; rr += 16) {
        f32x4 s[16];
#pragma unroll
        for (int u = 0; u < 16; ++u) s[u] = __builtin_nontemporal_load((const f32x4*)(s0 + (size_t)(rr + u) * 256));
#pragma unroll
        for (int u = 0; u < 16; ++u) { const int dk = wid * 32 + rr + u; const float kk = qv[256 + dk], qq = qv[dk];
            const f32x4 sn = s[u] * gm + v4 * kk; __builtin_nontemporal_store(sn, (f32x4*)(s1 + (size_t)(rr + u) * 256)); acc += sn * qq; }
    }
    *(LAS f32x4*)(red + wid * 256 + 4 * lane) = acc;
    __syncthreads();
    if (wid == 0) {
        f32x4 o = {0.f, 0.f, 0.f, 0.f};
#pragma unroll
        for (int w = 0; w < 8; ++w) o += *(const LAS f32x4*)(red + w * 256 + 4 * lane);
        const float ssq = wave_sum((o[0] * o[0] + o[1] * o[1]) + (o[2] * o[2] + o[3] * o[3]));
        const float rstd = rsqrtf(ssq * (1.0f / 256.0f) + EPS);
        const u32x2 gz = *(const u32x2*)(zrow + C_RG + h * 256 + 4 * lane);
        const f32x4 gn = *(const f32x4*)(rng + h * 256 + 4 * lane);
        u32x2 y; y.x = pk2(o[0] * rstd * gn[0] * silu_f(bflo(gz.x)), o[1] * rstd * gn[1] * silu_f(bfhi(gz.x)));
        y.y = pk2(o[2] * rstd * gn[2] * silu_f(bflo(gz.y)), o[3] * rstd * gn[3] * silu_f(bfhi(gz.y)));
        *(u32x2*)(MIX + (size_t)(LP + b) * DM + 1024 + h * 256 + 4 * lane) = y;
    }
    __syncthreads();
}

DI void attn_prompt_unit(LAS unsigned char* lds, const bf16_t* Z, bf16_t* MIX, const float* gq, const float* gk, const float* sinks, float* o_k, float* o_v, int nb, int kh, int hf, int tid) {
    LAS unsigned char* Kn = lds; LAS unsigned char* Vt = lds + 256 * 144;
    const int lane = tid & 63, wid = tid >> 6, r = lane & 31, hh = lane >> 5;
    {
        const int row = tid >> 1, half = tid & 1; const int tok = (nb - 1) * 128 + row;
        u32x4 v[4];
#pragma unroll
        for (int c = 0; c < 4; ++c) v[c] = (u32x4){0u, 0u, 0u, 0u};
        if (tok >= 0) {
#pragma unroll
            for (int c = 0; c < 4; ++c) v[c] = *(const u32x4*)(Z + (size_t)tok * INW + C_AK + kh * 64 + half * 32 + c * 8);
        }
        float f[32]; float ss = 0.f;
#pragma unroll
        for (int c = 0; c < 4; ++c)
#pragma unroll
            for (int e = 0; e < 4; ++e) { f[c * 8 + 2 * e] = bflo(v[c][e]); f[c * 8 + 2 * e + 1] = bfhi(v[c][e]); }
#pragma unroll
        for (int e = 0; e < 32; ++e) ss += f[e] * f[e];
        ss += __shfl_xor(ss, 1);
        const float rstd = rsqrtf(ss * (1.0f / 64.0f) + EPS);
#pragma unroll
        for (int c = 0; c < 8; ++c) { const f32x4 g = *(const f32x4*)(gk + half * 32 + c * 4);
#pragma unroll
            for (int e = 0; e < 4; ++e) f[c * 4 + e] *= rstd * g[e]; }
#pragma unroll
        for (int c = 0; c < 4; ++c) { u32x4 w; w.x = pk2(f[c * 8], f[c * 8 + 1]); w.y = pk2(f[c * 8 + 2], f[c * 8 + 3]); w.z = pk2(f[c * 8 + 4], f[c * 8 + 5]); w.w = pk2(f[c * 8 + 6], f[c * 8 + 7]);
            *(LAS u32x4*)(Kn + row * 144 + half * 64 + c * 16) = w; }
        if (nb == 63 && hf == 0 && row >= 128) { float* o = o_k + ((size_t)(row - 128) * 2 + kh) * 64 + half * 32;
#pragma unroll
            for (int c = 0; c < 8; ++c) *(f32x4*)(o + c * 4) = (f32x4){f[c * 4], f[c * 4 + 1], f[c * 4 + 2], f[c * 4 + 3]}; }
    }
#pragma unroll
    for (int k = 0; k < 2; ++k) {
        const int it = k * 512 + tid, kpl = it & 15, dgl = (it >> 4) & 3, rest = it >> 6, dg = dgl + 4 * (rest & 1), kp = kpl + 16 * (rest >> 1);
        const int tok0 = (nb - 1) * 128 + 2 * kp;
        u32x4 a = {0u, 0u, 0u, 0u}, b = {0u, 0u, 0u, 0u};
        if (tok0 >= 0) { const bf16_t* p = Z + (size_t)tok0 * INW + C_AV + kh * 64 + dg * 8; a = *(const u32x4*)p; b = *(const u32x4*)(p + INW); }
#pragma unroll
        for (int e = 0; e < 8; ++e) {
            const unsigned lo = (e & 1) ? (a[e >> 1] >> 16) : (a[e >> 1] & 0xffffu), hi = (e & 1) ? (b[e >> 1] & 0xffff0000u) : (b[e >> 1] << 16);
            *(LAS unsigned*)(Vt + (dg * 8 + e) * 520 + kp * 4) = lo | hi;
        }
        if (nb == 63 && hf == 0 && kp >= 64) { float* o = o_v + ((size_t)(2 * kp - 128) * 2 + kh) * 64 + dg * 8;
#pragma unroll
            for (int e = 0; e < 4; ++e) { o[2 * e] = bflo(a[e]); o[2 * e + 1] = bfhi(a[e]); o[128 + 2 * e] = bflo(b[e]); o[128 + 2 * e + 1] = bfhi(b[e]); } }
    }
    __syncthreads();
    const int hq = kh * 8 + 4 * hf + (wid >> 1), qh = wid & 1;
    const float sink = sinks[hq] * 1.4426950408889634f;
#pragma unroll 1
    for (int qq = 0; qq < 2; ++qq) {
        const int qi = 2 * qh + qq; const size_t tokq = (size_t)nb * 128 + 32 * qi + r;
        bf16x8 qf[4];
        {   const bf16_t* qp = Z + tokq * INW + hq * 64 + 8 * hh;
            u32x4 raw[4]; float ss = 0.f;
#pragma unroll
            for (int s = 0; s < 4; ++s) { raw[s] = *(const u32x4*)(qp + 16 * s);
#pragma unroll
                for (int e = 0; e < 4; ++e) { const float lo = bflo(raw[s][e]), hi = bfhi(raw[s][e]); ss += lo * lo + hi * hi; } }
            ss += __shfl_xor(ss, 32);
            const float rstd = rsqrtf(ss * (1.0f / 64.0f) + EPS) * (0.125f * 1.4426950408889634f);
#pragma unroll
            for (int s = 0; s < 4; ++s) { const f32x4 g0 = *(const f32x4*)(gq + 16 * s + 8 * hh), g1 = *(const f32x4*)(gq + 16 * s + 8 * hh + 4); u32x4 w;
                w.x = pk2(bflo(raw[s].x) * rstd * g0[0], bfhi(raw[s].x) * rstd * g0[1]); w.y = pk2(bflo(raw[s].y) * rstd * g0[2], bfhi(raw[s].y) * rstd * g0[3]);
                w.z = pk2(bflo(raw[s].z) * rstd * g1[0], bfhi(raw[s].z) * rstd * g1[1]); w.w = pk2(bflo(raw[s].w) * rstd * g1[2], bfhi(raw[s].w) * rstd * g1[3]);
                qf[s] = __builtin_bit_cast(bf16x8, w); }
        }
        f32x16 X[5];
#pragma unroll
        for (int t = 0; t < 5; ++t) { X[t] = zero16();
#pragma unroll
            for (int s = 0; s < 4; ++s) { const bf16x8 A = *(const LAS bf16x8*)(Kn + (32 * (qi + t) + r) * 144 + (16 * s + 8 * hh) * 2); X[t] = MFMA32(A, qf[s], X[t]); } }
        float m = -1e30f;
#pragma unroll
        for (int i = 0; i < 16; ++i) { X[0][i] = (crow(i, hh) >= r) ? X[0][i] : -1e30f; X[4][i] = (crow(i, hh) <= r) ? X[4][i] : -1e30f; }
#pragma unroll
        for (int t = 0; t < 5; ++t) { const bool out_t = (nb == 0) && (qi + t < 4);
#pragma unroll
            for (int i = 0; i < 16; ++i) { X[t][i] = out_t ? -1e30f : X[t][i]; m = fmaxf(m, X[t][i]); } }
        m = fmaxf(m, __shfl_xor(m, 32)); m = fmaxf(m, sink);
        float sum = 0.f;
#pragma unroll
        for (int t = 0; t < 5; ++t)
#pragma unroll
            for (int i = 0; i < 16; ++i) { const float p = __builtin_amdgcn_exp2f(X[t][i] - m); X[t][i] = p; sum += p; }
        sum += __shfl_xor(sum, 32);
        const float inv = 1.0f / (sum + __builtin_amdgcn_exp2f(sink - m));
        f32x16 o[2]; o[0] = zero16(); o[1] = zero16();
#pragma unroll
        for (int t = 0; t < 5; ++t)
#pragma unroll
            for (int s2 = 0; s2 < 2; ++s2) { const bf16x8 xs = pack8(X[t], s2);
#pragma unroll
                for (int dt = 0; dt < 2; ++dt) { const LAS unsigned char* pa = Vt + (32 * dt + r) * 520 + (32 * (qi + t) + 16 * s2 + 4 * hh) * 2;
                    const bf16x8 A = cat4(*(const LAS s16x4*)pa, *(const LAS s16x4*)(pa + 16)); o[dt] = MFMA32(A, xs, o[dt]); } }
#pragma unroll
        for (int dt = 0; dt < 2; ++dt)
#pragma unroll
            for (int g4 = 0; g4 < 4; ++g4) { u32x2 w; w.x = pk2(o[dt][4 * g4] * inv, o[dt][4 * g4 + 1] * inv); w.y = pk2(o[dt][4 * g4 + 2] * inv, o[dt][4 * g4 + 3] * inv);
                *(u32x2*)(MIX + tokq * DM + hq * 64 + 32 * dt + 8 * g4 + 4 * hh) = w; }
    }
    __syncthreads();
}

DI void attn_decode_unit(LAS unsigned char* lds, const bf16_t* Z, const float* ck, const float* cv, bf16_t* MIX, const float* gq, const float* gk, const float* sinks, float* o_k, float* o_v, int b, int kh, int tid) {
    LAS float* Kc = (LAS float*)lds; LAS float* Vc = Kc + 129 * 68; LAS float* qs = Vc + 129 * 64; LAS float* pw = qs + 512;
    const int lane = tid & 63, wid = tid >> 6;
#pragma unroll
    for (int k = 0; k < 4; ++k) {
        const int it = k * 512 + tid, w = it >> 4, c4 = (it & 15) * 4;
        const size_t src = ((size_t)(b * 128 + w) * 2 + kh) * 64 + c4;
        const f32x4 k4 = *(const f32x4*)(ck + src), v4 = *(const f32x4*)(cv + src);
        *(LAS f32x4*)(Kc + w * 68 + c4) = k4; *(LAS f32x4*)(Vc + w * 64 + c4) = v4;
        if (w >= 1) { const size_t dst = ((size_t)(b * 128 + w - 1) * 2 + kh) * 64 + c4; *(f32x4*)(o_k + dst) = k4; *(f32x4*)(o_v + dst) = v4; }
    }
    const bf16_t* zrow = Z + (size_t)(LP + b) * INW;
    const size_t dnew = ((size_t)(b * 128 + 127) * 2 + kh) * 64 + lane;
    if (wid == 0) { const float kx = bf2f(zrow[C_AK + kh * 64 + lane]); const float ss = wave_sum(kx * kx); const float kn = kx * rsqrtf(ss * (1.0f / 64.0f) + EPS) * gk[lane];
        Kc[128 * 68 + lane] = kn; o_k[dnew] = kn; }
    if (wid == 1) { const float vx = bf2f(zrow[C_AV + kh * 64 + lane]); Vc[128 * 64 + lane] = vx; o_v[dnew] = vx; }
    const int hq = kh * 8 + wid;
    { const float qx = bf2f(zrow[hq * 64 + lane]); const float ss = wave_sum(qx * qx); qs[wid * 64 + lane] = qx * rsqrtf(ss * (1.0f / 64.0f) + EPS) * gq[lane] * 0.125f; }
    __syncthreads();
    float s1 = 0.f, s2 = 0.f;
#pragma unroll 4
    for (int d4 = 0; d4 < 16; ++d4) { const f32x4 q = *(const LAS f32x4*)(qs + wid * 64 + 4 * d4), k1 = *(const LAS f32x4*)(Kc + lane * 68 + 4 * d4), k2 = *(const LAS f32x4*)(Kc + (lane + 64) * 68 + 4 * d4);
        s1 += (q[0] * k1[0] + q[1] * k1[1]) + (q[2] * k1[2] + q[3] * k1[3]); s2 += (q[0] * k2[0] + q[1] * k2[1]) + (q[2] * k2[2] + q[3] * k2[3]); }
    const float s3 = wave_sum(qs[wid * 64 + lane] * Kc[128 * 68 + lane]);
    const float sink = sinks[hq];
    const float m = fmaxf(wave_max(fmaxf(s1, s2)), fmaxf(s3, sink));
    const float p1 = __expf(s1 - m), p2 = __expf(s2 - m), p3 = __expf(s3 - m);
    const float denom = wave_sum(p1 + p2) + p3 + __expf(sink - m);
    pw[wid * 132 + lane] = p1; pw[wid * 132 + 64 + lane] = p2; if (lane == 0) pw[wid * 132 + 128] = p3;
    __syncthreads();
    float o = pw[wid * 132 + 128] * Vc[128 * 64 + lane];
#pragma unroll 4
    for (int j4 = 0; j4 < 32; ++j4) { const f32x4 p4 = *(const LAS f32x4*)(pw + wid * 132 + 4 * j4);
        o += (p4[0] * Vc[(4 * j4) * 64 + lane] + p4[1] * Vc[(4 * j4 + 1) * 64 + lane]) + (p4[2] * Vc[(4 * j4 + 2) * 64 + lane] + p4[3] * Vc[(4 * j4 + 3) * 64 + lane]); }
    MIX[(size_t)(LP + b) * DM + hq * 64 + lane] = (bf16_t)(pk2(o / denom, 0.f) & 0xffffu);
    __syncthreads();
}

template <int MT, class Epi>
DI void skinny_unit(LAS unsigned char* lds, const bf16_t* A, const bf16_t* Wt, int K, int cgi, int k0, int row0, const Epi& E, int tid) {
    const int lane = tid & 63, wid = tid >> 6, fr = lane & 15, fq = lane >> 4;
    const int c0 = cgi * 32;
    constexpr int NMT = 2 * MT;
    const bf16_t* pa = A + (size_t)(row0 + fr) * K + k0 + wid * 256 + 8 * fq;
    const bf16_t* pb = Wt + (size_t)(c0 + fr) * K + k0 + wid * 256 + 8 * fq;
    const size_t rs = (size_t)16 * K;
    f32x4 acc[NMT][2];
#pragma unroll
    for (int i = 0; i < NMT; ++i) { acc[i][0] = (f32x4){0.f, 0.f, 0.f, 0.f}; acc[i][1] = (f32x4){0.f, 0.f, 0.f, 0.f}; }
    bf16x8 fb[3][2], fa[3][NMT];
#define SK_LOAD(buf, c) do { _Pragma("unroll") for (int nt = 0; nt < 2; ++nt) fb[buf][nt] = *(const bf16x8*)(pb + nt * rs + 32 * (c)); \
        _Pragma("unroll") for (int mt = 0; mt < NMT; ++mt) fa[buf][mt] = *(const bf16x8*)(pa + mt * rs + 32 * (c)); } while (0)
#define SK_MMA(buf) do { _Pragma("unroll") for (int mt = 0; mt < NMT; ++mt) _Pragma("unroll") for (int nt = 0; nt < 2; ++nt) \
        acc[mt][nt] = __builtin_amdgcn_mfma_f32_16x16x32_bf16(fa[buf][mt], fb[buf][nt], acc[mt][nt], 0, 0, 0); } while (0)
    SK_LOAD(0, 0); SK_LOAD(1, 1);
    SK_LOAD(2, 2); SK_MMA(0);
    SK_LOAD(0, 3); SK_MMA(1);
    SK_LOAD(1, 4); SK_MMA(2);
    SK_LOAD(2, 5); SK_MMA(0);
    SK_LOAD(0, 6); SK_MMA(1);
    SK_LOAD(1, 7); SK_MMA(2);
    SK_MMA(0); SK_MMA(1);
#undef SK_LOAD
#undef SK_MMA
    constexpr int NR = 32 * MT;
    LAS float* red = (LAS float*)lds;
#pragma unroll
    for (int mt = 0; mt < NMT; ++mt)
#pragma unroll
        for (int nt = 0; nt < 2; ++nt)
#pragma unroll
            for (int j = 0; j < 4; ++j) red[(wid * NR + mt * 16 + 4 * fq + j) * 32 + nt * 16 + fr] = acc[mt][nt][j];
    __syncthreads();
    if (MT == 4) {
        const int row = tid >> 2, c8 = (tid & 3) * 8;
        f32x4 sa = {0.f, 0.f, 0.f, 0.f}, sb = {0.f, 0.f, 0.f, 0.f};
#pragma unroll
        for (int w = 0; w < 8; ++w) { sa += *(const LAS f32x4*)(red + (w * NR + row) * 32 + c8); sb += *(const LAS f32x4*)(red + (w * NR + row) * 32 + c8 + 4); }
        E(row0 + row, c0 + c8, sa); E(row0 + row, c0 + c8 + 4, sb);
    } else if (tid < 8 * NR) {
        const int row = tid >> 3, c4 = (tid & 7) * 4;
        f32x4 sa = {0.f, 0.f, 0.f, 0.f};
#pragma unroll
        for (int w = 0; w < 8; ++w) sa += *(const LAS f32x4*)(red + (w * NR + row) * 32 + c4);
        E(row0 + row, c0 + c4, sa);
    }
    __syncthreads();
}
struct SkOut { const float* xs; float* X1s; bf16_t* XBs;
    DI void operator()(int row, int col, f32x4 a) const { const f32x4 v = a + *(const f32x4*)(xs + (size_t)row * DM + col); *(f32x4*)(X1s + (size_t)row * DM + col) = v;
        u32x2 o; o.x = pk2(v[0], v[1]); o.y = pk2(v[2], v[3]); *(u32x2*)(XBs + (size_t)row * DM + col) = o; } };
struct SkUp { bf16_t* Us;
    DI void operator()(int row, int col, f32x4 a) const {
#pragma unroll
        for (int e = 0; e < 4; ++e) { a[e] = fmaxf(a[e], 0.f); a[e] *= a[e]; }
        u32x2 o; o.x = pk2(a[0], a[1]); o.y = pk2(a[2], a[3]); *(u32x2*)(Us + (size_t)row * FF + col) = o; } };
struct SkSlab { float* slab;
    DI void operator()(int row, int col, f32x4 a) const { *(f32x4*)(slab + (size_t)row * DM + col) = a; } };

#define RLX_AGENT __ATOMIC_RELAXED, __HIP_MEMORY_SCOPE_AGENT
#define XB_TMO      128
#define XB_XCNT(j)  (256  + 64 * (j))
#define XB_XSUB(j)  (1280 + 64 * (j))
#define XB_XGEN(j)  (2304 + 64 * (j))
#define XB_TOP      3328
#define XB_TOPGEN   3392
#define XCD_BAR_WORDS 3456
#define XB_SPIN_CAP (1u << 18)

__device__ __forceinline__ unsigned xb_ld(unsigned* p)              { return __hip_atomic_load(p, __ATOMIC_RELAXED, __HIP_MEMORY_SCOPE_AGENT); }
__device__ __forceinline__ unsigned xb_add(unsigned* p, unsigned v) { return __hip_atomic_fetch_add(p, v, __ATOMIC_RELAXED, __HIP_MEMORY_SCOPE_AGENT); }
__device__ __forceinline__ unsigned xb_xcc_id() { return (unsigned)__builtin_amdgcn_s_getreg((3 << 11) | 20) & 0xFu; }
#define XB_SPIN(cond, bar) do { unsigned _sp = 0; while (cond) { __builtin_amdgcn_s_sleep(1); \
    if ((++_sp & 255u) == 0u) { if (xb_ld(&(bar)[XB_TMO])) break; if (_sp > XB_SPIN_CAP) { atomicAdd(&(bar)[XB_TMO], 1u); break; } } } } while (0)

struct XcdBarrier {
    unsigned* bar; unsigned x;
    volatile LAS unsigned* st;
};

__device__ __forceinline__ XcdBarrier xcd_barrier_post(unsigned* bar, volatile LAS unsigned* st) {
    XcdBarrier b; b.bar = bar; b.x = xb_xcc_id(); b.st = st;
    if (threadIdx.x == 0) (void)xb_add(&bar[XB_XCNT(b.x)], 1u);
    return b;
}
__device__ __forceinline__ void xcd_barrier_complete(unsigned* bar, unsigned x, unsigned& nloc, unsigned& nx) {
    const unsigned G = gridDim.x * gridDim.y * gridDim.z;
    unsigned sum, cnt, mine, sp = 0u;
    for (;;) {
        sum = 0u; cnt = 0u; mine = 0u;
#pragma unroll
        for (unsigned j = 0; j < 16; ++j) { const unsigned c = xb_ld(&bar[XB_XCNT(j)]); sum += c; cnt += (c > 0u) ? 1u : 0u; mine = (j == x) ? c : mine; }
        if (sum == G) break;
        __builtin_amdgcn_s_sleep(1);
        if ((++sp & 255u) == 0u) { if (xb_ld(&bar[XB_TMO])) break; if (sp > XB_SPIN_CAP) { atomicAdd(&bar[XB_TMO], 1u); break; } }
    }
    nloc = mine > 0u ? mine : 1u; nx = cnt > 0u ? cnt : 1u;
}

__device__ __forceinline__ void xcd_barrier(const XcdBarrier& b) {
    asm volatile("s_waitcnt vmcnt(0)" ::: "memory");
    __syncthreads();
    if (threadIdx.x == 0) {
        unsigned* bar = b.bar;
        __builtin_amdgcn_s_waitcnt(0);
        unsigned nloc = b.st[0], nx = b.st[1];
        if (nloc == 0u) { xcd_barrier_complete(bar, b.x, nloc, nx); b.st[0] = nloc; b.st[1] = nx; }
        const unsigned old = xb_add(&bar[XB_XSUB(b.x)], 1u);
        const unsigned gen = old / nloc;
        if (old + 1u == (gen + 1u) * nloc) {
            __builtin_amdgcn_fence(__ATOMIC_RELEASE, "agent");
            asm volatile("s_waitcnt vmcnt(0)" ::: "memory");
            const unsigned og = xb_add(&bar[XB_TOP], 1u);
            const unsigned tg = og / nx;
            if (og + 1u == (tg + 1u) * nx) xb_add(&bar[XB_TOPGEN], 1u);
            else XB_SPIN(xb_ld(&bar[XB_TOPGEN]) == tg, bar);
            __builtin_amdgcn_fence(__ATOMIC_ACQUIRE, "agent");
            xb_add(&bar[XB_XGEN(b.x)], 1u);
            asm volatile("s_waitcnt vmcnt(0)" ::: "memory");
        } else {
            XB_SPIN(xb_ld(&bar[XB_XGEN(b.x)]) == gen, bar);
            __builtin_amdgcn_fence(__ATOMIC_ACQUIRE, "agent");
            asm volatile("s_waitcnt vmcnt(0)" ::: "memory");
        }
    }
    __syncthreads();
}

struct Args { const float* in[15]; float* out; unsigned char* ws; int ph_lo, ph_hi; };
constexpr int NPH = 9;
constexpr int NP0_REST = 9216;

__global__ void __launch_bounds__(512, 2) fwd_kernel(Args a) {
    extern __shared__ __attribute__((aligned(16))) unsigned char lds_raw[];
    LAS unsigned char* lds = (LAS unsigned char*)lds_raw;
    cg::grid_group grid = cg::this_grid();
    const int tid = threadIdx.x, lane = tid & 63, wid = __builtin_amdgcn_readfirstlane(tid >> 6);
    const int G = gridDim.x, bx = blockIdx.x;
    unsigned char* ws = a.ws; float* out = a.out;
    const float* x_p = a.in[0]; const float* x_s = a.in[1]; const float* cache_k = a.in[2]; const float* cache_v = a.in[3]; const float* state0 = a.in[4];
    const float* ln1_g = a.in[5]; const float* w_in = a.in[6]; const float* gq = a.in[7]; const float* gk = a.in[8]; const float* sinks = a.in[9];
    const float* rng = a.in[10]; const float* w_out = a.in[11]; const float* ln2_g = a.in[12]; const float* w_up = a.in[13]; const float* w_dn = a.in[14];
    bf16_t* WIN = (bf16_t*)(ws + WS_WIN); bf16_t* WOUT = (bf16_t*)(ws + WS_WOUT); bf16_t* WUP = (bf16_t*)(ws + WS_WUP); bf16_t* WDN = (bf16_t*)(ws + WS_WDN);
    bf16_t* H1 = (bf16_t*)(ws + WS_H1); bf16_t* XG = H1; bf16_t* MIX = (bf16_t*)(ws + WS_MIX); bf16_t* Z = (bf16_t*)(ws + WS_Z); bf16_t* U = (bf16_t*)(ws + WS_U);
    float* PART = (float*)(ws + WS_PART); float* RSTD2 = (float*)(ws + WS_RSTD2); bf16_t* KV = (bf16_t*)(ws + WS_KV); bf16_t* SP = (bf16_t*)(ws + WS_SP); float* SLAB = (float*)(ws + WS_SP);
    const int lo = a.ph_lo, hi = a.ph_hi;
#define IN(k) (lo <= (k) && (k) < hi)
    volatile LAS unsigned* MISC = (volatile LAS unsigned*)(lds + LDS_BYTES - 64);
    if (tid < 16) MISC[tid] = 0u;
    __syncthreads();
    const XcdBarrier bar = xcd_barrier_post((unsigned*)ws + 1024, MISC + 8);
    if (lo > hi) grid.sync();
#define SEAM(k) do { if (IN(k) && IN((k) + 1)) xcd_barrier(bar); } while (0)

    if (IN(0)) for (int rep_ = 0; rep_ < 1 + ((DUPMASK >> 0) & 1); ++rep_) { if (rep_) xcd_barrier(bar);
        LAS float* scr = (LAS float*)(lds + wid * 17408);
        const int gw = bx * 8 + wid, NGW = G * 8;
        constexpr int I_IN = (DM / 64) * (INW / 32);
        p0_convert(ResIn{w_in, WIN}, gw, NGW, I_IN, scr, lane);
        for (int m = gw; m < MP; m += NGW) {
            if (m < MR) rms_row(m < LP ? x_p + (size_t)m * DM : x_s + (size_t)(m - LP) * DM, ln1_g, H1 + (size_t)m * DM, lane);
            else {
#pragma unroll
                for (int j = 0; j < 8; ++j) *((u32x2*)(H1 + (size_t)m * DM) + lane + 64 * j) = (u32x2){0u, 0u};
            }
        }
    }
    SEAM(0);
    if (IN(1)) for (int rep_ = 0; rep_ < 1 + ((DUPMASK >> 1) & 1); ++rep_) { if (rep_) xcd_barrier(bar);
        pg8::Gemm g{H1, WIN, MP, INW, DM}; pg8::StaticOrder S; S.init(MP, INW, G, bx, WGM_IN);
        pg8::EpiIn E{Z};
        pg8::gemm_phase<pg8::EpiIn, pg8::StaticOrder, true, true>(lds, g, S, E);
        {
            constexpr int NT = (MP / 256) * (INW / 256); const int rounds = (NT + G - 1) / G, first_idle = NT - (rounds - 1) * G;
            const int nidle = (first_idle < G) ? (G - first_idle) : G, me = (first_idle < G) ? (bx - first_idle) : bx;
            if (me >= 0) {
                LAS float* scr = (LAS float*)(lds + wid * 17408);
                constexpr int I_OUT = (DM / 64) * (DM / 32), I_UP = (DM / 64) * (FF / 32), I_DN = (FF / 64) * (DM / 32);
                p0_convert(ResRest{w_out, w_up, w_dn, WOUT, WUP, WDN, ln2_g}, NP0_REST + me * 8 + wid, nidle * 8, I_OUT + I_UP + I_DN, scr, lane);
            }
        }
    }
    SEAM(1);
    if (IN(2)) for (int rep_ = 0; rep_ < 1 + ((DUPMASK >> 2) & 1); ++rep_) { if (rep_) xcd_barrier(bar);
        if (bx & 1) for (int u = bx; u < 256; u += G) ret_decode_unit(lds, Z, state0, out + O_SS, MIX, rng, u >> 2, u & 3, tid);
        for (int u = bx; u < 256; u += G) ret_step1(lds, Z, KV, u >> 2, u & 3, tid);
        if (!(bx & 1)) for (int u = bx; u < 256; u += G) ret_decode_unit(lds, Z, state0, out + O_SS, MIX, rng, u >> 2, u & 3, tid);
    }
    SEAM(2);
    if (IN(3)) for (int rep_ = 0; rep_ < 1 + ((DUPMASK >> 3) & 1); ++rep_) { if (rep_) xcd_barrier(bar);
        if (tid < 256) ret_scan(KV, SP, out + O_SP, bx * 256 + tid, G * 256);
        if (bx & 1) for (int u = bx; u < 256; u += G) attn_decode_unit(lds, Z, cache_k, cache_v, MIX, gq, gk, sinks, out + O_KS, out + O_VS, u >> 1, u & 1, tid);
        for (int u = 256 + bx; u < 512; u += G) ret_decode_unit(lds, Z, state0, out + O_SS, MIX, rng, u >> 2, u & 3, tid);
        if (!(bx & 1)) for (int u = bx; u < 256; u += G) attn_decode_unit(lds, Z, cache_k, cache_v, MIX, gq, gk, sinks, out + O_KS, out + O_VS, u >> 1, u & 1, tid);
    }
    SEAM(3);
    if (IN(4)) for (int rep_ = 0; rep_ < 1 + ((DUPMASK >> 4) & 1); ++rep_) { if (rep_) xcd_barrier(bar);
        for (int u = bx; u < 256; u += G) ret_step2(lds, Z, SP, MIX, rng, u >> 2, u & 3, tid);
        for (int u = bx; u < 256; u += G) attn_prompt_unit(lds, Z, MIX, gq, gk, sinks, out + O_KP, out + O_VP, u >> 2, (u >> 1) & 1, u & 1, tid);
        {
            LAS float* scr = (LAS float*)(lds + wid * 17408);
            p0_convert(ResRest{w_out, w_up, w_dn, WOUT, WUP, WDN, ln2_g}, bx * 8 + wid, G * 8, NP0_REST, scr, lane);
        }
    }
    SEAM(4);
    if (IN(5)) for (int rep_ = 0; rep_ < 1 + ((DUPMASK >> 5) & 1); ++rep_) { if (rep_) xcd_barrier(bar);
        pg8::Gemm g{MIX, WOUT, LP, DM, DM}; pg8::StaticOrder S; S.init(LP, DM, G, bx, WGM_OUT);
        pg8::EpiOut E{x_p, XG, PART};
        pg8::gemm_phase<pg8::EpiOut, pg8::StaticOrder, true, true>(lds, g, S, E);
        const SkOut SE{x_s, out + O_Y + (size_t)LP * DM, XG + (size_t)LP * DM};
        for (int u = bx; u < 4 * (DM / 32); u += G) skinny_unit<1>(lds, MIX + (size_t)LP * DM, WOUT, DM, u >> 2, 0, (u & 3) * 32, SE, tid);
    }
    SEAM(5);
    if (IN(6)) for (int rep_ = 0; rep_ < 1 + ((DUPMASK >> 6) & 1); ++rep_) { if (rep_) xcd_barrier(bar);
        for (int row = bx + G * tid; row < LP; row += G * 512) { float s = 0.f;
#pragma unroll
            for (int j = 0; j < 8; ++j) { const f32x4 p = *(const f32x4*)(PART + (size_t)row * 32 + 4 * j); s += (p[0] + p[1]) + (p[2] + p[3]); }
            RSTD2[row] = 1.0f / (s * (1.0f / DM) + EPS); }
        for (int row = LP + bx * 8 + wid; row < MR; row += G * 8) {
            const float* xr = out + O_Y + (size_t)row * DM; float s = 0.f;
#pragma unroll
            for (int j = 0; j < 8; ++j) { const f32x4 v = *((const f32x4*)xr + lane + 64 * j); s += (v[0] * v[0] + v[1] * v[1]) + (v[2] * v[2] + v[3] * v[3]); }
            s = wave_sum(s); if (lane == 0) RSTD2[row] = 1.0f / (s * (1.0f / DM) + EPS); }
        pg8::Gemm g{XG, WUP, LP, FF, DM}; pg8::StaticOrder S; S.init(LP, FF, G, bx, WGM_UP);
        pg8::EpiUp E{U};
        pg8::gemm_phase<pg8::EpiUp, pg8::StaticOrder, true, true>(lds, g, S, E);
        const SkUp SE{U + (size_t)LP * FF};
        for (int u = bx; u < FF / 32; u += G) skinny_unit<4>(lds, XG + (size_t)LP * DM, WUP, DM, u, 0, 0, SE, tid);
    }
    SEAM(6);
    if (IN(7)) {
        if (bx & 1) for (int u = bx; u < 4 * (DM / 32); u += G) { const SkSlab SE{SLAB + (size_t)(u & 3) * NS * DM}; skinny_unit<4>(lds, U + (size_t)LP * FF, WDN, FF, u >> 2, (u & 3) * 2048, 0, SE, tid); }
        pg8::Gemm g{U, WDN, LP, DM, FF}; pg8::StaticOrder S; S.init(LP, DM, G, bx, WGM_DN);
        pg8::EpiDown E{out + O_Y, XG, RSTD2};
        pg8::gemm_phase<pg8::EpiDown, pg8::StaticOrder, true, true>(lds, g, S, E);
        if (!(bx & 1)) for (int u = bx; u < 4 * (DM / 32); u += G) { const SkSlab SE{SLAB + (size_t)(u & 3) * NS * DM}; skinny_unit<4>(lds, U + (size_t)LP * FF, WDN, FF, u >> 2, (u & 3) * 2048, 0, SE, tid); }
    }
    SEAM(7);
    if (IN(8)) {
        for (int e = bx * 512 + tid; e < NS * DM / 4; e += G * 512) {
            const int row = e >> 9; float* p = out + O_Y + (size_t)LP * DM + (size_t)e * 4;
            const f32x4 s = (*(const f32x4*)(SLAB + (size_t)e * 4) + *(const f32x4*)(SLAB + (size_t)NS * DM + (size_t)e * 4)) + (*(const f32x4*)(SLAB + (size_t)2 * NS * DM + (size_t)e * 4) + *(const f32x4*)(SLAB + (size_t)3 * NS * DM + (size_t)e * 4));
            *(f32x4*)p = *(const f32x4*)p + s * RSTD2[LP + row];
        }
    }
#undef IN
#undef SEAM
}

#ifndef N_LAUNCHES
#define N_LAUNCHES 1
#endif
extern "C" void kernel_launch(void* const* d_in, const int* in_sizes, int n_in, void* d_out, int out_size, void* d_ws, size_t ws_size, hipStream_t stream) {
    static int grid = 0;
    if (grid == 0) {
        if (n_in != 15 || (size_t)out_size != O_END || ws_size < WS_END) { fprintf(stderr, "kernel_launch: unexpected shapes (n_in %d out %d ws %zu)\n", n_in, out_size, ws_size); grid = -1; return; }
        int dev = 0, cus = 0, per_cu = 0;
        (void)hipGetDevice(&dev); (void)hipDeviceGetAttribute(&cus, hipDeviceAttributeMultiprocessorCount, dev);
        if (hipFuncSetAttribute((const void*)fwd_kernel, hipFuncAttributeMaxDynamicSharedMemorySize, LDS_BYTES) != hipSuccess) { fprintf(stderr, "kernel_launch: hipFuncSetAttribute failed\n"); grid = -1; return; }
        (void)hipOccupancyMaxActiveBlocksPerMultiprocessor(&per_cu, (const void*)fwd_kernel, 512, LDS_BYTES);
        (void)hipGetLastError();
        if (per_cu < 1) { fprintf(stderr, "kernel_launch: occupancy query says %d blocks per CU\n", per_cu); }
        grid = cus > 0 ? cus : 256;
    }
    if (grid < 0) return;
    if (hipMemsetAsync(d_ws, 0, 65536, stream) != hipSuccess) { fprintf(stderr, "kernel_launch: memset failed\n"); return; }
    Args a{};
    for (int i = 0; i < 15; ++i) a.in[i] = (const float*)d_in[i];
    a.out = (float*)d_out; a.ws = (unsigned char*)d_ws;
    if (N_LAUNCHES == 1) {
        a.ph_lo = 0; a.ph_hi = NPH;
        void* args[] = {&a};
        hipError_t e = hipLaunchCooperativeKernel((const void*)fwd_kernel, dim3(grid), dim3(512), args, LDS_BYTES, stream);
        if (e != hipSuccess) fprintf(stderr, "cooperative launch failed: %s (grid %d)\n", hipGetErrorString(e), grid);
    } else {
        for (int p = 0; p < NPH; ++p) { a.ph_lo = p; a.ph_hi = p + 1; hipLaunchKernelGGL(fwd_kernel, dim3(grid), dim3(512), LDS_BYTES, stream, a); }
    }
}
```

```cpp
#include <hip/hip_runtime.h>
#include <hip/hip_cooperative_groups.h>
#include <cstdio>
#include <cstdint>
namespace cg = cooperative_groups;

#ifndef WGM_IN
#define WGM_IN 3
#endif
#ifndef WGM_OUT
#define WGM_OUT 2
#endif
#ifndef WGM_UP
#define WGM_UP 2
#endif
#ifndef WGM_DN
#define WGM_DN 2
#endif
#ifndef DUPMASK
#define DUPMASK 0
#endif
#define DI __device__ __forceinline__
#define LAS __attribute__((address_space(3)))
typedef float f32x2 __attribute__((ext_vector_type(2)));
typedef float f32x16 __attribute__((ext_vector_type(16)));
typedef short s16x4 __attribute__((ext_vector_type(4)));
typedef unsigned u32x2 __attribute__((ext_vector_type(2)));
typedef __bf16 bf16x2v __attribute__((ext_vector_type(2)));

constexpr int DM = 2048, LP = 8192, NS = 128, MR = LP + NS  , MP = 8448  ;
constexpr int INW = 5376, FF = 8192;
constexpr int C_AQ = 0, C_AK = 1024, C_AV = 1152, C_RQ = 1280, C_RK = 2304, C_RV = 3328, C_RG = 4352;
constexpr float EPS = 1e-6f;

DI unsigned pk2(float lo, float hi) { f32x2 v = {lo, hi}; return __builtin_bit_cast(unsigned, __builtin_convertvector(v, bf16x2v)); }
DI float bflo(unsigned u) { return __uint_as_float(u << 16); }
DI float bfhi(unsigned u) { return __uint_as_float(u & 0xffff0000u); }
DI float bf2f(unsigned short u) { return __uint_as_float(((unsigned)u) << 16); }

namespace pg8 {
#define PG8_LAS __attribute__((address_space(3)))
typedef unsigned short bf16_t;
typedef short bf16x8 __attribute__((ext_vector_type(8)));
typedef float f32x4 __attribute__((ext_vector_type(4)));
typedef unsigned u32x4 __attribute__((ext_vector_type(4)));
constexpr int BM = 256, BK = 64, HALF = 128, HTB = HALF * BK * 2  , STAGE_BYTES = 8 * HTB, NXCD = 8, WGM = 8;

__host__ __device__ __forceinline__ int lds_byte(int r, int c) { const int st = (r >> 4) * 2 + (c >> 5), rr = r & 15, cc = c & 31, ob = rr * 64 + cc * 2; return st * 1024 + (ob ^ (((ob >> 9) & 1) << 5)); }
__host__ __device__ __forceinline__ void stage_rc(int b, int& R, int& C) { const int st = b / 1024, sb = b % 1024, swz = sb ^ (((sb >> 9) & 1) << 5); R = (st >> 1) * 16 + swz / 64; C = (st & 1) * 32 + (swz % 64) / 2; }
__host__ __device__ __forceinline__ int perm32(int rho) { const int n = rho >> 4, i = rho & 15; return 8 * (i >> 2) + 4 * n + (i & 3); }

struct Unit { int pm, pn; };
struct Gemm { const bf16_t* A; const bf16_t* Bt; int M, N, K; };

struct StaticOrder {
    int nM, nN, nwg, G, c, wgm;
    __host__ __device__ void init(int M, int N, int G_, int c_, int wgm_) { nM = M / BM; nN = N / BM; nwg = nM * nN; G = G_; c = c_; wgm = wgm_; }
    __host__ __device__ bool next(int i, Unit& u) const {
        const long L = (long)i * G + c; if (L >= nwg) return false;
        int wgid = (int)L; { const int q = nwg / NXCD, r = nwg % NXCD, xcd = wgid % NXCD, off = wgid / NXCD; wgid = (xcd < r ? xcd * (q + 1) : r * (q + 1) + (xcd - r) * q) + off; }
        const int nig = wgm * nN, gid = wgid / nig, fm = gid * wgm, gsz = (nM - fm) < wgm ? (nM - fm) : wgm;
        u.pm = fm + ((wgid % nig) % gsz); u.pn = (wgid % nig) / gsz; return true;
    }
    __device__ __forceinline__ void a_ready(const Unit&) const {}
    __device__ __forceinline__ void done(const Unit&) const {}
};


DI u32x4 pack8f(const f32x4& a, const f32x4& b) { u32x4 w; w.x = pk2(a[0], a[1]); w.y = pk2(a[2], a[3]); w.z = pk2(b[0], b[1]); w.w = pk2(b[2], b[3]); return w; }

struct EpiIn {
    static constexpr bool PERM = true, AFTER_DRAIN = false;
    bf16_t* Z;
    __device__ __forceinline__ void operator()(const f32x4 (&acc)[2][2][4][2], const Unit& u, int wr, int wc, int fr, int fq) const {
        const int row0 = u.pm * BM + wr * 64 + fr, col0 = u.pn * BM + wc * 32 + 8 * fq;
        if (u.pn < 5 || u.pn > 12) {
#pragma unroll
            for (int ai = 0; ai < 2; ++ai)
#pragma unroll
                for (int m = 0; m < 4; ++m) { bf16_t* rowp = Z + (size_t)(row0 + ai * HALF + m * 16) * INW + col0;
#pragma unroll
                    for (int bj = 0; bj < 2; ++bj) *(u32x4*)(rowp + bj * HALF) = pack8f(acc[ai][bj][m][0], acc[ai][bj][m][1]); }
        } else {
            const int head = (u.pn - 5) & 3; const bool isk = u.pn >= 9;
            const float lg = log1pf(-exp2f(-5.0f - (float)head));
            float inv[8];
#pragma unroll
            for (int j = 0; j < 8; ++j) inv[j] = powf(10000.0f, -(float)(wc * 32 + 8 * fq + j) * (1.0f / 128.0f));
#pragma unroll
            for (int ai = 0; ai < 2; ++ai)
#pragma unroll
                for (int m = 0; m < 4; ++m) {
                    const int row = row0 + ai * HALF + m * 16;
                    const int pos = row < LP ? row : LP; const float t = row < LP ? (float)(row & 127) : 0.0f;
                    const float f = isk ? 0.0625f * __expf(-lg * t) : __expf(lg * t);
                    f32x4 o1[2], o2[2];
#pragma unroll
                    for (int n = 0; n < 2; ++n)
#pragma unroll
                        for (int e = 0; e < 4; ++e) {
                            const float ang = (float)pos * inv[n * 4 + e];
                            double rev = (double)ang * 0.15915494309189535; rev -= floor(rev);
                            const float fr_ = (float)rev; const float sn = __builtin_amdgcn_sinf(fr_), cs = __builtin_amdgcn_cosf(fr_);
                            const float x1 = acc[ai][0][m][n][e], x2 = acc[ai][1][m][n][e];
                            o1[n][e] = (x1 * cs - x2 * sn) * f; o2[n][e] = (x2 * cs + x1 * sn) * f;
                        }
                    bf16_t* rowp = Z + (size_t)row * INW + col0;
                    *(u32x4*)(rowp) = pack8f(o1[0], o1[1]); *(u32x4*)(rowp + HALF) = pack8f(o2[0], o2[1]);
                }
        }
    }
};

struct EpiOut {
    static constexpr bool PERM = true, AFTER_DRAIN = false;
    const float* xp; bf16_t* X1B; float* part;
    __device__ __forceinline__ void operator()(const f32x4 (&acc)[2][2][4][2], const Unit& u, int wr, int wc, int fr, int fq) const {
#pragma unroll
        for (int ai = 0; ai < 2; ++ai)
#pragma unroll
            for (int m = 0; m < 4; ++m) {
                const int row = u.pm * BM + ai * HALF + wr * 64 + m * 16 + fr;
                const float* xrow = xp + (size_t)row * DM;
                float ss = 0.f;
#pragma unroll
                for (int bj = 0; bj < 2; ++bj) {
                    const int col = u.pn * BM + bj * HALF + wc * 32 + 8 * fq;
                    const f32x4 v0 = acc[ai][bj][m][0] + __builtin_nontemporal_load((const f32x4*)(xrow + col)), v1 = acc[ai][bj][m][1] + __builtin_nontemporal_load((const f32x4*)(xrow + col + 4));
                    ss += (v0[0] * v0[0] + v0[1] * v0[1]) + (v0[2] * v0[2] + v0[3] * v0[3]) + (v1[0] * v1[0] + v1[1] * v1[1]) + (v1[2] * v1[2] + v1[3] * v1[3]);
                    *(u32x4*)(X1B + (size_t)row * DM + col) = pack8f(v0, v1);
                }
                ss += __shfl_xor(ss, 16); ss += __shfl_xor(ss, 32);
                if (fq == 0) part[(size_t)row * 32 + u.pn * 4 + wc] = ss;
            }
    }
};

struct EpiUp {
    static constexpr bool PERM = true, AFTER_DRAIN = false;
    bf16_t* U;
    __device__ __forceinline__ void operator()(const f32x4 (&acc)[2][2][4][2], const Unit& u, int wr, int wc, int fr, int fq) const {
        const int row0 = u.pm * BM + wr * 64 + fr, col0 = u.pn * BM + wc * 32 + 8 * fq;
#pragma unroll
        for (int ai = 0; ai < 2; ++ai)
#pragma unroll
            for (int m = 0; m < 4; ++m) { bf16_t* rowp = U + (size_t)(row0 + ai * HALF + m * 16) * FF + col0;
#pragma unroll
                for (int bj = 0; bj < 2; ++bj) { f32x4 a = acc[ai][bj][m][0], b = acc[ai][bj][m][1];
#pragma unroll
                    for (int e = 0; e < 4; ++e) { a[e] = fmaxf(a[e], 0.f); a[e] *= a[e]; b[e] = fmaxf(b[e], 0.f); b[e] *= b[e]; }
                    *(u32x4*)(rowp + bj * HALF) = pack8f(a, b); } }
    }
};

struct EpiDown {
    static constexpr bool PERM = true, AFTER_DRAIN = false;
    float* Y; const bf16_t* X1B; const float* rstd2;
    __device__ __forceinline__ void operator()(const f32x4 (&acc)[2][2][4][2], const Unit& u, int wr, int wc, int fr, int fq) const {
#pragma unroll
        for (int ai = 0; ai < 2; ++ai)
#pragma unroll
            for (int m = 0; m < 4; ++m) {
                const int row = u.pm * BM + ai * HALF + wr * 64 + m * 16 + fr; const float r2 = rstd2[row];
#pragma unroll
                for (int bj = 0; bj < 2; ++bj) { const size_t o = (size_t)row * DM + u.pn * BM + bj * HALF + wc * 32 + 8 * fq;
                    const u32x4 xb = *(const u32x4*)(X1B + o);
                    const f32x4 a = {bflo(xb.x), bfhi(xb.x), bflo(xb.y), bfhi(xb.y)}, b = {bflo(xb.z), bfhi(xb.z), bflo(xb.w), bfhi(xb.w)};
                    *(f32x4*)(Y + o) = a + acc[ai][bj][m][0] * r2; *(f32x4*)(Y + o + 4) = b + acc[ai][bj][m][1] * r2; }
            }
    }
};
template <class Epi, class Sched, bool ALIGN_EPI = false, bool SP2 = false>
__device__ __forceinline__ void gemm_phase(PG8_LAS unsigned char* lds, const Gemm g, const Sched& S, const Epi& E) {
    const int tid = threadIdx.x, wid = __builtin_amdgcn_readfirstlane(tid >> 6), lane = tid & 63, wr = wid >> 2, wc = wid & 3, fr = lane & 15, fq = lane >> 4;
    const int K = g.K, nt = K / BK;
    unsigned voffA[2], voffB[2];
#pragma unroll
    for (int i = 0; i < 2; ++i) { int R, C; stage_rc(tid * 16 + i * 8192, R, C); const int Rb = Epi::PERM ? ((R & ~31) + perm32(R & 31)) : R;
        voffA[i] = (unsigned)(R * K + C) * 2u; voffB[i] = (unsigned)(Rb * K + C) * 2u; }
    const size_t kstep = (size_t)(BK * 2);
    const size_t hstep = (size_t)HALF * K * 2;
    const size_t tstep = 2 * hstep;
    const unsigned ldsw = (unsigned)wid * 1024u;
    const int aoff = lds_byte(wr * 64 + fr, fq * 8), boff = lds_byte(wc * 32 + fr, fq * 8);
#define PG8_SA(b, h) (((b) * 2 + (h)) * HTB)
#define PG8_SB(b, h) ((4 + (b) * 2 + (h)) * HTB)
#define PG8_STAGE(bufoff, gbase, voff) do { _Pragma("unroll") for (int _i = 0; _i < 2; ++_i) \
        __builtin_amdgcn_global_load_lds((const unsigned*)((const char*)(gbase) + (voff)[_i]), (PG8_LAS unsigned*)(lds + (bufoff) + ldsw + _i * 8192), 16, 0, 0); } while (0)
#define PG8_LDA(dst, b, h) do { _Pragma("unroll") for (int m = 0; m < 4; ++m) _Pragma("unroll") for (int k = 0; k < 2; ++k) dst[m][k] = *(const PG8_LAS bf16x8*)(lds + PG8_SA(b, h) + aoff + m * 2048 + k * 1024); } while (0)
#define PG8_LDB(dst, b, h) do { _Pragma("unroll") for (int n = 0; n < 2; ++n) _Pragma("unroll") for (int k = 0; k < 2; ++k) dst[n][k] = *(const PG8_LAS bf16x8*)(lds + PG8_SB(b, h) + boff + n * 2048 + k * 1024); } while (0)
#define PG8_MMA(ai, bj, At, Bt) do { __builtin_amdgcn_s_setprio(1); _Pragma("unroll") for (int m = 0; m < 4; ++m) _Pragma("unroll") for (int n = 0; n < 2; ++n) _Pragma("unroll") for (int k = 0; k < 2; ++k) \
        acc[ai][bj][m][n] = __builtin_amdgcn_mfma_f32_16x16x32_bf16(Bt[n][k], At[m][k], acc[ai][bj][m][n], 0, 0, 0); __builtin_amdgcn_s_setprio(0); } while (0)
#define PG8_WAIT_V(n) asm volatile("s_waitcnt vmcnt(" #n ")" ::: "memory")
#define PG8_WAIT_L(n) asm volatile("s_waitcnt lgkmcnt(" #n ")" ::: "memory")
#define PG8_BAR __builtin_amdgcn_s_barrier()
#define PG8_SCHED __builtin_amdgcn_sched_barrier(0)
    Unit cur, nxt; int ui = 0;
    if (!S.next(0, cur)) return;
    f32x4 acc[2][2][4][2];
#pragma unroll
    for (int a = 0; a < 2; ++a)
#pragma unroll
        for (int b = 0; b < 2; ++b)
#pragma unroll
            for (int m = 0; m < 4; ++m)
#pragma unroll
                for (int n = 0; n < 2; ++n) acc[a][b][m][n] = (f32x4){0.f, 0.f, 0.f, 0.f};
    bf16x8 At[4][2], B0[2][2], B1[2][2];
    const char* cA = (const char*)g.A + (size_t)cur.pm * tstep; const char* cB = (const char*)g.Bt + (size_t)cur.pn * tstep;
    S.a_ready(cur);
    if constexpr (SP2) {
        PG8_STAGE(PG8_SB(0, 0), cB, voffB); PG8_STAGE(PG8_SB(0, 1), cB + hstep, voffB); PG8_STAGE(PG8_SA(0, 0), cA, voffA); PG8_STAGE(PG8_SA(0, 1), cA + hstep, voffA);
        if (wr == 1) PG8_BAR;
        PG8_WAIT_V(2); PG8_BAR;
        PG8_STAGE(PG8_SB(1, 0), cB + kstep, voffB); PG8_STAGE(PG8_SA(1, 0), cA + kstep, voffA); PG8_STAGE(PG8_SB(1, 1), cB + hstep + kstep, voffB);
        PG8_WAIT_V(6); PG8_BAR;
    } else {
        PG8_STAGE(PG8_SB(0, 0), cB, voffB); PG8_STAGE(PG8_SA(0, 0), cA, voffA); PG8_STAGE(PG8_SB(0, 1), cB + hstep, voffB); PG8_STAGE(PG8_SA(0, 1), cA + hstep, voffA);
        if (wr == 1) PG8_BAR;
        PG8_WAIT_V(4); PG8_BAR;
        PG8_STAGE(PG8_SB(1, 0), cB + kstep, voffB); PG8_STAGE(PG8_SA(1, 0), cA + kstep, voffA); PG8_STAGE(PG8_SB(1, 1), cB + hstep + kstep, voffB);
        PG8_WAIT_V(6); PG8_BAR;
    }
    for (;;) {
        const bool has_next = S.next(ui + 1, nxt);
        const char* nA = has_next ? (const char*)g.A + (size_t)nxt.pm * tstep : cA; const char* nB = has_next ? (const char*)g.Bt + (size_t)nxt.pn * tstep : cB;
        for (int t = 0; t < nt; t += 2) {
            const bool last = (t == nt - 2);
            const char* a1 = cA + (size_t)(t + 1) * kstep;
            const char* a2 = last ? nA : cA + (size_t)(t + 2) * kstep; const char* b2 = last ? nB : cB + (size_t)(t + 2) * kstep;
            const char* a3 = a2 + kstep; const char* b3 = b2 + kstep;
            if (last && has_next) S.a_ready(nxt);
            if constexpr (SP2) {
            PG8_LDB(B0, 0, 0); PG8_LDB(B1, 0, 1); PG8_SCHED; PG8_LDA(At, 0, 0); PG8_STAGE(PG8_SA(1, 1), a1 + hstep, voffA);
            PG8_WAIT_V(8); PG8_WAIT_L(0); PG8_BAR; PG8_MMA(0, 0, At, B0); PG8_MMA(0, 1, At, B1); PG8_BAR; PG8_SCHED;
            PG8_LDA(At, 0, 1); PG8_STAGE(PG8_SB(0, 0), b2, voffB); PG8_STAGE(PG8_SB(0, 1), b2 + hstep, voffB); PG8_STAGE(PG8_SA(0, 0), a2, voffA);
            PG8_WAIT_V(8); PG8_WAIT_L(0); PG8_BAR; PG8_MMA(1, 0, At, B0); PG8_MMA(1, 1, At, B1); PG8_BAR; PG8_SCHED;
            PG8_LDB(B0, 1, 0); PG8_LDB(B1, 1, 1); PG8_SCHED; PG8_LDA(At, 1, 0); PG8_STAGE(PG8_SA(0, 1), a2 + hstep, voffA);
            PG8_WAIT_V(8); PG8_WAIT_L(0); PG8_BAR; PG8_MMA(0, 0, At, B0); PG8_MMA(0, 1, At, B1); PG8_BAR; PG8_SCHED;
            PG8_LDA(At, 1, 1); PG8_STAGE(PG8_SB(1, 0), b3, voffB); PG8_STAGE(PG8_SB(1, 1), b3 + hstep, voffB); PG8_STAGE(PG8_SA(1, 0), a3, voffA);
            PG8_WAIT_V(8); PG8_WAIT_L(0); PG8_BAR; PG8_MMA(1, 0, At, B0); PG8_MMA(1, 1, At, B1); PG8_BAR; PG8_SCHED;
            } else {
            PG8_LDB(B0, 0, 0); PG8_SCHED; PG8_LDA(At, 0, 0); PG8_STAGE(PG8_SA(1, 1), a1 + hstep, voffA);
            PG8_WAIT_L(8); PG8_BAR; PG8_WAIT_L(0); PG8_MMA(0, 0, At, B0); PG8_BAR; PG8_SCHED;
            PG8_LDB(B1, 0, 1); PG8_STAGE(PG8_SB(0, 0), b2, voffB);
            PG8_BAR; PG8_WAIT_L(0); PG8_MMA(0, 1, At, B1); PG8_BAR;
            PG8_LDA(At, 0, 1); PG8_STAGE(PG8_SA(0, 0), a2, voffA);
            PG8_BAR; PG8_WAIT_L(0); PG8_MMA(1, 0, At, B0); PG8_BAR; PG8_SCHED;
            PG8_STAGE(PG8_SB(0, 1), b2 + hstep, voffB);
            PG8_WAIT_V(6); PG8_BAR; PG8_MMA(1, 1, At, B1); PG8_BAR;
            PG8_LDB(B0, 1, 0); PG8_SCHED; PG8_LDA(At, 1, 0); PG8_STAGE(PG8_SA(0, 1), a2 + hstep, voffA);
            PG8_WAIT_L(8); PG8_BAR; PG8_WAIT_L(0); PG8_MMA(0, 0, At, B0); PG8_BAR; PG8_SCHED;
            PG8_LDB(B1, 1, 1); PG8_STAGE(PG8_SB(1, 0), b3, voffB);
            PG8_BAR; PG8_WAIT_L(0); PG8_MMA(0, 1, At, B1); PG8_BAR;
            PG8_LDA(At, 1, 1); PG8_STAGE(PG8_SA(1, 0), a3, voffA);
            PG8_BAR; PG8_WAIT_L(0); PG8_MMA(1, 0, At, B0); PG8_BAR; PG8_SCHED;
            PG8_STAGE(PG8_SB(1, 1), b3 + hstep, voffB);
            PG8_WAIT_V(6); PG8_BAR; PG8_MMA(1, 1, At, B1); PG8_BAR;
            }
        }
        if constexpr (ALIGN_EPI) { if (wr == 0) PG8_BAR; }
        if constexpr (!Epi::AFTER_DRAIN) { E(acc, cur, wr, wc, fr, fq); S.done(cur); }
        if (!has_next) break;
#pragma unroll
        for (int a = 0; a < 2; ++a)
#pragma unroll
            for (int b = 0; b < 2; ++b)
#pragma unroll
                for (int m = 0; m < 4; ++m)
#pragma unroll
                    for (int n = 0; n < 2; ++n) acc[a][b][m][n] = (f32x4){0.f, 0.f, 0.f, 0.f};
        cur = nxt; cA = nA; cB = nB; ++ui;
        if constexpr (ALIGN_EPI) { if (wr == 1) PG8_BAR; }
    }
    PG8_WAIT_V(0);
    if constexpr (!ALIGN_EPI) { if (wr == 0) PG8_BAR; }
    PG8_BAR;
    if constexpr (Epi::AFTER_DRAIN) { E.fused(acc, cur, wr, wc, fr, fq, lds, wid, lane); S.done(cur); }
#undef PG8_SA
#undef PG8_SB
#undef PG8_STAGE
#undef PG8_LDA
#undef PG8_LDB
#undef PG8_MMA
#undef PG8_WAIT_V
#undef PG8_WAIT_L
#undef PG8_BAR
#undef PG8_SCHED
}
}

using pg8::bf16_t; using pg8::bf16x8; using pg8::f32x4; using pg8::u32x4;
#define MFMA32(a, b, c) __builtin_amdgcn_mfma_f32_32x32x16_bf16((a), (b), (c), 0, 0, 0)
DI int crow(int reg, int h) { return (reg & 3) + 8 * (reg >> 2) + 4 * h; }
DI float wave_sum(float v) {
#pragma unroll
    for (int o = 1; o < 64; o <<= 1) v += __shfl_xor(v, o);
    return v;
}
DI float wave_max(float v) {
#pragma unroll
    for (int o = 1; o < 64; o <<= 1) v = fmaxf(v, __shfl_xor(v, o));
    return v;
}
DI bf16x8 pack8(const f32x16& x, int s) { u32x4 p; p.x = pk2(x[8 * s], x[8 * s + 1]); p.y = pk2(x[8 * s + 2], x[8 * s + 3]); p.z = pk2(x[8 * s + 4], x[8 * s + 5]); p.w = pk2(x[8 * s + 6], x[8 * s + 7]); return __builtin_bit_cast(bf16x8, p); }
DI bf16x8 cat4(s16x4 lo, s16x4 hi) { return __builtin_shufflevector(lo, hi, 0, 1, 2, 3, 4, 5, 6, 7); }
DI f32x16 zero16() { f32x16 z;
#pragma unroll
    for (int i = 0; i < 16; ++i) z[i] = 0.f;
    return z; }
DI float gamma_of(int h) { return 1.0f - exp2f(-5.0f - (float)h); }

constexpr size_t MiB = 1u << 20;
constexpr size_t WS_WIN = 1 * MiB;
constexpr size_t WS_WOUT = 23 * MiB;
constexpr size_t WS_WUP = 31 * MiB;
constexpr size_t WS_WDN = 63 * MiB;
constexpr size_t WS_H1 = 95 * MiB;
constexpr size_t WS_MIX = 128 * MiB;
constexpr size_t WS_PART = 161 * MiB;
constexpr size_t WS_RSTD2 = 163 * MiB;
constexpr size_t WS_Z = 164 * MiB;
constexpr size_t WS_KV = 252 * MiB;
constexpr size_t WS_SP = 316 * MiB;
constexpr size_t WS_U = 164 * MiB;
constexpr size_t WS_END = 348 * MiB;
static_assert(WS_Z + (size_t)MP * INW * 2 <= WS_KV && WS_U + (size_t)MP * FF * 2 <= WS_END && WS_H1 + (size_t)MP * DM * 2 <= WS_MIX && WS_MIX + (size_t)MP * DM * 2 <= WS_PART, "ws map");
constexpr int LDS_BYTES = 147456;

constexpr size_t O_Y = 0, O_KP = (size_t)MR * DM, O_VP = O_KP + 16384, O_SP = O_VP + 16384, O_KS = O_SP + 262144, O_VS = O_KS + 2097152, O_SS = O_VS + 2097152, O_END = O_SS + 33554432;

struct TItem { const float* W; bf16_t* WT; int K, N, item; const float* rs; };
DI void p0_load(const TItem& t, f32x4 (&v)[8], int lane) {
    const int nblk = t.N / 32, kb = t.item / nblk, nb = t.item % nblk, k0 = 64 * kb, n0 = 32 * nb, c = lane & 7, rr = lane >> 3;
#pragma unroll
    for (int i = 0; i < 8; ++i) v[i] = __builtin_nontemporal_load((const f32x4*)(t.W + (size_t)(k0 + 8 * i + rr) * t.N + n0 + 4 * c));
    if (t.rs) {
#pragma unroll
        for (int i = 0; i < 8; ++i) v[i] = v[i] * t.rs[k0 + 8 * i + rr];
    }
}
DI void p0_store(const TItem& t, const f32x4 (&v)[8], LAS float* scr, int lane) {
    const int nblk = t.N / 32, kb = t.item / nblk, nb = t.item % nblk, k0 = 64 * kb, n0 = 32 * nb, c = lane & 7, rr = lane >> 3;
#pragma unroll
    for (int i = 0; i < 8; ++i) { LAS float* d = scr + (8 * i + rr) * 33 + 4 * c; d[0] = v[i][0]; d[1] = v[i][1]; d[2] = v[i][2]; d[3] = v[i][3]; }
    asm volatile("s_waitcnt lgkmcnt(0)" ::: "memory");
#pragma unroll
    for (int j = 0; j < 4; ++j) { const int n = (lane >> 3) + 8 * j; const LAS float* s = scr + (8 * c) * 33 + n;
        u32x4 o; o.x = pk2(s[0 * 33], s[1 * 33]); o.y = pk2(s[2 * 33], s[3 * 33]); o.z = pk2(s[4 * 33], s[5 * 33]); o.w = pk2(s[6 * 33], s[7 * 33]);
        *(u32x4*)(t.WT + (size_t)(n0 + n) * t.K + k0 + 8 * c) = o; }
    asm volatile("s_waitcnt lgkmcnt(0)" ::: "memory");
}
struct ResIn { const float* w; bf16_t* wt; DI TItem operator()(int it) const { return TItem{w, wt, DM, INW, it, nullptr}; } };
struct ResRest { const float* w_out; const float* w_up; const float* w_dn; bf16_t* WOUT; bf16_t* WUP; bf16_t* WDN; const float* g2;
    DI TItem operator()(int it) const { constexpr int I_OUT = (DM / 64) * (DM / 32), I_UP = (DM / 64) * (FF / 32); int r = it;
        if (r < I_OUT) return TItem{w_out, WOUT, DM, DM, r, nullptr}; r -= I_OUT;
        if (r < I_UP) return TItem{w_up, WUP, DM, FF, r, g2}; r -= I_UP;
        return TItem{w_dn, WDN, FF, DM, r, nullptr}; } };
template <class Resolve>
DI void p0_convert(const Resolve R, int first, int stride, int total, LAS float* scr, int lane) {
    for (int it = first; it < total; it += 2 * stride) {
        const bool two = it + stride < total;
        const TItem t0 = R(it), t1 = R(two ? it + stride : it);
        f32x4 v0[8], v1[8];
        p0_load(t0, v0, lane);
        if (two) p0_load(t1, v1, lane);
        p0_store(t0, v0, scr, lane);
        if (two) p0_store(t1, v1, scr + 64 * 33, lane);
    }
}
DI void rms_row(const float* xrow, const float* g, bf16_t* orow, int lane) {
    f32x4 v[8]; float s = 0.f;
#pragma unroll
    for (int j = 0; j < 8; ++j) { v[j] = __builtin_nontemporal_load((const f32x4*)xrow + lane + 64 * j); s += (v[j][0] * v[j][0] + v[j][1] * v[j][1]) + (v[j][2] * v[j][2] + v[j][3] * v[j][3]); }
    const float rstd = rsqrtf(wave_sum(s) * (1.0f / DM) + EPS);
#pragma unroll
    for (int j = 0; j < 8; ++j) { const f32x4 gg = *((const f32x4*)g + lane + 64 * j); u32x2 o; o.x = pk2(v[j][0] * rstd * gg[0], v[j][1] * rstd * gg[1]); o.y = pk2(v[j][2] * rstd * gg[2], v[j][3] * rstd * gg[3]);
        *((u32x2*)orow + lane + 64 * j) = o; }
}

DI void stage_T128x256(LAS unsigned char* img, const bf16_t* src, int tid) {
#pragma unroll
    for (int k = 0; k < 4; ++k) {
        const int it = k * 512 + tid, dgl = it & 3, tpl = (it >> 2) & 15, rest = it >> 6, dg = dgl + 4 * (rest & 7), tp = tpl + 16 * (rest >> 3);
        const bf16_t* p = src + (size_t)(2 * tp) * INW + dg * 8;
        const u32x4 a = *(const u32x4*)p, b = *(const u32x4*)(p + INW);
#pragma unroll
        for (int e = 0; e < 8; ++e) {
            const unsigned lo = (e & 1) ? (a[e >> 1] >> 16) : (a[e >> 1] & 0xffffu), hi = (e & 1) ? (b[e >> 1] & 0xffff0000u) : (b[e >> 1] << 16);
            *(LAS unsigned*)(img + (dg * 8 + e) * 264 + tp * 4) = lo | hi;
        }
    }
}

DI void ret_step1(LAS unsigned char* lds, const bf16_t* Z, bf16_t* KV, int n, int h, int tid) {
    LAS unsigned char* Kt = lds; LAS unsigned char* Vt = lds + 256 * 264;
    const int lane = tid & 63, wid = tid >> 6, r = lane & 31, hh = lane >> 5;
    stage_T128x256(Kt, Z + (size_t)(n * 128) * INW + C_RK + h * 256, tid);
    stage_T128x256(Vt, Z + (size_t)(n * 128) * INW + C_RV + h * 256, tid);
    __syncthreads();
    f32x16 acc[8];
#pragma unroll
    for (int i = 0; i < 8; ++i) acc[i] = zero16();
    const int dk0 = wid * 32;
#pragma unroll 2
    for (int s = 0; s < 8; ++s) {
        const LAS unsigned char* pa = Kt + (dk0 + r) * 264 + (16 * s + 8 * hh) * 2;
        const bf16x8 A = cat4(*(const LAS s16x4*)pa, *(const LAS s16x4*)(pa + 8));
#pragma unroll
        for (int dt = 0; dt < 8; ++dt) {
            const LAS unsigned char* pb = Vt + (dt * 32 + r) * 264 + (16 * s + 8 * hh) * 2;
            const bf16x8 B = cat4(*(const LAS s16x4*)pb, *(const LAS s16x4*)(pb + 8));
            acc[dt] = MFMA32(A, B, acc[dt]);
        }
    }
    bf16_t* out = KV + ((size_t)(n * 4 + h) * 256) * 256 + dk0 + 4 * hh;
#pragma unroll
    for (int dt = 0; dt < 8; ++dt)
#pragma unroll
        for (int g4 = 0; g4 < 4; ++g4) { u32x2 o; o.x = pk2(acc[dt][4 * g4], acc[dt][4 * g4 + 1]); o.y = pk2(acc[dt][4 * g4 + 2], acc[dt][4 * g4 + 3]);
            *(u32x2*)(out + (size_t)(dt * 32 + r) * 256 + 8 * g4) = o; }
    __syncthreads();
}

DI void ret_scan(const bf16_t* KV, bf16_t* SP, float* o_state, int gt, int nthreads) {
    for (int e = gt; e < 65536; e += nthreads) {
        const int h = e >> 14, dv = (e >> 6) & 255, dk4 = (e & 63) * 4;
        const float lg = log1pf(-exp2f(-5.0f - (float)h)), Dc = __expf(128.0f * lg), c1 = __expf(127.0f * lg);
        const size_t base = ((size_t)(h * 256 + dv)) * 256 + dk4;
        f32x4 s = {0.f, 0.f, 0.f, 0.f};
        for (int n0 = 0; n0 < 64; n0 += 32) {
            u32x2 q[32];
#pragma unroll
            for (int u = 0; u < 32; ++u) q[u] = *(const u32x2*)(KV + (size_t)(n0 + u) * 262144 + base);
#pragma unroll
            for (int u = 0; u < 32; ++u) { u32x2 o; o.x = pk2(s[0], s[1]); o.y = pk2(s[2], s[3]); *(u32x2*)(SP + (size_t)(n0 + u) * 262144 + base) = o;
                const f32x4 kv = {bflo(q[u].x), bfhi(q[u].x), bflo(q[u].y), bfhi(q[u].y)}; s = s * Dc + kv * c1; }
        }
#pragma unroll
        for (int j = 0; j < 4; ++j) o_state[((size_t)(h * 256 + dk4 + j)) * 256 + dv] = s[j];
    }
}

DI float silu_f(float x) { return x * __builtin_amdgcn_rcpf(1.0f + __builtin_amdgcn_exp2f(-1.4426950408889634f * x)); }

DI void ret_step2(LAS unsigned char* lds, const bf16_t* Z, const bf16_t* SP, bf16_t* MIX, const float* rng, int n, int h, int tid) {
    LAS unsigned char* Kr = lds; LAS unsigned char* Vt = lds + 128 * 528; LAS float* red = (LAS float*)(lds + 128 * 528 + 256 * 264);
    const int lane = tid & 63, wid = tid >> 6, r = lane & 31, hh = lane >> 5;
    const bf16_t* zc = Z + (size_t)(n * 128) * INW;
#pragma unroll
    for (int k = 0; k < 8; ++k) { const int it = k * 512 + tid, row = it >> 5, c = it & 31;
        *(LAS u32x4*)(Kr + row * 528 + c * 16) = *(const u32x4*)(zc + (size_t)row * INW + C_RK + h * 256 + c * 8); }
    stage_T128x256(Vt, zc + C_RV + h * 256, tid);
    const int it_ = wid >> 1, dh = wid & 1;
    bf16x8 qf[16];
    { const bf16_t* qp = zc + (size_t)(32 * it_ + r) * INW + C_RQ + h * 256 + 8 * hh;
#pragma unroll
      for (int s = 0; s < 16; ++s) qf[s] = *(const bf16x8*)(qp + 16 * s); }
    f32x16 acc[4];
#pragma unroll
    for (int i = 0; i < 4; ++i) acc[i] = zero16();
    const float gm = gamma_of(h);
    __syncthreads();
    for (int jt = 0; jt <= it_; ++jt) {
        f32x16 X = zero16();
#pragma unroll
        for (int s = 0; s < 16; ++s) { const bf16x8 A = *(const LAS bf16x8*)(Kr + (32 * jt + r) * 528 + (16 * s + 8 * hh) * 2); X = MFMA32(A, qf[s], X); }
        if (jt == it_) {
#pragma unroll
            for (int i = 0; i < 16; ++i) X[i] = (crow(i, hh) > r) ? 0.f : X[i];
        }
#pragma unroll
        for (int s2 = 0; s2 < 2; ++s2) { const bf16x8 xs = pack8(X, s2);
#pragma unroll
            for (int dt = 0; dt < 4; ++dt) { const LAS unsigned char* pa = Vt + (128 * dh + 32 * dt + r) * 264 + (32 * jt + 16 * s2 + 4 * hh) * 2;
                const bf16x8 A = cat4(*(const LAS s16x4*)pa, *(const LAS s16x4*)(pa + 16)); acc[dt] = MFMA32(A, xs, acc[dt]); } }
    }
    { const float ig = 1.0f / gm;
#pragma unroll
      for (int dt = 0; dt < 4; ++dt) acc[dt] = acc[dt] * ig; }
    __syncthreads();
    {
        const bf16_t* spg = SP + (size_t)(n * 4 + h) * 65536;
        const bf16_t* ge = spg + (size_t)(tid >> 5) * 256 + ((tid & 31) ^ (tid >> 5)) * 8;
        const bf16_t* go = spg + (size_t)(tid >> 5) * 256 + ((tid & 31) ^ (16 + (tid >> 5))) * 8;
        LAS unsigned char* ld = lds + wid * 1024;
#pragma unroll 1
        for (int k = 0; k < 16; k += 2) {
            __builtin_amdgcn_global_load_lds((const unsigned*)(ge + (size_t)k * 4096), (LAS unsigned*)(ld + k * 8192), 16, 0, 0);
            __builtin_amdgcn_global_load_lds((const unsigned*)(go + (size_t)(k + 1) * 4096), (LAS unsigned*)(ld + (k + 1) * 8192), 16, 0, 0);
        }
        asm volatile("s_waitcnt vmcnt(0)" ::: "memory");
    }
    __syncthreads();
#pragma unroll
    for (int dt = 0; dt < 4; ++dt)
#pragma unroll
        for (int s = 0; s < 16; ++s) { const int rw = 128 * dh + 32 * dt + r; const bf16x8 A = *(const LAS bf16x8*)(lds + rw * 512 + (((2 * s + hh) ^ (rw & 31)) * 16)); acc[dt] = MFMA32(A, qf[s], acc[dt]); }
#pragma unroll
    for (int dt = 0; dt < 4; ++dt) acc[dt] = acc[dt] * gm;
    float ss = 0.f;
#pragma unroll
    for (int dt = 0; dt < 4; ++dt)
#pragma unroll
        for (int i = 0; i < 16; ++i) ss += acc[dt][i] * acc[dt][i];
    ss += __shfl_xor(ss, 32);
    if (hh == 0) red[wid * 32 + r] = ss;
    __syncthreads();
    const float rstd = rsqrtf((red[wid * 32 + r] + red[(wid ^ 1) * 32 + r]) * (1.0f / 256.0f) + EPS);
#pragma unroll
    for (int dt = 0; dt < 4; ++dt)
#pragma unroll
        for (int g4 = 0; g4 < 4; ++g4) { const int dv = 128 * dh + 32 * dt + 8 * g4 + 4 * hh;
            *(LAS f32x4*)(lds + (32 * it_ + r) * 1040 + dv * 4) = (f32x4){acc[dt][4 * g4] * rstd, acc[dt][4 * g4 + 1] * rstd, acc[dt][4 * g4 + 2] * rstd, acc[dt][4 * g4 + 3] * rstd}; }
    __syncthreads();
#pragma unroll 1
    for (int k = 0; k < 8; ++k) {
        const int it = k * 512 + tid, tk = it >> 5, c8 = (it & 31) * 8; const size_t token = (size_t)n * 128 + tk;
        const u32x4 gz = *(const u32x4*)(Z + token * INW + C_RG + h * 256 + c8);
        const f32x4 g0 = *(const f32x4*)(rng + h * 256 + c8), g1 = *(const f32x4*)(rng + h * 256 + c8 + 4);
        const f32x4 p0 = *(const LAS f32x4*)(lds + tk * 1040 + c8 * 4), p1 = *(const LAS f32x4*)(lds + tk * 1040 + c8 * 4 + 16);
        u32x4 o;
        o.x = pk2(p0[0] * g0[0] * silu_f(bflo(gz.x)), p0[1] * g0[1] * silu_f(bfhi(gz.x))); o.y = pk2(p0[2] * g0[2] * silu_f(bflo(gz.y)), p0[3] * g0[3] * silu_f(bfhi(gz.y)));
        o.z = pk2(p1[0] * g1[0] * silu_f(bflo(gz.z)), p1[1] * g1[1] * silu_f(bfhi(gz.z))); o.w = pk2(p1[2] * g1[2] * silu_f(bflo(gz.w)), p1[3] * g1[3] * silu_f(bfhi(gz.w)));
        *(u32x4*)(MIX + token * DM + 1024 + h * 256 + c8) = o;
    }
    __syncthreads();
}

DI void ret_decode_unit(LAS unsigned char* lds, const bf16_t* Z, const float* S0, float* S1, bf16_t* MIX, const float* rng, int b, int h, int tid) {
    LAS float* qv = (LAS float*)lds; LAS float* red = qv + 768;
    const int lane = tid & 63, wid = tid >> 6;
    const bf16_t* zrow = Z + (size_t)(LP + b) * INW;
    if (tid < 256) { qv[tid] = bf2f(zrow[C_RQ + h * 256 + tid]); qv[256 + tid] = bf2f(zrow[C_RK + h * 256 + tid]); qv[512 + tid] = bf2f(zrow[C_RV + h * 256 + tid]); }
    __syncthreads();
    const float gm = gamma_of(h);
    const f32x4 v4 = *(const LAS f32x4*)(qv + 512 + 4 * lane);
    f32x4 acc = {0.f, 0.f, 0.f, 0.f};
    const size_t off = ((size_t)(b * 4 + h) * 256 + wid * 32) * 256 + 4 * lane;
    const float* s0 = S0 + off; float* s1 = S1 + off;
#pragma unroll 1
    for (int rr = 0; rr < 32; rr += 16) {
        f32x4 s[16];
#pragma unroll
        for (int u = 0; u < 16; ++u) s[u] = __builtin_nontemporal_load((const f32x4*)(s0 + (size_t)(rr + u) * 256));
#pragma unroll
        for (int u = 0; u < 16; ++u) { const int dk = wid * 32 + rr + u; const float kk = qv[256 + dk], qq = qv[dk];
            const f32x4 sn = s[u] * gm + v4 * kk; __builtin_nontemporal_store(sn, (f32x4*)(s1 + (size_t)(rr + u) * 256)); acc += sn * qq; }
    }
    *(LAS f32x4*)(red + wid * 256 + 4 * lane) = acc;
    __syncthreads();
    if (wid == 0) {
        f32x4 o = {0.f, 0.f, 0.f, 0.f};
#pragma unroll
        for (int w = 0; w < 8; ++w) o += *(const LAS f32x4*)(red + w * 256 + 4 * lane);
        const float ssq = wave_sum((o[0] * o[0] + o[1] * o[1]) + (o[2] * o[2] + o[3] * o[3]));
        const float rstd = rsqrtf(ssq * (1.0f / 256.0f) + EPS);
        const u32x2 gz = *(const u32x2*)(zrow + C_RG + h * 256 + 4 * lane);
        const f32x4 gn = *(const f32x4*)(rng + h * 256 + 4 * lane);
        u32x2 y; y.x = pk2(o[0] * rstd * gn[0] * silu_f(bflo(gz.x)), o[1] * rstd * gn[1] * silu_f(bfhi(gz.x)));
        y.y = pk2(o[2] * rstd * gn[2] * silu_f(bflo(gz.y)), o[3] * rstd * gn[3] * silu_f(bfhi(gz.y)));
        *(u32x2*)(MIX + (size_t)(LP + b) * DM + 1024 + h * 256 + 4 * lane) = y;
    }
    __syncthreads();
}

DI void attn_prompt_unit(LAS unsigned char* lds, const bf16_t* Z, bf16_t* MIX, const float* gq, const float* gk, const float* sinks, float* o_k, float* o_v, int nb, int kh, int hf, int tid) {
    LAS unsigned char* Kn = lds; LAS unsigned char* Vt = lds + 256 * 144;
    const int lane = tid & 63, wid = tid >> 6, r = lane & 31, hh = lane >> 5;
    {
        const int row = tid >> 1, half = tid & 1; const int tok = (nb - 1) * 128 + row;
        u32x4 v[4];
#pragma unroll
        for (int c = 0; c < 4; ++c) v[c] = (u32x4){0u, 0u, 0u, 0u};
        if (tok >= 0) {
#pragma unroll
            for (int c = 0; c < 4; ++c) v[c] = *(const u32x4*)(Z + (size_t)tok * INW + C_AK + kh * 64 + half * 32 + c * 8);
        }
        float f[32]; float ss = 0.f;
#pragma unroll
        for (int c = 0; c < 4; ++c)
#pragma unroll
            for (int e = 0; e < 4; ++e) { f[c * 8 + 2 * e] = bflo(v[c][e]); f[c * 8 + 2 * e + 1] = bfhi(v[c][e]); }
#pragma unroll
        for (int e = 0; e < 32; ++e) ss += f[e] * f[e];
        ss += __shfl_xor(ss, 1);
        const float rstd = rsqrtf(ss * (1.0f / 64.0f) + EPS);
#pragma unroll
        for (int c = 0; c < 8; ++c) { const f32x4 g = *(const f32x4*)(gk + half * 32 + c * 4);
#pragma unroll
            for (int e = 0; e < 4; ++e) f[c * 4 + e] *= rstd * g[e]; }
#pragma unroll
        for (int c = 0; c < 4; ++c) { u32x4 w; w.x = pk2(f[c * 8], f[c * 8 + 1]); w.y = pk2(f[c * 8 + 2], f[c * 8 + 3]); w.z = pk2(f[c * 8 + 4], f[c * 8 + 5]); w.w = pk2(f[c * 8 + 6], f[c * 8 + 7]);
            *(LAS u32x4*)(Kn + row * 144 + half * 64 + c * 16) = w; }
        if (nb == 63 && hf == 0 && row >= 128) { float* o = o_k + ((size_t)(row - 128) * 2 + kh) * 64 + half * 32;
#pragma unroll
            for (int c = 0; c < 8; ++c) *(f32x4*)(o + c * 4) = (f32x4){f[c * 4], f[c * 4 + 1], f[c * 4 + 2], f[c * 4 + 3]}; }
    }
#pragma unroll
    for (int k = 0; k < 2; ++k) {
        const int it = k * 512 + tid, kpl = it & 15, dgl = (it >> 4) & 3, rest = it >> 6, dg = dgl + 4 * (rest & 1), kp = kpl + 16 * (rest >> 1);
        const int tok0 = (nb - 1) * 128 + 2 * kp;
        u32x4 a = {0u, 0u, 0u, 0u}, b = {0u, 0u, 0u, 0u};
        if (tok0 >= 0) { const bf16_t* p = Z + (size_t)tok0 * INW + C_AV + kh * 64 + dg * 8; a = *(const u32x4*)p; b = *(const u32x4*)(p + INW); }
#pragma unroll
        for (int e = 0; e < 8; ++e) {
            const unsigned lo = (e & 1) ? (a[e >> 1] >> 16) : (a[e >> 1] & 0xffffu), hi = (e & 1) ? (b[e >> 1] & 0xffff0000u) : (b[e >> 1] << 16);
            *(LAS unsigned*)(Vt + (dg * 8 + e) * 520 + kp * 4) = lo | hi;
        }
        if (nb == 63 && hf == 0 && kp >= 64) { float* o = o_v + ((size_t)(2 * kp - 128) * 2 + kh) * 64 + dg * 8;
#pragma unroll
            for (int e = 0; e < 4; ++e) { o[2 * e] = bflo(a[e]); o[2 * e + 1] = bfhi(a[e]); o[128 + 2 * e] = bflo(b[e]); o[128 + 2 * e + 1] = bfhi(b[e]); } }
    }
    __syncthreads();
    const int hq = kh * 8 + 4 * hf + (wid >> 1), qh = wid & 1;
    const float sink = sinks[hq] * 1.4426950408889634f;
#pragma unroll 1
    for (int qq = 0; qq < 2; ++qq) {
        const int qi = 2 * qh + qq; const size_t tokq = (size_t)nb * 128 + 32 * qi + r;
        bf16x8 qf[4];
        {   const bf16_t* qp = Z + tokq * INW + hq * 64 + 8 * hh;
            u32x4 raw[4]; float ss = 0.f;
#pragma unroll
            for (int s = 0; s < 4; ++s) { raw[s] = *(const u32x4*)(qp + 16 * s);
#pragma unroll
                for (int e = 0; e < 4; ++e) { const float lo = bflo(raw[s][e]), hi = bfhi(raw[s][e]); ss += lo * lo + hi * hi; } }
            ss += __shfl_xor(ss, 32);
            const float rstd = rsqrtf(ss * (1.0f / 64.0f) + EPS) * (0.125f * 1.4426950408889634f);
#pragma unroll
            for (int s = 0; s < 4; ++s) { const f32x4 g0 = *(const f32x4*)(gq + 16 * s + 8 * hh), g1 = *(const f32x4*)(gq + 16 * s + 8 * hh + 4); u32x4 w;
                w.x = pk2(bflo(raw[s].x) * rstd * g0[0], bfhi(raw[s].x) * rstd * g0[1]); w.y = pk2(bflo(raw[s].y) * rstd * g0[2], bfhi(raw[s].y) * rstd * g0[3]);
                w.z = pk2(bflo(raw[s].z) * rstd * g1[0], bfhi(raw[s].z) * rstd * g1[1]); w.w = pk2(bflo(raw[s].w) * rstd * g1[2], bfhi(raw[s].w) * rstd * g1[3]);
                qf[s] = __builtin_bit_cast(bf16x8, w); }
        }
        f32x16 X[5];
#pragma unroll
        for (int t = 0; t < 5; ++t) { X[t] = zero16();
#pragma unroll
            for (int s = 0; s < 4; ++s) { const bf16x8 A = *(const LAS bf16x8*)(Kn + (32 * (qi + t) + r) * 144 + (16 * s + 8 * hh) * 2); X[t] = MFMA32(A, qf[s], X[t]); } }
        float m = -1e30f;
#pragma unroll
        for (int i = 0; i < 16; ++i) { X[0][i] = (crow(i, hh) >= r) ? X[0][i] : -1e30f; X[4][i] = (crow(i, hh) <= r) ? X[4][i] : -1e30f; }
#pragma unroll
        for (int t = 0; t < 5; ++t) { const bool out_t = (nb == 0) && (qi + t < 4);
#pragma unroll
            for (int i = 0; i < 16; ++i) { X[t][i] = out_t ? -1e30f : X[t][i]; m = fmaxf(m, X[t][i]); } }
        m = fmaxf(m, __shfl_xor(m, 32)); m = fmaxf(m, sink);
        float sum = 0.f;
#pragma unroll
        for (int t = 0; t < 5; ++t)
#pragma unroll
            for (int i = 0; i < 16; ++i) { const float p = __builtin_amdgcn_exp2f(X[t][i] - m); X[t][i] = p; sum += p; }
        sum += __shfl_xor(sum, 32);
        const float inv = 1.0f / (sum + __builtin_amdgcn_exp2f(sink - m));
        f32x16 o[2]; o[0] = zero16(); o[1] = zero16();
#pragma unroll
        for (int t = 0; t < 5; ++t)
#pragma unroll
            for (int s2 = 0; s2 < 2; ++s2) { const bf16x8 xs = pack8(X[t], s2);
#pragma unroll
                for (int dt = 0; dt < 2; ++dt) { const LAS unsigned char* pa = Vt + (32 * dt + r) * 520 + (32 * (qi + t) + 16 * s2 + 4 * hh) * 2;
                    const bf16x8 A = cat4(*(const LAS s16x4*)pa, *(const LAS s16x4*)(pa + 16)); o[dt] = MFMA32(A, xs, o[dt]); } }
#pragma unroll
        for (int dt = 0; dt < 2; ++dt)
#pragma unroll
            for (int g4 = 0; g4 < 4; ++g4) { u32x2 w; w.x = pk2(o[dt][4 * g4] * inv, o[dt][4 * g4 + 1] * inv); w.y = pk2(o[dt][4 * g4 + 2] * inv, o[dt][4 * g4 + 3] * inv);
                *(u32x2*)(MIX + tokq * DM + hq * 64 + 32 * dt + 8 * g4 + 4 * hh) = w; }
    }
    __syncthreads();
}

DI void attn_decode_unit(LAS unsigned char* lds, const bf16_t* Z, const float* ck, const float* cv, bf16_t* MIX, const float* gq, const float* gk, const float* sinks, float* o_k, float* o_v, int b, int kh, int tid) {
    LAS float* Kc = (LAS float*)lds; LAS float* Vc = Kc + 129 * 68; LAS float* qs = Vc + 129 * 64; LAS float* pw = qs + 512;
    const int lane = tid & 63, wid = tid >> 6;
#pragma unroll
    for (int k = 0; k < 4; ++k) {
        const int it = k * 512 + tid, w = it >> 4, c4 = (it & 15) * 4;
        const size_t src = ((size_t)(b * 128 + w) * 2 + kh) * 64 + c4;
        const f32x4 k4 = *(const f32x4*)(ck + src), v4 = *(const f32x4*)(cv + src);
        *(LAS f32x4*)(Kc + w * 68 + c4) = k4; *(LAS f32x4*)(Vc + w * 64 + c4) = v4;
        if (w >= 1) { const size_t dst = ((size_t)(b * 128 + w - 1) * 2 + kh) * 64 + c4; *(f32x4*)(o_k + dst) = k4; *(f32x4*)(o_v + dst) = v4; }
    }
    const bf16_t* zrow = Z + (size_t)(LP + b) * INW;
    const size_t dnew = ((size_t)(b * 128 + 127) * 2 + kh) * 64 + lane;
    if (wid == 0) { const float kx = bf2f(zrow[C_AK + kh * 64 + lane]); const float ss = wave_sum(kx * kx); const float kn = kx * rsqrtf(ss * (1.0f / 64.0f) + EPS) * gk[lane];
        Kc[128 * 68 + lane] = kn; o_k[dnew] = kn; }
    if (wid == 1) { const float vx = bf2f(zrow[C_AV + kh * 64 + lane]); Vc[128 * 64 + lane] = vx; o_v[dnew] = vx; }
    const int hq = kh * 8 + wid;
    { const float qx = bf2f(zrow[hq * 64 + lane]); const float ss = wave_sum(qx * qx); qs[wid * 64 + lane] = qx * rsqrtf(ss * (1.0f / 64.0f) + EPS) * gq[lane] * 0.125f; }
    __syncthreads();
    float s1 = 0.f, s2 = 0.f;
#pragma unroll 4
    for (int d4 = 0; d4 < 16; ++d4) { const f32x4 q = *(const LAS f32x4*)(qs + wid * 64 + 4 * d4), k1 = *(const LAS f32x4*)(Kc + lane * 68 + 4 * d4), k2 = *(const LAS f32x4*)(Kc + (lane + 64) * 68 + 4 * d4);
        s1 += (q[0] * k1[0] + q[1] * k1[1]) + (q[2] * k1[2] + q[3] * k1[3]); s2 += (q[0] * k2[0] + q[1] * k2[1]) + (q[2] * k2[2] + q[3] * k2[3]); }
    const float s3 = wave_sum(qs[wid * 64 + lane] * Kc[128 * 68 + lane]);
    const float sink = sinks[hq];
    const float m = fmaxf(wave_max(fmaxf(s1, s2)), fmaxf(s3, sink));
    const float p1 = __expf(s1 - m), p2 = __expf(s2 - m), p3 = __expf(s3 - m);
    const float denom = wave_sum(p1 + p2) + p3 + __expf(sink - m);
    pw[wid * 132 + lane] = p1; pw[wid * 132 + 64 + lane] = p2; if (lane == 0) pw[wid * 132 + 128] = p3;
    __syncthreads();
    float o = pw[wid * 132 + 128] * Vc[128 * 64 + lane];
#pragma unroll 4
    for (int j4 = 0; j4 < 32; ++j4) { const f32x4 p4 = *(const LAS f32x4*)(pw + wid * 132 + 4 * j4);
        o += (p4[0] * Vc[(4 * j4) * 64 + lane] + p4[1] * Vc[(4 * j4 + 1) * 64 + lane]) + (p4[2] * Vc[(4 * j4 + 2) * 64 + lane] + p4[3] * Vc[(4 * j4 + 3) * 64 + lane]); }
    MIX[(size_t)(LP + b) * DM + hq * 64 + lane] = (bf16_t)(pk2(o / denom, 0.f) & 0xffffu);
    __syncthreads();
}

template <int MT, class Epi>
DI void skinny_unit(LAS unsigned char* lds, const bf16_t* A, const bf16_t* Wt, int K, int cgi, int k0, int row0, const Epi& E, int tid) {
    const int lane = tid & 63, wid = tid >> 6, fr = lane & 15, fq = lane >> 4;
    const int c0 = cgi * 32;
    constexpr int NMT = 2 * MT;
    const bf16_t* pa = A + (size_t)(row0 + fr) * K + k0 + wid * 256 + 8 * fq;
    const bf16_t* pb = Wt + (size_t)(c0 + fr) * K + k0 + wid * 256 + 8 * fq;
    const size_t rs = (size_t)16 * K;
    f32x4 acc[NMT][2];
#pragma unroll
    for (int i = 0; i < NMT; ++i) { acc[i][0] = (f32x4){0.f, 0.f, 0.f, 0.f}; acc[i][1] = (f32x4){0.f, 0.f, 0.f, 0.f}; }
    bf16x8 fb[3][2], fa[3][NMT];
#define SK_LOAD(buf, c) do { _Pragma("unroll") for (int nt = 0; nt < 2; ++nt) fb[buf][nt] = *(const bf16x8*)(pb + nt * rs + 32 * (c)); \
        _Pragma("unroll") for (int mt = 0; mt < NMT; ++mt) fa[buf][mt] = *(const bf16x8*)(pa + mt * rs + 32 * (c)); } while (0)
#define SK_MMA(buf) do { _Pragma("unroll") for (int mt = 0; mt < NMT; ++mt) _Pragma("unroll") for (int nt = 0; nt < 2; ++nt) \
        acc[mt][nt] = __builtin_amdgcn_mfma_f32_16x16x32_bf16(fa[buf][mt], fb[buf][nt], acc[mt][nt], 0, 0, 0); } while (0)
    SK_LOAD(0, 0); SK_LOAD(1, 1);
    SK_LOAD(2, 2); SK_MMA(0);
    SK_LOAD(0, 3); SK_MMA(1);
    SK_LOAD(1, 4); SK_MMA(2);
    SK_LOAD(2, 5); SK_MMA(0);
    SK_LOAD(0, 6); SK_MMA(1);
    SK_LOAD(1, 7); SK_MMA(2);
    SK_MMA(0); SK_MMA(1);
#undef SK_LOAD
#undef SK_MMA
    constexpr int NR = 32 * MT;
    LAS float* red = (LAS float*)lds;
#pragma unroll
    for (int mt = 0; mt < NMT; ++mt)
#pragma unroll
        for (int nt = 0; nt < 2; ++nt)
#pragma unroll
            for (int j = 0; j < 4; ++j) red[(wid * NR + mt * 16 + 4 * fq + j) * 32 + nt * 16 + fr] = acc[mt][nt][j];
    __syncthreads();
    if (MT == 4) {
        const int row = tid >> 2, c8 = (tid & 3) * 8;
        f32x4 sa = {0.f, 0.f, 0.f, 0.f}, sb = {0.f, 0.f, 0.f, 0.f};
#pragma unroll
        for (int w = 0; w < 8; ++w) { sa += *(const LAS f32x4*)(red + (w * NR + row) * 32 + c8); sb += *(const LAS f32x4*)(red + (w * NR + row) * 32 + c8 + 4); }
        E(row0 + row, c0 + c8, sa); E(row0 + row, c0 + c8 + 4, sb);
    } else if (tid < 8 * NR) {
        const int row = tid >> 3, c4 = (tid & 7) * 4;
        f32x4 sa = {0.f, 0.f, 0.f, 0.f};
#pragma unroll
        for (int w = 0; w < 8; ++w) sa += *(const LAS f32x4*)(red + (w * NR + row) * 32 + c4);
        E(row0 + row, c0 + c4, sa);
    }
    __syncthreads();
}
struct SkOut { const float* xs; float* X1s; bf16_t* XBs;
    DI void operator()(int row, int col, f32x4 a) const { const f32x4 v = a + *(const f32x4*)(xs + (size_t)row * DM + col); *(f32x4*)(X1s + (size_t)row * DM + col) = v;
        u32x2 o; o.x = pk2(v[0], v[1]); o.y = pk2(v[2], v[3]); *(u32x2*)(XBs + (size_t)row * DM + col) = o; } };
struct SkUp { bf16_t* Us;
    DI void operator()(int row, int col, f32x4 a) const {
#pragma unroll
        for (int e = 0; e < 4; ++e) { a[e] = fmaxf(a[e], 0.f); a[e] *= a[e]; }
        u32x2 o; o.x = pk2(a[0], a[1]); o.y = pk2(a[2], a[3]); *(u32x2*)(Us + (size_t)row * FF + col) = o; } };
struct SkSlab { float* slab;
    DI void operator()(int row, int col, f32x4 a) const { *(f32x4*)(slab + (size_t)row * DM + col) = a; } };

#define RLX_AGENT __ATOMIC_RELAXED, __HIP_MEMORY_SCOPE_AGENT
#define XB_TMO      128
#define XB_XCNT(j)  (256  + 64 * (j))
#define XB_XSUB(j)  (1280 + 64 * (j))
#define XB_XGEN(j)  (2304 + 64 * (j))
#define XB_TOP      3328
#define XB_TOPGEN   3392
#define XCD_BAR_WORDS 3456
#define XB_SPIN_CAP (1u << 18)

__device__ __forceinline__ unsigned xb_ld(unsigned* p)              { return __hip_atomic_load(p, __ATOMIC_RELAXED, __HIP_MEMORY_SCOPE_AGENT); }
__device__ __forceinline__ unsigned xb_add(unsigned* p, unsigned v) { return __hip_atomic_fetch_add(p, v, __ATOMIC_RELAXED, __HIP_MEMORY_SCOPE_AGENT); }
__device__ __forceinline__ unsigned xb_xcc_id() { return (unsigned)__builtin_amdgcn_s_getreg((3 << 11) | 20) & 0xFu; }
#define XB_SPIN(cond, bar) do { unsigned _sp = 0; while (cond) { __builtin_amdgcn_s_sleep(1); \
    if ((++_sp & 255u) == 0u) { if (xb_ld(&(bar)[XB_TMO])) break; if (_sp > XB_SPIN_CAP) { atomicAdd(&(bar)[XB_TMO], 1u); break; } } } } while (0)

struct XcdBarrier {
    unsigned* bar; unsigned x;
    volatile LAS unsigned* st;
};

__device__ __forceinline__ XcdBarrier xcd_barrier_post(unsigned* bar, volatile LAS unsigned* st) {
    XcdBarrier b; b.bar = bar; b.x = xb_xcc_id(); b.st = st;
    if (threadIdx.x == 0) (void)xb_add(&bar[XB_XCNT(b.x)], 1u);
    return b;
}
__device__ __forceinline__ void xcd_barrier_complete(unsigned* bar, unsigned x, unsigned& nloc, unsigned& nx) {
    const unsigned G = gridDim.x * gridDim.y * gridDim.z;
    unsigned sum, cnt, mine, sp = 0u;
    for (;;) {
        sum = 0u; cnt = 0u; mine = 0u;
#pragma unroll
        for (unsigned j = 0; j < 16; ++j) { const unsigned c = xb_ld(&bar[XB_XCNT(j)]); sum += c; cnt += (c > 0u) ? 1u : 0u; mine = (j == x) ? c : mine; }
        if (sum == G) break;
        __builtin_amdgcn_s_sleep(1);
        if ((++sp & 255u) == 0u) { if (xb_ld(&bar[XB_TMO])) break; if (sp > XB_SPIN_CAP) { atomicAdd(&bar[XB_TMO], 1u); break; } }
    }
    nloc = mine > 0u ? mine : 1u; nx = cnt > 0u ? cnt : 1u;
}

__device__ __forceinline__ void xcd_barrier(const XcdBarrier& b) {
    asm volatile("s_waitcnt vmcnt(0)" ::: "memory");
    __syncthreads();
    if (threadIdx.x == 0) {
        unsigned* bar = b.bar;
        __builtin_amdgcn_s_waitcnt(0);
        unsigned nloc = b.st[0], nx = b.st[1];
        if (nloc == 0u) { xcd_barrier_complete(bar, b.x, nloc, nx); b.st[0] = nloc; b.st[1] = nx; }
        const unsigned old = xb_add(&bar[XB_XSUB(b.x)], 1u);
        const unsigned gen = old / nloc;
        if (old + 1u == (gen + 1u) * nloc) {
            __builtin_amdgcn_fence(__ATOMIC_RELEASE, "agent");
            asm volatile("s_waitcnt vmcnt(0)" ::: "memory");
            const unsigned og = xb_add(&bar[XB_TOP], 1u);
            const unsigned tg = og / nx;
            if (og + 1u == (tg + 1u) * nx) xb_add(&bar[XB_TOPGEN], 1u);
            else XB_SPIN(xb_ld(&bar[XB_TOPGEN]) == tg, bar);
            __builtin_amdgcn_fence(__ATOMIC_ACQUIRE, "agent");
            xb_add(&bar[XB_XGEN(b.x)], 1u);
            asm volatile("s_waitcnt vmcnt(0)" ::: "memory");
        } else {
            XB_SPIN(xb_ld(&bar[XB_XGEN(b.x)]) == gen, bar);
            __builtin_amdgcn_fence(__ATOMIC_ACQUIRE, "agent");
            asm volatile("s_waitcnt vmcnt(0)" ::: "memory");
        }
    }
    __syncthreads();
}

struct Args { const float* in[15]; float* out; unsigned char* ws; int ph_lo, ph_hi; };
constexpr int NPH = 9;
constexpr int NP0_REST = 9216;

__global__ void __launch_bounds__(512, 2) fwd_kernel(Args a) {
    extern __shared__ __attribute__((aligned(16))) unsigned char lds_raw[];
    LAS unsigned char* lds = (LAS unsigned char*)lds_raw;
    cg::grid_group grid = cg::this_grid();
    const int tid = threadIdx.x, lane = tid & 63, wid = __builtin_amdgcn_readfirstlane(tid >> 6);
    const int G = gridDim.x, bx = blockIdx.x;
    unsigned char* ws = a.ws; float* out = a.out;
    const float* x_p = a.in[0]; const float* x_s = a.in[1]; const float* cache_k = a.in[2]; const float* cache_v = a.in[3]; const float* state0 = a.in[4];
    const float* ln1_g = a.in[5]; const float* w_in = a.in[6]; const float* gq = a.in[7]; const float* gk = a.in[8]; const float* sinks = a.in[9];
    const float* rng = a.in[10]; const float* w_out = a.in[11]; const float* ln2_g = a.in[12]; const float* w_up = a.in[13]; const float* w_dn = a.in[14];
    bf16_t* WIN = (bf16_t*)(ws + WS_WIN); bf16_t* WOUT = (bf16_t*)(ws + WS_WOUT); bf16_t* WUP = (bf16_t*)(ws + WS_WUP); bf16_t* WDN = (bf16_t*)(ws + WS_WDN);
    bf16_t* H1 = (bf16_t*)(ws + WS_H1); bf16_t* XG = H1; bf16_t* MIX = (bf16_t*)(ws + WS_MIX); bf16_t* Z = (bf16_t*)(ws + WS_Z); bf16_t* U = (bf16_t*)(ws + WS_U);
    float* PART = (float*)(ws + WS_PART); float* RSTD2 = (float*)(ws + WS_RSTD2); bf16_t* KV = (bf16_t*)(ws + WS_KV); bf16_t* SP = (bf16_t*)(ws + WS_SP); float* SLAB = (float*)(ws + WS_SP);
    const int lo = a.ph_lo, hi = a.ph_hi;
#define IN(k) (lo <= (k) && (k) < hi)
    volatile LAS unsigned* MISC = (volatile LAS unsigned*)(lds + LDS_BYTES - 64);
    if (tid < 16) MISC[tid] = 0u;
    __syncthreads();
    const XcdBarrier bar = xcd_barrier_post((unsigned*)ws + 1024, MISC + 8);
    if (lo > hi) grid.sync();
#define SEAM(k) do { if (IN(k) && IN((k) + 1)) xcd_barrier(bar); } while (0)

    if (IN(0)) for (int rep_ = 0; rep_ < 1 + ((DUPMASK >> 0) & 1); ++rep_) { if (rep_) xcd_barrier(bar);
        LAS float* scr = (LAS float*)(lds + wid * 17408);
        const int gw = bx * 8 + wid, NGW = G * 8;
        constexpr int I_IN = (DM / 64) * (INW / 32);
        p0_convert(ResIn{w_in, WIN}, gw, NGW, I_IN, scr, lane);
        for (int m = gw; m < MP; m += NGW) {
            if (m < MR) rms_row(m < LP ? x_p + (size_t)m * DM : x_s + (size_t)(m - LP) * DM, ln1_g, H1 + (size_t)m * DM, lane);
            else {
#pragma unroll
                for (int j = 0; j < 8; ++j) *((u32x2*)(H1 + (size_t)m * DM) + lane + 64 * j) = (u32x2){0u, 0u};
            }
        }
    }
    SEAM(0);
    if (IN(1)) for (int rep_ = 0; rep_ < 1 + ((DUPMASK >> 1) & 1); ++rep_) { if (rep_) xcd_barrier(bar);
        pg8::Gemm g{H1, WIN, MP, INW, DM}; pg8::StaticOrder S; S.init(MP, INW, G, bx, WGM_IN);
        pg8::EpiIn E{Z};
        pg8::gemm_phase<pg8::EpiIn, pg8::StaticOrder, true, true>(lds, g, S, E);
        {
            constexpr int NT = (MP / 256) * (INW / 256); const int rounds = (NT + G - 1) / G, first_idle = NT - (rounds - 1) * G;
            const int nidle = (first_idle < G) ? (G - first_idle) : G, me = (first_idle < G) ? (bx - first_idle) : bx;
            if (me >= 0) {
                LAS float* scr = (LAS float*)(lds + wid * 17408);
                constexpr int I_OUT = (DM / 64) * (DM / 32), I_UP = (DM / 64) * (FF / 32), I_DN = (FF / 64) * (DM / 32);
                p0_convert(ResRest{w_out, w_up, w_dn, WOUT, WUP, WDN, ln2_g}, NP0_REST + me * 8 + wid, nidle * 8, I_OUT + I_UP + I_DN, scr, lane);
            }
        }
    }
    SEAM(1);
    if (IN(2)) for (int rep_ = 0; rep_ < 1 + ((DUPMASK >> 2) & 1); ++rep_) { if (rep_) xcd_barrier(bar);
        if (bx & 1) for (int u = bx; u < 256; u += G) ret_decode_unit(lds, Z, state0, out + O_SS, MIX, rng, u >> 2, u & 3, tid);
        for (int u = bx; u < 256; u += G) ret_step1(lds, Z, KV, u >> 2, u & 3, tid);
        if (!(bx & 1)) for (int u = bx; u < 256; u += G) ret_decode_unit(lds, Z, state0, out + O_SS, MIX, rng, u >> 2, u & 3, tid);
    }
    SEAM(2);
    if (IN(3)) for (int rep_ = 0; rep_ < 1 + ((DUPMASK >> 3) & 1); ++rep_) { if (rep_) xcd_barrier(bar);
        if (tid < 256) ret_scan(KV, SP, out + O_SP, bx * 256 + tid, G * 256);
        if (bx & 1) for (int u = bx; u < 256; u += G) attn_decode_unit(lds, Z, cache_k, cache_v, MIX, gq, gk, sinks, out + O_KS, out + O_VS, u >> 1, u & 1, tid);
        for (int u = 256 + bx; u < 512; u += G) ret_decode_unit(lds, Z, state0, out + O_SS, MIX, rng, u >> 2, u & 3, tid);
        if (!(bx & 1)) for (int u = bx; u < 256; u += G) attn_decode_unit(lds, Z, cache_k, cache_v, MIX, gq, gk, sinks, out + O_KS, out + O_VS, u >> 1, u & 1, tid);
    }
    SEAM(3);
    if (IN(4)) for (int rep_ = 0; rep_ < 1 + ((DUPMASK >> 4) & 1); ++rep_) { if (rep_) xcd_barrier(bar);
        for (int u = bx; u < 256; u += G) ret_step2(lds, Z, SP, MIX, rng, u >> 2, u & 3, tid);
        for (int u = bx; u < 256; u += G) attn_prompt_unit(lds, Z, MIX, gq, gk, sinks, out + O_KP, out + O_VP, u >> 2, (u >> 1) & 1, u & 1, tid);
        {
            LAS float* scr = (LAS float*)(lds + wid * 17408);
            p0_convert(ResRest{w_out, w_up, w_dn, WOUT, WUP, WDN, ln2_g}, bx * 8 + wid, G * 8, NP0_REST, scr, lane);
        }
    }
    SEAM(4);
    if (IN(5)) for (int rep_ = 0; rep_ < 1 + ((DUPMASK >> 5) & 1); ++rep_) { if (rep_) xcd_barrier(bar);
        pg8::Gemm g{MIX, WOUT, LP, DM, DM}; pg8::StaticOrder S; S.init(LP, DM, G, bx, WGM_OUT);
        pg8::EpiOut E{x_p, XG, PART};
        pg8::gemm_phase<pg8::EpiOut, pg8::StaticOrder, true, true>(lds, g, S, E);
        const SkOut SE{x_s, out + O_Y + (size_t)LP * DM, XG + (size_t)LP * DM};
        for (int u = bx; u < 4 * (DM / 32); u += G) skinny_unit<1>(lds, MIX + (size_t)LP * DM, WOUT, DM, u >> 2, 0, (u & 3) * 32, SE, tid);
    }
    SEAM(5);
    if (IN(6)) for (int rep_ = 0; rep_ < 1 + ((DUPMASK >> 6) & 1); ++rep_) { if (rep_) xcd_barrier(bar);
        for (int row = bx + G * tid; row < LP; row += G * 512) { float s = 0.f;
#pragma unroll
            for (int j = 0; j < 8; ++j) { const f32x4 p = *(const f32x4*)(PART + (size_t)row * 32 + 4 * j); s += (p[0] + p[1]) + (p[2] + p[3]); }
            RSTD2[row] = 1.0f / (s * (1.0f / DM) + EPS); }
        for (int row = LP + bx * 8 + wid; row < MR; row += G * 8) {
            const float* xr = out + O_Y + (size_t)row * DM; float s = 0.f;
#pragma unroll
            for (int j = 0; j < 8; ++j) { const f32x4 v = *((const f32x4*)xr + lane + 64 * j); s += (v[0] * v[0] + v[1] * v[1]) + (v[2] * v[2] + v[3] * v[3]); }
            s = wave_sum(s); if (lane == 0) RSTD2[row] = 1.0f / (s * (1.0f / DM) + EPS); }
        pg8::Gemm g{XG, WUP, LP, FF, DM}; pg8::StaticOrder S; S.init(LP, FF, G, bx, WGM_UP);
        pg8::EpiUp E{U};
        pg8::gemm_phase<pg8::EpiUp, pg8::StaticOrder, true, true>(lds, g, S, E);
        const SkUp SE{U + (size_t)LP * FF};
        for (int u = bx; u < FF / 32; u += G) skinny_unit<4>(lds, XG + (size_t)LP * DM, WUP, DM, u, 0, 0, SE, tid);
    }
    SEAM(6);
    if (IN(7)) {
        if (bx & 1) for (int u = bx; u < 4 * (DM / 32); u += G) { const SkSlab SE{SLAB + (size_t)(u & 3) * NS * DM}; skinny_unit<4>(lds, U + (size_t)LP * FF, WDN, FF, u >> 2, (u & 3) * 2048, 0, SE, tid); }
        pg8::Gemm g{U, WDN, LP, DM, FF}; pg8::StaticOrder S; S.init(LP, DM, G, bx, WGM_DN);
        pg8::EpiDown E{out + O_Y, XG, RSTD2};
        pg8::gemm_phase<pg8::EpiDown, pg8::StaticOrder, true, true>(lds, g, S, E);
        if (!(bx & 1)) for (int u = bx; u < 4 * (DM / 32); u += G) { const SkSlab SE{SLAB + (size_t)(u & 3) * NS * DM}; skinny_unit<4>(lds, U + (size_t)LP * FF, WDN, FF, u >> 2, (u & 3) * 2048, 0, SE, tid); }
    }
    SEAM(7);
    if (IN(8)) {
        for (int e = bx * 512 + tid; e < NS * DM / 4; e += G * 512) {
            const int row = e >> 9; float* p = out + O_Y + (size_t)LP * DM + (size_t)e * 4;
            const f32x4 s = (*(const f32x4*)(SLAB + (size_t)e * 4) + *(const f32x4*)(SLAB + (size_t)NS * DM + (size_t)e * 4)) + (*(const f32x4*)(SLAB + (size_t)2 * NS * DM + (size_t)e * 4) + *(const f32x4*)(SLAB + (size_t)3 * NS * DM + (size_t)e * 4));
            *(f32x4*)p = *(const f32x4*)p + s * RSTD2[LP + row];
        }
    }
#undef IN
#undef SEAM
}

#ifndef N_LAUNCHES
#define N_LAUNCHES 1
#endif
extern "C" void kernel_launch(void* const* d_in, const int* in_sizes, int n_in, void* d_out, int out_size, void* d_ws, size_t ws_size, hipStream_t stream) {
    static int grid = 0;
    if (grid == 0) {
        if (n_in != 15 || (size_t)out_size != O_END || ws_size < WS_END) { fprintf(stderr, "kernel_launch: unexpected shapes (n_in %d out %d ws %zu)\n", n_in, out_size, ws_size); grid = -1; return; }
        int dev = 0, cus = 0, per_cu = 0;
        (void)hipGetDevice(&dev); (void)hipDeviceGetAttribute(&cus, hipDeviceAttributeMultiprocessorCount, dev);
        if (hipFuncSetAttribute((const void*)fwd_kernel, hipFuncAttributeMaxDynamicSharedMemorySize, LDS_BYTES) != hipSuccess) { fprintf(stderr, "kernel_launch: hipFuncSetAttribute failed\n"); grid = -1; return; }
        (void)hipOccupancyMaxActiveBlocksPerMultiprocessor(&per_cu, (const void*)fwd_kernel, 512, LDS_BYTES);
        (void)hipGetLastError();
        if (per_cu < 1) { fprintf(stderr, "kernel_launch: occupancy query says %d blocks per CU\n", per_cu); }
        grid = cus > 0 ? cus : 256;
    }
    if (grid < 0) return;
    if (hipMemsetAsync(d_ws, 0, 65536, stream) != hipSuccess) { fprintf(stderr, "kernel_launch: memset failed\n"); return; }
    Args a{};
    for (int i = 0; i < 15; ++i) a.in[i] = (const float*)d_in[i];
    a.out = (float*)d_out; a.ws = (unsigned char*)d_ws;
    if (N_LAUNCHES == 1) {
        a.ph_lo = 0; a.ph_hi = NPH;
        void* args[] = {&a};
        hipError_t e = hipLaunchCooperativeKernel((const void*)fwd_kernel, dim3(grid), dim3(512), args, LDS_BYTES, stream);
        if (e != hipSuccess) fprintf(stderr, "cooperative launch failed: %s (grid %d)\n", hipGetErrorString(e), grid);
    } else {
        for (int p = 0; p < NPH; ++p) { a.ph_lo = p; a.ph_hi = p + 1; hipLaunchKernelGGL(fwd_kernel, dim3(grid), dim3(512), LDS_BYTES, stream, a); }
    }
}
```
